# Optimizing an MI355X kernel written in HIP

```python
import jax, jax.numpy as jnp
from jax import lax
import numpy as np

D_MODEL = 2048
BATCH = 4
SEQ = 2048
DEPTH = 1

PLE_DIM = 256
MLA_HEADS = 8
QK_NOPE = 128
QK_ROPE = 64
V_HEAD = 128
Q_LORA = 512
KV_LORA = 256
ROPE_THETA = 10000.0
Q_BLOCK = 128
SGU_GROUPS = 8
SGU_GROUP_DIM = 128
CHUNK = 128
MLA_WIDTH = MLA_HEADS * V_HEAD
SGU_WIDTH = SGU_GROUPS * SGU_GROUP_DIM
MIX_WIDTH = MLA_WIDTH + SGU_WIDTH
OFF_CKV = Q_LORA
OFF_KR = Q_LORA + KV_LORA
OFF_U = OFF_KR + QK_ROPE
OFF_V = OFF_U + SGU_WIDTH
IN_COLS = OFF_V + SGU_WIDTH
PEER_HEADS = 8
PEER_KEYS = 128
PEER_QDIM = 256
PEER_TOPK = 16
N_EXPERTS = PEER_KEYS * PEER_KEYS
EPS = 1e-6

kernel_name = "hymba_mla_sgu_peer_ple_block"


def rmsnorm(x, g):
    xf = x.astype(jnp.float32)
    y = xf * lax.rsqrt(jnp.mean(xf * xf, axis=-1, keepdims=True) + EPS)
    return (y * g.astype(jnp.float32)).astype(x.dtype)


def layernorm(x, g, b):
    xf = x.astype(jnp.float32)
    mu = jnp.mean(xf, axis=-1, keepdims=True)
    xc = xf - mu
    y = xc * lax.rsqrt(jnp.mean(xc * xc, axis=-1, keepdims=True) + EPS)
    return (y * g.astype(jnp.float32) + b.astype(jnp.float32)).astype(x.dtype)


def rope(x, pos):
    half = x.shape[-1] // 2
    freqs = ROPE_THETA ** (-jnp.arange(half, dtype=jnp.float32) / half)
    ang = pos.astype(jnp.float32)[..., None] * freqs
    cos = jnp.cos(ang)[:, :, None, :]
    sin = jnp.sin(ang)[:, :, None, :]
    xf = x.astype(jnp.float32)
    x1, x2 = xf[..., :half], xf[..., half:]
    out = jnp.concatenate([x1 * cos - x2 * sin, x2 * cos + x1 * sin], axis=-1)
    return out.astype(x.dtype)


def causal_block_attention(q, k, v):
    B, S, H, Dq = q.shape
    nb = S // Q_BLOCK
    scale = Dq ** -0.5
    qb = jnp.moveaxis(q.reshape(B, nb, Q_BLOCK, H, Dq), 1, 0)
    k_pos = jnp.arange(S)

    def one(args):
        q_blk, start = args
        s = jnp.einsum('bqhd,bkhd->bhqk', q_blk, k, preferred_element_type=jnp.float32) * scale
        q_pos = start + jnp.arange(Q_BLOCK)
        mask = k_pos[None, :] <= q_pos[:, None]
        s = jnp.where(mask[None, None], s, -jnp.inf)
        pr = jax.nn.softmax(s, axis=-1)
        return jnp.einsum('bhqk,bkhd->bqhd', pr.astype(v.dtype), v)

    starts = jnp.arange(nb) * Q_BLOCK
    out = lax.map(one, (qb, starts))
    return jnp.moveaxis(out, 0, 1).reshape(B, S, H, v.shape[-1])


def mla(c_q, c_kv, k_r, pos, g_cq, w_uq, g_ckv, w_ukv):
    B, S, _ = c_q.shape
    q = (rmsnorm(c_q, g_cq) @ w_uq).reshape(B, S, MLA_HEADS, QK_NOPE + QK_ROPE)
    kv = (rmsnorm(c_kv, g_ckv) @ w_ukv).reshape(B, S, MLA_HEADS, QK_NOPE + V_HEAD)
    q_nope, q_rope = q[..., :QK_NOPE], rope(q[..., QK_NOPE:], pos)
    k_nope, v = kv[..., :QK_NOPE], kv[..., QK_NOPE:]
    k_rope = rope(k_r[:, :, None, :], pos)
    q = jnp.concatenate([q_nope, q_rope], axis=-1)
    k = jnp.concatenate([k_nope, jnp.broadcast_to(k_rope, (B, S, MLA_HEADS, QK_ROPE))], axis=-1)
    o = causal_block_attention(q, k, v)
    return o.reshape(B, S, MLA_WIDTH)


def chunked_sgu(u, v, g_ln, b_ln, w_s, b_s):
    B, S, _ = u.shape
    nc = S // CHUNK
    u = jax.nn.gelu(u).reshape(B, nc, CHUNK, SGU_GROUPS, SGU_GROUP_DIM)
    v = layernorm(jax.nn.gelu(v).reshape(B, S, SGU_GROUPS, SGU_GROUP_DIM), g_ln, b_ln)
    v = v.reshape(B, nc, CHUNK, SGU_GROUPS, SGU_GROUP_DIM)
    w = w_s * jnp.tril(jnp.ones((CHUNK, CHUNK), dtype=w_s.dtype))[None]
    mixed = jnp.einsum('gts,bcsgd->bctgd', w, v) + jnp.transpose(b_s)[None, None, :, :, None]
    return (u * mixed).reshape(B, S, SGU_WIDTH)


def peer(a, w_q, k1, k2, u_exp, v_exp):
    B, S, D = a.shape
    half = PEER_QDIM // 2
    q = (a @ w_q).reshape(B, S, PEER_HEADS, PEER_QDIM)
    s1 = jnp.einsum('bshd,hnd->bshn', q[..., :half], k1, preferred_element_type=jnp.float32)
    s2 = jnp.einsum('bshd,hnd->bshn', q[..., half:], k2, preferred_element_type=jnp.float32)
    t1, i1 = lax.top_k(s1, PEER_TOPK)
    t2, i2 = lax.top_k(s2, PEER_TOPK)
    cand = (t1[..., :, None] + t2[..., None, :]).reshape(B, S, PEER_HEADS, PEER_TOPK * PEER_TOPK)
    cand_idx = (i1[..., :, None] * PEER_KEYS + i2[..., None, :]).reshape(B, S, PEER_HEADS, PEER_TOPK * PEER_TOPK)
    top, sel = lax.top_k(cand, PEER_TOPK)
    experts = jnp.take_along_axis(cand_idx, sel, axis=-1)
    gates = jax.nn.softmax(top, axis=-1)
    nc = S // CHUNK

    def to_chunks(t):
        return jnp.moveaxis(t.reshape((B, nc, CHUNK) + t.shape[2:]), 1, 0)

    def one(args):
        a_c, e_c, g_c = args
        u_sel = jnp.take(u_exp, e_c, axis=0)
        h = jnp.einsum('bthkd,btd->bthk', u_sel, a_c, preferred_element_type=jnp.float32)
        w = (g_c * jax.nn.gelu(h)).astype(a_c.dtype)
        v_sel = jnp.take(v_exp, e_c, axis=0)
        return jnp.einsum('bthk,bthkd->btd', w, v_sel)

    out = lax.map(one, (to_chunks(a), to_chunks(experts), to_chunks(gates)))
    return jnp.moveaxis(out, 0, 1).reshape(B, S, D)


def setup_inputs(seed: int = 0) -> dict:
    key = jax.random.key(seed)
    ks = iter(jax.random.split(key, 40))

    def nrm(shape, scale):
        return jax.random.normal(next(ks), shape, dtype=jnp.float32) * scale

    def gain(shape):
        return 1.0 + nrm(shape, 0.02)

    L = DEPTH
    x = nrm((BATCH, SEQ, D_MODEL), 1.0)
    p = nrm((DEPTH, BATCH, SEQ, PLE_DIM), 1.0)
    positions = (jax.random.randint(next(ks), (BATCH, 1), 0, 4096, dtype=jnp.int32)
                 + jnp.arange(SEQ, dtype=jnp.int32)[None, :])
    return {
        "x": x,
        "p": p,
        "positions": positions,
        "g_mix": gain((L, D_MODEL)),
        "w_in": nrm((L, D_MODEL, IN_COLS), D_MODEL ** -0.5),
        "g_cq": gain((L, Q_LORA)),
        "w_uq": nrm((L, Q_LORA, MLA_HEADS * (QK_NOPE + QK_ROPE)), Q_LORA ** -0.5),
        "g_ckv": gain((L, KV_LORA)),
        "w_ukv": nrm((L, KV_LORA, MLA_HEADS * (QK_NOPE + V_HEAD)), KV_LORA ** -0.5),
        "g_ln_sgu": gain((L, SGU_GROUPS, SGU_GROUP_DIM)),
        "b_ln_sgu": nrm((L, SGU_GROUPS, SGU_GROUP_DIM), 0.02),
        "w_sgu": nrm((L, SGU_GROUPS, CHUNK, CHUNK), CHUNK ** -0.5),
        "b_sgu": gain((L, SGU_GROUPS, CHUNK)),
        "g_out_attn": gain((L, MLA_WIDTH)),
        "g_out_sgu": gain((L, SGU_WIDTH)),
        "w_out": nrm((L, MIX_WIDTH, D_MODEL), MIX_WIDTH ** -0.5),
        "g_ffn": gain((L, D_MODEL)),
        "w_peer_q": nrm((L, D_MODEL, PEER_HEADS * PEER_QDIM), D_MODEL ** -0.5),
        "peer_k1": nrm((L, PEER_HEADS, PEER_KEYS, PEER_QDIM // 2), (PEER_QDIM // 2) ** -0.5),
        "peer_k2": nrm((L, PEER_HEADS, PEER_KEYS, PEER_QDIM // 2), (PEER_QDIM // 2) ** -0.5),
        "peer_u": nrm((L, N_EXPERTS, D_MODEL), D_MODEL ** -0.5),
        "peer_v": nrm((L, N_EXPERTS, D_MODEL), PEER_HEADS ** -0.5),
        "g_ple": gain((L, D_MODEL)),
        "w_ple_gate": nrm((L, D_MODEL, D_MODEL), D_MODEL ** -0.5),
        "w_ple_proj": nrm((L, PLE_DIM, D_MODEL), PLE_DIM ** -0.5),
        "g_final": gain((D_MODEL,)),
    }


def reference(x, p, positions, g_mix, w_in, g_cq, w_uq, g_ckv, w_ukv, g_ln_sgu, b_ln_sgu,
              w_sgu, b_sgu, g_out_attn, g_out_sgu, w_out, g_ffn, w_peer_q, peer_k1, peer_k2,
              peer_u, peer_v, g_ple, w_ple_gate, w_ple_proj, g_final):
    h = x
    for i in range(DEPTH):
        z = rmsnorm(h, g_mix[i]) @ w_in[i]
        c_q = z[..., :OFF_CKV]
        c_kv = z[..., OFF_CKV:OFF_KR]
        k_r = z[..., OFF_KR:OFF_U]
        u = z[..., OFF_U:OFF_V]
        v = z[..., OFF_V:]
        o_attn = rmsnorm(mla(c_q, c_kv, k_r, positions, g_cq[i], w_uq[i], g_ckv[i], w_ukv[i]),
                         g_out_attn[i])
        o_sgu = rmsnorm(chunked_sgu(u, v, g_ln_sgu[i], b_ln_sgu[i], w_sgu[i], b_sgu[i]),
                        g_out_sgu[i])
        h = h + jnp.concatenate([o_attn, o_sgu], axis=-1) @ w_out[i]
        h = h + peer(rmsnorm(h, g_ffn[i]), w_peer_q[i], peer_k1[i], peer_k2[i], peer_u[i], peer_v[i])
        gate = jax.nn.sigmoid(rmsnorm(h, g_ple[i]) @ w_ple_gate[i])
        h = h + gate * (p[i] @ w_ple_proj[i])
    return rmsnorm(h, g_final)
```

```cpp
#include <hip/hip_runtime.h>
#include <hip/hip_bf16.h>
#include <cstdio>
#include <cstdint>
#include <cmath>
#ifndef CUT
#define CUT 0
#endif
#ifndef ONE_LAUNCH
#define ONE_LAUNCH 0
#endif
constexpr int T_TOK = 8192, DM = 2048, SEQ = 2048, NBATCH = 4;
constexpr size_t MiB = 1u << 20;
constexpr size_t WS_CTL = 0;
constexpr size_t WS_WT_IN = 1 * MiB, WS_WT_UQ = 13 * MiB, WS_WT_UKV = 14 * MiB + 512 * 1024, WS_WT_PP = 15 * MiB + 512 * 1024;
constexpr size_t WS_K1B = 16 * MiB + 512 * 1024, WS_K2B = WS_K1B + 256 * 1024, WS_WSGU = 17 * MiB;
constexpr size_t WS_WT_OUT = 18 * MiB, WS_WT_PQ = 26 * MiB, WS_WT_PG = 34 * MiB;
constexpr size_t WS_UB = 42 * MiB, WS_VB = 106 * MiB;
constexpr size_t WS_R1 = 170 * MiB;
constexpr size_t WS_PB = 202 * MiB, WS_CS = 206 * MiB, WS_RSX = 208 * MiB, WS_RSH2 = 208 * MiB + 512 * 1024;
constexpr size_t WS_CQ = 209 * MiB, WS_CKV = 217 * MiB, WS_KR = 221 * MiB, WS_UG = 222 * MiB, WS_VG = 238 * MiB;
constexpr size_t WS_PSCQ = 254 * MiB, WS_PSCKV = 254 * MiB + 512 * 1024, WS_PSV = 255 * MiB;
constexpr size_t WS_Q = 257 * MiB, WS_KN = 281 * MiB, WS_VV = 297 * MiB, WS_H1B = 257 * MiB;
constexpr size_t WS_MIX = 313 * MiB, WS_PSA = 345 * MiB, WS_PSS = 345 * MiB + 512 * 1024;
constexpr size_t WS_H1 = 346 * MiB, WS_PSH1 = 410 * MiB, WS_IDX = 412 * MiB, WS_GATE = 416 * MiB, WS_PPROJ = 420 * MiB, WS_PSH3 = 452 * MiB;
constexpr size_t WS_NA0 = 454 * MiB, WS_NGL = 470 * MiB, WS_NPP = 486 * MiB, WS_END = 502 * MiB;
constexpr size_t WS_NZP = 42 * MiB, WS_NCQN = 65 * MiB, WS_NCKVN = 69 * MiB, WS_NQN = 71 * MiB, WS_NKV = 83 * MiB, WS_NVLN = 99 * MiB, WS_NOSGU = 107 * MiB, WS_NOATT = 115 * MiB, WS_NQPN = 123 * MiB;
namespace nv {
constexpr int TBAT = 2048;
__device__ __forceinline__ float gelu_t(float x) { const float c = 0.7978845608028654f; const float u = c * (x + 0.044715f * x * x * x); return 0.5f * x * (1.f + tanhf(u)); }
__device__ __forceinline__ float wave_sum(float v) {
#pragma unroll
    for (int o = 1; o < 64; o <<= 1) v += __shfl_xor(v, o);
    return v;
}
__device__ __forceinline__ float wave_max(float v) {
#pragma unroll
    for (int o = 1; o < 64; o <<= 1) v = fmaxf(v, __shfl_xor(v, o));
    return v;
}
__device__ __forceinline__ float blk_sum(float v, float* sh) {
    v = wave_sum(v); __syncthreads();
    if ((threadIdx.x & 63) == 0) sh[threadIdx.x >> 6] = v; __syncthreads();
    float r = 0.f; for (int i = 0; i < (int)(blockDim.x >> 6); ++i) r += sh[i]; return r;
}
__device__ __forceinline__ float blk_max(float v, float* sh) {
    v = wave_max(v); __syncthreads();
    if ((threadIdx.x & 63) == 0) sh[threadIdx.x >> 6] = v; __syncthreads();
    float r = sh[0]; for (int i = 1; i < (int)(blockDim.x >> 6); ++i) r = fmaxf(r, sh[i]); return r;
}
__global__ void __launch_bounds__(256) nk_rmsnorm(const float* x, size_t ldx, const float* g, float* out, size_t ldo, int D) {
    __shared__ float sh[8];
    const float* xr = x + (size_t)blockIdx.x * ldx; float* orow = out + (size_t)blockIdx.x * ldo;
    float s = 0.f; for (int i = threadIdx.x; i < D; i += 256) { const float v = xr[i]; s += v * v; }
    s = blk_sum(s, sh); const float r = rsqrtf(s / (float)D + 1e-6f);
    for (int i = threadIdx.x; i < D; i += 256) orow[i] = xr[i] * r * g[i];
}
__global__ void __launch_bounds__(256) nk_gemm(const float* A, size_t lda, const float* B, size_t ldb, float* C, size_t ldc, const float* R, size_t ldr, int K) {
    __shared__ float As[16][68], Bs[16][68];
    const int tid = threadIdx.x, tx = tid & 15, ty = tid >> 4, m0 = blockIdx.y * 64, n0 = blockIdx.x * 64;
    float acc[4][4] = {};
    for (int k0 = 0; k0 < K; k0 += 16) {
        { const int r = tid >> 2, c = (tid & 3) * 4; const float4 v = *(const float4*)(A + (size_t)(m0 + r) * lda + k0 + c); As[c][r] = v.x; As[c + 1][r] = v.y; As[c + 2][r] = v.z; As[c + 3][r] = v.w; }
        { const int r = tid >> 4, c = (tid & 15) * 4; const float4 v = *(const float4*)(B + (size_t)(k0 + r) * ldb + n0 + c); Bs[r][c] = v.x; Bs[r][c + 1] = v.y; Bs[r][c + 2] = v.z; Bs[r][c + 3] = v.w; }
        __syncthreads();
#pragma unroll
        for (int k = 0; k < 16; ++k) { float a[4], b[4];
#pragma unroll
            for (int i = 0; i < 4; ++i) { a[i] = As[k][ty * 4 + i]; b[i] = Bs[k][tx * 4 + i]; }
#pragma unroll
            for (int i = 0; i < 4; ++i)
#pragma unroll
                for (int j = 0; j < 4; ++j) acc[i][j] += a[i] * b[j]; }
        __syncthreads();
    }
#pragma unroll
    for (int i = 0; i < 4; ++i)
#pragma unroll
        for (int j = 0; j < 4; ++j) { const size_t r = m0 + ty * 4 + i, c = n0 + tx * 4 + j; C[r * ldc + c] = acc[i][j] + (R ? R[r * ldr + c] : 0.f); }
}
__device__ __forceinline__ void rope_cs(int pos, int i, float& c, float& s) { const double f = pow(10000.0, -(double)i / 32.0); const double a = (double)pos * f; c = (float)cos(a); s = (float)sin(a); }
__global__ void __launch_bounds__(256) nk_z_post(float* Z, const int* pos) {
    float* z = Z + (size_t)blockIdx.x * 2880; const int t = threadIdx.x;
    if (t < 32) { float c, s; rope_cs(pos[blockIdx.x], t, c, s); const float x1 = z[768 + t], x2 = z[800 + t]; z[768 + t] = x1 * c - x2 * s; z[800 + t] = x2 * c + x1 * s; }
    for (int i = 832 + t; i < 2880; i += 256) z[i] = gelu_t(z[i]);
}
__global__ void __launch_bounds__(256) nk_q_rope(float* Q, const int* pos) {
    float* q = Q + (size_t)blockIdx.x * 1536; const int h = threadIdx.x >> 5, i = threadIdx.x & 31;
    float c, s; rope_cs(pos[blockIdx.x], i, c, s); float* p = q + h * 192 + 128; const float x1 = p[i], x2 = p[32 + i]; p[i] = x1 * c - x2 * s; p[32 + i] = x2 * c + x1 * s;
}
__global__ void __launch_bounds__(256) nk_ln_group(const float* Z, const float* gln, const float* bln, float* VLN) {
    const int wv = blockIdx.x * 4 + (threadIdx.x >> 6), lane = threadIdx.x & 63, row = wv >> 3, g = wv & 7;
    const float* v = Z + (size_t)row * 2880 + 1856 + g * 128; const float a = v[lane], b = v[lane + 64];
    const float mu = wave_sum(a + b) * (1.f / 128.f); const float da = a - mu, db = b - mu; const float var = wave_sum(da * da + db * db) * (1.f / 128.f); const float r = rsqrtf(var + 1e-6f);
    float* o = VLN + (size_t)row * 1024 + g * 128; o[lane] = da * r * gln[g * 128 + lane] + bln[g * 128 + lane]; o[lane + 64] = db * r * gln[g * 128 + lane + 64] + bln[g * 128 + lane + 64];
}
__global__ void __launch_bounds__(256) nk_sgu(const float* Z, const float* VLN, const float* ws, const float* bs, float* OS) {
    const size_t idx = (size_t)blockIdx.x * 256 + threadIdx.x; const int row = (int)(idx >> 10), col = (int)(idx & 1023), g = col >> 7, t = row & 127, r0 = row - t;
    const float* w = ws + ((size_t)g * 128 + t) * 128; float acc = 0.f;
    for (int s = 0; s <= t; ++s) acc += w[s] * VLN[(size_t)(r0 + s) * 1024 + col];
    OS[idx] = Z[(size_t)row * 2880 + 832 + col] * (acc + bs[g * 128 + t]);
}
__global__ void __launch_bounds__(256) nk_attn(const float* Q, const float* KV, const float* Z, float* O) {
    __shared__ float qs[192], sc[2048], sh[8], part[128];
    const int i = blockIdx.x, h = blockIdx.y, tid = threadIdx.x, lane = tid & 63, wv = tid >> 6;
    if (tid < 192) qs[tid] = Q[(size_t)i * 1536 + h * 192 + tid]; __syncthreads();
    const float scale = 0.07216878364870323f;
    for (int j = wv; j <= i; j += 4) { const float* kn = KV + (size_t)j * 2048 + h * 256; const float* kr = Z + (size_t)j * 2880 + 768;
        float p = qs[lane] * kn[lane] + qs[64 + lane] * kn[64 + lane] + qs[128 + lane] * kr[lane]; p = wave_sum(p); if (lane == 0) sc[j] = p * scale; }
    __syncthreads();
    float m = -INFINITY; for (int j = tid; j <= i; j += 256) m = fmaxf(m, sc[j]); m = blk_max(m, sh);
    float l = 0.f; for (int j = tid; j <= i; j += 256) { const float e = expf(sc[j] - m); sc[j] = e; l += e; } l = blk_sum(l, sh);
    const int d = tid & 127, half = tid >> 7; float acc = 0.f;
    for (int j = half; j <= i; j += 2) acc += sc[j] * KV[(size_t)j * 2048 + h * 256 + 128 + d];
    if (half) part[d] = acc; __syncthreads();
    if (!half) O[(size_t)i * 1024 + h * 128 + d] = (acc + part[d]) / l;
}
__global__ void __launch_bounds__(128) nk_topk(const float* QP, const float* k1, const float* k2, int* IDX, float* GATE) {
    __shared__ float q[256], s1[128], s2[128], cand[256], t1[16], t2[16]; __shared__ int i1[16], i2[16];
    const int row = blockIdx.x >> 3, h = blockIdx.x & 7, n = threadIdx.x;
    q[n] = QP[(size_t)row * 2048 + h * 256 + n]; q[n + 128] = QP[(size_t)row * 2048 + h * 256 + 128 + n]; __syncthreads();
    { const float* a = k1 + ((size_t)h * 128 + n) * 128; const float* b = k2 + ((size_t)h * 128 + n) * 128; float x = 0.f, y = 0.f;
      for (int d = 0; d < 128; ++d) { x += q[d] * a[d]; y += q[128 + d] * b[d]; } s1[n] = x; s2[n] = y; }
    __syncthreads();
    if (n == 0 || n == 64) { float* s = n ? s2 : s1; float* tv = n ? t2 : t1; int* ti = n ? i2 : i1;
        for (int r = 0; r < 16; ++r) { float best = -INFINITY; int bi = 0; for (int j = 0; j < 128; ++j) if (s[j] > best) { best = s[j]; bi = j; } tv[r] = best; ti[r] = bi; s[bi] = -INFINITY; } }
    __syncthreads();
    cand[n] = t1[n >> 4] + t2[n & 15]; cand[n + 128] = t1[(n + 128) >> 4] + t2[n & 15]; __syncthreads();
    if (n == 0) { float tv[16]; int te[16];
        for (int r = 0; r < 16; ++r) { float best = -INFINITY; int bi = 0; for (int j = 0; j < 256; ++j) if (cand[j] > best) { best = cand[j]; bi = j; } tv[r] = best; te[r] = i1[bi >> 4] * 128 + i2[bi & 15]; cand[bi] = -INFINITY; }
        float l = 0.f, e[16]; for (int r = 0; r < 16; ++r) { e[r] = expf(tv[r] - tv[0]); l += e[r]; }
        for (int r = 0; r < 16; ++r) { IDX[(size_t)row * 128 + h * 16 + r] = te[r]; GATE[(size_t)row * 128 + h * 16 + r] = e[r] / l; } }
}
__global__ void __launch_bounds__(256) nk_gather(float* H, const float* A2, const int* IDX, const float* GATE, const float* U, const float* V) {
    __shared__ float a[2048], red[4][2048];
    const int row = blockIdx.x, tid = threadIdx.x, lane = tid & 63, wv = tid >> 6;
    for (int i = tid; i < 2048; i += 256) a[i] = A2[(size_t)row * 2048 + i]; __syncthreads();
    float acc[32];
#pragma unroll
    for (int i = 0; i < 32; ++i) acc[i] = 0.f;
    for (int k = 0; k < 32; ++k) { const int j = wv * 32 + k; const int e = IDX[(size_t)row * 128 + j]; const float gt = GATE[(size_t)row * 128 + j];
        const float* u = U + (size_t)e * 2048; const float* v = V + (size_t)e * 2048; float p = 0.f;
#pragma unroll
        for (int i = 0; i < 32; ++i) p += u[lane + 64 * i] * a[lane + 64 * i];
        p = wave_sum(p); const float w = gt * gelu_t(p);
#pragma unroll
        for (int i = 0; i < 32; ++i) acc[i] += w * v[lane + 64 * i]; }
#pragma unroll
    for (int i = 0; i < 32; ++i) red[wv][lane + 64 * i] = acc[i];
    __syncthreads();
    for (int i = tid; i < 2048; i += 256) H[(size_t)row * 2048 + i] += red[0][i] + red[1][i] + red[2][i] + red[3][i];
}
__global__ void __launch_bounds__(256) nk_ple(const float* H2, const float* GL, const float* PP, float* out) {
    const size_t i = (size_t)blockIdx.x * 256 + threadIdx.x; out[i] = H2[i] + PP[i] / (1.f + expf(-GL[i]));
}
}
#if CUT > 0
static void launch_fast(void* const* d_in, void* d_out, void* d_ws, hipStream_t stream);
static void launch_conv(int b, void* const* d_in, void* d_ws, hipStream_t stream);
#endif
extern "C" void kernel_launch(void* const* d_in, const int* in_sizes, int n_in, void* d_out, int out_size, void* d_ws, size_t ws_size, hipStream_t stream) {
    if (n_in != 26 || out_size != T_TOK * DM || ws_size < WS_END) { fprintf(stderr, "kernel_launch: unexpected shapes n_in %d out %d ws %zu\n", n_in, out_size, ws_size); return; }
    unsigned char* ws = (unsigned char*)d_ws;
    const float* x = (const float*)d_in[0]; const float* p = (const float*)d_in[1]; const int* pos = (const int*)d_in[2];
    const float *g_mix = (const float*)d_in[3], *w_in = (const float*)d_in[4], *g_cq = (const float*)d_in[5], *w_uq = (const float*)d_in[6], *g_ckv = (const float*)d_in[7], *w_ukv = (const float*)d_in[8];
    const float *g_ln = (const float*)d_in[9], *b_ln = (const float*)d_in[10], *w_sgu = (const float*)d_in[11], *b_sgu = (const float*)d_in[12], *g_oa = (const float*)d_in[13], *g_os = (const float*)d_in[14];
    const float *w_out = (const float*)d_in[15], *g_ffn = (const float*)d_in[16], *w_pq = (const float*)d_in[17], *k1 = (const float*)d_in[18], *k2 = (const float*)d_in[19], *pu = (const float*)d_in[20], *pv = (const float*)d_in[21];
    const float *g_ple = (const float*)d_in[22], *w_pg = (const float*)d_in[23], *w_pp = (const float*)d_in[24], *g_fin = (const float*)d_in[25];
    float* out = (float*)d_out;
#if CUT > 0
    launch_fast(d_in, d_out, d_ws, stream);
#endif
#if CUT < 9
    constexpr int S0 = CUT + 1; constexpr int TB = nv::TBAT;
    float* A0 = (float*)(ws + WS_NA0); float* GL = (float*)(ws + WS_NGL); float* PP = (float*)(ws + WS_NPP);
    float* ZP = (float*)(ws + WS_NZP); float* CQN = (float*)(ws + WS_NCQN); float* CKVN = (float*)(ws + WS_NCKVN); float* QN = (float*)(ws + WS_NQN); float* KV = (float*)(ws + WS_NKV);
    float* VLN = (float*)(ws + WS_NVLN); float* OSGU = (float*)(ws + WS_NOSGU); float* OATT = (float*)(ws + WS_NOATT); float* QPN = (float*)(ws + WS_NQPN);
    for (int b = 0; b < NBATCH; ++b) {
        const size_t t0 = (size_t)b * TB; const float* xb = x + t0 * DM; const int* posb = pos + t0; const float* pb = p + t0 * 256;
        float* H1 = (float*)(ws + WS_H1) + t0 * DM; int* IDX = (int*)(ws + WS_IDX) + t0 * 128; float* GATE = (float*)(ws + WS_GATE) + t0 * 128; float* outb = out + t0 * DM;
#if CUT > 0
        launch_conv(b, d_in, d_ws, stream);
#endif
        if (S0 <= 1) {
            nv::nk_rmsnorm<<<TB, 256, 0, stream>>>(xb, DM, g_mix, A0, DM, DM);
            nv::nk_gemm<<<dim3(2880 / 64, TB / 64), 256, 0, stream>>>(A0, DM, w_in, 2880, ZP, 2880, nullptr, 0, DM);
            nv::nk_z_post<<<TB, 256, 0, stream>>>(ZP, posb);
        }
        if (S0 <= 2) {
            nv::nk_rmsnorm<<<TB, 256, 0, stream>>>(ZP, 2880, g_cq, CQN, 512, 512);
            nv::nk_gemm<<<dim3(1536 / 64, TB / 64), 256, 0, stream>>>(CQN, 512, w_uq, 1536, QN, 1536, nullptr, 0, 512);
            nv::nk_q_rope<<<TB, 256, 0, stream>>>(QN, posb);
            nv::nk_rmsnorm<<<TB, 256, 0, stream>>>(ZP + 512, 2880, g_ckv, CKVN, 256, 256);
            nv::nk_gemm<<<dim3(2048 / 64, TB / 64), 256, 0, stream>>>(CKVN, 256, w_ukv, 2048, KV, 2048, nullptr, 0, 256);
            nv::nk_ln_group<<<TB * 8 / 4, 256, 0, stream>>>(ZP, g_ln, b_ln, VLN);
            nv::nk_sgu<<<TB * 1024 / 256, 256, 0, stream>>>(ZP, VLN, w_sgu, b_sgu, OSGU);
        }
        if (S0 <= 3) nv::nk_attn<<<dim3(TB, 8), 256, 0, stream>>>(QN, KV, ZP, OATT);
        if (S0 <= 4) {
            nv::nk_rmsnorm<<<TB, 256, 0, stream>>>(OATT, 1024, g_oa, A0, DM, 1024);
            nv::nk_rmsnorm<<<TB, 256, 0, stream>>>(OSGU, 1024, g_os, A0 + 1024, DM, 1024);
            nv::nk_gemm<<<dim3(DM / 64, TB / 64), 256, 0, stream>>>(A0, DM, w_out, DM, H1, DM, xb, DM, DM);
        }
        if (S0 <= 5) {
            nv::nk_rmsnorm<<<TB, 256, 0, stream>>>(H1, DM, g_ffn, A0, DM, DM);
            nv::nk_gemm<<<dim3(DM / 64, TB / 64), 256, 0, stream>>>(A0, DM, w_pq, DM, QPN, DM, nullptr, 0, DM);
        }
        if (S0 <= 6) nv::nk_topk<<<TB * 8, 128, 0, stream>>>(QPN, k1, k2, IDX, GATE);
        if (S0 <= 7) {
            nv::nk_rmsnorm<<<TB, 256, 0, stream>>>(H1, DM, g_ffn, A0, DM, DM);
            nv::nk_gather<<<TB, 256, 0, stream>>>(H1, A0, IDX, GATE, pu, pv);
        }
        if (S0 <= 8) {
            nv::nk_rmsnorm<<<TB, 256, 0, stream>>>(H1, DM, g_ple, A0, DM, DM);
            nv::nk_gemm<<<dim3(DM / 64, TB / 64), 256, 0, stream>>>(A0, DM, w_pg, DM, GL, DM, nullptr, 0, DM);
            nv::nk_gemm<<<dim3(DM / 64, TB / 64), 256, 0, stream>>>(pb, 256, w_pp, DM, PP, DM, nullptr, 0, 256);
            nv::nk_ple<<<TB * DM / 256, 256, 0, stream>>>(H1, GL, PP, outb);
        }
        nv::nk_rmsnorm<<<TB, 256, 0, stream>>>(outb, DM, g_fin, outb, DM, DM);
    }
#endif
}
```

```cpp
#include <hip/hip_runtime.h>
#include <hip/hip_bf16.h>
#include <cstdio>
#include <cstdint>
#include <cmath>
#ifndef CUT
#define CUT 9
#endif
#ifndef ONE_LAUNCH
#define ONE_LAUNCH 1
#endif
constexpr int T_TOK = 8192, DM = 2048, SEQ = 2048, NBATCH = 4;
constexpr size_t MiB = 1u << 20;
constexpr size_t WS_CTL = 0;
constexpr size_t WS_WT_IN = 1 * MiB, WS_WT_UQ = 13 * MiB, WS_WT_UKV = 14 * MiB + 512 * 1024, WS_WT_PP = 15 * MiB + 512 * 1024;
constexpr size_t WS_K1B = 16 * MiB + 512 * 1024, WS_K2B = WS_K1B + 256 * 1024, WS_WSGU = 17 * MiB;
constexpr size_t WS_WT_OUT = 18 * MiB, WS_WT_PQ = 26 * MiB, WS_WT_PG = 34 * MiB;
constexpr size_t WS_UB = 42 * MiB, WS_VB = 106 * MiB;
constexpr size_t WS_R1 = 170 * MiB;
constexpr size_t WS_PB = 202 * MiB, WS_CS = 206 * MiB, WS_RSX = 208 * MiB, WS_RSH2 = 208 * MiB + 512 * 1024;
constexpr size_t WS_CQ = 209 * MiB, WS_CKV = 217 * MiB, WS_KR = 221 * MiB, WS_UG = 222 * MiB, WS_VG = 238 * MiB;
constexpr size_t WS_PSCQ = 254 * MiB, WS_PSCKV = 254 * MiB + 512 * 1024, WS_PSV = 255 * MiB;
constexpr size_t WS_Q = 257 * MiB, WS_KN = 281 * MiB, WS_VV = 297 * MiB, WS_H1B = 257 * MiB;
constexpr size_t WS_MIX = 313 * MiB, WS_PSA = 345 * MiB, WS_PSS = 345 * MiB + 512 * 1024;
constexpr size_t WS_H1 = 346 * MiB, WS_PSH1 = 410 * MiB, WS_IDX = 412 * MiB, WS_GATE = 416 * MiB, WS_PPROJ = 420 * MiB, WS_PSH3 = 452 * MiB;
constexpr size_t WS_NA0 = 454 * MiB, WS_NGL = 470 * MiB, WS_NPP = 486 * MiB, WS_END = 502 * MiB;
constexpr size_t WS_NZP = 42 * MiB, WS_NCQN = 65 * MiB, WS_NCKVN = 69 * MiB, WS_NQN = 71 * MiB, WS_NKV = 83 * MiB, WS_NVLN = 99 * MiB, WS_NOSGU = 107 * MiB, WS_NOATT = 115 * MiB, WS_NQPN = 123 * MiB;
namespace nv {
constexpr int TBAT = 2048;
__device__ __forceinline__ float gelu_t(float x) { const float c = 0.7978845608028654f; const float u = c * (x + 0.044715f * x * x * x); return 0.5f * x * (1.f + tanhf(u)); }
__device__ __forceinline__ float wave_sum(float v) {
#pragma unroll
    for (int o = 1; o < 64; o <<= 1) v += __shfl_xor(v, o);
    return v;
}
__device__ __forceinline__ float wave_max(float v) {
#pragma unroll
    for (int o = 1; o < 64; o <<= 1) v = fmaxf(v, __shfl_xor(v, o));
    return v;
}
__device__ __forceinline__ float blk_sum(float v, float* sh) {
    v = wave_sum(v); __syncthreads();
    if ((threadIdx.x & 63) == 0) sh[threadIdx.x >> 6] = v; __syncthreads();
    float r = 0.f; for (int i = 0; i < (int)(blockDim.x >> 6); ++i) r += sh[i]; return r;
}
__device__ __forceinline__ float blk_max(float v, float* sh) {
    v = wave_max(v); __syncthreads();
    if ((threadIdx.x & 63) == 0) sh[threadIdx.x >> 6] = v; __syncthreads();
    float r = sh[0]; for (int i = 1; i < (int)(blockDim.x >> 6); ++i) r = fmaxf(r, sh[i]); return r;
}
__global__ void __launch_bounds__(256) nk_rmsnorm(const float* x, size_t ldx, const float* g, float* out, size_t ldo, int D) {
    __shared__ float sh[8];
    const float* xr = x + (size_t)blockIdx.x * ldx; float* orow = out + (size_t)blockIdx.x * ldo;
    float s = 0.f; for (int i = threadIdx.x; i < D; i += 256) { const float v = xr[i]; s += v * v; }
    s = blk_sum(s, sh); const float r = rsqrtf(s / (float)D + 1e-6f);
    for (int i = threadIdx.x; i < D; i += 256) orow[i] = xr[i] * r * g[i];
}
__global__ void __launch_bounds__(256) nk_gemm(const float* A, size_t lda, const float* B, size_t ldb, float* C, size_t ldc, const float* R, size_t ldr, int K) {
    __shared__ float As[16][68], Bs[16][68];
    const int tid = threadIdx.x, tx = tid & 15, ty = tid >> 4, m0 = blockIdx.y * 64, n0 = blockIdx.x * 64;
    float acc[4][4] = {};
    for (int k0 = 0; k0 < K; k0 += 16) {
        { const int r = tid >> 2, c = (tid & 3) * 4; const float4 v = *(const float4*)(A + (size_t)(m0 + r) * lda + k0 + c); As[c][r] = v.x; As[c + 1][r] = v.y; As[c + 2][r] = v.z; As[c + 3][r] = v.w; }
        { const int r = tid >> 4, c = (tid & 15) * 4; const float4 v = *(const float4*)(B + (size_t)(k0 + r) * ldb + n0 + c); Bs[r][c] = v.x; Bs[r][c + 1] = v.y; Bs[r][c + 2] = v.z; Bs[r][c + 3] = v.w; }
        __syncthreads();
#pragma unroll
        for (int k = 0; k < 16; ++k) { float a[4], b[4];
#pragma unroll
            for (int i = 0; i < 4; ++i) { a[i] = As[k][ty * 4 + i]; b[i] = Bs[k][tx * 4 + i]; }
#pragma unroll
            for (int i = 0; i < 4; ++i)
#pragma unroll
                for (int j = 0; j < 4; ++j) acc[i][j] += a[i] * b[j]; }
        __syncthreads();
    }
#pragma unroll
    for (int i = 0; i < 4; ++i)
#pragma unroll
        for (int j = 0; j < 4; ++j) { const size_t r = m0 + ty * 4 + i, c = n0 + tx * 4 + j; C[r * ldc + c] = acc[i][j] + (R ? R[r * ldr + c] : 0.f); }
}
__device__ __forceinline__ void rope_cs(int pos, int i, float& c, float& s) { const double f = pow(10000.0, -(double)i / 32.0); const double a = (double)pos * f; c = (float)cos(a); s = (float)sin(a); }
__global__ void __launch_bounds__(256) nk_z_post(float* Z, const int* pos) {
    float* z = Z + (size_t)blockIdx.x * 2880; const int t = threadIdx.x;
    if (t < 32) { float c, s; rope_cs(pos[blockIdx.x], t, c, s); const float x1 = z[768 + t], x2 = z[800 + t]; z[768 + t] = x1 * c - x2 * s; z[800 + t] = x2 * c + x1 * s; }
    for (int i = 832 + t; i < 2880; i += 256) z[i] = gelu_t(z[i]);
}
__global__ void __launch_bounds__(256) nk_q_rope(float* Q, const int* pos) {
    float* q = Q + (size_t)blockIdx.x * 1536; const int h = threadIdx.x >> 5, i = threadIdx.x & 31;
    float c, s; rope_cs(pos[blockIdx.x], i, c, s); float* p = q + h * 192 + 128; const float x1 = p[i], x2 = p[32 + i]; p[i] = x1 * c - x2 * s; p[32 + i] = x2 * c + x1 * s;
}
__global__ void __launch_bounds__(256) nk_ln_group(const float* Z, const float* gln, const float* bln, float* VLN) {
    const int wv = blockIdx.x * 4 + (threadIdx.x >> 6), lane = threadIdx.x & 63, row = wv >> 3, g = wv & 7;
    const float* v = Z + (size_t)row * 2880 + 1856 + g * 128; const float a = v[lane], b = v[lane + 64];
    const float mu = wave_sum(a + b) * (1.f / 128.f); const float da = a - mu, db = b - mu; const float var = wave_sum(da * da + db * db) * (1.f / 128.f); const float r = rsqrtf(var + 1e-6f);
    float* o = VLN + (size_t)row * 1024 + g * 128; o[lane] = da * r * gln[g * 128 + lane] + bln[g * 128 + lane]; o[lane + 64] = db * r * gln[g * 128 + lane + 64] + bln[g * 128 + lane + 64];
}
__global__ void __launch_bounds__(256) nk_sgu(const float* Z, const float* VLN, const float* ws, const float* bs, float* OS) {
    const size_t idx = (size_t)blockIdx.x * 256 + threadIdx.x; const int row = (int)(idx >> 10), col = (int)(idx & 1023), g = col >> 7, t = row & 127, r0 = row - t;
    const float* w = ws + ((size_t)g * 128 + t) * 128; float acc = 0.f;
    for (int s = 0; s <= t; ++s) acc += w[s] * VLN[(size_t)(r0 + s) * 1024 + col];
    OS[idx] = Z[(size_t)row * 2880 + 832 + col] * (acc + bs[g * 128 + t]);
}
__global__ void __launch_bounds__(256) nk_attn(const float* Q, const float* KV, const float* Z, float* O) {
    __shared__ float qs[192], sc[2048], sh[8], part[128];
    const int i = blockIdx.x, h = blockIdx.y, tid = threadIdx.x, lane = tid & 63, wv = tid >> 6;
    if (tid < 192) qs[tid] = Q[(size_t)i * 1536 + h * 192 + tid]; __syncthreads();
    const float scale = 0.07216878364870323f;
    for (int j = wv; j <= i; j += 4) { const float* kn = KV + (size_t)j * 2048 + h * 256; const float* kr = Z + (size_t)j * 2880 + 768;
        float p = qs[lane] * kn[lane] + qs[64 + lane] * kn[64 + lane] + qs[128 + lane] * kr[lane]; p = wave_sum(p); if (lane == 0) sc[j] = p * scale; }
    __syncthreads();
    float m = -INFINITY; for (int j = tid; j <= i; j += 256) m = fmaxf(m, sc[j]); m = blk_max(m, sh);
    float l = 0.f; for (int j = tid; j <= i; j += 256) { const float e = expf(sc[j] - m); sc[j] = e; l += e; } l = blk_sum(l, sh);
    const int d = tid & 127, half = tid >> 7; float acc = 0.f;
    for (int j = half; j <= i; j += 2) acc += sc[j] * KV[(size_t)j * 2048 + h * 256 + 128 + d];
    if (half) part[d] = acc; __syncthreads();
    if (!half) O[(size_t)i * 1024 + h * 128 + d] = (acc + part[d]) / l;
}
__global__ void __launch_bounds__(128) nk_topk(const float* QP, const float* k1, const float* k2, int* IDX, float* GATE) {
    __shared__ float q[256], s1[128], s2[128], cand[256], t1[16], t2[16]; __shared__ int i1[16], i2[16];
    const int row = blockIdx.x >> 3, h = blockIdx.x & 7, n = threadIdx.x;
    q[n] = QP[(size_t)row * 2048 + h * 256 + n]; q[n + 128] = QP[(size_t)row * 2048 + h * 256 + 128 + n]; __syncthreads();
    { const float* a = k1 + ((size_t)h * 128 + n) * 128; const float* b = k2 + ((size_t)h * 128 + n) * 128; float x = 0.f, y = 0.f;
      for (int d = 0; d < 128; ++d) { x += q[d] * a[d]; y += q[128 + d] * b[d]; } s1[n] = x; s2[n] = y; }
    __syncthreads();
    if (n == 0 || n == 64) { float* s = n ? s2 : s1; float* tv = n ? t2 : t1; int* ti = n ? i2 : i1;
        for (int r = 0; r < 16; ++r) { float best = -INFINITY; int bi = 0; for (int j = 0; j < 128; ++j) if (s[j] > best) { best = s[j]; bi = j; } tv[r] = best; ti[r] = bi; s[bi] = -INFINITY; } }
    __syncthreads();
    cand[n] = t1[n >> 4] + t2[n & 15]; cand[n + 128] = t1[(n + 128) >> 4] + t2[n & 15]; __syncthreads();
    if (n == 0) { float tv[16]; int te[16];
        for (int r = 0; r < 16; ++r) { float best = -INFINITY; int bi = 0; for (int j = 0; j < 256; ++j) if (cand[j] > best) { best = cand[j]; bi = j; } tv[r] = best; te[r] = i1[bi >> 4] * 128 + i2[bi & 15]; cand[bi] = -INFINITY; }
        float l = 0.f, e[16]; for (int r = 0; r < 16; ++r) { e[r] = expf(tv[r] - tv[0]); l += e[r]; }
        for (int r = 0; r < 16; ++r) { IDX[(size_t)row * 128 + h * 16 + r] = te[r]; GATE[(size_t)row * 128 + h * 16 + r] = e[r] / l; } }
}
__global__ void __launch_bounds__(256) nk_gather(float* H, const float* A2, const int* IDX, const float* GATE, const float* U, const float* V) {
    __shared__ float a[2048], red[4][2048];
    const int row = blockIdx.x, tid = threadIdx.x, lane = tid & 63, wv = tid >> 6;
    for (int i = tid; i < 2048; i += 256) a[i] = A2[(size_t)row * 2048 + i]; __syncthreads();
    float acc[32];
#pragma unroll
    for (int i = 0; i < 32; ++i) acc[i] = 0.f;
    for (int k = 0; k < 32; ++k) { const int j = wv * 32 + k; const int e = IDX[(size_t)row * 128 + j]; const float gt = GATE[(size_t)row * 128 + j];
        const float* u = U + (size_t)e * 2048; const float* v = V + (size_t)e * 2048; float p = 0.f;
#pragma unroll
        for (int i = 0; i < 32; ++i) p += u[lane + 64 * i] * a[lane + 64 * i];
        p = wave_sum(p); const float w = gt * gelu_t(p);
#pragma unroll
        for (int i = 0; i < 32; ++i) acc[i] += w * v[lane + 64 * i]; }
#pragma unroll
    for (int i = 0; i < 32; ++i) red[wv][lane + 64 * i] = acc[i];
    __syncthreads();
    for (int i = tid; i < 2048; i += 256) H[(size_t)row * 2048 + i] += red[0][i] + red[1][i] + red[2][i] + red[3][i];
}
__global__ void __launch_bounds__(256) nk_ple(const float* H2, const float* GL, const float* PP, float* out) {
    const size_t i = (size_t)blockIdx.x * 256 + threadIdx.x; out[i] = H2[i] + PP[i] / (1.f + expf(-GL[i]));
}
}
#define GAS __attribute__((address_space(1)))
#define LAS __attribute__((address_space(3)))
typedef unsigned short bf16;
typedef unsigned v4u __attribute__((ext_vector_type(4)));
typedef float f32x4 __attribute__((ext_vector_type(4)));
typedef short bf16x8 __attribute__((ext_vector_type(8)));
typedef GAS unsigned gu32;
typedef GAS unsigned long long gu64;
#define RLX_AGENT __ATOMIC_RELAXED, __HIP_MEMORY_SCOPE_AGENT
#define LDS_WAIT() asm volatile("s_waitcnt lgkmcnt(0)" ::: "memory")
#define VM_WAIT() asm volatile("s_waitcnt vmcnt(0)" ::: "memory")
__device__ __forceinline__ unsigned long long rt() { return __builtin_amdgcn_s_memrealtime(); }
__device__ __forceinline__ unsigned f2bf(float f) { unsigned u = __builtin_bit_cast(unsigned, f); return (u + 0x7fffu + ((u >> 16) & 1u)) >> 16; }
__device__ __forceinline__ unsigned pk2(float lo, float hi) { return f2bf(lo) | (f2bf(hi) << 16); }
#define XB_TMO      128
#define XB_XCNT(j)  (256  + 64 * (j))
#define XB_XSUB(j)  (1280 + 64 * (j))
#define XB_XGEN(j)  (2304 + 64 * (j))
#define XB_TOP      3328
#define XB_TOPGEN   3392
#define XCD_BAR_WORDS 3456
#define XB_SPIN_CAP (1u << 18)

__device__ __forceinline__ unsigned xb_ld(unsigned* p)              { return __hip_atomic_load(p, __ATOMIC_RELAXED, __HIP_MEMORY_SCOPE_AGENT); }
__device__ __forceinline__ unsigned xb_add(unsigned* p, unsigned v) { return __hip_atomic_fetch_add(p, v, __ATOMIC_RELAXED, __HIP_MEMORY_SCOPE_AGENT); }
__device__ __forceinline__ unsigned xb_xcc_id() { return (unsigned)__builtin_amdgcn_s_getreg((3 << 11) | 20) & 0xFu; }
#define XB_SPIN(cond, bar) do { unsigned _sp = 0; while (cond) { __builtin_amdgcn_s_sleep(1); \
    if ((++_sp & 255u) == 0u) { if (xb_ld(&(bar)[XB_TMO])) break; if (_sp > XB_SPIN_CAP) { atomicAdd(&(bar)[XB_TMO], 1u); break; } } } } while (0)

struct XcdBarrier {
    unsigned* bar; unsigned x;
    volatile LAS unsigned* st;
};

__device__ __forceinline__ int lane_id() { int r; asm volatile("v_mbcnt_lo_u32_b32 %0, -1, 0\n\tv_mbcnt_hi_u32_b32 %0, -1, %0" : "=v"(r)); return r; }
__device__ __forceinline__ XcdBarrier xcd_barrier_post(unsigned* bar, volatile LAS unsigned* st, int wid) {
    XcdBarrier b; b.bar = bar; b.x = xb_xcc_id(); b.st = st;
    if (wid == 0 && lane_id() == 0) (void)xb_add(&bar[XB_XCNT(b.x)], 1u);
    return b;
}
__device__ __forceinline__ void xcd_barrier_complete(unsigned* bar, unsigned x, unsigned& nloc, unsigned& nx) {
    const unsigned G = gridDim.x * gridDim.y * gridDim.z;
    unsigned sum, cnt, mine, sp = 0u;
    for (;;) {
        sum = 0u; cnt = 0u; mine = 0u;
#pragma unroll
        for (unsigned j = 0; j < 16; ++j) { const unsigned c = xb_ld(&bar[XB_XCNT(j)]); sum += c; cnt += (c > 0u) ? 1u : 0u; mine = (j == x) ? c : mine; }
        if (sum == G) break;
        __builtin_amdgcn_s_sleep(1);
        if ((++sp & 255u) == 0u) { if (xb_ld(&bar[XB_TMO])) break; if (sp > XB_SPIN_CAP) { atomicAdd(&bar[XB_TMO], 1u); break; } }
    }
    nloc = mine > 0u ? mine : 1u; nx = cnt > 0u ? cnt : 1u;
}

__device__ __forceinline__ void xcd_barrier(const XcdBarrier& b, int wid) {
    asm volatile("s_waitcnt vmcnt(0)" ::: "memory");
    __syncthreads();
    if (wid == 0 && lane_id() == 0) {
        unsigned* bar = b.bar;
        __builtin_amdgcn_s_waitcnt(0);
        unsigned nloc = b.st[0], nx = b.st[1];
        if (nloc == 0u) { xcd_barrier_complete(bar, b.x, nloc, nx); b.st[0] = nloc; b.st[1] = nx; }
        const unsigned old = xb_add(&bar[XB_XSUB(b.x)], 1u);
        const unsigned gen = old / nloc;
        if (old + 1u == (gen + 1u) * nloc) {
            __builtin_amdgcn_fence(__ATOMIC_RELEASE, "agent");
            asm volatile("s_waitcnt vmcnt(0)" ::: "memory");
            const unsigned og = xb_add(&bar[XB_TOP], 1u);
            const unsigned tg = og / nx;
            if (og + 1u == (tg + 1u) * nx) xb_add(&bar[XB_TOPGEN], 1u);
            else XB_SPIN(xb_ld(&bar[XB_TOPGEN]) == tg, bar);
            __builtin_amdgcn_fence(__ATOMIC_ACQUIRE, "agent");
            xb_add(&bar[XB_XGEN(b.x)], 1u);
            asm volatile("s_waitcnt vmcnt(0)" ::: "memory");
        } else {
            XB_SPIN(xb_ld(&bar[XB_XGEN(b.x)]) == gen, bar);
            __builtin_amdgcn_fence(__ATOMIC_ACQUIRE, "agent");
            asm volatile("s_waitcnt vmcnt(0)" ::: "memory");
        }
    }
    __syncthreads();
}
namespace pg8 {
#define PG8_LAS __attribute__((address_space(3)))
typedef unsigned short bf16_t;
typedef short bf16x8 __attribute__((ext_vector_type(8)));
typedef float f32x4 __attribute__((ext_vector_type(4)));
typedef unsigned u32x4 __attribute__((ext_vector_type(4)));
constexpr int BM = 256, BK = 64, HALF = 128, HTB = HALF * BK * 2  , STAGE_BYTES = 8 * HTB, NXCD = 8, WGM = 8;

__host__ __device__ __forceinline__ int lds_byte(int r, int c) { const int st = (r >> 4) * 2 + (c >> 5), rr = r & 15, cc = c & 31, ob = rr * 64 + cc * 2; return st * 1024 + (ob ^ (((ob >> 9) & 1) << 5)); }
__host__ __device__ __forceinline__ void stage_rc(int b, int& R, int& C) { const int st = b / 1024, sb = b % 1024, swz = sb ^ (((sb >> 9) & 1) << 5); R = (st >> 1) * 16 + swz / 64; C = (st & 1) * 32 + (swz % 64) / 2; }
__host__ __device__ __forceinline__ int perm32(int rho) { const int n = rho >> 4, i = rho & 15; return 8 * (i >> 2) + 4 * n + (i & 3); }

struct Unit { int pm, pn; };
struct Gemm { const bf16_t* A; const bf16_t* Bt; int M, N, K; };

struct StaticOrder {
    int nM, nN, nwg, G, c;
    __host__ __device__ void init(int M, int N, int G_, int c_) { nM = M / BM; nN = N / BM; nwg = nM * nN; G = G_; c = c_; }
    __host__ __device__ bool next(int i, Unit& u) const {
        const long L = (long)i * G + c; if (L >= nwg) return false;
        int wgid = (int)L; { const int q = nwg / NXCD, r = nwg % NXCD, xcd = wgid % NXCD, off = wgid / NXCD; wgid = (xcd < r ? xcd * (q + 1) : r * (q + 1) + (xcd - r) * q) + off; }
        const int nig = WGM * nN, gid = wgid / nig, fm = gid * WGM, gsz = (nM - fm) < WGM ? (nM - fm) : WGM;
        u.pm = fm + ((wgid % nig) % gsz); u.pn = (wgid % nig) / gsz; return true;
    }
    __device__ __forceinline__ void a_ready(const Unit&) const {}
    __device__ __forceinline__ void done(const Unit&) const {}
};

__device__ __forceinline__ unsigned cvt_pk_bf16(float lo, float hi) { unsigned r; asm volatile("v_cvt_pk_bf16_f32 %0, %1, %2" : "=v"(r) : "v"(lo), "v"(hi)); return r; }
typedef float f32x2 __attribute__((ext_vector_type(2)));
template <class Epi, class Sched, bool ALIGN_EPI = false, bool SP2 = false>
__device__ __forceinline__ void gemm_phase(PG8_LAS unsigned char* lds, const Gemm g, const Sched& S, const Epi& E, const int wid) {
    const int lane = ::lane_id(), tid = wid * 64 + lane, wr = wid >> 2, wc = wid & 3, fr = lane & 15, fq = lane >> 4;
    const int K = g.K, nt = K / BK;
    unsigned voffA[2], voffB[2];
#pragma unroll
    for (int i = 0; i < 2; ++i) { int R, C; stage_rc(tid * 16 + i * 8192, R, C); const int Rb = Epi::PERM ? ((R & ~31) + perm32(R & 31)) : R;
        voffA[i] = (unsigned)(R * K + C) * 2u; voffB[i] = (unsigned)(Rb * K + C) * 2u; }
    const size_t kstep = (size_t)(BK * 2);
    const size_t hstep = (size_t)HALF * K * 2;
    const size_t tstep = 2 * hstep;
    const unsigned ldsw = (unsigned)wid * 1024u;
    const int aoff = lds_byte(wr * 64 + fr, fq * 8), boff = lds_byte(wc * 32 + fr, fq * 8);
#define PG8_SA(b, h) (((b) * 2 + (h)) * HTB)
#define PG8_SB(b, h) ((4 + (b) * 2 + (h)) * HTB)
#define PG8_STAGE(bufoff, gbase, voff) do { _Pragma("unroll") for (int _i = 0; _i < 2; ++_i) \
        __builtin_amdgcn_global_load_lds((const unsigned*)((const char*)(gbase) + (voff)[_i]), (PG8_LAS unsigned*)(lds + (bufoff) + ldsw + _i * 8192), 16, 0, 0); } while (0)
#define PG8_LDA(dst, b, h) do { _Pragma("unroll") for (int m = 0; m < 4; ++m) _Pragma("unroll") for (int k = 0; k < 2; ++k) dst[m][k] = *(const PG8_LAS bf16x8*)(lds + PG8_SA(b, h) + aoff + m * 2048 + k * 1024); } while (0)
#define PG8_LDB(dst, b, h) do { _Pragma("unroll") for (int n = 0; n < 2; ++n) _Pragma("unroll") for (int k = 0; k < 2; ++k) dst[n][k] = *(const PG8_LAS bf16x8*)(lds + PG8_SB(b, h) + boff + n * 2048 + k * 1024); } while (0)
#define PG8_MMA(ai, bj, At, Bt) do { __builtin_amdgcn_s_setprio(1); _Pragma("unroll") for (int m = 0; m < 4; ++m) _Pragma("unroll") for (int n = 0; n < 2; ++n) _Pragma("unroll") for (int k = 0; k < 2; ++k) \
        acc[ai][bj][m][n] = __builtin_amdgcn_mfma_f32_16x16x32_bf16(Bt[n][k], At[m][k], acc[ai][bj][m][n], 0, 0, 0); __builtin_amdgcn_s_setprio(0); } while (0)
#define PG8_WAIT_V(n) asm volatile("s_waitcnt vmcnt(" #n ")" ::: "memory")
#define PG8_WAIT_L(n) asm volatile("s_waitcnt lgkmcnt(" #n ")" ::: "memory")
#define PG8_BAR __builtin_amdgcn_s_barrier()
#define PG8_SCHED __builtin_amdgcn_sched_barrier(0)
    Unit cur, nxt; int ui = 0;
    if (!S.next(0, cur)) return;
    f32x4 acc[2][2][4][2];
#pragma unroll
    for (int a = 0; a < 2; ++a)
#pragma unroll
        for (int b = 0; b < 2; ++b)
#pragma unroll
            for (int m = 0; m < 4; ++m)
#pragma unroll
                for (int n = 0; n < 2; ++n) acc[a][b][m][n] = (f32x4){0.f, 0.f, 0.f, 0.f};
    bf16x8 At[4][2], B0[2][2], B1[2][2];
    const char* cA = (const char*)g.A + (size_t)cur.pm * tstep; const char* cB = (const char*)g.Bt + (size_t)cur.pn * tstep;
    S.a_ready(cur);
    if constexpr (SP2) {
        PG8_STAGE(PG8_SB(0, 0), cB, voffB); PG8_STAGE(PG8_SB(0, 1), cB + hstep, voffB); PG8_STAGE(PG8_SA(0, 0), cA, voffA); PG8_STAGE(PG8_SA(0, 1), cA + hstep, voffA);
        if (wr == 1) PG8_BAR;
        PG8_WAIT_V(2); PG8_BAR;
        PG8_STAGE(PG8_SB(1, 0), cB + kstep, voffB); PG8_STAGE(PG8_SA(1, 0), cA + kstep, voffA); PG8_STAGE(PG8_SB(1, 1), cB + hstep + kstep, voffB);
        PG8_WAIT_V(6); PG8_BAR;
    } else {
        PG8_STAGE(PG8_SB(0, 0), cB, voffB); PG8_STAGE(PG8_SA(0, 0), cA, voffA); PG8_STAGE(PG8_SB(0, 1), cB + hstep, voffB); PG8_STAGE(PG8_SA(0, 1), cA + hstep, voffA);
        if (wr == 1) PG8_BAR;
        PG8_WAIT_V(4); PG8_BAR;
        PG8_STAGE(PG8_SB(1, 0), cB + kstep, voffB); PG8_STAGE(PG8_SA(1, 0), cA + kstep, voffA); PG8_STAGE(PG8_SB(1, 1), cB + hstep + kstep, voffB);
        PG8_WAIT_V(6); PG8_BAR;
    }
    for (;;) {
        const bool has_next = S.next(ui + 1, nxt);
        const char* nA = has_next ? (const char*)g.A + (size_t)nxt.pm * tstep : cA; const char* nB = has_next ? (const char*)g.Bt + (size_t)nxt.pn * tstep : cB;
        for (int t = 0; t < nt; t += 2) {
            if constexpr (Epi::MID) { if (t == (nt >> 1)) E.mid(acc, cur, wr, wc, fr, fq); }
            const bool last = (t == nt - 2);
            const char* a1 = cA + (size_t)(t + 1) * kstep;
            const char* a2 = last ? nA : cA + (size_t)(t + 2) * kstep; const char* b2 = last ? nB : cB + (size_t)(t + 2) * kstep;
            const char* a3 = a2 + kstep; const char* b3 = b2 + kstep;
            if (last && has_next) S.a_ready(nxt);
            if constexpr (SP2) {
            PG8_LDB(B0, 0, 0); PG8_LDB(B1, 0, 1); PG8_SCHED; PG8_LDA(At, 0, 0); PG8_STAGE(PG8_SA(1, 1), a1 + hstep, voffA);
            PG8_WAIT_V(8); PG8_WAIT_L(0); PG8_BAR; PG8_MMA(0, 0, At, B0); PG8_MMA(0, 1, At, B1); PG8_BAR; PG8_SCHED;
            PG8_LDA(At, 0, 1); PG8_STAGE(PG8_SB(0, 0), b2, voffB); PG8_STAGE(PG8_SB(0, 1), b2 + hstep, voffB); PG8_STAGE(PG8_SA(0, 0), a2, voffA);
            PG8_WAIT_V(8); PG8_WAIT_L(0); PG8_BAR; PG8_MMA(1, 0, At, B0); PG8_MMA(1, 1, At, B1); PG8_BAR; PG8_SCHED;
            PG8_LDB(B0, 1, 0); PG8_LDB(B1, 1, 1); PG8_SCHED; PG8_LDA(At, 1, 0); PG8_STAGE(PG8_SA(0, 1), a2 + hstep, voffA);
            PG8_WAIT_V(8); PG8_WAIT_L(0); PG8_BAR; PG8_MMA(0, 0, At, B0); PG8_MMA(0, 1, At, B1); PG8_BAR; PG8_SCHED;
            PG8_LDA(At, 1, 1); PG8_STAGE(PG8_SB(1, 0), b3, voffB); PG8_STAGE(PG8_SB(1, 1), b3 + hstep, voffB); PG8_STAGE(PG8_SA(1, 0), a3, voffA);
            PG8_WAIT_V(8); PG8_WAIT_L(0); PG8_BAR; PG8_MMA(1, 0, At, B0); PG8_MMA(1, 1, At, B1); PG8_BAR; PG8_SCHED;
            } else {
            PG8_LDB(B0, 0, 0); PG8_SCHED; PG8_LDA(At, 0, 0); PG8_STAGE(PG8_SA(1, 1), a1 + hstep, voffA);
            PG8_WAIT_L(8); PG8_BAR; PG8_WAIT_L(0); PG8_MMA(0, 0, At, B0); PG8_BAR; PG8_SCHED;
            PG8_LDB(B1, 0, 1); PG8_STAGE(PG8_SB(0, 0), b2, voffB);
            PG8_BAR; PG8_WAIT_L(0); PG8_MMA(0, 1, At, B1); PG8_BAR;
            PG8_LDA(At, 0, 1); PG8_STAGE(PG8_SA(0, 0), a2, voffA);
            PG8_BAR; PG8_WAIT_L(0); PG8_MMA(1, 0, At, B0); PG8_BAR; PG8_SCHED;
            PG8_STAGE(PG8_SB(0, 1), b2 + hstep, voffB);
            PG8_WAIT_V(6); PG8_BAR; PG8_MMA(1, 1, At, B1); PG8_BAR;
            PG8_LDB(B0, 1, 0); PG8_SCHED; PG8_LDA(At, 1, 0); PG8_STAGE(PG8_SA(0, 1), a2 + hstep, voffA);
            PG8_WAIT_L(8); PG8_BAR; PG8_WAIT_L(0); PG8_MMA(0, 0, At, B0); PG8_BAR; PG8_SCHED;
            PG8_LDB(B1, 1, 1); PG8_STAGE(PG8_SB(1, 0), b3, voffB);
            PG8_BAR; PG8_WAIT_L(0); PG8_MMA(0, 1, At, B1); PG8_BAR;
            PG8_LDA(At, 1, 1); PG8_STAGE(PG8_SA(1, 0), a3, voffA);
            PG8_BAR; PG8_WAIT_L(0); PG8_MMA(1, 0, At, B0); PG8_BAR; PG8_SCHED;
            PG8_STAGE(PG8_SB(1, 1), b3 + hstep, voffB);
            PG8_WAIT_V(6); PG8_BAR; PG8_MMA(1, 1, At, B1); PG8_BAR;
            }
        }
        if constexpr (ALIGN_EPI) { if (wr == 0) PG8_BAR; }
        if constexpr (!Epi::AFTER_DRAIN) { E(acc, cur, wr, wc, fr, fq); S.done(cur); }
        if (!has_next) break;
#pragma unroll
        for (int a = 0; a < 2; ++a)
#pragma unroll
            for (int b = 0; b < 2; ++b)
#pragma unroll
                for (int m = 0; m < 4; ++m)
#pragma unroll
                    for (int n = 0; n < 2; ++n) acc[a][b][m][n] = (f32x4){0.f, 0.f, 0.f, 0.f};
        cur = nxt; cA = nA; cB = nB; ++ui;
        if constexpr (ALIGN_EPI) { if (wr == 1) PG8_BAR; }
    }
    PG8_WAIT_V(0);
    if constexpr (!ALIGN_EPI) { if (wr == 0) PG8_BAR; }
    PG8_BAR;
    if constexpr (Epi::AFTER_DRAIN) { E.fused(acc, cur, wr, wc, fr, fq, lds, wid, lane); S.done(cur); }
#undef PG8_SA
#undef PG8_SB
#undef PG8_STAGE
#undef PG8_LDA
#undef PG8_LDB
#undef PG8_MMA
#undef PG8_WAIT_V
#undef PG8_WAIT_L
#undef PG8_BAR
#undef PG8_SCHED
}
}
constexpr int NWAVES = 8;
constexpr int RING_OFF = 0, RING_BYTES = 131072, TAB_OFF = RING_BYTES, TAB_BYTES = 8192, LDSCTL_OFF = TAB_OFF + TAB_BYTES, MISC_OFF = LDSCTL_OFF + 320, LDS_BYTES = 147456;
static_assert(MISC_OFF + 128 <= LDS_BYTES, "LDS map");
constexpr int CW_TMO = 0, CW_CODE = 1, CW_BAR = 4096;
constexpr size_t CTL_ZERO_BYTES = 64 * 1024;
constexpr float QK_C2 = 0.07216878364870323f * 1.4426950408889634f;
typedef float f32x2v __attribute__((ext_vector_type(2)));
typedef unsigned u32x2v __attribute__((ext_vector_type(2)));
__device__ __forceinline__ float bf2f(unsigned short b) { return __uint_as_float((unsigned)b << 16); }
__device__ __forceinline__ float gelu_f(float x) { const float u = 1.5957691216057308f * (x + 0.044715f * x * x * x); return x * __builtin_amdgcn_rcpf(1.f + __builtin_amdgcn_exp2f(-1.4426950408889634f * u)); }
__device__ __forceinline__ float wave_sum64(float v) {
#pragma unroll
    for (int o = 1; o < 64; o <<= 1) v += __shfl_xor(v, o);
    return v;
}
struct Args { const void* in[26]; float* out; unsigned char* ws; int ph_lo, ph_hi; };
struct Frame { LAS unsigned char* lds; volatile LAS unsigned* MISC; gu32* ctl; int tid, lane, wave, vcu, G; };

__device__ __forceinline__ int rope_pc(int lr) { const int nn = lr >> 5, i = lr & 31, c5 = i >> 4, f = i & 15; return 32 * c5 + 8 * (f >> 2) + 4 * nn + (f & 3); }
__device__ __forceinline__ int map_win(int n) { if (n < 768) return n; if (n < 832) return 2816 + rope_pc(n - 768); if (n < 1856) return 768 + (n - 832); return 1792 + (n - 1856); }
__device__ __forceinline__ int map_wuq(int n) { const int h = n / 192, lc = n - h * 192; return lc < 128 ? n : h * 192 + 128 + rope_pc(lc - 128); }
__device__ __forceinline__ int map_id(int n) { return n; }

template <class MapF, class ScaleF>
__device__ __forceinline__ void p0_transpose_item(const float* W, int K, int N, bf16* WT, LAS float* scr, int item, int lane, MapF mapf, ScaleF ks) {
    const int nblk = N / 32, kb = item / nblk, nb = item % nblk, k0 = 64 * kb, n0 = 32 * nb;
#pragma unroll 8
    for (int i = 0; i < 32; ++i) { const int kk = 2 * i + (lane >> 5); scr[kk * 33 + (lane & 31)] = W[(size_t)(k0 + kk) * N + n0 + (lane & 31)] * ks(k0 + kk); }
    LDS_WAIT(); asm volatile("" ::: "memory");
    const int c = lane & 7;
#pragma unroll
    for (int j = 0; j < 4; ++j) { const int n = (lane >> 3) + 8 * j; const LAS float* s = scr + (8 * c) * 33 + n;
        v4u o; o.x = pk2(s[0 * 33], s[1 * 33]); o.y = pk2(s[2 * 33], s[3 * 33]); o.z = pk2(s[4 * 33], s[5 * 33]); o.w = pk2(s[6 * 33], s[7 * 33]);
        *(GAS v4u*)(WT + (size_t)mapf(n0 + n) * K + k0 + 8 * c) = o; }
    LDS_WAIT(); asm volatile("" ::: "memory");
}
template <class ScaleF>
__device__ __forceinline__ void p0_cvt512(const float* src, bf16* dst, size_t e0, int lane, ScaleF sf) {
    const size_t e = e0 + (size_t)lane * 8; const f32x4 a = *(const GAS f32x4*)(src + e), b = *(const GAS f32x4*)(src + e + 4);
    v4u o; o.x = pk2(a.x * sf(e), a.y * sf(e + 1)); o.y = pk2(a.z * sf(e + 2), a.w * sf(e + 3)); o.z = pk2(b.x * sf(e + 4), b.y * sf(e + 5)); o.w = pk2(b.z * sf(e + 6), b.w * sf(e + 7));
    *(GAS v4u*)(dst + e) = o;
}
__device__ __forceinline__ void p0_prologue(const Args& A, Frame& F) {
    unsigned char* ws = A.ws;
    const float* x = (const float*)A.in[0]; const float* p = (const float*)A.in[1]; const int* pos = (const int*)A.in[2];
    const float *g_mix = (const float*)A.in[3], *w_in = (const float*)A.in[4], *g_cq = (const float*)A.in[5], *w_uq = (const float*)A.in[6], *g_ckv = (const float*)A.in[7], *w_ukv = (const float*)A.in[8];
    const float *w_sgu = (const float*)A.in[11], *g_oa = (const float*)A.in[13], *g_os = (const float*)A.in[14], *w_out = (const float*)A.in[15], *g_ffn = (const float*)A.in[16], *w_pq = (const float*)A.in[17];
    const float *k1 = (const float*)A.in[18], *k2 = (const float*)A.in[19], *pu = (const float*)A.in[20], *pv = (const float*)A.in[21], *g_ple = (const float*)A.in[22], *w_pg = (const float*)A.in[23], *w_pp = (const float*)A.in[24];
    LAS float* scr = (LAS float*)(F.lds + RING_OFF + F.wave * 16384);
    const int gw = F.vcu * NWAVES + F.wave, NGW = F.G * NWAVES, lane = F.lane;
    for (int m = gw; m < T_TOK; m += NGW) {
        const GAS f32x4* xr = (const GAS f32x4*)(x + (size_t)m * DM) + lane; f32x4 v[8]; float s = 0.f;
#pragma unroll
        for (int j = 0; j < 8; ++j) { v[j] = xr[64 * j]; s += (v[j].x * v[j].x + v[j].y * v[j].y) + (v[j].z * v[j].z + v[j].w * v[j].w); }
        s = wave_sum64(s); if (lane == 0) ((float*)(ws + WS_RSX))[m] = 1.0f / sqrtf(s * (1.f / DM) + 1e-6f);
        GAS u32x2v* o8 = (GAS u32x2v*)((bf16*)(ws + WS_R1) + (size_t)m * DM) + lane;
#pragma unroll
        for (int j = 0; j < 8; ++j) o8[64 * j] = (u32x2v){pk2(v[j].x, v[j].y), pk2(v[j].z, v[j].w)};
        const f32x4 pvv = *((const GAS f32x4*)(p + (size_t)m * 256) + lane);
        *((GAS u32x2v*)((bf16*)(ws + WS_PB) + (size_t)m * 256) + lane) = (u32x2v){pk2(pvv.x, pvv.y), pk2(pvv.z, pvv.w)};
    }
    for (int it = gw; it < T_TOK * 32 / 64; it += NGW) { const int idx = it * 64 + lane, row = idx >> 5, i = idx & 31;
        const double f = exp2((double)i * (-13.287712379549449 / 32.0)); const double a = (double)pos[row] * f;
        ((f32x2v*)(ws + WS_CS))[idx] = (f32x2v){(float)cos(a), (float)sin(a)}; }
    constexpr int I_IN = 32 * 90, I_UQ = 8 * 48, I_UKV = 4 * 64, I_SQ = 32 * 64, I_PP = 4 * 64;
    constexpr int NITEMS = I_IN + I_UQ + I_UKV + 3 * I_SQ + I_PP;
    for (int it = gw; it < NITEMS; it += NGW) {
        int r = it;
        if (r < I_IN) { p0_transpose_item(w_in, 2048, 2880, (bf16*)(ws + WS_WT_IN), scr, r, lane, [](int n) { return map_win(n); }, [=](int k) { return g_mix[k]; }); continue; } r -= I_IN;
        if (r < I_UQ) { p0_transpose_item(w_uq, 512, 1536, (bf16*)(ws + WS_WT_UQ), scr, r, lane, [](int n) { return map_wuq(n); }, [=](int k) { return g_cq[k] * QK_C2; }); continue; } r -= I_UQ;
        if (r < I_UKV) { p0_transpose_item(w_ukv, 256, 2048, (bf16*)(ws + WS_WT_UKV), scr, r, lane, [](int n) { return n; }, [=](int k) { return g_ckv[k]; }); continue; } r -= I_UKV;
        if (r < I_SQ) { p0_transpose_item(w_out, 2048, 2048, (bf16*)(ws + WS_WT_OUT), scr, r, lane, [](int n) { return n; }, [=](int k) { return k < 1024 ? g_oa[k] : g_os[k - 1024]; }); continue; } r -= I_SQ;
        if (r < I_SQ) { p0_transpose_item(w_pq, 2048, 2048, (bf16*)(ws + WS_WT_PQ), scr, r, lane, [](int n) { return n; }, [=](int k) { return g_ffn[k]; }); continue; } r -= I_SQ;
        if (r < I_SQ) { p0_transpose_item(w_pg, 2048, 2048, (bf16*)(ws + WS_WT_PG), scr, r, lane, [](int n) { return n; }, [=](int k) { return g_ple[k]; }); continue; } r -= I_SQ;
        p0_transpose_item(w_pp, 256, 2048, (bf16*)(ws + WS_WT_PP), scr, r, lane, [](int n) { return n; }, [](int) { return 1.f; });
    }
    for (int it = gw; it < 192 * 2048 / 512; it += NGW) *(GAS v4u*)((bf16*)(ws + WS_WT_IN) + (size_t)2880 * 2048 + (size_t)it * 512 + lane * 8) = (v4u){0u, 0u, 0u, 0u};
    for (int it = gw; it < 3 * 256; it += NGW) { const int w = it >> 8, c = it & 255;
        if (w == 0) p0_cvt512(k1, (bf16*)(ws + WS_K1B), (size_t)c * 512, lane, [](size_t) { return 1.f; });
        else if (w == 1) p0_cvt512(k2, (bf16*)(ws + WS_K2B), (size_t)c * 512, lane, [](size_t) { return 1.f; });
        else p0_cvt512(w_sgu, (bf16*)(ws + WS_WSGU), (size_t)c * 512, lane, [](size_t e) { const int s = (int)(e & 127), t = (int)((e >> 7) & 127); return s <= t ? 1.f : 0.f; }); }
#if CUT >= 7
    for (int it = gw; it < 2 * 16384 * 4; it += NGW) { const int w = it >= 16384 * 4, c = w ? it - 16384 * 4 : it;
        if (!w) p0_cvt512(pu, (bf16*)(ws + WS_UB), (size_t)c * 512, lane, [=](size_t e) { return g_ffn[e & 2047]; });
        else p0_cvt512(pv, (bf16*)(ws + WS_VB), (size_t)c * 512, lane, [](size_t) { return 1.f; }); }
#endif
}

__device__ __forceinline__ v4u pack8(f32x4 a, f32x4 b) { v4u w; w.x = pg8::cvt_pk_bf16(a[0], a[1]); w.y = pg8::cvt_pk_bf16(a[2], a[3]); w.z = pg8::cvt_pk_bf16(b[0], b[1]); w.w = pg8::cvt_pk_bf16(b[2], b[3]); return w; }
__device__ __forceinline__ float sq8(f32x4 a, f32x4 b) { return ((a[0] * a[0] + a[1] * a[1]) + (a[2] * a[2] + a[3] * a[3])) + ((b[0] * b[0] + b[1] * b[1]) + (b[2] * b[2] + b[3] * b[3])); }
__device__ __forceinline__ float fq_sum(float v) { v += __shfl_xor(v, 16); v += __shfl_xor(v, 32); return v; }
#define EPI_ROWS_BEGIN _Pragma("unroll") for (int ai = 0; ai < 2; ++ai) _Pragma("unroll") for (int m = 0; m < 4; ++m) { const int row = u.pm * 256 + ai * 128 + wr * 64 + m * 16 + fr;
#define EPI_ROWS_END }

struct EpiG1 {
    static constexpr bool PERM = true, AFTER_DRAIN = false, MID = false;
    const float* rsx; bf16 *CQ, *CKV, *KR, *UG, *VG; float *pscq, *psckv; f32x2v* psv; const f32x2v* cs;
    __device__ __forceinline__ void operator()(const f32x4 (&acc)[2][2][4][2], const pg8::Unit& u, int wr, int wc, int fr, int fq) const {
        const int pn = u.pn;
        EPI_ROWS_BEGIN
            const float rs = rsx[row];
#pragma unroll
            for (int bj = 0; bj < 2; ++bj) { f32x4 v0 = acc[ai][bj][m][0] * rs, v1 = acc[ai][bj][m][1] * rs; const int lc = bj * 128 + wc * 32 + fq * 8;
                if (pn <= 2) { const float ss = fq_sum(sq8(v0, v1));
                    if (pn < 2) { *(GAS v4u*)(CQ + (size_t)row * 512 + pn * 256 + lc) = pack8(v0, v1); if (fq == 0) pscq[row * 16 + (pn * 2 + bj) * 4 + wc] = ss; }
                    else { *(GAS v4u*)(CKV + (size_t)row * 256 + lc) = pack8(v0, v1); if (fq == 0) psckv[row * 8 + bj * 4 + wc] = ss; } }
                else if (pn <= 10) {
#pragma unroll
                    for (int e = 0; e < 4; ++e) { v0[e] = gelu_f(v0[e]); v1[e] = gelu_f(v1[e]); }
                    if (pn <= 6) *(GAS v4u*)(UG + (size_t)row * 1024 + (pn - 3) * 256 + lc) = pack8(v0, v1);
                    else { const float s = fq_sum(((v0[0] + v0[1]) + (v0[2] + v0[3])) + ((v1[0] + v1[1]) + (v1[2] + v1[3]))), q = fq_sum(sq8(v0, v1));
                        *(GAS v4u*)(VG + (size_t)row * 1024 + (pn - 7) * 256 + lc) = pack8(v0, v1); if (fq == 0) psv[(row * 8 + (pn - 7) * 2 + bj) * 4 + wc] = (f32x2v){s, q}; } }
                else if (bj == 0 && wc < 2) { f32x4 o0, o1;
#pragma unroll
                    for (int e = 0; e < 4; ++e) { const f32x2v c = cs[row * 32 + 16 * wc + 4 * fq + e]; o0[e] = v0[e] * c.x - v1[e] * c.y; o1[e] = v1[e] * c.x + v0[e] * c.y; }
                    *(GAS v4u*)(KR + (size_t)row * 64 + wc * 32 + fq * 8) = pack8(o0, o1); } }
        EPI_ROWS_END
    }
};
struct EpiPlain {
    static constexpr bool PERM = true, AFTER_DRAIN = false, MID = false;
    bf16* O; int ldc;
    __device__ __forceinline__ void operator()(const f32x4 (&acc)[2][2][4][2], const pg8::Unit& u, int wr, int wc, int fr, int fq) const {
        EPI_ROWS_BEGIN
#pragma unroll
            for (int bj = 0; bj < 2; ++bj) *(GAS v4u*)(O + (size_t)row * ldc + u.pn * 256 + bj * 128 + wc * 32 + fq * 8) = pack8(acc[ai][bj][m][0], acc[ai][bj][m][1]);
        EPI_ROWS_END
    }
};
template <class Sched>
__device__ __forceinline__ void setup_rowtab(LAS float* tab, const float* part, int NP, float inv_dim, const Sched& S, int wid) {
    pg8::Unit u; const int tid = wid * 64 + lane_id();
    if (S.next(0, u)) { const int r = tid >> 1, half = tid & 1, n2 = NP >> 1; const float* pp = part + (size_t)(u.pm * 256 + r) * NP + half * n2; float s = 0.f;
        for (int j = 0; j < n2; ++j) s += pp[j];
        s += __shfl_xor(s, 1); if (!half) tab[r] = 1.0f / sqrtf(s * inv_dim + 1e-6f); }
}
struct EpiQ {
    static constexpr bool PERM = true, AFTER_DRAIN = false, MID = false;
    const LAS float* tab; bf16* Q; const f32x2v* cs;
    __device__ __forceinline__ void operator()(const f32x4 (&acc)[2][2][4][2], const pg8::Unit& u, int wr, int wc, int fr, int fq) const {
        EPI_ROWS_BEGIN
            const float rs = tab[ai * 128 + wr * 64 + m * 16 + fr];
#pragma unroll
            for (int bj = 0; bj < 2; ++bj) { f32x4 v0 = acc[ai][bj][m][0] * rs, v1 = acc[ai][bj][m][1] * rs; const int gc = u.pn * 256 + bj * 128 + wc * 32;
                if (((gc >> 6) % 3) == 2) { f32x4 o0, o1;
#pragma unroll
                    for (int e = 0; e < 4; ++e) { const f32x2v c = cs[row * 32 + 16 * (wc & 1) + 4 * fq + e]; o0[e] = v0[e] * c.x - v1[e] * c.y; o1[e] = v1[e] * c.x + v0[e] * c.y; }
                    v0 = o0; v1 = o1; }
                *(GAS v4u*)(Q + (size_t)row * 1536 + gc + fq * 8) = pack8(v0, v1); }
        EPI_ROWS_END
    }
};
struct EpiKV {
    static constexpr bool PERM = true, AFTER_DRAIN = false, MID = false;
    const LAS float* tab; bf16 *KN, *VV;
    __device__ __forceinline__ void operator()(const f32x4 (&acc)[2][2][4][2], const pg8::Unit& u, int wr, int wc, int fr, int fq) const {
        EPI_ROWS_BEGIN
            const float rs = tab[ai * 128 + wr * 64 + m * 16 + fr];
#pragma unroll
            for (int bj = 0; bj < 2; ++bj) *(GAS v4u*)((bj ? VV : KN) + (size_t)row * 1024 + u.pn * 128 + wc * 32 + fq * 8) = pack8(acc[ai][bj][m][0] * rs, acc[ai][bj][m][1] * rs);
        EPI_ROWS_END
    }
};
struct EpiOut {
    static constexpr bool PERM = true, AFTER_DRAIN = false, MID = true;
    const LAS float* tab; const float* x; float* H1; bf16* H1B; float* psh1;
    __device__ __forceinline__ void mid(f32x4 (&acc)[2][2][4][2], const pg8::Unit& u, int wr, int wc, int fr, int fq) const {
#pragma unroll
        for (int ai = 0; ai < 2; ++ai)
#pragma unroll
            for (int m = 0; m < 4; ++m) { const int r = ai * 128 + wr * 64 + m * 16 + fr; const float rr = tab[r] / tab[256 + r];
#pragma unroll
                for (int bj = 0; bj < 2; ++bj) { acc[ai][bj][m][0] *= rr; acc[ai][bj][m][1] *= rr; } }
    }
    __device__ __forceinline__ void operator()(const f32x4 (&acc)[2][2][4][2], const pg8::Unit& u, int wr, int wc, int fr, int fq) const {
        EPI_ROWS_BEGIN
            const float rs = tab[256 + ai * 128 + wr * 64 + m * 16 + fr];
#pragma unroll
            for (int bj = 0; bj < 2; ++bj) { const size_t off = (size_t)row * DM + u.pn * 256 + bj * 128 + wc * 32 + fq * 8;
                const f32x4 v0 = *(const GAS f32x4*)(x + off) + acc[ai][bj][m][0] * rs, v1 = *(const GAS f32x4*)(x + off + 4) + acc[ai][bj][m][1] * rs;
                *(GAS f32x4*)(H1 + off) = v0; *(GAS f32x4*)(H1 + off + 4) = v1; *(GAS v4u*)(H1B + off) = pack8(v0, v1);
                const float ss = fq_sum(sq8(v0, v1)); if (fq == 0) psh1[row * 64 + u.pn * 8 + bj * 4 + wc] = ss; }
        EPI_ROWS_END
    }
};
struct EpiPQ {
    static constexpr bool PERM = true, AFTER_DRAIN = false, MID = false;
    const LAS float* tab; bf16* QP;
    __device__ __forceinline__ void operator()(const f32x4 (&acc)[2][2][4][2], const pg8::Unit& u, int wr, int wc, int fr, int fq) const {
        EPI_ROWS_BEGIN
            const float rs = tab[ai * 128 + wr * 64 + m * 16 + fr];
#pragma unroll
            for (int bj = 0; bj < 2; ++bj) *(GAS v4u*)(QP + (size_t)row * DM + u.pn * 256 + bj * 128 + wc * 32 + fq * 8) = pack8(acc[ai][bj][m][0] * rs, acc[ai][bj][m][1] * rs);
        EPI_ROWS_END
    }
};
struct EpiPLE {
    static constexpr bool PERM = true, AFTER_DRAIN = false, MID = false;
    const float* rsh2; const float* H2; const bf16* PPROJ; float* out; float* psh3;
    __device__ __forceinline__ void operator()(const f32x4 (&acc)[2][2][4][2], const pg8::Unit& u, int wr, int wc, int fr, int fq) const {
        EPI_ROWS_BEGIN
            const float rs = rsh2[row];
#pragma unroll
            for (int bj = 0; bj < 2; ++bj) { const size_t off = (size_t)row * DM + u.pn * 256 + bj * 128 + wc * 32 + fq * 8;
                const v4u pw = *(const GAS v4u*)(PPROJ + off); f32x4 h0 = *(const GAS f32x4*)(H2 + off), h1 = *(const GAS f32x4*)(H2 + off + 4);
                const unsigned pws[4] = {pw.x, pw.y, pw.z, pw.w};
#pragma unroll
                for (int e = 0; e < 4; ++e) { const float a = acc[ai][bj][m][e >> 1][(e & 1) * 2] * rs, b = acc[ai][bj][m][e >> 1][(e & 1) * 2 + 1] * rs;
                    const float ga = __builtin_amdgcn_rcpf(1.f + __builtin_amdgcn_exp2f(-1.4426950408889634f * a)), gb = __builtin_amdgcn_rcpf(1.f + __builtin_amdgcn_exp2f(-1.4426950408889634f * b));
                    const float pa = __uint_as_float(pws[e] << 16), pb = __uint_as_float(pws[e] & 0xffff0000u);
                    if (e < 2) { h0[(e & 1) * 2] += ga * pa; h0[(e & 1) * 2 + 1] += gb * pb; } else { h1[(e & 1) * 2] += ga * pa; h1[(e & 1) * 2 + 1] += gb * pb; } }
                *(GAS f32x4*)(out + off) = h0; *(GAS f32x4*)(out + off + 4) = h1;
                const float ss = fq_sum(sq8(h0, h1)); if (fq == 0) psh3[row * 64 + u.pn * 8 + bj * 4 + wc] = ss; }
        EPI_ROWS_END
    }
};
typedef float f32x16 __attribute__((ext_vector_type(16)));
typedef short s16x4 __attribute__((ext_vector_type(4)));
#define KSWZ(row, colB) ((row) * 256 + ((colB) ^ (((row) & 7) << 4)))
__device__ __forceinline__ int v_st(int k, int c) { const int kk = (k & ~0xC) | ((k & 4) << 1) | ((k & 8) >> 1); return ((kk >> 3) * 4 + (c >> 5)) * 512 + ((kk & 7) * 32 + (c & 31)) * 2; }
__device__ __forceinline__ int v_rd_base(int lane) { return ((lane & 3) << 3) | (((lane >> 2) & 3) << 6) | (((lane >> 4) & 1) << 5) | (((lane >> 5) & 1) << 8); }
__device__ __forceinline__ int crow(int r, int hi) { return (r & 3) + 8 * (r >> 2) + 4 * hi; }
#define TRRD(dst, off) asm volatile("ds_read_b64_tr_b16 %0, %1 offset:%2" : "=&v"(dst) : "v"(vb0), "i"(off) : "memory")
#define SBAR() __builtin_amdgcn_sched_barrier(0)
#define PV_ONE(o_, pa_, VOFF, D0, KS) do { s16x4 l_, h_; TRRD(l_, (VOFF) + (D0) * 512 + (KS) * 4096); TRRD(h_, (VOFF) + (D0) * 512 + (KS) * 4096 + 2048); \
        asm volatile("s_waitcnt lgkmcnt(0)" ::: "memory"); SBAR(); \
        o_ = __builtin_amdgcn_mfma_f32_32x32x16_bf16(pa_, (bf16x8){l_[0], l_[1], l_[2], l_[3], h_[0], h_[1], h_[2], h_[3]}, o_, 0, 0, 0); } while (0)
__device__ __forceinline__ float half_sum32(float v) { v += __shfl_xor(v, 1); v += __shfl_xor(v, 2); v += __shfl_xor(v, 4); v += __shfl_xor(v, 8); v += __shfl_xor(v, 16); return v; }

__device__ __forceinline__ void sgu_phase(const Args& A, Frame& F) {
    unsigned char* ws = A.ws;
    const bf16* VG = (const bf16*)(ws + WS_VG); const bf16* UG = (const bf16*)(ws + WS_UG); const bf16* WS = (const bf16*)(ws + WS_WSGU); const f32x2v* psv = (const f32x2v*)(ws + WS_PSV);
    const float* gln = (const float*)A.in[9]; const float* bln = (const float*)A.in[10]; const float* bs = (const float*)A.in[12];
    bf16* MIX = (bf16*)(ws + WS_MIX); float* pss = (float*)(ws + WS_PSS);
    const int lane = lane_id(), wid = F.wave, tid = wid * 64 + lane, r32 = lane & 31, hi = lane >> 5, tg = wid & 3, dh = wid >> 2;
    LAS unsigned char* V_lds = F.lds + RING_OFF;
    const int vb0 = (int)(uintptr_t)V_lds + v_rd_base(lane);
    for (int unit = F.vcu; unit < 512; unit += F.G) {
        const int g = unit & 7, R0 = (unit >> 3) * 128;
#pragma unroll
        for (int i = 0; i < 4; ++i) { const int s = (tid >> 4) + 32 * i, c = (tid & 15) * 8, row = R0 + s;
            const f32x2v* pp = psv + ((size_t)row * 8 + g) * 4; const f32x2v p0 = pp[0], p1 = pp[1], p2 = pp[2], p3 = pp[3];
            const float mean = ((p0.x + p1.x) + (p2.x + p3.x)) * (1.f / 128.f), var = ((p0.y + p1.y) + (p2.y + p3.y)) * (1.f / 128.f) - mean * mean, rstd = 1.0f / sqrtf(fmaxf(var, 0.f) + 1e-6f);
            const v4u xv = *(const GAS v4u*)(VG + (size_t)row * 1024 + g * 128 + c);
            const f32x4 g0 = *(const GAS f32x4*)(gln + g * 128 + c), g1 = *(const GAS f32x4*)(gln + g * 128 + c + 4), b0 = *(const GAS f32x4*)(bln + g * 128 + c), b1 = *(const GAS f32x4*)(bln + g * 128 + c + 4);
            f32x4 y0, y1;
            y0[0] = (__uint_as_float(xv.x << 16) - mean) * rstd * g0[0] + b0[0]; y0[1] = (__uint_as_float(xv.x & 0xffff0000u) - mean) * rstd * g0[1] + b0[1];
            y0[2] = (__uint_as_float(xv.y << 16) - mean) * rstd * g0[2] + b0[2]; y0[3] = (__uint_as_float(xv.y & 0xffff0000u) - mean) * rstd * g0[3] + b0[3];
            y1[0] = (__uint_as_float(xv.z << 16) - mean) * rstd * g1[0] + b1[0]; y1[1] = (__uint_as_float(xv.z & 0xffff0000u) - mean) * rstd * g1[1] + b1[1];
            y1[2] = (__uint_as_float(xv.w << 16) - mean) * rstd * g1[2] + b1[2]; y1[3] = (__uint_as_float(xv.w & 0xffff0000u) - mean) * rstd * g1[3] + b1[3];
            *(LAS v4u*)(V_lds + (s >> 6) * 16384 + v_st(s & 63, c)) = pack8(y0, y1); }
        bf16x8 afr[8];
#pragma unroll
        for (int ks = 0; ks < 8; ++ks) afr[ks] = *(const GAS bf16x8*)(WS + ((size_t)g * 128 + 32 * tg + r32) * 128 + 16 * ks + 8 * hi);
        __syncthreads();
        f32x16 o0 = {}, o1 = {};
#define SGU_TILE(TL) do { _Pragma("unroll") for (int ks = 0; ks < 4; ++ks) { \
            if (dh == 0) { PV_ONE(o0, afr[4 * TL + ks], TL * 16384, 0, ks); PV_ONE(o1, afr[4 * TL + ks], TL * 16384, 1, ks); } \
            else { PV_ONE(o0, afr[4 * TL + ks], TL * 16384, 2, ks); PV_ONE(o1, afr[4 * TL + ks], TL * 16384, 3, ks); } } } while (0)
        SGU_TILE(0); if (tg >= 2) SGU_TILE(1);
#undef SGU_TILE
#pragma unroll
        for (int r = 0; r < 16; ++r) { const int t = 32 * tg + crow(r, hi), row = R0 + t; const float bias = bs[g * 128 + t];
            const int d0 = 64 * dh + r32; const size_t uoff = (size_t)row * 1024 + g * 128 + d0;
            const float va = bf2f(UG[uoff]) * (o0[r] + bias), vb = bf2f(UG[uoff + 32]) * (o1[r] + bias);
            const float na = __shfl_xor(va, 1), nb = __shfl_xor(vb, 1);
            if ((r32 & 1) == 0) { bf16* mo = MIX + (size_t)row * 2048 + 1024 + g * 128 + d0; *(GAS unsigned*)mo = pg8::cvt_pk_bf16(va, na); *(GAS unsigned*)(mo + 32) = pg8::cvt_pk_bf16(vb, nb); }
            const float ss = half_sum32(va * va + vb * vb); if (r32 == 0) pss[row * 16 + g * 2 + dh] = ss; }
        __syncthreads();
    }
}

#define OPAQUE(x) asm volatile("" : "+v"(x))
constexpr int KT_ROW = 400, KT_BYTES = 64 * KT_ROW;
__device__ __forceinline__ void attn_phase(const Args& A, Frame& F) {
    unsigned char* ws = A.ws;
    const GAS unsigned char* Qg = (const GAS unsigned char*)(ws + WS_Q); const GAS unsigned char* KNg = (const GAS unsigned char*)(ws + WS_KN); const GAS unsigned char* VVg = (const GAS unsigned char*)(ws + WS_VV); const GAS unsigned char* KRg = (const GAS unsigned char*)(ws + WS_KR);
    bf16* MIX = (bf16*)(ws + WS_MIX); float* psa = (float*)(ws + WS_PSA);
    const int wid = F.wave, g = wid & 3, kh = wid >> 2;
    LAS unsigned char* V_lds = F.lds + RING_OFF; LAS unsigned char* Kt_lds = V_lds + 32768;
    LAS float* wsc = (LAS float*)(V_lds + 86016) + wid * 64;
    LAS float* ml1 = (LAS float*)(V_lds + 86016 + 2048);
    for (int item = F.vcu; item < 256; item += F.G) {
        const int bh = item >> 3, s = item & 7, b = bh >> 3, h = bh & 7, tok0 = b * SEQ;
        for (int pass = 0; pass < 2; ++pass) {
            const int jq = pass ? s : 15 - s, q0 = tok0 + 128 * jq, NT = 2 * (jq + 1);
            bf16x8 qr[12];
            { int ln = lane_id(); const int r32 = ln & 31, hi = ln >> 5; const GAS unsigned char* qp = Qg + (size_t)(q0 + 32 * g) * 3072 + h * 384; const unsigned qo = (unsigned)r32 * 3072u + (unsigned)hi * 16u;
#pragma unroll
              for (int ks = 0; ks < 12; ++ks) qr[ks] = *(const GAS bf16x8*)(qp + qo + ks * 32); }
            bf16x8 skn0, skn1, sv0, sv1, skr;
#define ALOAD(t_) do { int ln_ = lane_id(); const int tid_ = wid * 64 + ln_; const unsigned sr_ = tid_ >> 4, sc_ = tid_ & 15; \
                const GAS unsigned char* kb_ = KNg + (size_t)(tok0 + 64 * (t_)) * 2048 + h * 256; const GAS unsigned char* vb_ = VVg + (size_t)(tok0 + 64 * (t_)) * 2048 + h * 256; const GAS unsigned char* rb_ = KRg + (size_t)(tok0 + 64 * (t_)) * 128; \
                const unsigned o_ = sr_ * 2048u + sc_ * 16u; \
                skn0 = *(const GAS bf16x8*)(kb_ + o_); skn1 = *(const GAS bf16x8*)(kb_ + o_ + 65536u); sv0 = *(const GAS bf16x8*)(vb_ + o_); sv1 = *(const GAS bf16x8*)(vb_ + o_ + 65536u); \
                skr = *(const GAS bf16x8*)(rb_ + (unsigned)tid_ * 16u); } while (0)
#define AWRITE(bf_) do { int ln_ = lane_id(); const int tid_ = wid * 64 + ln_; const int sr_ = tid_ >> 4, sc_ = tid_ & 15; \
                LAS unsigned char* kt_ = Kt_lds + (bf_) * KT_BYTES; LAS unsigned char* vt_ = V_lds + (bf_) * 16384; \
                *(LAS bf16x8*)(kt_ + sr_ * KT_ROW + sc_ * 16) = skn0; *(LAS bf16x8*)(kt_ + (sr_ + 32) * KT_ROW + sc_ * 16) = skn1; \
                *(LAS bf16x8*)(vt_ + v_st(sr_, sc_ * 8)) = sv0; *(LAS bf16x8*)(vt_ + v_st(32 + sr_, sc_ * 8)) = sv1; \
                *(LAS bf16x8*)(kt_ + (tid_ >> 3) * KT_ROW + 256 + (tid_ & 7) * 16) = skr; } while (0)
            ALOAD(0); AWRITE(0); __syncthreads();
            float m_reg = -1e30f, l_reg = 0.f; f32x16 o[4] = {};
            for (int t = 0; t < NT; ++t) {
                const int bf = t & 1;
                if (t + 1 < NT) ALOAD(t + 1);
                int ln = lane_id(); const int r32 = ln & 31, hi = ln >> 5;
                f32x16 p = {};
                { const LAS unsigned char* kb = Kt_lds + bf * KT_BYTES + (32 * kh + r32) * KT_ROW + hi * 16;
#pragma unroll
                  for (int ks = 0; ks < 12; ++ks) p = __builtin_amdgcn_mfma_f32_32x32x16_bf16(*(const LAS bf16x8*)(kb + ks * 32), qr[ks], p, 0, 0, 0); }
                if (t >= 2 * jq) { const int dq = (32 * g + r32) - (64 * (t - 2 * jq) + 32 * kh + 4 * hi);
#pragma unroll
                    for (int r = 0; r < 16; ++r) { const int c = (r & 3) + 8 * (r >> 2); if (c > dq) p[r] = -__builtin_inff(); } }
                float pmax = p[0];
#pragma unroll
                for (int r = 1; r < 16; ++r) pmax = fmaxf(pmax, p[r]);
                { auto rr = __builtin_amdgcn_permlane32_swap(__float_as_uint(pmax), __float_as_uint(pmax), false, false); pmax = fmaxf(__uint_as_float(rr[0]), __uint_as_float(rr[1])); }
                const float mn = fmaxf(m_reg, pmax), alpha = __builtin_amdgcn_exp2f(m_reg - mn); m_reg = mn;
                float ps = 0.f;
#pragma unroll
                for (int r = 0; r < 16; ++r) { p[r] = __builtin_amdgcn_exp2f(p[r] - mn); ps += p[r]; }
                { auto rr = __builtin_amdgcn_permlane32_swap(__float_as_uint(ps), __float_as_uint(ps), false, false); ps = __uint_as_float(rr[0]) + __uint_as_float(rr[1]); }
                l_reg = l_reg * alpha + ps;
                if (__any(alpha < 1.f)) { if (hi == 0) wsc[r32] = alpha; asm volatile("s_waitcnt lgkmcnt(0)" ::: "memory");
#pragma unroll
                    for (int r = 0; r < 16; ++r) { const float f = wsc[crow(r, hi)];
#pragma unroll
                        for (int d_ = 0; d_ < 4; ++d_) o[d_][r] *= f; } }
                bf16x8 pa0, pa1;
#define PK4(P, B_, OUT) do { unsigned a0 = pg8::cvt_pk_bf16(P[B_ + 0], P[B_ + 1]), a1 = pg8::cvt_pk_bf16(P[B_ + 2], P[B_ + 3]), b0 = pg8::cvt_pk_bf16(P[B_ + 4], P[B_ + 5]), b1 = pg8::cvt_pk_bf16(P[B_ + 6], P[B_ + 7]); \
                    auto r0 = __builtin_amdgcn_permlane32_swap(a0, b0, false, false); auto r1 = __builtin_amdgcn_permlane32_swap(a1, b1, false, false); \
                    v4u w = {r0[0], r1[0], r0[1], r1[1]}; OUT = __builtin_bit_cast(bf16x8, w); } while (0)
                PK4(p, 0, pa0); PK4(p, 8, pa1);
#undef PK4
                { const int vb0 = (int)(uintptr_t)V_lds + v_rd_base(ln) + bf * 16384 + kh * 8192;
#pragma unroll
                  for (int d0 = 0; d0 < 4; ++d0) { PV_ONE(o[d0], pa0, 0, d0, 0); PV_ONE(o[d0], pa1, 0, d0, 1); } }
                if (t + 1 < NT) AWRITE(bf ^ 1);
                __syncthreads();
            }
#undef ALOAD
#undef AWRITE
            { int ln = lane_id(); const int r32 = ln & 31, hi = ln >> 5;
            LAS float* O1 = (LAS float*)(V_lds + g * 16384) + ln;
            if (kh == 1) {
#pragma unroll
                for (int d0 = 0; d0 < 4; ++d0)
#pragma unroll
                    for (int r = 0; r < 16; ++r) O1[(d0 * 16 + r) * 64] = o[d0][r];
                if (hi == 0) { ml1[g * 64 + r32] = m_reg; ml1[g * 64 + 32 + r32] = l_reg; } }
            __syncthreads();
            if (kh == 0) { const float m1 = ml1[g * 64 + r32], l1 = ml1[g * 64 + 32 + r32], mt = fmaxf(m_reg, m1), a0 = __builtin_amdgcn_exp2f(m_reg - mt), a1 = __builtin_amdgcn_exp2f(m1 - mt), il = 1.0f / (l_reg * a0 + l1 * a1);
                if (hi == 0) { wsc[r32] = a0 * il; wsc[32 + r32] = a1 * il; } asm volatile("s_waitcnt lgkmcnt(0)" ::: "memory");
#pragma unroll
                for (int r = 0; r < 16; ++r) { const int qrow = q0 + 32 * g + crow(r, hi); const float f0 = wsc[crow(r, hi)], f1 = wsc[32 + crow(r, hi)]; float ss = 0.f;
#pragma unroll
                    for (int d0 = 0; d0 < 4; ++d0) { const float v = o[d0][r] * f0 + O1[(d0 * 16 + r) * 64] * f1; ss += v * v; const float vn = __shfl_xor(v, 1);
                        if ((r32 & 1) == 0) *(GAS unsigned*)(MIX + (size_t)qrow * 2048 + h * 128 + d0 * 32 + r32) = pg8::cvt_pk_bf16(v, vn); }
                    ss = half_sum32(ss); if (r32 == 0) psa[qrow * 8 + h] = ss; } }
            __syncthreads(); }
        }
    }
}
typedef __bf16 bf16x2_t __attribute__((ext_vector_type(2)));
__device__ __forceinline__ unsigned ord_key(float f) { const unsigned u = __float_as_uint(f); return u ^ ((unsigned)((int)u >> 31) | 0x80000000u); }
__device__ __forceinline__ float ord_val(unsigned k) { return __uint_as_float((k & 0x80000000u) ? (k ^ 0x80000000u) : ~k); }
__device__ __forceinline__ unsigned umax3(unsigned a, unsigned b, unsigned c) { return max(max(a, b), c); }
__device__ __forceinline__ unsigned pair_max(unsigned v) { auto rr = __builtin_amdgcn_permlane32_swap(v, v, false, false); return max(rr[0], rr[1]); }
__device__ __forceinline__ unsigned pair_or(unsigned v) { auto rr = __builtin_amdgcn_permlane32_swap(v, v, false, false); return rr[0] | rr[1]; }
__host__ __device__ constexpr int cand_a(int c) { return c < 16 ? 0 : c < 24 ? 1 : c < 29 ? 2 : c < 33 ? 3 : c < 36 ? 4 : c < 38 ? 5 : c < 40 ? 6 : c < 42 ? 7 : c - 34; }
__host__ __device__ constexpr int cand_b(int c) { return c < 16 ? c : c < 24 ? c - 16 : c < 29 ? c - 24 : c < 33 ? c - 29 : c < 36 ? c - 33 : c < 38 ? c - 36 : c < 40 ? c - 38 : c < 42 ? c - 40 : 0; }
__device__ __forceinline__ void topk16_of_128(const bf16* keys  , const bf16* qrow  , int r32, int hi, unsigned (&sel)[16]) {
    bf16x8 qf[8];
#pragma unroll
    for (int ks = 0; ks < 8; ++ks) qf[ks] = *(const GAS bf16x8*)(qrow + 16 * ks + 8 * hi);
    unsigned k[64];
#pragma unroll
    for (int kb = 0; kb < 4; ++kb) { f32x16 acc = {};
#pragma unroll
        for (int ks = 0; ks < 8; ++ks) acc = __builtin_amdgcn_mfma_f32_32x32x16_bf16(*(const GAS bf16x8*)(keys + (size_t)(32 * kb + r32) * 128 + 16 * ks + 8 * hi), qf[ks], acc, 0, 0, 0);
#pragma unroll
        for (int r = 0; r < 16; ++r) k[kb * 16 + r] = (ord_key(acc[r]) & ~0x7fu) | (unsigned)(127 - (32 * kb + crow(r, hi))); }
#pragma unroll
    for (int it = 0; it < 16; ++it) { unsigned m = umax3(k[0], k[1], k[2]);
#pragma unroll
        for (int i = 3; i < 63; i += 2) m = umax3(m, k[i], k[i + 1]);
        m = max(m, k[63]); m = pair_max(m); sel[it] = m;
#pragma unroll
        for (int i = 0; i < 64; ++i) k[i] = (k[i] == m) ? 0u : k[i]; }
}
__device__ __forceinline__ void topk_phase(const Args& A, Frame& F) {
    unsigned char* ws = A.ws;
    const bf16* QP = (const bf16*)(ws + WS_R1); const bf16* K1 = (const bf16*)(ws + WS_K1B); const bf16* K2 = (const bf16*)(ws + WS_K2B); int* IDX = (int*)(ws + WS_IDX); float* GATE = (float*)(ws + WS_GATE);
    const int wid = F.wave;
    for (int unit = F.vcu; unit < 256; unit += F.G) {
        const int rb = unit >> 3, h = unit & 7; const int ln = lane_id(), r32 = ln & 31, hi = ln >> 5; const int tok = rb * 256 + wid * 32 + r32;
        unsigned s1[16], s2[16];
        topk16_of_128(K1 + (size_t)h * 16384, QP + (size_t)tok * 2048 + h * 256, r32, hi, s1);
        topk16_of_128(K2 + (size_t)h * 16384, QP + (size_t)tok * 2048 + h * 256 + 128, r32, hi, s2);
        float t1v[16], t2v[16]; int i1[16], i2[16];
#pragma unroll
        for (int a = 0; a < 16; ++a) { t1v[a] = ord_val(s1[a] & ~0x7fu); i1[a] = 127 - (int)(s1[a] & 0x7fu); t2v[a] = ord_val(s2[a] & ~0x7fu); i2[a] = 127 - (int)(s2[a] & 0x7fu); }
        unsigned ck[25]; int ce[25];
#pragma unroll
        for (int j = 0; j < 25; ++j) { constexpr int dummy = 0; (void)dummy;
            const int c0 = 2 * j, c1 = 2 * j + 1;
            const float v0 = t1v[cand_a(c0)] + t2v[cand_b(c0)], v1 = t1v[cand_a(c1)] + t2v[cand_b(c1)];
            const unsigned k0 = (ord_key(v0) & ~0xffu) | (unsigned)(255 - (cand_a(c0) * 16 + cand_b(c0))), k1 = (ord_key(v1) & ~0xffu) | (unsigned)(255 - (cand_a(c1) * 16 + cand_b(c1)));
            const int e0 = i1[cand_a(c0)] * 128 + i2[cand_b(c0)], e1 = i1[cand_a(c1)] * 128 + i2[cand_b(c1)];
            ck[j] = hi ? k1 : k0; ce[j] = hi ? e1 : e0; }
        unsigned gk[16]; int ge[16];
#pragma unroll
        for (int it = 0; it < 16; ++it) { unsigned m = ck[0];
#pragma unroll
            for (int j = 1; j < 25; j += 2) m = umax3(m, ck[j], ck[j + 1]);
            m = pair_max(m); gk[it] = m; int e = 0;
#pragma unroll
            for (int j = 0; j < 25; ++j) { const bool eq = ck[j] == m; e = eq ? ce[j] : e; ck[j] = eq ? 0u : ck[j]; }
            ge[it] = e; }
        float ev[16]; float l = 0.f; const float v0 = ord_val(gk[0] & ~0xffu);
#pragma unroll
        for (int it = 0; it < 16; ++it) { ge[it] = (int)pair_or((unsigned)ge[it]); ev[it] = __builtin_amdgcn_exp2f((ord_val(gk[it] & ~0xffu) - v0) * 1.4426950408889634f); l += ev[it]; }
        const float il = 1.0f / l;
        if (hi == 0) { int* ip = IDX + (size_t)tok * 128 + h * 16; float* gp = GATE + (size_t)tok * 128 + h * 16;
#pragma unroll
            for (int q = 0; q < 4; ++q) { *(GAS v4u*)(ip + 4 * q) = (v4u){(unsigned)ge[4 * q], (unsigned)ge[4 * q + 1], (unsigned)ge[4 * q + 2], (unsigned)ge[4 * q + 3]};
                *(GAS f32x4*)(gp + 4 * q) = (f32x4){ev[4 * q] * il, ev[4 * q + 1] * il, ev[4 * q + 2] * il, ev[4 * q + 3] * il}; } }
    }
}

__device__ __forceinline__ bf16x2_t asbf(unsigned u) { return __builtin_bit_cast(bf16x2_t, u); }
__device__ __forceinline__ float dot8(v4u a, v4u b, float c) {
    c = __builtin_amdgcn_fdot2_f32_bf16(asbf(a.x), asbf(b.x), c, false); c = __builtin_amdgcn_fdot2_f32_bf16(asbf(a.y), asbf(b.y), c, false);
    c = __builtin_amdgcn_fdot2_f32_bf16(asbf(a.z), asbf(b.z), c, false); c = __builtin_amdgcn_fdot2_f32_bf16(asbf(a.w), asbf(b.w), c, false); return c;
}
__device__ __forceinline__ void fmac_s(float& acc, float ws, float x) { asm("v_fmac_f32_e32 %0, %1, %2" : "+v"(acc) : "s"(ws), "v"(x)); }
__device__ __forceinline__ void axpy8(float (&acc)[8], v4u v, float w  ) {
    fmac_s(acc[0], w, __uint_as_float(v.x << 16)); fmac_s(acc[1], w, __uint_as_float(v.x & 0xffff0000u)); fmac_s(acc[2], w, __uint_as_float(v.y << 16)); fmac_s(acc[3], w, __uint_as_float(v.y & 0xffff0000u));
    fmac_s(acc[4], w, __uint_as_float(v.z << 16)); fmac_s(acc[5], w, __uint_as_float(v.z & 0xffff0000u)); fmac_s(acc[6], w, __uint_as_float(v.w << 16)); fmac_s(acc[7], w, __uint_as_float(v.w & 0xffff0000u));
}
struct Row4 { v4u c[4]; };
__device__ __forceinline__ Row4 load_row(const GAS unsigned char* base, unsigned e, unsigned lane16) { const GAS unsigned char* p = base + (size_t)e * 4096 + lane16; Row4 r; r.c[0] = *(const GAS v4u*)p; r.c[1] = *(const GAS v4u*)(p + 1024); r.c[2] = *(const GAS v4u*)(p + 2048); r.c[3] = *(const GAS v4u*)(p + 3072); return r; }
__device__ __forceinline__ void gather_phase(const Args& A, Frame& F) {
    unsigned char* ws = A.ws;
    const GAS unsigned char* UB = (const GAS unsigned char*)(ws + WS_UB); const GAS unsigned char* VB = (const GAS unsigned char*)(ws + WS_VB);
    float* H1 = (float*)(ws + WS_H1); bf16* H1B = (bf16*)(ws + WS_H1B); const float* psh1 = (const float*)(ws + WS_PSH1); const int* IDX = (const int*)(ws + WS_IDX); const float* GATE = (const float*)(ws + WS_GATE); float* rsh2 = (float*)(ws + WS_RSH2);
    const int gw = F.vcu * NWAVES + F.wave, NGW = F.G * NWAVES;
    for (int tk = gw; tk < T_TOK; tk += NGW) {
        const int lane = lane_id(); const unsigned lane16 = (unsigned)lane * 16u; const int kq = (lane >> 2) & 15;
        Row4 a = load_row((const GAS unsigned char*)H1B, (unsigned)tk, lane16);
        const float rs = 1.0f / sqrtf(wave_sum64(psh1[(size_t)tk * 64 + lane]) * (1.f / 2048.f) + 1e-6f);
        float acc[4][8];
#pragma unroll
        for (int j = 0; j < 4; ++j) { const f32x4 x0 = *(const GAS f32x4*)(H1 + (size_t)tk * 2048 + 512 * j + 8 * lane), x1 = *(const GAS f32x4*)(H1 + (size_t)tk * 2048 + 512 * j + 8 * lane + 4);
            acc[j][0] = x0[0]; acc[j][1] = x0[1]; acc[j][2] = x0[2]; acc[j][3] = x0[3]; acc[j][4] = x1[0]; acc[j][5] = x1[1]; acc[j][6] = x1[2]; acc[j][7] = x1[3]; }
        for (int hd = 0; hd < 8; ++hd) {
            const int ev = IDX[(size_t)tk * 128 + hd * 16 + kq]; const float gv = GATE[(size_t)tk * 128 + hd * 16 + kq];
            float p[16];
            Row4 bA[2], bB[2];
#define LD2(buf, base, k0) do { _Pragma("unroll") for (int q = 0; q < 2; ++q) buf[q] = load_row(base, (unsigned)__builtin_amdgcn_readlane(ev, 4 * ((k0) + q)), lane16); } while (0)
#define DOT2(buf, k0) do { _Pragma("unroll") for (int q = 0; q < 2; ++q) { float s = 0.f; _Pragma("unroll") for (int j = 0; j < 4; ++j) s = dot8(a.c[j], buf[q].c[j], s); p[(k0) + q] = s; } } while (0)
            LD2(bA, UB, 0); LD2(bB, UB, 2); SBAR();
#pragma unroll
            for (int k0 = 0; k0 < 16; k0 += 4) { DOT2(bA, k0); SBAR(); if (k0 + 4 < 16) LD2(bA, UB, k0 + 4); else LD2(bA, VB, 0); SBAR(); DOT2(bB, k0 + 2); SBAR(); if (k0 + 6 < 16) LD2(bB, UB, k0 + 6); else LD2(bB, VB, 2); SBAR(); }
            { const bool b5 = lane & 32, b4 = lane & 16, b3 = lane & 8, b2 = lane & 4; float q8[8], q4[4], q2[2], q1;
#pragma unroll
              for (int i = 0; i < 8; ++i) { const float keep = b5 ? p[i + 8] : p[i], send = b5 ? p[i] : p[i + 8]; q8[i] = keep + __shfl_xor(send, 32); }
#pragma unroll
              for (int i = 0; i < 4; ++i) { const float keep = b4 ? q8[i + 4] : q8[i], send = b4 ? q8[i] : q8[i + 4]; q4[i] = keep + __shfl_xor(send, 16); }
#pragma unroll
              for (int i = 0; i < 2; ++i) { const float keep = b3 ? q4[i + 2] : q4[i], send = b3 ? q4[i] : q4[i + 2]; q2[i] = keep + __shfl_xor(send, 8); }
              { const float keep = b2 ? q2[1] : q2[0], send = b2 ? q2[0] : q2[1]; q1 = keep + __shfl_xor(send, 4); }
              q1 += __shfl_xor(q1, 2); q1 += __shfl_xor(q1, 1); p[0] = q1; }
            const float w = gv * gelu_f(p[0] * rs);
#define AX2(buf, k0) do { _Pragma("unroll") for (int q = 0; q < 2; ++q) { const float wk = __uint_as_float((unsigned)__builtin_amdgcn_readlane((int)__float_as_uint(w), 4 * ((k0) + q))); _Pragma("unroll") for (int j = 0; j < 4; ++j) axpy8(acc[j], buf[q].c[j], wk); } } while (0)
            SBAR();
#pragma unroll
            for (int k0 = 0; k0 < 16; k0 += 4) { AX2(bA, k0); SBAR(); if (k0 + 4 < 16) LD2(bA, VB, k0 + 4); SBAR(); AX2(bB, k0 + 2); SBAR(); if (k0 + 6 < 16) LD2(bB, VB, k0 + 6); SBAR(); }
#undef LD2
#undef DOT2
#undef AX2
        }
        float ss = 0.f;
#pragma unroll
        for (int j = 0; j < 4; ++j) { f32x4 y0 = {acc[j][0], acc[j][1], acc[j][2], acc[j][3]}, y1 = {acc[j][4], acc[j][5], acc[j][6], acc[j][7]}; ss += sq8(y0, y1);
            *(GAS f32x4*)(H1 + (size_t)tk * 2048 + 512 * j + 8 * lane) = y0; *(GAS f32x4*)(H1 + (size_t)tk * 2048 + 512 * j + 8 * lane + 4) = y1; *(GAS v4u*)(H1B + (size_t)tk * 2048 + 512 * j + 8 * lane) = pack8(y0, y1); }
        ss = wave_sum64(ss); if (lane == 0) rsh2[tk] = 1.0f / sqrtf(ss * (1.f / 2048.f) + 1e-6f);
    }
}
__device__ __forceinline__ void final_phase(const Args& A, Frame& F) {
    unsigned char* ws = A.ws; const float* psh3 = (const float*)(ws + WS_PSH3); const float* gf = (const float*)A.in[25]; float* out = A.out;
    const int gw = F.vcu * NWAVES + F.wave, NGW = F.G * NWAVES;
    for (int tk = gw; tk < T_TOK; tk += NGW) { const int lane = lane_id();
        const float rs = 1.0f / sqrtf(wave_sum64(psh3[(size_t)tk * 64 + lane]) * (1.f / 2048.f) + 1e-6f);
#pragma unroll
        for (int j = 0; j < 8; ++j) { GAS f32x4* o = (GAS f32x4*)(out + (size_t)tk * 2048 + 256 * j) + lane; const f32x4 g = *((const GAS f32x4*)(gf + 256 * j) + lane); *o = *o * rs * g; } }
}
#define PHASES_2_9 \
    if (IN(2)) { \
        { pg8::Gemm g{(const bf16*)(ws + WS_CQ), (const bf16*)(ws + WS_WT_UQ), T_TOK, 1536, 512}; pg8::StaticOrder S; S.init(T_TOK, 1536, F.G, (int)blockIdx.x); \
          LAS float* tab = (LAS float*)(F.lds + TAB_OFF); setup_rowtab(tab, (const float*)(ws + WS_PSCQ), 16, 1.f / 512.f, S, F.wave); __syncthreads(); \
          EpiQ E{tab, (bf16*)(ws + WS_Q), (const f32x2v*)(ws + WS_CS)}; pg8::gemm_phase<EpiQ, pg8::StaticOrder, true, true>(F.lds + RING_OFF, g, S, E, F.wave); } \
        __syncthreads(); \
        { pg8::Gemm g{(const bf16*)(ws + WS_CKV), (const bf16*)(ws + WS_WT_UKV), T_TOK, 2048, 256}; pg8::StaticOrder S; S.init(T_TOK, 2048, F.G, (int)blockIdx.x); \
          LAS float* tab = (LAS float*)(F.lds + TAB_OFF); setup_rowtab(tab, (const float*)(ws + WS_PSCKV), 8, 1.f / 256.f, S, F.wave); __syncthreads(); \
          EpiKV E{tab, (bf16*)(ws + WS_KN), (bf16*)(ws + WS_VV)}; pg8::gemm_phase<EpiKV, pg8::StaticOrder, true, true>(F.lds + RING_OFF, g, S, E, F.wave); } \
        __syncthreads(); \
        sgu_phase(args, F); \
        SEAM(2); } \
    if (IN(3)) { attn_phase(args, F); SEAM(3); } \
    if (IN(4)) { \
        { pg8::Gemm g{(const bf16*)(ws + WS_MIX), (const bf16*)(ws + WS_WT_OUT), T_TOK, 2048, 2048}; pg8::StaticOrder S; S.init(T_TOK, 2048, F.G, (int)blockIdx.x); \
          LAS float* tab = (LAS float*)(F.lds + TAB_OFF); setup_rowtab(tab, (const float*)(ws + WS_PSA), 8, 1.f / 1024.f, S, F.wave); setup_rowtab(tab + 256, (const float*)(ws + WS_PSS), 16, 1.f / 1024.f, S, F.wave); __syncthreads(); \
          EpiOut E{tab, (const float*)args.in[0], (float*)(ws + WS_H1), (bf16*)(ws + WS_H1B), (float*)(ws + WS_PSH1)}; pg8::gemm_phase<EpiOut, pg8::StaticOrder, true, true>(F.lds + RING_OFF, g, S, E, F.wave); } \
        SEAM(4); } \
    if (IN(5)) { \
        { pg8::Gemm g{(const bf16*)(ws + WS_H1B), (const bf16*)(ws + WS_WT_PQ), T_TOK, 2048, 2048}; pg8::StaticOrder S; S.init(T_TOK, 2048, F.G, (int)blockIdx.x); \
          LAS float* tab = (LAS float*)(F.lds + TAB_OFF); setup_rowtab(tab, (const float*)(ws + WS_PSH1), 64, 1.f / 2048.f, S, F.wave); __syncthreads(); \
          EpiPQ E{tab, (bf16*)(ws + WS_R1)}; pg8::gemm_phase<EpiPQ, pg8::StaticOrder, true, true>(F.lds + RING_OFF, g, S, E, F.wave); } \
        SEAM(5); } \
    PHASES_6_9
#define PHASES_6_9 \
    if (IN(6)) { topk_phase(args, F); SEAM(6); } \
    if (IN(7)) { gather_phase(args, F); SEAM(7); } \
    if (IN(8)) { \
        { pg8::Gemm g{(const bf16*)(ws + WS_H1B), (const bf16*)(ws + WS_WT_PG), T_TOK, 2048, 2048}; pg8::StaticOrder S; S.init(T_TOK, 2048, F.G, (int)blockIdx.x); \
          EpiPLE E{(const float*)(ws + WS_RSH2), (const float*)(ws + WS_H1), (const bf16*)(ws + WS_PPROJ), args.out, (float*)(ws + WS_PSH3)}; pg8::gemm_phase<EpiPLE, pg8::StaticOrder, true, true>(F.lds + RING_OFF, g, S, E, F.wave); } \
        SEAM(8); } \
    if (IN(9)) { final_phase(args, F); }
constexpr int N_PHASES = 10;
__global__ void __launch_bounds__(NWAVES * 64, 2) mega_fwd(Args args) {
    extern __shared__ __attribute__((aligned(16))) unsigned char lds[];
    Frame F;
    F.lds = (LAS unsigned char*)lds; F.MISC = (volatile LAS unsigned*)(F.lds + MISC_OFF);
    F.wave = __builtin_amdgcn_readfirstlane(threadIdx.x >> 6); F.lane = lane_id(); F.tid = F.wave * 64 + F.lane;
    F.G = gridDim.x; { const int bx = blockIdx.x; F.vcu = (F.G % 8 == 0) ? (bx % 8) * (F.G / 8) + bx / 8 : bx; }
    unsigned char* ws = args.ws; F.ctl = (gu32*)(ws + WS_CTL);
    for (int u = F.wave * 64 + lane_id(); u < (LDS_BYTES - LDSCTL_OFF) / 4; u += NWAVES * 64) ((LAS unsigned*)(F.lds + LDSCTL_OFF))[u] = 0u;
    __syncthreads();
    const int lo = args.ph_lo, hi = args.ph_hi;
    XcdBarrier bar; bar.bar = (unsigned*)(F.ctl + CW_BAR); bar.x = 0; bar.st = nullptr;
    if (hi - lo > 1) bar = xcd_barrier_post((unsigned*)(F.ctl + CW_BAR), F.MISC + 8, F.wave);
#define IN(k) (lo <= (k) && (k) < hi)
#define SEAM(k) do { if (IN(k) && IN((k) + 1)) xcd_barrier(bar, F.wave); } while (0)
    if (IN(0)) { p0_prologue(args, F); SEAM(0); }
    if (IN(1)) {
        { pg8::Gemm g{(const bf16*)(ws + WS_R1), (const bf16*)(ws + WS_WT_IN), T_TOK, 3072, 2048}; pg8::StaticOrder S; S.init(T_TOK, 3072, F.G, (int)blockIdx.x);
          EpiG1 E{(const float*)(ws + WS_RSX), (bf16*)(ws + WS_CQ), (bf16*)(ws + WS_CKV), (bf16*)(ws + WS_KR), (bf16*)(ws + WS_UG), (bf16*)(ws + WS_VG), (float*)(ws + WS_PSCQ), (float*)(ws + WS_PSCKV), (f32x2v*)(ws + WS_PSV), (const f32x2v*)(ws + WS_CS)};
          pg8::gemm_phase<EpiG1, pg8::StaticOrder, true, true>(F.lds + RING_OFF, g, S, E, F.wave); }
        { pg8::Gemm g{(const bf16*)(ws + WS_PB), (const bf16*)(ws + WS_WT_PP), T_TOK, 2048, 256}; pg8::StaticOrder S; S.init(T_TOK, 2048, F.G, (int)blockIdx.x);
          EpiPlain E{(bf16*)(ws + WS_PPROJ), 2048};
          pg8::gemm_phase<EpiPlain, pg8::StaticOrder, true, true>(F.lds + RING_OFF, g, S, E, F.wave); }
        SEAM(1);
    }
    PHASES_2_9
#undef IN
#undef SEAM
}

#if CUT > 0 && CUT < 9
__device__ __forceinline__ int rope_unpc(int pc) { const int c5 = pc >> 5, fq = (pc >> 3) & 3, nn = (pc >> 2) & 1, e = pc & 3; return 16 * c5 + 4 * fq + e + 32 * nn; }
__global__ void __launch_bounds__(256) conv1(const unsigned char* ws, int b, float* ZP) {
    const int r = blockIdx.x; const size_t row = (size_t)b * 2048 + r; float* z = ZP + (size_t)r * 2880;
    const bf16 *CQ = (const bf16*)(ws + WS_CQ) + row * 512, *CKV = (const bf16*)(ws + WS_CKV) + row * 256, *KR = (const bf16*)(ws + WS_KR) + row * 64, *UG = (const bf16*)(ws + WS_UG) + row * 1024, *VG = (const bf16*)(ws + WS_VG) + row * 1024;
    for (int i = threadIdx.x; i < 512; i += 256) z[i] = bf2f(CQ[i]);
    for (int i = threadIdx.x; i < 256; i += 256) z[512 + i] = bf2f(CKV[i]);
    if (threadIdx.x < 64) z[768 + rope_unpc(threadIdx.x)] = bf2f(KR[threadIdx.x]);
    for (int i = threadIdx.x; i < 1024; i += 256) { z[832 + i] = bf2f(UG[i]); z[1856 + i] = bf2f(VG[i]); }
}
__global__ void __launch_bounds__(256) conv2(const unsigned char* ws, int b, float* ZP, float* QN, float* KV, float* OSGU) {
    const int r = blockIdx.x; const size_t row = (size_t)b * 2048 + r;
    const bf16 *Q = (const bf16*)(ws + WS_Q) + row * 1536, *KN = (const bf16*)(ws + WS_KN) + row * 1024, *VV = (const bf16*)(ws + WS_VV) + row * 1024, *KR = (const bf16*)(ws + WS_KR) + row * 64, *MIX = (const bf16*)(ws + WS_MIX) + row * 2048;
    for (int i = threadIdx.x; i < 1536; i += 256) { const int h = i / 192, lc = i - h * 192; const int dst = lc < 128 ? i : h * 192 + 128 + rope_unpc(lc - 128); QN[(size_t)r * 1536 + dst] = bf2f(Q[i]) * (1.f / QK_C2); }
    for (int i = threadIdx.x; i < 1024; i += 256) { const int h = i >> 7, d = i & 127; KV[(size_t)r * 2048 + h * 256 + d] = bf2f(KN[i]); KV[(size_t)r * 2048 + h * 256 + 128 + d] = bf2f(VV[i]); OSGU[(size_t)r * 1024 + i] = bf2f(MIX[1024 + i]); }
    if (threadIdx.x < 64) ZP[(size_t)r * 2880 + 768 + rope_unpc(threadIdx.x)] = bf2f(KR[threadIdx.x]);
}
__global__ void __launch_bounds__(256) conv3(const unsigned char* ws, int b, float* OATT, float* OSGU) {
    const int r = blockIdx.x; const size_t row = (size_t)b * 2048 + r; const bf16* MIX = (const bf16*)(ws + WS_MIX) + row * 2048;
    for (int i = threadIdx.x; i < 1024; i += 256) { OATT[(size_t)r * 1024 + i] = bf2f(MIX[i]); OSGU[(size_t)r * 1024 + i] = bf2f(MIX[1024 + i]); }
}
__global__ void __launch_bounds__(256) conv5(const unsigned char* ws, int b, float* QPN) {
    const int r = blockIdx.x; const size_t row = (size_t)b * 2048 + r; const bf16* QP = (const bf16*)(ws + WS_R1) + row * 2048;
    for (int i = threadIdx.x; i < 2048; i += 256) QPN[(size_t)r * 2048 + i] = bf2f(QP[i]);
}
static void launch_conv(int b, void* const* d_in, void* d_ws, hipStream_t stream) {
    unsigned char* ws = (unsigned char*)d_ws; (void)d_in;
    if (CUT == 1) conv1<<<2048, 256, 0, stream>>>(ws, b, (float*)(ws + WS_NZP));
    if (CUT == 2) conv2<<<2048, 256, 0, stream>>>(ws, b, (float*)(ws + WS_NZP), (float*)(ws + WS_NQN), (float*)(ws + WS_NKV), (float*)(ws + WS_NOSGU));
    if (CUT == 3) conv3<<<2048, 256, 0, stream>>>(ws, b, (float*)(ws + WS_NOATT), (float*)(ws + WS_NOSGU));
    if (CUT == 5) conv5<<<2048, 256, 0, stream>>>(ws, b, (float*)(ws + WS_NQPN));
}
#endif
#if CUT > 0
static void launch_fast(void* const* d_in, void* d_out, void* d_ws, hipStream_t stream) {
    static int grid = 0;
    if (grid == 0) {
        int dev = 0, cus = 0, per_cu = 0;
        if (hipGetDevice(&dev) != hipSuccess || hipDeviceGetAttribute(&cus, hipDeviceAttributeMultiprocessorCount, dev) != hipSuccess) { fprintf(stderr, "launch_fast: device query failed\n"); grid = -1; return; }
        if (hipFuncSetAttribute((const void*)mega_fwd, hipFuncAttributeMaxDynamicSharedMemorySize, LDS_BYTES) != hipSuccess) { fprintf(stderr, "launch_fast: hipFuncSetAttribute failed\n"); grid = -1; return; }
        if (hipOccupancyMaxActiveBlocksPerMultiprocessor(&per_cu, (const void*)mega_fwd, NWAVES * 64, LDS_BYTES) != hipSuccess || per_cu < 1) fprintf(stderr, "launch_fast: occupancy query says %d blocks per CU\n", per_cu);
        (void)hipGetLastError();
        grid = cus;
        if (grid != 256) fprintf(stderr, "launch_fast: %d CUs (built for 256)\n", grid);
    }
    if (grid < 0) return;
    (void)hipMemsetAsync((char*)d_ws + WS_CTL, 0, CTL_ZERO_BYTES, stream);
    Args a{};
    for (int i = 0; i < 26; ++i) a.in[i] = d_in[i];
    a.out = (float*)d_out; a.ws = (unsigned char*)d_ws;
    constexpr int LAST = CUT + 1;
#if ONE_LAUNCH
    a.ph_lo = 0; a.ph_hi = LAST; hipLaunchKernelGGL(mega_fwd, dim3(grid), dim3(NWAVES * 64), LDS_BYTES, stream, a);
#else
    for (int ph = 0; ph < LAST; ++ph) { a.ph_lo = ph; a.ph_hi = ph + 1; hipLaunchKernelGGL(mega_fwd, dim3(grid), dim3(NWAVES * 64), LDS_BYTES, stream, a); }
#endif
    const hipError_t le = hipPeekAtLastError(); if (le != hipSuccess) fprintf(stderr, "launch_fast: launch failed: %s\n", hipGetErrorName(le));
}
#endif
#if CUT > 0
static void launch_fast(void* const* d_in, void* d_out, void* d_ws, hipStream_t stream);
static void launch_conv(int b, void* const* d_in, void* d_ws, hipStream_t stream);
#endif
extern "C" void kernel_launch(void* const* d_in, const int* in_sizes, int n_in, void* d_out, int out_size, void* d_ws, size_t ws_size, hipStream_t stream) {
    if (n_in != 26 || out_size != T_TOK * DM || ws_size < WS_END) { fprintf(stderr, "kernel_launch: unexpected shapes n_in %d out %d ws %zu\n", n_in, out_size, ws_size); return; }
    unsigned char* ws = (unsigned char*)d_ws;
    const float* x = (const float*)d_in[0]; const float* p = (const float*)d_in[1]; const int* pos = (const int*)d_in[2];
    const float *g_mix = (const float*)d_in[3], *w_in = (const float*)d_in[4], *g_cq = (const float*)d_in[5], *w_uq = (const float*)d_in[6], *g_ckv = (const float*)d_in[7], *w_ukv = (const float*)d_in[8];
    const float *g_ln = (const float*)d_in[9], *b_ln = (const float*)d_in[10], *w_sgu = (const float*)d_in[11], *b_sgu = (const float*)d_in[12], *g_oa = (const float*)d_in[13], *g_os = (const float*)d_in[14];
    const float *w_out = (const float*)d_in[15], *g_ffn = (const float*)d_in[16], *w_pq = (const float*)d_in[17], *k1 = (const float*)d_in[18], *k2 = (const float*)d_in[19], *pu = (const float*)d_in[20], *pv = (const float*)d_in[21];
    const float *g_ple = (const float*)d_in[22], *w_pg = (const float*)d_in[23], *w_pp = (const float*)d_in[24], *g_fin = (const float*)d_in[25];
    float* out = (float*)d_out;
#if CUT > 0
    launch_fast(d_in, d_out, d_ws, stream);
#endif
#if CUT < 9
    constexpr int S0 = CUT + 1; constexpr int TB = nv::TBAT;
    float* A0 = (float*)(ws + WS_NA0); float* GL = (float*)(ws + WS_NGL); float* PP = (float*)(ws + WS_NPP);
    float* ZP = (float*)(ws + WS_NZP); float* CQN = (float*)(ws + WS_NCQN); float* CKVN = (float*)(ws + WS_NCKVN); float* QN = (float*)(ws + WS_NQN); float* KV = (float*)(ws + WS_NKV);
    float* VLN = (float*)(ws + WS_NVLN); float* OSGU = (float*)(ws + WS_NOSGU); float* OATT = (float*)(ws + WS_NOATT); float* QPN = (float*)(ws + WS_NQPN);
    for (int b = 0; b < NBATCH; ++b) {
        const size_t t0 = (size_t)b * TB; const float* xb = x + t0 * DM; const int* posb = pos + t0; const float* pb = p + t0 * 256;
        float* H1 = (float*)(ws + WS_H1) + t0 * DM; int* IDX = (int*)(ws + WS_IDX) + t0 * 128; float* GATE = (float*)(ws + WS_GATE) + t0 * 128; float* outb = out + t0 * DM;
#if CUT > 0
        launch_conv(b, d_in, d_ws, stream);
#endif
        if (S0 <= 1) {
            nv::nk_rmsnorm<<<TB, 256, 0, stream>>>(xb, DM, g_mix, A0, DM, DM);
            nv::nk_gemm<<<dim3(2880 / 64, TB / 64), 256, 0, stream>>>(A0, DM, w_in, 2880, ZP, 2880, nullptr, 0, DM);
            nv::nk_z_post<<<TB, 256, 0, stream>>>(ZP, posb);
        }
        if (S0 <= 2) {
            nv::nk_rmsnorm<<<TB, 256, 0, stream>>>(ZP, 2880, g_cq, CQN, 512, 512);
            nv::nk_gemm<<<dim3(1536 / 64, TB / 64), 256, 0, stream>>>(CQN, 512, w_uq, 1536, QN, 1536, nullptr, 0, 512);
            nv::nk_q_rope<<<TB, 256, 0, stream>>>(QN, posb);
            nv::nk_rmsnorm<<<TB, 256, 0, stream>>>(ZP + 512, 2880, g_ckv, CKVN, 256, 256);
            nv::nk_gemm<<<dim3(2048 / 64, TB / 64), 256, 0, stream>>>(CKVN, 256, w_ukv, 2048, KV, 2048, nullptr, 0, 256);
            nv::nk_ln_group<<<TB * 8 / 4, 256, 0, stream>>>(ZP, g_ln, b_ln, VLN);
            nv::nk_sgu<<<TB * 1024 / 256, 256, 0, stream>>>(ZP, VLN, w_sgu, b_sgu, OSGU);
        }
        if (S0 <= 3) nv::nk_attn<<<dim3(TB, 8), 256, 0, stream>>>(QN, KV, ZP, OATT);
        if (S0 <= 4) {
            nv::nk_rmsnorm<<<TB, 256, 0, stream>>>(OATT, 1024, g_oa, A0, DM, 1024);
            nv::nk_rmsnorm<<<TB, 256, 0, stream>>>(OSGU, 1024, g_os, A0 + 1024, DM, 1024);
            nv::nk_gemm<<<dim3(DM / 64, TB / 64), 256, 0, stream>>>(A0, DM, w_out, DM, H1, DM, xb, DM, DM);
        }
        if (S0 <= 5) {
            nv::nk_rmsnorm<<<TB, 256, 0, stream>>>(H1, DM, g_ffn, A0, DM, DM);
            nv::nk_gemm<<<dim3(DM / 64, TB / 64), 256, 0, stream>>>(A0, DM, w_pq, DM, QPN, DM, nullptr, 0, DM);
        }
        if (S0 <= 6) nv::nk_topk<<<TB * 8, 128, 0, stream>>>(QPN, k1, k2, IDX, GATE);
        if (S0 <= 7) {
            nv::nk_rmsnorm<<<TB, 256, 0, stream>>>(H1, DM, g_ffn, A0, DM, DM);
            nv::nk_gather<<<TB, 256, 0, stream>>>(H1, A0, IDX, GATE, pu, pv);
        }
        if (S0 <= 8) {
            nv::nk_rmsnorm<<<TB, 256, 0, stream>>>(H1, DM, g_ple, A0, DM, DM);
            nv::nk_gemm<<<dim3(DM / 64, TB / 64), 256, 0, stream>>>(A0, DM, w_pg, DM, GL, DM, nullptr, 0, DM);
            nv::nk_gemm<<<dim3(DM / 64, TB / 64), 256, 0, stream>>>(pb, 256, w_pp, DM, PP, DM, nullptr, 0, 256);
            nv::nk_ple<<<TB * DM / 256, 256, 0, stream>>>(H1, GL, PP, outb);
        }
        nv::nk_rmsnorm<<<TB, 256, 0, stream>>>(outb, DM, g_fin, outb, DM, DM);
    }
#endif
}
```

```cpp
#include <hip/hip_runtime.h>
#include <hip/hip_bf16.h>
#include <cstdio>
#include <cstdint>
#include <cmath>
#ifndef CUT
#define CUT 9
#endif
#ifndef ONE_LAUNCH
#define ONE_LAUNCH 1
#endif
#ifndef REPEAT_PH
#define REPEAT_PH -1
#endif
constexpr int T_TOK = 8192, DM = 2048, SEQ = 2048, NBATCH = 4;
constexpr size_t MiB = 1u << 20;
constexpr size_t WS_CTL = 0;
constexpr size_t WS_WT_IN = 1 * MiB, WS_WT_UQ = 13 * MiB, WS_WT_UKV = 14 * MiB + 512 * 1024, WS_WT_PP = 15 * MiB + 512 * 1024;
constexpr size_t WS_K1B = 16 * MiB + 512 * 1024, WS_K2B = WS_K1B + 256 * 1024, WS_WSGU = 17 * MiB;
constexpr size_t WS_WT_OUT = 18 * MiB, WS_WT_PQ = 26 * MiB, WS_WT_PG = 34 * MiB;
constexpr size_t WS_UB = 42 * MiB, WS_VB = 106 * MiB;
constexpr size_t WS_R1 = 170 * MiB;
constexpr size_t WS_PB = 202 * MiB, WS_CS = 206 * MiB, WS_RSX = 208 * MiB, WS_RSH2 = 208 * MiB + 512 * 1024;
constexpr size_t WS_CQ = 209 * MiB, WS_CKV = 217 * MiB, WS_KR = 221 * MiB, WS_UG = 222 * MiB, WS_VG = 238 * MiB;
constexpr size_t WS_PSCQ = 254 * MiB, WS_PSCKV = 254 * MiB + 512 * 1024, WS_PSV = 255 * MiB;
constexpr size_t WS_Q = 257 * MiB, WS_KN = 281 * MiB, WS_VV = 297 * MiB, WS_H1B = 257 * MiB;
constexpr size_t WS_MIX = 313 * MiB, WS_PSA = 345 * MiB, WS_PSS = 345 * MiB + 512 * 1024;
constexpr size_t WS_H1 = 346 * MiB, WS_PSH1 = 410 * MiB, WS_IDX = 412 * MiB, WS_GATE = 416 * MiB, WS_PPROJ = 420 * MiB, WS_PSH3 = 452 * MiB;
constexpr size_t WS_NA0 = 454 * MiB, WS_NGL = 470 * MiB, WS_NPP = 486 * MiB, WS_END = 502 * MiB;
constexpr size_t WS_NZP = 42 * MiB, WS_NCQN = 65 * MiB, WS_NCKVN = 69 * MiB, WS_NQN = 71 * MiB, WS_NKV = 83 * MiB, WS_NVLN = 99 * MiB, WS_NOSGU = 107 * MiB, WS_NOATT = 115 * MiB, WS_NQPN = 123 * MiB;
namespace nv {
constexpr int TBAT = 2048;
__device__ __forceinline__ float gelu_t(float x) { const float c = 0.7978845608028654f; const float u = c * (x + 0.044715f * x * x * x); return 0.5f * x * (1.f + tanhf(u)); }
__device__ __forceinline__ float wave_sum(float v) {
#pragma unroll
    for (int o = 1; o < 64; o <<= 1) v += __shfl_xor(v, o);
    return v;
}
__device__ __forceinline__ float wave_max(float v) {
#pragma unroll
    for (int o = 1; o < 64; o <<= 1) v = fmaxf(v, __shfl_xor(v, o));
    return v;
}
__device__ __forceinline__ float blk_sum(float v, float* sh) {
    v = wave_sum(v); __syncthreads();
    if ((threadIdx.x & 63) == 0) sh[threadIdx.x >> 6] = v; __syncthreads();
    float r = 0.f; for (int i = 0; i < (int)(blockDim.x >> 6); ++i) r += sh[i]; return r;
}
__device__ __forceinline__ float blk_max(float v, float* sh) {
    v = wave_max(v); __syncthreads();
    if ((threadIdx.x & 63) == 0) sh[threadIdx.x >> 6] = v; __syncthreads();
    float r = sh[0]; for (int i = 1; i < (int)(blockDim.x >> 6); ++i) r = fmaxf(r, sh[i]); return r;
}
__global__ void __launch_bounds__(256) nk_rmsnorm(const float* x, size_t ldx, const float* g, float* out, size_t ldo, int D) {
    __shared__ float sh[8];
    const float* xr = x + (size_t)blockIdx.x * ldx; float* orow = out + (size_t)blockIdx.x * ldo;
    float s = 0.f; for (int i = threadIdx.x; i < D; i += 256) { const float v = xr[i]; s += v * v; }
    s = blk_sum(s, sh); const float r = rsqrtf(s / (float)D + 1e-6f);
    for (int i = threadIdx.x; i < D; i += 256) orow[i] = xr[i] * r * g[i];
}
__global__ void __launch_bounds__(256) nk_gemm(const float* A, size_t lda, const float* B, size_t ldb, float* C, size_t ldc, const float* R, size_t ldr, int K) {
    __shared__ float As[16][68], Bs[16][68];
    const int tid = threadIdx.x, tx = tid & 15, ty = tid >> 4, m0 = blockIdx.y * 64, n0 = blockIdx.x * 64;
    float acc[4][4] = {};
    for (int k0 = 0; k0 < K; k0 += 16) {
        { const int r = tid >> 2, c = (tid & 3) * 4; const float4 v = *(const float4*)(A + (size_t)(m0 + r) * lda + k0 + c); As[c][r] = v.x; As[c + 1][r] = v.y; As[c + 2][r] = v.z; As[c + 3][r] = v.w; }
        { const int r = tid >> 4, c = (tid & 15) * 4; const float4 v = *(const float4*)(B + (size_t)(k0 + r) * ldb + n0 + c); Bs[r][c] = v.x; Bs[r][c + 1] = v.y; Bs[r][c + 2] = v.z; Bs[r][c + 3] = v.w; }
        __syncthreads();
#pragma unroll
        for (int k = 0; k < 16; ++k) { float a[4], b[4];
#pragma unroll
            for (int i = 0; i < 4; ++i) { a[i] = As[k][ty * 4 + i]; b[i] = Bs[k][tx * 4 + i]; }
#pragma unroll
            for (int i = 0; i < 4; ++i)
#pragma unroll
                for (int j = 0; j < 4; ++j) acc[i][j] += a[i] * b[j]; }
        __syncthreads();
    }
#pragma unroll
    for (int i = 0; i < 4; ++i)
#pragma unroll
        for (int j = 0; j < 4; ++j) { const size_t r = m0 + ty * 4 + i, c = n0 + tx * 4 + j; C[r * ldc + c] = acc[i][j] + (R ? R[r * ldr + c] : 0.f); }
}
__device__ __forceinline__ void rope_cs(int pos, int i, float& c, float& s) { const double f = pow(10000.0, -(double)i / 32.0); const double a = (double)pos * f; c = (float)cos(a); s = (float)sin(a); }
__global__ void __launch_bounds__(256) nk_z_post(float* Z, const int* pos) {
    float* z = Z + (size_t)blockIdx.x * 2880; const int t = threadIdx.x;
    if (t < 32) { float c, s; rope_cs(pos[blockIdx.x], t, c, s); const float x1 = z[768 + t], x2 = z[800 + t]; z[768 + t] = x1 * c - x2 * s; z[800 + t] = x2 * c + x1 * s; }
    for (int i = 832 + t; i < 2880; i += 256) z[i] = gelu_t(z[i]);
}
__global__ void __launch_bounds__(256) nk_q_rope(float* Q, const int* pos) {
    float* q = Q + (size_t)blockIdx.x * 1536; const int h = threadIdx.x >> 5, i = threadIdx.x & 31;
    float c, s; rope_cs(pos[blockIdx.x], i, c, s); float* p = q + h * 192 + 128; const float x1 = p[i], x2 = p[32 + i]; p[i] = x1 * c - x2 * s; p[32 + i] = x2 * c + x1 * s;
}
__global__ void __launch_bounds__(256) nk_ln_group(const float* Z, const float* gln, const float* bln, float* VLN) {
    const int wv = blockIdx.x * 4 + (threadIdx.x >> 6), lane = threadIdx.x & 63, row = wv >> 3, g = wv & 7;
    const float* v = Z + (size_t)row * 2880 + 1856 + g * 128; const float a = v[lane], b = v[lane + 64];
    const float mu = wave_sum(a + b) * (1.f / 128.f); const float da = a - mu, db = b - mu; const float var = wave_sum(da * da + db * db) * (1.f / 128.f); const float r = rsqrtf(var + 1e-6f);
    float* o = VLN + (size_t)row * 1024 + g * 128; o[lane] = da * r * gln[g * 128 + lane] + bln[g * 128 + lane]; o[lane + 64] = db * r * gln[g * 128 + lane + 64] + bln[g * 128 + lane + 64];
}
__global__ void __launch_bounds__(256) nk_sgu(const float* Z, const float* VLN, const float* ws, const float* bs, float* OS) {
    const size_t idx = (size_t)blockIdx.x * 256 + threadIdx.x; const int row = (int)(idx >> 10), col = (int)(idx & 1023), g = col >> 7, t = row & 127, r0 = row - t;
    const float* w = ws + ((size_t)g * 128 + t) * 128; float acc = 0.f;
    for (int s = 0; s <= t; ++s) acc += w[s] * VLN[(size_t)(r0 + s) * 1024 + col];
    OS[idx] = Z[(size_t)row * 2880 + 832 + col] * (acc + bs[g * 128 + t]);
}
__global__ void __launch_bounds__(256) nk_attn(const float* Q, const float* KV, const float* Z, float* O) {
    __shared__ float qs[192], sc[2048], sh[8], part[128];
    const int i = blockIdx.x, h = blockIdx.y, tid = threadIdx.x, lane = tid & 63, wv = tid >> 6;
    if (tid < 192) qs[tid] = Q[(size_t)i * 1536 + h * 192 + tid]; __syncthreads();
    const float scale = 0.07216878364870323f;
    for (int j = wv; j <= i; j += 4) { const float* kn = KV + (size_t)j * 2048 + h * 256; const float* kr = Z + (size_t)j * 2880 + 768;
        float p = qs[lane] * kn[lane] + qs[64 + lane] * kn[64 + lane] + qs[128 + lane] * kr[lane]; p = wave_sum(p); if (lane == 0) sc[j] = p * scale; }
    __syncthreads();
    float m = -INFINITY; for (int j = tid; j <= i; j += 256) m = fmaxf(m, sc[j]); m = blk_max(m, sh);
    float l = 0.f; for (int j = tid; j <= i; j += 256) { const float e = expf(sc[j] - m); sc[j] = e; l += e; } l = blk_sum(l, sh);
    const int d = tid & 127, half = tid >> 7; float acc = 0.f;
    for (int j = half; j <= i; j += 2) acc += sc[j] * KV[(size_t)j * 2048 + h * 256 + 128 + d];
    if (half) part[d] = acc; __syncthreads();
    if (!half) O[(size_t)i * 1024 + h * 128 + d] = (acc + part[d]) / l;
}
__global__ void __launch_bounds__(128) nk_topk(const float* QP, const float* k1, const float* k2, int* IDX, float* GATE) {
    __shared__ float q[256], s1[128], s2[128], cand[256], t1[16], t2[16]; __shared__ int i1[16], i2[16];
    const int row = blockIdx.x >> 3, h = blockIdx.x & 7, n = threadIdx.x;
    q[n] = QP[(size_t)row * 2048 + h * 256 + n]; q[n + 128] = QP[(size_t)row * 2048 + h * 256 + 128 + n]; __syncthreads();
    { const float* a = k1 + ((size_t)h * 128 + n) * 128; const float* b = k2 + ((size_t)h * 128 + n) * 128; float x = 0.f, y = 0.f;
      for (int d = 0; d < 128; ++d) { x += q[d] * a[d]; y += q[128 + d] * b[d]; } s1[n] = x; s2[n] = y; }
    __syncthreads();
    if (n == 0 || n == 64) { float* s = n ? s2 : s1; float* tv = n ? t2 : t1; int* ti = n ? i2 : i1;
        for (int r = 0; r < 16; ++r) { float best = -INFINITY; int bi = 0; for (int j = 0; j < 128; ++j) if (s[j] > best) { best = s[j]; bi = j; } tv[r] = best; ti[r] = bi; s[bi] = -INFINITY; } }
    __syncthreads();
    cand[n] = t1[n >> 4] + t2[n & 15]; cand[n + 128] = t1[(n + 128) >> 4] + t2[n & 15]; __syncthreads();
    if (n == 0) { float tv[16]; int te[16];
        for (int r = 0; r < 16; ++r) { float best = -INFINITY; int bi = 0; for (int j = 0; j < 256; ++j) if (cand[j] > best) { best = cand[j]; bi = j; } tv[r] = best; te[r] = i1[bi >> 4] * 128 + i2[bi & 15]; cand[bi] = -INFINITY; }
        float l = 0.f, e[16]; for (int r = 0; r < 16; ++r) { e[r] = expf(tv[r] - tv[0]); l += e[r]; }
        for (int r = 0; r < 16; ++r) { IDX[(size_t)row * 128 + h * 16 + r] = te[r]; GATE[(size_t)row * 128 + h * 16 + r] = e[r] / l; } }
}
__global__ void __launch_bounds__(256) nk_gather(float* H, const float* A2, const int* IDX, const float* GATE, const float* U, const float* V) {
    __shared__ float a[2048], red[4][2048];
    const int row = blockIdx.x, tid = threadIdx.x, lane = tid & 63, wv = tid >> 6;
    for (int i = tid; i < 2048; i += 256) a[i] = A2[(size_t)row * 2048 + i]; __syncthreads();
    float acc[32];
#pragma unroll
    for (int i = 0; i < 32; ++i) acc[i] = 0.f;
    for (int k = 0; k < 32; ++k) { const int j = wv * 32 + k; const int e = IDX[(size_t)row * 128 + j]; const float gt = GATE[(size_t)row * 128 + j];
        const float* u = U + (size_t)e * 2048; const float* v = V + (size_t)e * 2048; float p = 0.f;
#pragma unroll
        for (int i = 0; i < 32; ++i) p += u[lane + 64 * i] * a[lane + 64 * i];
        p = wave_sum(p); const float w = gt * gelu_t(p);
#pragma unroll
        for (int i = 0; i < 32; ++i) acc[i] += w * v[lane + 64 * i]; }
#pragma unroll
    for (int i = 0; i < 32; ++i) red[wv][lane + 64 * i] = acc[i];
    __syncthreads();
    for (int i = tid; i < 2048; i += 256) H[(size_t)row * 2048 + i] += red[0][i] + red[1][i] + red[2][i] + red[3][i];
}
__global__ void __launch_bounds__(256) nk_ple(const float* H2, const float* GL, const float* PP, float* out) {
    const size_t i = (size_t)blockIdx.x * 256 + threadIdx.x; out[i] = H2[i] + PP[i] / (1.f + expf(-GL[i]));
}
}
#define GAS __attribute__((address_space(1)))
#define LAS __attribute__((address_space(3)))
typedef unsigned short bf16;
typedef unsigned v4u __attribute__((ext_vector_type(4)));
typedef float f32x4 __attribute__((ext_vector_type(4)));
typedef short bf16x8 __attribute__((ext_vector_type(8)));
typedef GAS unsigned gu32;
typedef GAS unsigned long long gu64;
#define RLX_AGENT __ATOMIC_RELAXED, __HIP_MEMORY_SCOPE_AGENT
#define LDS_WAIT() asm volatile("s_waitcnt lgkmcnt(0)" ::: "memory")
#define VM_WAIT() asm volatile("s_waitcnt vmcnt(0)" ::: "memory")
__device__ __forceinline__ unsigned long long rt() { return __builtin_amdgcn_s_memrealtime(); }
__device__ __forceinline__ unsigned f2bf(float f) { unsigned u = __builtin_bit_cast(unsigned, f); return (u + 0x7fffu + ((u >> 16) & 1u)) >> 16; }
__device__ __forceinline__ unsigned pk2(float lo, float hi) { return f2bf(lo) | (f2bf(hi) << 16); }
#define XB_TMO      128
#define XB_XCNT(j)  (256  + 64 * (j))
#define XB_XSUB(j)  (1280 + 64 * (j))
#define XB_XGEN(j)  (2304 + 64 * (j))
#define XB_TOP      3328
#define XB_TOPGEN   3392
#define XCD_BAR_WORDS 3456
#define XB_SPIN_CAP (1u << 18)

__device__ __forceinline__ unsigned xb_ld(unsigned* p)              { return __hip_atomic_load(p, __ATOMIC_RELAXED, __HIP_MEMORY_SCOPE_AGENT); }
__device__ __forceinline__ unsigned xb_add(unsigned* p, unsigned v) { return __hip_atomic_fetch_add(p, v, __ATOMIC_RELAXED, __HIP_MEMORY_SCOPE_AGENT); }
__device__ __forceinline__ unsigned xb_xcc_id() { return (unsigned)__builtin_amdgcn_s_getreg((3 << 11) | 20) & 0xFu; }
#define XB_SPIN(cond, bar) do { unsigned _sp = 0; while (cond) { __builtin_amdgcn_s_sleep(1); \
    if ((++_sp & 255u) == 0u) { if (xb_ld(&(bar)[XB_TMO])) break; if (_sp > XB_SPIN_CAP) { atomicAdd(&(bar)[XB_TMO], 1u); break; } } } } while (0)

struct XcdBarrier {
    unsigned* bar; unsigned x;
    volatile LAS unsigned* st;
};

__device__ __forceinline__ int lane_id() { int r; asm volatile("v_mbcnt_lo_u32_b32 %0, -1, 0\n\tv_mbcnt_hi_u32_b32 %0, -1, %0" : "=v"(r)); return r; }
__device__ __forceinline__ XcdBarrier xcd_barrier_post(unsigned* bar, volatile LAS unsigned* st, int wid) {
    XcdBarrier b; b.bar = bar; b.x = xb_xcc_id(); b.st = st;
    if (wid == 0 && lane_id() == 0) (void)xb_add(&bar[XB_XCNT(b.x)], 1u);
    return b;
}
__device__ __forceinline__ void xcd_barrier_complete(unsigned* bar, unsigned x, unsigned& nloc, unsigned& nx) {
    const unsigned G = gridDim.x * gridDim.y * gridDim.z;
    unsigned sum, cnt, mine, sp = 0u;
    for (;;) {
        sum = 0u; cnt = 0u; mine = 0u;
#pragma unroll
        for (unsigned j = 0; j < 16; ++j) { const unsigned c = xb_ld(&bar[XB_XCNT(j)]); sum += c; cnt += (c > 0u) ? 1u : 0u; mine = (j == x) ? c : mine; }
        if (sum == G) break;
        __builtin_amdgcn_s_sleep(1);
        if ((++sp & 255u) == 0u) { if (xb_ld(&bar[XB_TMO])) break; if (sp > XB_SPIN_CAP) { atomicAdd(&bar[XB_TMO], 1u); break; } }
    }
    nloc = mine > 0u ? mine : 1u; nx = cnt > 0u ? cnt : 1u;
}

__device__ __forceinline__ void xcd_barrier(const XcdBarrier& b, int wid) {
    asm volatile("s_waitcnt vmcnt(0)" ::: "memory");
    __syncthreads();
    if (wid == 0 && lane_id() == 0) {
        unsigned* bar = b.bar;
        __builtin_amdgcn_s_waitcnt(0);
        unsigned nloc = b.st[0], nx = b.st[1];
        if (nloc == 0u) { xcd_barrier_complete(bar, b.x, nloc, nx); b.st[0] = nloc; b.st[1] = nx; }
        const unsigned old = xb_add(&bar[XB_XSUB(b.x)], 1u);
        const unsigned gen = old / nloc;
        if (old + 1u == (gen + 1u) * nloc) {
            __builtin_amdgcn_fence(__ATOMIC_RELEASE, "agent");
            asm volatile("s_waitcnt vmcnt(0)" ::: "memory");
            const unsigned og = xb_add(&bar[XB_TOP], 1u);
            const unsigned tg = og / nx;
            if (og + 1u == (tg + 1u) * nx) xb_add(&bar[XB_TOPGEN], 1u);
            else XB_SPIN(xb_ld(&bar[XB_TOPGEN]) == tg, bar);
            __builtin_amdgcn_fence(__ATOMIC_ACQUIRE, "agent");
            xb_add(&bar[XB_XGEN(b.x)], 1u);
            asm volatile("s_waitcnt vmcnt(0)" ::: "memory");
        } else {
            XB_SPIN(xb_ld(&bar[XB_XGEN(b.x)]) == gen, bar);
            __builtin_amdgcn_fence(__ATOMIC_ACQUIRE, "agent");
            asm volatile("s_waitcnt vmcnt(0)" ::: "memory");
        }
    }
    __syncthreads();
}
namespace pg8 {
#define PG8_LAS __attribute__((address_space(3)))
typedef unsigned short bf16_t;
typedef short bf16x8 __attribute__((ext_vector_type(8)));
typedef float f32x4 __attribute__((ext_vector_type(4)));
typedef unsigned u32x4 __attribute__((ext_vector_type(4)));
constexpr int BM = 256, BK = 64, HALF = 128, HTB = HALF * BK * 2  , STAGE_BYTES = 8 * HTB, NXCD = 8, WGM = 8;

__host__ __device__ __forceinline__ int lds_byte(int r, int c) { const int st = (r >> 4) * 2 + (c >> 5), rr = r & 15, cc = c & 31, ob = rr * 64 + cc * 2; return st * 1024 + (ob ^ (((ob >> 9) & 1) << 5)); }
__host__ __device__ __forceinline__ void stage_rc(int b, int& R, int& C) { const int st = b / 1024, sb = b % 1024, swz = sb ^ (((sb >> 9) & 1) << 5); R = (st >> 1) * 16 + swz / 64; C = (st & 1) * 32 + (swz % 64) / 2; }
__host__ __device__ __forceinline__ int perm32(int rho) { const int n = rho >> 4, i = rho & 15; return 8 * (i >> 2) + 4 * n + (i & 3); }

struct Unit { int pm, pn; };
struct Gemm { const bf16_t* A; const bf16_t* Bt; int M, N, K; };

struct StaticOrder {
    int nM, nN, nwg, G, c;
    __host__ __device__ void init(int M, int N, int G_, int c_) { nM = M / BM; nN = N / BM; nwg = nM * nN; G = G_; c = c_; }
    __host__ __device__ bool next(int i, Unit& u) const {
        const long L = (long)i * G + c; if (L >= nwg) return false;
        int wgid = (int)L; { const int q = nwg / NXCD, r = nwg % NXCD, xcd = wgid % NXCD, off = wgid / NXCD; wgid = (xcd < r ? xcd * (q + 1) : r * (q + 1) + (xcd - r) * q) + off; }
        const int nig = WGM * nN, gid = wgid / nig, fm = gid * WGM, gsz = (nM - fm) < WGM ? (nM - fm) : WGM;
        u.pm = fm + ((wgid % nig) % gsz); u.pn = (wgid % nig) / gsz; return true;
    }
    __device__ __forceinline__ void a_ready(const Unit&) const {}
    __device__ __forceinline__ void done(const Unit&) const {}
};

__device__ __forceinline__ unsigned cvt_pk_bf16(float lo, float hi) { unsigned r; asm volatile("v_cvt_pk_bf16_f32 %0, %1, %2" : "=v"(r) : "v"(lo), "v"(hi)); return r; }
typedef float f32x2 __attribute__((ext_vector_type(2)));
template <class Epi, class Sched, bool ALIGN_EPI = false, bool SP2 = false>
__device__ __forceinline__ void gemm_phase(PG8_LAS unsigned char* lds, const Gemm g, const Sched& S, const Epi& E, const int wid) {
    const int lane = ::lane_id(), tid = wid * 64 + lane, wr = wid >> 2, wc = wid & 3, fr = lane & 15, fq = lane >> 4;
    const int K = g.K, nt = K / BK;
    unsigned voffA[2], voffB[2];
#pragma unroll
    for (int i = 0; i < 2; ++i) { int R, C; stage_rc(tid * 16 + i * 8192, R, C); const int Rb = Epi::PERM ? ((R & ~31) + perm32(R & 31)) : R;
        voffA[i] = (unsigned)(R * K + C) * 2u; voffB[i] = (unsigned)(Rb * K + C) * 2u; }
    const size_t kstep = (size_t)(BK * 2);
    const size_t hstep = (size_t)HALF * K * 2;
    const size_t tstep = 2 * hstep;
    const unsigned ldsw = (unsigned)wid * 1024u;
    const int aoff = lds_byte(wr * 64 + fr, fq * 8), boff = lds_byte(wc * 32 + fr, fq * 8);
#define PG8_SA(b, h) (((b) * 2 + (h)) * HTB)
#define PG8_SB(b, h) ((4 + (b) * 2 + (h)) * HTB)
#define PG8_STAGE(bufoff, gbase, voff) do { _Pragma("unroll") for (int _i = 0; _i < 2; ++_i) \
        __builtin_amdgcn_global_load_lds((const unsigned*)((const char*)(gbase) + (voff)[_i]), (PG8_LAS unsigned*)(lds + (bufoff) + ldsw + _i * 8192), 16, 0, 0); } while (0)
#define PG8_LDA(dst, b, h) do { _Pragma("unroll") for (int m = 0; m < 4; ++m) _Pragma("unroll") for (int k = 0; k < 2; ++k) dst[m][k] = *(const PG8_LAS bf16x8*)(lds + PG8_SA(b, h) + aoff + m * 2048 + k * 1024); } while (0)
#define PG8_LDB(dst, b, h) do { _Pragma("unroll") for (int n = 0; n < 2; ++n) _Pragma("unroll") for (int k = 0; k < 2; ++k) dst[n][k] = *(const PG8_LAS bf16x8*)(lds + PG8_SB(b, h) + boff + n * 2048 + k * 1024); } while (0)
#define PG8_MMA(ai, bj, At, Bt) do { __builtin_amdgcn_s_setprio(1); _Pragma("unroll") for (int m = 0; m < 4; ++m) _Pragma("unroll") for (int n = 0; n < 2; ++n) _Pragma("unroll") for (int k = 0; k < 2; ++k) \
        acc[ai][bj][m][n] = __builtin_amdgcn_mfma_f32_16x16x32_bf16(Bt[n][k], At[m][k], acc[ai][bj][m][n], 0, 0, 0); __builtin_amdgcn_s_setprio(0); } while (0)
#define PG8_WAIT_V(n) asm volatile("s_waitcnt vmcnt(" #n ")" ::: "memory")
#define PG8_WAIT_L(n) asm volatile("s_waitcnt lgkmcnt(" #n ")" ::: "memory")
#define PG8_BAR __builtin_amdgcn_s_barrier()
#define PG8_SCHED __builtin_amdgcn_sched_barrier(0)
    Unit cur, nxt; int ui = 0;
    if (!S.next(0, cur)) return;
    f32x4 acc[2][2][4][2];
#pragma unroll
    for (int a = 0; a < 2; ++a)
#pragma unroll
        for (int b = 0; b < 2; ++b)
#pragma unroll
            for (int m = 0; m < 4; ++m)
#pragma unroll
                for (int n = 0; n < 2; ++n) acc[a][b][m][n] = (f32x4){0.f, 0.f, 0.f, 0.f};
    bf16x8 At[4][2], B0[2][2], B1[2][2];
    const char* cA = (const char*)g.A + (size_t)cur.pm * tstep; const char* cB = (const char*)g.Bt + (size_t)cur.pn * tstep;
    S.a_ready(cur);
    if constexpr (SP2) {
        PG8_STAGE(PG8_SB(0, 0), cB, voffB); PG8_STAGE(PG8_SB(0, 1), cB + hstep, voffB); PG8_STAGE(PG8_SA(0, 0), cA, voffA); PG8_STAGE(PG8_SA(0, 1), cA + hstep, voffA);
        if (wr == 1) PG8_BAR;
        PG8_WAIT_V(2); PG8_BAR;
        PG8_STAGE(PG8_SB(1, 0), cB + kstep, voffB); PG8_STAGE(PG8_SA(1, 0), cA + kstep, voffA); PG8_STAGE(PG8_SB(1, 1), cB + hstep + kstep, voffB);
        PG8_WAIT_V(6); PG8_BAR;
    } else {
        PG8_STAGE(PG8_SB(0, 0), cB, voffB); PG8_STAGE(PG8_SA(0, 0), cA, voffA); PG8_STAGE(PG8_SB(0, 1), cB + hstep, voffB); PG8_STAGE(PG8_SA(0, 1), cA + hstep, voffA);
        if (wr == 1) PG8_BAR;
        PG8_WAIT_V(4); PG8_BAR;
        PG8_STAGE(PG8_SB(1, 0), cB + kstep, voffB); PG8_STAGE(PG8_SA(1, 0), cA + kstep, voffA); PG8_STAGE(PG8_SB(1, 1), cB + hstep + kstep, voffB);
        PG8_WAIT_V(6); PG8_BAR;
    }
    for (;;) {
        const bool has_next = S.next(ui + 1, nxt);
        const char* nA = has_next ? (const char*)g.A + (size_t)nxt.pm * tstep : cA; const char* nB = has_next ? (const char*)g.Bt + (size_t)nxt.pn * tstep : cB;
        for (int t = 0; t < nt; t += 2) {
            if constexpr (Epi::MID) { if (t == (nt >> 1)) E.mid(acc, cur, wr, wc, fr, fq); }
            const bool last = (t == nt - 2);
            const char* a1 = cA + (size_t)(t + 1) * kstep;
            const char* a2 = last ? nA : cA + (size_t)(t + 2) * kstep; const char* b2 = last ? nB : cB + (size_t)(t + 2) * kstep;
            const char* a3 = a2 + kstep; const char* b3 = b2 + kstep;
            if (last && has_next) S.a_ready(nxt);
            if constexpr (SP2) {
            PG8_LDB(B0, 0, 0); PG8_LDB(B1, 0, 1); PG8_SCHED; PG8_LDA(At, 0, 0); PG8_STAGE(PG8_SA(1, 1), a1 + hstep, voffA);
            PG8_WAIT_V(8); PG8_WAIT_L(0); PG8_BAR; PG8_MMA(0, 0, At, B0); PG8_MMA(0, 1, At, B1); PG8_BAR; PG8_SCHED;
            PG8_LDA(At, 0, 1); PG8_STAGE(PG8_SB(0, 0), b2, voffB); PG8_STAGE(PG8_SB(0, 1), b2 + hstep, voffB); PG8_STAGE(PG8_SA(0, 0), a2, voffA);
            PG8_WAIT_V(8); PG8_WAIT_L(0); PG8_BAR; PG8_MMA(1, 0, At, B0); PG8_MMA(1, 1, At, B1); PG8_BAR; PG8_SCHED;
            PG8_LDB(B0, 1, 0); PG8_LDB(B1, 1, 1); PG8_SCHED; PG8_LDA(At, 1, 0); PG8_STAGE(PG8_SA(0, 1), a2 + hstep, voffA);
            PG8_WAIT_V(8); PG8_WAIT_L(0); PG8_BAR; PG8_MMA(0, 0, At, B0); PG8_MMA(0, 1, At, B1); PG8_BAR; PG8_SCHED;
            PG8_LDA(At, 1, 1); PG8_STAGE(PG8_SB(1, 0), b3, voffB); PG8_STAGE(PG8_SB(1, 1), b3 + hstep, voffB); PG8_STAGE(PG8_SA(1, 0), a3, voffA);
            PG8_WAIT_V(8); PG8_WAIT_L(0); PG8_BAR; PG8_MMA(1, 0, At, B0); PG8_MMA(1, 1, At, B1); PG8_BAR; PG8_SCHED;
            } else {
            PG8_LDB(B0, 0, 0); PG8_SCHED; PG8_LDA(At, 0, 0); PG8_STAGE(PG8_SA(1, 1), a1 + hstep, voffA);
            PG8_WAIT_L(8); PG8_BAR; PG8_WAIT_L(0); PG8_MMA(0, 0, At, B0); PG8_BAR; PG8_SCHED;
            PG8_LDB(B1, 0, 1); PG8_STAGE(PG8_SB(0, 0), b2, voffB);
            PG8_BAR; PG8_WAIT_L(0); PG8_MMA(0, 1, At, B1); PG8_BAR;
            PG8_LDA(At, 0, 1); PG8_STAGE(PG8_SA(0, 0), a2, voffA);
            PG8_BAR; PG8_WAIT_L(0); PG8_MMA(1, 0, At, B0); PG8_BAR; PG8_SCHED;
            PG8_STAGE(PG8_SB(0, 1), b2 + hstep, voffB);
            PG8_WAIT_V(6); PG8_BAR; PG8_MMA(1, 1, At, B1); PG8_BAR;
            PG8_LDB(B0, 1, 0); PG8_SCHED; PG8_LDA(At, 1, 0); PG8_STAGE(PG8_SA(0, 1), a2 + hstep, voffA);
            PG8_WAIT_L(8); PG8_BAR; PG8_WAIT_L(0); PG8_MMA(0, 0, At, B0); PG8_BAR; PG8_SCHED;
            PG8_LDB(B1, 1, 1); PG8_STAGE(PG8_SB(1, 0), b3, voffB);
            PG8_BAR; PG8_WAIT_L(0); PG8_MMA(0, 1, At, B1); PG8_BAR;
            PG8_LDA(At, 1, 1); PG8_STAGE(PG8_SA(1, 0), a3, voffA);
            PG8_BAR; PG8_WAIT_L(0); PG8_MMA(1, 0, At, B0); PG8_BAR; PG8_SCHED;
            PG8_STAGE(PG8_SB(1, 1), b3 + hstep, voffB);
            PG8_WAIT_V(6); PG8_BAR; PG8_MMA(1, 1, At, B1); PG8_BAR;
            }
        }
        if constexpr (ALIGN_EPI) { if (wr == 0) PG8_BAR; }
        if constexpr (!Epi::AFTER_DRAIN) { E(acc, cur, wr, wc, fr, fq); S.done(cur); }
        if (!has_next) break;
#pragma unroll
        for (int a = 0; a < 2; ++a)
#pragma unroll
            for (int b = 0; b < 2; ++b)
#pragma unroll
                for (int m = 0; m < 4; ++m)
#pragma unroll
                    for (int n = 0; n < 2; ++n) acc[a][b][m][n] = (f32x4){0.f, 0.f, 0.f, 0.f};
        cur = nxt; cA = nA; cB = nB; ++ui;
        if constexpr (ALIGN_EPI) { if (wr == 1) PG8_BAR; }
    }
    PG8_WAIT_V(0);
    if constexpr (!ALIGN_EPI) { if (wr == 0) PG8_BAR; }
    PG8_BAR;
    if constexpr (Epi::AFTER_DRAIN) { E.fused(acc, cur, wr, wc, fr, fq, lds, wid, lane); S.done(cur); }
#undef PG8_SA
#undef PG8_SB
#undef PG8_STAGE
#undef PG8_LDA
#undef PG8_LDB
#undef PG8_MMA
#undef PG8_WAIT_V
#undef PG8_WAIT_L
#undef PG8_BAR
#undef PG8_SCHED
}
}
constexpr int NWAVES = 8;
constexpr int RING_OFF = 0, RING_BYTES = 131072, TAB_OFF = RING_BYTES, TAB_BYTES = 8192, LDSCTL_OFF = TAB_OFF + TAB_BYTES, MISC_OFF = LDSCTL_OFF + 320, LDS_BYTES = 147456;
static_assert(MISC_OFF + 128 <= LDS_BYTES, "LDS map");
constexpr int CW_TMO = 0, CW_CODE = 1, CW_BAR = 4096;
constexpr size_t CTL_ZERO_BYTES = 64 * 1024;
constexpr float QK_C2 = 0.07216878364870323f * 1.4426950408889634f;
typedef float f32x2v __attribute__((ext_vector_type(2)));
typedef unsigned u32x2v __attribute__((ext_vector_type(2)));
__device__ __forceinline__ float bf2f(unsigned short b) { return __uint_as_float((unsigned)b << 16); }
__device__ __forceinline__ float gelu_f(float x) { const float u = 1.5957691216057308f * (x + 0.044715f * x * x * x); return x * __builtin_amdgcn_rcpf(1.f + __builtin_amdgcn_exp2f(-1.4426950408889634f * u)); }
__device__ __forceinline__ float wave_sum64(float v) {
#pragma unroll
    for (int o = 1; o < 64; o <<= 1) v += __shfl_xor(v, o);
    return v;
}
struct Args { const void* in[26]; float* out; unsigned char* ws; int ph_lo, ph_hi; };
struct Frame { LAS unsigned char* lds; volatile LAS unsigned* MISC; gu32* ctl; int tid, lane, wave, vcu, G; };

__device__ __forceinline__ int rope_pc(int lr) { const int nn = lr >> 5, i = lr & 31, c5 = i >> 4, f = i & 15; return 32 * c5 + 8 * (f >> 2) + 4 * nn + (f & 3); }
__device__ __forceinline__ int map_win(int n) { if (n < 768) return n; if (n < 832) return 2816 + rope_pc(n - 768); if (n < 1856) return 768 + (n - 832); return 1792 + (n - 1856); }
__device__ __forceinline__ int map_wuq(int n) { const int h = n / 192, lc = n - h * 192; return lc < 128 ? n : h * 192 + 128 + rope_pc(lc - 128); }
__device__ __forceinline__ int map_id(int n) { return n; }

template <class MapF, class ScaleF>
__device__ __forceinline__ void p0_transpose_item(const float* W, int K, int N, bf16* WT, LAS float* scr, int item, int lane, MapF mapf, ScaleF ks) {
    const int nblk = N / 32, kb = item / nblk, nb = item % nblk, k0 = 64 * kb, n0 = 32 * nb;
#pragma unroll 8
    for (int i = 0; i < 32; ++i) { const int kk = 2 * i + (lane >> 5); scr[kk * 33 + (lane & 31)] = W[(size_t)(k0 + kk) * N + n0 + (lane & 31)] * ks(k0 + kk); }
    LDS_WAIT(); asm volatile("" ::: "memory");
    const int c = lane & 7;
#pragma unroll
    for (int j = 0; j < 4; ++j) { const int n = (lane >> 3) + 8 * j; const LAS float* s = scr + (8 * c) * 33 + n;
        v4u o; o.x = pk2(s[0 * 33], s[1 * 33]); o.y = pk2(s[2 * 33], s[3 * 33]); o.z = pk2(s[4 * 33], s[5 * 33]); o.w = pk2(s[6 * 33], s[7 * 33]);
        *(GAS v4u*)(WT + (size_t)mapf(n0 + n) * K + k0 + 8 * c) = o; }
    LDS_WAIT(); asm volatile("" ::: "memory");
}
template <class ScaleF>
__device__ __forceinline__ void p0_cvt512(const float* src, bf16* dst, size_t e0, int lane, ScaleF sf) {
    const size_t e = e0 + (size_t)lane * 8; const f32x4 a = *(const GAS f32x4*)(src + e), b = *(const GAS f32x4*)(src + e + 4);
    v4u o; o.x = pk2(a.x * sf(e), a.y * sf(e + 1)); o.y = pk2(a.z * sf(e + 2), a.w * sf(e + 3)); o.z = pk2(b.x * sf(e + 4), b.y * sf(e + 5)); o.w = pk2(b.z * sf(e + 6), b.w * sf(e + 7));
    *(GAS v4u*)(dst + e) = o;
}
__device__ __forceinline__ void p0_prologue(const Args& A, Frame& F) {
    unsigned char* ws = A.ws;
    const float* x = (const float*)A.in[0]; const float* p = (const float*)A.in[1]; const int* pos = (const int*)A.in[2];
    const float *g_mix = (const float*)A.in[3], *w_in = (const float*)A.in[4], *g_cq = (const float*)A.in[5], *w_uq = (const float*)A.in[6], *g_ckv = (const float*)A.in[7], *w_ukv = (const float*)A.in[8];
    const float *w_sgu = (const float*)A.in[11], *g_oa = (const float*)A.in[13], *g_os = (const float*)A.in[14], *w_out = (const float*)A.in[15], *g_ffn = (const float*)A.in[16], *w_pq = (const float*)A.in[17];
    const float *k1 = (const float*)A.in[18], *k2 = (const float*)A.in[19], *pu = (const float*)A.in[20], *pv = (const float*)A.in[21], *g_ple = (const float*)A.in[22], *w_pg = (const float*)A.in[23], *w_pp = (const float*)A.in[24];
    LAS float* scr = (LAS float*)(F.lds + RING_OFF + F.wave * 16384);
    const int gw = F.vcu * NWAVES + F.wave, NGW = F.G * NWAVES, lane = F.lane;
    for (int m = gw; m < T_TOK; m += NGW) {
        const GAS f32x4* xr = (const GAS f32x4*)(x + (size_t)m * DM) + lane; f32x4 v[8]; float s = 0.f;
#pragma unroll
        for (int j = 0; j < 8; ++j) { v[j] = xr[64 * j]; s += (v[j].x * v[j].x + v[j].y * v[j].y) + (v[j].z * v[j].z + v[j].w * v[j].w); }
        s = wave_sum64(s); if (lane == 0) ((float*)(ws + WS_RSX))[m] = 1.0f / sqrtf(s * (1.f / DM) + 1e-6f);
        GAS u32x2v* o8 = (GAS u32x2v*)((bf16*)(ws + WS_R1) + (size_t)m * DM) + lane;
#pragma unroll
        for (int j = 0; j < 8; ++j) o8[64 * j] = (u32x2v){pk2(v[j].x, v[j].y), pk2(v[j].z, v[j].w)};
        const f32x4 pvv = *((const GAS f32x4*)(p + (size_t)m * 256) + lane);
        *((GAS u32x2v*)((bf16*)(ws + WS_PB) + (size_t)m * 256) + lane) = (u32x2v){pk2(pvv.x, pvv.y), pk2(pvv.z, pvv.w)};
    }
    for (int it = gw; it < T_TOK * 32 / 64; it += NGW) { const int idx = it * 64 + lane, row = idx >> 5, i = idx & 31;
        const double f = exp2((double)i * (-13.287712379549449 / 32.0)); const double a = (double)pos[row] * f;
        ((f32x2v*)(ws + WS_CS))[idx] = (f32x2v){(float)cos(a), (float)sin(a)}; }
    constexpr int I_IN = 32 * 90, I_UQ = 8 * 48, I_UKV = 4 * 64, I_SQ = 32 * 64, I_PP = 4 * 64;
    constexpr int NITEMS = I_IN + I_UQ + I_UKV + 3 * I_SQ + I_PP;
    for (int it = gw; it < NITEMS; it += NGW) {
        int r = it;
        if (r < I_IN) { p0_transpose_item(w_in, 2048, 2880, (bf16*)(ws + WS_WT_IN), scr, r, lane, [](int n) { return map_win(n); }, [=](int k) { return g_mix[k]; }); continue; } r -= I_IN;
        if (r < I_UQ) { p0_transpose_item(w_uq, 512, 1536, (bf16*)(ws + WS_WT_UQ), scr, r, lane, [](int n) { return map_wuq(n); }, [=](int k) { return g_cq[k] * QK_C2; }); continue; } r -= I_UQ;
        if (r < I_UKV) { p0_transpose_item(w_ukv, 256, 2048, (bf16*)(ws + WS_WT_UKV), scr, r, lane, [](int n) { return n; }, [=](int k) { return g_ckv[k]; }); continue; } r -= I_UKV;
        if (r < I_SQ) { p0_transpose_item(w_out, 2048, 2048, (bf16*)(ws + WS_WT_OUT), scr, r, lane, [](int n) { return n; }, [=](int k) { return k < 1024 ? g_oa[k] : g_os[k - 1024]; }); continue; } r -= I_SQ;
        if (r < I_SQ) { p0_transpose_item(w_pq, 2048, 2048, (bf16*)(ws + WS_WT_PQ), scr, r, lane, [](int n) { return n; }, [=](int k) { return g_ffn[k]; }); continue; } r -= I_SQ;
        if (r < I_SQ) { p0_transpose_item(w_pg, 2048, 2048, (bf16*)(ws + WS_WT_PG), scr, r, lane, [](int n) { return n; }, [=](int k) { return g_ple[k]; }); continue; } r -= I_SQ;
        p0_transpose_item(w_pp, 256, 2048, (bf16*)(ws + WS_WT_PP), scr, r, lane, [](int n) { return n; }, [](int) { return 1.f; });
    }
    for (int it = gw; it < 192 * 2048 / 512; it += NGW) *(GAS v4u*)((bf16*)(ws + WS_WT_IN) + (size_t)2880 * 2048 + (size_t)it * 512 + lane * 8) = (v4u){0u, 0u, 0u, 0u};
    for (int it = gw; it < 3 * 256; it += NGW) { const int w = it >> 8, c = it & 255;
        if (w == 0) p0_cvt512(k1, (bf16*)(ws + WS_K1B), (size_t)c * 512, lane, [](size_t) { return 1.f; });
        else if (w == 1) p0_cvt512(k2, (bf16*)(ws + WS_K2B), (size_t)c * 512, lane, [](size_t) { return 1.f; });
        else p0_cvt512(w_sgu, (bf16*)(ws + WS_WSGU), (size_t)c * 512, lane, [](size_t e) { const int s = (int)(e & 127), t = (int)((e >> 7) & 127); return s <= t ? 1.f : 0.f; }); }
#if CUT >= 7
    for (int it = gw; it < 2 * 16384 * 2; it += NGW) { const int w = it >= 16384 * 2, c = w ? it - 16384 * 2 : it; const float* src = (w ? pv : pu) + (size_t)c * 1024 + lane * 16; const int d0 = (c & 1) * 1024 + lane * 16;
        f32x4 x[4];
#pragma unroll
        for (int q = 0; q < 4; ++q) x[q] = *(const GAS f32x4*)(src + 4 * q);
        if (!w) {
#pragma unroll
            for (int q = 0; q < 4; ++q) x[q] = x[q] * *(const GAS f32x4*)(g_ffn + d0 + 4 * q) * 256.f; }
        else {
#pragma unroll
            for (int q = 0; q < 4; ++q) x[q] = x[q] * 16.f; }
        v4u o; int t;
        t = 0; t = __builtin_amdgcn_cvt_pk_fp8_f32(x[0][0], x[0][1], t, false); t = __builtin_amdgcn_cvt_pk_fp8_f32(x[0][2], x[0][3], t, true); o.x = (unsigned)t;
        t = 0; t = __builtin_amdgcn_cvt_pk_fp8_f32(x[1][0], x[1][1], t, false); t = __builtin_amdgcn_cvt_pk_fp8_f32(x[1][2], x[1][3], t, true); o.y = (unsigned)t;
        t = 0; t = __builtin_amdgcn_cvt_pk_fp8_f32(x[2][0], x[2][1], t, false); t = __builtin_amdgcn_cvt_pk_fp8_f32(x[2][2], x[2][3], t, true); o.z = (unsigned)t;
        t = 0; t = __builtin_amdgcn_cvt_pk_fp8_f32(x[3][0], x[3][1], t, false); t = __builtin_amdgcn_cvt_pk_fp8_f32(x[3][2], x[3][3], t, true); o.w = (unsigned)t;
        *(GAS v4u*)((unsigned char*)(ws + (w ? WS_VB : WS_UB)) + (size_t)c * 1024 + lane * 16) = o; }
#endif
}

__device__ __forceinline__ v4u pack8(f32x4 a, f32x4 b) { v4u w; w.x = pg8::cvt_pk_bf16(a[0], a[1]); w.y = pg8::cvt_pk_bf16(a[2], a[3]); w.z = pg8::cvt_pk_bf16(b[0], b[1]); w.w = pg8::cvt_pk_bf16(b[2], b[3]); return w; }
__device__ __forceinline__ float sq8(f32x4 a, f32x4 b) { return ((a[0] * a[0] + a[1] * a[1]) + (a[2] * a[2] + a[3] * a[3])) + ((b[0] * b[0] + b[1] * b[1]) + (b[2] * b[2] + b[3] * b[3])); }
__device__ __forceinline__ float fq_sum(float v) { v += __shfl_xor(v, 16); v += __shfl_xor(v, 32); return v; }
#define EPI_ROWS_BEGIN _Pragma("unroll") for (int ai = 0; ai < 2; ++ai) _Pragma("unroll") for (int m = 0; m < 4; ++m) { const int row = u.pm * 256 + ai * 128 + wr * 64 + m * 16 + fr;
#define EPI_ROWS_END }

struct EpiG1 {
    static constexpr bool PERM = true, AFTER_DRAIN = false, MID = false;
    const float* rsx; bf16 *CQ, *CKV, *KR, *UG, *VG; float *pscq, *psckv; f32x2v* psv; const f32x2v* cs;
    __device__ __forceinline__ void operator()(const f32x4 (&acc)[2][2][4][2], const pg8::Unit& u, int wr, int wc, int fr, int fq) const {
        const int pn = u.pn;
        EPI_ROWS_BEGIN
            const float rs = rsx[row];
#pragma unroll
            for (int bj = 0; bj < 2; ++bj) { f32x4 v0 = acc[ai][bj][m][0] * rs, v1 = acc[ai][bj][m][1] * rs; const int lc = bj * 128 + wc * 32 + fq * 8;
                if (pn <= 2) { const float ss = fq_sum(sq8(v0, v1));
                    if (pn < 2) { *(GAS v4u*)(CQ + (size_t)row * 512 + pn * 256 + lc) = pack8(v0, v1); if (fq == 0) pscq[row * 16 + (pn * 2 + bj) * 4 + wc] = ss; }
                    else { *(GAS v4u*)(CKV + (size_t)row * 256 + lc) = pack8(v0, v1); if (fq == 0) psckv[row * 8 + bj * 4 + wc] = ss; } }
                else if (pn <= 10) {
#pragma unroll
                    for (int e = 0; e < 4; ++e) { v0[e] = gelu_f(v0[e]); v1[e] = gelu_f(v1[e]); }
                    if (pn <= 6) *(GAS v4u*)(UG + (size_t)row * 1024 + (pn - 3) * 256 + lc) = pack8(v0, v1);
                    else { const float s = fq_sum(((v0[0] + v0[1]) + (v0[2] + v0[3])) + ((v1[0] + v1[1]) + (v1[2] + v1[3]))), q = fq_sum(sq8(v0, v1));
                        *(GAS v4u*)(VG + (size_t)row * 1024 + (pn - 7) * 256 + lc) = pack8(v0, v1); if (fq == 0) psv[(row * 8 + (pn - 7) * 2 + bj) * 4 + wc] = (f32x2v){s, q}; } }
                else if (bj == 0 && wc < 2) { f32x4 o0, o1;
#pragma unroll
                    for (int e = 0; e < 4; ++e) { const f32x2v c = cs[row * 32 + 16 * wc + 4 * fq + e]; o0[e] = v0[e] * c.x - v1[e] * c.y; o1[e] = v1[e] * c.x + v0[e] * c.y; }
                    *(GAS v4u*)(KR + (size_t)row * 64 + wc * 32 + fq * 8) = pack8(o0, o1); } }
        EPI_ROWS_END
    }
};
struct EpiPlain {
    static constexpr bool PERM = true, AFTER_DRAIN = false, MID = false;
    bf16* O; int ldc;
    __device__ __forceinline__ void operator()(const f32x4 (&acc)[2][2][4][2], const pg8::Unit& u, int wr, int wc, int fr, int fq) const {
        EPI_ROWS_BEGIN
#pragma unroll
            for (int bj = 0; bj < 2; ++bj) *(GAS v4u*)(O + (size_t)row * ldc + u.pn * 256 + bj * 128 + wc * 32 + fq * 8) = pack8(acc[ai][bj][m][0], acc[ai][bj][m][1]);
        EPI_ROWS_END
    }
};
template <class Sched>
__device__ __forceinline__ void setup_rowtab(LAS float* tab, const float* part, int NP, float inv_dim, const Sched& S, int wid) {
    pg8::Unit u; const int tid = wid * 64 + lane_id();
    if (S.next(0, u)) { const int r = tid >> 1, half = tid & 1, n2 = NP >> 1; const float* pp = part + (size_t)(u.pm * 256 + r) * NP + half * n2; float s = 0.f;
        for (int j = 0; j < n2; ++j) s += pp[j];
        s += __shfl_xor(s, 1); if (!half) tab[r] = 1.0f / sqrtf(s * inv_dim + 1e-6f); }
}
struct EpiQ {
    static constexpr bool PERM = true, AFTER_DRAIN = false, MID = false;
    const LAS float* tab; bf16* Q; const f32x2v* cs;
    __device__ __forceinline__ void operator()(const f32x4 (&acc)[2][2][4][2], const pg8::Unit& u, int wr, int wc, int fr, int fq) const {
        EPI_ROWS_BEGIN
            const float rs = tab[ai * 128 + wr * 64 + m * 16 + fr];
#pragma unroll
            for (int bj = 0; bj < 2; ++bj) { f32x4 v0 = acc[ai][bj][m][0] * rs, v1 = acc[ai][bj][m][1] * rs; const int gc = u.pn * 256 + bj * 128 + wc * 32;
                if (((gc >> 6) % 3) == 2) { f32x4 o0, o1;
#pragma unroll
                    for (int e = 0; e < 4; ++e) { const f32x2v c = cs[row * 32 + 16 * (wc & 1) + 4 * fq + e]; o0[e] = v0[e] * c.x - v1[e] * c.y; o1[e] = v1[e] * c.x + v0[e] * c.y; }
                    v0 = o0; v1 = o1; }
                *(GAS v4u*)(Q + (size_t)row * 1536 + gc + fq * 8) = pack8(v0, v1); }
        EPI_ROWS_END
    }
};
struct EpiKV {
    static constexpr bool PERM = true, AFTER_DRAIN = false, MID = false;
    const LAS float* tab; bf16 *KN, *VV;
    __device__ __forceinline__ void operator()(const f32x4 (&acc)[2][2][4][2], const pg8::Unit& u, int wr, int wc, int fr, int fq) const {
        EPI_ROWS_BEGIN
            const float rs = tab[ai * 128 + wr * 64 + m * 16 + fr];
#pragma unroll
            for (int bj = 0; bj < 2; ++bj) *(GAS v4u*)((bj ? VV : KN) + (size_t)row * 1024 + u.pn * 128 + wc * 32 + fq * 8) = pack8(acc[ai][bj][m][0] * rs, acc[ai][bj][m][1] * rs);
        EPI_ROWS_END
    }
};
struct EpiOut {
    static constexpr bool PERM = true, AFTER_DRAIN = false, MID = true;
    const LAS float* tab; const float* x; float* H1; bf16* H1B; float* psh1;
    __device__ __forceinline__ void mid(f32x4 (&acc)[2][2][4][2], const pg8::Unit& u, int wr, int wc, int fr, int fq) const {
#pragma unroll
        for (int ai = 0; ai < 2; ++ai)
#pragma unroll
            for (int m = 0; m < 4; ++m) { const int r = ai * 128 + wr * 64 + m * 16 + fr; const float rr = tab[r] / tab[256 + r];
#pragma unroll
                for (int bj = 0; bj < 2; ++bj) { acc[ai][bj][m][0] *= rr; acc[ai][bj][m][1] *= rr; } }
    }
    __device__ __forceinline__ void operator()(const f32x4 (&acc)[2][2][4][2], const pg8::Unit& u, int wr, int wc, int fr, int fq) const {
        EPI_ROWS_BEGIN
            const float rs = tab[256 + ai * 128 + wr * 64 + m * 16 + fr];
#pragma unroll
            for (int bj = 0; bj < 2; ++bj) { const size_t off = (size_t)row * DM + u.pn * 256 + bj * 128 + wc * 32 + fq * 8;
                const f32x4 v0 = *(const GAS f32x4*)(x + off) + acc[ai][bj][m][0] * rs, v1 = *(const GAS f32x4*)(x + off + 4) + acc[ai][bj][m][1] * rs;
                *(GAS f32x4*)(H1 + off) = v0; *(GAS f32x4*)(H1 + off + 4) = v1; *(GAS v4u*)(H1B + off) = pack8(v0, v1);
                const float ss = fq_sum(sq8(v0, v1)); if (fq == 0) psh1[row * 64 + u.pn * 8 + bj * 4 + wc] = ss; }
        EPI_ROWS_END
    }
};
struct EpiPQ {
    static constexpr bool PERM = true, AFTER_DRAIN = false, MID = false;
    const LAS float* tab; bf16* QP;
    __device__ __forceinline__ void operator()(const f32x4 (&acc)[2][2][4][2], const pg8::Unit& u, int wr, int wc, int fr, int fq) const {
        EPI_ROWS_BEGIN
            const float rs = tab[ai * 128 + wr * 64 + m * 16 + fr];
#pragma unroll
            for (int bj = 0; bj < 2; ++bj) *(GAS v4u*)(QP + (size_t)row * DM + u.pn * 256 + bj * 128 + wc * 32 + fq * 8) = pack8(acc[ai][bj][m][0] * rs, acc[ai][bj][m][1] * rs);
        EPI_ROWS_END
    }
};
struct EpiPLE {
    static constexpr bool PERM = true, AFTER_DRAIN = false, MID = false;
    const float* rsh2; const float* H2; const bf16* PPROJ; float* out; float* psh3;
    __device__ __forceinline__ void operator()(const f32x4 (&acc)[2][2][4][2], const pg8::Unit& u, int wr, int wc, int fr, int fq) const {
        EPI_ROWS_BEGIN
            const float rs = rsh2[row];
#pragma unroll
            for (int bj = 0; bj < 2; ++bj) { const size_t off = (size_t)row * DM + u.pn * 256 + bj * 128 + wc * 32 + fq * 8;
                const v4u pw = *(const GAS v4u*)(PPROJ + off); f32x4 h0 = *(const GAS f32x4*)(H2 + off), h1 = *(const GAS f32x4*)(H2 + off + 4);
                const unsigned pws[4] = {pw.x, pw.y, pw.z, pw.w};
#pragma unroll
                for (int e = 0; e < 4; ++e) { const float a = acc[ai][bj][m][e >> 1][(e & 1) * 2] * rs, b = acc[ai][bj][m][e >> 1][(e & 1) * 2 + 1] * rs;
                    const float ga = __builtin_amdgcn_rcpf(1.f + __builtin_amdgcn_exp2f(-1.4426950408889634f * a)), gb = __builtin_amdgcn_rcpf(1.f + __builtin_amdgcn_exp2f(-1.4426950408889634f * b));
                    const float pa = __uint_as_float(pws[e] << 16), pb = __uint_as_float(pws[e] & 0xffff0000u);
                    if (e < 2) { h0[(e & 1) * 2] += ga * pa; h0[(e & 1) * 2 + 1] += gb * pb; } else { h1[(e & 1) * 2] += ga * pa; h1[(e & 1) * 2 + 1] += gb * pb; } }
                *(GAS f32x4*)(out + off) = h0; *(GAS f32x4*)(out + off + 4) = h1;
                const float ss = fq_sum(sq8(h0, h1)); if (fq == 0) psh3[row * 64 + u.pn * 8 + bj * 4 + wc] = ss; }
        EPI_ROWS_END
    }
};
typedef float f32x16 __attribute__((ext_vector_type(16)));
typedef short s16x4 __attribute__((ext_vector_type(4)));
#define KSWZ(row, colB) ((row) * 256 + ((colB) ^ (((row) & 7) << 4)))
__device__ __forceinline__ int v_st(int k, int c) { const int kk = (k & ~0xC) | ((k & 4) << 1) | ((k & 8) >> 1); return ((kk >> 3) * 4 + (c >> 5)) * 512 + ((kk & 7) * 32 + (c & 31)) * 2; }
__device__ __forceinline__ int v_rd_base(int lane) { return ((lane & 3) << 3) | (((lane >> 2) & 3) << 6) | (((lane >> 4) & 1) << 5) | (((lane >> 5) & 1) << 8); }
__device__ __forceinline__ int crow(int r, int hi) { return (r & 3) + 8 * (r >> 2) + 4 * hi; }
#define TRRD(dst, off) asm volatile("ds_read_b64_tr_b16 %0, %1 offset:%2" : "=&v"(dst) : "v"(vb0), "i"(off) : "memory")
#define SBAR() __builtin_amdgcn_sched_barrier(0)
#define PV_ONE(o_, pa_, VOFF, D0, KS) do { s16x4 l_, h_; TRRD(l_, (VOFF) + (D0) * 512 + (KS) * 4096); TRRD(h_, (VOFF) + (D0) * 512 + (KS) * 4096 + 2048); \
        asm volatile("s_waitcnt lgkmcnt(0)" ::: "memory"); SBAR(); \
        o_ = __builtin_amdgcn_mfma_f32_32x32x16_bf16(pa_, (bf16x8){l_[0], l_[1], l_[2], l_[3], h_[0], h_[1], h_[2], h_[3]}, o_, 0, 0, 0); } while (0)
__device__ __forceinline__ float half_sum32(float v) { v += __shfl_xor(v, 1); v += __shfl_xor(v, 2); v += __shfl_xor(v, 4); v += __shfl_xor(v, 8); v += __shfl_xor(v, 16); return v; }

__device__ __forceinline__ void sgu_phase(const Args& A, Frame& F) {
    unsigned char* ws = A.ws;
    const bf16* VG = (const bf16*)(ws + WS_VG); const bf16* UG = (const bf16*)(ws + WS_UG); const bf16* WS = (const bf16*)(ws + WS_WSGU); const f32x2v* psv = (const f32x2v*)(ws + WS_PSV);
    const float* gln = (const float*)A.in[9]; const float* bln = (const float*)A.in[10]; const float* bs = (const float*)A.in[12];
    bf16* MIX = (bf16*)(ws + WS_MIX); float* pss = (float*)(ws + WS_PSS);
    const int lane = lane_id(), wid = F.wave, tid = wid * 64 + lane, r32 = lane & 31, hi = lane >> 5, tg = wid & 3, dh = wid >> 2;
    LAS unsigned char* V_lds = F.lds + RING_OFF;
    const int vb0 = (int)(uintptr_t)V_lds + v_rd_base(lane);
    for (int unit = F.vcu; unit < 512; unit += F.G) {
        const int g = unit & 7, R0 = (unit >> 3) * 128;
#pragma unroll
        for (int i = 0; i < 4; ++i) { const int s = (tid >> 4) + 32 * i, c = (tid & 15) * 8, row = R0 + s;
            const f32x2v* pp = psv + ((size_t)row * 8 + g) * 4; const f32x2v p0 = pp[0], p1 = pp[1], p2 = pp[2], p3 = pp[3];
            const float mean = ((p0.x + p1.x) + (p2.x + p3.x)) * (1.f / 128.f), var = ((p0.y + p1.y) + (p2.y + p3.y)) * (1.f / 128.f) - mean * mean, rstd = 1.0f / sqrtf(fmaxf(var, 0.f) + 1e-6f);
            const v4u xv = *(const GAS v4u*)(VG + (size_t)row * 1024 + g * 128 + c);
            const f32x4 g0 = *(const GAS f32x4*)(gln + g * 128 + c), g1 = *(const GAS f32x4*)(gln + g * 128 + c + 4), b0 = *(const GAS f32x4*)(bln + g * 128 + c), b1 = *(const GAS f32x4*)(bln + g * 128 + c + 4);
            f32x4 y0, y1;
            y0[0] = (__uint_as_float(xv.x << 16) - mean) * rstd * g0[0] + b0[0]; y0[1] = (__uint_as_float(xv.x & 0xffff0000u) - mean) * rstd * g0[1] + b0[1];
            y0[2] = (__uint_as_float(xv.y << 16) - mean) * rstd * g0[2] + b0[2]; y0[3] = (__uint_as_float(xv.y & 0xffff0000u) - mean) * rstd * g0[3] + b0[3];
            y1[0] = (__uint_as_float(xv.z << 16) - mean) * rstd * g1[0] + b1[0]; y1[1] = (__uint_as_float(xv.z & 0xffff0000u) - mean) * rstd * g1[1] + b1[1];
            y1[2] = (__uint_as_float(xv.w << 16) - mean) * rstd * g1[2] + b1[2]; y1[3] = (__uint_as_float(xv.w & 0xffff0000u) - mean) * rstd * g1[3] + b1[3];
            *(LAS v4u*)(V_lds + (s >> 6) * 16384 + v_st(s & 63, c)) = pack8(y0, y1); }
        bf16x8 afr[8];
#pragma unroll
        for (int ks = 0; ks < 8; ++ks) afr[ks] = *(const GAS bf16x8*)(WS + ((size_t)g * 128 + 32 * tg + r32) * 128 + 16 * ks + 8 * hi);
        __syncthreads();
        f32x16 o0 = {}, o1 = {};
#define SGU_TILE(TL) do { _Pragma("unroll") for (int ks = 0; ks < 4; ++ks) { \
            if (dh == 0) { PV_ONE(o0, afr[4 * TL + ks], TL * 16384, 0, ks); PV_ONE(o1, afr[4 * TL + ks], TL * 16384, 1, ks); } \
            else { PV_ONE(o0, afr[4 * TL + ks], TL * 16384, 2, ks); PV_ONE(o1, afr[4 * TL + ks], TL * 16384, 3, ks); } } } while (0)
        SGU_TILE(0); if (tg >= 2) SGU_TILE(1);
#undef SGU_TILE
#pragma unroll
        for (int r = 0; r < 16; ++r) { const int t = 32 * tg + crow(r, hi), row = R0 + t; const float bias = bs[g * 128 + t];
            const int d0 = 64 * dh + r32; const size_t uoff = (size_t)row * 1024 + g * 128 + d0;
            const float va = bf2f(UG[uoff]) * (o0[r] + bias), vb = bf2f(UG[uoff + 32]) * (o1[r] + bias);
            const float na = __shfl_xor(va, 1), nb = __shfl_xor(vb, 1);
            if ((r32 & 1) == 0) { bf16* mo = MIX + (size_t)row * 2048 + 1024 + g * 128 + d0; *(GAS unsigned*)mo = pg8::cvt_pk_bf16(va, na); *(GAS unsigned*)(mo + 32) = pg8::cvt_pk_bf16(vb, nb); }
            const float ss = half_sum32(va * va + vb * vb); if (r32 == 0) pss[row * 16 + g * 2 + dh] = ss; }
        __syncthreads();
    }
}

#define OPAQUE(x) asm volatile("" : "+v"(x))
constexpr int KT_ROW = 400, KT_BYTES = 64 * KT_ROW;
__device__ __forceinline__ void attn_phase(const Args& A, Frame& F) {
    unsigned char* ws = A.ws;
    const GAS unsigned char* Qg = (const GAS unsigned char*)(ws + WS_Q); const GAS unsigned char* KNg = (const GAS unsigned char*)(ws + WS_KN); const GAS unsigned char* VVg = (const GAS unsigned char*)(ws + WS_VV); const GAS unsigned char* KRg = (const GAS unsigned char*)(ws + WS_KR);
    bf16* MIX = (bf16*)(ws + WS_MIX); float* psa = (float*)(ws + WS_PSA);
    const int wid = F.wave, g = wid & 3, kh = wid >> 2;
    LAS unsigned char* V_lds = F.lds + RING_OFF; LAS unsigned char* Kt_lds = V_lds + 32768;
    LAS float* wsc = (LAS float*)(V_lds + 86016) + wid * 64;
    LAS float* ml1 = (LAS float*)(V_lds + 86016 + 2048);
    for (int item = F.vcu; item < 256; item += F.G) {
        const int bh = item >> 3, s = item & 7, b = bh >> 3, h = bh & 7, tok0 = b * SEQ;
        for (int pass = 0; pass < 2; ++pass) {
            const int jq = pass ? s : 15 - s, q0 = tok0 + 128 * jq, NT = 2 * (jq + 1);
            bf16x8 qr[12];
            { int ln = lane_id(); const int r32 = ln & 31, hi = ln >> 5; const GAS unsigned char* qp = Qg + (size_t)(q0 + 32 * g) * 3072 + h * 384; const unsigned qo = (unsigned)r32 * 3072u + (unsigned)hi * 16u;
#pragma unroll
              for (int ks = 0; ks < 12; ++ks) qr[ks] = *(const GAS bf16x8*)(qp + qo + ks * 32); }
            bf16x8 skn0, skn1, sv0, sv1, skr;
#define ALOAD(t_) do { int ln_ = lane_id(); const int tid_ = wid * 64 + ln_; const unsigned sr_ = tid_ >> 4, sc_ = tid_ & 15; \
                const GAS unsigned char* kb_ = KNg + (size_t)(tok0 + 64 * (t_)) * 2048 + h * 256; const GAS unsigned char* vb_ = VVg + (size_t)(tok0 + 64 * (t_)) * 2048 + h * 256; const GAS unsigned char* rb_ = KRg + (size_t)(tok0 + 64 * (t_)) * 128; \
                const unsigned o_ = sr_ * 2048u + sc_ * 16u; \
                skn0 = *(const GAS bf16x8*)(kb_ + o_); skn1 = *(const GAS bf16x8*)(kb_ + o_ + 65536u); sv0 = *(const GAS bf16x8*)(vb_ + o_); sv1 = *(const GAS bf16x8*)(vb_ + o_ + 65536u); \
                skr = *(const GAS bf16x8*)(rb_ + (unsigned)tid_ * 16u); } while (0)
#define AWRITE(bf_) do { int ln_ = lane_id(); const int tid_ = wid * 64 + ln_; const int sr_ = tid_ >> 4, sc_ = tid_ & 15; \
                LAS unsigned char* kt_ = Kt_lds + (bf_) * KT_BYTES; LAS unsigned char* vt_ = V_lds + (bf_) * 16384; \
                *(LAS bf16x8*)(kt_ + sr_ * KT_ROW + sc_ * 16) = skn0; *(LAS bf16x8*)(kt_ + (sr_ + 32) * KT_ROW + sc_ * 16) = skn1; \
                *(LAS bf16x8*)(vt_ + v_st(sr_, sc_ * 8)) = sv0; *(LAS bf16x8*)(vt_ + v_st(32 + sr_, sc_ * 8)) = sv1; \
                *(LAS bf16x8*)(kt_ + (tid_ >> 3) * KT_ROW + 256 + (tid_ & 7) * 16) = skr; } while (0)
            ALOAD(0); AWRITE(0); __syncthreads();
            float m_reg = -1e30f, l_reg = 0.f; f32x16 o[4] = {};
            for (int t = 0; t < NT; ++t) {
                const int bf = t & 1;
                if (t + 1 < NT) ALOAD(t + 1);
                int ln = lane_id(); const int r32 = ln & 31, hi = ln >> 5;
                f32x16 p = {};
                { const LAS unsigned char* kb = Kt_lds + bf * KT_BYTES + (32 * kh + r32) * KT_ROW + hi * 16;
#pragma unroll
                  for (int ks = 0; ks < 12; ++ks) p = __builtin_amdgcn_mfma_f32_32x32x16_bf16(*(const LAS bf16x8*)(kb + ks * 32), qr[ks], p, 0, 0, 0); }
                if (t >= 2 * jq) { const int dq = (32 * g + r32) - (64 * (t - 2 * jq) + 32 * kh + 4 * hi);
#pragma unroll
                    for (int r = 0; r < 16; ++r) { const int c = (r & 3) + 8 * (r >> 2); if (c > dq) p[r] = -__builtin_inff(); } }
                float pmax = p[0];
#pragma unroll
                for (int r = 1; r < 16; ++r) pmax = fmaxf(pmax, p[r]);
                { auto rr = __builtin_amdgcn_permlane32_swap(__float_as_uint(pmax), __float_as_uint(pmax), false, false); pmax = fmaxf(__uint_as_float(rr[0]), __uint_as_float(rr[1])); }
                const float mn = fmaxf(m_reg, pmax), alpha = __builtin_amdgcn_exp2f(m_reg - mn); m_reg = mn;
                float ps = 0.f;
#pragma unroll
                for (int r = 0; r < 16; ++r) { p[r] = __builtin_amdgcn_exp2f(p[r] - mn); ps += p[r]; }
                { auto rr = __builtin_amdgcn_permlane32_swap(__float_as_uint(ps), __float_as_uint(ps), false, false); ps = __uint_as_float(rr[0]) + __uint_as_float(rr[1]); }
                l_reg = l_reg * alpha + ps;
                if (__any(alpha < 1.f)) { if (hi == 0) wsc[r32] = alpha; asm volatile("s_waitcnt lgkmcnt(0)" ::: "memory");
#pragma unroll
                    for (int r = 0; r < 16; ++r) { const float f = wsc[crow(r, hi)];
#pragma unroll
                        for (int d_ = 0; d_ < 4; ++d_) o[d_][r] *= f; } }
                bf16x8 pa0, pa1;
#define PK4(P, B_, OUT) do { unsigned a0 = pg8::cvt_pk_bf16(P[B_ + 0], P[B_ + 1]), a1 = pg8::cvt_pk_bf16(P[B_ + 2], P[B_ + 3]), b0 = pg8::cvt_pk_bf16(P[B_ + 4], P[B_ + 5]), b1 = pg8::cvt_pk_bf16(P[B_ + 6], P[B_ + 7]); \
                    auto r0 = __builtin_amdgcn_permlane32_swap(a0, b0, false, false); auto r1 = __builtin_amdgcn_permlane32_swap(a1, b1, false, false); \
                    v4u w = {r0[0], r1[0], r0[1], r1[1]}; OUT = __builtin_bit_cast(bf16x8, w); } while (0)
                PK4(p, 0, pa0); PK4(p, 8, pa1);
#undef PK4
                { const int vb0 = (int)(uintptr_t)V_lds + v_rd_base(ln) + bf * 16384 + kh * 8192;
#pragma unroll
                  for (int d0 = 0; d0 < 4; ++d0) { PV_ONE(o[d0], pa0, 0, d0, 0); PV_ONE(o[d0], pa1, 0, d0, 1); } }
                if (t + 1 < NT) AWRITE(bf ^ 1);
                __syncthreads();
            }
#undef ALOAD
#undef AWRITE
            { int ln = lane_id(); const int r32 = ln & 31, hi = ln >> 5;
            LAS float* O1 = (LAS float*)(V_lds + g * 16384) + ln;
            if (kh == 1) {
#pragma unroll
                for (int d0 = 0; d0 < 4; ++d0)
#pragma unroll
                    for (int r = 0; r < 16; ++r) O1[(d0 * 16 + r) * 64] = o[d0][r];
                if (hi == 0) { ml1[g * 64 + r32] = m_reg; ml1[g * 64 + 32 + r32] = l_reg; } }
            __syncthreads();
            if (kh == 0) { const float m1 = ml1[g * 64 + r32], l1 = ml1[g * 64 + 32 + r32], mt = fmaxf(m_reg, m1), a0 = __builtin_amdgcn_exp2f(m_reg - mt), a1 = __builtin_amdgcn_exp2f(m1 - mt), il = 1.0f / (l_reg * a0 + l1 * a1);
                if (hi == 0) { wsc[r32] = a0 * il; wsc[32 + r32] = a1 * il; } asm volatile("s_waitcnt lgkmcnt(0)" ::: "memory");
#pragma unroll
                for (int r = 0; r < 16; ++r) { const int qrow = q0 + 32 * g + crow(r, hi); const float f0 = wsc[crow(r, hi)], f1 = wsc[32 + crow(r, hi)]; float ss = 0.f;
#pragma unroll
                    for (int d0 = 0; d0 < 4; ++d0) { const float v = o[d0][r] * f0 + O1[(d0 * 16 + r) * 64] * f1; ss += v * v; const float vn = __shfl_xor(v, 1);
                        if ((r32 & 1) == 0) *(GAS unsigned*)(MIX + (size_t)qrow * 2048 + h * 128 + d0 * 32 + r32) = pg8::cvt_pk_bf16(v, vn); }
                    ss = half_sum32(ss); if (r32 == 0) psa[qrow * 8 + h] = ss; } }
            __syncthreads(); }
        }
    }
}
typedef __bf16 bf16x2_t __attribute__((ext_vector_type(2)));
__device__ __forceinline__ unsigned ord_key(float f) { const unsigned u = __float_as_uint(f); return u ^ ((unsigned)((int)u >> 31) | 0x80000000u); }
__device__ __forceinline__ float ord_val(unsigned k) { return __uint_as_float((k & 0x80000000u) ? (k ^ 0x80000000u) : ~k); }
__device__ __forceinline__ unsigned umax3(unsigned a, unsigned b, unsigned c) { return max(max(a, b), c); }
__device__ __forceinline__ unsigned pair_max(unsigned v) { auto rr = __builtin_amdgcn_permlane32_swap(v, v, false, false); return max(rr[0], rr[1]); }
__device__ __forceinline__ unsigned pair_or(unsigned v) { auto rr = __builtin_amdgcn_permlane32_swap(v, v, false, false); return rr[0] | rr[1]; }
__host__ __device__ constexpr int cand_a(int c) { return c < 16 ? 0 : c < 24 ? 1 : c < 29 ? 2 : c < 33 ? 3 : c < 36 ? 4 : c < 38 ? 5 : c < 40 ? 6 : c < 42 ? 7 : c - 34; }
__host__ __device__ constexpr int cand_b(int c) { return c < 16 ? c : c < 24 ? c - 16 : c < 29 ? c - 24 : c < 33 ? c - 29 : c < 36 ? c - 33 : c < 38 ? c - 36 : c < 40 ? c - 38 : c < 42 ? c - 40 : 0; }
__device__ __forceinline__ void topk16_of_128(const bf16* keys  , const bf16* qrow  , int r32, int hi, unsigned (&sel)[16]) {
    bf16x8 qf[8];
#pragma unroll
    for (int ks = 0; ks < 8; ++ks) qf[ks] = *(const GAS bf16x8*)(qrow + 16 * ks + 8 * hi);
    unsigned k[64];
#pragma unroll
    for (int kb = 0; kb < 4; ++kb) { f32x16 acc = {};
#pragma unroll
        for (int ks = 0; ks < 8; ++ks) acc = __builtin_amdgcn_mfma_f32_32x32x16_bf16(*(const GAS bf16x8*)(keys + (size_t)(32 * kb + r32) * 128 + 16 * ks + 8 * hi), qf[ks], acc, 0, 0, 0);
#pragma unroll
        for (int r = 0; r < 16; ++r) k[kb * 16 + r] = (ord_key(acc[r]) & ~0x7fu) | (unsigned)(127 - (32 * kb + crow(r, hi))); }
#pragma unroll
    for (int it = 0; it < 16; ++it) { unsigned m = umax3(k[0], k[1], k[2]);
#pragma unroll
        for (int i = 3; i < 63; i += 2) m = umax3(m, k[i], k[i + 1]);
        m = max(m, k[63]); m = pair_max(m); sel[it] = m;
#pragma unroll
        for (int i = 0; i < 64; ++i) k[i] = (k[i] == m) ? 0u : k[i]; }
}
__device__ __forceinline__ void topk_phase(const Args& A, Frame& F) {
    unsigned char* ws = A.ws;
    const bf16* QP = (const bf16*)(ws + WS_R1); const bf16* K1 = (const bf16*)(ws + WS_K1B); const bf16* K2 = (const bf16*)(ws + WS_K2B); int* IDX = (int*)(ws + WS_IDX); float* GATE = (float*)(ws + WS_GATE);
    const int wid = F.wave;
    for (int unit = F.vcu; unit < 256; unit += F.G) {
        const int rb = unit >> 3, h = unit & 7; const int ln = lane_id(), r32 = ln & 31, hi = ln >> 5; const int tok = rb * 256 + wid * 32 + r32;
        unsigned s1[16], s2[16];
        topk16_of_128(K1 + (size_t)h * 16384, QP + (size_t)tok * 2048 + h * 256, r32, hi, s1);
        topk16_of_128(K2 + (size_t)h * 16384, QP + (size_t)tok * 2048 + h * 256 + 128, r32, hi, s2);
        float t1v[16], t2v[16]; int i1[16], i2[16];
#pragma unroll
        for (int a = 0; a < 16; ++a) { t1v[a] = ord_val(s1[a] & ~0x7fu); i1[a] = 127 - (int)(s1[a] & 0x7fu); t2v[a] = ord_val(s2[a] & ~0x7fu); i2[a] = 127 - (int)(s2[a] & 0x7fu); }
        unsigned ck[25]; int ce[25];
#pragma unroll
        for (int j = 0; j < 25; ++j) { constexpr int dummy = 0; (void)dummy;
            const int c0 = 2 * j, c1 = 2 * j + 1;
            const float v0 = t1v[cand_a(c0)] + t2v[cand_b(c0)], v1 = t1v[cand_a(c1)] + t2v[cand_b(c1)];
            const unsigned k0 = (ord_key(v0) & ~0xffu) | (unsigned)(255 - (cand_a(c0) * 16 + cand_b(c0))), k1 = (ord_key(v1) & ~0xffu) | (unsigned)(255 - (cand_a(c1) * 16 + cand_b(c1)));
            const int e0 = i1[cand_a(c0)] * 128 + i2[cand_b(c0)], e1 = i1[cand_a(c1)] * 128 + i2[cand_b(c1)];
            ck[j] = hi ? k1 : k0; ce[j] = hi ? e1 : e0; }
        unsigned gk[16]; int ge[16];
#pragma unroll
        for (int it = 0; it < 16; ++it) { unsigned m = ck[0];
#pragma unroll
            for (int j = 1; j < 25; j += 2) m = umax3(m, ck[j], ck[j + 1]);
            m = pair_max(m); gk[it] = m; int e = 0;
#pragma unroll
            for (int j = 0; j < 25; ++j) { const bool eq = ck[j] == m; e = eq ? ce[j] : e; ck[j] = eq ? 0u : ck[j]; }
            ge[it] = e; }
        float ev[16]; float l = 0.f; const float v0 = ord_val(gk[0] & ~0xffu);
#pragma unroll
        for (int it = 0; it < 16; ++it) { ge[it] = (int)pair_or((unsigned)ge[it]); ev[it] = __builtin_amdgcn_exp2f((ord_val(gk[it] & ~0xffu) - v0) * 1.4426950408889634f); l += ev[it]; }
        const float il = 1.0f / l;
        if (hi == 0) { int* ip = IDX + (size_t)tok * 128 + h * 16; float* gp = GATE + (size_t)tok * 128 + h * 16;
#pragma unroll
            for (int q = 0; q < 4; ++q) { *(GAS v4u*)(ip + 4 * q) = (v4u){(unsigned)ge[4 * q], (unsigned)ge[4 * q + 1], (unsigned)ge[4 * q + 2], (unsigned)ge[4 * q + 3]};
                *(GAS f32x4*)(gp + 4 * q) = (f32x4){ev[4 * q] * il, ev[4 * q + 1] * il, ev[4 * q + 2] * il, ev[4 * q + 3] * il}; } }
    }
}

__device__ __forceinline__ bf16x2_t asbf(unsigned u) { return __builtin_bit_cast(bf16x2_t, u); }
__device__ __forceinline__ float dot8(v4u a, v4u b, float c) {
    c = __builtin_amdgcn_fdot2_f32_bf16(asbf(a.x), asbf(b.x), c, false); c = __builtin_amdgcn_fdot2_f32_bf16(asbf(a.y), asbf(b.y), c, false);
    c = __builtin_amdgcn_fdot2_f32_bf16(asbf(a.z), asbf(b.z), c, false); c = __builtin_amdgcn_fdot2_f32_bf16(asbf(a.w), asbf(b.w), c, false); return c;
}
__device__ __forceinline__ void fmac_s(float& acc, float ws, float x) { asm("v_fmac_f32_e32 %0, %1, %2" : "+v"(acc) : "s"(ws), "v"(x)); }
__device__ __forceinline__ void axpy8(float (&acc)[8], v4u v, float w  ) {
    fmac_s(acc[0], w, __uint_as_float(v.x << 16)); fmac_s(acc[1], w, __uint_as_float(v.x & 0xffff0000u)); fmac_s(acc[2], w, __uint_as_float(v.y << 16)); fmac_s(acc[3], w, __uint_as_float(v.y & 0xffff0000u));
    fmac_s(acc[4], w, __uint_as_float(v.z << 16)); fmac_s(acc[5], w, __uint_as_float(v.z & 0xffff0000u)); fmac_s(acc[6], w, __uint_as_float(v.w << 16)); fmac_s(acc[7], w, __uint_as_float(v.w & 0xffff0000u));
}
constexpr float U8_SCALE = 256.f, V8_SCALE = 16.f;
typedef float f32x2c __attribute__((ext_vector_type(2)));
struct Row2 { v4u c[2]; };
__device__ __forceinline__ Row2 load_row8(const GAS unsigned char* base, unsigned e, unsigned lane16) { const GAS unsigned char* p = base + (size_t)e * 2048 + lane16; Row2 r; r.c[0] = *(const GAS v4u*)p; r.c[1] = *(const GAS v4u*)(p + 1024); return r; }
__device__ __forceinline__ float fma_s(float a, float b, float c) { float r; asm("v_fma_f32 %0, %1, %2, %3" : "=v"(r) : "v"(a), "v"(b), "v"(c)); return r; }
__device__ __forceinline__ float dot4_8(const float* a, unsigned w, float s) { const f32x2c lo = __builtin_amdgcn_cvt_pk_f32_fp8((int)w, false), hi = __builtin_amdgcn_cvt_pk_f32_fp8((int)w, true);
    s = fma_s(a[0], lo.x, s); s = fma_s(a[1], lo.y, s); s = fma_s(a[2], hi.x, s); s = fma_s(a[3], hi.y, s); return s; }
__device__ __forceinline__ void axpy4_8(float* acc, unsigned w, float ws) { const f32x2c lo = __builtin_amdgcn_cvt_pk_f32_fp8((int)w, false), hi = __builtin_amdgcn_cvt_pk_f32_fp8((int)w, true);
    fmac_s(acc[0], ws, lo.x); fmac_s(acc[1], ws, lo.y); fmac_s(acc[2], ws, hi.x); fmac_s(acc[3], ws, hi.y); }
template <bool DRY> __device__ __forceinline__ void gather_phase(const Args& A, Frame& F) {
    unsigned char* ws = A.ws;
    const GAS unsigned char* UB = (const GAS unsigned char*)(ws + WS_UB); const GAS unsigned char* VB = (const GAS unsigned char*)(ws + WS_VB);
    float* H1 = (float*)(ws + WS_H1); bf16* H1B = (bf16*)(ws + WS_H1B); const float* psh1 = (const float*)(ws + WS_PSH1); const int* IDX = (const int*)(ws + WS_IDX); const float* GATE = (const float*)(ws + WS_GATE); float* rsh2 = (float*)(ws + WS_RSH2);
    const int gw = F.vcu * NWAVES + F.wave, NGW = F.G * NWAVES;
    for (int tk = gw; tk < T_TOK; tk += NGW) {
        const int lane = lane_id(); const unsigned lane16 = (unsigned)lane * 16u; const int kq = (lane >> 2) & 15;
        const float rs = (1.0f / sqrtf(wave_sum64(psh1[(size_t)tk * 64 + lane]) * (1.f / 2048.f) + 1e-6f)) * (1.f / U8_SCALE);
        float af[32], acc[32];
#pragma unroll
        for (int j = 0; j < 2; ++j) { const v4u a0 = *(const GAS v4u*)(H1B + (size_t)tk * 2048 + 1024 * j + 16 * lane), a1 = *(const GAS v4u*)(H1B + (size_t)tk * 2048 + 1024 * j + 16 * lane + 8);
            const unsigned aw[8] = {a0.x, a0.y, a0.z, a0.w, a1.x, a1.y, a1.z, a1.w};
#pragma unroll
            for (int q = 0; q < 8; ++q) { af[16 * j + 2 * q] = __uint_as_float(aw[q] << 16); af[16 * j + 2 * q + 1] = __uint_as_float(aw[q] & 0xffff0000u); }
#pragma unroll
            for (int q = 0; q < 4; ++q) { const f32x4 x = *(const GAS f32x4*)(H1 + (size_t)tk * 2048 + 1024 * j + 16 * lane + 4 * q); acc[16 * j + 4 * q] = x[0]; acc[16 * j + 4 * q + 1] = x[1]; acc[16 * j + 4 * q + 2] = x[2]; acc[16 * j + 4 * q + 3] = x[3]; } }
        for (int hd = 0; hd < 8; ++hd) {
            const int ev = IDX[(size_t)tk * 128 + hd * 16 + kq]; const float gv = GATE[(size_t)tk * 128 + hd * 16 + kq];
            float p[16];
            Row2 bA[4], bB[4];
#define LD4(buf, base, k0) do { _Pragma("unroll") for (int q = 0; q < 4; ++q) buf[q] = load_row8(base, (unsigned)__builtin_amdgcn_readlane(ev, 4 * ((k0) + q)), lane16); } while (0)
#define DOT4(buf, k0) do { _Pragma("unroll") for (int q = 0; q < 4; ++q) { float s = 0.f; _Pragma("unroll") for (int j = 0; j < 2; ++j) { s = dot4_8(af + 16 * j, buf[q].c[j].x, s); s = dot4_8(af + 16 * j + 4, buf[q].c[j].y, s); s = dot4_8(af + 16 * j + 8, buf[q].c[j].z, s); s = dot4_8(af + 16 * j + 12, buf[q].c[j].w, s); } p[(k0) + q] = s; } } while (0)
#define AX4(buf, k0) do { _Pragma("unroll") for (int q = 0; q < 4; ++q) { const float wk = __uint_as_float((unsigned)__builtin_amdgcn_readlane((int)__float_as_uint(w), 4 * ((k0) + q))); _Pragma("unroll") for (int j = 0; j < 2; ++j) { axpy4_8(acc + 16 * j, buf[q].c[j].x, wk); axpy4_8(acc + 16 * j + 4, buf[q].c[j].y, wk); axpy4_8(acc + 16 * j + 8, buf[q].c[j].z, wk); axpy4_8(acc + 16 * j + 12, buf[q].c[j].w, wk); } } } while (0)
            LD4(bA, UB, 0); LD4(bB, UB, 4); SBAR(); DOT4(bA, 0); SBAR(); LD4(bA, UB, 8); SBAR(); DOT4(bB, 4); SBAR(); LD4(bB, UB, 12); SBAR(); DOT4(bA, 8); SBAR(); LD4(bA, VB, 0); SBAR(); DOT4(bB, 12); SBAR(); LD4(bB, VB, 4); SBAR();
            { const bool b5 = lane & 32, b4 = lane & 16, b3 = lane & 8, b2 = lane & 4; float q8[8], q4[4], q2[2], q1;
#pragma unroll
              for (int i = 0; i < 8; ++i) { const float keep = b5 ? p[i + 8] : p[i], send = b5 ? p[i] : p[i + 8]; q8[i] = keep + __shfl_xor(send, 32); }
#pragma unroll
              for (int i = 0; i < 4; ++i) { const float keep = b4 ? q8[i + 4] : q8[i], send = b4 ? q8[i] : q8[i + 4]; q4[i] = keep + __shfl_xor(send, 16); }
#pragma unroll
              for (int i = 0; i < 2; ++i) { const float keep = b3 ? q4[i + 2] : q4[i], send = b3 ? q4[i] : q4[i + 2]; q2[i] = keep + __shfl_xor(send, 8); }
              { const float keep = b2 ? q2[1] : q2[0], send = b2 ? q2[0] : q2[1]; q1 = keep + __shfl_xor(send, 4); }
              q1 += __shfl_xor(q1, 2); q1 += __shfl_xor(q1, 1); p[0] = q1; }
            const float w = gv * gelu_f(p[0] * rs) * (1.f / V8_SCALE);
            SBAR(); AX4(bA, 0); SBAR(); LD4(bA, VB, 8); SBAR(); AX4(bB, 4); SBAR(); LD4(bB, VB, 12); SBAR(); AX4(bA, 8); SBAR(); AX4(bB, 12); SBAR();
#undef LD4
#undef DOT4
#undef AX4
        }
        float ss = 0.f;
        float* H1o = DRY ? (float*)(ws + WS_NA0) + (size_t)(tk & 2047) * 2048 : H1 + (size_t)tk * 2048; bf16* H1Bo = DRY ? (bf16*)(ws + WS_NGL) + (size_t)(tk & 2047) * 2048 : H1B + (size_t)tk * 2048;
#pragma unroll
        for (int j = 0; j < 2; ++j) {
#pragma unroll
            for (int q = 0; q < 2; ++q) { const f32x4 y0 = {acc[16 * j + 8 * q], acc[16 * j + 8 * q + 1], acc[16 * j + 8 * q + 2], acc[16 * j + 8 * q + 3]}, y1 = {acc[16 * j + 8 * q + 4], acc[16 * j + 8 * q + 5], acc[16 * j + 8 * q + 6], acc[16 * j + 8 * q + 7]}; ss += sq8(y0, y1);
                *(GAS f32x4*)(H1o + 1024 * j + 16 * lane + 8 * q) = y0; *(GAS f32x4*)(H1o + 1024 * j + 16 * lane + 8 * q + 4) = y1; *(GAS v4u*)(H1Bo + 1024 * j + 16 * lane + 8 * q) = pack8(y0, y1); } }
        ss = wave_sum64(ss); if (lane == 0 && !DRY) rsh2[tk] = 1.0f / sqrtf(ss * (1.f / 2048.f) + 1e-6f);
    }
}
__device__ __forceinline__ void final_phase(const Args& A, Frame& F) {
    unsigned char* ws = A.ws; const float* psh3 = (const float*)(ws + WS_PSH3); const float* gf = (const float*)A.in[25]; float* out = A.out;
    const int gw = F.vcu * NWAVES + F.wave, NGW = F.G * NWAVES;
    for (int tk = gw; tk < T_TOK; tk += NGW) { const int lane = lane_id();
        const float rs = 1.0f / sqrtf(wave_sum64(psh3[(size_t)tk * 64 + lane]) * (1.f / 2048.f) + 1e-6f);
#pragma unroll
        for (int j = 0; j < 8; ++j) { GAS f32x4* o = (GAS f32x4*)(out + (size_t)tk * 2048 + 256 * j) + lane; const f32x4 g = *((const GAS f32x4*)(gf + 256 * j) + lane); *o = *o * rs * g; } }
}
#define PHASES_2_9 \
    if (IN(2)) { \
        { pg8::Gemm g{(const bf16*)(ws + WS_CQ), (const bf16*)(ws + WS_WT_UQ), T_TOK, 1536, 512}; pg8::StaticOrder S; S.init(T_TOK, 1536, F.G, (int)blockIdx.x); \
          LAS float* tab = (LAS float*)(F.lds + TAB_OFF); setup_rowtab(tab, (const float*)(ws + WS_PSCQ), 16, 1.f / 512.f, S, F.wave); __syncthreads(); \
          EpiQ E{tab, (bf16*)(ws + WS_Q), (const f32x2v*)(ws + WS_CS)}; pg8::gemm_phase<EpiQ, pg8::StaticOrder, true, true>(F.lds + RING_OFF, g, S, E, F.wave); } \
        __syncthreads(); \
        { pg8::Gemm g{(const bf16*)(ws + WS_CKV), (const bf16*)(ws + WS_WT_UKV), T_TOK, 2048, 256}; pg8::StaticOrder S; S.init(T_TOK, 2048, F.G, (int)blockIdx.x); \
          LAS float* tab = (LAS float*)(F.lds + TAB_OFF); setup_rowtab(tab, (const float*)(ws + WS_PSCKV), 8, 1.f / 256.f, S, F.wave); __syncthreads(); \
          EpiKV E{tab, (bf16*)(ws + WS_KN), (bf16*)(ws + WS_VV)}; pg8::gemm_phase<EpiKV, pg8::StaticOrder, true, true>(F.lds + RING_OFF, g, S, E, F.wave); } \
        __syncthreads(); \
        sgu_phase(args, F); \
        SEAM(2); } \
    if (IN(3)) { if (REPEAT_PH == 3) { attn_phase(args, F); __syncthreads(); } attn_phase(args, F); SEAM(3); } \
    if (IN(4)) { \
        { pg8::Gemm g{(const bf16*)(ws + WS_MIX), (const bf16*)(ws + WS_WT_OUT), T_TOK, 2048, 2048}; pg8::StaticOrder S; S.init(T_TOK, 2048, F.G, (int)blockIdx.x); \
          LAS float* tab = (LAS float*)(F.lds + TAB_OFF); setup_rowtab(tab, (const float*)(ws + WS_PSA), 8, 1.f / 1024.f, S, F.wave); setup_rowtab(tab + 256, (const float*)(ws + WS_PSS), 16, 1.f / 1024.f, S, F.wave); __syncthreads(); \
          EpiOut E{tab, (const float*)args.in[0], (float*)(ws + WS_H1), (bf16*)(ws + WS_H1B), (float*)(ws + WS_PSH1)}; pg8::gemm_phase<EpiOut, pg8::StaticOrder, true, true>(F.lds + RING_OFF, g, S, E, F.wave); } \
        SEAM(4); } \
    if (IN(5)) { \
        { pg8::Gemm g{(const bf16*)(ws + WS_H1B), (const bf16*)(ws + WS_WT_PQ), T_TOK, 2048, 2048}; pg8::StaticOrder S; S.init(T_TOK, 2048, F.G, (int)blockIdx.x); \
          LAS float* tab = (LAS float*)(F.lds + TAB_OFF); setup_rowtab(tab, (const float*)(ws + WS_PSH1), 64, 1.f / 2048.f, S, F.wave); __syncthreads(); \
          EpiPQ E{tab, (bf16*)(ws + WS_R1)}; pg8::gemm_phase<EpiPQ, pg8::StaticOrder, true, true>(F.lds + RING_OFF, g, S, E, F.wave); } \
        SEAM(5); } \
    PHASES_6_9
#define PHASES_6_9 \
    if (IN(6)) { if (REPEAT_PH == 6) { topk_phase(args, F); __syncthreads(); } topk_phase(args, F); SEAM(6); } \
    if (IN(7)) { if (REPEAT_PH == 7) { gather_phase<true>(args, F); __syncthreads(); } gather_phase<false>(args, F); SEAM(7); } \
    if (IN(8)) { \
        { pg8::Gemm g{(const bf16*)(ws + WS_H1B), (const bf16*)(ws + WS_WT_PG), T_TOK, 2048, 2048}; pg8::StaticOrder S; S.init(T_TOK, 2048, F.G, (int)blockIdx.x); \
          EpiPLE E{(const float*)(ws + WS_RSH2), (const float*)(ws + WS_H1), (const bf16*)(ws + WS_PPROJ), args.out, (float*)(ws + WS_PSH3)}; pg8::gemm_phase<EpiPLE, pg8::StaticOrder, true, true>(F.lds + RING_OFF, g, S, E, F.wave); } \
        SEAM(8); } \
    if (IN(9)) { final_phase(args, F); }
constexpr int N_PHASES = 10;
__global__ void __launch_bounds__(NWAVES * 64, 2) mega_fwd(Args args) {
    extern __shared__ __attribute__((aligned(16))) unsigned char lds[];
    Frame F;
    F.lds = (LAS unsigned char*)lds; F.MISC = (volatile LAS unsigned*)(F.lds + MISC_OFF);
    F.wave = __builtin_amdgcn_readfirstlane(threadIdx.x >> 6); F.lane = lane_id(); F.tid = F.wave * 64 + F.lane;
    F.G = gridDim.x; { const int bx = blockIdx.x; F.vcu = (F.G % 8 == 0) ? (bx % 8) * (F.G / 8) + bx / 8 : bx; }
    unsigned char* ws = args.ws; F.ctl = (gu32*)(ws + WS_CTL);
    for (int u = F.wave * 64 + lane_id(); u < (LDS_BYTES - LDSCTL_OFF) / 4; u += NWAVES * 64) ((LAS unsigned*)(F.lds + LDSCTL_OFF))[u] = 0u;
    __syncthreads();
    const int lo = args.ph_lo, hi = args.ph_hi;
    XcdBarrier bar; bar.bar = (unsigned*)(F.ctl + CW_BAR); bar.x = 0; bar.st = nullptr;
    if (hi - lo > 1) bar = xcd_barrier_post((unsigned*)(F.ctl + CW_BAR), F.MISC + 8, F.wave);
#define IN(k) (lo <= (k) && (k) < hi)
#define SEAM(k) do { if (IN(k) && IN((k) + 1)) xcd_barrier(bar, F.wave); } while (0)
    if (IN(0)) { if (REPEAT_PH == 0) { p0_prologue(args, F); __syncthreads(); } p0_prologue(args, F); SEAM(0); }
    if (IN(1)) {
        { pg8::Gemm g{(const bf16*)(ws + WS_R1), (const bf16*)(ws + WS_WT_IN), T_TOK, 3072, 2048}; pg8::StaticOrder S; S.init(T_TOK, 3072, F.G, (int)blockIdx.x);
          EpiG1 E{(const float*)(ws + WS_RSX), (bf16*)(ws + WS_CQ), (bf16*)(ws + WS_CKV), (bf16*)(ws + WS_KR), (bf16*)(ws + WS_UG), (bf16*)(ws + WS_VG), (float*)(ws + WS_PSCQ), (float*)(ws + WS_PSCKV), (f32x2v*)(ws + WS_PSV), (const f32x2v*)(ws + WS_CS)};
          pg8::gemm_phase<EpiG1, pg8::StaticOrder, true, true>(F.lds + RING_OFF, g, S, E, F.wave); }
        { pg8::Gemm g{(const bf16*)(ws + WS_PB), (const bf16*)(ws + WS_WT_PP), T_TOK, 2048, 256}; pg8::StaticOrder S; S.init(T_TOK, 2048, F.G, (int)blockIdx.x);
          EpiPlain E{(bf16*)(ws + WS_PPROJ), 2048};
          pg8::gemm_phase<EpiPlain, pg8::StaticOrder, true, true>(F.lds + RING_OFF, g, S, E, F.wave); }
        SEAM(1);
    }
    PHASES_2_9
#undef IN
#undef SEAM
}

#if CUT > 0 && CUT < 9
__device__ __forceinline__ int rope_unpc(int pc) { const int c5 = pc >> 5, fq = (pc >> 3) & 3, nn = (pc >> 2) & 1, e = pc & 3; return 16 * c5 + 4 * fq + e + 32 * nn; }
__global__ void __launch_bounds__(256) conv1(const unsigned char* ws, int b, float* ZP) {
    const int r = blockIdx.x; const size_t row = (size_t)b * 2048 + r; float* z = ZP + (size_t)r * 2880;
    const bf16 *CQ = (const bf16*)(ws + WS_CQ) + row * 512, *CKV = (const bf16*)(ws + WS_CKV) + row * 256, *KR = (const bf16*)(ws + WS_KR) + row * 64, *UG = (const bf16*)(ws + WS_UG) + row * 1024, *VG = (const bf16*)(ws + WS_VG) + row * 1024;
    for (int i = threadIdx.x; i < 512; i += 256) z[i] = bf2f(CQ[i]);
    for (int i = threadIdx.x; i < 256; i += 256) z[512 + i] = bf2f(CKV[i]);
    if (threadIdx.x < 64) z[768 + rope_unpc(threadIdx.x)] = bf2f(KR[threadIdx.x]);
    for (int i = threadIdx.x; i < 1024; i += 256) { z[832 + i] = bf2f(UG[i]); z[1856 + i] = bf2f(VG[i]); }
}
__global__ void __launch_bounds__(256) conv2(const unsigned char* ws, int b, float* ZP, float* QN, float* KV, float* OSGU) {
    const int r = blockIdx.x; const size_t row = (size_t)b * 2048 + r;
    const bf16 *Q = (const bf16*)(ws + WS_Q) + row * 1536, *KN = (const bf16*)(ws + WS_KN) + row * 1024, *VV = (const bf16*)(ws + WS_VV) + row * 1024, *KR = (const bf16*)(ws + WS_KR) + row * 64, *MIX = (const bf16*)(ws + WS_MIX) + row * 2048;
    for (int i = threadIdx.x; i < 1536; i += 256) { const int h = i / 192, lc = i - h * 192; const int dst = lc < 128 ? i : h * 192 + 128 + rope_unpc(lc - 128); QN[(size_t)r * 1536 + dst] = bf2f(Q[i]) * (1.f / QK_C2); }
    for (int i = threadIdx.x; i < 1024; i += 256) { const int h = i >> 7, d = i & 127; KV[(size_t)r * 2048 + h * 256 + d] = bf2f(KN[i]); KV[(size_t)r * 2048 + h * 256 + 128 + d] = bf2f(VV[i]); OSGU[(size_t)r * 1024 + i] = bf2f(MIX[1024 + i]); }
    if (threadIdx.x < 64) ZP[(size_t)r * 2880 + 768 + rope_unpc(threadIdx.x)] = bf2f(KR[threadIdx.x]);
}
__global__ void __launch_bounds__(256) conv3(const unsigned char* ws, int b, float* OATT, float* OSGU) {
    const int r = blockIdx.x; const size_t row = (size_t)b * 2048 + r; const bf16* MIX = (const bf16*)(ws + WS_MIX) + row * 2048;
    for (int i = threadIdx.x; i < 1024; i += 256) { OATT[(size_t)r * 1024 + i] = bf2f(MIX[i]); OSGU[(size_t)r * 1024 + i] = bf2f(MIX[1024 + i]); }
}
__global__ void __launch_bounds__(256) conv5(const unsigned char* ws, int b, float* QPN) {
    const int r = blockIdx.x; const size_t row = (size_t)b * 2048 + r; const bf16* QP = (const bf16*)(ws + WS_R1) + row * 2048;
    for (int i = threadIdx.x; i < 2048; i += 256) QPN[(size_t)r * 2048 + i] = bf2f(QP[i]);
}
static void launch_conv(int b, void* const* d_in, void* d_ws, hipStream_t stream) {
    unsigned char* ws = (unsigned char*)d_ws; (void)d_in;
    if (CUT == 1) conv1<<<2048, 256, 0, stream>>>(ws, b, (float*)(ws + WS_NZP));
    if (CUT == 2) conv2<<<2048, 256, 0, stream>>>(ws, b, (float*)(ws + WS_NZP), (float*)(ws + WS_NQN), (float*)(ws + WS_NKV), (float*)(ws + WS_NOSGU));
    if (CUT == 3) conv3<<<2048, 256, 0, stream>>>(ws, b, (float*)(ws + WS_NOATT), (float*)(ws + WS_NOSGU));
    if (CUT == 5) conv5<<<2048, 256, 0, stream>>>(ws, b, (float*)(ws + WS_NQPN));
}
#endif
#if CUT > 0
static void launch_fast(void* const* d_in, void* d_out, void* d_ws, hipStream_t stream) {
    static int grid = 0;
    if (grid == 0) {
        int dev = 0, cus = 0, per_cu = 0;
        if (hipGetDevice(&dev) != hipSuccess || hipDeviceGetAttribute(&cus, hipDeviceAttributeMultiprocessorCount, dev) != hipSuccess) { fprintf(stderr, "launch_fast: device query failed\n"); grid = -1; return; }
        if (hipFuncSetAttribute((const void*)mega_fwd, hipFuncAttributeMaxDynamicSharedMemorySize, LDS_BYTES) != hipSuccess) { fprintf(stderr, "launch_fast: hipFuncSetAttribute failed\n"); grid = -1; return; }
        if (hipOccupancyMaxActiveBlocksPerMultiprocessor(&per_cu, (const void*)mega_fwd, NWAVES * 64, LDS_BYTES) != hipSuccess || per_cu < 1) fprintf(stderr, "launch_fast: occupancy query says %d blocks per CU\n", per_cu);
        (void)hipGetLastError();
        grid = cus;
        if (grid != 256) fprintf(stderr, "launch_fast: %d CUs (built for 256)\n", grid);
    }
    if (grid < 0) return;
    (void)hipMemsetAsync((char*)d_ws + WS_CTL, 0, CTL_ZERO_BYTES, stream);
    Args a{};
    for (int i = 0; i < 26; ++i) a.in[i] = d_in[i];
    a.out = (float*)d_out; a.ws = (unsigned char*)d_ws;
    constexpr int LAST = CUT + 1;
#if ONE_LAUNCH
    a.ph_lo = 0; a.ph_hi = LAST; hipLaunchKernelGGL(mega_fwd, dim3(grid), dim3(NWAVES * 64), LDS_BYTES, stream, a);
#else
    for (int ph = 0; ph < LAST; ++ph) { a.ph_lo = ph; a.ph_hi = ph + 1; hipLaunchKernelGGL(mega_fwd, dim3(grid), dim3(NWAVES * 64), LDS_BYTES, stream, a); }
#endif
    const hipError_t le = hipPeekAtLastError(); if (le != hipSuccess) fprintf(stderr, "launch_fast: launch failed: %s\n", hipGetErrorName(le));
}
#endif
#if CUT > 0
static void launch_fast(void* const* d_in, void* d_out, void* d_ws, hipStream_t stream);
static void launch_conv(int b, void* const* d_in, void* d_ws, hipStream_t stream);
#endif
extern "C" void kernel_launch(void* const* d_in, const int* in_sizes, int n_in, void* d_out, int out_size, void* d_ws, size_t ws_size, hipStream_t stream) {
    if (n_in != 26 || out_size != T_TOK * DM || ws_size < WS_END) { fprintf(stderr, "kernel_launch: unexpected shapes n_in %d out %d ws %zu\n", n_in, out_size, ws_size); return; }
    unsigned char* ws = (unsigned char*)d_ws;
    const float* x = (const float*)d_in[0]; const float* p = (const float*)d_in[1]; const int* pos = (const int*)d_in[2];
    const float *g_mix = (const float*)d_in[3], *w_in = (const float*)d_in[4], *g_cq = (const float*)d_in[5], *w_uq = (const float*)d_in[6], *g_ckv = (const float*)d_in[7], *w_ukv = (const float*)d_in[8];
    const float *g_ln = (const float*)d_in[9], *b_ln = (const float*)d_in[10], *w_sgu = (const float*)d_in[11], *b_sgu = (const float*)d_in[12], *g_oa = (const float*)d_in[13], *g_os = (const float*)d_in[14];
    const float *w_out = (const float*)d_in[15], *g_ffn = (const float*)d_in[16], *w_pq = (const float*)d_in[17], *k1 = (const float*)d_in[18], *k2 = (const float*)d_in[19], *pu = (const float*)d_in[20], *pv = (const float*)d_in[21];
    const float *g_ple = (const float*)d_in[22], *w_pg = (const float*)d_in[23], *w_pp = (const float*)d_in[24], *g_fin = (const float*)d_in[25];
    float* out = (float*)d_out;
#if CUT > 0
    launch_fast(d_in, d_out, d_ws, stream);
#endif
#if CUT < 9
    constexpr int S0 = CUT + 1; constexpr int TB = nv::TBAT;
    float* A0 = (float*)(ws + WS_NA0); float* GL = (float*)(ws + WS_NGL); float* PP = (float*)(ws + WS_NPP);
    float* ZP = (float*)(ws + WS_NZP); float* CQN = (float*)(ws + WS_NCQN); float* CKVN = (float*)(ws + WS_NCKVN); float* QN = (float*)(ws + WS_NQN); float* KV = (float*)(ws + WS_NKV);
    float* VLN = (float*)(ws + WS_NVLN); float* OSGU = (float*)(ws + WS_NOSGU); float* OATT = (float*)(ws + WS_NOATT); float* QPN = (float*)(ws + WS_NQPN);
    for (int b = 0; b < NBATCH; ++b) {
        const size_t t0 = (size_t)b * TB; const float* xb = x + t0 * DM; const int* posb = pos + t0; const float* pb = p + t0 * 256;
        float* H1 = (float*)(ws + WS_H1) + t0 * DM; int* IDX = (int*)(ws + WS_IDX) + t0 * 128; float* GATE = (float*)(ws + WS_GATE) + t0 * 128; float* outb = out + t0 * DM;
#if CUT > 0
        launch_conv(b, d_in, d_ws, stream);
#endif
        if (S0 <= 1) {
            nv::nk_rmsnorm<<<TB, 256, 0, stream>>>(xb, DM, g_mix, A0, DM, DM);
            nv::nk_gemm<<<dim3(2880 / 64, TB / 64), 256, 0, stream>>>(A0, DM, w_in, 2880, ZP, 2880, nullptr, 0, DM);
            nv::nk_z_post<<<TB, 256, 0, stream>>>(ZP, posb);
        }
        if (S0 <= 2) {
            nv::nk_rmsnorm<<<TB, 256, 0, stream>>>(ZP, 2880, g_cq, CQN, 512, 512);
            nv::nk_gemm<<<dim3(1536 / 64, TB / 64), 256, 0, stream>>>(CQN, 512, w_uq, 1536, QN, 1536, nullptr, 0, 512);
            nv::nk_q_rope<<<TB, 256, 0, stream>>>(QN, posb);
            nv::nk_rmsnorm<<<TB, 256, 0, stream>>>(ZP + 512, 2880, g_ckv, CKVN, 256, 256);
            nv::nk_gemm<<<dim3(2048 / 64, TB / 64), 256, 0, stream>>>(CKVN, 256, w_ukv, 2048, KV, 2048, nullptr, 0, 256);
            nv::nk_ln_group<<<TB * 8 / 4, 256, 0, stream>>>(ZP, g_ln, b_ln, VLN);
            nv::nk_sgu<<<TB * 1024 / 256, 256, 0, stream>>>(ZP, VLN, w_sgu, b_sgu, OSGU);
        }
        if (S0 <= 3) nv::nk_attn<<<dim3(TB, 8), 256, 0, stream>>>(QN, KV, ZP, OATT);
        if (S0 <= 4) {
            nv::nk_rmsnorm<<<TB, 256, 0, stream>>>(OATT, 1024, g_oa, A0, DM, 1024);
            nv::nk_rmsnorm<<<TB, 256, 0, stream>>>(OSGU, 1024, g_os, A0 + 1024, DM, 1024);
            nv::nk_gemm<<<dim3(DM / 64, TB / 64), 256, 0, stream>>>(A0, DM, w_out, DM, H1, DM, xb, DM, DM);
        }
        if (S0 <= 5) {
            nv::nk_rmsnorm<<<TB, 256, 0, stream>>>(H1, DM, g_ffn, A0, DM, DM);
            nv::nk_gemm<<<dim3(DM / 64, TB / 64), 256, 0, stream>>>(A0, DM, w_pq, DM, QPN, DM, nullptr, 0, DM);
        }
        if (S0 <= 6) nv::nk_topk<<<TB * 8, 128, 0, stream>>>(QPN, k1, k2, IDX, GATE);
        if (S0 <= 7) {
            nv::nk_rmsnorm<<<TB, 256, 0, stream>>>(H1, DM, g_ffn, A0, DM, DM);
            nv::nk_gather<<<TB, 256, 0, stream>>>(H1, A0, IDX, GATE, pu, pv);
        }
        if (S0 <= 8) {
            nv::nk_rmsnorm<<<TB, 256, 0, stream>>>(H1, DM, g_ple, A0, DM, DM);
            nv::nk_gemm<<<dim3(DM / 64, TB / 64), 256, 0, stream>>>(A0, DM, w_pg, DM, GL, DM, nullptr, 0, DM);
            nv::nk_gemm<<<dim3(DM / 64, TB / 64), 256, 0, stream>>>(pb, 256, w_pp, DM, PP, DM, nullptr, 0, 256);
            nv::nk_ple<<<TB * DM / 256, 256, 0, stream>>>(H1, GL, PP, outb);
        }
        nv::nk_rmsnorm<<<TB, 256, 0, stream>>>(outb, DM, g_fin, outb, DM, DM);
    }
#endif
}
```

```cpp
#include <hip/hip_runtime.h>
#include <hip/hip_bf16.h>
#include <cstdio>
#include <cstdint>
#include <cmath>
#ifndef CUT
#define CUT 9
#endif
#ifndef ONE_LAUNCH
#define ONE_LAUNCH 1
#endif
#ifndef REPEAT_PH
#define REPEAT_PH -1
#endif
#ifndef GATHER_FN
#define GATHER_FN gather_sliced2_phase
#endif
constexpr int T_TOK = 8192, DM = 2048, SEQ = 2048, NBATCH = 4;
constexpr size_t MiB = 1u << 20;
constexpr size_t WS_CTL = 0;
constexpr size_t WS_WT_IN = 1 * MiB, WS_WT_UQ = 13 * MiB, WS_WT_UKV = 14 * MiB + 512 * 1024, WS_WT_PP = 15 * MiB + 512 * 1024;
constexpr size_t WS_K1B = 16 * MiB + 512 * 1024, WS_K2B = WS_K1B + 256 * 1024, WS_WSGU = 17 * MiB;
constexpr size_t WS_WT_OUT = 18 * MiB, WS_WT_PQ = 26 * MiB, WS_WT_PG = 34 * MiB;
constexpr size_t WS_UB = 42 * MiB, WS_VB = 106 * MiB;
constexpr size_t WS_R1 = 170 * MiB;
constexpr size_t WS_PB = 202 * MiB, WS_CS = 206 * MiB, WS_RSX = 208 * MiB, WS_RSH2 = 208 * MiB + 512 * 1024;
constexpr size_t WS_CQ = 209 * MiB, WS_CKV = 217 * MiB, WS_KR = 221 * MiB, WS_UG = 222 * MiB, WS_VG = 238 * MiB;
constexpr size_t WS_PSCQ = 254 * MiB, WS_PSCKV = 254 * MiB + 512 * 1024, WS_PSV = 255 * MiB;
constexpr size_t WS_Q = 257 * MiB, WS_KN = 281 * MiB, WS_VV = 297 * MiB, WS_H1B = 257 * MiB;
constexpr size_t WS_MIX = 313 * MiB, WS_PSA = 345 * MiB, WS_PSS = 345 * MiB + 512 * 1024;
constexpr size_t WS_H1 = 346 * MiB, WS_PSH1 = 410 * MiB, WS_IDX = 412 * MiB, WS_GATE = 416 * MiB, WS_PPROJ = 420 * MiB, WS_PSH3 = 452 * MiB;
constexpr size_t WS_NA0 = 454 * MiB, WS_NGL = 470 * MiB, WS_NPP = 486 * MiB, WS_END = 502 * MiB;
constexpr size_t WS_NZP = 42 * MiB, WS_NCQN = 65 * MiB, WS_NCKVN = 69 * MiB, WS_NQN = 71 * MiB, WS_NKV = 83 * MiB, WS_NVLN = 99 * MiB, WS_NOSGU = 107 * MiB, WS_NOATT = 115 * MiB, WS_NQPN = 123 * MiB;
namespace nv {
constexpr int TBAT = 2048;
__device__ __forceinline__ float gelu_t(float x) { const float c = 0.7978845608028654f; const float u = c * (x + 0.044715f * x * x * x); return 0.5f * x * (1.f + tanhf(u)); }
__device__ __forceinline__ float wave_sum(float v) {
#pragma unroll
    for (int o = 1; o < 64; o <<= 1) v += __shfl_xor(v, o);
    return v;
}
__device__ __forceinline__ float wave_max(float v) {
#pragma unroll
    for (int o = 1; o < 64; o <<= 1) v = fmaxf(v, __shfl_xor(v, o));
    return v;
}
__device__ __forceinline__ float blk_sum(float v, float* sh) {
    v = wave_sum(v); __syncthreads();
    if ((threadIdx.x & 63) == 0) sh[threadIdx.x >> 6] = v; __syncthreads();
    float r = 0.f; for (int i = 0; i < (int)(blockDim.x >> 6); ++i) r += sh[i]; return r;
}
__device__ __forceinline__ float blk_max(float v, float* sh) {
    v = wave_max(v); __syncthreads();
    if ((threadIdx.x & 63) == 0) sh[threadIdx.x >> 6] = v; __syncthreads();
    float r = sh[0]; for (int i = 1; i < (int)(blockDim.x >> 6); ++i) r = fmaxf(r, sh[i]); return r;
}
__global__ void __launch_bounds__(256) nk_rmsnorm(const float* x, size_t ldx, const float* g, float* out, size_t ldo, int D) {
    __shared__ float sh[8];
    const float* xr = x + (size_t)blockIdx.x * ldx; float* orow = out + (size_t)blockIdx.x * ldo;
    float s = 0.f; for (int i = threadIdx.x; i < D; i += 256) { const float v = xr[i]; s += v * v; }
    s = blk_sum(s, sh); const float r = rsqrtf(s / (float)D + 1e-6f);
    for (int i = threadIdx.x; i < D; i += 256) orow[i] = xr[i] * r * g[i];
}
__global__ void __launch_bounds__(256) nk_gemm(const float* A, size_t lda, const float* B, size_t ldb, float* C, size_t ldc, const float* R, size_t ldr, int K) {
    __shared__ float As[16][68], Bs[16][68];
    const int tid = threadIdx.x, tx = tid & 15, ty = tid >> 4, m0 = blockIdx.y * 64, n0 = blockIdx.x * 64;
    float acc[4][4] = {};
    for (int k0 = 0; k0 < K; k0 += 16) {
        { const int r = tid >> 2, c = (tid & 3) * 4; const float4 v = *(const float4*)(A + (size_t)(m0 + r) * lda + k0 + c); As[c][r] = v.x; As[c + 1][r] = v.y; As[c + 2][r] = v.z; As[c + 3][r] = v.w; }
        { const int r = tid >> 4, c = (tid & 15) * 4; const float4 v = *(const float4*)(B + (size_t)(k0 + r) * ldb + n0 + c); Bs[r][c] = v.x; Bs[r][c + 1] = v.y; Bs[r][c + 2] = v.z; Bs[r][c + 3] = v.w; }
        __syncthreads();
#pragma unroll
        for (int k = 0; k < 16; ++k) { float a[4], b[4];
#pragma unroll
            for (int i = 0; i < 4; ++i) { a[i] = As[k][ty * 4 + i]; b[i] = Bs[k][tx * 4 + i]; }
#pragma unroll
            for (int i = 0; i < 4; ++i)
#pragma unroll
                for (int j = 0; j < 4; ++j) acc[i][j] += a[i] * b[j]; }
        __syncthreads();
    }
#pragma unroll
    for (int i = 0; i < 4; ++i)
#pragma unroll
        for (int j = 0; j < 4; ++j) { const size_t r = m0 + ty * 4 + i, c = n0 + tx * 4 + j; C[r * ldc + c] = acc[i][j] + (R ? R[r * ldr + c] : 0.f); }
}
__device__ __forceinline__ void rope_cs(int pos, int i, float& c, float& s) { const double f = pow(10000.0, -(double)i / 32.0); const double a = (double)pos * f; c = (float)cos(a); s = (float)sin(a); }
__global__ void __launch_bounds__(256) nk_z_post(float* Z, const int* pos) {
    float* z = Z + (size_t)blockIdx.x * 2880; const int t = threadIdx.x;
    if (t < 32) { float c, s; rope_cs(pos[blockIdx.x], t, c, s); const float x1 = z[768 + t], x2 = z[800 + t]; z[768 + t] = x1 * c - x2 * s; z[800 + t] = x2 * c + x1 * s; }
    for (int i = 832 + t; i < 2880; i += 256) z[i] = gelu_t(z[i]);
}
__global__ void __launch_bounds__(256) nk_q_rope(float* Q, const int* pos) {
    float* q = Q + (size_t)blockIdx.x * 1536; const int h = threadIdx.x >> 5, i = threadIdx.x & 31;
    float c, s; rope_cs(pos[blockIdx.x], i, c, s); float* p = q + h * 192 + 128; const float x1 = p[i], x2 = p[32 + i]; p[i] = x1 * c - x2 * s; p[32 + i] = x2 * c + x1 * s;
}
__global__ void __launch_bounds__(256) nk_ln_group(const float* Z, const float* gln, const float* bln, float* VLN) {
    const int wv = blockIdx.x * 4 + (threadIdx.x >> 6), lane = threadIdx.x & 63, row = wv >> 3, g = wv & 7;
    const float* v = Z + (size_t)row * 2880 + 1856 + g * 128; const float a = v[lane], b = v[lane + 64];
    const float mu = wave_sum(a + b) * (1.f / 128.f); const float da = a - mu, db = b - mu; const float var = wave_sum(da * da + db * db) * (1.f / 128.f); const float r = rsqrtf(var + 1e-6f);
    float* o = VLN + (size_t)row * 1024 + g * 128; o[lane] = da * r * gln[g * 128 + lane] + bln[g * 128 + lane]; o[lane + 64] = db * r * gln[g * 128 + lane + 64] + bln[g * 128 + lane + 64];
}
__global__ void __launch_bounds__(256) nk_sgu(const float* Z, const float* VLN, const float* ws, const float* bs, float* OS) {
    const size_t idx = (size_t)blockIdx.x * 256 + threadIdx.x; const int row = (int)(idx >> 10), col = (int)(idx & 1023), g = col >> 7, t = row & 127, r0 = row - t;
    const float* w = ws + ((size_t)g * 128 + t) * 128; float acc = 0.f;
    for (int s = 0; s <= t; ++s) acc += w[s] * VLN[(size_t)(r0 + s) * 1024 + col];
    OS[idx] = Z[(size_t)row * 2880 + 832 + col] * (acc + bs[g * 128 + t]);
}
__global__ void __launch_bounds__(256) nk_attn(const float* Q, const float* KV, const float* Z, float* O) {
    __shared__ float qs[192], sc[2048], sh[8], part[128];
    const int i = blockIdx.x, h = blockIdx.y, tid = threadIdx.x, lane = tid & 63, wv = tid >> 6;
    if (tid < 192) qs[tid] = Q[(size_t)i * 1536 + h * 192 + tid]; __syncthreads();
    const float scale = 0.07216878364870323f;
    for (int j = wv; j <= i; j += 4) { const float* kn = KV + (size_t)j * 2048 + h * 256; const float* kr = Z + (size_t)j * 2880 + 768;
        float p = qs[lane] * kn[lane] + qs[64 + lane] * kn[64 + lane] + qs[128 + lane] * kr[lane]; p = wave_sum(p); if (lane == 0) sc[j] = p * scale; }
    __syncthreads();
    float m = -INFINITY; for (int j = tid; j <= i; j += 256) m = fmaxf(m, sc[j]); m = blk_max(m, sh);
    float l = 0.f; for (int j = tid; j <= i; j += 256) { const float e = expf(sc[j] - m); sc[j] = e; l += e; } l = blk_sum(l, sh);
    const int d = tid & 127, half = tid >> 7; float acc = 0.f;
    for (int j = half; j <= i; j += 2) acc += sc[j] * KV[(size_t)j * 2048 + h * 256 + 128 + d];
    if (half) part[d] = acc; __syncthreads();
    if (!half) O[(size_t)i * 1024 + h * 128 + d] = (acc + part[d]) / l;
}
__global__ void __launch_bounds__(128) nk_topk(const float* QP, const float* k1, const float* k2, int* IDX, float* GATE) {
    __shared__ float q[256], s1[128], s2[128], cand[256], t1[16], t2[16]; __shared__ int i1[16], i2[16];
    const int row = blockIdx.x >> 3, h = blockIdx.x & 7, n = threadIdx.x;
    q[n] = QP[(size_t)row * 2048 + h * 256 + n]; q[n + 128] = QP[(size_t)row * 2048 + h * 256 + 128 + n]; __syncthreads();
    { const float* a = k1 + ((size_t)h * 128 + n) * 128; const float* b = k2 + ((size_t)h * 128 + n) * 128; float x = 0.f, y = 0.f;
      for (int d = 0; d < 128; ++d) { x += q[d] * a[d]; y += q[128 + d] * b[d]; } s1[n] = x; s2[n] = y; }
    __syncthreads();
    if (n == 0 || n == 64) { float* s = n ? s2 : s1; float* tv = n ? t2 : t1; int* ti = n ? i2 : i1;
        for (int r = 0; r < 16; ++r) { float best = -INFINITY; int bi = 0; for (int j = 0; j < 128; ++j) if (s[j] > best) { best = s[j]; bi = j; } tv[r] = best; ti[r] = bi; s[bi] = -INFINITY; } }
    __syncthreads();
    cand[n] = t1[n >> 4] + t2[n & 15]; cand[n + 128] = t1[(n + 128) >> 4] + t2[n & 15]; __syncthreads();
    if (n == 0) { float tv[16]; int te[16];
        for (int r = 0; r < 16; ++r) { float best = -INFINITY; int bi = 0; for (int j = 0; j < 256; ++j) if (cand[j] > best) { best = cand[j]; bi = j; } tv[r] = best; te[r] = i1[bi >> 4] * 128 + i2[bi & 15]; cand[bi] = -INFINITY; }
        float l = 0.f, e[16]; for (int r = 0; r < 16; ++r) { e[r] = expf(tv[r] - tv[0]); l += e[r]; }
        for (int r = 0; r < 16; ++r) { IDX[(size_t)row * 128 + h * 16 + r] = te[r]; GATE[(size_t)row * 128 + h * 16 + r] = e[r] / l; } }
}
__global__ void __launch_bounds__(256) nk_gather(float* H, const float* A2, const int* IDX, const float* GATE, const float* U, const float* V) {
    __shared__ float a[2048], red[4][2048];
    const int row = blockIdx.x, tid = threadIdx.x, lane = tid & 63, wv = tid >> 6;
    for (int i = tid; i < 2048; i += 256) a[i] = A2[(size_t)row * 2048 + i]; __syncthreads();
    float acc[32];
#pragma unroll
    for (int i = 0; i < 32; ++i) acc[i] = 0.f;
    for (int k = 0; k < 32; ++k) { const int j = wv * 32 + k; const int e = IDX[(size_t)row * 128 + j]; const float gt = GATE[(size_t)row * 128 + j];
        const float* u = U + (size_t)e * 2048; const float* v = V + (size_t)e * 2048; float p = 0.f;
#pragma unroll
        for (int i = 0; i < 32; ++i) p += u[lane + 64 * i] * a[lane + 64 * i];
        p = wave_sum(p); const float w = gt * gelu_t(p);
#pragma unroll
        for (int i = 0; i < 32; ++i) acc[i] += w * v[lane + 64 * i]; }
#pragma unroll
    for (int i = 0; i < 32; ++i) red[wv][lane + 64 * i] = acc[i];
    __syncthreads();
    for (int i = tid; i < 2048; i += 256) H[(size_t)row * 2048 + i] += red[0][i] + red[1][i] + red[2][i] + red[3][i];
}
__global__ void __launch_bounds__(256) nk_ple(const float* H2, const float* GL, const float* PP, float* out) {
    const size_t i = (size_t)blockIdx.x * 256 + threadIdx.x; out[i] = H2[i] + PP[i] / (1.f + expf(-GL[i]));
}
}
#define GAS __attribute__((address_space(1)))
#define LAS __attribute__((address_space(3)))
typedef unsigned short bf16;
typedef unsigned v4u __attribute__((ext_vector_type(4)));
typedef float f32x4 __attribute__((ext_vector_type(4)));
typedef short bf16x8 __attribute__((ext_vector_type(8)));
typedef GAS unsigned gu32;
typedef GAS unsigned long long gu64;
#define RLX_AGENT __ATOMIC_RELAXED, __HIP_MEMORY_SCOPE_AGENT
#define LDS_WAIT() asm volatile("s_waitcnt lgkmcnt(0)" ::: "memory")
#define VM_WAIT() asm volatile("s_waitcnt vmcnt(0)" ::: "memory")
__device__ __forceinline__ unsigned long long rt() { return __builtin_amdgcn_s_memrealtime(); }
__device__ __forceinline__ unsigned f2bf(float f) { unsigned u = __builtin_bit_cast(unsigned, f); return (u + 0x7fffu + ((u >> 16) & 1u)) >> 16; }
__device__ __forceinline__ unsigned pk2(float lo, float hi) { return f2bf(lo) | (f2bf(hi) << 16); }
#define XB_TMO      128
#define XB_XCNT(j)  (256  + 64 * (j))
#define XB_XSUB(j)  (1280 + 64 * (j))
#define XB_XGEN(j)  (2304 + 64 * (j))
#define XB_TOP      3328
#define XB_TOPGEN   3392
#define XCD_BAR_WORDS 3456
#define XB_SPIN_CAP (1u << 18)

__device__ __forceinline__ unsigned xb_ld(unsigned* p)              { return __hip_atomic_load(p, __ATOMIC_RELAXED, __HIP_MEMORY_SCOPE_AGENT); }
__device__ __forceinline__ unsigned xb_add(unsigned* p, unsigned v) { return __hip_atomic_fetch_add(p, v, __ATOMIC_RELAXED, __HIP_MEMORY_SCOPE_AGENT); }
__device__ __forceinline__ unsigned xb_xcc_id() { return (unsigned)__builtin_amdgcn_s_getreg((3 << 11) | 20) & 0xFu; }
#define XB_SPIN(cond, bar) do { unsigned _sp = 0; while (cond) { __builtin_amdgcn_s_sleep(1); \
    if ((++_sp & 255u) == 0u) { if (xb_ld(&(bar)[XB_TMO])) break; if (_sp > XB_SPIN_CAP) { atomicAdd(&(bar)[XB_TMO], 1u); break; } } } } while (0)

struct XcdBarrier {
    unsigned* bar; unsigned x;
    volatile LAS unsigned* st;
};

__device__ __forceinline__ int lane_id() { int r; asm volatile("v_mbcnt_lo_u32_b32 %0, -1, 0\n\tv_mbcnt_hi_u32_b32 %0, -1, %0" : "=v"(r)); return r; }
__device__ __forceinline__ XcdBarrier xcd_barrier_post(unsigned* bar, volatile LAS unsigned* st, int wid) {
    XcdBarrier b; b.bar = bar; b.x = xb_xcc_id(); b.st = st;
    if (wid == 0 && lane_id() == 0) (void)xb_add(&bar[XB_XCNT(b.x)], 1u);
    return b;
}
__device__ __forceinline__ void xcd_barrier_complete(unsigned* bar, unsigned x, unsigned& nloc, unsigned& nx) {
    const unsigned G = gridDim.x * gridDim.y * gridDim.z;
    unsigned sum, cnt, mine, sp = 0u;
    for (;;) {
        sum = 0u; cnt = 0u; mine = 0u;
#pragma unroll
        for (unsigned j = 0; j < 16; ++j) { const unsigned c = xb_ld(&bar[XB_XCNT(j)]); sum += c; cnt += (c > 0u) ? 1u : 0u; mine = (j == x) ? c : mine; }
        if (sum == G) break;
        __builtin_amdgcn_s_sleep(1);
        if ((++sp & 255u) == 0u) { if (xb_ld(&bar[XB_TMO])) break; if (sp > XB_SPIN_CAP) { atomicAdd(&bar[XB_TMO], 1u); break; } }
    }
    nloc = mine > 0u ? mine : 1u; nx = cnt > 0u ? cnt : 1u;
}

__device__ __forceinline__ void xcd_barrier(const XcdBarrier& b, int wid) {
    asm volatile("s_waitcnt vmcnt(0)" ::: "memory");
    __syncthreads();
    if (wid == 0 && lane_id() == 0) {
        unsigned* bar = b.bar;
        __builtin_amdgcn_s_waitcnt(0);
        unsigned nloc = b.st[0], nx = b.st[1];
        if (nloc == 0u) { xcd_barrier_complete(bar, b.x, nloc, nx); b.st[0] = nloc; b.st[1] = nx; }
        const unsigned old = xb_add(&bar[XB_XSUB(b.x)], 1u);
        const unsigned gen = old / nloc;
        if (old + 1u == (gen + 1u) * nloc) {
            __builtin_amdgcn_fence(__ATOMIC_RELEASE, "agent");
            asm volatile("s_waitcnt vmcnt(0)" ::: "memory");
            const unsigned og = xb_add(&bar[XB_TOP], 1u);
            const unsigned tg = og / nx;
            if (og + 1u == (tg + 1u) * nx) xb_add(&bar[XB_TOPGEN], 1u);
            else XB_SPIN(xb_ld(&bar[XB_TOPGEN]) == tg, bar);
            __builtin_amdgcn_fence(__ATOMIC_ACQUIRE, "agent");
            xb_add(&bar[XB_XGEN(b.x)], 1u);
            asm volatile("s_waitcnt vmcnt(0)" ::: "memory");
        } else {
            XB_SPIN(xb_ld(&bar[XB_XGEN(b.x)]) == gen, bar);
            __builtin_amdgcn_fence(__ATOMIC_ACQUIRE, "agent");
            asm volatile("s_waitcnt vmcnt(0)" ::: "memory");
        }
    }
    __syncthreads();
}
namespace pg8 {
#define PG8_LAS __attribute__((address_space(3)))
typedef unsigned short bf16_t;
typedef short bf16x8 __attribute__((ext_vector_type(8)));
typedef float f32x4 __attribute__((ext_vector_type(4)));
typedef unsigned u32x4 __attribute__((ext_vector_type(4)));
constexpr int BM = 256, BK = 64, HALF = 128, HTB = HALF * BK * 2  , STAGE_BYTES = 8 * HTB, NXCD = 8, WGM = 8;

__host__ __device__ __forceinline__ int lds_byte(int r, int c) { const int st = (r >> 4) * 2 + (c >> 5), rr = r & 15, cc = c & 31, ob = rr * 64 + cc * 2; return st * 1024 + (ob ^ (((ob >> 9) & 1) << 5)); }
__host__ __device__ __forceinline__ void stage_rc(int b, int& R, int& C) { const int st = b / 1024, sb = b % 1024, swz = sb ^ (((sb >> 9) & 1) << 5); R = (st >> 1) * 16 + swz / 64; C = (st & 1) * 32 + (swz % 64) / 2; }
__host__ __device__ __forceinline__ int perm32(int rho) { const int n = rho >> 4, i = rho & 15; return 8 * (i >> 2) + 4 * n + (i & 3); }

struct Unit { int pm, pn; };
struct Gemm { const bf16_t* A; const bf16_t* Bt; int M, N, K; };

struct StaticOrder {
    int nM, nN, nwg, G, c;
    __host__ __device__ void init(int M, int N, int G_, int c_) { nM = M / BM; nN = N / BM; nwg = nM * nN; G = G_; c = c_; }
    __host__ __device__ bool next(int i, Unit& u) const {
        const long L = (long)i * G + c; if (L >= nwg) return false;
        int wgid = (int)L; { const int q = nwg / NXCD, r = nwg % NXCD, xcd = wgid % NXCD, off = wgid / NXCD; wgid = (xcd < r ? xcd * (q + 1) : r * (q + 1) + (xcd - r) * q) + off; }
        const int nig = WGM * nN, gid = wgid / nig, fm = gid * WGM, gsz = (nM - fm) < WGM ? (nM - fm) : WGM;
        u.pm = fm + ((wgid % nig) % gsz); u.pn = (wgid % nig) / gsz; return true;
    }
    __device__ __forceinline__ void a_ready(const Unit&) const {}
    __device__ __forceinline__ void done(const Unit&) const {}
};

__device__ __forceinline__ unsigned cvt_pk_bf16(float lo, float hi) { unsigned r; asm volatile("v_cvt_pk_bf16_f32 %0, %1, %2" : "=v"(r) : "v"(lo), "v"(hi)); return r; }
typedef float f32x2 __attribute__((ext_vector_type(2)));
template <class Epi, class Sched, bool ALIGN_EPI = false, bool SP2 = false>
__device__ __forceinline__ void gemm_phase(PG8_LAS unsigned char* lds, const Gemm g, const Sched& S, const Epi& E, const int wid) {
    const int lane = ::lane_id(), tid = wid * 64 + lane, wr = wid >> 2, wc = wid & 3, fr = lane & 15, fq = lane >> 4;
    const int K = g.K, nt = K / BK;
    unsigned voffA[2], voffB[2];
#pragma unroll
    for (int i = 0; i < 2; ++i) { int R, C; stage_rc(tid * 16 + i * 8192, R, C); const int Rb = Epi::PERM ? ((R & ~31) + perm32(R & 31)) : R;
        voffA[i] = (unsigned)(R * K + C) * 2u; voffB[i] = (unsigned)(Rb * K + C) * 2u; }
    const size_t kstep = (size_t)(BK * 2);
    const size_t hstep = (size_t)HALF * K * 2;
    const size_t tstep = 2 * hstep;
    const unsigned ldsw = (unsigned)wid * 1024u;
    const int aoff = lds_byte(wr * 64 + fr, fq * 8), boff = lds_byte(wc * 32 + fr, fq * 8);
#define PG8_SA(b, h) (((b) * 2 + (h)) * HTB)
#define PG8_SB(b, h) ((4 + (b) * 2 + (h)) * HTB)
#define PG8_STAGE(bufoff, gbase, voff) do { _Pragma("unroll") for (int _i = 0; _i < 2; ++_i) \
        __builtin_amdgcn_global_load_lds((const unsigned*)((const char*)(gbase) + (voff)[_i]), (PG8_LAS unsigned*)(lds + (bufoff) + ldsw + _i * 8192), 16, 0, 0); } while (0)
#define PG8_LDA(dst, b, h) do { _Pragma("unroll") for (int m = 0; m < 4; ++m) _Pragma("unroll") for (int k = 0; k < 2; ++k) dst[m][k] = *(const PG8_LAS bf16x8*)(lds + PG8_SA(b, h) + aoff + m * 2048 + k * 1024); } while (0)
#define PG8_LDB(dst, b, h) do { _Pragma("unroll") for (int n = 0; n < 2; ++n) _Pragma("unroll") for (int k = 0; k < 2; ++k) dst[n][k] = *(const PG8_LAS bf16x8*)(lds + PG8_SB(b, h) + boff + n * 2048 + k * 1024); } while (0)
#define PG8_MMA(ai, bj, At, Bt) do { __builtin_amdgcn_s_setprio(1); _Pragma("unroll") for (int m = 0; m < 4; ++m) _Pragma("unroll") for (int n = 0; n < 2; ++n) _Pragma("unroll") for (int k = 0; k < 2; ++k) \
        acc[ai][bj][m][n] = __builtin_amdgcn_mfma_f32_16x16x32_bf16(Bt[n][k], At[m][k], acc[ai][bj][m][n], 0, 0, 0); __builtin_amdgcn_s_setprio(0); } while (0)
#define PG8_WAIT_V(n) asm volatile("s_waitcnt vmcnt(" #n ")" ::: "memory")
#define PG8_WAIT_L(n) asm volatile("s_waitcnt lgkmcnt(" #n ")" ::: "memory")
#define PG8_BAR __builtin_amdgcn_s_barrier()
#define PG8_SCHED __builtin_amdgcn_sched_barrier(0)
    Unit cur, nxt; int ui = 0;
    if (!S.next(0, cur)) return;
    f32x4 acc[2][2][4][2];
#pragma unroll
    for (int a = 0; a < 2; ++a)
#pragma unroll
        for (int b = 0; b < 2; ++b)
#pragma unroll
            for (int m = 0; m < 4; ++m)
#pragma unroll
                for (int n = 0; n < 2; ++n) acc[a][b][m][n] = (f32x4){0.f, 0.f, 0.f, 0.f};
    bf16x8 At[4][2], B0[2][2], B1[2][2];
    const char* cA = (const char*)g.A + (size_t)cur.pm * tstep; const char* cB = (const char*)g.Bt + (size_t)cur.pn * tstep;
    S.a_ready(cur);
    if constexpr (SP2) {
        PG8_STAGE(PG8_SB(0, 0), cB, voffB); PG8_STAGE(PG8_SB(0, 1), cB + hstep, voffB); PG8_STAGE(PG8_SA(0, 0), cA, voffA); PG8_STAGE(PG8_SA(0, 1), cA + hstep, voffA);
        if (wr == 1) PG8_BAR;
        PG8_WAIT_V(2); PG8_BAR;
        PG8_STAGE(PG8_SB(1, 0), cB + kstep, voffB); PG8_STAGE(PG8_SA(1, 0), cA + kstep, voffA); PG8_STAGE(PG8_SB(1, 1), cB + hstep + kstep, voffB);
        PG8_WAIT_V(6); PG8_BAR;
    } else {
        PG8_STAGE(PG8_SB(0, 0), cB, voffB); PG8_STAGE(PG8_SA(0, 0), cA, voffA); PG8_STAGE(PG8_SB(0, 1), cB + hstep, voffB); PG8_STAGE(PG8_SA(0, 1), cA + hstep, voffA);
        if (wr == 1) PG8_BAR;
        PG8_WAIT_V(4); PG8_BAR;
        PG8_STAGE(PG8_SB(1, 0), cB + kstep, voffB); PG8_STAGE(PG8_SA(1, 0), cA + kstep, voffA); PG8_STAGE(PG8_SB(1, 1), cB + hstep + kstep, voffB);
        PG8_WAIT_V(6); PG8_BAR;
    }
    for (;;) {
        const bool has_next = S.next(ui + 1, nxt);
        const char* nA = has_next ? (const char*)g.A + (size_t)nxt.pm * tstep : cA; const char* nB = has_next ? (const char*)g.Bt + (size_t)nxt.pn * tstep : cB;
        for (int t = 0; t < nt; t += 2) {
            if constexpr (Epi::MID) { if (t == (nt >> 1)) E.mid(acc, cur, wr, wc, fr, fq); }
            const bool last = (t == nt - 2);
            const char* a1 = cA + (size_t)(t + 1) * kstep;
            const char* a2 = last ? nA : cA + (size_t)(t + 2) * kstep; const char* b2 = last ? nB : cB + (size_t)(t + 2) * kstep;
            const char* a3 = a2 + kstep; const char* b3 = b2 + kstep;
            if (last && has_next) S.a_ready(nxt);
            if constexpr (SP2) {
            PG8_LDB(B0, 0, 0); PG8_LDB(B1, 0, 1); PG8_SCHED; PG8_LDA(At, 0, 0); PG8_STAGE(PG8_SA(1, 1), a1 + hstep, voffA);
            PG8_WAIT_V(8); PG8_WAIT_L(0); PG8_BAR; PG8_MMA(0, 0, At, B0); PG8_MMA(0, 1, At, B1); PG8_BAR; PG8_SCHED;
            PG8_LDA(At, 0, 1); PG8_STAGE(PG8_SB(0, 0), b2, voffB); PG8_STAGE(PG8_SB(0, 1), b2 + hstep, voffB); PG8_STAGE(PG8_SA(0, 0), a2, voffA);
            PG8_WAIT_V(8); PG8_WAIT_L(0); PG8_BAR; PG8_MMA(1, 0, At, B0); PG8_MMA(1, 1, At, B1); PG8_BAR; PG8_SCHED;
            PG8_LDB(B0, 1, 0); PG8_LDB(B1, 1, 1); PG8_SCHED; PG8_LDA(At, 1, 0); PG8_STAGE(PG8_SA(0, 1), a2 + hstep, voffA);
            PG8_WAIT_V(8); PG8_WAIT_L(0); PG8_BAR; PG8_MMA(0, 0, At, B0); PG8_MMA(0, 1, At, B1); PG8_BAR; PG8_SCHED;
            PG8_LDA(At, 1, 1); PG8_STAGE(PG8_SB(1, 0), b3, voffB); PG8_STAGE(PG8_SB(1, 1), b3 + hstep, voffB); PG8_STAGE(PG8_SA(1, 0), a3, voffA);
            PG8_WAIT_V(8); PG8_WAIT_L(0); PG8_BAR; PG8_MMA(1, 0, At, B0); PG8_MMA(1, 1, At, B1); PG8_BAR; PG8_SCHED;
            } else {
            PG8_LDB(B0, 0, 0); PG8_SCHED; PG8_LDA(At, 0, 0); PG8_STAGE(PG8_SA(1, 1), a1 + hstep, voffA);
            PG8_WAIT_L(8); PG8_BAR; PG8_WAIT_L(0); PG8_MMA(0, 0, At, B0); PG8_BAR; PG8_SCHED;
            PG8_LDB(B1, 0, 1); PG8_STAGE(PG8_SB(0, 0), b2, voffB);
            PG8_BAR; PG8_WAIT_L(0); PG8_MMA(0, 1, At, B1); PG8_BAR;
            PG8_LDA(At, 0, 1); PG8_STAGE(PG8_SA(0, 0), a2, voffA);
            PG8_BAR; PG8_WAIT_L(0); PG8_MMA(1, 0, At, B0); PG8_BAR; PG8_SCHED;
            PG8_STAGE(PG8_SB(0, 1), b2 + hstep, voffB);
            PG8_WAIT_V(6); PG8_BAR; PG8_MMA(1, 1, At, B1); PG8_BAR;
            PG8_LDB(B0, 1, 0); PG8_SCHED; PG8_LDA(At, 1, 0); PG8_STAGE(PG8_SA(0, 1), a2 + hstep, voffA);
            PG8_WAIT_L(8); PG8_BAR; PG8_WAIT_L(0); PG8_MMA(0, 0, At, B0); PG8_BAR; PG8_SCHED;
            PG8_LDB(B1, 1, 1); PG8_STAGE(PG8_SB(1, 0), b3, voffB);
            PG8_BAR; PG8_WAIT_L(0); PG8_MMA(0, 1, At, B1); PG8_BAR;
            PG8_LDA(At, 1, 1); PG8_STAGE(PG8_SA(1, 0), a3, voffA);
            PG8_BAR; PG8_WAIT_L(0); PG8_MMA(1, 0, At, B0); PG8_BAR; PG8_SCHED;
            PG8_STAGE(PG8_SB(1, 1), b3 + hstep, voffB);
            PG8_WAIT_V(6); PG8_BAR; PG8_MMA(1, 1, At, B1); PG8_BAR;
            }
        }
        if constexpr (ALIGN_EPI) { if (wr == 0) PG8_BAR; }
        if constexpr (!Epi::AFTER_DRAIN) { E(acc, cur, wr, wc, fr, fq); S.done(cur); }
        if (!has_next) break;
#pragma unroll
        for (int a = 0; a < 2; ++a)
#pragma unroll
            for (int b = 0; b < 2; ++b)
#pragma unroll
                for (int m = 0; m < 4; ++m)
#pragma unroll
                    for (int n = 0; n < 2; ++n) acc[a][b][m][n] = (f32x4){0.f, 0.f, 0.f, 0.f};
        cur = nxt; cA = nA; cB = nB; ++ui;
        if constexpr (ALIGN_EPI) { if (wr == 1) PG8_BAR; }
    }
    PG8_WAIT_V(0);
    if constexpr (!ALIGN_EPI) { if (wr == 0) PG8_BAR; }
    PG8_BAR;
    if constexpr (Epi::AFTER_DRAIN) { E.fused(acc, cur, wr, wc, fr, fq, lds, wid, lane); S.done(cur); }
#undef PG8_SA
#undef PG8_SB
#undef PG8_STAGE
#undef PG8_LDA
#undef PG8_LDB
#undef PG8_MMA
#undef PG8_WAIT_V
#undef PG8_WAIT_L
#undef PG8_BAR
#undef PG8_SCHED
}
}
constexpr int NWAVES = 8;
constexpr int RING_OFF = 0, RING_BYTES = 131072, TAB_OFF = RING_BYTES, TAB_BYTES = 8192, LDSCTL_OFF = TAB_OFF + TAB_BYTES, MISC_OFF = LDSCTL_OFF + 320, LDS_BYTES = 147456;
static_assert(MISC_OFF + 128 <= LDS_BYTES, "LDS map");
constexpr int CW_TMO = 0, CW_CODE = 1, CW_BAR = 4096;
constexpr size_t CTL_ZERO_BYTES = 64 * 1024;
constexpr float QK_C2 = 0.07216878364870323f * 1.4426950408889634f;
typedef float f32x2v __attribute__((ext_vector_type(2)));
typedef unsigned u32x2v __attribute__((ext_vector_type(2)));
__device__ __forceinline__ float bf2f(unsigned short b) { return __uint_as_float((unsigned)b << 16); }
__device__ __forceinline__ float gelu_f(float x) { const float u = 1.5957691216057308f * (x + 0.044715f * x * x * x); return x * __builtin_amdgcn_rcpf(1.f + __builtin_amdgcn_exp2f(-1.4426950408889634f * u)); }
__device__ __forceinline__ float wave_sum64(float v) {
#pragma unroll
    for (int o = 1; o < 64; o <<= 1) v += __shfl_xor(v, o);
    return v;
}
struct Args { const void* in[26]; float* out; unsigned char* ws; int ph_lo, ph_hi; };
struct Frame { LAS unsigned char* lds; volatile LAS unsigned* MISC; gu32* ctl; int tid, lane, wave, vcu, G; };

__device__ __forceinline__ int rope_pc(int lr) { const int nn = lr >> 5, i = lr & 31, c5 = i >> 4, f = i & 15; return 32 * c5 + 8 * (f >> 2) + 4 * nn + (f & 3); }
__device__ __forceinline__ int map_win(int n) { if (n < 768) return n; if (n < 832) return 2816 + rope_pc(n - 768); if (n < 1856) return 768 + (n - 832); return 1792 + (n - 1856); }
__device__ __forceinline__ int map_wuq(int n) { const int h = n / 192, lc = n - h * 192; return lc < 128 ? n : h * 192 + 128 + rope_pc(lc - 128); }
__device__ __forceinline__ int map_id(int n) { return n; }

template <class MapF, class ScaleF>
__device__ __forceinline__ void p0_transpose_item(const float* W, int K, int N, bf16* WT, LAS float* scr, int item, int lane, MapF mapf, ScaleF ks) {
    const int nblk = N / 32, kb = item / nblk, nb = item % nblk, k0 = 64 * kb, n0 = 32 * nb;
#pragma unroll 8
    for (int i = 0; i < 32; ++i) { const int kk = 2 * i + (lane >> 5); scr[kk * 33 + (lane & 31)] = W[(size_t)(k0 + kk) * N + n0 + (lane & 31)] * ks(k0 + kk); }
    LDS_WAIT(); asm volatile("" ::: "memory");
    const int c = lane & 7;
#pragma unroll
    for (int j = 0; j < 4; ++j) { const int n = (lane >> 3) + 8 * j; const LAS float* s = scr + (8 * c) * 33 + n;
        v4u o; o.x = pk2(s[0 * 33], s[1 * 33]); o.y = pk2(s[2 * 33], s[3 * 33]); o.z = pk2(s[4 * 33], s[5 * 33]); o.w = pk2(s[6 * 33], s[7 * 33]);
        *(GAS v4u*)(WT + (size_t)mapf(n0 + n) * K + k0 + 8 * c) = o; }
    LDS_WAIT(); asm volatile("" ::: "memory");
}
template <class ScaleF>
__device__ __forceinline__ void p0_cvt512(const float* src, bf16* dst, size_t e0, int lane, ScaleF sf) {
    const size_t e = e0 + (size_t)lane * 8; const f32x4 a = *(const GAS f32x4*)(src + e), b = *(const GAS f32x4*)(src + e + 4);
    v4u o; o.x = pk2(a.x * sf(e), a.y * sf(e + 1)); o.y = pk2(a.z * sf(e + 2), a.w * sf(e + 3)); o.z = pk2(b.x * sf(e + 4), b.y * sf(e + 5)); o.w = pk2(b.z * sf(e + 6), b.w * sf(e + 7));
    *(GAS v4u*)(dst + e) = o;
}
__device__ __forceinline__ void p0_prologue(const Args& A, Frame& F) {
    unsigned char* ws = A.ws;
    const float* x = (const float*)A.in[0]; const float* p = (const float*)A.in[1]; const int* pos = (const int*)A.in[2];
    const float *g_mix = (const float*)A.in[3], *w_in = (const float*)A.in[4], *g_cq = (const float*)A.in[5], *w_uq = (const float*)A.in[6], *g_ckv = (const float*)A.in[7], *w_ukv = (const float*)A.in[8];
    const float *w_sgu = (const float*)A.in[11], *g_oa = (const float*)A.in[13], *g_os = (const float*)A.in[14], *w_out = (const float*)A.in[15], *g_ffn = (const float*)A.in[16], *w_pq = (const float*)A.in[17];
    const float *k1 = (const float*)A.in[18], *k2 = (const float*)A.in[19], *pu = (const float*)A.in[20], *pv = (const float*)A.in[21], *g_ple = (const float*)A.in[22], *w_pg = (const float*)A.in[23], *w_pp = (const float*)A.in[24];
    LAS float* scr = (LAS float*)(F.lds + RING_OFF + F.wave * 16384);
    const int gw = F.vcu * NWAVES + F.wave, NGW = F.G * NWAVES, lane = F.lane;
    for (int m = gw; m < T_TOK; m += NGW) {
        const GAS f32x4* xr = (const GAS f32x4*)(x + (size_t)m * DM) + lane; f32x4 v[8]; float s = 0.f;
#pragma unroll
        for (int j = 0; j < 8; ++j) { v[j] = xr[64 * j]; s += (v[j].x * v[j].x + v[j].y * v[j].y) + (v[j].z * v[j].z + v[j].w * v[j].w); }
        s = wave_sum64(s); if (lane == 0) ((float*)(ws + WS_RSX))[m] = 1.0f / sqrtf(s * (1.f / DM) + 1e-6f);
        GAS u32x2v* o8 = (GAS u32x2v*)((bf16*)(ws + WS_R1) + (size_t)m * DM) + lane;
#pragma unroll
        for (int j = 0; j < 8; ++j) o8[64 * j] = (u32x2v){pk2(v[j].x, v[j].y), pk2(v[j].z, v[j].w)};
        const f32x4 pvv = *((const GAS f32x4*)(p + (size_t)m * 256) + lane);
        *((GAS u32x2v*)((bf16*)(ws + WS_PB) + (size_t)m * 256) + lane) = (u32x2v){pk2(pvv.x, pvv.y), pk2(pvv.z, pvv.w)};
    }
    for (int it = gw; it < T_TOK * 32 / 64; it += NGW) { const int idx = it * 64 + lane, row = idx >> 5, i = idx & 31;
        const double f = exp2((double)i * (-13.287712379549449 / 32.0)); const double a = (double)pos[row] * f;
        ((f32x2v*)(ws + WS_CS))[idx] = (f32x2v){(float)cos(a), (float)sin(a)}; }
    constexpr int I_IN = 32 * 90, I_UQ = 8 * 48, I_UKV = 4 * 64, I_SQ = 32 * 64, I_PP = 4 * 64;
    constexpr int NITEMS = I_IN + I_UQ + I_UKV + 3 * I_SQ + I_PP;
    for (int it = gw; it < NITEMS; it += NGW) {
        int r = it;
        if (r < I_IN) { p0_transpose_item(w_in, 2048, 2880, (bf16*)(ws + WS_WT_IN), scr, r, lane, [](int n) { return map_win(n); }, [=](int k) { return g_mix[k]; }); continue; } r -= I_IN;
        if (r < I_UQ) { p0_transpose_item(w_uq, 512, 1536, (bf16*)(ws + WS_WT_UQ), scr, r, lane, [](int n) { return map_wuq(n); }, [=](int k) { return g_cq[k] * QK_C2; }); continue; } r -= I_UQ;
        if (r < I_UKV) { p0_transpose_item(w_ukv, 256, 2048, (bf16*)(ws + WS_WT_UKV), scr, r, lane, [](int n) { return n; }, [=](int k) { return g_ckv[k]; }); continue; } r -= I_UKV;
        if (r < I_SQ) { p0_transpose_item(w_out, 2048, 2048, (bf16*)(ws + WS_WT_OUT), scr, r, lane, [](int n) { return n; }, [=](int k) { return k < 1024 ? g_oa[k] : g_os[k - 1024]; }); continue; } r -= I_SQ;
        if (r < I_SQ) { p0_transpose_item(w_pq, 2048, 2048, (bf16*)(ws + WS_WT_PQ), scr, r, lane, [](int n) { return n; }, [=](int k) { return g_ffn[k]; }); continue; } r -= I_SQ;
        if (r < I_SQ) { p0_transpose_item(w_pg, 2048, 2048, (bf16*)(ws + WS_WT_PG), scr, r, lane, [](int n) { return n; }, [=](int k) { return g_ple[k]; }); continue; } r -= I_SQ;
        p0_transpose_item(w_pp, 256, 2048, (bf16*)(ws + WS_WT_PP), scr, r, lane, [](int n) { return n; }, [](int) { return 1.f; });
    }
    for (int it = gw; it < 192 * 2048 / 512; it += NGW) *(GAS v4u*)((bf16*)(ws + WS_WT_IN) + (size_t)2880 * 2048 + (size_t)it * 512 + lane * 8) = (v4u){0u, 0u, 0u, 0u};
    for (int it = gw; it < 3 * 256; it += NGW) { const int w = it >> 8, c = it & 255;
        if (w == 0) p0_cvt512(k1, (bf16*)(ws + WS_K1B), (size_t)c * 512, lane, [](size_t) { return 1.f; });
        else if (w == 1) p0_cvt512(k2, (bf16*)(ws + WS_K2B), (size_t)c * 512, lane, [](size_t) { return 1.f; });
        else p0_cvt512(w_sgu, (bf16*)(ws + WS_WSGU), (size_t)c * 512, lane, [](size_t e) { const int s = (int)(e & 127), t = (int)((e >> 7) & 127); return s <= t ? 1.f : 0.f; }); }
#if CUT >= 7
    for (int it = gw; it < 2 * 16384 * 2; it += NGW) { const int w = it >= 16384 * 2, c = w ? it - 16384 * 2 : it; const float* src = (w ? pv : pu) + (size_t)c * 1024 + lane * 16; const int d0 = (c & 1) * 1024 + lane * 16;
        f32x4 x[4];
#pragma unroll
        for (int q = 0; q < 4; ++q) x[q] = *(const GAS f32x4*)(src + 4 * q);
        if (!w) {
#pragma unroll
            for (int q = 0; q < 4; ++q) x[q] = x[q] * *(const GAS f32x4*)(g_ffn + d0 + 4 * q) * 256.f; }
        else {
#pragma unroll
            for (int q = 0; q < 4; ++q) x[q] = x[q] * 16.f; }
        v4u o; int t;
        t = 0; t = __builtin_amdgcn_cvt_pk_fp8_f32(x[0][0], x[0][1], t, false); t = __builtin_amdgcn_cvt_pk_fp8_f32(x[0][2], x[0][3], t, true); o.x = (unsigned)t;
        t = 0; t = __builtin_amdgcn_cvt_pk_fp8_f32(x[1][0], x[1][1], t, false); t = __builtin_amdgcn_cvt_pk_fp8_f32(x[1][2], x[1][3], t, true); o.y = (unsigned)t;
        t = 0; t = __builtin_amdgcn_cvt_pk_fp8_f32(x[2][0], x[2][1], t, false); t = __builtin_amdgcn_cvt_pk_fp8_f32(x[2][2], x[2][3], t, true); o.z = (unsigned)t;
        t = 0; t = __builtin_amdgcn_cvt_pk_fp8_f32(x[3][0], x[3][1], t, false); t = __builtin_amdgcn_cvt_pk_fp8_f32(x[3][2], x[3][3], t, true); o.w = (unsigned)t;
        *(GAS v4u*)((unsigned char*)(ws + (w ? WS_VB : WS_UB)) + (size_t)c * 1024 + lane * 16) = o; }
#endif
}

__device__ __forceinline__ v4u pack8(f32x4 a, f32x4 b) { v4u w; w.x = pg8::cvt_pk_bf16(a[0], a[1]); w.y = pg8::cvt_pk_bf16(a[2], a[3]); w.z = pg8::cvt_pk_bf16(b[0], b[1]); w.w = pg8::cvt_pk_bf16(b[2], b[3]); return w; }
__device__ __forceinline__ float sq8(f32x4 a, f32x4 b) { return ((a[0] * a[0] + a[1] * a[1]) + (a[2] * a[2] + a[3] * a[3])) + ((b[0] * b[0] + b[1] * b[1]) + (b[2] * b[2] + b[3] * b[3])); }
__device__ __forceinline__ float fq_sum(float v) { v += __shfl_xor(v, 16); v += __shfl_xor(v, 32); return v; }
#define EPI_ROWS_BEGIN _Pragma("unroll") for (int ai = 0; ai < 2; ++ai) _Pragma("unroll") for (int m = 0; m < 4; ++m) { const int row = u.pm * 256 + ai * 128 + wr * 64 + m * 16 + fr;
#define EPI_ROWS_END }

struct EpiG1 {
    static constexpr bool PERM = true, AFTER_DRAIN = false, MID = false;
    const float* rsx; bf16 *CQ, *CKV, *KR, *UG, *VG; float *pscq, *psckv; f32x2v* psv; const f32x2v* cs;
    __device__ __forceinline__ void operator()(const f32x4 (&acc)[2][2][4][2], const pg8::Unit& u, int wr, int wc, int fr, int fq) const {
        const int pn = u.pn;
        EPI_ROWS_BEGIN
            const float rs = rsx[row];
#pragma unroll
            for (int bj = 0; bj < 2; ++bj) { f32x4 v0 = acc[ai][bj][m][0] * rs, v1 = acc[ai][bj][m][1] * rs; const int lc = bj * 128 + wc * 32 + fq * 8;
                if (pn <= 2) { const float ss = fq_sum(sq8(v0, v1));
                    if (pn < 2) { *(GAS v4u*)(CQ + (size_t)row * 512 + pn * 256 + lc) = pack8(v0, v1); if (fq == 0) pscq[row * 16 + (pn * 2 + bj) * 4 + wc] = ss; }
                    else { *(GAS v4u*)(CKV + (size_t)row * 256 + lc) = pack8(v0, v1); if (fq == 0) psckv[row * 8 + bj * 4 + wc] = ss; } }
                else if (pn <= 10) {
#pragma unroll
                    for (int e = 0; e < 4; ++e) { v0[e] = gelu_f(v0[e]); v1[e] = gelu_f(v1[e]); }
                    if (pn <= 6) *(GAS v4u*)(UG + (size_t)row * 1024 + (pn - 3) * 256 + lc) = pack8(v0, v1);
                    else { const float s = fq_sum(((v0[0] + v0[1]) + (v0[2] + v0[3])) + ((v1[0] + v1[1]) + (v1[2] + v1[3]))), q = fq_sum(sq8(v0, v1));
                        *(GAS v4u*)(VG + (size_t)row * 1024 + (pn - 7) * 256 + lc) = pack8(v0, v1); if (fq == 0) psv[(row * 8 + (pn - 7) * 2 + bj) * 4 + wc] = (f32x2v){s, q}; } }
                else if (bj == 0 && wc < 2) { f32x4 o0, o1;
#pragma unroll
                    for (int e = 0; e < 4; ++e) { const f32x2v c = cs[row * 32 + 16 * wc + 4 * fq + e]; o0[e] = v0[e] * c.x - v1[e] * c.y; o1[e] = v1[e] * c.x + v0[e] * c.y; }
                    *(GAS v4u*)(KR + (size_t)row * 64 + wc * 32 + fq * 8) = pack8(o0, o1); } }
        EPI_ROWS_END
    }
};
struct EpiPlain {
    static constexpr bool PERM = true, AFTER_DRAIN = false, MID = false;
    bf16* O; int ldc;
    __device__ __forceinline__ void operator()(const f32x4 (&acc)[2][2][4][2], const pg8::Unit& u, int wr, int wc, int fr, int fq) const {
        EPI_ROWS_BEGIN
#pragma unroll
            for (int bj = 0; bj < 2; ++bj) *(GAS v4u*)(O + (size_t)row * ldc + u.pn * 256 + bj * 128 + wc * 32 + fq * 8) = pack8(acc[ai][bj][m][0], acc[ai][bj][m][1]);
        EPI_ROWS_END
    }
};
template <class Sched>
__device__ __forceinline__ void setup_rowtab(LAS float* tab, const float* part, int NP, float inv_dim, const Sched& S, int wid) {
    pg8::Unit u; const int tid = wid * 64 + lane_id();
    if (S.next(0, u)) { const int r = tid >> 1, half = tid & 1, n2 = NP >> 1; const float* pp = part + (size_t)(u.pm * 256 + r) * NP + half * n2; float s = 0.f;
        for (int j = 0; j < n2; ++j) s += pp[j];
        s += __shfl_xor(s, 1); if (!half) tab[r] = 1.0f / sqrtf(s * inv_dim + 1e-6f); }
}
struct EpiQ {
    static constexpr bool PERM = true, AFTER_DRAIN = false, MID = false;
    const LAS float* tab; bf16* Q; const f32x2v* cs;
    __device__ __forceinline__ void operator()(const f32x4 (&acc)[2][2][4][2], const pg8::Unit& u, int wr, int wc, int fr, int fq) const {
        EPI_ROWS_BEGIN
            const float rs = tab[ai * 128 + wr * 64 + m * 16 + fr];
#pragma unroll
            for (int bj = 0; bj < 2; ++bj) { f32x4 v0 = acc[ai][bj][m][0] * rs, v1 = acc[ai][bj][m][1] * rs; const int gc = u.pn * 256 + bj * 128 + wc * 32;
                if (((gc >> 6) % 3) == 2) { f32x4 o0, o1;
#pragma unroll
                    for (int e = 0; e < 4; ++e) { const f32x2v c = cs[row * 32 + 16 * (wc & 1) + 4 * fq + e]; o0[e] = v0[e] * c.x - v1[e] * c.y; o1[e] = v1[e] * c.x + v0[e] * c.y; }
                    v0 = o0; v1 = o1; }
                *(GAS v4u*)(Q + (size_t)row * 1536 + gc + fq * 8) = pack8(v0, v1); }
        EPI_ROWS_END
    }
};
struct EpiKV {
    static constexpr bool PERM = true, AFTER_DRAIN = false, MID = false;
    const LAS float* tab; bf16 *KN, *VV;
    __device__ __forceinline__ void operator()(const f32x4 (&acc)[2][2][4][2], const pg8::Unit& u, int wr, int wc, int fr, int fq) const {
        EPI_ROWS_BEGIN
            const float rs = tab[ai * 128 + wr * 64 + m * 16 + fr];
#pragma unroll
            for (int bj = 0; bj < 2; ++bj) *(GAS v4u*)((bj ? VV : KN) + (size_t)row * 1024 + u.pn * 128 + wc * 32 + fq * 8) = pack8(acc[ai][bj][m][0] * rs, acc[ai][bj][m][1] * rs);
        EPI_ROWS_END
    }
};
struct EpiOut {
    static constexpr bool PERM = true, AFTER_DRAIN = false, MID = true;
    const LAS float* tab; const float* x; float* H1; bf16* H1B; float* psh1;
    __device__ __forceinline__ void mid(f32x4 (&acc)[2][2][4][2], const pg8::Unit& u, int wr, int wc, int fr, int fq) const {
#pragma unroll
        for (int ai = 0; ai < 2; ++ai)
#pragma unroll
            for (int m = 0; m < 4; ++m) { const int r = ai * 128 + wr * 64 + m * 16 + fr; const float rr = tab[r] / tab[256 + r];
#pragma unroll
                for (int bj = 0; bj < 2; ++bj) { acc[ai][bj][m][0] *= rr; acc[ai][bj][m][1] *= rr; } }
    }
    __device__ __forceinline__ void operator()(const f32x4 (&acc)[2][2][4][2], const pg8::Unit& u, int wr, int wc, int fr, int fq) const {
        EPI_ROWS_BEGIN
            const float rs = tab[256 + ai * 128 + wr * 64 + m * 16 + fr];
#pragma unroll
            for (int bj = 0; bj < 2; ++bj) { const size_t off = (size_t)row * DM + u.pn * 256 + bj * 128 + wc * 32 + fq * 8;
                const f32x4 v0 = *(const GAS f32x4*)(x + off) + acc[ai][bj][m][0] * rs, v1 = *(const GAS f32x4*)(x + off + 4) + acc[ai][bj][m][1] * rs;
                *(GAS f32x4*)(H1 + off) = v0; *(GAS f32x4*)(H1 + off + 4) = v1; *(GAS v4u*)(H1B + off) = pack8(v0, v1);
                const float ss = fq_sum(sq8(v0, v1)); if (fq == 0) psh1[row * 64 + u.pn * 8 + bj * 4 + wc] = ss; }
        EPI_ROWS_END
    }
};
struct EpiPQ {
    static constexpr bool PERM = true, AFTER_DRAIN = false, MID = false;
    const LAS float* tab; bf16* QP;
    __device__ __forceinline__ void operator()(const f32x4 (&acc)[2][2][4][2], const pg8::Unit& u, int wr, int wc, int fr, int fq) const {
        EPI_ROWS_BEGIN
            const float rs = tab[ai * 128 + wr * 64 + m * 16 + fr];
#pragma unroll
            for (int bj = 0; bj < 2; ++bj) *(GAS v4u*)(QP + (size_t)row * DM + u.pn * 256 + bj * 128 + wc * 32 + fq * 8) = pack8(acc[ai][bj][m][0] * rs, acc[ai][bj][m][1] * rs);
        EPI_ROWS_END
    }
};
struct EpiPLE {
    static constexpr bool PERM = true, AFTER_DRAIN = false, MID = false;
    const float* rsh2; const float* H2; const bf16* PPROJ; float* out; float* psh3;
    __device__ __forceinline__ void operator()(const f32x4 (&acc)[2][2][4][2], const pg8::Unit& u, int wr, int wc, int fr, int fq) const {
        EPI_ROWS_BEGIN
            const float rs = rsh2[row];
#pragma unroll
            for (int bj = 0; bj < 2; ++bj) { const size_t off = (size_t)row * DM + u.pn * 256 + bj * 128 + wc * 32 + fq * 8;
                const v4u pw = *(const GAS v4u*)(PPROJ + off); f32x4 h0 = *(const GAS f32x4*)(H2 + off), h1 = *(const GAS f32x4*)(H2 + off + 4);
                const unsigned pws[4] = {pw.x, pw.y, pw.z, pw.w};
#pragma unroll
                for (int e = 0; e < 4; ++e) { const float a = acc[ai][bj][m][e >> 1][(e & 1) * 2] * rs, b = acc[ai][bj][m][e >> 1][(e & 1) * 2 + 1] * rs;
                    const float ga = __builtin_amdgcn_rcpf(1.f + __builtin_amdgcn_exp2f(-1.4426950408889634f * a)), gb = __builtin_amdgcn_rcpf(1.f + __builtin_amdgcn_exp2f(-1.4426950408889634f * b));
                    const float pa = __uint_as_float(pws[e] << 16), pb = __uint_as_float(pws[e] & 0xffff0000u);
                    if (e < 2) { h0[(e & 1) * 2] += ga * pa; h0[(e & 1) * 2 + 1] += gb * pb; } else { h1[(e & 1) * 2] += ga * pa; h1[(e & 1) * 2 + 1] += gb * pb; } }
                *(GAS f32x4*)(out + off) = h0; *(GAS f32x4*)(out + off + 4) = h1;
                const float ss = fq_sum(sq8(h0, h1)); if (fq == 0) psh3[row * 64 + u.pn * 8 + bj * 4 + wc] = ss; }
        EPI_ROWS_END
    }
};
typedef float f32x16 __attribute__((ext_vector_type(16)));
typedef short s16x4 __attribute__((ext_vector_type(4)));
#define KSWZ(row, colB) ((row) * 256 + ((colB) ^ (((row) & 7) << 4)))
__device__ __forceinline__ int v_st(int k, int c) { const int kk = (k & ~0xC) | ((k & 4) << 1) | ((k & 8) >> 1); return ((kk >> 3) * 4 + (c >> 5)) * 512 + ((kk & 7) * 32 + (c & 31)) * 2; }
__device__ __forceinline__ int v_rd_base(int lane) { return ((lane & 3) << 3) | (((lane >> 2) & 3) << 6) | (((lane >> 4) & 1) << 5) | (((lane >> 5) & 1) << 8); }
__device__ __forceinline__ int crow(int r, int hi) { return (r & 3) + 8 * (r >> 2) + 4 * hi; }
#define TRRD(dst, off) asm volatile("ds_read_b64_tr_b16 %0, %1 offset:%2" : "=&v"(dst) : "v"(vb0), "i"(off) : "memory")
#define SBAR() __builtin_amdgcn_sched_barrier(0)
#define PV_ONE(o_, pa_, VOFF, D0, KS) do { s16x4 l_, h_; TRRD(l_, (VOFF) + (D0) * 512 + (KS) * 4096); TRRD(h_, (VOFF) + (D0) * 512 + (KS) * 4096 + 2048); \
        asm volatile("s_waitcnt lgkmcnt(0)" ::: "memory"); SBAR(); \
        o_ = __builtin_amdgcn_mfma_f32_32x32x16_bf16(pa_, (bf16x8){l_[0], l_[1], l_[2], l_[3], h_[0], h_[1], h_[2], h_[3]}, o_, 0, 0, 0); } while (0)
__device__ __forceinline__ float half_sum32(float v) { v += __shfl_xor(v, 1); v += __shfl_xor(v, 2); v += __shfl_xor(v, 4); v += __shfl_xor(v, 8); v += __shfl_xor(v, 16); return v; }

__device__ __forceinline__ void sgu_phase(const Args& A, Frame& F) {
    unsigned char* ws = A.ws;
    const bf16* VG = (const bf16*)(ws + WS_VG); const bf16* UG = (const bf16*)(ws + WS_UG); const bf16* WS = (const bf16*)(ws + WS_WSGU); const f32x2v* psv = (const f32x2v*)(ws + WS_PSV);
    const float* gln = (const float*)A.in[9]; const float* bln = (const float*)A.in[10]; const float* bs = (const float*)A.in[12];
    bf16* MIX = (bf16*)(ws + WS_MIX); float* pss = (float*)(ws + WS_PSS);
    const int lane = lane_id(), wid = F.wave, tid = wid * 64 + lane, r32 = lane & 31, hi = lane >> 5, tg = wid & 3, dh = wid >> 2;
    LAS unsigned char* V_lds = F.lds + RING_OFF;
    const int vb0 = (int)(uintptr_t)V_lds + v_rd_base(lane);
    for (int unit = F.vcu; unit < 512; unit += F.G) {
        const int g = unit & 7, R0 = (unit >> 3) * 128;
#pragma unroll
        for (int i = 0; i < 4; ++i) { const int s = (tid >> 4) + 32 * i, c = (tid & 15) * 8, row = R0 + s;
            const f32x2v* pp = psv + ((size_t)row * 8 + g) * 4; const f32x2v p0 = pp[0], p1 = pp[1], p2 = pp[2], p3 = pp[3];
            const float mean = ((p0.x + p1.x) + (p2.x + p3.x)) * (1.f / 128.f), var = ((p0.y + p1.y) + (p2.y + p3.y)) * (1.f / 128.f) - mean * mean, rstd = 1.0f / sqrtf(fmaxf(var, 0.f) + 1e-6f);
            const v4u xv = *(const GAS v4u*)(VG + (size_t)row * 1024 + g * 128 + c);
            const f32x4 g0 = *(const GAS f32x4*)(gln + g * 128 + c), g1 = *(const GAS f32x4*)(gln + g * 128 + c + 4), b0 = *(const GAS f32x4*)(bln + g * 128 + c), b1 = *(const GAS f32x4*)(bln + g * 128 + c + 4);
            f32x4 y0, y1;
            y0[0] = (__uint_as_float(xv.x << 16) - mean) * rstd * g0[0] + b0[0]; y0[1] = (__uint_as_float(xv.x & 0xffff0000u) - mean) * rstd * g0[1] + b0[1];
            y0[2] = (__uint_as_float(xv.y << 16) - mean) * rstd * g0[2] + b0[2]; y0[3] = (__uint_as_float(xv.y & 0xffff0000u) - mean) * rstd * g0[3] + b0[3];
            y1[0] = (__uint_as_float(xv.z << 16) - mean) * rstd * g1[0] + b1[0]; y1[1] = (__uint_as_float(xv.z & 0xffff0000u) - mean) * rstd * g1[1] + b1[1];
            y1[2] = (__uint_as_float(xv.w << 16) - mean) * rstd * g1[2] + b1[2]; y1[3] = (__uint_as_float(xv.w & 0xffff0000u) - mean) * rstd * g1[3] + b1[3];
            *(LAS v4u*)(V_lds + (s >> 6) * 16384 + v_st(s & 63, c)) = pack8(y0, y1); }
        bf16x8 afr[8];
#pragma unroll
        for (int ks = 0; ks < 8; ++ks) afr[ks] = *(const GAS bf16x8*)(WS + ((size_t)g * 128 + 32 * tg + r32) * 128 + 16 * ks + 8 * hi);
        __syncthreads();
        f32x16 o0 = {}, o1 = {};
#define SGU_TILE(TL) do { _Pragma("unroll") for (int ks = 0; ks < 4; ++ks) { \
            if (dh == 0) { PV_ONE(o0, afr[4 * TL + ks], TL * 16384, 0, ks); PV_ONE(o1, afr[4 * TL + ks], TL * 16384, 1, ks); } \
            else { PV_ONE(o0, afr[4 * TL + ks], TL * 16384, 2, ks); PV_ONE(o1, afr[4 * TL + ks], TL * 16384, 3, ks); } } } while (0)
        SGU_TILE(0); if (tg >= 2) SGU_TILE(1);
#undef SGU_TILE
#pragma unroll
        for (int r = 0; r < 16; ++r) { const int t = 32 * tg + crow(r, hi), row = R0 + t; const float bias = bs[g * 128 + t];
            const int d0 = 64 * dh + r32; const size_t uoff = (size_t)row * 1024 + g * 128 + d0;
            const float va = bf2f(UG[uoff]) * (o0[r] + bias), vb = bf2f(UG[uoff + 32]) * (o1[r] + bias);
            const float na = __shfl_xor(va, 1), nb = __shfl_xor(vb, 1);
            if ((r32 & 1) == 0) { bf16* mo = MIX + (size_t)row * 2048 + 1024 + g * 128 + d0; *(GAS unsigned*)mo = pg8::cvt_pk_bf16(va, na); *(GAS unsigned*)(mo + 32) = pg8::cvt_pk_bf16(vb, nb); }
            const float ss = half_sum32(va * va + vb * vb); if (r32 == 0) pss[row * 16 + g * 2 + dh] = ss; }
        __syncthreads();
    }
}

#define OPAQUE(x) asm volatile("" : "+v"(x))
constexpr int KT_ROW = 400, KT_BYTES = 64 * KT_ROW;
__device__ __forceinline__ void attn_phase(const Args& A, Frame& F) {
    unsigned char* ws = A.ws;
    const GAS unsigned char* Qg = (const GAS unsigned char*)(ws + WS_Q); const GAS unsigned char* KNg = (const GAS unsigned char*)(ws + WS_KN); const GAS unsigned char* VVg = (const GAS unsigned char*)(ws + WS_VV); const GAS unsigned char* KRg = (const GAS unsigned char*)(ws + WS_KR);
    bf16* MIX = (bf16*)(ws + WS_MIX); float* psa = (float*)(ws + WS_PSA);
    const int wid = F.wave, g = wid & 3, kh = wid >> 2;
    LAS unsigned char* V_lds = F.lds + RING_OFF; LAS unsigned char* Kt_lds = V_lds + 32768;
    LAS float* wsc = (LAS float*)(V_lds + 86016) + wid * 64;
    LAS float* ml1 = (LAS float*)(V_lds + 86016 + 2048);
    for (int item = F.vcu; item < 256; item += F.G) {
        const int bh = item >> 3, s = item & 7, b = bh >> 3, h = bh & 7, tok0 = b * SEQ;
        for (int pass = 0; pass < 2; ++pass) {
            const int jq = pass ? s : 15 - s, q0 = tok0 + 128 * jq, NT = 2 * (jq + 1);
            bf16x8 qr[12];
            { int ln = lane_id(); const int r32 = ln & 31, hi = ln >> 5; const GAS unsigned char* qp = Qg + (size_t)(q0 + 32 * g) * 3072 + h * 384; const unsigned qo = (unsigned)r32 * 3072u + (unsigned)hi * 16u;
#pragma unroll
              for (int ks = 0; ks < 12; ++ks) qr[ks] = *(const GAS bf16x8*)(qp + qo + ks * 32); }
            bf16x8 skn0, skn1, sv0, sv1, skr;
#define ALOAD(t_) do { int ln_ = lane_id(); const int tid_ = wid * 64 + ln_; const unsigned sr_ = tid_ >> 4, sc_ = tid_ & 15; \
                const GAS unsigned char* kb_ = KNg + (size_t)(tok0 + 64 * (t_)) * 2048 + h * 256; const GAS unsigned char* vb_ = VVg + (size_t)(tok0 + 64 * (t_)) * 2048 + h * 256; const GAS unsigned char* rb_ = KRg + (size_t)(tok0 + 64 * (t_)) * 128; \
                const unsigned o_ = sr_ * 2048u + sc_ * 16u; \
                skn0 = *(const GAS bf16x8*)(kb_ + o_); skn1 = *(const GAS bf16x8*)(kb_ + o_ + 65536u); sv0 = *(const GAS bf16x8*)(vb_ + o_); sv1 = *(const GAS bf16x8*)(vb_ + o_ + 65536u); \
                skr = *(const GAS bf16x8*)(rb_ + (unsigned)tid_ * 16u); } while (0)
#define AWRITE(bf_) do { int ln_ = lane_id(); const int tid_ = wid * 64 + ln_; const int sr_ = tid_ >> 4, sc_ = tid_ & 15; \
                LAS unsigned char* kt_ = Kt_lds + (bf_) * KT_BYTES; LAS unsigned char* vt_ = V_lds + (bf_) * 16384; \
                *(LAS bf16x8*)(kt_ + sr_ * KT_ROW + sc_ * 16) = skn0; *(LAS bf16x8*)(kt_ + (sr_ + 32) * KT_ROW + sc_ * 16) = skn1; \
                *(LAS bf16x8*)(vt_ + v_st(sr_, sc_ * 8)) = sv0; *(LAS bf16x8*)(vt_ + v_st(32 + sr_, sc_ * 8)) = sv1; \
                *(LAS bf16x8*)(kt_ + (tid_ >> 3) * KT_ROW + 256 + (tid_ & 7) * 16) = skr; } while (0)
            ALOAD(0); AWRITE(0); __syncthreads();
            float m_reg = -1e30f, l_reg = 0.f; f32x16 o[4] = {};
            for (int t = 0; t < NT; ++t) {
                const int bf = t & 1;
                if (t + 1 < NT) ALOAD(t + 1);
                int ln = lane_id(); const int r32 = ln & 31, hi = ln >> 5;
                f32x16 p = {};
                { const LAS unsigned char* kb = Kt_lds + bf * KT_BYTES + (32 * kh + r32) * KT_ROW + hi * 16;
#pragma unroll
                  for (int ks = 0; ks < 12; ++ks) p = __builtin_amdgcn_mfma_f32_32x32x16_bf16(*(const LAS bf16x8*)(kb + ks * 32), qr[ks], p, 0, 0, 0); }
                if (t >= 2 * jq) { const int dq = (32 * g + r32) - (64 * (t - 2 * jq) + 32 * kh + 4 * hi);
#pragma unroll
                    for (int r = 0; r < 16; ++r) { const int c = (r & 3) + 8 * (r >> 2); if (c > dq) p[r] = -__builtin_inff(); } }
                float pmax = p[0];
#pragma unroll
                for (int r = 1; r < 16; ++r) pmax = fmaxf(pmax, p[r]);
                { auto rr = __builtin_amdgcn_permlane32_swap(__float_as_uint(pmax), __float_as_uint(pmax), false, false); pmax = fmaxf(__uint_as_float(rr[0]), __uint_as_float(rr[1])); }
                const float mn = fmaxf(m_reg, pmax), alpha = __builtin_amdgcn_exp2f(m_reg - mn); m_reg = mn;
                float ps = 0.f;
#pragma unroll
                for (int r = 0; r < 16; ++r) { p[r] = __builtin_amdgcn_exp2f(p[r] - mn); ps += p[r]; }
                { auto rr = __builtin_amdgcn_permlane32_swap(__float_as_uint(ps), __float_as_uint(ps), false, false); ps = __uint_as_float(rr[0]) + __uint_as_float(rr[1]); }
                l_reg = l_reg * alpha + ps;
                if (__any(alpha < 1.f)) { if (hi == 0) wsc[r32] = alpha; asm volatile("s_waitcnt lgkmcnt(0)" ::: "memory");
#pragma unroll
                    for (int r = 0; r < 16; ++r) { const float f = wsc[crow(r, hi)];
#pragma unroll
                        for (int d_ = 0; d_ < 4; ++d_) o[d_][r] *= f; } }
                bf16x8 pa0, pa1;
#define PK4(P, B_, OUT) do { unsigned a0 = pg8::cvt_pk_bf16(P[B_ + 0], P[B_ + 1]), a1 = pg8::cvt_pk_bf16(P[B_ + 2], P[B_ + 3]), b0 = pg8::cvt_pk_bf16(P[B_ + 4], P[B_ + 5]), b1 = pg8::cvt_pk_bf16(P[B_ + 6], P[B_ + 7]); \
                    auto r0 = __builtin_amdgcn_permlane32_swap(a0, b0, false, false); auto r1 = __builtin_amdgcn_permlane32_swap(a1, b1, false, false); \
                    v4u w = {r0[0], r1[0], r0[1], r1[1]}; OUT = __builtin_bit_cast(bf16x8, w); } while (0)
                PK4(p, 0, pa0); PK4(p, 8, pa1);
#undef PK4
                { const int vb0 = (int)(uintptr_t)V_lds + v_rd_base(ln) + bf * 16384 + kh * 8192;
#pragma unroll
                  for (int d0 = 0; d0 < 4; ++d0) { PV_ONE(o[d0], pa0, 0, d0, 0); PV_ONE(o[d0], pa1, 0, d0, 1); } }
                if (t + 1 < NT) AWRITE(bf ^ 1);
                __syncthreads();
            }
#undef ALOAD
#undef AWRITE
            { int ln = lane_id(); const int r32 = ln & 31, hi = ln >> 5;
            LAS float* O1 = (LAS float*)(V_lds + g * 16384) + ln;
            if (kh == 1) {
#pragma unroll
                for (int d0 = 0; d0 < 4; ++d0)
#pragma unroll
                    for (int r = 0; r < 16; ++r) O1[(d0 * 16 + r) * 64] = o[d0][r];
                if (hi == 0) { ml1[g * 64 + r32] = m_reg; ml1[g * 64 + 32 + r32] = l_reg; } }
            __syncthreads();
            if (kh == 0) { const float m1 = ml1[g * 64 + r32], l1 = ml1[g * 64 + 32 + r32], mt = fmaxf(m_reg, m1), a0 = __builtin_amdgcn_exp2f(m_reg - mt), a1 = __builtin_amdgcn_exp2f(m1 - mt), il = 1.0f / (l_reg * a0 + l1 * a1);
                if (hi == 0) { wsc[r32] = a0 * il; wsc[32 + r32] = a1 * il; } asm volatile("s_waitcnt lgkmcnt(0)" ::: "memory");
#pragma unroll
                for (int r = 0; r < 16; ++r) { const int qrow = q0 + 32 * g + crow(r, hi); const float f0 = wsc[crow(r, hi)], f1 = wsc[32 + crow(r, hi)]; float ss = 0.f;
#pragma unroll
                    for (int d0 = 0; d0 < 4; ++d0) { const float v = o[d0][r] * f0 + O1[(d0 * 16 + r) * 64] * f1; ss += v * v; const float vn = __shfl_xor(v, 1);
                        if ((r32 & 1) == 0) *(GAS unsigned*)(MIX + (size_t)qrow * 2048 + h * 128 + d0 * 32 + r32) = pg8::cvt_pk_bf16(v, vn); }
                    ss = half_sum32(ss); if (r32 == 0) psa[qrow * 8 + h] = ss; } }
            __syncthreads(); }
        }
    }
}
typedef __bf16 bf16x2_t __attribute__((ext_vector_type(2)));
__device__ __forceinline__ unsigned ord_key(float f) { const unsigned u = __float_as_uint(f); return u ^ ((unsigned)((int)u >> 31) | 0x80000000u); }
__device__ __forceinline__ float ord_val(unsigned k) { return __uint_as_float((k & 0x80000000u) ? (k ^ 0x80000000u) : ~k); }
__device__ __forceinline__ unsigned umax3(unsigned a, unsigned b, unsigned c) { return max(max(a, b), c); }
__device__ __forceinline__ unsigned pair_max(unsigned v) { auto rr = __builtin_amdgcn_permlane32_swap(v, v, false, false); return max(rr[0], rr[1]); }
__device__ __forceinline__ unsigned pair_or(unsigned v) { auto rr = __builtin_amdgcn_permlane32_swap(v, v, false, false); return rr[0] | rr[1]; }
__host__ __device__ constexpr int cand_a(int c) { return c < 16 ? 0 : c < 24 ? 1 : c < 29 ? 2 : c < 33 ? 3 : c < 36 ? 4 : c < 38 ? 5 : c < 40 ? 6 : c < 42 ? 7 : c - 34; }
__host__ __device__ constexpr int cand_b(int c) { return c < 16 ? c : c < 24 ? c - 16 : c < 29 ? c - 24 : c < 33 ? c - 29 : c < 36 ? c - 33 : c < 38 ? c - 36 : c < 40 ? c - 38 : c < 42 ? c - 40 : 0; }
__device__ __forceinline__ void topk16_of_128(const bf16* keys  , const bf16* qrow  , int r32, int hi, unsigned (&sel)[16]) {
    bf16x8 qf[8];
#pragma unroll
    for (int ks = 0; ks < 8; ++ks) qf[ks] = *(const GAS bf16x8*)(qrow + 16 * ks + 8 * hi);
    unsigned k[64];
#pragma unroll
    for (int kb = 0; kb < 4; ++kb) { f32x16 acc = {};
#pragma unroll
        for (int ks = 0; ks < 8; ++ks) acc = __builtin_amdgcn_mfma_f32_32x32x16_bf16(*(const GAS bf16x8*)(keys + (size_t)(32 * kb + r32) * 128 + 16 * ks + 8 * hi), qf[ks], acc, 0, 0, 0);
#pragma unroll
        for (int r = 0; r < 16; ++r) k[kb * 16 + r] = (ord_key(acc[r]) & ~0x7fu) | (unsigned)(127 - (32 * kb + crow(r, hi))); }
#pragma unroll
    for (int it = 0; it < 16; ++it) { unsigned m = umax3(k[0], k[1], k[2]);
#pragma unroll
        for (int i = 3; i < 63; i += 2) m = umax3(m, k[i], k[i + 1]);
        m = max(m, k[63]); m = pair_max(m); sel[it] = m;
#pragma unroll
        for (int i = 0; i < 64; ++i) k[i] = (k[i] == m) ? 0u : k[i]; }
}
__device__ __forceinline__ void topk_phase(const Args& A, Frame& F) {
    unsigned char* ws = A.ws;
    const bf16* QP = (const bf16*)(ws + WS_R1); const bf16* K1 = (const bf16*)(ws + WS_K1B); const bf16* K2 = (const bf16*)(ws + WS_K2B); int* IDX = (int*)(ws + WS_IDX); float* GATE = (float*)(ws + WS_GATE);
    const int wid = F.wave;
    for (int unit = F.vcu; unit < 256; unit += F.G) {
        const int rb = unit >> 3, h = unit & 7; const int ln = lane_id(), r32 = ln & 31, hi = ln >> 5; const int tok = rb * 256 + wid * 32 + r32;
        unsigned s1[16], s2[16];
        topk16_of_128(K1 + (size_t)h * 16384, QP + (size_t)tok * 2048 + h * 256, r32, hi, s1);
        topk16_of_128(K2 + (size_t)h * 16384, QP + (size_t)tok * 2048 + h * 256 + 128, r32, hi, s2);
        float t1v[16], t2v[16]; int i1[16], i2[16];
#pragma unroll
        for (int a = 0; a < 16; ++a) { t1v[a] = ord_val(s1[a] & ~0x7fu); i1[a] = 127 - (int)(s1[a] & 0x7fu); t2v[a] = ord_val(s2[a] & ~0x7fu); i2[a] = 127 - (int)(s2[a] & 0x7fu); }
        unsigned ck[25]; int ce[25];
#pragma unroll
        for (int j = 0; j < 25; ++j) { constexpr int dummy = 0; (void)dummy;
            const int c0 = 2 * j, c1 = 2 * j + 1;
            const float v0 = t1v[cand_a(c0)] + t2v[cand_b(c0)], v1 = t1v[cand_a(c1)] + t2v[cand_b(c1)];
            const unsigned k0 = (ord_key(v0) & ~0xffu) | (unsigned)(255 - (cand_a(c0) * 16 + cand_b(c0))), k1 = (ord_key(v1) & ~0xffu) | (unsigned)(255 - (cand_a(c1) * 16 + cand_b(c1)));
            const int e0 = i1[cand_a(c0)] * 128 + i2[cand_b(c0)], e1 = i1[cand_a(c1)] * 128 + i2[cand_b(c1)];
            ck[j] = hi ? k1 : k0; ce[j] = hi ? e1 : e0; }
        unsigned gk[16]; int ge[16];
#pragma unroll
        for (int it = 0; it < 16; ++it) { unsigned m = ck[0];
#pragma unroll
            for (int j = 1; j < 25; j += 2) m = umax3(m, ck[j], ck[j + 1]);
            m = pair_max(m); gk[it] = m; int e = 0;
#pragma unroll
            for (int j = 0; j < 25; ++j) { const bool eq = ck[j] == m; e = eq ? ce[j] : e; ck[j] = eq ? 0u : ck[j]; }
            ge[it] = e; }
        float ev[16]; float l = 0.f; const float v0 = ord_val(gk[0] & ~0xffu);
#pragma unroll
        for (int it = 0; it < 16; ++it) { ge[it] = (int)pair_or((unsigned)ge[it]); ev[it] = __builtin_amdgcn_exp2f((ord_val(gk[it] & ~0xffu) - v0) * 1.4426950408889634f); l += ev[it]; }
        const float il = 1.0f / l;
        if (hi == 0) { int* ip = IDX + (size_t)tok * 128 + h * 16; float* gp = GATE + (size_t)tok * 128 + h * 16;
#pragma unroll
            for (int q = 0; q < 4; ++q) { *(GAS v4u*)(ip + 4 * q) = (v4u){(unsigned)ge[4 * q], (unsigned)ge[4 * q + 1], (unsigned)ge[4 * q + 2], (unsigned)ge[4 * q + 3]};
                *(GAS f32x4*)(gp + 4 * q) = (f32x4){ev[4 * q] * il, ev[4 * q + 1] * il, ev[4 * q + 2] * il, ev[4 * q + 3] * il}; } }
    }
}

__device__ __forceinline__ bf16x2_t asbf(unsigned u) { return __builtin_bit_cast(bf16x2_t, u); }
__device__ __forceinline__ float dot8(v4u a, v4u b, float c) {
    c = __builtin_amdgcn_fdot2_f32_bf16(asbf(a.x), asbf(b.x), c, false); c = __builtin_amdgcn_fdot2_f32_bf16(asbf(a.y), asbf(b.y), c, false);
    c = __builtin_amdgcn_fdot2_f32_bf16(asbf(a.z), asbf(b.z), c, false); c = __builtin_amdgcn_fdot2_f32_bf16(asbf(a.w), asbf(b.w), c, false); return c;
}
__device__ __forceinline__ void fmac_s(float& acc, float ws, float x) { asm("v_fmac_f32_e32 %0, %1, %2" : "+v"(acc) : "s"(ws), "v"(x)); }
__device__ __forceinline__ void axpy8(float (&acc)[8], v4u v, float w  ) {
    fmac_s(acc[0], w, __uint_as_float(v.x << 16)); fmac_s(acc[1], w, __uint_as_float(v.x & 0xffff0000u)); fmac_s(acc[2], w, __uint_as_float(v.y << 16)); fmac_s(acc[3], w, __uint_as_float(v.y & 0xffff0000u));
    fmac_s(acc[4], w, __uint_as_float(v.z << 16)); fmac_s(acc[5], w, __uint_as_float(v.z & 0xffff0000u)); fmac_s(acc[6], w, __uint_as_float(v.w << 16)); fmac_s(acc[7], w, __uint_as_float(v.w & 0xffff0000u));
}
constexpr float U8_SCALE = 256.f, V8_SCALE = 16.f;
typedef float f32x2c __attribute__((ext_vector_type(2)));
struct Row2 { v4u c[2]; };
__device__ __forceinline__ Row2 load_row8(const GAS unsigned char* base, unsigned e, unsigned lane16) { const GAS unsigned char* p = base + (size_t)e * 2048 + lane16; Row2 r; r.c[0] = *(const GAS v4u*)p; r.c[1] = *(const GAS v4u*)(p + 1024); return r; }
__device__ __forceinline__ float fma_s(float a, float b, float c) { float r; asm("v_fma_f32 %0, %1, %2, %3" : "=v"(r) : "v"(a), "v"(b), "v"(c)); return r; }
__device__ __forceinline__ float dot4_8(const float* a, unsigned w, float s) { const f32x2c lo = __builtin_amdgcn_cvt_pk_f32_fp8((int)w, false), hi = __builtin_amdgcn_cvt_pk_f32_fp8((int)w, true);
    s = fma_s(a[0], lo.x, s); s = fma_s(a[1], lo.y, s); s = fma_s(a[2], hi.x, s); s = fma_s(a[3], hi.y, s); return s; }
__device__ __forceinline__ void axpy4_8(float* acc, unsigned w, float ws) { const f32x2c lo = __builtin_amdgcn_cvt_pk_f32_fp8((int)w, false), hi = __builtin_amdgcn_cvt_pk_f32_fp8((int)w, true);
    fmac_s(acc[0], ws, lo.x); fmac_s(acc[1], ws, lo.y); fmac_s(acc[2], ws, hi.x); fmac_s(acc[3], ws, hi.y); }
template <bool DRY> __device__ __forceinline__ void gather_phase(const Args& A, Frame& F) {
    unsigned char* ws = A.ws;
    const GAS unsigned char* UB = (const GAS unsigned char*)(ws + WS_UB); const GAS unsigned char* VB = (const GAS unsigned char*)(ws + WS_VB);
    float* H1 = (float*)(ws + WS_H1); bf16* H1B = (bf16*)(ws + WS_H1B); const float* psh1 = (const float*)(ws + WS_PSH1); const int* IDX = (const int*)(ws + WS_IDX); const float* GATE = (const float*)(ws + WS_GATE); float* rsh2 = (float*)(ws + WS_RSH2);
    const int gw = F.vcu * NWAVES + F.wave, NGW = F.G * NWAVES;
    for (int tk = gw; tk < T_TOK; tk += NGW) {
        const int lane = lane_id(); const unsigned lane16 = (unsigned)lane * 16u; const int kq = (lane >> 2) & 15;
        const float rs = (1.0f / sqrtf(wave_sum64(psh1[(size_t)tk * 64 + lane]) * (1.f / 2048.f) + 1e-6f)) * (1.f / U8_SCALE);
        float af[32], acc[32];
#pragma unroll
        for (int j = 0; j < 2; ++j) { const v4u a0 = *(const GAS v4u*)(H1B + (size_t)tk * 2048 + 1024 * j + 16 * lane), a1 = *(const GAS v4u*)(H1B + (size_t)tk * 2048 + 1024 * j + 16 * lane + 8);
            const unsigned aw[8] = {a0.x, a0.y, a0.z, a0.w, a1.x, a1.y, a1.z, a1.w};
#pragma unroll
            for (int q = 0; q < 8; ++q) { af[16 * j + 2 * q] = __uint_as_float(aw[q] << 16); af[16 * j + 2 * q + 1] = __uint_as_float(aw[q] & 0xffff0000u); }
#pragma unroll
            for (int q = 0; q < 4; ++q) { const f32x4 x = *(const GAS f32x4*)(H1 + (size_t)tk * 2048 + 1024 * j + 16 * lane + 4 * q); acc[16 * j + 4 * q] = x[0]; acc[16 * j + 4 * q + 1] = x[1]; acc[16 * j + 4 * q + 2] = x[2]; acc[16 * j + 4 * q + 3] = x[3]; } }
        for (int hd = 0; hd < 8; ++hd) {
            const int ev = IDX[(size_t)tk * 128 + hd * 16 + kq]; const float gv = GATE[(size_t)tk * 128 + hd * 16 + kq];
            float p[16];
            Row2 bA[4], bB[4];
#define LD4(buf, base, k0) do { _Pragma("unroll") for (int q = 0; q < 4; ++q) buf[q] = load_row8(base, (unsigned)__builtin_amdgcn_readlane(ev, 4 * ((k0) + q)), lane16); } while (0)
#define DOT4(buf, k0) do { _Pragma("unroll") for (int q = 0; q < 4; ++q) { float s = 0.f; _Pragma("unroll") for (int j = 0; j < 2; ++j) { s = dot4_8(af + 16 * j, buf[q].c[j].x, s); s = dot4_8(af + 16 * j + 4, buf[q].c[j].y, s); s = dot4_8(af + 16 * j + 8, buf[q].c[j].z, s); s = dot4_8(af + 16 * j + 12, buf[q].c[j].w, s); } p[(k0) + q] = s; } } while (0)
#define AX4(buf, k0) do { _Pragma("unroll") for (int q = 0; q < 4; ++q) { const float wk = __uint_as_float((unsigned)__builtin_amdgcn_readlane((int)__float_as_uint(w), 4 * ((k0) + q))); _Pragma("unroll") for (int j = 0; j < 2; ++j) { axpy4_8(acc + 16 * j, buf[q].c[j].x, wk); axpy4_8(acc + 16 * j + 4, buf[q].c[j].y, wk); axpy4_8(acc + 16 * j + 8, buf[q].c[j].z, wk); axpy4_8(acc + 16 * j + 12, buf[q].c[j].w, wk); } } } while (0)
            LD4(bA, UB, 0); LD4(bB, UB, 4); SBAR(); DOT4(bA, 0); SBAR(); LD4(bA, UB, 8); SBAR(); DOT4(bB, 4); SBAR(); LD4(bB, UB, 12); SBAR(); DOT4(bA, 8); SBAR(); LD4(bA, VB, 0); SBAR(); DOT4(bB, 12); SBAR(); LD4(bB, VB, 4); SBAR();
            { const bool b5 = lane & 32, b4 = lane & 16, b3 = lane & 8, b2 = lane & 4; float q8[8], q4[4], q2[2], q1;
#pragma unroll
              for (int i = 0; i < 8; ++i) { const float keep = b5 ? p[i + 8] : p[i], send = b5 ? p[i] : p[i + 8]; q8[i] = keep + __shfl_xor(send, 32); }
#pragma unroll
              for (int i = 0; i < 4; ++i) { const float keep = b4 ? q8[i + 4] : q8[i], send = b4 ? q8[i] : q8[i + 4]; q4[i] = keep + __shfl_xor(send, 16); }
#pragma unroll
              for (int i = 0; i < 2; ++i) { const float keep = b3 ? q4[i + 2] : q4[i], send = b3 ? q4[i] : q4[i + 2]; q2[i] = keep + __shfl_xor(send, 8); }
              { const float keep = b2 ? q2[1] : q2[0], send = b2 ? q2[0] : q2[1]; q1 = keep + __shfl_xor(send, 4); }
              q1 += __shfl_xor(q1, 2); q1 += __shfl_xor(q1, 1); p[0] = q1; }
            const float w = gv * gelu_f(p[0] * rs) * (1.f / V8_SCALE);
            SBAR(); AX4(bA, 0); SBAR(); LD4(bA, VB, 8); SBAR(); AX4(bB, 4); SBAR(); LD4(bB, VB, 12); SBAR(); AX4(bA, 8); SBAR(); AX4(bB, 12); SBAR();
#undef LD4
#undef DOT4
#undef AX4
        }
        float ss = 0.f;
        float* H1o = DRY ? (float*)(ws + WS_NA0) + (size_t)(tk & 2047) * 2048 : H1 + (size_t)tk * 2048; bf16* H1Bo = DRY ? (bf16*)(ws + WS_NGL) + (size_t)(tk & 2047) * 2048 : H1B + (size_t)tk * 2048;
#pragma unroll
        for (int j = 0; j < 2; ++j) {
#pragma unroll
            for (int q = 0; q < 2; ++q) { const f32x4 y0 = {acc[16 * j + 8 * q], acc[16 * j + 8 * q + 1], acc[16 * j + 8 * q + 2], acc[16 * j + 8 * q + 3]}, y1 = {acc[16 * j + 8 * q + 4], acc[16 * j + 8 * q + 5], acc[16 * j + 8 * q + 6], acc[16 * j + 8 * q + 7]}; ss += sq8(y0, y1);
                *(GAS f32x4*)(H1o + 1024 * j + 16 * lane + 8 * q) = y0; *(GAS f32x4*)(H1o + 1024 * j + 16 * lane + 8 * q + 4) = y1; *(GAS v4u*)(H1Bo + 1024 * j + 16 * lane + 8 * q) = pack8(y0, y1); } }
        ss = wave_sum64(ss); if (lane == 0 && !DRY) rsh2[tk] = 1.0f / sqrtf(ss * (1.f / 2048.f) + 1e-6f);
    }
}
#ifndef NSLICE_SHIFT
#define NSLICE_SHIFT 9
#endif
__device__ __forceinline__ void tok_load(const unsigned char* ws, int tk, int lane, float (&af)[32], float (&acc)[32], float& rs, int (&ev)[2], float (&gv)[2]) {
    const float* H1 = (const float*)(ws + WS_H1); const bf16* H1B = (const bf16*)(ws + WS_H1B); const float* psh1 = (const float*)(ws + WS_PSH1); const int* IDX = (const int*)(ws + WS_IDX); const float* GATE = (const float*)(ws + WS_GATE);
    rs = (1.0f / sqrtf(wave_sum64(psh1[(size_t)tk * 64 + lane]) * (1.f / 2048.f) + 1e-6f)) * (1.f / U8_SCALE);
#pragma unroll
    for (int j = 0; j < 2; ++j) { const v4u a0 = *(const GAS v4u*)(H1B + (size_t)tk * 2048 + 1024 * j + 16 * lane), a1 = *(const GAS v4u*)(H1B + (size_t)tk * 2048 + 1024 * j + 16 * lane + 8);
        const unsigned aw[8] = {a0.x, a0.y, a0.z, a0.w, a1.x, a1.y, a1.z, a1.w};
#pragma unroll
        for (int q = 0; q < 8; ++q) { af[16 * j + 2 * q] = __uint_as_float(aw[q] << 16); af[16 * j + 2 * q + 1] = __uint_as_float(aw[q] & 0xffff0000u); }
#pragma unroll
        for (int q = 0; q < 4; ++q) { const f32x4 x = *(const GAS f32x4*)(H1 + (size_t)tk * 2048 + 1024 * j + 16 * lane + 4 * q); acc[16 * j + 4 * q] = x[0]; acc[16 * j + 4 * q + 1] = x[1]; acc[16 * j + 4 * q + 2] = x[2]; acc[16 * j + 4 * q + 3] = x[3]; } }
    ev[0] = IDX[(size_t)tk * 128 + lane]; ev[1] = IDX[(size_t)tk * 128 + 64 + lane]; gv[0] = GATE[(size_t)tk * 128 + lane]; gv[1] = GATE[(size_t)tk * 128 + 64 + lane];
}
template <bool DRY> __device__ __forceinline__ void tok_store(unsigned char* ws, int tk, int lane, const float (&acc)[32]) {
    float* H1 = (float*)(ws + WS_H1); bf16* H1B = (bf16*)(ws + WS_H1B); float* rsh2 = (float*)(ws + WS_RSH2);
    float ss = 0.f;
    float* H1o = DRY ? (float*)(ws + WS_NA0) + (size_t)(tk & 2047) * 2048 : H1 + (size_t)tk * 2048; bf16* H1Bo = DRY ? (bf16*)(ws + WS_NGL) + (size_t)(tk & 2047) * 2048 : H1B + (size_t)tk * 2048;
#pragma unroll
    for (int j = 0; j < 2; ++j) {
#pragma unroll
        for (int q = 0; q < 2; ++q) { const f32x4 y0 = {acc[16 * j + 8 * q], acc[16 * j + 8 * q + 1], acc[16 * j + 8 * q + 2], acc[16 * j + 8 * q + 3]}, y1 = {acc[16 * j + 8 * q + 4], acc[16 * j + 8 * q + 5], acc[16 * j + 8 * q + 6], acc[16 * j + 8 * q + 7]}; ss += sq8(y0, y1);
            *(GAS f32x4*)(H1o + 1024 * j + 16 * lane + 8 * q) = y0; *(GAS f32x4*)(H1o + 1024 * j + 16 * lane + 8 * q + 4) = y1; *(GAS v4u*)(H1Bo + 1024 * j + 16 * lane + 8 * q) = pack8(y0, y1); } }
    ss = wave_sum64(ss); if (lane == 0 && !DRY) rsh2[tk] = 1.0f / sqrtf(ss * (1.f / 2048.f) + 1e-6f);
}
__device__ __forceinline__ float dot_row8(const float (&af)[32], const Row2& r) { float s = 0.f;
#pragma unroll
    for (int j = 0; j < 2; ++j) { s = dot4_8(af + 16 * j, r.c[j].x, s); s = dot4_8(af + 16 * j + 4, r.c[j].y, s); s = dot4_8(af + 16 * j + 8, r.c[j].z, s); s = dot4_8(af + 16 * j + 12, r.c[j].w, s); }
    return s; }
__device__ __forceinline__ void axpy_row8(float (&acc)[32], const Row2& r, float wk) {
#pragma unroll
    for (int j = 0; j < 2; ++j) { axpy4_8(acc + 16 * j, r.c[j].x, wk); axpy4_8(acc + 16 * j + 4, r.c[j].y, wk); axpy4_8(acc + 16 * j + 8, r.c[j].z, wk); axpy4_8(acc + 16 * j + 12, r.c[j].w, wk); } }
__device__ __forceinline__ void tok_slice(const GAS unsigned char* UB, const GAS unsigned char* VB, int s, int lane, unsigned lane16, const float (&af)[32], float (&acc)[32], float rs, const int (&ev)[2], const float (&gv)[2]) {
    unsigned long long m0 = __ballot((ev[0] >> NSLICE_SHIFT) == s), m1 = __ballot((ev[1] >> NSLICE_SHIFT) == s);
    while (m0 | m1) {
        int e0, e1; float g0, g1;
        if (m0) { const int i = __builtin_ctzll(m0); m0 &= m0 - 1; e0 = __builtin_amdgcn_readlane(ev[0], i); g0 = __uint_as_float((unsigned)__builtin_amdgcn_readlane((int)__float_as_uint(gv[0]), i)); }
        else { const int i = __builtin_ctzll(m1); m1 &= m1 - 1; e0 = __builtin_amdgcn_readlane(ev[1], i); g0 = __uint_as_float((unsigned)__builtin_amdgcn_readlane((int)__float_as_uint(gv[1]), i)); }
        if (m0) { const int i = __builtin_ctzll(m0); m0 &= m0 - 1; e1 = __builtin_amdgcn_readlane(ev[0], i); g1 = __uint_as_float((unsigned)__builtin_amdgcn_readlane((int)__float_as_uint(gv[0]), i)); }
        else if (m1) { const int i = __builtin_ctzll(m1); m1 &= m1 - 1; e1 = __builtin_amdgcn_readlane(ev[1], i); g1 = __uint_as_float((unsigned)__builtin_amdgcn_readlane((int)__float_as_uint(gv[1]), i)); }
        else { e1 = e0; g1 = 0.f; }
        const Row2 u0 = load_row8(UB, (unsigned)e0, lane16), u1 = load_row8(UB, (unsigned)e1, lane16), v0 = load_row8(VB, (unsigned)e0, lane16), v1 = load_row8(VB, (unsigned)e1, lane16);
        const float p0 = dot_row8(af, u0), p1 = dot_row8(af, u1);
        const bool b5 = lane & 32; float h = (b5 ? p1 : p0) + __shfl_xor(b5 ? p0 : p1, 32);
        h += __shfl_xor(h, 16); h += __shfl_xor(h, 8); h += __shfl_xor(h, 4); h += __shfl_xor(h, 2); h += __shfl_xor(h, 1);
        const float w = (b5 ? g1 : g0) * gelu_f(h * rs) * (1.f / V8_SCALE);
        const float w0 = __uint_as_float((unsigned)__builtin_amdgcn_readlane((int)__float_as_uint(w), 0)), w1 = __uint_as_float((unsigned)__builtin_amdgcn_readlane((int)__float_as_uint(w), 32));
        axpy_row8(acc, v0, w0); axpy_row8(acc, v1, w1);
    }
}
template <bool DRY> __device__ __forceinline__ void gather_sliced_phase(const Args& A, Frame& F) {
    unsigned char* ws = A.ws;
    const GAS unsigned char* UB = (const GAS unsigned char*)(ws + WS_UB); const GAS unsigned char* VB = (const GAS unsigned char*)(ws + WS_VB);
    const int gw = F.vcu * NWAVES + F.wave, NGW = F.G * NWAVES;
    for (int tk0 = 2 * gw; tk0 < T_TOK; tk0 += 2 * NGW) {
        const int lane = lane_id(); const unsigned lane16 = (unsigned)lane * 16u;
        float afA[32], accA[32], afB[32], accB[32], rsA, rsB; int evA[2], evB[2]; float gvA[2], gvB[2];
        tok_load(ws, tk0, lane, afA, accA, rsA, evA, gvA); tok_load(ws, tk0 + 1, lane, afB, accB, rsB, evB, gvB);
        for (int s = 0; s < (16384 >> NSLICE_SHIFT); ++s) { tok_slice(UB, VB, s, lane, lane16, afA, accA, rsA, evA, gvA); tok_slice(UB, VB, s, lane, lane16, afB, accB, rsB, evB, gvB); }
        tok_store<DRY>(ws, tk0, lane, accA); tok_store<DRY>(ws, tk0 + 1, lane, accB);
    }
}
#ifndef PROBE_NOV
#define PROBE_NOV 0
#endif
struct Tok2 { f32x2c af[16], acc[16]; float rs; int ev[2]; float gv[2]; };
__device__ __forceinline__ void tok2_load(const unsigned char* ws, int tk, int lane, Tok2& T) {
    const float* H1 = (const float*)(ws + WS_H1); const bf16* H1B = (const bf16*)(ws + WS_H1B); const float* psh1 = (const float*)(ws + WS_PSH1); const int* IDX = (const int*)(ws + WS_IDX); const float* GATE = (const float*)(ws + WS_GATE);
    T.rs = (1.0f / sqrtf(wave_sum64(psh1[(size_t)tk * 64 + lane]) * (1.f / 2048.f) + 1e-6f)) * (1.f / U8_SCALE);
#pragma unroll
    for (int j = 0; j < 2; ++j) { const v4u a0 = *(const GAS v4u*)(H1B + (size_t)tk * 2048 + 1024 * j + 16 * lane), a1 = *(const GAS v4u*)(H1B + (size_t)tk * 2048 + 1024 * j + 16 * lane + 8);
        const unsigned aw[8] = {a0.x, a0.y, a0.z, a0.w, a1.x, a1.y, a1.z, a1.w};
#pragma unroll
        for (int q = 0; q < 8; ++q) T.af[8 * j + q] = (f32x2c){__uint_as_float(aw[q] << 16), __uint_as_float(aw[q] & 0xffff0000u)};
#pragma unroll
        for (int q = 0; q < 4; ++q) { const f32x4 x = *(const GAS f32x4*)(H1 + (size_t)tk * 2048 + 1024 * j + 16 * lane + 4 * q); T.acc[8 * j + 2 * q] = (f32x2c){x[0], x[1]}; T.acc[8 * j + 2 * q + 1] = (f32x2c){x[2], x[3]}; } }
    T.ev[0] = IDX[(size_t)tk * 128 + lane]; T.ev[1] = IDX[(size_t)tk * 128 + 64 + lane]; T.gv[0] = GATE[(size_t)tk * 128 + lane]; T.gv[1] = GATE[(size_t)tk * 128 + 64 + lane];
}
template <bool DRY> __device__ __forceinline__ void tok2_store(unsigned char* ws, int tk, int lane, const Tok2& T) {
    float* H1 = (float*)(ws + WS_H1); bf16* H1B = (bf16*)(ws + WS_H1B); float* rsh2 = (float*)(ws + WS_RSH2);
    float ss = 0.f;
    float* H1o = DRY ? (float*)(ws + WS_NA0) + (size_t)(tk & 2047) * 2048 : H1 + (size_t)tk * 2048; bf16* H1Bo = DRY ? (bf16*)(ws + WS_NGL) + (size_t)(tk & 2047) * 2048 : H1B + (size_t)tk * 2048;
#pragma unroll
    for (int j = 0; j < 2; ++j) {
#pragma unroll
        for (int q = 0; q < 2; ++q) { const f32x4 y0 = {T.acc[8 * j + 4 * q].x, T.acc[8 * j + 4 * q].y, T.acc[8 * j + 4 * q + 1].x, T.acc[8 * j + 4 * q + 1].y}, y1 = {T.acc[8 * j + 4 * q + 2].x, T.acc[8 * j + 4 * q + 2].y, T.acc[8 * j + 4 * q + 3].x, T.acc[8 * j + 4 * q + 3].y}; ss += sq8(y0, y1);
            *(GAS f32x4*)(H1o + 1024 * j + 16 * lane + 8 * q) = y0; *(GAS f32x4*)(H1o + 1024 * j + 16 * lane + 8 * q + 4) = y1; *(GAS v4u*)(H1Bo + 1024 * j + 16 * lane + 8 * q) = pack8(y0, y1); } }
    ss = wave_sum64(ss); if (lane == 0 && !DRY) rsh2[tk] = 1.0f / sqrtf(ss * (1.f / 2048.f) + 1e-6f);
}
__device__ __forceinline__ float dot_row8p(const Tok2& T, const Row2& r) { f32x2c s0 = {0.f, 0.f}, s1 = {0.f, 0.f}, s2 = {0.f, 0.f}, s3 = {0.f, 0.f};
#pragma unroll
    for (int j = 0; j < 2; ++j) { const unsigned w[4] = {r.c[j].x, r.c[j].y, r.c[j].z, r.c[j].w};
#pragma unroll
        for (int d = 0; d < 4; ++d) { const f32x2c lo = __builtin_amdgcn_cvt_pk_f32_fp8((int)w[d], false), hi = __builtin_amdgcn_cvt_pk_f32_fp8((int)w[d], true);
            if (j == 0) { s0 = __builtin_elementwise_fma(T.af[2 * d], lo, s0); s1 = __builtin_elementwise_fma(T.af[2 * d + 1], hi, s1); }
            else { s2 = __builtin_elementwise_fma(T.af[8 + 2 * d], lo, s2); s3 = __builtin_elementwise_fma(T.af[8 + 2 * d + 1], hi, s3); } } }
    const f32x2c t = (s0 + s1) + (s2 + s3); return t.x + t.y; }
__device__ __forceinline__ void axpy_row8p(Tok2& T, const Row2& r, float wk) { const f32x2c w2 = {wk, wk};
#pragma unroll
    for (int j = 0; j < 2; ++j) { const unsigned w[4] = {r.c[j].x, r.c[j].y, r.c[j].z, r.c[j].w};
#pragma unroll
        for (int d = 0; d < 4; ++d) { const f32x2c lo = __builtin_amdgcn_cvt_pk_f32_fp8((int)w[d], false), hi = __builtin_amdgcn_cvt_pk_f32_fp8((int)w[d], true);
            T.acc[8 * j + 2 * d] = __builtin_elementwise_fma(w2, lo, T.acc[8 * j + 2 * d]); T.acc[8 * j + 2 * d + 1] = __builtin_elementwise_fma(w2, hi, T.acc[8 * j + 2 * d + 1]); } } }
__device__ __forceinline__ float dpp_add(float v, const int ctrl, const int rmask) { return v; }
#define DPP_ADD(v, ctrl, rmask) v += __uint_as_float((unsigned)__builtin_amdgcn_update_dpp(0, (int)__float_as_uint(v), ctrl, rmask, 0xF, true))
__device__ __forceinline__ float reduce2(float p0, float p1) {
    auto rr = __builtin_amdgcn_permlane32_swap(__float_as_uint(p0), __float_as_uint(p1), false, false);
    float h = __uint_as_float(rr[0]) + __uint_as_float(rr[1]);
    DPP_ADD(h, 0xB1, 0xF); DPP_ADD(h, 0x4E, 0xF); DPP_ADD(h, 0x141, 0xF); DPP_ADD(h, 0x140, 0xF); DPP_ADD(h, 0x142, 0xA);
    return h; }
__device__ __forceinline__ int take2(unsigned long long& m0, unsigned long long& m1, const Tok2& T, int& e0, float& g0, int& e1, float& g1) {
    if (!(m0 | m1)) return 0;
    if (m0) { const int i = __builtin_ctzll(m0); m0 &= m0 - 1; e0 = __builtin_amdgcn_readlane(T.ev[0], i); g0 = __uint_as_float((unsigned)__builtin_amdgcn_readlane((int)__float_as_uint(T.gv[0]), i)); }
    else { const int i = __builtin_ctzll(m1); m1 &= m1 - 1; e0 = __builtin_amdgcn_readlane(T.ev[1], i); g0 = __uint_as_float((unsigned)__builtin_amdgcn_readlane((int)__float_as_uint(T.gv[1]), i)); }
    if (m0) { const int i = __builtin_ctzll(m0); m0 &= m0 - 1; e1 = __builtin_amdgcn_readlane(T.ev[0], i); g1 = __uint_as_float((unsigned)__builtin_amdgcn_readlane((int)__float_as_uint(T.gv[0]), i)); return 2; }
    if (m1) { const int i = __builtin_ctzll(m1); m1 &= m1 - 1; e1 = __builtin_amdgcn_readlane(T.ev[1], i); g1 = __uint_as_float((unsigned)__builtin_amdgcn_readlane((int)__float_as_uint(T.gv[1]), i)); return 2; }
    e1 = e0; g1 = 0.f; return 1;
}
__device__ __forceinline__ void batch2(Tok2& T, const Row2& u0, const Row2& u1, const Row2& v0, const Row2& v1, float g0, float g1, int lane) {
    const float h = reduce2(dot_row8p(T, u0), dot_row8p(T, u1));
    const float w = ((lane & 32) ? g1 : g0) * gelu_f(h * T.rs) * (1.f / V8_SCALE);
    const float w0 = __uint_as_float((unsigned)__builtin_amdgcn_readlane((int)__float_as_uint(w), 31)), w1 = __uint_as_float((unsigned)__builtin_amdgcn_readlane((int)__float_as_uint(w), 63));
    axpy_row8p(T, v0, w0); axpy_row8p(T, v1, w1);
}
#ifndef GATHER_PREFETCH
#define GATHER_PREFETCH 0
#endif
constexpr int SLICE_EXPERTS = 1 << NSLICE_SHIFT, SLICE_SHARE = 2048;
static_assert(NSLICE_SHIFT != 8 || SLICE_EXPERTS * 2048 / 256 == SLICE_SHARE, "prefetch share");
__device__ __forceinline__ unsigned slice_prefetch(const GAS unsigned char* UB, const GAS unsigned char* VB, int snext, unsigned wx) {
    const GAS unsigned char* pu = UB + (size_t)snext * (SLICE_EXPERTS * 2048) + (size_t)wx * SLICE_SHARE; const GAS unsigned char* pv = VB + (size_t)snext * (SLICE_EXPERTS * 2048) + (size_t)wx * SLICE_SHARE;
    unsigned d;
    asm volatile("s_load_dword %0, %1, 0x0\n\ts_load_dword %0, %1, 0x80\n\ts_load_dword %0, %1, 0x100\n\ts_load_dword %0, %1, 0x180\n\ts_load_dword %0, %1, 0x200\n\ts_load_dword %0, %1, 0x280\n\ts_load_dword %0, %1, 0x300\n\ts_load_dword %0, %1, 0x380\n\ts_load_dword %0, %1, 0x400\n\ts_load_dword %0, %1, 0x480\n\ts_load_dword %0, %1, 0x500\n\ts_load_dword %0, %1, 0x580\n\ts_load_dword %0, %1, 0x600\n\ts_load_dword %0, %1, 0x680\n\ts_load_dword %0, %1, 0x700\n\ts_load_dword %0, %1, 0x780\n\ts_load_dword %0, %2, 0x0\n\ts_load_dword %0, %2, 0x80\n\ts_load_dword %0, %2, 0x100\n\ts_load_dword %0, %2, 0x180\n\ts_load_dword %0, %2, 0x200\n\ts_load_dword %0, %2, 0x280\n\ts_load_dword %0, %2, 0x300\n\ts_load_dword %0, %2, 0x380\n\ts_load_dword %0, %2, 0x400\n\ts_load_dword %0, %2, 0x480\n\ts_load_dword %0, %2, 0x500\n\ts_load_dword %0, %2, 0x580\n\ts_load_dword %0, %2, 0x600\n\ts_load_dword %0, %2, 0x680\n\ts_load_dword %0, %2, 0x700\n\ts_load_dword %0, %2, 0x780\n\ts_nop 0" : "=&s"(d) : "s"(pu), "s"(pv));
    return d;
}
__device__ __forceinline__ void slice_prefetch_done(unsigned& d) { asm volatile("s_waitcnt lgkmcnt(0)" : "+s"(d)); }
template <bool DRY> __device__ __forceinline__ void gather_sliced2_phase(const Args& A, Frame& F) {
    unsigned char* ws = A.ws;
    const GAS unsigned char* UB = (const GAS unsigned char*)(ws + WS_UB); const GAS unsigned char* VB = (const GAS unsigned char*)(ws + WS_VB);
    const int gw = F.vcu * NWAVES + F.wave, NGW = F.G * NWAVES;
    for (int tk0 = 2 * gw; tk0 < T_TOK; tk0 += 2 * NGW) {
        const int lane = lane_id(); const unsigned lane16 = (unsigned)lane * 16u;
        Tok2 TA, TB; tok2_load(ws, tk0, lane, TA); tok2_load(ws, tk0 + 1, lane, TB);
        const unsigned wx = (unsigned)((F.vcu & 31) * NWAVES + F.wave);
        for (int s = 0; s < (16384 >> NSLICE_SHIFT); ++s) {
            unsigned pf_d = 0u; if (GATHER_PREFETCH && NSLICE_SHIFT == 8) pf_d = slice_prefetch(UB, VB, (s + 1) & ((16384 >> NSLICE_SHIFT) - 1), wx);
            unsigned long long a0 = __ballot((TA.ev[0] >> NSLICE_SHIFT) == s), a1 = __ballot((TA.ev[1] >> NSLICE_SHIFT) == s), b0 = __ballot((TB.ev[0] >> NSLICE_SHIFT) == s), b1 = __ballot((TB.ev[1] >> NSLICE_SHIFT) == s);
            while (a0 | a1 | b0 | b1) {
                int eA0 = 0, eA1 = 0, eB0 = 0, eB1 = 0; float gA0 = 0.f, gA1 = 0.f, gB0 = 0.f, gB1 = 0.f;
                const int nA = take2(a0, a1, TA, eA0, gA0, eA1, gA1), nB = take2(b0, b1, TB, eB0, gB0, eB1, gB1);
                Row2 uA0, uA1, vA0, vA1, uB0, uB1, vB0, vB1;
                if (DRY && PROBE_NOV == 2) { uA0.c[0] = uA0.c[1] = (v4u){(unsigned)eA0, (unsigned)lane, 0x38383838u, 0x3c3c3c3cu}; uA1 = uA0; vA0 = uA0; vA1 = uA0; uB0 = uA0; uB1 = uA0; vB0 = uA0; vB1 = uA0; } else
                if (nA) { uA0 = load_row8(UB, (unsigned)eA0, lane16); uA1 = load_row8(UB, (unsigned)eA1, lane16); if (DRY && PROBE_NOV) { vA0 = uA0; vA1 = uA1; } else { vA0 = load_row8(VB, (unsigned)eA0, lane16); vA1 = load_row8(VB, (unsigned)eA1, lane16); } }
                if (!(DRY && PROBE_NOV == 2)) if (nB) { uB0 = load_row8(UB, (unsigned)eB0, lane16); uB1 = load_row8(UB, (unsigned)eB1, lane16); if (DRY && PROBE_NOV) { vB0 = uB0; vB1 = uB1; } else { vB0 = load_row8(VB, (unsigned)eB0, lane16); vB1 = load_row8(VB, (unsigned)eB1, lane16); } }
                if (nA) batch2(TA, uA0, uA1, vA0, vA1, gA0, gA1, lane);
                if (nB) batch2(TB, uB0, uB1, vB0, vB1, gB0, gB1, lane);
            }
            if (GATHER_PREFETCH && NSLICE_SHIFT == 8) slice_prefetch_done(pf_d);
        }
        tok2_store<DRY>(ws, tk0, lane, TA); tok2_store<DRY>(ws, tk0 + 1, lane, TB);
    }
}
struct Acc2 { f32x2c acc[16]; float rs; int ev[2]; float gv[2]; };
struct It8 { int nA, nB; float gA0, gA1, gB0, gB1; Row2 uA0, uA1, vA0, vA1, uB0, uB1, vB0, vB1; };
__device__ __forceinline__ void tok3_load(const unsigned char* ws, int tk, int lane, Acc2& T, LAS unsigned char* afl  ) {
    const float* H1 = (const float*)(ws + WS_H1); const bf16* H1B = (const bf16*)(ws + WS_H1B); const float* psh1 = (const float*)(ws + WS_PSH1); const int* IDX = (const int*)(ws + WS_IDX); const float* GATE = (const float*)(ws + WS_GATE);
    T.rs = (1.0f / sqrtf(wave_sum64(psh1[(size_t)tk * 64 + lane]) * (1.f / 2048.f) + 1e-6f)) * (1.f / U8_SCALE);
#pragma unroll
    for (int j = 0; j < 2; ++j) { const v4u a0 = *(const GAS v4u*)(H1B + (size_t)tk * 2048 + 1024 * j + 16 * lane), a1 = *(const GAS v4u*)(H1B + (size_t)tk * 2048 + 1024 * j + 16 * lane + 8);
        const unsigned aw[8] = {a0.x, a0.y, a0.z, a0.w, a1.x, a1.y, a1.z, a1.w};
#pragma unroll
        for (int d = 0; d < 4; ++d) *(LAS f32x4*)(afl + (4 * j + d) * 1024 + lane * 16) = (f32x4){__uint_as_float(aw[2 * d] << 16), __uint_as_float(aw[2 * d] & 0xffff0000u), __uint_as_float(aw[2 * d + 1] << 16), __uint_as_float(aw[2 * d + 1] & 0xffff0000u)};
#pragma unroll
        for (int q = 0; q < 4; ++q) { const f32x4 x = *(const GAS f32x4*)(H1 + (size_t)tk * 2048 + 1024 * j + 16 * lane + 4 * q); T.acc[8 * j + 2 * q] = (f32x2c){x[0], x[1]}; T.acc[8 * j + 2 * q + 1] = (f32x2c){x[2], x[3]}; } }
    T.ev[0] = IDX[(size_t)tk * 128 + lane]; T.ev[1] = IDX[(size_t)tk * 128 + 64 + lane]; T.gv[0] = GATE[(size_t)tk * 128 + lane]; T.gv[1] = GATE[(size_t)tk * 128 + 64 + lane];
}
template <bool DRY> __device__ __forceinline__ void tok3_store(unsigned char* ws, int tk, int lane, const Acc2& T) {
    float* H1 = (float*)(ws + WS_H1); bf16* H1B = (bf16*)(ws + WS_H1B); float* rsh2 = (float*)(ws + WS_RSH2);
    float ss = 0.f;
    float* H1o = DRY ? (float*)(ws + WS_NA0) + (size_t)(tk & 2047) * 2048 : H1 + (size_t)tk * 2048; bf16* H1Bo = DRY ? (bf16*)(ws + WS_NGL) + (size_t)(tk & 2047) * 2048 : H1B + (size_t)tk * 2048;
#pragma unroll
    for (int j = 0; j < 2; ++j) {
#pragma unroll
        for (int q = 0; q < 2; ++q) { const f32x4 y0 = {T.acc[8 * j + 4 * q].x, T.acc[8 * j + 4 * q].y, T.acc[8 * j + 4 * q + 1].x, T.acc[8 * j + 4 * q + 1].y}, y1 = {T.acc[8 * j + 4 * q + 2].x, T.acc[8 * j + 4 * q + 2].y, T.acc[8 * j + 4 * q + 3].x, T.acc[8 * j + 4 * q + 3].y}; ss += sq8(y0, y1);
            *(GAS f32x4*)(H1o + 1024 * j + 16 * lane + 8 * q) = y0; *(GAS f32x4*)(H1o + 1024 * j + 16 * lane + 8 * q + 4) = y1; *(GAS v4u*)(H1Bo + 1024 * j + 16 * lane + 8 * q) = pack8(y0, y1); } }
    ss = wave_sum64(ss); if (lane == 0 && !DRY) rsh2[tk] = 1.0f / sqrtf(ss * (1.f / 2048.f) + 1e-6f);
}
__device__ __forceinline__ void batch3(Acc2& T, const LAS unsigned char* afl, const Row2& u0, const Row2& u1, const Row2& v0, const Row2& v1, float g0, float g1, int lane) {
    f32x2c s0 = {0.f, 0.f}, s1 = {0.f, 0.f}, t0 = {0.f, 0.f}, t1 = {0.f, 0.f};
#pragma unroll
    for (int j = 0; j < 2; ++j) { const unsigned w0[4] = {u0.c[j].x, u0.c[j].y, u0.c[j].z, u0.c[j].w}, w1[4] = {u1.c[j].x, u1.c[j].y, u1.c[j].z, u1.c[j].w};
#pragma unroll
        for (int d = 0; d < 4; ++d) { const f32x4 a = *(const LAS f32x4*)(afl + (4 * j + d) * 1024 + lane * 16); const f32x2c alo = {a[0], a[1]}, ahi = {a[2], a[3]};
            s0 = __builtin_elementwise_fma(alo, __builtin_amdgcn_cvt_pk_f32_fp8((int)w0[d], false), s0); s1 = __builtin_elementwise_fma(ahi, __builtin_amdgcn_cvt_pk_f32_fp8((int)w0[d], true), s1);
            t0 = __builtin_elementwise_fma(alo, __builtin_amdgcn_cvt_pk_f32_fp8((int)w1[d], false), t0); t1 = __builtin_elementwise_fma(ahi, __builtin_amdgcn_cvt_pk_f32_fp8((int)w1[d], true), t1); } }
    const f32x2c ps = s0 + s1, pt = t0 + t1;
    const float h = reduce2(ps.x + ps.y, pt.x + pt.y);
    const float w = ((lane & 32) ? g1 : g0) * gelu_f(h * T.rs) * (1.f / V8_SCALE);
    const float wa = __uint_as_float((unsigned)__builtin_amdgcn_readlane((int)__float_as_uint(w), 31)), wb = __uint_as_float((unsigned)__builtin_amdgcn_readlane((int)__float_as_uint(w), 63));
    const f32x2c wa2 = {wa, wa}, wb2 = {wb, wb};
#pragma unroll
    for (int j = 0; j < 2; ++j) { const unsigned w0[4] = {v0.c[j].x, v0.c[j].y, v0.c[j].z, v0.c[j].w}, w1[4] = {v1.c[j].x, v1.c[j].y, v1.c[j].z, v1.c[j].w};
#pragma unroll
        for (int d = 0; d < 4; ++d) {
            T.acc[8 * j + 2 * d] = __builtin_elementwise_fma(wa2, __builtin_amdgcn_cvt_pk_f32_fp8((int)w0[d], false), T.acc[8 * j + 2 * d]); T.acc[8 * j + 2 * d + 1] = __builtin_elementwise_fma(wa2, __builtin_amdgcn_cvt_pk_f32_fp8((int)w0[d], true), T.acc[8 * j + 2 * d + 1]);
            T.acc[8 * j + 2 * d] = __builtin_elementwise_fma(wb2, __builtin_amdgcn_cvt_pk_f32_fp8((int)w1[d], false), T.acc[8 * j + 2 * d]); T.acc[8 * j + 2 * d + 1] = __builtin_elementwise_fma(wb2, __builtin_amdgcn_cvt_pk_f32_fp8((int)w1[d], true), T.acc[8 * j + 2 * d + 1]); } }
}
struct Sweep { int s; unsigned long long a0, a1, b0, b1; };
__device__ __forceinline__ int take2b(unsigned long long& m0, unsigned long long& m1, const int (&ev)[2], const float (&gv)[2], int& e0, float& g0, int& e1, float& g1) {
    if (!(m0 | m1)) return 0;
    if (m0) { const int i = __builtin_ctzll(m0); m0 &= m0 - 1; e0 = __builtin_amdgcn_readlane(ev[0], i); g0 = __uint_as_float((unsigned)__builtin_amdgcn_readlane((int)__float_as_uint(gv[0]), i)); }
    else { const int i = __builtin_ctzll(m1); m1 &= m1 - 1; e0 = __builtin_amdgcn_readlane(ev[1], i); g0 = __uint_as_float((unsigned)__builtin_amdgcn_readlane((int)__float_as_uint(gv[1]), i)); }
    if (m0) { const int i = __builtin_ctzll(m0); m0 &= m0 - 1; e1 = __builtin_amdgcn_readlane(ev[0], i); g1 = __uint_as_float((unsigned)__builtin_amdgcn_readlane((int)__float_as_uint(gv[0]), i)); return 2; }
    if (m1) { const int i = __builtin_ctzll(m1); m1 &= m1 - 1; e1 = __builtin_amdgcn_readlane(ev[1], i); g1 = __uint_as_float((unsigned)__builtin_amdgcn_readlane((int)__float_as_uint(gv[1]), i)); return 2; }
    e1 = e0; g1 = 0.f; return 1;
}
__device__ __forceinline__ void gen_load(Sweep& W, const Acc2& TA, const Acc2& TB, const GAS unsigned char* UB, const GAS unsigned char* VB, unsigned lane16, It8& I) {
    while (!(W.a0 | W.a1 | W.b0 | W.b1) && W.s + 1 < (16384 >> NSLICE_SHIFT)) { ++W.s;
        W.a0 = __ballot((TA.ev[0] >> NSLICE_SHIFT) == W.s); W.a1 = __ballot((TA.ev[1] >> NSLICE_SHIFT) == W.s); W.b0 = __ballot((TB.ev[0] >> NSLICE_SHIFT) == W.s); W.b1 = __ballot((TB.ev[1] >> NSLICE_SHIFT) == W.s); }
    int eA0 = 0, eA1 = 0, eB0 = 0, eB1 = 0; I.gA0 = 0.f; I.gA1 = 0.f; I.gB0 = 0.f; I.gB1 = 0.f;
    I.nA = take2b(W.a0, W.a1, TA.ev, TA.gv, eA0, I.gA0, eA1, I.gA1); I.nB = take2b(W.b0, W.b1, TB.ev, TB.gv, eB0, I.gB0, eB1, I.gB1);
    if (!I.nA) { eA0 = eB0; eA1 = eB1; } if (!I.nB) { eB0 = eA0; eB1 = eA1; }
    I.uA0 = load_row8(UB, (unsigned)eA0, lane16); I.uA1 = load_row8(UB, (unsigned)eA1, lane16); I.vA0 = load_row8(VB, (unsigned)eA0, lane16); I.vA1 = load_row8(VB, (unsigned)eA1, lane16);
    I.uB0 = load_row8(UB, (unsigned)eB0, lane16); I.uB1 = load_row8(UB, (unsigned)eB1, lane16); I.vB0 = load_row8(VB, (unsigned)eB0, lane16); I.vB1 = load_row8(VB, (unsigned)eB1, lane16);
}
template <bool DRY> __device__ __forceinline__ void gather_sliced3_phase(const Args& A, Frame& F) {
    unsigned char* ws = A.ws;
    const GAS unsigned char* UB = (const GAS unsigned char*)(ws + WS_UB); const GAS unsigned char* VB = (const GAS unsigned char*)(ws + WS_VB);
    const int gw = F.vcu * NWAVES + F.wave, NGW = F.G * NWAVES;
    LAS unsigned char* aflA = F.lds + RING_OFF + F.wave * 16384; LAS unsigned char* aflB = aflA + 8192;
    for (int tk0 = 2 * gw; tk0 < T_TOK; tk0 += 2 * NGW) {
        const int lane = lane_id(); const unsigned lane16 = (unsigned)lane * 16u;
        Acc2 TA, TB; tok3_load(ws, tk0, lane, TA, aflA); tok3_load(ws, tk0 + 1, lane, TB, aflB);
        Sweep W; W.s = -1; W.a0 = W.a1 = W.b0 = W.b1 = 0ull;
        It8 X, Y;
        gen_load(W, TA, TB, UB, VB, lane16, X);
        for (;;) {
            gen_load(W, TA, TB, UB, VB, lane16, Y);
            if (X.nA) batch3(TA, aflA, X.uA0, X.uA1, X.vA0, X.vA1, X.gA0, X.gA1, lane);
            if (X.nB) batch3(TB, aflB, X.uB0, X.uB1, X.vB0, X.vB1, X.gB0, X.gB1, lane);
            if (!(Y.nA | Y.nB)) break;
            gen_load(W, TA, TB, UB, VB, lane16, X);
            if (Y.nA) batch3(TA, aflA, Y.uA0, Y.uA1, Y.vA0, Y.vA1, Y.gA0, Y.gA1, lane);
            if (Y.nB) batch3(TB, aflB, Y.uB0, Y.uB1, Y.vB0, Y.vB1, Y.gB0, Y.gB1, lane);
            if (!(X.nA | X.nB)) break;
        }
        tok3_store<DRY>(ws, tk0, lane, TA); tok3_store<DRY>(ws, tk0 + 1, lane, TB);
    }
}
__device__ __forceinline__ void final_phase(const Args& A, Frame& F) {
    unsigned char* ws = A.ws; const float* psh3 = (const float*)(ws + WS_PSH3); const float* gf = (const float*)A.in[25]; float* out = A.out;
    const int gw = F.vcu * NWAVES + F.wave, NGW = F.G * NWAVES;
    for (int tk = gw; tk < T_TOK; tk += NGW) { const int lane = lane_id();
        const float rs = 1.0f / sqrtf(wave_sum64(psh3[(size_t)tk * 64 + lane]) * (1.f / 2048.f) + 1e-6f);
#pragma unroll
        for (int j = 0; j < 8; ++j) { GAS f32x4* o = (GAS f32x4*)(out + (size_t)tk * 2048 + 256 * j) + lane; const f32x4 g = *((const GAS f32x4*)(gf + 256 * j) + lane); *o = *o * rs * g; } }
}
#define PH2_BODY \
        { pg8::Gemm g{(const bf16*)(ws + WS_CQ), (const bf16*)(ws + WS_WT_UQ), T_TOK, 1536, 512}; pg8::StaticOrder S; S.init(T_TOK, 1536, F.G, (int)blockIdx.x); \
          LAS float* tab = (LAS float*)(F.lds + TAB_OFF); setup_rowtab(tab, (const float*)(ws + WS_PSCQ), 16, 1.f / 512.f, S, F.wave); __syncthreads(); \
          EpiQ E{tab, (bf16*)(ws + WS_Q), (const f32x2v*)(ws + WS_CS)}; pg8::gemm_phase<EpiQ, pg8::StaticOrder, true, true>(F.lds + RING_OFF, g, S, E, F.wave); } \
        __syncthreads(); \
        { pg8::Gemm g{(const bf16*)(ws + WS_CKV), (const bf16*)(ws + WS_WT_UKV), T_TOK, 2048, 256}; pg8::StaticOrder S; S.init(T_TOK, 2048, F.G, (int)blockIdx.x); \
          LAS float* tab = (LAS float*)(F.lds + TAB_OFF); setup_rowtab(tab, (const float*)(ws + WS_PSCKV), 8, 1.f / 256.f, S, F.wave); __syncthreads(); \
          EpiKV E{tab, (bf16*)(ws + WS_KN), (bf16*)(ws + WS_VV)}; pg8::gemm_phase<EpiKV, pg8::StaticOrder, true, true>(F.lds + RING_OFF, g, S, E, F.wave); } \
        __syncthreads(); \
        sgu_phase(args, F); __syncthreads();

#define PH4_BODY \
        { pg8::Gemm g{(const bf16*)(ws + WS_MIX), (const bf16*)(ws + WS_WT_OUT), T_TOK, 2048, 2048}; pg8::StaticOrder S; S.init(T_TOK, 2048, F.G, (int)blockIdx.x); \
          LAS float* tab = (LAS float*)(F.lds + TAB_OFF); setup_rowtab(tab, (const float*)(ws + WS_PSA), 8, 1.f / 1024.f, S, F.wave); setup_rowtab(tab + 256, (const float*)(ws + WS_PSS), 16, 1.f / 1024.f, S, F.wave); __syncthreads(); \
          EpiOut E{tab, (const float*)args.in[0], (float*)(ws + WS_H1), (bf16*)(ws + WS_H1B), (float*)(ws + WS_PSH1)}; pg8::gemm_phase<EpiOut, pg8::StaticOrder, true, true>(F.lds + RING_OFF, g, S, E, F.wave); } __syncthreads();

#define PH5_BODY \
        { pg8::Gemm g{(const bf16*)(ws + WS_H1B), (const bf16*)(ws + WS_WT_PQ), T_TOK, 2048, 2048}; pg8::StaticOrder S; S.init(T_TOK, 2048, F.G, (int)blockIdx.x); \
          LAS float* tab = (LAS float*)(F.lds + TAB_OFF); setup_rowtab(tab, (const float*)(ws + WS_PSH1), 64, 1.f / 2048.f, S, F.wave); __syncthreads(); \
          EpiPQ E{tab, (bf16*)(ws + WS_R1)}; pg8::gemm_phase<EpiPQ, pg8::StaticOrder, true, true>(F.lds + RING_OFF, g, S, E, F.wave); }

#define PH8_BODY \
        { pg8::Gemm g{(const bf16*)(ws + WS_H1B), (const bf16*)(ws + WS_WT_PG), T_TOK, 2048, 2048}; pg8::StaticOrder S; S.init(T_TOK, 2048, F.G, (int)blockIdx.x); \
          EpiPLE E{(const float*)(ws + WS_RSH2), (const float*)(ws + WS_H1), (const bf16*)(ws + WS_PPROJ), args.out, (float*)(ws + WS_PSH3)}; pg8::gemm_phase<EpiPLE, pg8::StaticOrder, true, true>(F.lds + RING_OFF, g, S, E, F.wave); } __syncthreads();

#define PHASES_2_9 \
    if (IN(2)) { if (REPEAT_PH == 2) { PH2_BODY __syncthreads(); } PH2_BODY SEAM(2); } \
    if (IN(3)) { if (REPEAT_PH == 3) { attn_phase(args, F); __syncthreads(); } attn_phase(args, F); SEAM(3); } \
    if (IN(4)) { if (REPEAT_PH == 4) { PH4_BODY __syncthreads(); } PH4_BODY SEAM(4); } \
    if (IN(5)) { if (REPEAT_PH == 5) { PH5_BODY __syncthreads(); } PH5_BODY SEAM(5); } \
    PHASES_6_9
#define PHASES_6_9 \
    if (IN(6)) { if (REPEAT_PH == 6) { topk_phase(args, F); __syncthreads(); } topk_phase(args, F); SEAM(6); } \
    if (IN(7)) { if (REPEAT_PH == 7) { GATHER_FN<true>(args, F); __syncthreads(); } GATHER_FN<false>(args, F); SEAM(7); } \
    if (IN(8)) { if (REPEAT_PH == 8) { PH8_BODY __syncthreads(); } PH8_BODY SEAM(8); } \
    if (IN(9)) { final_phase(args, F); }
#define PH1_BODY \
        { pg8::Gemm g{(const bf16*)(ws + WS_R1), (const bf16*)(ws + WS_WT_IN), T_TOK, 3072, 2048}; pg8::StaticOrder S; S.init(T_TOK, 3072, F.G, (int)blockIdx.x); \
          EpiG1 E{(const float*)(ws + WS_RSX), (bf16*)(ws + WS_CQ), (bf16*)(ws + WS_CKV), (bf16*)(ws + WS_KR), (bf16*)(ws + WS_UG), (bf16*)(ws + WS_VG), (float*)(ws + WS_PSCQ), (float*)(ws + WS_PSCKV), (f32x2v*)(ws + WS_PSV), (const f32x2v*)(ws + WS_CS)}; \
          pg8::gemm_phase<EpiG1, pg8::StaticOrder, true, true>(F.lds + RING_OFF, g, S, E, F.wave); } \
        { pg8::Gemm g{(const bf16*)(ws + WS_PB), (const bf16*)(ws + WS_WT_PP), T_TOK, 2048, 256}; pg8::StaticOrder S; S.init(T_TOK, 2048, F.G, (int)blockIdx.x); \
          EpiPlain E{(bf16*)(ws + WS_PPROJ), 2048}; \
          pg8::gemm_phase<EpiPlain, pg8::StaticOrder, true, true>(F.lds + RING_OFF, g, S, E, F.wave); }
constexpr int N_PHASES = 10;
__global__ void __launch_bounds__(NWAVES * 64, 2) mega_fwd(Args args) {
    extern __shared__ __attribute__((aligned(16))) unsigned char lds[];
    Frame F;
    F.lds = (LAS unsigned char*)lds; F.MISC = (volatile LAS unsigned*)(F.lds + MISC_OFF);
    F.wave = __builtin_amdgcn_readfirstlane(threadIdx.x >> 6); F.lane = lane_id(); F.tid = F.wave * 64 + F.lane;
    F.G = gridDim.x; { const int bx = blockIdx.x; F.vcu = (F.G % 8 == 0) ? (bx % 8) * (F.G / 8) + bx / 8 : bx; }
    unsigned char* ws = args.ws; F.ctl = (gu32*)(ws + WS_CTL);
    for (int u = F.wave * 64 + lane_id(); u < (LDS_BYTES - LDSCTL_OFF) / 4; u += NWAVES * 64) ((LAS unsigned*)(F.lds + LDSCTL_OFF))[u] = 0u;
    __syncthreads();
    const int lo = args.ph_lo, hi = args.ph_hi;
    XcdBarrier bar; bar.bar = (unsigned*)(F.ctl + CW_BAR); bar.x = 0; bar.st = nullptr;
    if (hi - lo > 1) bar = xcd_barrier_post((unsigned*)(F.ctl + CW_BAR), F.MISC + 8, F.wave);
#define IN(k) (lo <= (k) && (k) < hi)
#define SEAM(k) do { if (IN(k) && IN((k) + 1)) xcd_barrier(bar, F.wave); } while (0)
    if (IN(0)) { if (REPEAT_PH == 0) { p0_prologue(args, F); __syncthreads(); } p0_prologue(args, F); SEAM(0); }
    if (IN(1)) { if (REPEAT_PH == 1) { PH1_BODY __syncthreads(); } PH1_BODY SEAM(1); }
    PHASES_2_9
#undef IN
#undef SEAM
}

#if CUT > 0 && CUT < 9
__device__ __forceinline__ int rope_unpc(int pc) { const int c5 = pc >> 5, fq = (pc >> 3) & 3, nn = (pc >> 2) & 1, e = pc & 3; return 16 * c5 + 4 * fq + e + 32 * nn; }
__global__ void __launch_bounds__(256) conv1(const unsigned char* ws, int b, float* ZP) {
    const int r = blockIdx.x; const size_t row = (size_t)b * 2048 + r; float* z = ZP + (size_t)r * 2880;
    const bf16 *CQ = (const bf16*)(ws + WS_CQ) + row * 512, *CKV = (const bf16*)(ws + WS_CKV) + row * 256, *KR = (const bf16*)(ws + WS_KR) + row * 64, *UG = (const bf16*)(ws + WS_UG) + row * 1024, *VG = (const bf16*)(ws + WS_VG) + row * 1024;
    for (int i = threadIdx.x; i < 512; i += 256) z[i] = bf2f(CQ[i]);
    for (int i = threadIdx.x; i < 256; i += 256) z[512 + i] = bf2f(CKV[i]);
    if (threadIdx.x < 64) z[768 + rope_unpc(threadIdx.x)] = bf2f(KR[threadIdx.x]);
    for (int i = threadIdx.x; i < 1024; i += 256) { z[832 + i] = bf2f(UG[i]); z[1856 + i] = bf2f(VG[i]); }
}
__global__ void __launch_bounds__(256) conv2(const unsigned char* ws, int b, float* ZP, float* QN, float* KV, float* OSGU) {
    const int r = blockIdx.x; const size_t row = (size_t)b * 2048 + r;
    const bf16 *Q = (const bf16*)(ws + WS_Q) + row * 1536, *KN = (const bf16*)(ws + WS_KN) + row * 1024, *VV = (const bf16*)(ws + WS_VV) + row * 1024, *KR = (const bf16*)(ws + WS_KR) + row * 64, *MIX = (const bf16*)(ws + WS_MIX) + row * 2048;
    for (int i = threadIdx.x; i < 1536; i += 256) { const int h = i / 192, lc = i - h * 192; const int dst = lc < 128 ? i : h * 192 + 128 + rope_unpc(lc - 128); QN[(size_t)r * 1536 + dst] = bf2f(Q[i]) * (1.f / QK_C2); }
    for (int i = threadIdx.x; i < 1024; i += 256) { const int h = i >> 7, d = i & 127; KV[(size_t)r * 2048 + h * 256 + d] = bf2f(KN[i]); KV[(size_t)r * 2048 + h * 256 + 128 + d] = bf2f(VV[i]); OSGU[(size_t)r * 1024 + i] = bf2f(MIX[1024 + i]); }
    if (threadIdx.x < 64) ZP[(size_t)r * 2880 + 768 + rope_unpc(threadIdx.x)] = bf2f(KR[threadIdx.x]);
}
__global__ void __launch_bounds__(256) conv3(const unsigned char* ws, int b, float* OATT, float* OSGU) {
    const int r = blockIdx.x; const size_t row = (size_t)b * 2048 + r; const bf16* MIX = (const bf16*)(ws + WS_MIX) + row * 2048;
    for (int i = threadIdx.x; i < 1024; i += 256) { OATT[(size_t)r * 1024 + i] = bf2f(MIX[i]); OSGU[(size_t)r * 1024 + i] = bf2f(MIX[1024 + i]); }
}
__global__ void __launch_bounds__(256) conv5(const unsigned char* ws, int b, float* QPN) {
    const int r = blockIdx.x; const size_t row = (size_t)b * 2048 + r; const bf16* QP = (const bf16*)(ws + WS_R1) + row * 2048;
    for (int i = threadIdx.x; i < 2048; i += 256) QPN[(size_t)r * 2048 + i] = bf2f(QP[i]);
}
static void launch_conv(int b, void* const* d_in, void* d_ws, hipStream_t stream) {
    unsigned char* ws = (unsigned char*)d_ws; (void)d_in;
    if (CUT == 1) conv1<<<2048, 256, 0, stream>>>(ws, b, (float*)(ws + WS_NZP));
    if (CUT == 2) conv2<<<2048, 256, 0, stream>>>(ws, b, (float*)(ws + WS_NZP), (float*)(ws + WS_NQN), (float*)(ws + WS_NKV), (float*)(ws + WS_NOSGU));
    if (CUT == 3) conv3<<<2048, 256, 0, stream>>>(ws, b, (float*)(ws + WS_NOATT), (float*)(ws + WS_NOSGU));
    if (CUT == 5) conv5<<<2048, 256, 0, stream>>>(ws, b, (float*)(ws + WS_NQPN));
}
#endif
#if CUT > 0
static void launch_fast(void* const* d_in, void* d_out, void* d_ws, hipStream_t stream) {
    static int grid = 0;
    if (grid == 0) {
        int dev = 0, cus = 0, per_cu = 0;
        if (hipGetDevice(&dev) != hipSuccess || hipDeviceGetAttribute(&cus, hipDeviceAttributeMultiprocessorCount, dev) != hipSuccess) { fprintf(stderr, "launch_fast: device query failed\n"); grid = -1; return; }
        if (hipFuncSetAttribute((const void*)mega_fwd, hipFuncAttributeMaxDynamicSharedMemorySize, LDS_BYTES) != hipSuccess) { fprintf(stderr, "launch_fast: hipFuncSetAttribute failed\n"); grid = -1; return; }
        if (hipOccupancyMaxActiveBlocksPerMultiprocessor(&per_cu, (const void*)mega_fwd, NWAVES * 64, LDS_BYTES) != hipSuccess || per_cu < 1) fprintf(stderr, "launch_fast: occupancy query says %d blocks per CU\n", per_cu);
        (void)hipGetLastError();
        grid = cus;
        if (grid != 256) fprintf(stderr, "launch_fast: %d CUs (built for 256)\n", grid);
    }
    if (grid < 0) return;
    (void)hipMemsetAsync((char*)d_ws + WS_CTL, 0, CTL_ZERO_BYTES, stream);
    Args a{};
    for (int i = 0; i < 26; ++i) a.in[i] = d_in[i];
    a.out = (float*)d_out; a.ws = (unsigned char*)d_ws;
    constexpr int LAST = CUT + 1;
#if ONE_LAUNCH
    a.ph_lo = 0; a.ph_hi = LAST; hipLaunchKernelGGL(mega_fwd, dim3(grid), dim3(NWAVES * 64), LDS_BYTES, stream, a);
#else
    for (int ph = 0; ph < LAST; ++ph) { a.ph_lo = ph; a.ph_hi = ph + 1; hipLaunchKernelGGL(mega_fwd, dim3(grid), dim3(NWAVES * 64), LDS_BYTES, stream, a); }
#endif
    const hipError_t le = hipPeekAtLastError(); if (le != hipSuccess) fprintf(stderr, "launch_fast: launch failed: %s\n", hipGetErrorName(le));
}
#endif
#if CUT > 0
static void launch_fast(void* const* d_in, void* d_out, void* d_ws, hipStream_t stream);
static void launch_conv(int b, void* const* d_in, void* d_ws, hipStream_t stream);
#endif
extern "C" void kernel_launch(void* const* d_in, const int* in_sizes, int n_in, void* d_out, int out_size, void* d_ws, size_t ws_size, hipStream_t stream) {
    if (n_in != 26 || out_size != T_TOK * DM || ws_size < WS_END) { fprintf(stderr, "kernel_launch: unexpected shapes n_in %d out %d ws %zu\n", n_in, out_size, ws_size); return; }
    unsigned char* ws = (unsigned char*)d_ws;
    const float* x = (const float*)d_in[0]; const float* p = (const float*)d_in[1]; const int* pos = (const int*)d_in[2];
    const float *g_mix = (const float*)d_in[3], *w_in = (const float*)d_in[4], *g_cq = (const float*)d_in[5], *w_uq = (const float*)d_in[6], *g_ckv = (const float*)d_in[7], *w_ukv = (const float*)d_in[8];
    const float *g_ln = (const float*)d_in[9], *b_ln = (const float*)d_in[10], *w_sgu = (const float*)d_in[11], *b_sgu = (const float*)d_in[12], *g_oa = (const float*)d_in[13], *g_os = (const float*)d_in[14];
    const float *w_out = (const float*)d_in[15], *g_ffn = (const float*)d_in[16], *w_pq = (const float*)d_in[17], *k1 = (const float*)d_in[18], *k2 = (const float*)d_in[19], *pu = (const float*)d_in[20], *pv = (const float*)d_in[21];
    const float *g_ple = (const float*)d_in[22], *w_pg = (const float*)d_in[23], *w_pp = (const float*)d_in[24], *g_fin = (const float*)d_in[25];
    float* out = (float*)d_out;
#if CUT > 0
    launch_fast(d_in, d_out, d_ws, stream);
#endif
#if CUT < 9
    constexpr int S0 = CUT + 1; constexpr int TB = nv::TBAT;
    float* A0 = (float*)(ws + WS_NA0); float* GL = (float*)(ws + WS_NGL); float* PP = (float*)(ws + WS_NPP);
    float* ZP = (float*)(ws + WS_NZP); float* CQN = (float*)(ws + WS_NCQN); float* CKVN = (float*)(ws + WS_NCKVN); float* QN = (float*)(ws + WS_NQN); float* KV = (float*)(ws + WS_NKV);
    float* VLN = (float*)(ws + WS_NVLN); float* OSGU = (float*)(ws + WS_NOSGU); float* OATT = (float*)(ws + WS_NOATT); float* QPN = (float*)(ws + WS_NQPN);
    for (int b = 0; b < NBATCH; ++b) {
        const size_t t0 = (size_t)b * TB; const float* xb = x + t0 * DM; const int* posb = pos + t0; const float* pb = p + t0 * 256;
        float* H1 = (float*)(ws + WS_H1) + t0 * DM; int* IDX = (int*)(ws + WS_IDX) + t0 * 128; float* GATE = (float*)(ws + WS_GATE) + t0 * 128; float* outb = out + t0 * DM;
#if CUT > 0
        launch_conv(b, d_in, d_ws, stream);
#endif
        if (S0 <= 1) {
            nv::nk_rmsnorm<<<TB, 256, 0, stream>>>(xb, DM, g_mix, A0, DM, DM);
            nv::nk_gemm<<<dim3(2880 / 64, TB / 64), 256, 0, stream>>>(A0, DM, w_in, 2880, ZP, 2880, nullptr, 0, DM);
            nv::nk_z_post<<<TB, 256, 0, stream>>>(ZP, posb);
        }
        if (S0 <= 2) {
            nv::nk_rmsnorm<<<TB, 256, 0, stream>>>(ZP, 2880, g_cq, CQN, 512, 512);
            nv::nk_gemm<<<dim3(1536 / 64, TB / 64), 256, 0, stream>>>(CQN, 512, w_uq, 1536, QN, 1536, nullptr, 0, 512);
            nv::nk_q_rope<<<TB, 256, 0, stream>>>(QN, posb);
            nv::nk_rmsnorm<<<TB, 256, 0, stream>>>(ZP + 512, 2880, g_ckv, CKVN, 256, 256);
            nv::nk_gemm<<<dim3(2048 / 64, TB / 64), 256, 0, stream>>>(CKVN, 256, w_ukv, 2048, KV, 2048, nullptr, 0, 256);
            nv::nk_ln_group<<<TB * 8 / 4, 256, 0, stream>>>(ZP, g_ln, b_ln, VLN);
            nv::nk_sgu<<<TB * 1024 / 256, 256, 0, stream>>>(ZP, VLN, w_sgu, b_sgu, OSGU);
        }
        if (S0 <= 3) nv::nk_attn<<<dim3(TB, 8), 256, 0, stream>>>(QN, KV, ZP, OATT);
        if (S0 <= 4) {
            nv::nk_rmsnorm<<<TB, 256, 0, stream>>>(OATT, 1024, g_oa, A0, DM, 1024);
            nv::nk_rmsnorm<<<TB, 256, 0, stream>>>(OSGU, 1024, g_os, A0 + 1024, DM, 1024);
            nv::nk_gemm<<<dim3(DM / 64, TB / 64), 256, 0, stream>>>(A0, DM, w_out, DM, H1, DM, xb, DM, DM);
        }
        if (S0 <= 5) {
            nv::nk_rmsnorm<<<TB, 256, 0, stream>>>(H1, DM, g_ffn, A0, DM, DM);
            nv::nk_gemm<<<dim3(DM / 64, TB / 64), 256, 0, stream>>>(A0, DM, w_pq, DM, QPN, DM, nullptr, 0, DM);
        }
        if (S0 <= 6) nv::nk_topk<<<TB * 8, 128, 0, stream>>>(QPN, k1, k2, IDX, GATE);
        if (S0 <= 7) {
            nv::nk_rmsnorm<<<TB, 256, 0, stream>>>(H1, DM, g_ffn, A0, DM, DM);
            nv::nk_gather<<<TB, 256, 0, stream>>>(H1, A0, IDX, GATE, pu, pv);
        }
        if (S0 <= 8) {
            nv::nk_rmsnorm<<<TB, 256, 0, stream>>>(H1, DM, g_ple, A0, DM, DM);
            nv::nk_gemm<<<dim3(DM / 64, TB / 64), 256, 0, stream>>>(A0, DM, w_pg, DM, GL, DM, nullptr, 0, DM);
            nv::nk_gemm<<<dim3(DM / 64, TB / 64), 256, 0, stream>>>(pb, 256, w_pp, DM, PP, DM, nullptr, 0, 256);
            nv::nk_ple<<<TB * DM / 256, 256, 0, stream>>>(H1, GL, PP, outb);
        }
        nv::nk_rmsnorm<<<TB, 256, 0, stream>>>(outb, DM, g_fin, outb, DM, DM);
    }
#endif
}
```

```cpp
#include <hip/hip_runtime.h>
#include <hip/hip_bf16.h>
#include <cstdio>
#include <cstdint>
#include <cmath>
#ifndef CUT
#define CUT 9
#endif
#ifndef ONE_LAUNCH
#define ONE_LAUNCH 1
#endif
#ifndef REPEAT_PH
#define REPEAT_PH -1
#endif
#ifndef GATHER_FN
#define GATHER_FN gather_sliced9_phase
#endif
constexpr int T_TOK = 8192, DM = 2048, SEQ = 2048, NBATCH = 4;
constexpr size_t MiB = 1u << 20;
constexpr size_t WS_CTL = 0;
constexpr size_t WS_WT_IN = 1 * MiB, WS_WT_UQ = 13 * MiB, WS_WT_UKV = 14 * MiB + 512 * 1024, WS_WT_PP = 15 * MiB + 512 * 1024;
constexpr size_t WS_K1B = 16 * MiB + 512 * 1024, WS_K2B = WS_K1B + 256 * 1024, WS_WSGU = 17 * MiB;
constexpr size_t WS_WT_OUT = 18 * MiB, WS_WT_PQ = 26 * MiB, WS_WT_PG = 34 * MiB;
constexpr size_t WS_UB = 42 * MiB, WS_VB = 106 * MiB;
constexpr size_t WS_R1 = 170 * MiB;
constexpr size_t WS_PB = 202 * MiB, WS_CS = 206 * MiB, WS_RSX = 208 * MiB, WS_RSH2 = 208 * MiB + 512 * 1024;
constexpr size_t WS_CQ = 209 * MiB, WS_CKV = 217 * MiB, WS_KR = 221 * MiB, WS_UG = 222 * MiB, WS_VG = 238 * MiB;
constexpr size_t WS_PSCQ = 254 * MiB, WS_PSCKV = 254 * MiB + 512 * 1024, WS_PSV = 255 * MiB;
constexpr size_t WS_Q = 257 * MiB, WS_KN = 281 * MiB, WS_VV = 297 * MiB, WS_H1B = 257 * MiB;
constexpr size_t WS_MIX = 313 * MiB, WS_PSA = 345 * MiB, WS_PSS = 345 * MiB + 512 * 1024;
constexpr size_t WS_H1 = 346 * MiB, WS_PSH1 = 410 * MiB, WS_IDX = 412 * MiB, WS_GATE = 416 * MiB, WS_PPROJ = 420 * MiB, WS_PSH3 = 452 * MiB;
constexpr size_t WS_NA0 = 454 * MiB, WS_NGL = 470 * MiB, WS_NPP = 486 * MiB, WS_END = 502 * MiB;
constexpr size_t WS_NZP = 42 * MiB, WS_NCQN = 65 * MiB, WS_NCKVN = 69 * MiB, WS_NQN = 71 * MiB, WS_NKV = 83 * MiB, WS_NVLN = 99 * MiB, WS_NOSGU = 107 * MiB, WS_NOATT = 115 * MiB, WS_NQPN = 123 * MiB;
namespace nv {
constexpr int TBAT = 2048;
__device__ __forceinline__ float gelu_t(float x) { const float c = 0.7978845608028654f; const float u = c * (x + 0.044715f * x * x * x); return 0.5f * x * (1.f + tanhf(u)); }
__device__ __forceinline__ float wave_sum(float v) {
#pragma unroll
    for (int o = 1; o < 64; o <<= 1) v += __shfl_xor(v, o);
    return v;
}
__device__ __forceinline__ float wave_max(float v) {
#pragma unroll
    for (int o = 1; o < 64; o <<= 1) v = fmaxf(v, __shfl_xor(v, o));
    return v;
}
__device__ __forceinline__ float blk_sum(float v, float* sh) {
    v = wave_sum(v); __syncthreads();
    if ((threadIdx.x & 63) == 0) sh[threadIdx.x >> 6] = v; __syncthreads();
    float r = 0.f; for (int i = 0; i < (int)(blockDim.x >> 6); ++i) r += sh[i]; return r;
}
__device__ __forceinline__ float blk_max(float v, float* sh) {
    v = wave_max(v); __syncthreads();
    if ((threadIdx.x & 63) == 0) sh[threadIdx.x >> 6] = v; __syncthreads();
    float r = sh[0]; for (int i = 1; i < (int)(blockDim.x >> 6); ++i) r = fmaxf(r, sh[i]); return r;
}
__global__ void __launch_bounds__(256) nk_rmsnorm(const float* x, size_t ldx, const float* g, float* out, size_t ldo, int D) {
    __shared__ float sh[8];
    const float* xr = x + (size_t)blockIdx.x * ldx; float* orow = out + (size_t)blockIdx.x * ldo;
    float s = 0.f; for (int i = threadIdx.x; i < D; i += 256) { const float v = xr[i]; s += v * v; }
    s = blk_sum(s, sh); const float r = rsqrtf(s / (float)D + 1e-6f);
    for (int i = threadIdx.x; i < D; i += 256) orow[i] = xr[i] * r * g[i];
}
__global__ void __launch_bounds__(256) nk_gemm(const float* A, size_t lda, const float* B, size_t ldb, float* C, size_t ldc, const float* R, size_t ldr, int K) {
    __shared__ float As[16][68], Bs[16][68];
    const int tid = threadIdx.x, tx = tid & 15, ty = tid >> 4, m0 = blockIdx.y * 64, n0 = blockIdx.x * 64;
    float acc[4][4] = {};
    for (int k0 = 0; k0 < K; k0 += 16) {
        { const int r = tid >> 2, c = (tid & 3) * 4; const float4 v = *(const float4*)(A + (size_t)(m0 + r) * lda + k0 + c); As[c][r] = v.x; As[c + 1][r] = v.y; As[c + 2][r] = v.z; As[c + 3][r] = v.w; }
        { const int r = tid >> 4, c = (tid & 15) * 4; const float4 v = *(const float4*)(B + (size_t)(k0 + r) * ldb + n0 + c); Bs[r][c] = v.x; Bs[r][c + 1] = v.y; Bs[r][c + 2] = v.z; Bs[r][c + 3] = v.w; }
        __syncthreads();
#pragma unroll
        for (int k = 0; k < 16; ++k) { float a[4], b[4];
#pragma unroll
            for (int i = 0; i < 4; ++i) { a[i] = As[k][ty * 4 + i]; b[i] = Bs[k][tx * 4 + i]; }
#pragma unroll
            for (int i = 0; i < 4; ++i)
#pragma unroll
                for (int j = 0; j < 4; ++j) acc[i][j] += a[i] * b[j]; }
        __syncthreads();
    }
#pragma unroll
    for (int i = 0; i < 4; ++i)
#pragma unroll
        for (int j = 0; j < 4; ++j) { const size_t r = m0 + ty * 4 + i, c = n0 + tx * 4 + j; C[r * ldc + c] = acc[i][j] + (R ? R[r * ldr + c] : 0.f); }
}
__device__ __forceinline__ void rope_cs(int pos, int i, float& c, float& s) { const double f = pow(10000.0, -(double)i / 32.0); const double a = (double)pos * f; c = (float)cos(a); s = (float)sin(a); }
__global__ void __launch_bounds__(256) nk_z_post(float* Z, const int* pos) {
    float* z = Z + (size_t)blockIdx.x * 2880; const int t = threadIdx.x;
    if (t < 32) { float c, s; rope_cs(pos[blockIdx.x], t, c, s); const float x1 = z[768 + t], x2 = z[800 + t]; z[768 + t] = x1 * c - x2 * s; z[800 + t] = x2 * c + x1 * s; }
    for (int i = 832 + t; i < 2880; i += 256) z[i] = gelu_t(z[i]);
}
__global__ void __launch_bounds__(256) nk_q_rope(float* Q, const int* pos) {
    float* q = Q + (size_t)blockIdx.x * 1536; const int h = threadIdx.x >> 5, i = threadIdx.x & 31;
    float c, s; rope_cs(pos[blockIdx.x], i, c, s); float* p = q + h * 192 + 128; const float x1 = p[i], x2 = p[32 + i]; p[i] = x1 * c - x2 * s; p[32 + i] = x2 * c + x1 * s;
}
__global__ void __launch_bounds__(256) nk_ln_group(const float* Z, const float* gln, const float* bln, float* VLN) {
    const int wv = blockIdx.x * 4 + (threadIdx.x >> 6), lane = threadIdx.x & 63, row = wv >> 3, g = wv & 7;
    const float* v = Z + (size_t)row * 2880 + 1856 + g * 128; const float a = v[lane], b = v[lane + 64];
    const float mu = wave_sum(a + b) * (1.f / 128.f); const float da = a - mu, db = b - mu; const float var = wave_sum(da * da + db * db) * (1.f / 128.f); const float r = rsqrtf(var + 1e-6f);
    float* o = VLN + (size_t)row * 1024 + g * 128; o[lane] = da * r * gln[g * 128 + lane] + bln[g * 128 + lane]; o[lane + 64] = db * r * gln[g * 128 + lane + 64] + bln[g * 128 + lane + 64];
}
__global__ void __launch_bounds__(256) nk_sgu(const float* Z, const float* VLN, const float* ws, const float* bs, float* OS) {
    const size_t idx = (size_t)blockIdx.x * 256 + threadIdx.x; const int row = (int)(idx >> 10), col = (int)(idx & 1023), g = col >> 7, t = row & 127, r0 = row - t;
    const float* w = ws + ((size_t)g * 128 + t) * 128; float acc = 0.f;
    for (int s = 0; s <= t; ++s) acc += w[s] * VLN[(size_t)(r0 + s) * 1024 + col];
    OS[idx] = Z[(size_t)row * 2880 + 832 + col] * (acc + bs[g * 128 + t]);
}
__global__ void __launch_bounds__(256) nk_attn(const float* Q, const float* KV, const float* Z, float* O) {
    __shared__ float qs[192], sc[2048], sh[8], part[128];
    const int i = blockIdx.x, h = blockIdx.y, tid = threadIdx.x, lane = tid & 63, wv = tid >> 6;
    if (tid < 192) qs[tid] = Q[(size_t)i * 1536 + h * 192 + tid]; __syncthreads();
    const float scale = 0.07216878364870323f;
    for (int j = wv; j <= i; j += 4) { const float* kn = KV + (size_t)j * 2048 + h * 256; const float* kr = Z + (size_t)j * 2880 + 768;
        float p = qs[lane] * kn[lane] + qs[64 + lane] * kn[64 + lane] + qs[128 + lane] * kr[lane]; p = wave_sum(p); if (lane == 0) sc[j] = p * scale; }
    __syncthreads();
    float m = -INFINITY; for (int j = tid; j <= i; j += 256) m = fmaxf(m, sc[j]); m = blk_max(m, sh);
    float l = 0.f; for (int j = tid; j <= i; j += 256) { const float e = expf(sc[j] - m); sc[j] = e; l += e; } l = blk_sum(l, sh);
    const int d = tid & 127, half = tid >> 7; float acc = 0.f;
    for (int j = half; j <= i; j += 2) acc += sc[j] * KV[(size_t)j * 2048 + h * 256 + 128 + d];
    if (half) part[d] = acc; __syncthreads();
    if (!half) O[(size_t)i * 1024 + h * 128 + d] = (acc + part[d]) / l;
}
__global__ void __launch_bounds__(128) nk_topk(const float* QP, const float* k1, const float* k2, int* IDX, float* GATE) {
    __shared__ float q[256], s1[128], s2[128], cand[256], t1[16], t2[16]; __shared__ int i1[16], i2[16];
    const int row = blockIdx.x >> 3, h = blockIdx.x & 7, n = threadIdx.x;
    q[n] = QP[(size_t)row * 2048 + h * 256 + n]; q[n + 128] = QP[(size_t)row * 2048 + h * 256 + 128 + n]; __syncthreads();
    { const float* a = k1 + ((size_t)h * 128 + n) * 128; const float* b = k2 + ((size_t)h * 128 + n) * 128; float x = 0.f, y = 0.f;
      for (int d = 0; d < 128; ++d) { x += q[d] * a[d]; y += q[128 + d] * b[d]; } s1[n] = x; s2[n] = y; }
    __syncthreads();
    if (n == 0 || n == 64) { float* s = n ? s2 : s1; float* tv = n ? t2 : t1; int* ti = n ? i2 : i1;
        for (int r = 0; r < 16; ++r) { float best = -INFINITY; int bi = 0; for (int j = 0; j < 128; ++j) if (s[j] > best) { best = s[j]; bi = j; } tv[r] = best; ti[r] = bi; s[bi] = -INFINITY; } }
    __syncthreads();
    cand[n] = t1[n >> 4] + t2[n & 15]; cand[n + 128] = t1[(n + 128) >> 4] + t2[n & 15]; __syncthreads();
    if (n == 0) { float tv[16]; int te[16];
        for (int r = 0; r < 16; ++r) { float best = -INFINITY; int bi = 0; for (int j = 0; j < 256; ++j) if (cand[j] > best) { best = cand[j]; bi = j; } tv[r] = best; te[r] = i1[bi >> 4] * 128 + i2[bi & 15]; cand[bi] = -INFINITY; }
        float l = 0.f, e[16]; for (int r = 0; r < 16; ++r) { e[r] = expf(tv[r] - tv[0]); l += e[r]; }
        for (int r = 0; r < 16; ++r) { IDX[(size_t)row * 128 + h * 16 + r] = te[r]; GATE[(size_t)row * 128 + h * 16 + r] = e[r] / l; } }
}
__global__ void __launch_bounds__(256) nk_gather(float* H, const float* A2, const int* IDX, const float* GATE, const float* U, const float* V) {
    __shared__ float a[2048], red[4][2048];
    const int row = blockIdx.x, tid = threadIdx.x, lane = tid & 63, wv = tid >> 6;
    for (int i = tid; i < 2048; i += 256) a[i] = A2[(size_t)row * 2048 + i]; __syncthreads();
    float acc[32];
#pragma unroll
    for (int i = 0; i < 32; ++i) acc[i] = 0.f;
    for (int k = 0; k < 32; ++k) { const int j = wv * 32 + k; const int e = IDX[(size_t)row * 128 + j]; const float gt = GATE[(size_t)row * 128 + j];
        const float* u = U + (size_t)e * 2048; const float* v = V + (size_t)e * 2048; float p = 0.f;
#pragma unroll
        for (int i = 0; i < 32; ++i) p += u[lane + 64 * i] * a[lane + 64 * i];
        p = wave_sum(p); const float w = gt * gelu_t(p);
#pragma unroll
        for (int i = 0; i < 32; ++i) acc[i] += w * v[lane + 64 * i]; }
#pragma unroll
    for (int i = 0; i < 32; ++i) red[wv][lane + 64 * i] = acc[i];
    __syncthreads();
    for (int i = tid; i < 2048; i += 256) H[(size_t)row * 2048 + i] += red[0][i] + red[1][i] + red[2][i] + red[3][i];
}
__global__ void __launch_bounds__(256) nk_ple(const float* H2, const float* GL, const float* PP, float* out) {
    const size_t i = (size_t)blockIdx.x * 256 + threadIdx.x; out[i] = H2[i] + PP[i] / (1.f + expf(-GL[i]));
}
}
#define GAS __attribute__((address_space(1)))
#define LAS __attribute__((address_space(3)))
typedef unsigned short bf16;
typedef unsigned v4u __attribute__((ext_vector_type(4)));
typedef float f32x4 __attribute__((ext_vector_type(4)));
typedef short bf16x8 __attribute__((ext_vector_type(8)));
typedef GAS unsigned gu32;
typedef GAS unsigned long long gu64;
#define RLX_AGENT __ATOMIC_RELAXED, __HIP_MEMORY_SCOPE_AGENT
#define LDS_WAIT() asm volatile("s_waitcnt lgkmcnt(0)" ::: "memory")
#define VM_WAIT() asm volatile("s_waitcnt vmcnt(0)" ::: "memory")
__device__ __forceinline__ unsigned long long rt() { return __builtin_amdgcn_s_memrealtime(); }
__device__ __forceinline__ unsigned f2bf(float f) { unsigned u = __builtin_bit_cast(unsigned, f); return (u + 0x7fffu + ((u >> 16) & 1u)) >> 16; }
__device__ __forceinline__ unsigned pk2(float lo, float hi) { return f2bf(lo) | (f2bf(hi) << 16); }
#define XB_TMO      128
#define XB_XCNT(j)  (256  + 64 * (j))
#define XB_XSUB(j)  (1280 + 64 * (j))
#define XB_XGEN(j)  (2304 + 64 * (j))
#define XB_TOP      3328
#define XB_TOPGEN   3392
#define XCD_BAR_WORDS 3456
#define XB_SPIN_CAP (1u << 18)

__device__ __forceinline__ unsigned xb_ld(unsigned* p)              { return __hip_atomic_load(p, __ATOMIC_RELAXED, __HIP_MEMORY_SCOPE_AGENT); }
__device__ __forceinline__ unsigned xb_add(unsigned* p, unsigned v) { return __hip_atomic_fetch_add(p, v, __ATOMIC_RELAXED, __HIP_MEMORY_SCOPE_AGENT); }
__device__ __forceinline__ unsigned xb_xcc_id() { return (unsigned)__builtin_amdgcn_s_getreg((3 << 11) | 20) & 0xFu; }
#define XB_SPIN(cond, bar) do { unsigned _sp = 0; while (cond) { __builtin_amdgcn_s_sleep(1); \
    if ((++_sp & 255u) == 0u) { if (xb_ld(&(bar)[XB_TMO])) break; if (_sp > XB_SPIN_CAP) { atomicAdd(&(bar)[XB_TMO], 1u); break; } } } } while (0)

struct XcdBarrier {
    unsigned* bar; unsigned x;
    volatile LAS unsigned* st;
};

__device__ __forceinline__ int lane_id() { int r; asm volatile("v_mbcnt_lo_u32_b32 %0, -1, 0\n\tv_mbcnt_hi_u32_b32 %0, -1, %0" : "=v"(r)); return r; }
__device__ __forceinline__ XcdBarrier xcd_barrier_post(unsigned* bar, volatile LAS unsigned* st, int wid) {
    XcdBarrier b; b.bar = bar; b.x = xb_xcc_id(); b.st = st;
    if (wid == 0 && lane_id() == 0) (void)xb_add(&bar[XB_XCNT(b.x)], 1u);
    return b;
}
__device__ __forceinline__ void xcd_barrier_complete(unsigned* bar, unsigned x, unsigned& nloc, unsigned& nx) {
    const unsigned G = gridDim.x * gridDim.y * gridDim.z;
    unsigned sum, cnt, mine, sp = 0u;
    for (;;) {
        sum = 0u; cnt = 0u; mine = 0u;
#pragma unroll
        for (unsigned j = 0; j < 16; ++j) { const unsigned c = xb_ld(&bar[XB_XCNT(j)]); sum += c; cnt += (c > 0u) ? 1u : 0u; mine = (j == x) ? c : mine; }
        if (sum == G) break;
        __builtin_amdgcn_s_sleep(1);
        if ((++sp & 255u) == 0u) { if (xb_ld(&bar[XB_TMO])) break; if (sp > XB_SPIN_CAP) { atomicAdd(&bar[XB_TMO], 1u); break; } }
    }
    nloc = mine > 0u ? mine : 1u; nx = cnt > 0u ? cnt : 1u;
}

__device__ __forceinline__ void xcd_barrier(const XcdBarrier& b, int wid) {
    asm volatile("s_waitcnt vmcnt(0)" ::: "memory");
    __syncthreads();
    if (wid == 0 && lane_id() == 0) {
        unsigned* bar = b.bar;
        __builtin_amdgcn_s_waitcnt(0);
        unsigned nloc = b.st[0], nx = b.st[1];
        if (nloc == 0u) { xcd_barrier_complete(bar, b.x, nloc, nx); b.st[0] = nloc; b.st[1] = nx; }
        const unsigned old = xb_add(&bar[XB_XSUB(b.x)], 1u);
        const unsigned gen = old / nloc;
        if (old + 1u == (gen + 1u) * nloc) {
            __builtin_amdgcn_fence(__ATOMIC_RELEASE, "agent");
            asm volatile("s_waitcnt vmcnt(0)" ::: "memory");
            const unsigned og = xb_add(&bar[XB_TOP], 1u);
            const unsigned tg = og / nx;
            if (og + 1u == (tg + 1u) * nx) xb_add(&bar[XB_TOPGEN], 1u);
            else XB_SPIN(xb_ld(&bar[XB_TOPGEN]) == tg, bar);
            __builtin_amdgcn_fence(__ATOMIC_ACQUIRE, "agent");
            xb_add(&bar[XB_XGEN(b.x)], 1u);
            asm volatile("s_waitcnt vmcnt(0)" ::: "memory");
        } else {
            XB_SPIN(xb_ld(&bar[XB_XGEN(b.x)]) == gen, bar);
            __builtin_amdgcn_fence(__ATOMIC_ACQUIRE, "agent");
            asm volatile("s_waitcnt vmcnt(0)" ::: "memory");
        }
    }
    __syncthreads();
}
namespace pg8 {
#define PG8_LAS __attribute__((address_space(3)))
typedef unsigned short bf16_t;
typedef short bf16x8 __attribute__((ext_vector_type(8)));
typedef float f32x4 __attribute__((ext_vector_type(4)));
typedef unsigned u32x4 __attribute__((ext_vector_type(4)));
constexpr int BM = 256, BK = 64, HALF = 128, HTB = HALF * BK * 2  , STAGE_BYTES = 8 * HTB, NXCD = 8, WGM = 8;

__host__ __device__ __forceinline__ int lds_byte(int r, int c) { const int st = (r >> 4) * 2 + (c >> 5), rr = r & 15, cc = c & 31, ob = rr * 64 + cc * 2; return st * 1024 + (ob ^ (((ob >> 9) & 1) << 5)); }
__host__ __device__ __forceinline__ void stage_rc(int b, int& R, int& C) { const int st = b / 1024, sb = b % 1024, swz = sb ^ (((sb >> 9) & 1) << 5); R = (st >> 1) * 16 + swz / 64; C = (st & 1) * 32 + (swz % 64) / 2; }
__host__ __device__ __forceinline__ int perm32(int rho) { const int n = rho >> 4, i = rho & 15; return 8 * (i >> 2) + 4 * n + (i & 3); }

struct Unit { int pm, pn; };
struct Gemm { const bf16_t* A; const bf16_t* Bt; int M, N, K; };

struct StaticOrder {
    int nM, nN, nwg, G, c;
    __host__ __device__ void init(int M, int N, int G_, int c_) { nM = M / BM; nN = N / BM; nwg = nM * nN; G = G_; c = c_; }
    __host__ __device__ bool next(int i, Unit& u) const {
        const long L = (long)i * G + c; if (L >= nwg) return false;
        int wgid = (int)L; { const int q = nwg / NXCD, r = nwg % NXCD, xcd = wgid % NXCD, off = wgid / NXCD; wgid = (xcd < r ? xcd * (q + 1) : r * (q + 1) + (xcd - r) * q) + off; }
        const int nig = WGM * nN, gid = wgid / nig, fm = gid * WGM, gsz = (nM - fm) < WGM ? (nM - fm) : WGM;
        u.pm = fm + ((wgid % nig) % gsz); u.pn = (wgid % nig) / gsz; return true;
    }
    __device__ __forceinline__ void a_ready(const Unit&) const {}
    __device__ __forceinline__ void done(const Unit&) const {}
};

__device__ __forceinline__ unsigned cvt_pk_bf16(float lo, float hi) { unsigned r; asm volatile("v_cvt_pk_bf16_f32 %0, %1, %2" : "=v"(r) : "v"(lo), "v"(hi)); return r; }
typedef float f32x2 __attribute__((ext_vector_type(2)));
template <class Epi, class Sched, bool ALIGN_EPI = false, bool SP2 = false>
__device__ __forceinline__ void gemm_phase(PG8_LAS unsigned char* lds, const Gemm g, const Sched& S, const Epi& E, const int wid) {
    const int lane = ::lane_id(), tid = wid * 64 + lane, wr = wid >> 2, wc = wid & 3, fr = lane & 15, fq = lane >> 4;
    const int K = g.K, nt = K / BK;
    unsigned voffA[2], voffB[2];
#pragma unroll
    for (int i = 0; i < 2; ++i) { int R, C; stage_rc(tid * 16 + i * 8192, R, C); const int Rb = Epi::PERM ? ((R & ~31) + perm32(R & 31)) : R;
        voffA[i] = (unsigned)(R * K + C) * 2u; voffB[i] = (unsigned)(Rb * K + C) * 2u; }
    const size_t kstep = (size_t)(BK * 2);
    const size_t hstep = (size_t)HALF * K * 2;
    const size_t tstep = 2 * hstep;
    const unsigned ldsw = (unsigned)wid * 1024u;
    const int aoff = lds_byte(wr * 64 + fr, fq * 8), boff = lds_byte(wc * 32 + fr, fq * 8);
#define PG8_SA(b, h) (((b) * 2 + (h)) * HTB)
#define PG8_SB(b, h) ((4 + (b) * 2 + (h)) * HTB)
#define PG8_STAGE(bufoff, gbase, voff) do { _Pragma("unroll") for (int _i = 0; _i < 2; ++_i) \
        __builtin_amdgcn_global_load_lds((const unsigned*)((const char*)(gbase) + (voff)[_i]), (PG8_LAS unsigned*)(lds + (bufoff) + ldsw + _i * 8192), 16, 0, 0); } while (0)
#define PG8_LDA(dst, b, h) do { _Pragma("unroll") for (int m = 0; m < 4; ++m) _Pragma("unroll") for (int k = 0; k < 2; ++k) dst[m][k] = *(const PG8_LAS bf16x8*)(lds + PG8_SA(b, h) + aoff + m * 2048 + k * 1024); } while (0)
#define PG8_LDB(dst, b, h) do { _Pragma("unroll") for (int n = 0; n < 2; ++n) _Pragma("unroll") for (int k = 0; k < 2; ++k) dst[n][k] = *(const PG8_LAS bf16x8*)(lds + PG8_SB(b, h) + boff + n * 2048 + k * 1024); } while (0)
#define PG8_MMA(ai, bj, At, Bt) do { __builtin_amdgcn_s_setprio(1); _Pragma("unroll") for (int m = 0; m < 4; ++m) _Pragma("unroll") for (int n = 0; n < 2; ++n) _Pragma("unroll") for (int k = 0; k < 2; ++k) \
        acc[ai][bj][m][n] = __builtin_amdgcn_mfma_f32_16x16x32_bf16(Bt[n][k], At[m][k], acc[ai][bj][m][n], 0, 0, 0); __builtin_amdgcn_s_setprio(0); } while (0)
#define PG8_WAIT_V(n) asm volatile("s_waitcnt vmcnt(" #n ")" ::: "memory")
#define PG8_WAIT_L(n) asm volatile("s_waitcnt lgkmcnt(" #n ")" ::: "memory")
#define PG8_BAR __builtin_amdgcn_s_barrier()
#define PG8_SCHED __builtin_amdgcn_sched_barrier(0)
    Unit cur, nxt; int ui = 0;
    if (!S.next(0, cur)) return;
    f32x4 acc[2][2][4][2];
#pragma unroll
    for (int a = 0; a < 2; ++a)
#pragma unroll
        for (int b = 0; b < 2; ++b)
#pragma unroll
            for (int m = 0; m < 4; ++m)
#pragma unroll
                for (int n = 0; n < 2; ++n) acc[a][b][m][n] = (f32x4){0.f, 0.f, 0.f, 0.f};
    bf16x8 At[4][2], B0[2][2], B1[2][2];
    const char* cA = (const char*)g.A + (size_t)cur.pm * tstep; const char* cB = (const char*)g.Bt + (size_t)cur.pn * tstep;
    S.a_ready(cur);
    if constexpr (SP2) {
        PG8_STAGE(PG8_SB(0, 0), cB, voffB); PG8_STAGE(PG8_SB(0, 1), cB + hstep, voffB); PG8_STAGE(PG8_SA(0, 0), cA, voffA); PG8_STAGE(PG8_SA(0, 1), cA + hstep, voffA);
        if (wr == 1) PG8_BAR;
        PG8_WAIT_V(2); PG8_BAR;
        PG8_STAGE(PG8_SB(1, 0), cB + kstep, voffB); PG8_STAGE(PG8_SA(1, 0), cA + kstep, voffA); PG8_STAGE(PG8_SB(1, 1), cB + hstep + kstep, voffB);
        PG8_WAIT_V(6); PG8_BAR;
    } else {
        PG8_STAGE(PG8_SB(0, 0), cB, voffB); PG8_STAGE(PG8_SA(0, 0), cA, voffA); PG8_STAGE(PG8_SB(0, 1), cB + hstep, voffB); PG8_STAGE(PG8_SA(0, 1), cA + hstep, voffA);
        if (wr == 1) PG8_BAR;
        PG8_WAIT_V(4); PG8_BAR;
        PG8_STAGE(PG8_SB(1, 0), cB + kstep, voffB); PG8_STAGE(PG8_SA(1, 0), cA + kstep, voffA); PG8_STAGE(PG8_SB(1, 1), cB + hstep + kstep, voffB);
        PG8_WAIT_V(6); PG8_BAR;
    }
    for (;;) {
        const bool has_next = S.next(ui + 1, nxt);
        const char* nA = has_next ? (const char*)g.A + (size_t)nxt.pm * tstep : cA; const char* nB = has_next ? (const char*)g.Bt + (size_t)nxt.pn * tstep : cB;
        for (int t = 0; t < nt; t += 2) {
            if constexpr (Epi::MID) { if (t == (nt >> 1)) E.mid(acc, cur, wr, wc, fr, fq); }
            const bool last = (t == nt - 2);
            const char* a1 = cA + (size_t)(t + 1) * kstep;
            const char* a2 = last ? nA : cA + (size_t)(t + 2) * kstep; const char* b2 = last ? nB : cB + (size_t)(t + 2) * kstep;
            const char* a3 = a2 + kstep; const char* b3 = b2 + kstep;
            if (last && has_next) S.a_ready(nxt);
            if constexpr (SP2) {
            PG8_LDB(B0, 0, 0); PG8_LDB(B1, 0, 1); PG8_SCHED; PG8_LDA(At, 0, 0); PG8_STAGE(PG8_SA(1, 1), a1 + hstep, voffA);
            PG8_WAIT_V(8); PG8_WAIT_L(0); PG8_BAR; PG8_MMA(0, 0, At, B0); PG8_MMA(0, 1, At, B1); PG8_BAR; PG8_SCHED;
            PG8_LDA(At, 0, 1); PG8_STAGE(PG8_SB(0, 0), b2, voffB); PG8_STAGE(PG8_SB(0, 1), b2 + hstep, voffB); PG8_STAGE(PG8_SA(0, 0), a2, voffA);
            PG8_WAIT_V(8); PG8_WAIT_L(0); PG8_BAR; PG8_MMA(1, 0, At, B0); PG8_MMA(1, 1, At, B1); PG8_BAR; PG8_SCHED;
            PG8_LDB(B0, 1, 0); PG8_LDB(B1, 1, 1); PG8_SCHED; PG8_LDA(At, 1, 0); PG8_STAGE(PG8_SA(0, 1), a2 + hstep, voffA);
            PG8_WAIT_V(8); PG8_WAIT_L(0); PG8_BAR; PG8_MMA(0, 0, At, B0); PG8_MMA(0, 1, At, B1); PG8_BAR; PG8_SCHED;
            PG8_LDA(At, 1, 1); PG8_STAGE(PG8_SB(1, 0), b3, voffB); PG8_STAGE(PG8_SB(1, 1), b3 + hstep, voffB); PG8_STAGE(PG8_SA(1, 0), a3, voffA);
            PG8_WAIT_V(8); PG8_WAIT_L(0); PG8_BAR; PG8_MMA(1, 0, At, B0); PG8_MMA(1, 1, At, B1); PG8_BAR; PG8_SCHED;
            } else {
            PG8_LDB(B0, 0, 0); PG8_SCHED; PG8_LDA(At, 0, 0); PG8_STAGE(PG8_SA(1, 1), a1 + hstep, voffA);
            PG8_WAIT_L(8); PG8_BAR; PG8_WAIT_L(0); PG8_MMA(0, 0, At, B0); PG8_BAR; PG8_SCHED;
            PG8_LDB(B1, 0, 1); PG8_STAGE(PG8_SB(0, 0), b2, voffB);
            PG8_BAR; PG8_WAIT_L(0); PG8_MMA(0, 1, At, B1); PG8_BAR;
            PG8_LDA(At, 0, 1); PG8_STAGE(PG8_SA(0, 0), a2, voffA);
            PG8_BAR; PG8_WAIT_L(0); PG8_MMA(1, 0, At, B0); PG8_BAR; PG8_SCHED;
            PG8_STAGE(PG8_SB(0, 1), b2 + hstep, voffB);
            PG8_WAIT_V(6); PG8_BAR; PG8_MMA(1, 1, At, B1); PG8_BAR;
            PG8_LDB(B0, 1, 0); PG8_SCHED; PG8_LDA(At, 1, 0); PG8_STAGE(PG8_SA(0, 1), a2 + hstep, voffA);
            PG8_WAIT_L(8); PG8_BAR; PG8_WAIT_L(0); PG8_MMA(0, 0, At, B0); PG8_BAR; PG8_SCHED;
            PG8_LDB(B1, 1, 1); PG8_STAGE(PG8_SB(1, 0), b3, voffB);
            PG8_BAR; PG8_WAIT_L(0); PG8_MMA(0, 1, At, B1); PG8_BAR;
            PG8_LDA(At, 1, 1); PG8_STAGE(PG8_SA(1, 0), a3, voffA);
            PG8_BAR; PG8_WAIT_L(0); PG8_MMA(1, 0, At, B0); PG8_BAR; PG8_SCHED;
            PG8_STAGE(PG8_SB(1, 1), b3 + hstep, voffB);
            PG8_WAIT_V(6); PG8_BAR; PG8_MMA(1, 1, At, B1); PG8_BAR;
            }
        }
        if constexpr (ALIGN_EPI) { if (wr == 0) PG8_BAR; }
        if constexpr (!Epi::AFTER_DRAIN) { E(acc, cur, wr, wc, fr, fq); S.done(cur); }
        if (!has_next) break;
#pragma unroll
        for (int a = 0; a < 2; ++a)
#pragma unroll
            for (int b = 0; b < 2; ++b)
#pragma unroll
                for (int m = 0; m < 4; ++m)
#pragma unroll
                    for (int n = 0; n < 2; ++n) acc[a][b][m][n] = (f32x4){0.f, 0.f, 0.f, 0.f};
        cur = nxt; cA = nA; cB = nB; ++ui;
        if constexpr (ALIGN_EPI) { if (wr == 1) PG8_BAR; }
    }
    PG8_WAIT_V(0);
    if constexpr (!ALIGN_EPI) { if (wr == 0) PG8_BAR; }
    PG8_BAR;
    if constexpr (Epi::AFTER_DRAIN) { E.fused(acc, cur, wr, wc, fr, fq, lds, wid, lane); S.done(cur); }
#undef PG8_SA
#undef PG8_SB
#undef PG8_STAGE
#undef PG8_LDA
#undef PG8_LDB
#undef PG8_MMA
#undef PG8_WAIT_V
#undef PG8_WAIT_L
#undef PG8_BAR
#undef PG8_SCHED
}
}
constexpr int NWAVES = 8;
constexpr int RING_OFF = 0, RING_BYTES = 131072, TAB_OFF = RING_BYTES, TAB_BYTES = 8192, LDSCTL_OFF = TAB_OFF + TAB_BYTES, MISC_OFF = LDSCTL_OFF + 320, LDS_BYTES = 147456;
static_assert(MISC_OFF + 128 <= LDS_BYTES, "LDS map");
constexpr int CW_TMO = 0, CW_CODE = 1, CW_BAR = 4096;
constexpr size_t CTL_ZERO_BYTES = 64 * 1024;
constexpr float QK_C2 = 0.07216878364870323f * 1.4426950408889634f;
typedef float f32x2v __attribute__((ext_vector_type(2)));
typedef unsigned u32x2v __attribute__((ext_vector_type(2)));
__device__ __forceinline__ float bf2f(unsigned short b) { return __uint_as_float((unsigned)b << 16); }
__device__ __forceinline__ float gelu_f(float x) { const float u = 1.5957691216057308f * (x + 0.044715f * x * x * x); return x * __builtin_amdgcn_rcpf(1.f + __builtin_amdgcn_exp2f(-1.4426950408889634f * u)); }
__device__ __forceinline__ float wave_sum64(float v) {
#pragma unroll
    for (int o = 1; o < 64; o <<= 1) v += __shfl_xor(v, o);
    return v;
}
struct Args { const void* in[26]; float* out; unsigned char* ws; int ph_lo, ph_hi; };
struct Frame { LAS unsigned char* lds; volatile LAS unsigned* MISC; gu32* ctl; int tid, lane, wave, vcu, G; };

__device__ __forceinline__ int rope_pc(int lr) { const int nn = lr >> 5, i = lr & 31, c5 = i >> 4, f = i & 15; return 32 * c5 + 8 * (f >> 2) + 4 * nn + (f & 3); }
__device__ __forceinline__ int map_win(int n) { if (n < 768) return n; if (n < 832) return 2816 + rope_pc(n - 768); if (n < 1856) return 768 + (n - 832); return 1792 + (n - 1856); }
__device__ __forceinline__ int map_wuq(int n) { const int h = n / 192, lc = n - h * 192; return lc < 128 ? n : h * 192 + 128 + rope_pc(lc - 128); }
__device__ __forceinline__ int map_id(int n) { return n; }

template <class MapF, class ScaleF>
__device__ __forceinline__ void p0_transpose_item(const float* W, int K, int N, bf16* WT, LAS float* scr, int item, int lane, MapF mapf, ScaleF ks) {
    const int nblk = N / 32, kb = item / nblk, nb = item % nblk, k0 = 64 * kb, n0 = 32 * nb;
#pragma unroll 8
    for (int i = 0; i < 32; ++i) { const int kk = 2 * i + (lane >> 5); scr[kk * 33 + (lane & 31)] = W[(size_t)(k0 + kk) * N + n0 + (lane & 31)] * ks(k0 + kk); }
    LDS_WAIT(); asm volatile("" ::: "memory");
    const int c = lane & 7;
#pragma unroll
    for (int j = 0; j < 4; ++j) { const int n = (lane >> 3) + 8 * j; const LAS float* s = scr + (8 * c) * 33 + n;
        v4u o; o.x = pk2(s[0 * 33], s[1 * 33]); o.y = pk2(s[2 * 33], s[3 * 33]); o.z = pk2(s[4 * 33], s[5 * 33]); o.w = pk2(s[6 * 33], s[7 * 33]);
        *(GAS v4u*)(WT + (size_t)mapf(n0 + n) * K + k0 + 8 * c) = o; }
    LDS_WAIT(); asm volatile("" ::: "memory");
}
template <class ScaleF>
__device__ __forceinline__ void p0_cvt512(const float* src, bf16* dst, size_t e0, int lane, ScaleF sf) {
    const size_t e = e0 + (size_t)lane * 8; const f32x4 a = *(const GAS f32x4*)(src + e), b = *(const GAS f32x4*)(src + e + 4);
    v4u o; o.x = pk2(a.x * sf(e), a.y * sf(e + 1)); o.y = pk2(a.z * sf(e + 2), a.w * sf(e + 3)); o.z = pk2(b.x * sf(e + 4), b.y * sf(e + 5)); o.w = pk2(b.z * sf(e + 6), b.w * sf(e + 7));
    *(GAS v4u*)(dst + e) = o;
}
__device__ __forceinline__ void p0_prologue(const Args& A, Frame& F) {
    unsigned char* ws = A.ws;
    const float* x = (const float*)A.in[0]; const float* p = (const float*)A.in[1]; const int* pos = (const int*)A.in[2];
    const float *g_mix = (const float*)A.in[3], *w_in = (const float*)A.in[4], *g_cq = (const float*)A.in[5], *w_uq = (const float*)A.in[6], *g_ckv = (const float*)A.in[7], *w_ukv = (const float*)A.in[8];
    const float *w_sgu = (const float*)A.in[11], *g_oa = (const float*)A.in[13], *g_os = (const float*)A.in[14], *w_out = (const float*)A.in[15], *g_ffn = (const float*)A.in[16], *w_pq = (const float*)A.in[17];
    const float *k1 = (const float*)A.in[18], *k2 = (const float*)A.in[19], *pu = (const float*)A.in[20], *pv = (const float*)A.in[21], *g_ple = (const float*)A.in[22], *w_pg = (const float*)A.in[23], *w_pp = (const float*)A.in[24];
    LAS float* scr = (LAS float*)(F.lds + RING_OFF + F.wave * 16384);
    const int gw = F.vcu * NWAVES + F.wave, NGW = F.G * NWAVES, lane = F.lane;
    for (int m = gw; m < T_TOK; m += NGW) {
        const GAS f32x4* xr = (const GAS f32x4*)(x + (size_t)m * DM) + lane; f32x4 v[8]; float s = 0.f;
#pragma unroll
        for (int j = 0; j < 8; ++j) { v[j] = xr[64 * j]; s += (v[j].x * v[j].x + v[j].y * v[j].y) + (v[j].z * v[j].z + v[j].w * v[j].w); }
        s = wave_sum64(s); if (lane == 0) ((float*)(ws + WS_RSX))[m] = 1.0f / sqrtf(s * (1.f / DM) + 1e-6f);
        GAS u32x2v* o8 = (GAS u32x2v*)((bf16*)(ws + WS_R1) + (size_t)m * DM) + lane;
#pragma unroll
        for (int j = 0; j < 8; ++j) o8[64 * j] = (u32x2v){pk2(v[j].x, v[j].y), pk2(v[j].z, v[j].w)};
        const f32x4 pvv = *((const GAS f32x4*)(p + (size_t)m * 256) + lane);
        *((GAS u32x2v*)((bf16*)(ws + WS_PB) + (size_t)m * 256) + lane) = (u32x2v){pk2(pvv.x, pvv.y), pk2(pvv.z, pvv.w)};
    }
    for (int it = gw; it < T_TOK * 32 / 64; it += NGW) { const int idx = it * 64 + lane, row = idx >> 5, i = idx & 31;
        const double f = exp2((double)i * (-13.287712379549449 / 32.0)); const double a = (double)pos[row] * f;
        ((f32x2v*)(ws + WS_CS))[idx] = (f32x2v){(float)cos(a), (float)sin(a)}; }
    constexpr int I_IN = 32 * 90, I_UQ = 8 * 48, I_UKV = 4 * 64, I_SQ = 32 * 64, I_PP = 4 * 64;
    constexpr int NITEMS = I_IN + I_UQ + I_UKV + 3 * I_SQ + I_PP;
    for (int it = gw; it < NITEMS; it += NGW) {
        int r = it;
        if (r < I_IN) { p0_transpose_item(w_in, 2048, 2880, (bf16*)(ws + WS_WT_IN), scr, r, lane, [](int n) { return map_win(n); }, [=](int k) { return g_mix[k]; }); continue; } r -= I_IN;
        if (r < I_UQ) { p0_transpose_item(w_uq, 512, 1536, (bf16*)(ws + WS_WT_UQ), scr, r, lane, [](int n) { return map_wuq(n); }, [=](int k) { return g_cq[k] * QK_C2; }); continue; } r -= I_UQ;
        if (r < I_UKV) { p0_transpose_item(w_ukv, 256, 2048, (bf16*)(ws + WS_WT_UKV), scr, r, lane, [](int n) { return n; }, [=](int k) { return g_ckv[k]; }); continue; } r -= I_UKV;
        if (r < I_SQ) { p0_transpose_item(w_out, 2048, 2048, (bf16*)(ws + WS_WT_OUT), scr, r, lane, [](int n) { return n; }, [=](int k) { return k < 1024 ? g_oa[k] : g_os[k - 1024]; }); continue; } r -= I_SQ;
        if (r < I_SQ) { p0_transpose_item(w_pq, 2048, 2048, (bf16*)(ws + WS_WT_PQ), scr, r, lane, [](int n) { return n; }, [=](int k) { return g_ffn[k]; }); continue; } r -= I_SQ;
        if (r < I_SQ) { p0_transpose_item(w_pg, 2048, 2048, (bf16*)(ws + WS_WT_PG), scr, r, lane, [](int n) { return n; }, [=](int k) { return g_ple[k]; }); continue; } r -= I_SQ;
        p0_transpose_item(w_pp, 256, 2048, (bf16*)(ws + WS_WT_PP), scr, r, lane, [](int n) { return n; }, [](int) { return 1.f; });
    }
    for (int it = gw; it < 192 * 2048 / 512; it += NGW) *(GAS v4u*)((bf16*)(ws + WS_WT_IN) + (size_t)2880 * 2048 + (size_t)it * 512 + lane * 8) = (v4u){0u, 0u, 0u, 0u};
    for (int it = gw; it < 3 * 256; it += NGW) { const int w = it >> 8, c = it & 255;
        if (w == 0) p0_cvt512(k1, (bf16*)(ws + WS_K1B), (size_t)c * 512, lane, [](size_t) { return 1.f; });
        else if (w == 1) p0_cvt512(k2, (bf16*)(ws + WS_K2B), (size_t)c * 512, lane, [](size_t) { return 1.f; });
        else p0_cvt512(w_sgu, (bf16*)(ws + WS_WSGU), (size_t)c * 512, lane, [](size_t e) { const int s = (int)(e & 127), t = (int)((e >> 7) & 127); return s <= t ? 1.f : 0.f; }); }
#if CUT >= 7
    for (int it = gw; it < 2 * 16384 * 2; it += NGW) { const int w = it >= 16384 * 2, c = w ? it - 16384 * 2 : it; const float* src = (w ? pv : pu) + (size_t)c * 1024 + lane * 16; const int d0 = (c & 1) * 1024 + lane * 16;
        f32x4 x[4];
#pragma unroll
        for (int q = 0; q < 4; ++q) x[q] = *(const GAS f32x4*)(src + 4 * q);
        if (!w) {
#pragma unroll
            for (int q = 0; q < 4; ++q) x[q] = x[q] * *(const GAS f32x4*)(g_ffn + d0 + 4 * q) * 256.f; }
        else {
#pragma unroll
            for (int q = 0; q < 4; ++q) x[q] = x[q] * 16.f; }
        v4u o; int t;
        t = 0; t = __builtin_amdgcn_cvt_pk_fp8_f32(x[0][0], x[0][1], t, false); t = __builtin_amdgcn_cvt_pk_fp8_f32(x[0][2], x[0][3], t, true); o.x = (unsigned)t;
        t = 0; t = __builtin_amdgcn_cvt_pk_fp8_f32(x[1][0], x[1][1], t, false); t = __builtin_amdgcn_cvt_pk_fp8_f32(x[1][2], x[1][3], t, true); o.y = (unsigned)t;
        t = 0; t = __builtin_amdgcn_cvt_pk_fp8_f32(x[2][0], x[2][1], t, false); t = __builtin_amdgcn_cvt_pk_fp8_f32(x[2][2], x[2][3], t, true); o.z = (unsigned)t;
        t = 0; t = __builtin_amdgcn_cvt_pk_fp8_f32(x[3][0], x[3][1], t, false); t = __builtin_amdgcn_cvt_pk_fp8_f32(x[3][2], x[3][3], t, true); o.w = (unsigned)t;
        *(GAS v4u*)((unsigned char*)(ws + (w ? WS_VB : WS_UB)) + (size_t)c * 1024 + lane * 16) = o; }
#endif
}

__device__ __forceinline__ v4u pack8(f32x4 a, f32x4 b) { v4u w; w.x = pg8::cvt_pk_bf16(a[0], a[1]); w.y = pg8::cvt_pk_bf16(a[2], a[3]); w.z = pg8::cvt_pk_bf16(b[0], b[1]); w.w = pg8::cvt_pk_bf16(b[2], b[3]); return w; }
__device__ __forceinline__ float sq8(f32x4 a, f32x4 b) { return ((a[0] * a[0] + a[1] * a[1]) + (a[2] * a[2] + a[3] * a[3])) + ((b[0] * b[0] + b[1] * b[1]) + (b[2] * b[2] + b[3] * b[3])); }
__device__ __forceinline__ float fq_sum(float v) { v += __shfl_xor(v, 16); v += __shfl_xor(v, 32); return v; }
#define EPI_ROWS_BEGIN _Pragma("unroll") for (int ai = 0; ai < 2; ++ai) _Pragma("unroll") for (int m = 0; m < 4; ++m) { const int row = u.pm * 256 + ai * 128 + wr * 64 + m * 16 + fr;
#define EPI_ROWS_END }

struct EpiG1 {
    static constexpr bool PERM = true, AFTER_DRAIN = false, MID = false;
    const float* rsx; bf16 *CQ, *CKV, *KR, *UG, *VG; float *pscq, *psckv; f32x2v* psv; const f32x2v* cs;
    __device__ __forceinline__ void operator()(const f32x4 (&acc)[2][2][4][2], const pg8::Unit& u, int wr, int wc, int fr, int fq) const {
        const int pn = u.pn;
        EPI_ROWS_BEGIN
            const float rs = rsx[row];
#pragma unroll
            for (int bj = 0; bj < 2; ++bj) { f32x4 v0 = acc[ai][bj][m][0] * rs, v1 = acc[ai][bj][m][1] * rs; const int lc = bj * 128 + wc * 32 + fq * 8;
                if (pn <= 2) { const float ss = fq_sum(sq8(v0, v1));
                    if (pn < 2) { *(GAS v4u*)(CQ + (size_t)row * 512 + pn * 256 + lc) = pack8(v0, v1); if (fq == 0) pscq[row * 16 + (pn * 2 + bj) * 4 + wc] = ss; }
                    else { *(GAS v4u*)(CKV + (size_t)row * 256 + lc) = pack8(v0, v1); if (fq == 0) psckv[row * 8 + bj * 4 + wc] = ss; } }
                else if (pn <= 10) {
#pragma unroll
                    for (int e = 0; e < 4; ++e) { v0[e] = gelu_f(v0[e]); v1[e] = gelu_f(v1[e]); }
                    if (pn <= 6) *(GAS v4u*)(UG + (size_t)row * 1024 + (pn - 3) * 256 + lc) = pack8(v0, v1);
                    else { const float s = fq_sum(((v0[0] + v0[1]) + (v0[2] + v0[3])) + ((v1[0] + v1[1]) + (v1[2] + v1[3]))), q = fq_sum(sq8(v0, v1));
                        *(GAS v4u*)(VG + (size_t)row * 1024 + (pn - 7) * 256 + lc) = pack8(v0, v1); if (fq == 0) psv[(row * 8 + (pn - 7) * 2 + bj) * 4 + wc] = (f32x2v){s, q}; } }
                else if (bj == 0 && wc < 2) { f32x4 o0, o1;
#pragma unroll
                    for (int e = 0; e < 4; ++e) { const f32x2v c = cs[row * 32 + 16 * wc + 4 * fq + e]; o0[e] = v0[e] * c.x - v1[e] * c.y; o1[e] = v1[e] * c.x + v0[e] * c.y; }
                    *(GAS v4u*)(KR + (size_t)row * 64 + wc * 32 + fq * 8) = pack8(o0, o1); } }
        EPI_ROWS_END
    }
};
struct EpiPlain {
    static constexpr bool PERM = true, AFTER_DRAIN = false, MID = false;
    bf16* O; int ldc;
    __device__ __forceinline__ void operator()(const f32x4 (&acc)[2][2][4][2], const pg8::Unit& u, int wr, int wc, int fr, int fq) const {
        EPI_ROWS_BEGIN
#pragma unroll
            for (int bj = 0; bj < 2; ++bj) *(GAS v4u*)(O + (size_t)row * ldc + u.pn * 256 + bj * 128 + wc * 32 + fq * 8) = pack8(acc[ai][bj][m][0], acc[ai][bj][m][1]);
        EPI_ROWS_END
    }
};
template <class Sched>
__device__ __forceinline__ void setup_rowtab(LAS float* tab, const float* part, int NP, float inv_dim, const Sched& S, int wid) {
    pg8::Unit u; const int tid = wid * 64 + lane_id();
    if (S.next(0, u)) { const int r = tid >> 1, half = tid & 1, n2 = NP >> 1; const float* pp = part + (size_t)(u.pm * 256 + r) * NP + half * n2; float s = 0.f;
        for (int j = 0; j < n2; ++j) s += pp[j];
        s += __shfl_xor(s, 1); if (!half) tab[r] = 1.0f / sqrtf(s * inv_dim + 1e-6f); }
}
struct EpiQ {
    static constexpr bool PERM = true, AFTER_DRAIN = false, MID = false;
    const LAS float* tab; bf16* Q; const f32x2v* cs;
    __device__ __forceinline__ void operator()(const f32x4 (&acc)[2][2][4][2], const pg8::Unit& u, int wr, int wc, int fr, int fq) const {
        EPI_ROWS_BEGIN
            const float rs = tab[ai * 128 + wr * 64 + m * 16 + fr];
#pragma unroll
            for (int bj = 0; bj < 2; ++bj) { f32x4 v0 = acc[ai][bj][m][0] * rs, v1 = acc[ai][bj][m][1] * rs; const int gc = u.pn * 256 + bj * 128 + wc * 32;
                if (((gc >> 6) % 3) == 2) { f32x4 o0, o1;
#pragma unroll
                    for (int e = 0; e < 4; ++e) { const f32x2v c = cs[row * 32 + 16 * (wc & 1) + 4 * fq + e]; o0[e] = v0[e] * c.x - v1[e] * c.y; o1[e] = v1[e] * c.x + v0[e] * c.y; }
                    v0 = o0; v1 = o1; }
                *(GAS v4u*)(Q + (size_t)row * 1536 + gc + fq * 8) = pack8(v0, v1); }
        EPI_ROWS_END
    }
};
struct EpiKV {
    static constexpr bool PERM = true, AFTER_DRAIN = false, MID = false;
    const LAS float* tab; bf16 *KN, *VV;
    __device__ __forceinline__ void operator()(const f32x4 (&acc)[2][2][4][2], const pg8::Unit& u, int wr, int wc, int fr, int fq) const {
        EPI_ROWS_BEGIN
            const float rs = tab[ai * 128 + wr * 64 + m * 16 + fr];
#pragma unroll
            for (int bj = 0; bj < 2; ++bj) *(GAS v4u*)((bj ? VV : KN) + (size_t)row * 1024 + u.pn * 128 + wc * 32 + fq * 8) = pack8(acc[ai][bj][m][0] * rs, acc[ai][bj][m][1] * rs);
        EPI_ROWS_END
    }
};
struct EpiOut {
    static constexpr bool PERM = true, AFTER_DRAIN = false, MID = true;
    const LAS float* tab; const float* x; float* H1; bf16* H1B; float* psh1;
    __device__ __forceinline__ void mid(f32x4 (&acc)[2][2][4][2], const pg8::Unit& u, int wr, int wc, int fr, int fq) const {
#pragma unroll
        for (int ai = 0; ai < 2; ++ai)
#pragma unroll
            for (int m = 0; m < 4; ++m) { const int r = ai * 128 + wr * 64 + m * 16 + fr; const float rr = tab[r] / tab[256 + r];
#pragma unroll
                for (int bj = 0; bj < 2; ++bj) { acc[ai][bj][m][0] *= rr; acc[ai][bj][m][1] *= rr; } }
    }
    __device__ __forceinline__ void operator()(const f32x4 (&acc)[2][2][4][2], const pg8::Unit& u, int wr, int wc, int fr, int fq) const {
        EPI_ROWS_BEGIN
            const float rs = tab[256 + ai * 128 + wr * 64 + m * 16 + fr];
#pragma unroll
            for (int bj = 0; bj < 2; ++bj) { const size_t off = (size_t)row * DM + u.pn * 256 + bj * 128 + wc * 32 + fq * 8;
                const f32x4 v0 = *(const GAS f32x4*)(x + off) + acc[ai][bj][m][0] * rs, v1 = *(const GAS f32x4*)(x + off + 4) + acc[ai][bj][m][1] * rs;
                *(GAS f32x4*)(H1 + off) = v0; *(GAS f32x4*)(H1 + off + 4) = v1; *(GAS v4u*)(H1B + off) = pack8(v0, v1);
                const float ss = fq_sum(sq8(v0, v1)); if (fq == 0) psh1[row * 64 + u.pn * 8 + bj * 4 + wc] = ss; }
        EPI_ROWS_END
    }
};
struct EpiPQ {
    static constexpr bool PERM = true, AFTER_DRAIN = false, MID = false;
    const LAS float* tab; bf16* QP;
    __device__ __forceinline__ void operator()(const f32x4 (&acc)[2][2][4][2], const pg8::Unit& u, int wr, int wc, int fr, int fq) const {
        EPI_ROWS_BEGIN
            const float rs = tab[ai * 128 + wr * 64 + m * 16 + fr];
#pragma unroll
            for (int bj = 0; bj < 2; ++bj) *(GAS v4u*)(QP + (size_t)row * DM + u.pn * 256 + bj * 128 + wc * 32 + fq * 8) = pack8(acc[ai][bj][m][0] * rs, acc[ai][bj][m][1] * rs);
        EPI_ROWS_END
    }
};
struct EpiPLE {
    static constexpr bool PERM = true, AFTER_DRAIN = false, MID = false;
    const float* rsh2; const float* H2; const bf16* PPROJ; float* out; float* psh3;
    __device__ __forceinline__ void operator()(const f32x4 (&acc)[2][2][4][2], const pg8::Unit& u, int wr, int wc, int fr, int fq) const {
        EPI_ROWS_BEGIN
            const float rs = rsh2[row];
#pragma unroll
            for (int bj = 0; bj < 2; ++bj) { const size_t off = (size_t)row * DM + u.pn * 256 + bj * 128 + wc * 32 + fq * 8;
                const v4u pw = *(const GAS v4u*)(PPROJ + off); f32x4 h0 = *(const GAS f32x4*)(H2 + off), h1 = *(const GAS f32x4*)(H2 + off + 4);
                const unsigned pws[4] = {pw.x, pw.y, pw.z, pw.w};
#pragma unroll
                for (int e = 0; e < 4; ++e) { const float a = acc[ai][bj][m][e >> 1][(e & 1) * 2] * rs, b = acc[ai][bj][m][e >> 1][(e & 1) * 2 + 1] * rs;
                    const float ga = __builtin_amdgcn_rcpf(1.f + __builtin_amdgcn_exp2f(-1.4426950408889634f * a)), gb = __builtin_amdgcn_rcpf(1.f + __builtin_amdgcn_exp2f(-1.4426950408889634f * b));
                    const float pa = __uint_as_float(pws[e] << 16), pb = __uint_as_float(pws[e] & 0xffff0000u);
                    if (e < 2) { h0[(e & 1) * 2] += ga * pa; h0[(e & 1) * 2 + 1] += gb * pb; } else { h1[(e & 1) * 2] += ga * pa; h1[(e & 1) * 2 + 1] += gb * pb; } }
                *(GAS f32x4*)(out + off) = h0; *(GAS f32x4*)(out + off + 4) = h1;
                const float ss = fq_sum(sq8(h0, h1)); if (fq == 0) psh3[row * 64 + u.pn * 8 + bj * 4 + wc] = ss; }
        EPI_ROWS_END
    }
};
typedef float f32x16 __attribute__((ext_vector_type(16)));
typedef short s16x4 __attribute__((ext_vector_type(4)));
#define KSWZ(row, colB) ((row) * 256 + ((colB) ^ (((row) & 7) << 4)))
__device__ __forceinline__ int v_st(int k, int c) { const int kk = (k & ~0xC) | ((k & 4) << 1) | ((k & 8) >> 1); return ((kk >> 3) * 4 + (c >> 5)) * 512 + ((kk & 7) * 32 + (c & 31)) * 2; }
__device__ __forceinline__ int v_rd_base(int lane) { return ((lane & 3) << 3) | (((lane >> 2) & 3) << 6) | (((lane >> 4) & 1) << 5) | (((lane >> 5) & 1) << 8); }
__device__ __forceinline__ int crow(int r, int hi) { return (r & 3) + 8 * (r >> 2) + 4 * hi; }
#define TRRD(dst, off) asm volatile("ds_read_b64_tr_b16 %0, %1 offset:%2" : "=&v"(dst) : "v"(vb0), "i"(off) : "memory")
#define SBAR() __builtin_amdgcn_sched_barrier(0)
#define PV_ONE(o_, pa_, VOFF, D0, KS) do { s16x4 l_, h_; TRRD(l_, (VOFF) + (D0) * 512 + (KS) * 4096); TRRD(h_, (VOFF) + (D0) * 512 + (KS) * 4096 + 2048); \
        asm volatile("s_waitcnt lgkmcnt(0)" ::: "memory"); SBAR(); \
        o_ = __builtin_amdgcn_mfma_f32_32x32x16_bf16(pa_, (bf16x8){l_[0], l_[1], l_[2], l_[3], h_[0], h_[1], h_[2], h_[3]}, o_, 0, 0, 0); } while (0)
__device__ __forceinline__ float half_sum32(float v) { v += __shfl_xor(v, 1); v += __shfl_xor(v, 2); v += __shfl_xor(v, 4); v += __shfl_xor(v, 8); v += __shfl_xor(v, 16); return v; }

__device__ __forceinline__ void sgu_phase(const Args& A, Frame& F) {
    unsigned char* ws = A.ws;
    const bf16* VG = (const bf16*)(ws + WS_VG); const bf16* UG = (const bf16*)(ws + WS_UG); const bf16* WS = (const bf16*)(ws + WS_WSGU); const f32x2v* psv = (const f32x2v*)(ws + WS_PSV);
    const float* gln = (const float*)A.in[9]; const float* bln = (const float*)A.in[10]; const float* bs = (const float*)A.in[12];
    bf16* MIX = (bf16*)(ws + WS_MIX); float* pss = (float*)(ws + WS_PSS);
    const int lane = lane_id(), wid = F.wave, tid = wid * 64 + lane, r32 = lane & 31, hi = lane >> 5, tg = wid & 3, dh = wid >> 2;
    LAS unsigned char* V_lds = F.lds + RING_OFF;
    const int vb0 = (int)(uintptr_t)V_lds + v_rd_base(lane);
    for (int unit = F.vcu; unit < 512; unit += F.G) {
        const int g = unit & 7, R0 = (unit >> 3) * 128;
#pragma unroll
        for (int i = 0; i < 4; ++i) { const int s = (tid >> 4) + 32 * i, c = (tid & 15) * 8, row = R0 + s;
            const f32x2v* pp = psv + ((size_t)row * 8 + g) * 4; const f32x2v p0 = pp[0], p1 = pp[1], p2 = pp[2], p3 = pp[3];
            const float mean = ((p0.x + p1.x) + (p2.x + p3.x)) * (1.f / 128.f), var = ((p0.y + p1.y) + (p2.y + p3.y)) * (1.f / 128.f) - mean * mean, rstd = 1.0f / sqrtf(fmaxf(var, 0.f) + 1e-6f);
            const v4u xv = *(const GAS v4u*)(VG + (size_t)row * 1024 + g * 128 + c);
            const f32x4 g0 = *(const GAS f32x4*)(gln + g * 128 + c), g1 = *(const GAS f32x4*)(gln + g * 128 + c + 4), b0 = *(const GAS f32x4*)(bln + g * 128 + c), b1 = *(const GAS f32x4*)(bln + g * 128 + c + 4);
            f32x4 y0, y1;
            y0[0] = (__uint_as_float(xv.x << 16) - mean) * rstd * g0[0] + b0[0]; y0[1] = (__uint_as_float(xv.x & 0xffff0000u) - mean) * rstd * g0[1] + b0[1];
            y0[2] = (__uint_as_float(xv.y << 16) - mean) * rstd * g0[2] + b0[2]; y0[3] = (__uint_as_float(xv.y & 0xffff0000u) - mean) * rstd * g0[3] + b0[3];
            y1[0] = (__uint_as_float(xv.z << 16) - mean) * rstd * g1[0] + b1[0]; y1[1] = (__uint_as_float(xv.z & 0xffff0000u) - mean) * rstd * g1[1] + b1[1];
            y1[2] = (__uint_as_float(xv.w << 16) - mean) * rstd * g1[2] + b1[2]; y1[3] = (__uint_as_float(xv.w & 0xffff0000u) - mean) * rstd * g1[3] + b1[3];
            *(LAS v4u*)(V_lds + (s >> 6) * 16384 + v_st(s & 63, c)) = pack8(y0, y1); }
        bf16x8 afr[8];
#pragma unroll
        for (int ks = 0; ks < 8; ++ks) afr[ks] = *(const GAS bf16x8*)(WS + ((size_t)g * 128 + 32 * tg + r32) * 128 + 16 * ks + 8 * hi);
        __syncthreads();
        f32x16 o0 = {}, o1 = {};
#define SGU_TILE(TL) do { _Pragma("unroll") for (int ks = 0; ks < 4; ++ks) { \
            if (dh == 0) { PV_ONE(o0, afr[4 * TL + ks], TL * 16384, 0, ks); PV_ONE(o1, afr[4 * TL + ks], TL * 16384, 1, ks); } \
            else { PV_ONE(o0, afr[4 * TL + ks], TL * 16384, 2, ks); PV_ONE(o1, afr[4 * TL + ks], TL * 16384, 3, ks); } } } while (0)
        SGU_TILE(0); if (tg >= 2) SGU_TILE(1);
#undef SGU_TILE
#pragma unroll
        for (int r = 0; r < 16; ++r) { const int t = 32 * tg + crow(r, hi), row = R0 + t; const float bias = bs[g * 128 + t];
            const int d0 = 64 * dh + r32; const size_t uoff = (size_t)row * 1024 + g * 128 + d0;
            const float va = bf2f(UG[uoff]) * (o0[r] + bias), vb = bf2f(UG[uoff + 32]) * (o1[r] + bias);
            const float na = __shfl_xor(va, 1), nb = __shfl_xor(vb, 1);
            if ((r32 & 1) == 0) { bf16* mo = MIX + (size_t)row * 2048 + 1024 + g * 128 + d0; *(GAS unsigned*)mo = pg8::cvt_pk_bf16(va, na); *(GAS unsigned*)(mo + 32) = pg8::cvt_pk_bf16(vb, nb); }
            const float ss = half_sum32(va * va + vb * vb); if (r32 == 0) pss[row * 16 + g * 2 + dh] = ss; }
        __syncthreads();
    }
}

#define OPAQUE(x) asm volatile("" : "+v"(x))
constexpr int KT_ROW = 400, KT_BYTES = 64 * KT_ROW;
__device__ __forceinline__ void attn_phase(const Args& A, Frame& F) {
    unsigned char* ws = A.ws;
    const GAS unsigned char* Qg = (const GAS unsigned char*)(ws + WS_Q); const GAS unsigned char* KNg = (const GAS unsigned char*)(ws + WS_KN); const GAS unsigned char* VVg = (const GAS unsigned char*)(ws + WS_VV); const GAS unsigned char* KRg = (const GAS unsigned char*)(ws + WS_KR);
    bf16* MIX = (bf16*)(ws + WS_MIX); float* psa = (float*)(ws + WS_PSA);
    const int wid = F.wave, g = wid & 3, kh = wid >> 2;
    LAS unsigned char* V_lds = F.lds + RING_OFF; LAS unsigned char* Kt_lds = V_lds + 32768;
    LAS float* wsc = (LAS float*)(V_lds + 86016) + wid * 64;
    LAS float* ml1 = (LAS float*)(V_lds + 86016 + 2048);
    for (int item = F.vcu; item < 256; item += F.G) {
        const int bh = item >> 3, s = item & 7, b = bh >> 3, h = bh & 7, tok0 = b * SEQ;
        for (int pass = 0; pass < 2; ++pass) {
            const int jq = pass ? s : 15 - s, q0 = tok0 + 128 * jq, NT = 2 * (jq + 1);
            bf16x8 qr[12];
            { int ln = lane_id(); const int r32 = ln & 31, hi = ln >> 5; const GAS unsigned char* qp = Qg + (size_t)(q0 + 32 * g) * 3072 + h * 384; const unsigned qo = (unsigned)r32 * 3072u + (unsigned)hi * 16u;
#pragma unroll
              for (int ks = 0; ks < 12; ++ks) qr[ks] = *(const GAS bf16x8*)(qp + qo + ks * 32); }
            bf16x8 skn0, skn1, sv0, sv1, skr;
#define ALOAD(t_) do { int ln_ = lane_id(); const int tid_ = wid * 64 + ln_; const unsigned sr_ = tid_ >> 4, sc_ = tid_ & 15; \
                const GAS unsigned char* kb_ = KNg + (size_t)(tok0 + 64 * (t_)) * 2048 + h * 256; const GAS unsigned char* vb_ = VVg + (size_t)(tok0 + 64 * (t_)) * 2048 + h * 256; const GAS unsigned char* rb_ = KRg + (size_t)(tok0 + 64 * (t_)) * 128; \
                const unsigned o_ = sr_ * 2048u + sc_ * 16u; \
                skn0 = *(const GAS bf16x8*)(kb_ + o_); skn1 = *(const GAS bf16x8*)(kb_ + o_ + 65536u); sv0 = *(const GAS bf16x8*)(vb_ + o_); sv1 = *(const GAS bf16x8*)(vb_ + o_ + 65536u); \
                skr = *(const GAS bf16x8*)(rb_ + (unsigned)tid_ * 16u); } while (0)
#define AWRITE(bf_) do { int ln_ = lane_id(); const int tid_ = wid * 64 + ln_; const int sr_ = tid_ >> 4, sc_ = tid_ & 15; \
                LAS unsigned char* kt_ = Kt_lds + (bf_) * KT_BYTES; LAS unsigned char* vt_ = V_lds + (bf_) * 16384; \
                *(LAS bf16x8*)(kt_ + sr_ * KT_ROW + sc_ * 16) = skn0; *(LAS bf16x8*)(kt_ + (sr_ + 32) * KT_ROW + sc_ * 16) = skn1; \
                *(LAS bf16x8*)(vt_ + v_st(sr_, sc_ * 8)) = sv0; *(LAS bf16x8*)(vt_ + v_st(32 + sr_, sc_ * 8)) = sv1; \
                *(LAS bf16x8*)(kt_ + (tid_ >> 3) * KT_ROW + 256 + (tid_ & 7) * 16) = skr; } while (0)
            ALOAD(0); AWRITE(0); __syncthreads();
            float m_reg = -1e30f, l_reg = 0.f; f32x16 o[4] = {};
            for (int t = 0; t < NT; ++t) {
                const int bf = t & 1;
                if (t + 1 < NT) ALOAD(t + 1);
                int ln = lane_id(); const int r32 = ln & 31, hi = ln >> 5;
                f32x16 p = {};
                { const LAS unsigned char* kb = Kt_lds + bf * KT_BYTES + (32 * kh + r32) * KT_ROW + hi * 16;
#pragma unroll
                  for (int ks = 0; ks < 12; ++ks) p = __builtin_amdgcn_mfma_f32_32x32x16_bf16(*(const LAS bf16x8*)(kb + ks * 32), qr[ks], p, 0, 0, 0); }
                if (t >= 2 * jq) { const int dq = (32 * g + r32) - (64 * (t - 2 * jq) + 32 * kh + 4 * hi);
#pragma unroll
                    for (int r = 0; r < 16; ++r) { const int c = (r & 3) + 8 * (r >> 2); if (c > dq) p[r] = -__builtin_inff(); } }
                float pmax = p[0];
#pragma unroll
                for (int r = 1; r < 16; ++r) pmax = fmaxf(pmax, p[r]);
                { auto rr = __builtin_amdgcn_permlane32_swap(__float_as_uint(pmax), __float_as_uint(pmax), false, false); pmax = fmaxf(__uint_as_float(rr[0]), __uint_as_float(rr[1])); }
                const float mn = fmaxf(m_reg, pmax), alpha = __builtin_amdgcn_exp2f(m_reg - mn); m_reg = mn;
                float ps = 0.f;
#pragma unroll
                for (int r = 0; r < 16; ++r) { p[r] = __builtin_amdgcn_exp2f(p[r] - mn); ps += p[r]; }
                { auto rr = __builtin_amdgcn_permlane32_swap(__float_as_uint(ps), __float_as_uint(ps), false, false); ps = __uint_as_float(rr[0]) + __uint_as_float(rr[1]); }
                l_reg = l_reg * alpha + ps;
                if (__any(alpha < 1.f)) { if (hi == 0) wsc[r32] = alpha; asm volatile("s_waitcnt lgkmcnt(0)" ::: "memory");
#pragma unroll
                    for (int r = 0; r < 16; ++r) { const float f = wsc[crow(r, hi)];
#pragma unroll
                        for (int d_ = 0; d_ < 4; ++d_) o[d_][r] *= f; } }
                bf16x8 pa0, pa1;
#define PK4(P, B_, OUT) do { unsigned a0 = pg8::cvt_pk_bf16(P[B_ + 0], P[B_ + 1]), a1 = pg8::cvt_pk_bf16(P[B_ + 2], P[B_ + 3]), b0 = pg8::cvt_pk_bf16(P[B_ + 4], P[B_ + 5]), b1 = pg8::cvt_pk_bf16(P[B_ + 6], P[B_ + 7]); \
                    auto r0 = __builtin_amdgcn_permlane32_swap(a0, b0, false, false); auto r1 = __builtin_amdgcn_permlane32_swap(a1, b1, false, false); \
                    v4u w = {r0[0], r1[0], r0[1], r1[1]}; OUT = __builtin_bit_cast(bf16x8, w); } while (0)
                PK4(p, 0, pa0); PK4(p, 8, pa1);
#undef PK4
                { const int vb0 = (int)(uintptr_t)V_lds + v_rd_base(ln) + bf * 16384 + kh * 8192;
#pragma unroll
                  for (int d0 = 0; d0 < 4; ++d0) { PV_ONE(o[d0], pa0, 0, d0, 0); PV_ONE(o[d0], pa1, 0, d0, 1); } }
                if (t + 1 < NT) AWRITE(bf ^ 1);
                __syncthreads();
            }
#undef ALOAD
#undef AWRITE
            { int ln = lane_id(); const int r32 = ln & 31, hi = ln >> 5;
            LAS float* O1 = (LAS float*)(V_lds + g * 16384) + ln;
            if (kh == 1) {
#pragma unroll
                for (int d0 = 0; d0 < 4; ++d0)
#pragma unroll
                    for (int r = 0; r < 16; ++r) O1[(d0 * 16 + r) * 64] = o[d0][r];
                if (hi == 0) { ml1[g * 64 + r32] = m_reg; ml1[g * 64 + 32 + r32] = l_reg; } }
            __syncthreads();
            if (kh == 0) { const float m1 = ml1[g * 64 + r32], l1 = ml1[g * 64 + 32 + r32], mt = fmaxf(m_reg, m1), a0 = __builtin_amdgcn_exp2f(m_reg - mt), a1 = __builtin_amdgcn_exp2f(m1 - mt), il = 1.0f / (l_reg * a0 + l1 * a1);
                if (hi == 0) { wsc[r32] = a0 * il; wsc[32 + r32] = a1 * il; } asm volatile("s_waitcnt lgkmcnt(0)" ::: "memory");
#pragma unroll
                for (int r = 0; r < 16; ++r) { const int qrow = q0 + 32 * g + crow(r, hi); const float f0 = wsc[crow(r, hi)], f1 = wsc[32 + crow(r, hi)]; float ss = 0.f;
#pragma unroll
                    for (int d0 = 0; d0 < 4; ++d0) { const float v = o[d0][r] * f0 + O1[(d0 * 16 + r) * 64] * f1; ss += v * v; const float vn = __shfl_xor(v, 1);
                        if ((r32 & 1) == 0) *(GAS unsigned*)(MIX + (size_t)qrow * 2048 + h * 128 + d0 * 32 + r32) = pg8::cvt_pk_bf16(v, vn); }
                    ss = half_sum32(ss); if (r32 == 0) psa[qrow * 8 + h] = ss; } }
            __syncthreads(); }
        }
    }
}
typedef __bf16 bf16x2_t __attribute__((ext_vector_type(2)));
__device__ __forceinline__ unsigned ord_key(float f) { const unsigned u = __float_as_uint(f); return u ^ ((unsigned)((int)u >> 31) | 0x80000000u); }
__device__ __forceinline__ float ord_val(unsigned k) { return __uint_as_float((k & 0x80000000u) ? (k ^ 0x80000000u) : ~k); }
__device__ __forceinline__ unsigned umax3(unsigned a, unsigned b, unsigned c) { return max(max(a, b), c); }
__device__ __forceinline__ unsigned pair_max(unsigned v) { auto rr = __builtin_amdgcn_permlane32_swap(v, v, false, false); return max(rr[0], rr[1]); }
__device__ __forceinline__ unsigned pair_or(unsigned v) { auto rr = __builtin_amdgcn_permlane32_swap(v, v, false, false); return rr[0] | rr[1]; }
__host__ __device__ constexpr int cand_a(int c) { return c < 16 ? 0 : c < 24 ? 1 : c < 29 ? 2 : c < 33 ? 3 : c < 36 ? 4 : c < 38 ? 5 : c < 40 ? 6 : c < 42 ? 7 : c - 34; }
__host__ __device__ constexpr int cand_b(int c) { return c < 16 ? c : c < 24 ? c - 16 : c < 29 ? c - 24 : c < 33 ? c - 29 : c < 36 ? c - 33 : c < 38 ? c - 36 : c < 40 ? c - 38 : c < 42 ? c - 40 : 0; }
__device__ __forceinline__ void topk16_of_128(const bf16* keys  , const bf16* qrow  , int r32, int hi, unsigned (&sel)[16]) {
    bf16x8 qf[8];
#pragma unroll
    for (int ks = 0; ks < 8; ++ks) qf[ks] = *(const GAS bf16x8*)(qrow + 16 * ks + 8 * hi);
    unsigned k[64];
#pragma unroll
    for (int kb = 0; kb < 4; ++kb) { f32x16 acc = {};
#pragma unroll
        for (int ks = 0; ks < 8; ++ks) acc = __builtin_amdgcn_mfma_f32_32x32x16_bf16(*(const GAS bf16x8*)(keys + (size_t)(32 * kb + r32) * 128 + 16 * ks + 8 * hi), qf[ks], acc, 0, 0, 0);
#pragma unroll
        for (int r = 0; r < 16; ++r) k[kb * 16 + r] = (ord_key(acc[r]) & ~0x7fu) | (unsigned)(127 - (32 * kb + crow(r, hi))); }
#pragma unroll
    for (int it = 0; it < 16; ++it) { unsigned m = umax3(k[0], k[1], k[2]);
#pragma unroll
        for (int i = 3; i < 63; i += 2) m = umax3(m, k[i], k[i + 1]);
        m = max(m, k[63]); m = pair_max(m); sel[it] = m;
#pragma unroll
        for (int i = 0; i < 64; ++i) k[i] = (k[i] == m) ? 0u : k[i]; }
}
__device__ __forceinline__ void topk_phase(const Args& A, Frame& F) {
    unsigned char* ws = A.ws;
    const bf16* QP = (const bf16*)(ws + WS_R1); const bf16* K1 = (const bf16*)(ws + WS_K1B); const bf16* K2 = (const bf16*)(ws + WS_K2B); int* IDX = (int*)(ws + WS_IDX); float* GATE = (float*)(ws + WS_GATE);
    const int wid = F.wave;
    for (int unit = F.vcu; unit < 256; unit += F.G) {
        const int rb = unit >> 3, h = unit & 7; const int ln = lane_id(), r32 = ln & 31, hi = ln >> 5; const int tok = rb * 256 + wid * 32 + r32;
        unsigned s1[16], s2[16];
        topk16_of_128(K1 + (size_t)h * 16384, QP + (size_t)tok * 2048 + h * 256, r32, hi, s1);
        topk16_of_128(K2 + (size_t)h * 16384, QP + (size_t)tok * 2048 + h * 256 + 128, r32, hi, s2);
        float t1v[16], t2v[16]; int i1[16], i2[16];
#pragma unroll
        for (int a = 0; a < 16; ++a) { t1v[a] = ord_val(s1[a] & ~0x7fu); i1[a] = 127 - (int)(s1[a] & 0x7fu); t2v[a] = ord_val(s2[a] & ~0x7fu); i2[a] = 127 - (int)(s2[a] & 0x7fu); }
        unsigned ck[25]; int ce[25];
#pragma unroll
        for (int j = 0; j < 25; ++j) { constexpr int dummy = 0; (void)dummy;
            const int c0 = 2 * j, c1 = 2 * j + 1;
            const float v0 = t1v[cand_a(c0)] + t2v[cand_b(c0)], v1 = t1v[cand_a(c1)] + t2v[cand_b(c1)];
            const unsigned k0 = (ord_key(v0) & ~0xffu) | (unsigned)(255 - (cand_a(c0) * 16 + cand_b(c0))), k1 = (ord_key(v1) & ~0xffu) | (unsigned)(255 - (cand_a(c1) * 16 + cand_b(c1)));
            const int e0 = i1[cand_a(c0)] * 128 + i2[cand_b(c0)], e1 = i1[cand_a(c1)] * 128 + i2[cand_b(c1)];
            ck[j] = hi ? k1 : k0; ce[j] = hi ? e1 : e0; }
        unsigned gk[16]; int ge[16];
#pragma unroll
        for (int it = 0; it < 16; ++it) { unsigned m = ck[0];
#pragma unroll
            for (int j = 1; j < 25; j += 2) m = umax3(m, ck[j], ck[j + 1]);
            m = pair_max(m); gk[it] = m; int e = 0;
#pragma unroll
            for (int j = 0; j < 25; ++j) { const bool eq = ck[j] == m; e = eq ? ce[j] : e; ck[j] = eq ? 0u : ck[j]; }
            ge[it] = e; }
        float ev[16]; float l = 0.f; const float v0 = ord_val(gk[0] & ~0xffu);
#pragma unroll
        for (int it = 0; it < 16; ++it) { ge[it] = (int)pair_or((unsigned)ge[it]); ev[it] = __builtin_amdgcn_exp2f((ord_val(gk[it] & ~0xffu) - v0) * 1.4426950408889634f); l += ev[it]; }
        const float il = 1.0f / l;
        if (hi == 0) { int* ip = IDX + (size_t)tok * 128 + h * 16; float* gp = GATE + (size_t)tok * 128 + h * 16;
#pragma unroll
            for (int q = 0; q < 4; ++q) { *(GAS v4u*)(ip + 4 * q) = (v4u){(unsigned)ge[4 * q], (unsigned)ge[4 * q + 1], (unsigned)ge[4 * q + 2], (unsigned)ge[4 * q + 3]};
                *(GAS f32x4*)(gp + 4 * q) = (f32x4){ev[4 * q] * il, ev[4 * q + 1] * il, ev[4 * q + 2] * il, ev[4 * q + 3] * il}; } }
    }
}

__device__ __forceinline__ bf16x2_t asbf(unsigned u) { return __builtin_bit_cast(bf16x2_t, u); }
__device__ __forceinline__ float dot8(v4u a, v4u b, float c) {
    c = __builtin_amdgcn_fdot2_f32_bf16(asbf(a.x), asbf(b.x), c, false); c = __builtin_amdgcn_fdot2_f32_bf16(asbf(a.y), asbf(b.y), c, false);
    c = __builtin_amdgcn_fdot2_f32_bf16(asbf(a.z), asbf(b.z), c, false); c = __builtin_amdgcn_fdot2_f32_bf16(asbf(a.w), asbf(b.w), c, false); return c;
}
__device__ __forceinline__ void fmac_s(float& acc, float ws, float x) { asm("v_fmac_f32_e32 %0, %1, %2" : "+v"(acc) : "s"(ws), "v"(x)); }
__device__ __forceinline__ void axpy8(float (&acc)[8], v4u v, float w  ) {
    fmac_s(acc[0], w, __uint_as_float(v.x << 16)); fmac_s(acc[1], w, __uint_as_float(v.x & 0xffff0000u)); fmac_s(acc[2], w, __uint_as_float(v.y << 16)); fmac_s(acc[3], w, __uint_as_float(v.y & 0xffff0000u));
    fmac_s(acc[4], w, __uint_as_float(v.z << 16)); fmac_s(acc[5], w, __uint_as_float(v.z & 0xffff0000u)); fmac_s(acc[6], w, __uint_as_float(v.w << 16)); fmac_s(acc[7], w, __uint_as_float(v.w & 0xffff0000u));
}
constexpr float U8_SCALE = 256.f, V8_SCALE = 16.f;
typedef float f32x2c __attribute__((ext_vector_type(2)));
struct Row2 { v4u c[2]; };
__device__ __forceinline__ Row2 load_row8(const GAS unsigned char* base, unsigned e, unsigned lane16) { const GAS unsigned char* p = base + (size_t)e * 2048 + lane16; Row2 r; r.c[0] = *(const GAS v4u*)p; r.c[1] = *(const GAS v4u*)(p + 1024); return r; }
__device__ __forceinline__ float fma_s(float a, float b, float c) { float r; asm("v_fma_f32 %0, %1, %2, %3" : "=v"(r) : "v"(a), "v"(b), "v"(c)); return r; }
__device__ __forceinline__ float dot4_8(const float* a, unsigned w, float s) { const f32x2c lo = __builtin_amdgcn_cvt_pk_f32_fp8((int)w, false), hi = __builtin_amdgcn_cvt_pk_f32_fp8((int)w, true);
    s = fma_s(a[0], lo.x, s); s = fma_s(a[1], lo.y, s); s = fma_s(a[2], hi.x, s); s = fma_s(a[3], hi.y, s); return s; }
__device__ __forceinline__ void axpy4_8(float* acc, unsigned w, float ws) { const f32x2c lo = __builtin_amdgcn_cvt_pk_f32_fp8((int)w, false), hi = __builtin_amdgcn_cvt_pk_f32_fp8((int)w, true);
    fmac_s(acc[0], ws, lo.x); fmac_s(acc[1], ws, lo.y); fmac_s(acc[2], ws, hi.x); fmac_s(acc[3], ws, hi.y); }
template <bool DRY> __device__ __forceinline__ void gather_phase(const Args& A, Frame& F) {
    unsigned char* ws = A.ws;
    const GAS unsigned char* UB = (const GAS unsigned char*)(ws + WS_UB); const GAS unsigned char* VB = (const GAS unsigned char*)(ws + WS_VB);
    float* H1 = (float*)(ws + WS_H1); bf16* H1B = (bf16*)(ws + WS_H1B); const float* psh1 = (const float*)(ws + WS_PSH1); const int* IDX = (const int*)(ws + WS_IDX); const float* GATE = (const float*)(ws + WS_GATE); float* rsh2 = (float*)(ws + WS_RSH2);
    const int gw = F.vcu * NWAVES + F.wave, NGW = F.G * NWAVES;
    for (int tk = gw; tk < T_TOK; tk += NGW) {
        const int lane = lane_id(); const unsigned lane16 = (unsigned)lane * 16u; const int kq = (lane >> 2) & 15;
        const float rs = (1.0f / sqrtf(wave_sum64(psh1[(size_t)tk * 64 + lane]) * (1.f / 2048.f) + 1e-6f)) * (1.f / U8_SCALE);
        float af[32], acc[32];
#pragma unroll
        for (int j = 0; j < 2; ++j) { const v4u a0 = *(const GAS v4u*)(H1B + (size_t)tk * 2048 + 1024 * j + 16 * lane), a1 = *(const GAS v4u*)(H1B + (size_t)tk * 2048 + 1024 * j + 16 * lane + 8);
            const unsigned aw[8] = {a0.x, a0.y, a0.z, a0.w, a1.x, a1.y, a1.z, a1.w};
#pragma unroll
            for (int q = 0; q < 8; ++q) { af[16 * j + 2 * q] = __uint_as_float(aw[q] << 16); af[16 * j + 2 * q + 1] = __uint_as_float(aw[q] & 0xffff0000u); }
#pragma unroll
            for (int q = 0; q < 4; ++q) { const f32x4 x = *(const GAS f32x4*)(H1 + (size_t)tk * 2048 + 1024 * j + 16 * lane + 4 * q); acc[16 * j + 4 * q] = x[0]; acc[16 * j + 4 * q + 1] = x[1]; acc[16 * j + 4 * q + 2] = x[2]; acc[16 * j + 4 * q + 3] = x[3]; } }
        for (int hd = 0; hd < 8; ++hd) {
            const int ev = IDX[(size_t)tk * 128 + hd * 16 + kq]; const float gv = GATE[(size_t)tk * 128 + hd * 16 + kq];
            float p[16];
            Row2 bA[4], bB[4];
#define LD4(buf, base, k0) do { _Pragma("unroll") for (int q = 0; q < 4; ++q) buf[q] = load_row8(base, (unsigned)__builtin_amdgcn_readlane(ev, 4 * ((k0) + q)), lane16); } while (0)
#define DOT4(buf, k0) do { _Pragma("unroll") for (int q = 0; q < 4; ++q) { float s = 0.f; _Pragma("unroll") for (int j = 0; j < 2; ++j) { s = dot4_8(af + 16 * j, buf[q].c[j].x, s); s = dot4_8(af + 16 * j + 4, buf[q].c[j].y, s); s = dot4_8(af + 16 * j + 8, buf[q].c[j].z, s); s = dot4_8(af + 16 * j + 12, buf[q].c[j].w, s); } p[(k0) + q] = s; } } while (0)
#define AX4(buf, k0) do { _Pragma("unroll") for (int q = 0; q < 4; ++q) { const float wk = __uint_as_float((unsigned)__builtin_amdgcn_readlane((int)__float_as_uint(w), 4 * ((k0) + q))); _Pragma("unroll") for (int j = 0; j < 2; ++j) { axpy4_8(acc + 16 * j, buf[q].c[j].x, wk); axpy4_8(acc + 16 * j + 4, buf[q].c[j].y, wk); axpy4_8(acc + 16 * j + 8, buf[q].c[j].z, wk); axpy4_8(acc + 16 * j + 12, buf[q].c[j].w, wk); } } } while (0)
            LD4(bA, UB, 0); LD4(bB, UB, 4); SBAR(); DOT4(bA, 0); SBAR(); LD4(bA, UB, 8); SBAR(); DOT4(bB, 4); SBAR(); LD4(bB, UB, 12); SBAR(); DOT4(bA, 8); SBAR(); LD4(bA, VB, 0); SBAR(); DOT4(bB, 12); SBAR(); LD4(bB, VB, 4); SBAR();
            { const bool b5 = lane & 32, b4 = lane & 16, b3 = lane & 8, b2 = lane & 4; float q8[8], q4[4], q2[2], q1;
#pragma unroll
              for (int i = 0; i < 8; ++i) { const float keep = b5 ? p[i + 8] : p[i], send = b5 ? p[i] : p[i + 8]; q8[i] = keep + __shfl_xor(send, 32); }
#pragma unroll
              for (int i = 0; i < 4; ++i) { const float keep = b4 ? q8[i + 4] : q8[i], send = b4 ? q8[i] : q8[i + 4]; q4[i] = keep + __shfl_xor(send, 16); }
#pragma unroll
              for (int i = 0; i < 2; ++i) { const float keep = b3 ? q4[i + 2] : q4[i], send = b3 ? q4[i] : q4[i + 2]; q2[i] = keep + __shfl_xor(send, 8); }
              { const float keep = b2 ? q2[1] : q2[0], send = b2 ? q2[0] : q2[1]; q1 = keep + __shfl_xor(send, 4); }
              q1 += __shfl_xor(q1, 2); q1 += __shfl_xor(q1, 1); p[0] = q1; }
            const float w = gv * gelu_f(p[0] * rs) * (1.f / V8_SCALE);
            SBAR(); AX4(bA, 0); SBAR(); LD4(bA, VB, 8); SBAR(); AX4(bB, 4); SBAR(); LD4(bB, VB, 12); SBAR(); AX4(bA, 8); SBAR(); AX4(bB, 12); SBAR();
#undef LD4
#undef DOT4
#undef AX4
        }
        float ss = 0.f;
        float* H1o = DRY ? (float*)(ws + WS_NA0) + (size_t)(tk & 2047) * 2048 : H1 + (size_t)tk * 2048; bf16* H1Bo = DRY ? (bf16*)(ws + WS_NGL) + (size_t)(tk & 2047) * 2048 : H1B + (size_t)tk * 2048;
#pragma unroll
        for (int j = 0; j < 2; ++j) {
#pragma unroll
            for (int q = 0; q < 2; ++q) { const f32x4 y0 = {acc[16 * j + 8 * q], acc[16 * j + 8 * q + 1], acc[16 * j + 8 * q + 2], acc[16 * j + 8 * q + 3]}, y1 = {acc[16 * j + 8 * q + 4], acc[16 * j + 8 * q + 5], acc[16 * j + 8 * q + 6], acc[16 * j + 8 * q + 7]}; ss += sq8(y0, y1);
                *(GAS f32x4*)(H1o + 1024 * j + 16 * lane + 8 * q) = y0; *(GAS f32x4*)(H1o + 1024 * j + 16 * lane + 8 * q + 4) = y1; *(GAS v4u*)(H1Bo + 1024 * j + 16 * lane + 8 * q) = pack8(y0, y1); } }
        ss = wave_sum64(ss); if (lane == 0 && !DRY) rsh2[tk] = 1.0f / sqrtf(ss * (1.f / 2048.f) + 1e-6f);
    }
}
#ifndef NSLICE_SHIFT
#define NSLICE_SHIFT 9
#endif
__device__ __forceinline__ void tok_load(const unsigned char* ws, int tk, int lane, float (&af)[32], float (&acc)[32], float& rs, int (&ev)[2], float (&gv)[2]) {
    const float* H1 = (const float*)(ws + WS_H1); const bf16* H1B = (const bf16*)(ws + WS_H1B); const float* psh1 = (const float*)(ws + WS_PSH1); const int* IDX = (const int*)(ws + WS_IDX); const float* GATE = (const float*)(ws + WS_GATE);
    rs = (1.0f / sqrtf(wave_sum64(psh1[(size_t)tk * 64 + lane]) * (1.f / 2048.f) + 1e-6f)) * (1.f / U8_SCALE);
#pragma unroll
    for (int j = 0; j < 2; ++j) { const v4u a0 = *(const GAS v4u*)(H1B + (size_t)tk * 2048 + 1024 * j + 16 * lane), a1 = *(const GAS v4u*)(H1B + (size_t)tk * 2048 + 1024 * j + 16 * lane + 8);
        const unsigned aw[8] = {a0.x, a0.y, a0.z, a0.w, a1.x, a1.y, a1.z, a1.w};
#pragma unroll
        for (int q = 0; q < 8; ++q) { af[16 * j + 2 * q] = __uint_as_float(aw[q] << 16); af[16 * j + 2 * q + 1] = __uint_as_float(aw[q] & 0xffff0000u); }
#pragma unroll
        for (int q = 0; q < 4; ++q) { const f32x4 x = *(const GAS f32x4*)(H1 + (size_t)tk * 2048 + 1024 * j + 16 * lane + 4 * q); acc[16 * j + 4 * q] = x[0]; acc[16 * j + 4 * q + 1] = x[1]; acc[16 * j + 4 * q + 2] = x[2]; acc[16 * j + 4 * q + 3] = x[3]; } }
    ev[0] = IDX[(size_t)tk * 128 + lane]; ev[1] = IDX[(size_t)tk * 128 + 64 + lane]; gv[0] = GATE[(size_t)tk * 128 + lane]; gv[1] = GATE[(size_t)tk * 128 + 64 + lane];
}
template <bool DRY> __device__ __forceinline__ void tok_store(unsigned char* ws, int tk, int lane, const float (&acc)[32]) {
    float* H1 = (float*)(ws + WS_H1); bf16* H1B = (bf16*)(ws + WS_H1B); float* rsh2 = (float*)(ws + WS_RSH2);
    float ss = 0.f;
    float* H1o = DRY ? (float*)(ws + WS_NA0) + (size_t)(tk & 2047) * 2048 : H1 + (size_t)tk * 2048; bf16* H1Bo = DRY ? (bf16*)(ws + WS_NGL) + (size_t)(tk & 2047) * 2048 : H1B + (size_t)tk * 2048;
#pragma unroll
    for (int j = 0; j < 2; ++j) {
#pragma unroll
        for (int q = 0; q < 2; ++q) { const f32x4 y0 = {acc[16 * j + 8 * q], acc[16 * j + 8 * q + 1], acc[16 * j + 8 * q + 2], acc[16 * j + 8 * q + 3]}, y1 = {acc[16 * j + 8 * q + 4], acc[16 * j + 8 * q + 5], acc[16 * j + 8 * q + 6], acc[16 * j + 8 * q + 7]}; ss += sq8(y0, y1);
            *(GAS f32x4*)(H1o + 1024 * j + 16 * lane + 8 * q) = y0; *(GAS f32x4*)(H1o + 1024 * j + 16 * lane + 8 * q + 4) = y1; *(GAS v4u*)(H1Bo + 1024 * j + 16 * lane + 8 * q) = pack8(y0, y1); } }
    ss = wave_sum64(ss); if (lane == 0 && !DRY) rsh2[tk] = 1.0f / sqrtf(ss * (1.f / 2048.f) + 1e-6f);
}
__device__ __forceinline__ float dot_row8(const float (&af)[32], const Row2& r) { float s = 0.f;
#pragma unroll
    for (int j = 0; j < 2; ++j) { s = dot4_8(af + 16 * j, r.c[j].x, s); s = dot4_8(af + 16 * j + 4, r.c[j].y, s); s = dot4_8(af + 16 * j + 8, r.c[j].z, s); s = dot4_8(af + 16 * j + 12, r.c[j].w, s); }
    return s; }
__device__ __forceinline__ void axpy_row8(float (&acc)[32], const Row2& r, float wk) {
#pragma unroll
    for (int j = 0; j < 2; ++j) { axpy4_8(acc + 16 * j, r.c[j].x, wk); axpy4_8(acc + 16 * j + 4, r.c[j].y, wk); axpy4_8(acc + 16 * j + 8, r.c[j].z, wk); axpy4_8(acc + 16 * j + 12, r.c[j].w, wk); } }
__device__ __forceinline__ void tok_slice(const GAS unsigned char* UB, const GAS unsigned char* VB, int s, int lane, unsigned lane16, const float (&af)[32], float (&acc)[32], float rs, const int (&ev)[2], const float (&gv)[2]) {
    unsigned long long m0 = __ballot((ev[0] >> NSLICE_SHIFT) == s), m1 = __ballot((ev[1] >> NSLICE_SHIFT) == s);
    while (m0 | m1) {
        int e0, e1; float g0, g1;
        if (m0) { const int i = __builtin_ctzll(m0); m0 &= m0 - 1; e0 = __builtin_amdgcn_readlane(ev[0], i); g0 = __uint_as_float((unsigned)__builtin_amdgcn_readlane((int)__float_as_uint(gv[0]), i)); }
        else { const int i = __builtin_ctzll(m1); m1 &= m1 - 1; e0 = __builtin_amdgcn_readlane(ev[1], i); g0 = __uint_as_float((unsigned)__builtin_amdgcn_readlane((int)__float_as_uint(gv[1]), i)); }
        if (m0) { const int i = __builtin_ctzll(m0); m0 &= m0 - 1; e1 = __builtin_amdgcn_readlane(ev[0], i); g1 = __uint_as_float((unsigned)__builtin_amdgcn_readlane((int)__float_as_uint(gv[0]), i)); }
        else if (m1) { const int i = __builtin_ctzll(m1); m1 &= m1 - 1; e1 = __builtin_amdgcn_readlane(ev[1], i); g1 = __uint_as_float((unsigned)__builtin_amdgcn_readlane((int)__float_as_uint(gv[1]), i)); }
        else { e1 = e0; g1 = 0.f; }
        const Row2 u0 = load_row8(UB, (unsigned)e0, lane16), u1 = load_row8(UB, (unsigned)e1, lane16), v0 = load_row8(VB, (unsigned)e0, lane16), v1 = load_row8(VB, (unsigned)e1, lane16);
        const float p0 = dot_row8(af, u0), p1 = dot_row8(af, u1);
        const bool b5 = lane & 32; float h = (b5 ? p1 : p0) + __shfl_xor(b5 ? p0 : p1, 32);
        h += __shfl_xor(h, 16); h += __shfl_xor(h, 8); h += __shfl_xor(h, 4); h += __shfl_xor(h, 2); h += __shfl_xor(h, 1);
        const float w = (b5 ? g1 : g0) * gelu_f(h * rs) * (1.f / V8_SCALE);
        const float w0 = __uint_as_float((unsigned)__builtin_amdgcn_readlane((int)__float_as_uint(w), 0)), w1 = __uint_as_float((unsigned)__builtin_amdgcn_readlane((int)__float_as_uint(w), 32));
        axpy_row8(acc, v0, w0); axpy_row8(acc, v1, w1);
    }
}
template <bool DRY> __device__ __forceinline__ void gather_sliced_phase(const Args& A, Frame& F) {
    unsigned char* ws = A.ws;
    const GAS unsigned char* UB = (const GAS unsigned char*)(ws + WS_UB); const GAS unsigned char* VB = (const GAS unsigned char*)(ws + WS_VB);
    const int gw = F.vcu * NWAVES + F.wave, NGW = F.G * NWAVES;
    for (int tk0 = 2 * gw; tk0 < T_TOK; tk0 += 2 * NGW) {
        const int lane = lane_id(); const unsigned lane16 = (unsigned)lane * 16u;
        float afA[32], accA[32], afB[32], accB[32], rsA, rsB; int evA[2], evB[2]; float gvA[2], gvB[2];
        tok_load(ws, tk0, lane, afA, accA, rsA, evA, gvA); tok_load(ws, tk0 + 1, lane, afB, accB, rsB, evB, gvB);
        for (int s = 0; s < (16384 >> NSLICE_SHIFT); ++s) { tok_slice(UB, VB, s, lane, lane16, afA, accA, rsA, evA, gvA); tok_slice(UB, VB, s, lane, lane16, afB, accB, rsB, evB, gvB); }
        tok_store<DRY>(ws, tk0, lane, accA); tok_store<DRY>(ws, tk0 + 1, lane, accB);
    }
}
#ifndef PROBE_NOV
#define PROBE_NOV 0
#endif
struct Tok2 { f32x2c af[16], acc[16]; float rs; int ev[2]; float gv[2]; };
__device__ __forceinline__ void tok2_load(const unsigned char* ws, int tk, int lane, Tok2& T) {
    const float* H1 = (const float*)(ws + WS_H1); const bf16* H1B = (const bf16*)(ws + WS_H1B); const float* psh1 = (const float*)(ws + WS_PSH1); const int* IDX = (const int*)(ws + WS_IDX); const float* GATE = (const float*)(ws + WS_GATE);
    T.rs = (1.0f / sqrtf(wave_sum64(psh1[(size_t)tk * 64 + lane]) * (1.f / 2048.f) + 1e-6f)) * (1.f / U8_SCALE);
#pragma unroll
    for (int j = 0; j < 2; ++j) { const v4u a0 = *(const GAS v4u*)(H1B + (size_t)tk * 2048 + 1024 * j + 16 * lane), a1 = *(const GAS v4u*)(H1B + (size_t)tk * 2048 + 1024 * j + 16 * lane + 8);
        const unsigned aw[8] = {a0.x, a0.y, a0.z, a0.w, a1.x, a1.y, a1.z, a1.w};
#pragma unroll
        for (int q = 0; q < 8; ++q) T.af[8 * j + q] = (f32x2c){__uint_as_float(aw[q] << 16), __uint_as_float(aw[q] & 0xffff0000u)};
#pragma unroll
        for (int q = 0; q < 4; ++q) { const f32x4 x = *(const GAS f32x4*)(H1 + (size_t)tk * 2048 + 1024 * j + 16 * lane + 4 * q); T.acc[8 * j + 2 * q] = (f32x2c){x[0], x[1]}; T.acc[8 * j + 2 * q + 1] = (f32x2c){x[2], x[3]}; } }
    T.ev[0] = IDX[(size_t)tk * 128 + lane]; T.ev[1] = IDX[(size_t)tk * 128 + 64 + lane]; T.gv[0] = GATE[(size_t)tk * 128 + lane]; T.gv[1] = GATE[(size_t)tk * 128 + 64 + lane];
}
template <bool DRY> __device__ __forceinline__ void tok2_store(unsigned char* ws, int tk, int lane_, const Tok2& T) {
    const int lane = lane_id(); (void)lane_;
    float* H1 = (float*)(ws + WS_H1); bf16* H1B = (bf16*)(ws + WS_H1B); float* rsh2 = (float*)(ws + WS_RSH2);
    float ss = 0.f;
    float* H1o = DRY ? (float*)(ws + WS_NA0) + (size_t)(tk & 2047) * 2048 : H1 + (size_t)tk * 2048; bf16* H1Bo = DRY ? (bf16*)(ws + WS_NGL) + (size_t)(tk & 2047) * 2048 : H1B + (size_t)tk * 2048;
#pragma unroll
    for (int j = 0; j < 2; ++j) {
#pragma unroll
        for (int q = 0; q < 2; ++q) { const f32x4 y0 = {T.acc[8 * j + 4 * q].x, T.acc[8 * j + 4 * q].y, T.acc[8 * j + 4 * q + 1].x, T.acc[8 * j + 4 * q + 1].y}, y1 = {T.acc[8 * j + 4 * q + 2].x, T.acc[8 * j + 4 * q + 2].y, T.acc[8 * j + 4 * q + 3].x, T.acc[8 * j + 4 * q + 3].y}; ss += sq8(y0, y1);
            *(GAS f32x4*)(H1o + 1024 * j + 16 * lane + 8 * q) = y0; *(GAS f32x4*)(H1o + 1024 * j + 16 * lane + 8 * q + 4) = y1; *(GAS v4u*)(H1Bo + 1024 * j + 16 * lane + 8 * q) = pack8(y0, y1); } }
    ss = wave_sum64(ss); if (lane == 0 && !DRY) rsh2[tk] = 1.0f / sqrtf(ss * (1.f / 2048.f) + 1e-6f);
}
__device__ __forceinline__ float dot_row8p(const Tok2& T, const Row2& r) { f32x2c s0 = {0.f, 0.f}, s1 = {0.f, 0.f}, s2 = {0.f, 0.f}, s3 = {0.f, 0.f};
#pragma unroll
    for (int j = 0; j < 2; ++j) { const unsigned w[4] = {r.c[j].x, r.c[j].y, r.c[j].z, r.c[j].w};
#pragma unroll
        for (int d = 0; d < 4; ++d) { const f32x2c lo = __builtin_amdgcn_cvt_pk_f32_fp8((int)w[d], false), hi = __builtin_amdgcn_cvt_pk_f32_fp8((int)w[d], true);
            if (j == 0) { s0 = __builtin_elementwise_fma(T.af[2 * d], lo, s0); s1 = __builtin_elementwise_fma(T.af[2 * d + 1], hi, s1); }
            else { s2 = __builtin_elementwise_fma(T.af[8 + 2 * d], lo, s2); s3 = __builtin_elementwise_fma(T.af[8 + 2 * d + 1], hi, s3); } } }
    const f32x2c t = (s0 + s1) + (s2 + s3); return t.x + t.y; }
__device__ __forceinline__ void axpy_row8p(Tok2& T, const Row2& r, float wk) { const f32x2c w2 = {wk, wk};
#pragma unroll
    for (int j = 0; j < 2; ++j) { const unsigned w[4] = {r.c[j].x, r.c[j].y, r.c[j].z, r.c[j].w};
#pragma unroll
        for (int d = 0; d < 4; ++d) { const f32x2c lo = __builtin_amdgcn_cvt_pk_f32_fp8((int)w[d], false), hi = __builtin_amdgcn_cvt_pk_f32_fp8((int)w[d], true);
            T.acc[8 * j + 2 * d] = __builtin_elementwise_fma(w2, lo, T.acc[8 * j + 2 * d]); T.acc[8 * j + 2 * d + 1] = __builtin_elementwise_fma(w2, hi, T.acc[8 * j + 2 * d + 1]); } } }
__device__ __forceinline__ float dpp_add(float v, const int ctrl, const int rmask) { return v; }
#define DPP_ADD(v, ctrl, rmask) v += __uint_as_float((unsigned)__builtin_amdgcn_update_dpp(0, (int)__float_as_uint(v), ctrl, rmask, 0xF, true))
__device__ __forceinline__ float reduce2(float p0, float p1) {
    auto rr = __builtin_amdgcn_permlane32_swap(__float_as_uint(p0), __float_as_uint(p1), false, false);
    float h = __uint_as_float(rr[0]) + __uint_as_float(rr[1]);
    DPP_ADD(h, 0xB1, 0xF); DPP_ADD(h, 0x4E, 0xF); DPP_ADD(h, 0x141, 0xF); DPP_ADD(h, 0x140, 0xF); DPP_ADD(h, 0x142, 0xA);
    return h; }
__device__ __forceinline__ int take2(unsigned long long& m0, unsigned long long& m1, const Tok2& T, int& e0, float& g0, int& e1, float& g1) {
    if (!(m0 | m1)) return 0;
    if (m0) { const int i = __builtin_ctzll(m0); m0 &= m0 - 1; e0 = __builtin_amdgcn_readlane(T.ev[0], i); g0 = __uint_as_float((unsigned)__builtin_amdgcn_readlane((int)__float_as_uint(T.gv[0]), i)); }
    else { const int i = __builtin_ctzll(m1); m1 &= m1 - 1; e0 = __builtin_amdgcn_readlane(T.ev[1], i); g0 = __uint_as_float((unsigned)__builtin_amdgcn_readlane((int)__float_as_uint(T.gv[1]), i)); }
    if (m0) { const int i = __builtin_ctzll(m0); m0 &= m0 - 1; e1 = __builtin_amdgcn_readlane(T.ev[0], i); g1 = __uint_as_float((unsigned)__builtin_amdgcn_readlane((int)__float_as_uint(T.gv[0]), i)); return 2; }
    if (m1) { const int i = __builtin_ctzll(m1); m1 &= m1 - 1; e1 = __builtin_amdgcn_readlane(T.ev[1], i); g1 = __uint_as_float((unsigned)__builtin_amdgcn_readlane((int)__float_as_uint(T.gv[1]), i)); return 2; }
    e1 = e0; g1 = 0.f; return 1;
}
__device__ __forceinline__ void batch2(Tok2& T, const Row2& u0, const Row2& u1, const Row2& v0, const Row2& v1, float g0, float g1, int lane) {
    const float h = reduce2(dot_row8p(T, u0), dot_row8p(T, u1));
    const float w = ((lane & 32) ? g1 : g0) * gelu_f(h * T.rs) * (1.f / V8_SCALE);
    const float w0 = __uint_as_float((unsigned)__builtin_amdgcn_readlane((int)__float_as_uint(w), 31)), w1 = __uint_as_float((unsigned)__builtin_amdgcn_readlane((int)__float_as_uint(w), 63));
    axpy_row8p(T, v0, w0); axpy_row8p(T, v1, w1);
}
#ifndef GATHER_PREFETCH
#define GATHER_PREFETCH 0
#endif
constexpr int SLICE_EXPERTS = 1 << NSLICE_SHIFT, SLICE_SHARE = 2048;
static_assert(NSLICE_SHIFT != 8 || SLICE_EXPERTS * 2048 / 256 == SLICE_SHARE, "prefetch share");
__device__ __forceinline__ unsigned slice_prefetch(const GAS unsigned char* UB, const GAS unsigned char* VB, int snext, unsigned wx) {
    const GAS unsigned char* pu = UB + (size_t)snext * (SLICE_EXPERTS * 2048) + (size_t)wx * SLICE_SHARE; const GAS unsigned char* pv = VB + (size_t)snext * (SLICE_EXPERTS * 2048) + (size_t)wx * SLICE_SHARE;
    unsigned d;
    asm volatile("s_load_dword %0, %1, 0x0\n\ts_load_dword %0, %1, 0x80\n\ts_load_dword %0, %1, 0x100\n\ts_load_dword %0, %1, 0x180\n\ts_load_dword %0, %1, 0x200\n\ts_load_dword %0, %1, 0x280\n\ts_load_dword %0, %1, 0x300\n\ts_load_dword %0, %1, 0x380\n\ts_load_dword %0, %1, 0x400\n\ts_load_dword %0, %1, 0x480\n\ts_load_dword %0, %1, 0x500\n\ts_load_dword %0, %1, 0x580\n\ts_load_dword %0, %1, 0x600\n\ts_load_dword %0, %1, 0x680\n\ts_load_dword %0, %1, 0x700\n\ts_load_dword %0, %1, 0x780\n\ts_load_dword %0, %2, 0x0\n\ts_load_dword %0, %2, 0x80\n\ts_load_dword %0, %2, 0x100\n\ts_load_dword %0, %2, 0x180\n\ts_load_dword %0, %2, 0x200\n\ts_load_dword %0, %2, 0x280\n\ts_load_dword %0, %2, 0x300\n\ts_load_dword %0, %2, 0x380\n\ts_load_dword %0, %2, 0x400\n\ts_load_dword %0, %2, 0x480\n\ts_load_dword %0, %2, 0x500\n\ts_load_dword %0, %2, 0x580\n\ts_load_dword %0, %2, 0x600\n\ts_load_dword %0, %2, 0x680\n\ts_load_dword %0, %2, 0x700\n\ts_load_dword %0, %2, 0x780\n\ts_nop 0" : "=&s"(d) : "s"(pu), "s"(pv));
    return d;
}
__device__ __forceinline__ void slice_prefetch_done(unsigned& d) { asm volatile("s_waitcnt lgkmcnt(0)" : "+s"(d)); }
template <bool DRY> __device__ __forceinline__ void gather_sliced2_phase(const Args& A, Frame& F) {
    unsigned char* ws = A.ws;
    const GAS unsigned char* UB = (const GAS unsigned char*)(ws + WS_UB); const GAS unsigned char* VB = (const GAS unsigned char*)(ws + WS_VB);
    const int gw = F.vcu * NWAVES + F.wave, NGW = F.G * NWAVES;
    for (int tk0 = 2 * gw; tk0 < T_TOK; tk0 += 2 * NGW) {
        const int lane = lane_id(); const unsigned lane16 = (unsigned)lane * 16u;
        Tok2 TA, TB; tok2_load(ws, tk0, lane, TA); tok2_load(ws, tk0 + 1, lane, TB);
        const unsigned wx = (unsigned)((F.vcu & 31) * NWAVES + F.wave);
        for (int s = 0; s < (16384 >> NSLICE_SHIFT); ++s) {
            unsigned pf_d = 0u; if (GATHER_PREFETCH && NSLICE_SHIFT == 8) pf_d = slice_prefetch(UB, VB, (s + 1) & ((16384 >> NSLICE_SHIFT) - 1), wx);
            unsigned long long a0 = __ballot((TA.ev[0] >> NSLICE_SHIFT) == s), a1 = __ballot((TA.ev[1] >> NSLICE_SHIFT) == s), b0 = __ballot((TB.ev[0] >> NSLICE_SHIFT) == s), b1 = __ballot((TB.ev[1] >> NSLICE_SHIFT) == s);
            while (a0 | a1 | b0 | b1) {
                int eA0 = 0, eA1 = 0, eB0 = 0, eB1 = 0; float gA0 = 0.f, gA1 = 0.f, gB0 = 0.f, gB1 = 0.f;
                const int nA = take2(a0, a1, TA, eA0, gA0, eA1, gA1), nB = take2(b0, b1, TB, eB0, gB0, eB1, gB1);
                if (DRY && PROBE_NOV == 4) { eA0 &= 255; eA1 &= 255; eB0 &= 255; eB1 &= 255; } if (DRY && PROBE_NOV == 5) { eA0 &= 3; eA1 &= 3; eB0 &= 3; eB1 &= 3; }
                Row2 uA0, uA1, vA0, vA1, uB0, uB1, vB0, vB1;
                if (DRY && PROBE_NOV == 2) { uA0.c[0] = uA0.c[1] = (v4u){(unsigned)eA0, (unsigned)lane, 0x38383838u, 0x3c3c3c3cu}; uA1 = uA0; vA0 = uA0; vA1 = uA0; uB0 = uA0; uB1 = uA0; vB0 = uA0; vB1 = uA0; } else
                if (nA) { uA0 = load_row8(UB, (unsigned)eA0, lane16); uA1 = load_row8(UB, (unsigned)eA1, lane16); if (DRY && PROBE_NOV) { vA0 = uA0; vA1 = uA1; } else { vA0 = load_row8(VB, (unsigned)eA0, lane16); vA1 = load_row8(VB, (unsigned)eA1, lane16); } }
                if (!(DRY && PROBE_NOV == 2)) if (nB) { uB0 = load_row8(UB, (unsigned)eB0, lane16); uB1 = load_row8(UB, (unsigned)eB1, lane16); if (DRY && PROBE_NOV) { vB0 = uB0; vB1 = uB1; } else { vB0 = load_row8(VB, (unsigned)eB0, lane16); vB1 = load_row8(VB, (unsigned)eB1, lane16); } }
                if (DRY && PROBE_NOV == 3) { unsigned x = 0;
                    if (nA) x ^= uA0.c[0].x ^ uA0.c[0].w ^ uA0.c[1].y ^ uA1.c[0].x ^ uA1.c[1].w ^ vA0.c[0].x ^ vA0.c[1].w ^ vA1.c[0].y ^ vA1.c[1].z ^ uA0.c[0].y ^ uA0.c[0].z ^ uA0.c[1].x ^ uA0.c[1].z ^ uA0.c[1].w ^ uA1.c[0].y ^ uA1.c[0].z ^ uA1.c[0].w ^ uA1.c[1].x ^ uA1.c[1].y ^ uA1.c[1].z ^ vA0.c[0].y ^ vA0.c[0].z ^ vA0.c[0].w ^ vA0.c[1].x ^ vA0.c[1].y ^ vA0.c[1].z ^ vA1.c[0].x ^ vA1.c[0].z ^ vA1.c[0].w ^ vA1.c[1].x ^ vA1.c[1].y ^ vA1.c[1].w;
                    if (nB) x ^= uB0.c[0].x ^ uB0.c[0].w ^ uB0.c[1].y ^ uB1.c[0].x ^ uB1.c[1].w ^ vB0.c[0].x ^ vB0.c[1].w ^ vB1.c[0].y ^ vB1.c[1].z ^ uB0.c[0].y ^ uB0.c[0].z ^ uB0.c[1].x ^ uB0.c[1].z ^ uB0.c[1].w ^ uB1.c[0].y ^ uB1.c[0].z ^ uB1.c[0].w ^ uB1.c[1].x ^ uB1.c[1].y ^ uB1.c[1].z ^ vB0.c[0].y ^ vB0.c[0].z ^ vB0.c[0].w ^ vB0.c[1].x ^ vB0.c[1].y ^ vB0.c[1].z ^ vB1.c[0].x ^ vB1.c[0].z ^ vB1.c[0].w ^ vB1.c[1].x ^ vB1.c[1].y ^ vB1.c[1].w;
                    TA.acc[0].x += __uint_as_float(x & 1u); } else {
                if (nA) batch2(TA, uA0, uA1, vA0, vA1, gA0, gA1, lane);
                if (nB) batch2(TB, uB0, uB1, vB0, vB1, gB0, gB1, lane); }
            }
            if (GATHER_PREFETCH && NSLICE_SHIFT == 8) slice_prefetch_done(pf_d);
        }
        tok2_store<DRY>(ws, tk0, lane, TA); tok2_store<DRY>(ws, tk0 + 1, lane, TB);
    }
}
struct Acc2 { f32x2c acc[16]; float rs; int ev[2]; float gv[2]; };
struct It8 { int nA, nB; float gA0, gA1, gB0, gB1; Row2 uA0, uA1, vA0, vA1, uB0, uB1, vB0, vB1; };
__device__ __forceinline__ void tok3_load(const unsigned char* ws, int tk, int lane, Acc2& T, LAS unsigned char* afl  ) {
    const float* H1 = (const float*)(ws + WS_H1); const bf16* H1B = (const bf16*)(ws + WS_H1B); const float* psh1 = (const float*)(ws + WS_PSH1); const int* IDX = (const int*)(ws + WS_IDX); const float* GATE = (const float*)(ws + WS_GATE);
    T.rs = (1.0f / sqrtf(wave_sum64(psh1[(size_t)tk * 64 + lane]) * (1.f / 2048.f) + 1e-6f)) * (1.f / U8_SCALE);
#pragma unroll
    for (int j = 0; j < 2; ++j) { const v4u a0 = *(const GAS v4u*)(H1B + (size_t)tk * 2048 + 1024 * j + 16 * lane), a1 = *(const GAS v4u*)(H1B + (size_t)tk * 2048 + 1024 * j + 16 * lane + 8);
        const unsigned aw[8] = {a0.x, a0.y, a0.z, a0.w, a1.x, a1.y, a1.z, a1.w};
#pragma unroll
        for (int d = 0; d < 4; ++d) *(LAS f32x4*)(afl + (4 * j + d) * 1024 + lane * 16) = (f32x4){__uint_as_float(aw[2 * d] << 16), __uint_as_float(aw[2 * d] & 0xffff0000u), __uint_as_float(aw[2 * d + 1] << 16), __uint_as_float(aw[2 * d + 1] & 0xffff0000u)};
#pragma unroll
        for (int q = 0; q < 4; ++q) { const f32x4 x = *(const GAS f32x4*)(H1 + (size_t)tk * 2048 + 1024 * j + 16 * lane + 4 * q); T.acc[8 * j + 2 * q] = (f32x2c){x[0], x[1]}; T.acc[8 * j + 2 * q + 1] = (f32x2c){x[2], x[3]}; } }
    T.ev[0] = IDX[(size_t)tk * 128 + lane]; T.ev[1] = IDX[(size_t)tk * 128 + 64 + lane]; T.gv[0] = GATE[(size_t)tk * 128 + lane]; T.gv[1] = GATE[(size_t)tk * 128 + 64 + lane];
}
template <bool DRY> __device__ __forceinline__ void tok3_store(unsigned char* ws, int tk, int lane, const Acc2& T) {
    float* H1 = (float*)(ws + WS_H1); bf16* H1B = (bf16*)(ws + WS_H1B); float* rsh2 = (float*)(ws + WS_RSH2);
    float ss = 0.f;
    float* H1o = DRY ? (float*)(ws + WS_NA0) + (size_t)(tk & 2047) * 2048 : H1 + (size_t)tk * 2048; bf16* H1Bo = DRY ? (bf16*)(ws + WS_NGL) + (size_t)(tk & 2047) * 2048 : H1B + (size_t)tk * 2048;
#pragma unroll
    for (int j = 0; j < 2; ++j) {
#pragma unroll
        for (int q = 0; q < 2; ++q) { const f32x4 y0 = {T.acc[8 * j + 4 * q].x, T.acc[8 * j + 4 * q].y, T.acc[8 * j + 4 * q + 1].x, T.acc[8 * j + 4 * q + 1].y}, y1 = {T.acc[8 * j + 4 * q + 2].x, T.acc[8 * j + 4 * q + 2].y, T.acc[8 * j + 4 * q + 3].x, T.acc[8 * j + 4 * q + 3].y}; ss += sq8(y0, y1);
            *(GAS f32x4*)(H1o + 1024 * j + 16 * lane + 8 * q) = y0; *(GAS f32x4*)(H1o + 1024 * j + 16 * lane + 8 * q + 4) = y1; *(GAS v4u*)(H1Bo + 1024 * j + 16 * lane + 8 * q) = pack8(y0, y1); } }
    ss = wave_sum64(ss); if (lane == 0 && !DRY) rsh2[tk] = 1.0f / sqrtf(ss * (1.f / 2048.f) + 1e-6f);
}
__device__ __forceinline__ void batch3(Acc2& T, const LAS unsigned char* afl, const Row2& u0, const Row2& u1, const Row2& v0, const Row2& v1, float g0, float g1, int lane) {
    f32x2c s0 = {0.f, 0.f}, s1 = {0.f, 0.f}, t0 = {0.f, 0.f}, t1 = {0.f, 0.f};
    f32x4 aa[8];
#pragma unroll
    for (int c = 0; c < 8; ++c) aa[c] = *(const LAS f32x4*)(afl + c * 1024 + lane * 16);
    asm volatile("s_waitcnt lgkmcnt(0)" : "+v"(aa[0]), "+v"(aa[1]), "+v"(aa[2]), "+v"(aa[3]), "+v"(aa[4]), "+v"(aa[5]), "+v"(aa[6]), "+v"(aa[7]));
#pragma unroll
    for (int j = 0; j < 2; ++j) { const unsigned w0[4] = {u0.c[j].x, u0.c[j].y, u0.c[j].z, u0.c[j].w}, w1[4] = {u1.c[j].x, u1.c[j].y, u1.c[j].z, u1.c[j].w};
#pragma unroll
        for (int d = 0; d < 4; ++d) { const f32x4 a = aa[4 * j + d]; const f32x2c alo = {a[0], a[1]}, ahi = {a[2], a[3]};
            s0 = __builtin_elementwise_fma(alo, __builtin_amdgcn_cvt_pk_f32_fp8((int)w0[d], false), s0); s1 = __builtin_elementwise_fma(ahi, __builtin_amdgcn_cvt_pk_f32_fp8((int)w0[d], true), s1);
            t0 = __builtin_elementwise_fma(alo, __builtin_amdgcn_cvt_pk_f32_fp8((int)w1[d], false), t0); t1 = __builtin_elementwise_fma(ahi, __builtin_amdgcn_cvt_pk_f32_fp8((int)w1[d], true), t1); } }
    const f32x2c ps = s0 + s1, pt = t0 + t1;
    const float h = reduce2(ps.x + ps.y, pt.x + pt.y);
    const float w = ((lane & 32) ? g1 : g0) * gelu_f(h * T.rs) * (1.f / V8_SCALE);
    const float wa = __uint_as_float((unsigned)__builtin_amdgcn_readlane((int)__float_as_uint(w), 31)), wb = __uint_as_float((unsigned)__builtin_amdgcn_readlane((int)__float_as_uint(w), 63));
    const f32x2c wa2 = {wa, wa}, wb2 = {wb, wb};
#pragma unroll
    for (int j = 0; j < 2; ++j) { const unsigned w0[4] = {v0.c[j].x, v0.c[j].y, v0.c[j].z, v0.c[j].w}, w1[4] = {v1.c[j].x, v1.c[j].y, v1.c[j].z, v1.c[j].w};
#pragma unroll
        for (int d = 0; d < 4; ++d) {
            T.acc[8 * j + 2 * d] = __builtin_elementwise_fma(wa2, __builtin_amdgcn_cvt_pk_f32_fp8((int)w0[d], false), T.acc[8 * j + 2 * d]); T.acc[8 * j + 2 * d + 1] = __builtin_elementwise_fma(wa2, __builtin_amdgcn_cvt_pk_f32_fp8((int)w0[d], true), T.acc[8 * j + 2 * d + 1]);
            T.acc[8 * j + 2 * d] = __builtin_elementwise_fma(wb2, __builtin_amdgcn_cvt_pk_f32_fp8((int)w1[d], false), T.acc[8 * j + 2 * d]); T.acc[8 * j + 2 * d + 1] = __builtin_elementwise_fma(wb2, __builtin_amdgcn_cvt_pk_f32_fp8((int)w1[d], true), T.acc[8 * j + 2 * d + 1]); } }
}
struct Sweep { int s; unsigned long long a0, a1, b0, b1; };
__device__ __forceinline__ int take2b(unsigned long long& m0, unsigned long long& m1, const int (&ev)[2], const float (&gv)[2], int& e0, float& g0, int& e1, float& g1) {
    if (!(m0 | m1)) return 0;
    if (m0) { const int i = __builtin_ctzll(m0); m0 &= m0 - 1; e0 = __builtin_amdgcn_readlane(ev[0], i); g0 = __uint_as_float((unsigned)__builtin_amdgcn_readlane((int)__float_as_uint(gv[0]), i)); }
    else { const int i = __builtin_ctzll(m1); m1 &= m1 - 1; e0 = __builtin_amdgcn_readlane(ev[1], i); g0 = __uint_as_float((unsigned)__builtin_amdgcn_readlane((int)__float_as_uint(gv[1]), i)); }
    if (m0) { const int i = __builtin_ctzll(m0); m0 &= m0 - 1; e1 = __builtin_amdgcn_readlane(ev[0], i); g1 = __uint_as_float((unsigned)__builtin_amdgcn_readlane((int)__float_as_uint(gv[0]), i)); return 2; }
    if (m1) { const int i = __builtin_ctzll(m1); m1 &= m1 - 1; e1 = __builtin_amdgcn_readlane(ev[1], i); g1 = __uint_as_float((unsigned)__builtin_amdgcn_readlane((int)__float_as_uint(gv[1]), i)); return 2; }
    e1 = e0; g1 = 0.f; return 1;
}
__device__ __forceinline__ void gen_load(Sweep& W, const Acc2& TA, const Acc2& TB, const GAS unsigned char* UB, const GAS unsigned char* VB, unsigned lane16, It8& I) {
    while (!(W.a0 | W.a1 | W.b0 | W.b1) && W.s + 1 < (16384 >> NSLICE_SHIFT)) { ++W.s;
        W.a0 = __ballot((TA.ev[0] >> NSLICE_SHIFT) == W.s); W.a1 = __ballot((TA.ev[1] >> NSLICE_SHIFT) == W.s); W.b0 = __ballot((TB.ev[0] >> NSLICE_SHIFT) == W.s); W.b1 = __ballot((TB.ev[1] >> NSLICE_SHIFT) == W.s); }
    int eA0 = 0, eA1 = 0, eB0 = 0, eB1 = 0; I.gA0 = 0.f; I.gA1 = 0.f; I.gB0 = 0.f; I.gB1 = 0.f;
    I.nA = take2b(W.a0, W.a1, TA.ev, TA.gv, eA0, I.gA0, eA1, I.gA1); I.nB = take2b(W.b0, W.b1, TB.ev, TB.gv, eB0, I.gB0, eB1, I.gB1);
    if (!I.nA) { eA0 = eB0; eA1 = eB1; } if (!I.nB) { eB0 = eA0; eB1 = eA1; }
    I.uA0 = load_row8(UB, (unsigned)eA0, lane16); I.uA1 = load_row8(UB, (unsigned)eA1, lane16); I.vA0 = load_row8(VB, (unsigned)eA0, lane16); I.vA1 = load_row8(VB, (unsigned)eA1, lane16);
    I.uB0 = load_row8(UB, (unsigned)eB0, lane16); I.uB1 = load_row8(UB, (unsigned)eB1, lane16); I.vB0 = load_row8(VB, (unsigned)eB0, lane16); I.vB1 = load_row8(VB, (unsigned)eB1, lane16);
}
template <bool DRY> __device__ __forceinline__ void gather_sliced3_phase(const Args& A, Frame& F) {
    unsigned char* ws = A.ws;
    const GAS unsigned char* UB = (const GAS unsigned char*)(ws + WS_UB); const GAS unsigned char* VB = (const GAS unsigned char*)(ws + WS_VB);
    const int gw = F.vcu * NWAVES + F.wave, NGW = F.G * NWAVES;
    LAS unsigned char* aflA = F.lds + RING_OFF + F.wave * 16384; LAS unsigned char* aflB = aflA + 8192;
    for (int tk0 = 2 * gw; tk0 < T_TOK; tk0 += 2 * NGW) {
        const int lane = lane_id(); const unsigned lane16 = (unsigned)lane * 16u;
        Acc2 TA, TB; tok3_load(ws, tk0, lane, TA, aflA); tok3_load(ws, tk0 + 1, lane, TB, aflB);
        Sweep W; W.s = -1; W.a0 = W.a1 = W.b0 = W.b1 = 0ull;
        It8 X, Y;
        gen_load(W, TA, TB, UB, VB, lane16, X);
        for (;;) {
            gen_load(W, TA, TB, UB, VB, lane16, Y);
            if (X.nA) batch3(TA, aflA, X.uA0, X.uA1, X.vA0, X.vA1, X.gA0, X.gA1, lane);
            if (X.nB) batch3(TB, aflB, X.uB0, X.uB1, X.vB0, X.vB1, X.gB0, X.gB1, lane);
            if (!(Y.nA | Y.nB)) break;
            gen_load(W, TA, TB, UB, VB, lane16, X);
            if (Y.nA) batch3(TA, aflA, Y.uA0, Y.uA1, Y.vA0, Y.vA1, Y.gA0, Y.gA1, lane);
            if (Y.nB) batch3(TB, aflB, Y.uB0, Y.uB1, Y.vB0, Y.vB1, Y.gB0, Y.gB1, lane);
            if (!(X.nA | X.nB)) break;
        }
        tok3_store<DRY>(ws, tk0, lane, TA); tok3_store<DRY>(ws, tk0 + 1, lane, TB);
    }
}
struct It4 { int tok; float g0, g1; Row2 u0, u1, v0, v1; };
__device__ __forceinline__ void gen4(Sweep& W, const Tok2& TA, const Tok2& TB, const GAS unsigned char* UB, const GAS unsigned char* VB, unsigned lane16, It4& I) {
    while (!(W.a0 | W.a1 | W.b0 | W.b1) && W.s + 1 < (16384 >> NSLICE_SHIFT)) { ++W.s;
        W.a0 = __ballot((TA.ev[0] >> NSLICE_SHIFT) == W.s); W.a1 = __ballot((TA.ev[1] >> NSLICE_SHIFT) == W.s); W.b0 = __ballot((TB.ev[0] >> NSLICE_SHIFT) == W.s); W.b1 = __ballot((TB.ev[1] >> NSLICE_SHIFT) == W.s); }
    int e0 = 0, e1 = 0; I.g0 = 0.f; I.g1 = 0.f; I.tok = -1;
    if (W.a0 | W.a1) { take2b(W.a0, W.a1, TA.ev, TA.gv, e0, I.g0, e1, I.g1); I.tok = 0; }
    else if (W.b0 | W.b1) { take2b(W.b0, W.b1, TB.ev, TB.gv, e0, I.g0, e1, I.g1); I.tok = 1; }
    I.u0 = load_row8(UB, (unsigned)e0, lane16); I.u1 = load_row8(UB, (unsigned)e1, lane16); I.v0 = load_row8(VB, (unsigned)e0, lane16); I.v1 = load_row8(VB, (unsigned)e1, lane16);
}
template <bool DRY> __device__ __forceinline__ void gather_sliced4_phase(const Args& A, Frame& F) {
    unsigned char* ws = A.ws;
    const GAS unsigned char* UB = (const GAS unsigned char*)(ws + WS_UB); const GAS unsigned char* VB = (const GAS unsigned char*)(ws + WS_VB);
    const int gw = F.vcu * NWAVES + F.wave, NGW = F.G * NWAVES;
    for (int tk0 = 2 * gw; tk0 < T_TOK; tk0 += 2 * NGW) {
        const int lane = lane_id(); const unsigned lane16 = (unsigned)lane * 16u;
        Tok2 TA, TB; tok2_load(ws, tk0, lane, TA); tok2_load(ws, tk0 + 1, lane, TB);
        Sweep W; W.s = -1; W.a0 = W.a1 = W.b0 = W.b1 = 0ull;
        It4 X, Y;
        gen4(W, TA, TB, UB, VB, lane16, X);
        for (;;) {
            gen4(W, TA, TB, UB, VB, lane16, Y);
            if (X.tok == 0) batch2(TA, X.u0, X.u1, X.v0, X.v1, X.g0, X.g1, lane); else if (X.tok == 1) batch2(TB, X.u0, X.u1, X.v0, X.v1, X.g0, X.g1, lane);
            if (Y.tok < 0) break;
            gen4(W, TA, TB, UB, VB, lane16, X);
            if (Y.tok == 0) batch2(TA, Y.u0, Y.u1, Y.v0, Y.v1, Y.g0, Y.g1, lane); else if (Y.tok == 1) batch2(TB, Y.u0, Y.u1, Y.v0, Y.v1, Y.g0, Y.g1, lane);
            if (X.tok < 0) break;
        }
        tok2_store<DRY>(ws, tk0, lane, TA); tok2_store<DRY>(ws, tk0 + 1, lane, TB);
    }
}
__device__ __forceinline__ void gen5(Sweep& W, const Acc2& TA, const Acc2& TB, const GAS unsigned char* UB, const GAS unsigned char* VB, unsigned lane16, It4& I) {
    while (!(W.a0 | W.a1 | W.b0 | W.b1) && W.s + 1 < (16384 >> NSLICE_SHIFT)) { ++W.s;
        W.a0 = __ballot((TA.ev[0] >> NSLICE_SHIFT) == W.s); W.a1 = __ballot((TA.ev[1] >> NSLICE_SHIFT) == W.s); W.b0 = __ballot((TB.ev[0] >> NSLICE_SHIFT) == W.s); W.b1 = __ballot((TB.ev[1] >> NSLICE_SHIFT) == W.s); }
    int e0 = 0, e1 = 0; I.g0 = 0.f; I.g1 = 0.f; I.tok = -1;
    if (W.a0 | W.a1) { take2b(W.a0, W.a1, TA.ev, TA.gv, e0, I.g0, e1, I.g1); I.tok = 0; }
    else if (W.b0 | W.b1) { take2b(W.b0, W.b1, TB.ev, TB.gv, e0, I.g0, e1, I.g1); I.tok = 1; }
    I.u0 = load_row8(UB, (unsigned)e0, lane16); I.u1 = load_row8(UB, (unsigned)e1, lane16); I.v0 = load_row8(VB, (unsigned)e0, lane16); I.v1 = load_row8(VB, (unsigned)e1, lane16);
}
template <bool DRY> __device__ __forceinline__ void gather_sliced5_phase(const Args& A, Frame& F) {
    unsigned char* ws = A.ws;
    const GAS unsigned char* UB = (const GAS unsigned char*)(ws + WS_UB); const GAS unsigned char* VB = (const GAS unsigned char*)(ws + WS_VB);
    const int gw = F.vcu * NWAVES + F.wave, NGW = F.G * NWAVES;
    LAS unsigned char* aflA = F.lds + RING_OFF + F.wave * 16384; LAS unsigned char* aflB = aflA + 8192;
    for (int tk0 = 2 * gw; tk0 < T_TOK; tk0 += 2 * NGW) {
        const int lane = lane_id(); const unsigned lane16 = (unsigned)lane * 16u;
        Acc2 TA, TB; tok3_load(ws, tk0, lane, TA, aflA); tok3_load(ws, tk0 + 1, lane, TB, aflB);
        Sweep W; W.s = -1; W.a0 = W.a1 = W.b0 = W.b1 = 0ull;
        It4 X, Y;
        gen5(W, TA, TB, UB, VB, lane16, X);
        for (;;) {
            gen5(W, TA, TB, UB, VB, lane16, Y);
            if (X.tok == 0) batch3(TA, aflA, X.u0, X.u1, X.v0, X.v1, X.g0, X.g1, lane); else if (X.tok == 1) batch3(TB, aflB, X.u0, X.u1, X.v0, X.v1, X.g0, X.g1, lane);
            if (Y.tok < 0) break;
            gen5(W, TA, TB, UB, VB, lane16, X);
            if (Y.tok == 0) batch3(TA, aflA, Y.u0, Y.u1, Y.v0, Y.v1, Y.g0, Y.g1, lane); else if (Y.tok == 1) batch3(TB, aflB, Y.u0, Y.u1, Y.v0, Y.v1, Y.g0, Y.g1, lane);
            if (X.tok < 0) break;
        }
        tok3_store<DRY>(ws, tk0, lane, TA); tok3_store<DRY>(ws, tk0 + 1, lane, TB);
    }
}
struct Cur { int s; unsigned long long m0, m1; };
__device__ __forceinline__ int gen6(Cur& C, const Tok2& T, const GAS unsigned char* UB, const GAS unsigned char* VB, unsigned lane16, Row2& u0, Row2& u1, Row2& v0, Row2& v1, float& g0, float& g1) {
    while (!(C.m0 | C.m1) && C.s + 1 < (16384 >> NSLICE_SHIFT)) { ++C.s; C.m0 = __ballot((T.ev[0] >> NSLICE_SHIFT) == C.s); C.m1 = __ballot((T.ev[1] >> NSLICE_SHIFT) == C.s); }
    int e0 = 0, e1 = 0; g0 = 0.f; g1 = 0.f;
    const int n = take2b(C.m0, C.m1, T.ev, T.gv, e0, g0, e1, g1);
    u0 = load_row8(UB, (unsigned)e0, lane16); u1 = load_row8(UB, (unsigned)e1, lane16); v0 = load_row8(VB, (unsigned)e0, lane16); v1 = load_row8(VB, (unsigned)e1, lane16);
    return n;
}
template <bool DRY> __device__ __forceinline__ void gather_sliced6_phase(const Args& A, Frame& F) {
    unsigned char* ws = A.ws;
    const GAS unsigned char* UB = (const GAS unsigned char*)(ws + WS_UB); const GAS unsigned char* VB = (const GAS unsigned char*)(ws + WS_VB);
    const int gw = F.vcu * NWAVES + F.wave, NGW = F.G * NWAVES;
    for (int tk0 = 2 * gw; tk0 < T_TOK; tk0 += 2 * NGW) {
        const int lane = lane_id(); const unsigned lane16 = (unsigned)lane * 16u;
        Tok2 TA, TB; tok2_load(ws, tk0, lane, TA); SBAR(); tok2_load(ws, tk0 + 1, lane, TB); SBAR();
        Cur CA, CB; CA.s = -1; CA.m0 = CA.m1 = 0ull; CB.s = -1; CB.m0 = CB.m1 = 0ull;
        Row2 uA0, uA1, vA0, vA1, uB0, uB1, vB0, vB1; float gA0, gA1, gB0, gB1;
        int nA = gen6(CA, TA, UB, VB, lane16, uA0, uA1, vA0, vA1, gA0, gA1), nB = gen6(CB, TB, UB, VB, lane16, uB0, uB1, vB0, vB1, gB0, gB1);
        while (nA | nB) {
            if (nA) batch2(TA, uA0, uA1, vA0, vA1, gA0, gA1, lane);
            SBAR(); nA = gen6(CA, TA, UB, VB, lane16, uA0, uA1, vA0, vA1, gA0, gA1); SBAR();
            if (nB) batch2(TB, uB0, uB1, vB0, vB1, gB0, gB1, lane);
            SBAR(); nB = gen6(CB, TB, UB, VB, lane16, uB0, uB1, vB0, vB1, gB0, gB1); SBAR();
        }
        tok2_store<DRY>(ws, tk0, lane, TA); tok2_store<DRY>(ws, tk0 + 1, lane, TB);
    }
}
__device__ __forceinline__ int gen7(Cur& C, const Acc2& T, const GAS unsigned char* UB, const GAS unsigned char* VB, unsigned lane16, Row2& u0, Row2& u1, Row2& v0, Row2& v1, float& g0, float& g1) {
    while (!(C.m0 | C.m1) && C.s + 1 < (16384 >> NSLICE_SHIFT)) { ++C.s; C.m0 = __ballot((T.ev[0] >> NSLICE_SHIFT) == C.s); C.m1 = __ballot((T.ev[1] >> NSLICE_SHIFT) == C.s); }
    int e0 = 0, e1 = 0; g0 = 0.f; g1 = 0.f;
    const int n = take2b(C.m0, C.m1, T.ev, T.gv, e0, g0, e1, g1);
    u0 = load_row8(UB, (unsigned)e0, lane16); u1 = load_row8(UB, (unsigned)e1, lane16); v0 = load_row8(VB, (unsigned)e0, lane16); v1 = load_row8(VB, (unsigned)e1, lane16);
    return n;
}
template <bool DRY> __device__ __forceinline__ void gather_sliced7_phase(const Args& A, Frame& F) {
    unsigned char* ws = A.ws;
    const GAS unsigned char* UB = (const GAS unsigned char*)(ws + WS_UB); const GAS unsigned char* VB = (const GAS unsigned char*)(ws + WS_VB);
    const int gw = F.vcu * NWAVES + F.wave, NGW = F.G * NWAVES;
    LAS unsigned char* aflA = F.lds + RING_OFF + F.wave * 16384; LAS unsigned char* aflB = aflA + 8192;
    for (int tk0 = 2 * gw; tk0 < T_TOK; tk0 += 2 * NGW) {
        const int lane = lane_id(); const unsigned lane16 = (unsigned)lane * 16u;
        Acc2 TA, TB; tok3_load(ws, tk0, lane, TA, aflA); tok3_load(ws, tk0 + 1, lane, TB, aflB);
        Cur CA, CB; CA.s = -1; CA.m0 = CA.m1 = 0ull; CB.s = -1; CB.m0 = CB.m1 = 0ull;
        Row2 uA0, uA1, vA0, vA1, uB0, uB1, vB0, vB1; float gA0, gA1, gB0, gB1;
        int nA = gen7(CA, TA, UB, VB, lane16, uA0, uA1, vA0, vA1, gA0, gA1), nB = gen7(CB, TB, UB, VB, lane16, uB0, uB1, vB0, vB1, gB0, gB1);
        while (nA | nB) {
            if (nA) batch3(TA, aflA, uA0, uA1, vA0, vA1, gA0, gA1, lane);
            nA = gen7(CA, TA, UB, VB, lane16, uA0, uA1, vA0, vA1, gA0, gA1);
            if (nB) batch3(TB, aflB, uB0, uB1, vB0, vB1, gB0, gB1, lane);
            nB = gen7(CB, TB, UB, VB, lane16, uB0, uB1, vB0, vB1, gB0, gB1);
        }
        tok3_store<DRY>(ws, tk0, lane, TA); tok3_store<DRY>(ws, tk0 + 1, lane, TB);
    }
}
__device__ __forceinline__ void fma8_lo(f32x2c& s, f32x2c a, unsigned w) { f32x2c t; asm("v_cvt_pk_f32_fp8_e32 %1, %3\n\tv_pk_fma_f32 %0, %2, %1, %0" : "+v"(s), "=&v"(t) : "v"(a), "v"(w)); }
__device__ __forceinline__ void fma8_hi(f32x2c& s, f32x2c a, unsigned w) { f32x2c t; asm("v_cvt_pk_f32_fp8_sdwa %1, %3 src0_sel:WORD_1\n\tv_pk_fma_f32 %0, %2, %1, %0" : "+v"(s), "=&v"(t) : "v"(a), "v"(w)); }
__device__ __forceinline__ void dots2(const Tok2& T, const Row2& u0, const Row2& u1, float& p0, float& p1) {
    f32x2c s0 = {0.f, 0.f}, s1 = {0.f, 0.f};
#pragma unroll
    for (int j = 0; j < 2; ++j) { const unsigned w0[4] = {u0.c[j].x, u0.c[j].y, u0.c[j].z, u0.c[j].w}, w1[4] = {u1.c[j].x, u1.c[j].y, u1.c[j].z, u1.c[j].w};
#pragma unroll
        for (int d = 0; d < 4; ++d) { fma8_lo(s0, T.af[8 * j + 2 * d], w0[d]); fma8_lo(s1, T.af[8 * j + 2 * d], w1[d]); fma8_hi(s0, T.af[8 * j + 2 * d + 1], w0[d]); fma8_hi(s1, T.af[8 * j + 2 * d + 1], w1[d]); } }
    p0 = s0.x + s0.y; p1 = s1.x + s1.y;
}
__device__ __forceinline__ void axpy2(Tok2& T, const Row2& v0, const Row2& v1, float wa, float wb) { const f32x2c wa2 = {wa, wa}, wb2 = {wb, wb};
#pragma unroll
    for (int j = 0; j < 2; ++j) { const unsigned w0[4] = {v0.c[j].x, v0.c[j].y, v0.c[j].z, v0.c[j].w}, w1[4] = {v1.c[j].x, v1.c[j].y, v1.c[j].z, v1.c[j].w};
#pragma unroll
        for (int d = 0; d < 4; ++d) { fma8_lo(T.acc[8 * j + 2 * d], wa2, w0[d]); fma8_hi(T.acc[8 * j + 2 * d + 1], wa2, w0[d]); fma8_lo(T.acc[8 * j + 2 * d], wb2, w1[d]); fma8_hi(T.acc[8 * j + 2 * d + 1], wb2, w1[d]); } }
}
__device__ __forceinline__ void gates2(const Tok2& T, float p0, float p1, float g0, float g1, int lane, float& w0, float& w1) {
    const float h = reduce2(p0, p1); const float w = ((lane & 32) ? g1 : g0) * gelu_f(h * T.rs) * (1.f / V8_SCALE);
    w0 = __uint_as_float((unsigned)__builtin_amdgcn_readlane((int)__float_as_uint(w), 31)); w1 = __uint_as_float((unsigned)__builtin_amdgcn_readlane((int)__float_as_uint(w), 63));
}
__device__ __forceinline__ int next8(Cur& C, const Tok2& T, int& e0, int& e1, float& g0, float& g1) {
    while (!(C.m0 | C.m1) && C.s + 1 < (16384 >> NSLICE_SHIFT)) { ++C.s; C.m0 = __ballot((T.ev[0] >> NSLICE_SHIFT) == C.s); C.m1 = __ballot((T.ev[1] >> NSLICE_SHIFT) == C.s); }
    e0 = 0; e1 = 0; g0 = 0.f; g1 = 0.f; return take2b(C.m0, C.m1, T.ev, T.gv, e0, g0, e1, g1);
}
__device__ __forceinline__ Row2 load_row8b(__amdgpu_buffer_rsrc_t rs, unsigned e, unsigned lane16) { Row2 r; r.c[0] = __builtin_amdgcn_raw_buffer_load_b128(rs, lane16, e * 2048u, 0); r.c[1] = __builtin_amdgcn_raw_buffer_load_b128(rs, lane16 + 1024u, e * 2048u, 0); return r; }
template <bool DRY> __device__ __forceinline__ void gather_sliced8_phase(const Args& A, Frame& F) {
    unsigned char* ws = A.ws;
    const GAS unsigned char* UB = (const GAS unsigned char*)(ws + WS_UB); const GAS unsigned char* VB = (const GAS unsigned char*)(ws + WS_VB);
    const int gw = F.vcu * NWAVES + F.wave, NGW = F.G * NWAVES;
    const __amdgpu_buffer_rsrc_t RU = __builtin_amdgcn_make_buffer_rsrc((void*)(ws + WS_UB), 0, 16384 * 2048, 0x00020000), RV = __builtin_amdgcn_make_buffer_rsrc((void*)(ws + WS_VB), 0, 16384 * 2048, 0x00020000);
    for (int tk0 = 2 * gw; tk0 < T_TOK; tk0 += 2 * NGW) {
        const int lane = lane_id(); const unsigned lane16 = (unsigned)lane * 16u;
        Tok2 TA, TB; tok2_load(ws, tk0, lane, TA); tok2_load(ws, tk0 + 1, lane, TB);
        Cur CA, CB; CA.s = -1; CA.m0 = CA.m1 = 0ull; CB.s = -1; CB.m0 = CB.m1 = 0ull;
        Row2 uA0, uA1, vA0, vA1, uB0, uB1, vB0, vB1;
        int eA0, eA1, eB0, eB1; float gA0, gA1, gB0, gB1;
        int nA = next8(CA, TA, eA0, eA1, gA0, gA1), nB = next8(CB, TB, eB0, eB1, gB0, gB1);
        uA0 = load_row8b(RU, (unsigned)eA0, lane16); uA1 = load_row8b(RU, (unsigned)eA1, lane16); uB0 = load_row8b(RU, (unsigned)eB0, lane16); uB1 = load_row8b(RU, (unsigned)eB1, lane16);
        vA0 = load_row8b(RV, (unsigned)eA0, lane16); vA1 = load_row8b(RV, (unsigned)eA1, lane16); vB0 = load_row8b(RV, (unsigned)eB0, lane16); vB1 = load_row8b(RV, (unsigned)eB1, lane16);
        do {
            float wA0 = 0.f, wA1 = 0.f, wB0 = 0.f, wB1 = 0.f; const int cA = nA, cB = nB;
            if (cA) { float p0, p1; dots2(TA, uA0, uA1, p0, p1); gates2(TA, p0, p1, gA0, gA1, lane, wA0, wA1); }
            nA = next8(CA, TA, eA0, eA1, gA0, gA1); SBAR(); uA0 = load_row8b(RU, (unsigned)eA0, lane16); uA1 = load_row8b(RU, (unsigned)eA1, lane16); SBAR();
            if (cB) { float p0, p1; dots2(TB, uB0, uB1, p0, p1); gates2(TB, p0, p1, gB0, gB1, lane, wB0, wB1); }
            nB = next8(CB, TB, eB0, eB1, gB0, gB1); SBAR(); uB0 = load_row8b(RU, (unsigned)eB0, lane16); uB1 = load_row8b(RU, (unsigned)eB1, lane16); SBAR();
            if (cA) axpy2(TA, vA0, vA1, wA0, wA1);
            SBAR(); vA0 = load_row8b(RV, (unsigned)eA0, lane16); vA1 = load_row8b(RV, (unsigned)eA1, lane16); SBAR();
            if (cB) axpy2(TB, vB0, vB1, wB0, wB1);
            SBAR(); vB0 = load_row8b(RV, (unsigned)eB0, lane16); vB1 = load_row8b(RV, (unsigned)eB1, lane16); SBAR();
        } while (nA | nB);
        tok2_store<DRY>(ws, tk0, lane, TA); tok2_store<DRY>(ws, tk0 + 1, lane, TB);
    }
}
typedef int v8i __attribute__((ext_vector_type(8)));
struct Tok9 { f32x2c acc[16]; Row2 ahi, alo; float rs; int ev[2]; float gv[2]; };
__device__ __forceinline__ unsigned pk4_fp8(float a, float b, float c, float d) { int t = 0; t = __builtin_amdgcn_cvt_pk_fp8_f32(a, b, t, false); t = __builtin_amdgcn_cvt_pk_fp8_f32(c, d, t, true); return (unsigned)t; }
__device__ __forceinline__ void tok9_load(const unsigned char* ws, int tk, int lane, Tok9& T) {
    const float* H1 = (const float*)(ws + WS_H1); const bf16* H1B = (const bf16*)(ws + WS_H1B); const float* psh1 = (const float*)(ws + WS_PSH1); const int* IDX = (const int*)(ws + WS_IDX); const float* GATE = (const float*)(ws + WS_GATE);
    T.rs = (1.0f / sqrtf(wave_sum64(psh1[(size_t)tk * 64 + lane]) * (1.f / 2048.f) + 1e-6f)) * (1.f / U8_SCALE);
#pragma unroll
    for (int j = 0; j < 2; ++j) { const v4u a0 = *(const GAS v4u*)(H1B + (size_t)tk * 2048 + 1024 * j + 16 * lane), a1 = *(const GAS v4u*)(H1B + (size_t)tk * 2048 + 1024 * j + 16 * lane + 8);
        const unsigned aw[8] = {a0.x, a0.y, a0.z, a0.w, a1.x, a1.y, a1.z, a1.w}; unsigned hi4[4], lo4[4];
#pragma unroll
        for (int d = 0; d < 4; ++d) { const float x0 = __uint_as_float(aw[2 * d] << 16), x1 = __uint_as_float(aw[2 * d] & 0xffff0000u), x2 = __uint_as_float(aw[2 * d + 1] << 16), x3 = __uint_as_float(aw[2 * d + 1] & 0xffff0000u);
            const unsigned h = pk4_fp8(x0, x1, x2, x3); const f32x2c l = __builtin_amdgcn_cvt_pk_f32_fp8((int)h, false), u = __builtin_amdgcn_cvt_pk_f32_fp8((int)h, true);
            hi4[d] = h; lo4[d] = pk4_fp8((x0 - l.x) * 16.f, (x1 - l.y) * 16.f, (x2 - u.x) * 16.f, (x3 - u.y) * 16.f); }
        T.ahi.c[j] = (v4u){hi4[0], hi4[1], hi4[2], hi4[3]}; T.alo.c[j] = (v4u){lo4[0], lo4[1], lo4[2], lo4[3]};
#pragma unroll
        for (int q = 0; q < 4; ++q) { const f32x4 x = *(const GAS f32x4*)(H1 + (size_t)tk * 2048 + 1024 * j + 16 * lane + 4 * q); T.acc[8 * j + 2 * q] = (f32x2c){x[0], x[1]}; T.acc[8 * j + 2 * q + 1] = (f32x2c){x[2], x[3]}; } }
    T.ev[0] = IDX[(size_t)tk * 128 + lane]; T.ev[1] = IDX[(size_t)tk * 128 + 64 + lane]; T.gv[0] = GATE[(size_t)tk * 128 + lane]; T.gv[1] = GATE[(size_t)tk * 128 + 64 + lane];
}
template <bool DRY> __device__ __forceinline__ void tok9_store(unsigned char* ws, int tk, const Tok9& T) {
    const int lane = lane_id();
    float* H1 = (float*)(ws + WS_H1); bf16* H1B = (bf16*)(ws + WS_H1B); float* rsh2 = (float*)(ws + WS_RSH2);
    float ss = 0.f;
    float* H1o = DRY ? (float*)(ws + WS_NA0) + (size_t)(tk & 2047) * 2048 : H1 + (size_t)tk * 2048; bf16* H1Bo = DRY ? (bf16*)(ws + WS_NGL) + (size_t)(tk & 2047) * 2048 : H1B + (size_t)tk * 2048;
#pragma unroll
    for (int j = 0; j < 2; ++j) {
#pragma unroll
        for (int q = 0; q < 2; ++q) { const f32x4 y0 = {T.acc[8 * j + 4 * q].x, T.acc[8 * j + 4 * q].y, T.acc[8 * j + 4 * q + 1].x, T.acc[8 * j + 4 * q + 1].y}, y1 = {T.acc[8 * j + 4 * q + 2].x, T.acc[8 * j + 4 * q + 2].y, T.acc[8 * j + 4 * q + 3].x, T.acc[8 * j + 4 * q + 3].y}; ss += sq8(y0, y1);
            *(GAS f32x4*)(H1o + 1024 * j + 16 * lane + 8 * q) = y0; *(GAS f32x4*)(H1o + 1024 * j + 16 * lane + 8 * q + 4) = y1; *(GAS v4u*)(H1Bo + 1024 * j + 16 * lane + 8 * q) = pack8(y0, y1); } }
    ss = wave_sum64(ss); if (lane == 0 && !DRY) rsh2[tk] = 1.0f / sqrtf(ss * (1.f / 2048.f) + 1e-6f);
}
__device__ __forceinline__ v8i as_v8i(const Row2& r) { return (v8i){(int)r.c[0].x, (int)r.c[0].y, (int)r.c[0].z, (int)r.c[0].w, (int)r.c[1].x, (int)r.c[1].y, (int)r.c[1].z, (int)r.c[1].w}; }
__device__ __forceinline__ float dot_mfma(const Tok9& T, const Row2& u, int lane) {
    const v8i ua = as_v8i(u); f32x4 c = {0.f, 0.f, 0.f, 0.f};
    c = __builtin_amdgcn_mfma_scale_f32_16x16x128_f8f6f4(ua, as_v8i(T.ahi), c, 0, 0, 0, 127, 0, 127);
    c = __builtin_amdgcn_mfma_scale_f32_16x16x128_f8f6f4(ua, as_v8i(T.alo), c, 0, 0, 0, 127, 0, 123);
    const int n = lane & 15; const float t0 = (n & 1) ? c[1] : c[0], t1 = (n & 1) ? c[3] : c[2], v = (n & 2) ? t1 : t0;
    return ((lane >> 4) == (n >> 2)) ? v : 0.f;
}
__device__ __forceinline__ void axpy9(Tok9& T, const Row2& v0, const Row2& v1, float wa, float wb) { const f32x2c wa2 = {wa, wa}, wb2 = {wb, wb};
#pragma unroll
    for (int j = 0; j < 2; ++j) { const unsigned w0[4] = {v0.c[j].x, v0.c[j].y, v0.c[j].z, v0.c[j].w}, w1[4] = {v1.c[j].x, v1.c[j].y, v1.c[j].z, v1.c[j].w};
#pragma unroll
        for (int d = 0; d < 4; ++d) { fma8_lo(T.acc[8 * j + 2 * d], wa2, w0[d]); fma8_hi(T.acc[8 * j + 2 * d + 1], wa2, w0[d]); fma8_lo(T.acc[8 * j + 2 * d], wb2, w1[d]); fma8_hi(T.acc[8 * j + 2 * d + 1], wb2, w1[d]); } }
}
__device__ __forceinline__ void batch9(Tok9& T, const Row2& u0, const Row2& u1, const Row2& v0, const Row2& v1, float g0, float g1, int lane) {
    const float h = reduce2(dot_mfma(T, u0, lane), dot_mfma(T, u1, lane));
    const float w = ((lane & 32) ? g1 : g0) * gelu_f(h * T.rs) * (1.f / V8_SCALE);
    const float w0 = __uint_as_float((unsigned)__builtin_amdgcn_readlane((int)__float_as_uint(w), 31)), w1 = __uint_as_float((unsigned)__builtin_amdgcn_readlane((int)__float_as_uint(w), 63));
    axpy9(T, v0, v1, w0, w1);
}
__device__ __forceinline__ int take9(unsigned long long& m0, unsigned long long& m1, const Tok9& T, int& e0, float& g0, int& e1, float& g1) { return take2b(m0, m1, T.ev, T.gv, e0, g0, e1, g1); }
template <bool DRY> __device__ __forceinline__ void gather_sliced9_phase(const Args& A, Frame& F) {
    unsigned char* ws = A.ws;
    const int gw = F.vcu * NWAVES + F.wave, NGW = F.G * NWAVES;
    const __amdgpu_buffer_rsrc_t RU = __builtin_amdgcn_make_buffer_rsrc((void*)(ws + WS_UB), 0, 16384 * 2048, 0x00020000), RV = __builtin_amdgcn_make_buffer_rsrc((void*)(ws + WS_VB), 0, 16384 * 2048, 0x00020000);
    for (int tk0 = 2 * gw; tk0 < T_TOK; tk0 += 2 * NGW) {
        const int lane = lane_id(); const unsigned lane16 = (unsigned)lane * 16u;
        Tok9 TA, TB; tok9_load(ws, tk0, lane, TA); tok9_load(ws, tk0 + 1, lane, TB);
        for (int s = 0; s < (16384 >> NSLICE_SHIFT); ++s) {
            unsigned long long a0 = __ballot((TA.ev[0] >> NSLICE_SHIFT) == s), a1 = __ballot((TA.ev[1] >> NSLICE_SHIFT) == s), b0 = __ballot((TB.ev[0] >> NSLICE_SHIFT) == s), b1 = __ballot((TB.ev[1] >> NSLICE_SHIFT) == s);
            while (a0 | a1 | b0 | b1) {
                int eA0 = 0, eA1 = 0, eB0 = 0, eB1 = 0; float gA0 = 0.f, gA1 = 0.f, gB0 = 0.f, gB1 = 0.f;
                const int nA = take9(a0, a1, TA, eA0, gA0, eA1, gA1), nB = take9(b0, b1, TB, eB0, gB0, eB1, gB1);
                if (DRY && PROBE_NOV == 5) { eA0 &= 3; eA1 &= 3; eB0 &= 3; eB1 &= 3; } if (DRY && PROBE_NOV == 4) { eA0 &= 255; eA1 &= 255; eB0 &= 255; eB1 &= 255; }
                Row2 uA0, uA1, vA0, vA1, uB0, uB1, vB0, vB1;
                if (nA) { uA0 = load_row8b(RU, (unsigned)eA0, lane16); vA0 = load_row8b(RV, (unsigned)eA0, lane16); if (nA == 2) { uA1 = load_row8b(RU, (unsigned)eA1, lane16); vA1 = load_row8b(RV, (unsigned)eA1, lane16); } else { uA1 = uA0; vA1 = vA0; } }
                if (nB) { uB0 = load_row8b(RU, (unsigned)eB0, lane16); vB0 = load_row8b(RV, (unsigned)eB0, lane16); if (nB == 2) { uB1 = load_row8b(RU, (unsigned)eB1, lane16); vB1 = load_row8b(RV, (unsigned)eB1, lane16); } else { uB1 = uB0; vB1 = vB0; } }
                if (nA) batch9(TA, uA0, uA1, vA0, vA1, gA0, gA1, lane);
                if (nB) batch9(TB, uB0, uB1, vB0, vB1, gB0, gB1, lane);
            }
        }
        tok9_store<DRY>(ws, tk0, TA); tok9_store<DRY>(ws, tk0 + 1, TB);
    }
}
__device__ __forceinline__ void final_phase(const Args& A, Frame& F) {
    unsigned char* ws = A.ws; const float* psh3 = (const float*)(ws + WS_PSH3); const float* gf = (const float*)A.in[25]; float* out = A.out;
    const int gw = F.vcu * NWAVES + F.wave, NGW = F.G * NWAVES;
    for (int tk = gw; tk < T_TOK; tk += NGW) { const int lane = lane_id();
        const float rs = 1.0f / sqrtf(wave_sum64(psh3[(size_t)tk * 64 + lane]) * (1.f / 2048.f) + 1e-6f);
#pragma unroll
        for (int j = 0; j < 8; ++j) { GAS f32x4* o = (GAS f32x4*)(out + (size_t)tk * 2048 + 256 * j) + lane; const f32x4 g = *((const GAS f32x4*)(gf + 256 * j) + lane); *o = *o * rs * g; } }
}
#define PH2_BODY \
        { pg8::Gemm g{(const bf16*)(ws + WS_CQ), (const bf16*)(ws + WS_WT_UQ), T_TOK, 1536, 512}; pg8::StaticOrder S; S.init(T_TOK, 1536, F.G, (int)blockIdx.x); \
          LAS float* tab = (LAS float*)(F.lds + TAB_OFF); setup_rowtab(tab, (const float*)(ws + WS_PSCQ), 16, 1.f / 512.f, S, F.wave); __syncthreads(); \
          EpiQ E{tab, (bf16*)(ws + WS_Q), (const f32x2v*)(ws + WS_CS)}; pg8::gemm_phase<EpiQ, pg8::StaticOrder, true, true>(F.lds + RING_OFF, g, S, E, F.wave); } \
        __syncthreads(); \
        { pg8::Gemm g{(const bf16*)(ws + WS_CKV), (const bf16*)(ws + WS_WT_UKV), T_TOK, 2048, 256}; pg8::StaticOrder S; S.init(T_TOK, 2048, F.G, (int)blockIdx.x); \
          LAS float* tab = (LAS float*)(F.lds + TAB_OFF); setup_rowtab(tab, (const float*)(ws + WS_PSCKV), 8, 1.f / 256.f, S, F.wave); __syncthreads(); \
          EpiKV E{tab, (bf16*)(ws + WS_KN), (bf16*)(ws + WS_VV)}; pg8::gemm_phase<EpiKV, pg8::StaticOrder, true, true>(F.lds + RING_OFF, g, S, E, F.wave); } \
        __syncthreads(); \
        sgu_phase(args, F); __syncthreads();

#define PH4_BODY \
        { pg8::Gemm g{(const bf16*)(ws + WS_MIX), (const bf16*)(ws + WS_WT_OUT), T_TOK, 2048, 2048}; pg8::StaticOrder S; S.init(T_TOK, 2048, F.G, (int)blockIdx.x); \
          LAS float* tab = (LAS float*)(F.lds + TAB_OFF); setup_rowtab(tab, (const float*)(ws + WS_PSA), 8, 1.f / 1024.f, S, F.wave); setup_rowtab(tab + 256, (const float*)(ws + WS_PSS), 16, 1.f / 1024.f, S, F.wave); __syncthreads(); \
          EpiOut E{tab, (const float*)args.in[0], (float*)(ws + WS_H1), (bf16*)(ws + WS_H1B), (float*)(ws + WS_PSH1)}; pg8::gemm_phase<EpiOut, pg8::StaticOrder, true, true>(F.lds + RING_OFF, g, S, E, F.wave); } __syncthreads();

#define PH5_BODY \
        { pg8::Gemm g{(const bf16*)(ws + WS_H1B), (const bf16*)(ws + WS_WT_PQ), T_TOK, 2048, 2048}; pg8::StaticOrder S; S.init(T_TOK, 2048, F.G, (int)blockIdx.x); \
          LAS float* tab = (LAS float*)(F.lds + TAB_OFF); setup_rowtab(tab, (const float*)(ws + WS_PSH1), 64, 1.f / 2048.f, S, F.wave); __syncthreads(); \
          EpiPQ E{tab, (bf16*)(ws + WS_R1)}; pg8::gemm_phase<EpiPQ, pg8::StaticOrder, true, true>(F.lds + RING_OFF, g, S, E, F.wave); }

#define PH8_BODY \
        { pg8::Gemm g{(const bf16*)(ws + WS_H1B), (const bf16*)(ws + WS_WT_PG), T_TOK, 2048, 2048}; pg8::StaticOrder S; S.init(T_TOK, 2048, F.G, (int)blockIdx.x); \
          EpiPLE E{(const float*)(ws + WS_RSH2), (const float*)(ws + WS_H1), (const bf16*)(ws + WS_PPROJ), args.out, (float*)(ws + WS_PSH3)}; pg8::gemm_phase<EpiPLE, pg8::StaticOrder, true, true>(F.lds + RING_OFF, g, S, E, F.wave); } __syncthreads();

#define PHASES_2_9 \
    if (IN(2)) { if (REPEAT_PH == 2) { PH2_BODY __syncthreads(); } PH2_BODY SEAM(2); } \
    if (IN(3)) { if (REPEAT_PH == 3) { attn_phase(args, F); __syncthreads(); } attn_phase(args, F); SEAM(3); } \
    if (IN(4)) { if (REPEAT_PH == 4) { PH4_BODY __syncthreads(); } PH4_BODY SEAM(4); } \
    if (IN(5)) { if (REPEAT_PH == 5) { PH5_BODY __syncthreads(); } PH5_BODY SEAM(5); } \
    PHASES_6_9
#define PHASES_6_9 \
    if (IN(6)) { if (REPEAT_PH == 6) { topk_phase(args, F); __syncthreads(); } topk_phase(args, F); SEAM(6); } \
    if (IN(7)) { if (REPEAT_PH == 7) { GATHER_FN<true>(args, F); __syncthreads(); } GATHER_FN<false>(args, F); SEAM(7); } \
    if (IN(8)) { if (REPEAT_PH == 8) { PH8_BODY __syncthreads(); } PH8_BODY SEAM(8); } \
    if (IN(9)) { final_phase(args, F); }
#define PH1_BODY \
        { pg8::Gemm g{(const bf16*)(ws + WS_R1), (const bf16*)(ws + WS_WT_IN), T_TOK, 3072, 2048}; pg8::StaticOrder S; S.init(T_TOK, 3072, F.G, (int)blockIdx.x); \
          EpiG1 E{(const float*)(ws + WS_RSX), (bf16*)(ws + WS_CQ), (bf16*)(ws + WS_CKV), (bf16*)(ws + WS_KR), (bf16*)(ws + WS_UG), (bf16*)(ws + WS_VG), (float*)(ws + WS_PSCQ), (float*)(ws + WS_PSCKV), (f32x2v*)(ws + WS_PSV), (const f32x2v*)(ws + WS_CS)}; \
          pg8::gemm_phase<EpiG1, pg8::StaticOrder, true, true>(F.lds + RING_OFF, g, S, E, F.wave); } \
        { pg8::Gemm g{(const bf16*)(ws + WS_PB), (const bf16*)(ws + WS_WT_PP), T_TOK, 2048, 256}; pg8::StaticOrder S; S.init(T_TOK, 2048, F.G, (int)blockIdx.x); \
          EpiPlain E{(bf16*)(ws + WS_PPROJ), 2048}; \
          pg8::gemm_phase<EpiPlain, pg8::StaticOrder, true, true>(F.lds + RING_OFF, g, S, E, F.wave); }
constexpr int N_PHASES = 10;
__global__ void __launch_bounds__(NWAVES * 64, 2) mega_fwd(Args args) {
    extern __shared__ __attribute__((aligned(16))) unsigned char lds[];
    Frame F;
    F.lds = (LAS unsigned char*)lds; F.MISC = (volatile LAS unsigned*)(F.lds + MISC_OFF);
    F.wave = __builtin_amdgcn_readfirstlane(threadIdx.x >> 6); F.lane = lane_id(); F.tid = F.wave * 64 + F.lane;
    F.G = gridDim.x; { const int bx = blockIdx.x; F.vcu = (F.G % 8 == 0) ? (bx % 8) * (F.G / 8) + bx / 8 : bx; }
    unsigned char* ws = args.ws; F.ctl = (gu32*)(ws + WS_CTL);
    for (int u = F.wave * 64 + lane_id(); u < (LDS_BYTES - LDSCTL_OFF) / 4; u += NWAVES * 64) ((LAS unsigned*)(F.lds + LDSCTL_OFF))[u] = 0u;
    __syncthreads();
    const int lo = args.ph_lo, hi = args.ph_hi;
    XcdBarrier bar; bar.bar = (unsigned*)(F.ctl + CW_BAR); bar.x = 0; bar.st = nullptr;
    if (hi - lo > 1) bar = xcd_barrier_post((unsigned*)(F.ctl + CW_BAR), F.MISC + 8, F.wave);
#define IN(k) (lo <= (k) && (k) < hi)
#define SEAM(k) do { if (IN(k) && IN((k) + 1)) xcd_barrier(bar, F.wave); } while (0)
    if (IN(0)) { if (REPEAT_PH == 0) { p0_prologue(args, F); __syncthreads(); } p0_prologue(args, F); SEAM(0); }
    if (IN(1)) { if (REPEAT_PH == 1) { PH1_BODY __syncthreads(); } PH1_BODY SEAM(1); }
    PHASES_2_9
#undef IN
#undef SEAM
}

#if CUT > 0 && CUT < 9
__device__ __forceinline__ int rope_unpc(int pc) { const int c5 = pc >> 5, fq = (pc >> 3) & 3, nn = (pc >> 2) & 1, e = pc & 3; return 16 * c5 + 4 * fq + e + 32 * nn; }
__global__ void __launch_bounds__(256) conv1(const unsigned char* ws, int b, float* ZP) {
    const int r = blockIdx.x; const size_t row = (size_t)b * 2048 + r; float* z = ZP + (size_t)r * 2880;
    const bf16 *CQ = (const bf16*)(ws + WS_CQ) + row * 512, *CKV = (const bf16*)(ws + WS_CKV) + row * 256, *KR = (const bf16*)(ws + WS_KR) + row * 64, *UG = (const bf16*)(ws + WS_UG) + row * 1024, *VG = (const bf16*)(ws + WS_VG) + row * 1024;
    for (int i = threadIdx.x; i < 512; i += 256) z[i] = bf2f(CQ[i]);
    for (int i = threadIdx.x; i < 256; i += 256) z[512 + i] = bf2f(CKV[i]);
    if (threadIdx.x < 64) z[768 + rope_unpc(threadIdx.x)] = bf2f(KR[threadIdx.x]);
    for (int i = threadIdx.x; i < 1024; i += 256) { z[832 + i] = bf2f(UG[i]); z[1856 + i] = bf2f(VG[i]); }
}
__global__ void __launch_bounds__(256) conv2(const unsigned char* ws, int b, float* ZP, float* QN, float* KV, float* OSGU) {
    const int r = blockIdx.x; const size_t row = (size_t)b * 2048 + r;
    const bf16 *Q = (const bf16*)(ws + WS_Q) + row * 1536, *KN = (const bf16*)(ws + WS_KN) + row * 1024, *VV = (const bf16*)(ws + WS_VV) + row * 1024, *KR = (const bf16*)(ws + WS_KR) + row * 64, *MIX = (const bf16*)(ws + WS_MIX) + row * 2048;
    for (int i = threadIdx.x; i < 1536; i += 256) { const int h = i / 192, lc = i - h * 192; const int dst = lc < 128 ? i : h * 192 + 128 + rope_unpc(lc - 128); QN[(size_t)r * 1536 + dst] = bf2f(Q[i]) * (1.f / QK_C2); }
    for (int i = threadIdx.x; i < 1024; i += 256) { const int h = i >> 7, d = i & 127; KV[(size_t)r * 2048 + h * 256 + d] = bf2f(KN[i]); KV[(size_t)r * 2048 + h * 256 + 128 + d] = bf2f(VV[i]); OSGU[(size_t)r * 1024 + i] = bf2f(MIX[1024 + i]); }
    if (threadIdx.x < 64) ZP[(size_t)r * 2880 + 768 + rope_unpc(threadIdx.x)] = bf2f(KR[threadIdx.x]);
}
__global__ void __launch_bounds__(256) conv3(const unsigned char* ws, int b, float* OATT, float* OSGU) {
    const int r = blockIdx.x; const size_t row = (size_t)b * 2048 + r; const bf16* MIX = (const bf16*)(ws + WS_MIX) + row * 2048;
    for (int i = threadIdx.x; i < 1024; i += 256) { OATT[(size_t)r * 1024 + i] = bf2f(MIX[i]); OSGU[(size_t)r * 1024 + i] = bf2f(MIX[1024 + i]); }
}
__global__ void __launch_bounds__(256) conv5(const unsigned char* ws, int b, float* QPN) {
    const int r = blockIdx.x; const size_t row = (size_t)b * 2048 + r; const bf16* QP = (const bf16*)(ws + WS_R1) + row * 2048;
    for (int i = threadIdx.x; i < 2048; i += 256) QPN[(size_t)r * 2048 + i] = bf2f(QP[i]);
}
static void launch_conv(int b, void* const* d_in, void* d_ws, hipStream_t stream) {
    unsigned char* ws = (unsigned char*)d_ws; (void)d_in;
    if (CUT == 1) conv1<<<2048, 256, 0, stream>>>(ws, b, (float*)(ws + WS_NZP));
    if (CUT == 2) conv2<<<2048, 256, 0, stream>>>(ws, b, (float*)(ws + WS_NZP), (float*)(ws + WS_NQN), (float*)(ws + WS_NKV), (float*)(ws + WS_NOSGU));
    if (CUT == 3) conv3<<<2048, 256, 0, stream>>>(ws, b, (float*)(ws + WS_NOATT), (float*)(ws + WS_NOSGU));
    if (CUT == 5) conv5<<<2048, 256, 0, stream>>>(ws, b, (float*)(ws + WS_NQPN));
}
#endif
#if CUT > 0
static void launch_fast(void* const* d_in, void* d_out, void* d_ws, hipStream_t stream) {
    static int grid = 0;
    if (grid == 0) {
        int dev = 0, cus = 0, per_cu = 0;
        if (hipGetDevice(&dev) != hipSuccess || hipDeviceGetAttribute(&cus, hipDeviceAttributeMultiprocessorCount, dev) != hipSuccess) { fprintf(stderr, "launch_fast: device query failed\n"); grid = -1; return; }
        if (hipFuncSetAttribute((const void*)mega_fwd, hipFuncAttributeMaxDynamicSharedMemorySize, LDS_BYTES) != hipSuccess) { fprintf(stderr, "launch_fast: hipFuncSetAttribute failed\n"); grid = -1; return; }
        if (hipOccupancyMaxActiveBlocksPerMultiprocessor(&per_cu, (const void*)mega_fwd, NWAVES * 64, LDS_BYTES) != hipSuccess || per_cu < 1) fprintf(stderr, "launch_fast: occupancy query says %d blocks per CU\n", per_cu);
        (void)hipGetLastError();
        grid = cus;
        if (grid != 256) fprintf(stderr, "launch_fast: %d CUs (built for 256)\n", grid);
    }
    if (grid < 0) return;
    (void)hipMemsetAsync((char*)d_ws + WS_CTL, 0, CTL_ZERO_BYTES, stream);
    Args a{};
    for (int i = 0; i < 26; ++i) a.in[i] = d_in[i];
    a.out = (float*)d_out; a.ws = (unsigned char*)d_ws;
    constexpr int LAST = CUT + 1;
#if ONE_LAUNCH
    a.ph_lo = 0; a.ph_hi = LAST; hipLaunchKernelGGL(mega_fwd, dim3(grid), dim3(NWAVES * 64), LDS_BYTES, stream, a);
#else
    for (int ph = 0; ph < LAST; ++ph) { a.ph_lo = ph; a.ph_hi = ph + 1; hipLaunchKernelGGL(mega_fwd, dim3(grid), dim3(NWAVES * 64), LDS_BYTES, stream, a); }
#endif
    const hipError_t le = hipPeekAtLastError(); if (le != hipSuccess) fprintf(stderr, "launch_fast: launch failed: %s\n", hipGetErrorName(le));
}
#endif
#if CUT > 0
static void launch_fast(void* const* d_in, void* d_out, void* d_ws, hipStream_t stream);
static void launch_conv(int b, void* const* d_in, void* d_ws, hipStream_t stream);
#endif
extern "C" void kernel_launch(void* const* d_in, const int* in_sizes, int n_in, void* d_out, int out_size, void* d_ws, size_t ws_size, hipStream_t stream) {
    if (n_in != 26 || out_size != T_TOK * DM || ws_size < WS_END) { fprintf(stderr, "kernel_launch: unexpected shapes n_in %d out %d ws %zu\n", n_in, out_size, ws_size); return; }
    unsigned char* ws = (unsigned char*)d_ws;
    const float* x = (const float*)d_in[0]; const float* p = (const float*)d_in[1]; const int* pos = (const int*)d_in[2];
    const float *g_mix = (const float*)d_in[3], *w_in = (const float*)d_in[4], *g_cq = (const float*)d_in[5], *w_uq = (const float*)d_in[6], *g_ckv = (const float*)d_in[7], *w_ukv = (const float*)d_in[8];
    const float *g_ln = (const float*)d_in[9], *b_ln = (const float*)d_in[10], *w_sgu = (const float*)d_in[11], *b_sgu = (const float*)d_in[12], *g_oa = (const float*)d_in[13], *g_os = (const float*)d_in[14];
    const float *w_out = (const float*)d_in[15], *g_ffn = (const float*)d_in[16], *w_pq = (const float*)d_in[17], *k1 = (const float*)d_in[18], *k2 = (const float*)d_in[19], *pu = (const float*)d_in[20], *pv = (const float*)d_in[21];
    const float *g_ple = (const float*)d_in[22], *w_pg = (const float*)d_in[23], *w_pp = (const float*)d_in[24], *g_fin = (const float*)d_in[25];
    float* out = (float*)d_out;
#if CUT > 0
    launch_fast(d_in, d_out, d_ws, stream);
#endif
#if CUT < 9
    constexpr int S0 = CUT + 1; constexpr int TB = nv::TBAT;
    float* A0 = (float*)(ws + WS_NA0); float* GL = (float*)(ws + WS_NGL); float* PP = (float*)(ws + WS_NPP);
    float* ZP = (float*)(ws + WS_NZP); float* CQN = (float*)(ws + WS_NCQN); float* CKVN = (float*)(ws + WS_NCKVN); float* QN = (float*)(ws + WS_NQN); float* KV = (float*)(ws + WS_NKV);
    float* VLN = (float*)(ws + WS_NVLN); float* OSGU = (float*)(ws + WS_NOSGU); float* OATT = (float*)(ws + WS_NOATT); float* QPN = (float*)(ws + WS_NQPN);
    for (int b = 0; b < NBATCH; ++b) {
        const size_t t0 = (size_t)b * TB; const float* xb = x + t0 * DM; const int* posb = pos + t0; const float* pb = p + t0 * 256;
        float* H1 = (float*)(ws + WS_H1) + t0 * DM; int* IDX = (int*)(ws + WS_IDX) + t0 * 128; float* GATE = (float*)(ws + WS_GATE) + t0 * 128; float* outb = out + t0 * DM;
#if CUT > 0
        launch_conv(b, d_in, d_ws, stream);
#endif
        if (S0 <= 1) {
            nv::nk_rmsnorm<<<TB, 256, 0, stream>>>(xb, DM, g_mix, A0, DM, DM);
            nv::nk_gemm<<<dim3(2880 / 64, TB / 64), 256, 0, stream>>>(A0, DM, w_in, 2880, ZP, 2880, nullptr, 0, DM);
            nv::nk_z_post<<<TB, 256, 0, stream>>>(ZP, posb);
        }
        if (S0 <= 2) {
            nv::nk_rmsnorm<<<TB, 256, 0, stream>>>(ZP, 2880, g_cq, CQN, 512, 512);
            nv::nk_gemm<<<dim3(1536 / 64, TB / 64), 256, 0, stream>>>(CQN, 512, w_uq, 1536, QN, 1536, nullptr, 0, 512);
            nv::nk_q_rope<<<TB, 256, 0, stream>>>(QN, posb);
            nv::nk_rmsnorm<<<TB, 256, 0, stream>>>(ZP + 512, 2880, g_ckv, CKVN, 256, 256);
            nv::nk_gemm<<<dim3(2048 / 64, TB / 64), 256, 0, stream>>>(CKVN, 256, w_ukv, 2048, KV, 2048, nullptr, 0, 256);
            nv::nk_ln_group<<<TB * 8 / 4, 256, 0, stream>>>(ZP, g_ln, b_ln, VLN);
            nv::nk_sgu<<<TB * 1024 / 256, 256, 0, stream>>>(ZP, VLN, w_sgu, b_sgu, OSGU);
        }
        if (S0 <= 3) nv::nk_attn<<<dim3(TB, 8), 256, 0, stream>>>(QN, KV, ZP, OATT);
        if (S0 <= 4) {
            nv::nk_rmsnorm<<<TB, 256, 0, stream>>>(OATT, 1024, g_oa, A0, DM, 1024);
            nv::nk_rmsnorm<<<TB, 256, 0, stream>>>(OSGU, 1024, g_os, A0 + 1024, DM, 1024);
            nv::nk_gemm<<<dim3(DM / 64, TB / 64), 256, 0, stream>>>(A0, DM, w_out, DM, H1, DM, xb, DM, DM);
        }
        if (S0 <= 5) {
            nv::nk_rmsnorm<<<TB, 256, 0, stream>>>(H1, DM, g_ffn, A0, DM, DM);
            nv::nk_gemm<<<dim3(DM / 64, TB / 64), 256, 0, stream>>>(A0, DM, w_pq, DM, QPN, DM, nullptr, 0, DM);
        }
        if (S0 <= 6) nv::nk_topk<<<TB * 8, 128, 0, stream>>>(QPN, k1, k2, IDX, GATE);
        if (S0 <= 7) {
            nv::nk_rmsnorm<<<TB, 256, 0, stream>>>(H1, DM, g_ffn, A0, DM, DM);
            nv::nk_gather<<<TB, 256, 0, stream>>>(H1, A0, IDX, GATE, pu, pv);
        }
        if (S0 <= 8) {
            nv::nk_rmsnorm<<<TB, 256, 0, stream>>>(H1, DM, g_ple, A0, DM, DM);
            nv::nk_gemm<<<dim3(DM / 64, TB / 64), 256, 0, stream>>>(A0, DM, w_pg, DM, GL, DM, nullptr, 0, DM);
            nv::nk_gemm<<<dim3(DM / 64, TB / 64), 256, 0, stream>>>(pb, 256, w_pp, DM, PP, DM, nullptr, 0, 256);
            nv::nk_ple<<<TB * DM / 256, 256, 0, stream>>>(H1, GL, PP, outb);
        }
        nv::nk_rmsnorm<<<TB, 256, 0, stream>>>(outb, DM, g_fin, outb, DM, DM);
    }
#endif
}
```

```cpp
#include <hip/hip_runtime.h>
#include <hip/hip_bf16.h>
#include <cstdio>
#include <cstdint>
#include <cmath>
#ifndef CUT
#define CUT 9
#endif
#ifndef ONE_LAUNCH
#define ONE_LAUNCH 1
#endif
#ifndef REPEAT_PH
#define REPEAT_PH -1
#endif
#ifndef PEER_FP6
#define PEER_FP6 1
#endif
#ifndef U_FP6
#define U_FP6 1
#endif
#ifndef V_FP6
#define V_FP6 1
#endif
#ifndef GATHER_FN
#define GATHER_FN gather_fp6_phase
#endif
constexpr int T_TOK = 8192, DM = 2048, SEQ = 2048, NBATCH = 4;
constexpr size_t MiB = 1u << 20;
constexpr size_t WS_CTL = 0;
constexpr size_t WS_WT_IN = 1 * MiB, WS_WT_UQ = 13 * MiB, WS_WT_UKV = 14 * MiB + 512 * 1024, WS_WT_PP = 15 * MiB + 512 * 1024;
constexpr size_t WS_K1B = 16 * MiB + 512 * 1024, WS_K2B = WS_K1B + 256 * 1024, WS_WSGU = 17 * MiB;
constexpr size_t WS_WT_OUT = 18 * MiB, WS_WT_PQ = 26 * MiB, WS_WT_PG = 34 * MiB;
constexpr size_t WS_UB = 42 * MiB, WS_VB = 106 * MiB;
constexpr size_t WS_R1 = 170 * MiB;
constexpr size_t WS_PB = 202 * MiB, WS_CS = 206 * MiB, WS_RSX = 208 * MiB, WS_RSH2 = 208 * MiB + 512 * 1024;
constexpr size_t WS_CQ = 209 * MiB, WS_CKV = 217 * MiB, WS_KR = 221 * MiB, WS_UG = 222 * MiB, WS_VG = 238 * MiB;
constexpr size_t WS_PSCQ = 254 * MiB, WS_PSCKV = 254 * MiB + 512 * 1024, WS_PSV = 255 * MiB;
constexpr size_t WS_Q = 257 * MiB, WS_KN = 281 * MiB, WS_VV = 297 * MiB, WS_H1B = 257 * MiB;
constexpr size_t WS_MIX = 313 * MiB, WS_PSA = 345 * MiB, WS_PSS = 345 * MiB + 512 * 1024;
constexpr size_t WS_H1 = 346 * MiB, WS_PSH1 = 410 * MiB, WS_IDX = 412 * MiB, WS_GATE = 416 * MiB, WS_PPROJ = 420 * MiB, WS_PSH3 = 452 * MiB;
constexpr size_t WS_NA0 = 454 * MiB, WS_NGL = 470 * MiB, WS_NPP = 486 * MiB, WS_END = 502 * MiB;
constexpr size_t WS_NZP = 42 * MiB, WS_NCQN = 65 * MiB, WS_NCKVN = 69 * MiB, WS_NQN = 71 * MiB, WS_NKV = 83 * MiB, WS_NVLN = 99 * MiB, WS_NOSGU = 107 * MiB, WS_NOATT = 115 * MiB, WS_NQPN = 123 * MiB;
namespace nv {
constexpr int TBAT = 2048;
__device__ __forceinline__ float gelu_t(float x) { const float c = 0.7978845608028654f; const float u = c * (x + 0.044715f * x * x * x); return 0.5f * x * (1.f + tanhf(u)); }
__device__ __forceinline__ float wave_sum(float v) {
#pragma unroll
    for (int o = 1; o < 64; o <<= 1) v += __shfl_xor(v, o);
    return v;
}
__device__ __forceinline__ float wave_max(float v) {
#pragma unroll
    for (int o = 1; o < 64; o <<= 1) v = fmaxf(v, __shfl_xor(v, o));
    return v;
}
__device__ __forceinline__ float blk_sum(float v, float* sh) {
    v = wave_sum(v); __syncthreads();
    if ((threadIdx.x & 63) == 0) sh[threadIdx.x >> 6] = v; __syncthreads();
    float r = 0.f; for (int i = 0; i < (int)(blockDim.x >> 6); ++i) r += sh[i]; return r;
}
__device__ __forceinline__ float blk_max(float v, float* sh) {
    v = wave_max(v); __syncthreads();
    if ((threadIdx.x & 63) == 0) sh[threadIdx.x >> 6] = v; __syncthreads();
    float r = sh[0]; for (int i = 1; i < (int)(blockDim.x >> 6); ++i) r = fmaxf(r, sh[i]); return r;
}
__global__ void __launch_bounds__(256) nk_rmsnorm(const float* x, size_t ldx, const float* g, float* out, size_t ldo, int D) {
    __shared__ float sh[8];
    const float* xr = x + (size_t)blockIdx.x * ldx; float* orow = out + (size_t)blockIdx.x * ldo;
    float s = 0.f; for (int i = threadIdx.x; i < D; i += 256) { const float v = xr[i]; s += v * v; }
    s = blk_sum(s, sh); const float r = rsqrtf(s / (float)D + 1e-6f);
    for (int i = threadIdx.x; i < D; i += 256) orow[i] = xr[i] * r * g[i];
}
__global__ void __launch_bounds__(256) nk_gemm(const float* A, size_t lda, const float* B, size_t ldb, float* C, size_t ldc, const float* R, size_t ldr, int K) {
    __shared__ float As[16][68], Bs[16][68];
    const int tid = threadIdx.x, tx = tid & 15, ty = tid >> 4, m0 = blockIdx.y * 64, n0 = blockIdx.x * 64;
    float acc[4][4] = {};
    for (int k0 = 0; k0 < K; k0 += 16) {
        { const int r = tid >> 2, c = (tid & 3) * 4; const float4 v = *(const float4*)(A + (size_t)(m0 + r) * lda + k0 + c); As[c][r] = v.x; As[c + 1][r] = v.y; As[c + 2][r] = v.z; As[c + 3][r] = v.w; }
        { const int r = tid >> 4, c = (tid & 15) * 4; const float4 v = *(const float4*)(B + (size_t)(k0 + r) * ldb + n0 + c); Bs[r][c] = v.x; Bs[r][c + 1] = v.y; Bs[r][c + 2] = v.z; Bs[r][c + 3] = v.w; }
        __syncthreads();
#pragma unroll
        for (int k = 0; k < 16; ++k) { float a[4], b[4];
#pragma unroll
            for (int i = 0; i < 4; ++i) { a[i] = As[k][ty * 4 + i]; b[i] = Bs[k][tx * 4 + i]; }
#pragma unroll
            for (int i = 0; i < 4; ++i)
#pragma unroll
                for (int j = 0; j < 4; ++j) acc[i][j] += a[i] * b[j]; }
        __syncthreads();
    }
#pragma unroll
    for (int i = 0; i < 4; ++i)
#pragma unroll
        for (int j = 0; j < 4; ++j) { const size_t r = m0 + ty * 4 + i, c = n0 + tx * 4 + j; C[r * ldc + c] = acc[i][j] + (R ? R[r * ldr + c] : 0.f); }
}
__device__ __forceinline__ void rope_cs(int pos, int i, float& c, float& s) { const double f = pow(10000.0, -(double)i / 32.0); const double a = (double)pos * f; c = (float)cos(a); s = (float)sin(a); }
__global__ void __launch_bounds__(256) nk_z_post(float* Z, const int* pos) {
    float* z = Z + (size_t)blockIdx.x * 2880; const int t = threadIdx.x;
    if (t < 32) { float c, s; rope_cs(pos[blockIdx.x], t, c, s); const float x1 = z[768 + t], x2 = z[800 + t]; z[768 + t] = x1 * c - x2 * s; z[800 + t] = x2 * c + x1 * s; }
    for (int i = 832 + t; i < 2880; i += 256) z[i] = gelu_t(z[i]);
}
__global__ void __launch_bounds__(256) nk_q_rope(float* Q, const int* pos) {
    float* q = Q + (size_t)blockIdx.x * 1536; const int h = threadIdx.x >> 5, i = threadIdx.x & 31;
    float c, s; rope_cs(pos[blockIdx.x], i, c, s); float* p = q + h * 192 + 128; const float x1 = p[i], x2 = p[32 + i]; p[i] = x1 * c - x2 * s; p[32 + i] = x2 * c + x1 * s;
}
__global__ void __launch_bounds__(256) nk_ln_group(const float* Z, const float* gln, const float* bln, float* VLN) {
    const int wv = blockIdx.x * 4 + (threadIdx.x >> 6), lane = threadIdx.x & 63, row = wv >> 3, g = wv & 7;
    const float* v = Z + (size_t)row * 2880 + 1856 + g * 128; const float a = v[lane], b = v[lane + 64];
    const float mu = wave_sum(a + b) * (1.f / 128.f); const float da = a - mu, db = b - mu; const float var = wave_sum(da * da + db * db) * (1.f / 128.f); const float r = rsqrtf(var + 1e-6f);
    float* o = VLN + (size_t)row * 1024 + g * 128; o[lane] = da * r * gln[g * 128 + lane] + bln[g * 128 + lane]; o[lane + 64] = db * r * gln[g * 128 + lane + 64] + bln[g * 128 + lane + 64];
}
__global__ void __launch_bounds__(256) nk_sgu(const float* Z, const float* VLN, const float* ws, const float* bs, float* OS) {
    const size_t idx = (size_t)blockIdx.x * 256 + threadIdx.x; const int row = (int)(idx >> 10), col = (int)(idx & 1023), g = col >> 7, t = row & 127, r0 = row - t;
    const float* w = ws + ((size_t)g * 128 + t) * 128; float acc = 0.f;
    for (int s = 0; s <= t; ++s) acc += w[s] * VLN[(size_t)(r0 + s) * 1024 + col];
    OS[idx] = Z[(size_t)row * 2880 + 832 + col] * (acc + bs[g * 128 + t]);
}
__global__ void __launch_bounds__(256) nk_attn(const float* Q, const float* KV, const float* Z, float* O) {
    __shared__ float qs[192], sc[2048], sh[8], part[128];
    const int i = blockIdx.x, h = blockIdx.y, tid = threadIdx.x, lane = tid & 63, wv = tid >> 6;
    if (tid < 192) qs[tid] = Q[(size_t)i * 1536 + h * 192 + tid]; __syncthreads();
    const float scale = 0.07216878364870323f;
    for (int j = wv; j <= i; j += 4) { const float* kn = KV + (size_t)j * 2048 + h * 256; const float* kr = Z + (size_t)j * 2880 + 768;
        float p = qs[lane] * kn[lane] + qs[64 + lane] * kn[64 + lane] + qs[128 + lane] * kr[lane]; p = wave_sum(p); if (lane == 0) sc[j] = p * scale; }
    __syncthreads();
    float m = -INFINITY; for (int j = tid; j <= i; j += 256) m = fmaxf(m, sc[j]); m = blk_max(m, sh);
    float l = 0.f; for (int j = tid; j <= i; j += 256) { const float e = expf(sc[j] - m); sc[j] = e; l += e; } l = blk_sum(l, sh);
    const int d = tid & 127, half = tid >> 7; float acc = 0.f;
    for (int j = half; j <= i; j += 2) acc += sc[j] * KV[(size_t)j * 2048 + h * 256 + 128 + d];
    if (half) part[d] = acc; __syncthreads();
    if (!half) O[(size_t)i * 1024 + h * 128 + d] = (acc + part[d]) / l;
}
__global__ void __launch_bounds__(128) nk_topk(const float* QP, const float* k1, const float* k2, int* IDX, float* GATE) {
    __shared__ float q[256], s1[128], s2[128], cand[256], t1[16], t2[16]; __shared__ int i1[16], i2[16];
    const int row = blockIdx.x >> 3, h = blockIdx.x & 7, n = threadIdx.x;
    q[n] = QP[(size_t)row * 2048 + h * 256 + n]; q[n + 128] = QP[(size_t)row * 2048 + h * 256 + 128 + n]; __syncthreads();
    { const float* a = k1 + ((size_t)h * 128 + n) * 128; const float* b = k2 + ((size_t)h * 128 + n) * 128; float x = 0.f, y = 0.f;
      for (int d = 0; d < 128; ++d) { x += q[d] * a[d]; y += q[128 + d] * b[d]; } s1[n] = x; s2[n] = y; }
    __syncthreads();
    if (n == 0 || n == 64) { float* s = n ? s2 : s1; float* tv = n ? t2 : t1; int* ti = n ? i2 : i1;
        for (int r = 0; r < 16; ++r) { float best = -INFINITY; int bi = 0; for (int j = 0; j < 128; ++j) if (s[j] > best) { best = s[j]; bi = j; } tv[r] = best; ti[r] = bi; s[bi] = -INFINITY; } }
    __syncthreads();
    cand[n] = t1[n >> 4] + t2[n & 15]; cand[n + 128] = t1[(n + 128) >> 4] + t2[n & 15]; __syncthreads();
    if (n == 0) { float tv[16]; int te[16];
        for (int r = 0; r < 16; ++r) { float best = -INFINITY; int bi = 0; for (int j = 0; j < 256; ++j) if (cand[j] > best) { best = cand[j]; bi = j; } tv[r] = best; te[r] = i1[bi >> 4] * 128 + i2[bi & 15]; cand[bi] = -INFINITY; }
        float l = 0.f, e[16]; for (int r = 0; r < 16; ++r) { e[r] = expf(tv[r] - tv[0]); l += e[r]; }
        for (int r = 0; r < 16; ++r) { IDX[(size_t)row * 128 + h * 16 + r] = te[r]; GATE[(size_t)row * 128 + h * 16 + r] = e[r] / l; } }
}
__global__ void __launch_bounds__(256) nk_gather(float* H, const float* A2, const int* IDX, const float* GATE, const float* U, const float* V) {
    __shared__ float a[2048], red[4][2048];
    const int row = blockIdx.x, tid = threadIdx.x, lane = tid & 63, wv = tid >> 6;
    for (int i = tid; i < 2048; i += 256) a[i] = A2[(size_t)row * 2048 + i]; __syncthreads();
    float acc[32];
#pragma unroll
    for (int i = 0; i < 32; ++i) acc[i] = 0.f;
    for (int k = 0; k < 32; ++k) { const int j = wv * 32 + k; const int e = IDX[(size_t)row * 128 + j]; const float gt = GATE[(size_t)row * 128 + j];
        const float* u = U + (size_t)e * 2048; const float* v = V + (size_t)e * 2048; float p = 0.f;
#pragma unroll
        for (int i = 0; i < 32; ++i) p += u[lane + 64 * i] * a[lane + 64 * i];
        p = wave_sum(p); const float w = gt * gelu_t(p);
#pragma unroll
        for (int i = 0; i < 32; ++i) acc[i] += w * v[lane + 64 * i]; }
#pragma unroll
    for (int i = 0; i < 32; ++i) red[wv][lane + 64 * i] = acc[i];
    __syncthreads();
    for (int i = tid; i < 2048; i += 256) H[(size_t)row * 2048 + i] += red[0][i] + red[1][i] + red[2][i] + red[3][i];
}
__global__ void __launch_bounds__(256) nk_ple(const float* H2, const float* GL, const float* PP, float* out) {
    const size_t i = (size_t)blockIdx.x * 256 + threadIdx.x; out[i] = H2[i] + PP[i] / (1.f + expf(-GL[i]));
}
}
#define GAS __attribute__((address_space(1)))
#define LAS __attribute__((address_space(3)))
typedef unsigned short bf16;
typedef unsigned v4u __attribute__((ext_vector_type(4)));
typedef float f32x4 __attribute__((ext_vector_type(4)));
typedef short bf16x8 __attribute__((ext_vector_type(8)));
typedef GAS unsigned gu32;
typedef GAS unsigned long long gu64;
#define RLX_AGENT __ATOMIC_RELAXED, __HIP_MEMORY_SCOPE_AGENT
#define LDS_WAIT() asm volatile("s_waitcnt lgkmcnt(0)" ::: "memory")
#define VM_WAIT() asm volatile("s_waitcnt vmcnt(0)" ::: "memory")
__device__ __forceinline__ unsigned long long rt() { return __builtin_amdgcn_s_memrealtime(); }
__device__ __forceinline__ unsigned f2bf(float f) { unsigned u = __builtin_bit_cast(unsigned, f); return (u + 0x7fffu + ((u >> 16) & 1u)) >> 16; }
__device__ __forceinline__ unsigned pk2(float lo, float hi) { return f2bf(lo) | (f2bf(hi) << 16); }
#define XB_TMO      128
#define XB_XCNT(j)  (256  + 64 * (j))
#define XB_XSUB(j)  (1280 + 64 * (j))
#define XB_XGEN(j)  (2304 + 64 * (j))
#define XB_TOP      3328
#define XB_TOPGEN   3392
#define XCD_BAR_WORDS 3456
#define XB_SPIN_CAP (1u << 18)

__device__ __forceinline__ unsigned xb_ld(unsigned* p)              { return __hip_atomic_load(p, __ATOMIC_RELAXED, __HIP_MEMORY_SCOPE_AGENT); }
__device__ __forceinline__ unsigned xb_add(unsigned* p, unsigned v) { return __hip_atomic_fetch_add(p, v, __ATOMIC_RELAXED, __HIP_MEMORY_SCOPE_AGENT); }
__device__ __forceinline__ unsigned xb_xcc_id() { return (unsigned)__builtin_amdgcn_s_getreg((3 << 11) | 20) & 0xFu; }
#define XB_SPIN(cond, bar) do { unsigned _sp = 0; while (cond) { __builtin_amdgcn_s_sleep(1); \
    if ((++_sp & 255u) == 0u) { if (xb_ld(&(bar)[XB_TMO])) break; if (_sp > XB_SPIN_CAP) { atomicAdd(&(bar)[XB_TMO], 1u); break; } } } } while (0)

struct XcdBarrier {
    unsigned* bar; unsigned x;
    volatile LAS unsigned* st;
};

__device__ __forceinline__ int lane_id() { int r; asm volatile("v_mbcnt_lo_u32_b32 %0, -1, 0\n\tv_mbcnt_hi_u32_b32 %0, -1, %0" : "=v"(r)); return r; }
__device__ __forceinline__ XcdBarrier xcd_barrier_post(unsigned* bar, volatile LAS unsigned* st, int wid) {
    XcdBarrier b; b.bar = bar; b.x = xb_xcc_id(); b.st = st;
    if (wid == 0 && lane_id() == 0) (void)xb_add(&bar[XB_XCNT(b.x)], 1u);
    return b;
}
__device__ __forceinline__ void xcd_barrier_complete(unsigned* bar, unsigned x, unsigned& nloc, unsigned& nx) {
    const unsigned G = gridDim.x * gridDim.y * gridDim.z;
    unsigned sum, cnt, mine, sp = 0u;
    for (;;) {
        sum = 0u; cnt = 0u; mine = 0u;
#pragma unroll
        for (unsigned j = 0; j < 16; ++j) { const unsigned c = xb_ld(&bar[XB_XCNT(j)]); sum += c; cnt += (c > 0u) ? 1u : 0u; mine = (j == x) ? c : mine; }
        if (sum == G) break;
        __builtin_amdgcn_s_sleep(1);
        if ((++sp & 255u) == 0u) { if (xb_ld(&bar[XB_TMO])) break; if (sp > XB_SPIN_CAP) { atomicAdd(&bar[XB_TMO], 1u); break; } }
    }
    nloc = mine > 0u ? mine : 1u; nx = cnt > 0u ? cnt : 1u;
}

__device__ __forceinline__ void xcd_barrier(const XcdBarrier& b, int wid) {
    asm volatile("s_waitcnt vmcnt(0)" ::: "memory");
    __syncthreads();
    if (wid == 0 && lane_id() == 0) {
        unsigned* bar = b.bar;
        __builtin_amdgcn_s_waitcnt(0);
        unsigned nloc = b.st[0], nx = b.st[1];
        if (nloc == 0u) { xcd_barrier_complete(bar, b.x, nloc, nx); b.st[0] = nloc; b.st[1] = nx; }
        const unsigned old = xb_add(&bar[XB_XSUB(b.x)], 1u);
        const unsigned gen = old / nloc;
        if (old + 1u == (gen + 1u) * nloc) {
            __builtin_amdgcn_fence(__ATOMIC_RELEASE, "agent");
            asm volatile("s_waitcnt vmcnt(0)" ::: "memory");
            const unsigned og = xb_add(&bar[XB_TOP], 1u);
            const unsigned tg = og / nx;
            if (og + 1u == (tg + 1u) * nx) xb_add(&bar[XB_TOPGEN], 1u);
            else XB_SPIN(xb_ld(&bar[XB_TOPGEN]) == tg, bar);
            __builtin_amdgcn_fence(__ATOMIC_ACQUIRE, "agent");
            xb_add(&bar[XB_XGEN(b.x)], 1u);
            asm volatile("s_waitcnt vmcnt(0)" ::: "memory");
        } else {
            XB_SPIN(xb_ld(&bar[XB_XGEN(b.x)]) == gen, bar);
            __builtin_amdgcn_fence(__ATOMIC_ACQUIRE, "agent");
            asm volatile("s_waitcnt vmcnt(0)" ::: "memory");
        }
    }
    __syncthreads();
}
namespace pg8 {
#define PG8_LAS __attribute__((address_space(3)))
typedef unsigned short bf16_t;
typedef short bf16x8 __attribute__((ext_vector_type(8)));
typedef float f32x4 __attribute__((ext_vector_type(4)));
typedef unsigned u32x4 __attribute__((ext_vector_type(4)));
constexpr int BM = 256, BK = 64, HALF = 128, HTB = HALF * BK * 2  , STAGE_BYTES = 8 * HTB, NXCD = 8, WGM = 8;

__host__ __device__ __forceinline__ int lds_byte(int r, int c) { const int st = (r >> 4) * 2 + (c >> 5), rr = r & 15, cc = c & 31, ob = rr * 64 + cc * 2; return st * 1024 + (ob ^ (((ob >> 9) & 1) << 5)); }
__host__ __device__ __forceinline__ void stage_rc(int b, int& R, int& C) { const int st = b / 1024, sb = b % 1024, swz = sb ^ (((sb >> 9) & 1) << 5); R = (st >> 1) * 16 + swz / 64; C = (st & 1) * 32 + (swz % 64) / 2; }
__host__ __device__ __forceinline__ int perm32(int rho) { const int n = rho >> 4, i = rho & 15; return 8 * (i >> 2) + 4 * n + (i & 3); }

struct Unit { int pm, pn; };
struct Gemm { const bf16_t* A; const bf16_t* Bt; int M, N, K; };

struct StaticOrder {
    int nM, nN, nwg, G, c;
    __host__ __device__ void init(int M, int N, int G_, int c_) { nM = M / BM; nN = N / BM; nwg = nM * nN; G = G_; c = c_; }
    __host__ __device__ bool next(int i, Unit& u) const {
        const long L = (long)i * G + c; if (L >= nwg) return false;
        int wgid = (int)L; { const int q = nwg / NXCD, r = nwg % NXCD, xcd = wgid % NXCD, off = wgid / NXCD; wgid = (xcd < r ? xcd * (q + 1) : r * (q + 1) + (xcd - r) * q) + off; }
        const int nig = WGM * nN, gid = wgid / nig, fm = gid * WGM, gsz = (nM - fm) < WGM ? (nM - fm) : WGM;
        u.pm = fm + ((wgid % nig) % gsz); u.pn = (wgid % nig) / gsz; return true;
    }
    __device__ __forceinline__ void a_ready(const Unit&) const {}
    __device__ __forceinline__ void done(const Unit&) const {}
};

__device__ __forceinline__ unsigned cvt_pk_bf16(float lo, float hi) { unsigned r; asm volatile("v_cvt_pk_bf16_f32 %0, %1, %2" : "=v"(r) : "v"(lo), "v"(hi)); return r; }
typedef float f32x2 __attribute__((ext_vector_type(2)));
template <class Epi, class Sched, bool ALIGN_EPI = false, bool SP2 = false>
__device__ __forceinline__ void gemm_phase(PG8_LAS unsigned char* lds, const Gemm g, const Sched& S, const Epi& E, const int wid) {
    const int lane = ::lane_id(), tid = wid * 64 + lane, wr = wid >> 2, wc = wid & 3, fr = lane & 15, fq = lane >> 4;
    const int K = g.K, nt = K / BK;
    unsigned voffA[2], voffB[2];
#pragma unroll
    for (int i = 0; i < 2; ++i) { int R, C; stage_rc(tid * 16 + i * 8192, R, C); const int Rb = Epi::PERM ? ((R & ~31) + perm32(R & 31)) : R;
        voffA[i] = (unsigned)(R * K + C) * 2u; voffB[i] = (unsigned)(Rb * K + C) * 2u; }
    const size_t kstep = (size_t)(BK * 2);
    const size_t hstep = (size_t)HALF * K * 2;
    const size_t tstep = 2 * hstep;
    const unsigned ldsw = (unsigned)wid * 1024u;
    const int aoff = lds_byte(wr * 64 + fr, fq * 8), boff = lds_byte(wc * 32 + fr, fq * 8);
#define PG8_SA(b, h) (((b) * 2 + (h)) * HTB)
#define PG8_SB(b, h) ((4 + (b) * 2 + (h)) * HTB)
#define PG8_STAGE(bufoff, gbase, voff) do { _Pragma("unroll") for (int _i = 0; _i < 2; ++_i) \
        __builtin_amdgcn_global_load_lds((const unsigned*)((const char*)(gbase) + (voff)[_i]), (PG8_LAS unsigned*)(lds + (bufoff) + ldsw + _i * 8192), 16, 0, 0); } while (0)
#define PG8_LDA(dst, b, h) do { _Pragma("unroll") for (int m = 0; m < 4; ++m) _Pragma("unroll") for (int k = 0; k < 2; ++k) dst[m][k] = *(const PG8_LAS bf16x8*)(lds + PG8_SA(b, h) + aoff + m * 2048 + k * 1024); } while (0)
#define PG8_LDB(dst, b, h) do { _Pragma("unroll") for (int n = 0; n < 2; ++n) _Pragma("unroll") for (int k = 0; k < 2; ++k) dst[n][k] = *(const PG8_LAS bf16x8*)(lds + PG8_SB(b, h) + boff + n * 2048 + k * 1024); } while (0)
#define PG8_MMA(ai, bj, At, Bt) do { __builtin_amdgcn_s_setprio(1); _Pragma("unroll") for (int m = 0; m < 4; ++m) _Pragma("unroll") for (int n = 0; n < 2; ++n) _Pragma("unroll") for (int k = 0; k < 2; ++k) \
        acc[ai][bj][m][n] = __builtin_amdgcn_mfma_f32_16x16x32_bf16(Bt[n][k], At[m][k], acc[ai][bj][m][n], 0, 0, 0); __builtin_amdgcn_s_setprio(0); } while (0)
#define PG8_WAIT_V(n) asm volatile("s_waitcnt vmcnt(" #n ")" ::: "memory")
#define PG8_WAIT_L(n) asm volatile("s_waitcnt lgkmcnt(" #n ")" ::: "memory")
#define PG8_BAR __builtin_amdgcn_s_barrier()
#define PG8_SCHED __builtin_amdgcn_sched_barrier(0)
    Unit cur, nxt; int ui = 0;
    if (!S.next(0, cur)) return;
    f32x4 acc[2][2][4][2];
#pragma unroll
    for (int a = 0; a < 2; ++a)
#pragma unroll
        for (int b = 0; b < 2; ++b)
#pragma unroll
            for (int m = 0; m < 4; ++m)
#pragma unroll
                for (int n = 0; n < 2; ++n) acc[a][b][m][n] = (f32x4){0.f, 0.f, 0.f, 0.f};
    bf16x8 At[4][2], B0[2][2], B1[2][2];
    const char* cA = (const char*)g.A + (size_t)cur.pm * tstep; const char* cB = (const char*)g.Bt + (size_t)cur.pn * tstep;
    S.a_ready(cur);
    if constexpr (SP2) {
        PG8_STAGE(PG8_SB(0, 0), cB, voffB); PG8_STAGE(PG8_SB(0, 1), cB + hstep, voffB); PG8_STAGE(PG8_SA(0, 0), cA, voffA); PG8_STAGE(PG8_SA(0, 1), cA + hstep, voffA);
        if (wr == 1) PG8_BAR;
        PG8_WAIT_V(2); PG8_BAR;
        PG8_STAGE(PG8_SB(1, 0), cB + kstep, voffB); PG8_STAGE(PG8_SA(1, 0), cA + kstep, voffA); PG8_STAGE(PG8_SB(1, 1), cB + hstep + kstep, voffB);
        PG8_WAIT_V(6); PG8_BAR;
    } else {
        PG8_STAGE(PG8_SB(0, 0), cB, voffB); PG8_STAGE(PG8_SA(0, 0), cA, voffA); PG8_STAGE(PG8_SB(0, 1), cB + hstep, voffB); PG8_STAGE(PG8_SA(0, 1), cA + hstep, voffA);
        if (wr == 1) PG8_BAR;
        PG8_WAIT_V(4); PG8_BAR;
        PG8_STAGE(PG8_SB(1, 0), cB + kstep, voffB); PG8_STAGE(PG8_SA(1, 0), cA + kstep, voffA); PG8_STAGE(PG8_SB(1, 1), cB + hstep + kstep, voffB);
        PG8_WAIT_V(6); PG8_BAR;
    }
    for (;;) {
        const bool has_next = S.next(ui + 1, nxt);
        const char* nA = has_next ? (const char*)g.A + (size_t)nxt.pm * tstep : cA; const char* nB = has_next ? (const char*)g.Bt + (size_t)nxt.pn * tstep : cB;
        for (int t = 0; t < nt; t += 2) {
            if constexpr (Epi::MID) { if (t == (nt >> 1)) E.mid(acc, cur, wr, wc, fr, fq); }
            const bool last = (t == nt - 2);
            const char* a1 = cA + (size_t)(t + 1) * kstep;
            const char* a2 = last ? nA : cA + (size_t)(t + 2) * kstep; const char* b2 = last ? nB : cB + (size_t)(t + 2) * kstep;
            const char* a3 = a2 + kstep; const char* b3 = b2 + kstep;
            if (last && has_next) S.a_ready(nxt);
            if constexpr (SP2) {
            PG8_LDB(B0, 0, 0); PG8_LDB(B1, 0, 1); PG8_SCHED; PG8_LDA(At, 0, 0); PG8_STAGE(PG8_SA(1, 1), a1 + hstep, voffA);
            PG8_WAIT_V(8); PG8_WAIT_L(0); PG8_BAR; PG8_MMA(0, 0, At, B0); PG8_MMA(0, 1, At, B1); PG8_BAR; PG8_SCHED;
            PG8_LDA(At, 0, 1); PG8_STAGE(PG8_SB(0, 0), b2, voffB); PG8_STAGE(PG8_SB(0, 1), b2 + hstep, voffB); PG8_STAGE(PG8_SA(0, 0), a2, voffA);
            PG8_WAIT_V(8); PG8_WAIT_L(0); PG8_BAR; PG8_MMA(1, 0, At, B0); PG8_MMA(1, 1, At, B1); PG8_BAR; PG8_SCHED;
            PG8_LDB(B0, 1, 0); PG8_LDB(B1, 1, 1); PG8_SCHED; PG8_LDA(At, 1, 0); PG8_STAGE(PG8_SA(0, 1), a2 + hstep, voffA);
            PG8_WAIT_V(8); PG8_WAIT_L(0); PG8_BAR; PG8_MMA(0, 0, At, B0); PG8_MMA(0, 1, At, B1); PG8_BAR; PG8_SCHED;
            PG8_LDA(At, 1, 1); PG8_STAGE(PG8_SB(1, 0), b3, voffB); PG8_STAGE(PG8_SB(1, 1), b3 + hstep, voffB); PG8_STAGE(PG8_SA(1, 0), a3, voffA);
            PG8_WAIT_V(8); PG8_WAIT_L(0); PG8_BAR; PG8_MMA(1, 0, At, B0); PG8_MMA(1, 1, At, B1); PG8_BAR; PG8_SCHED;
            } else {
            PG8_LDB(B0, 0, 0); PG8_SCHED; PG8_LDA(At, 0, 0); PG8_STAGE(PG8_SA(1, 1), a1 + hstep, voffA);
            PG8_WAIT_L(8); PG8_BAR; PG8_WAIT_L(0); PG8_MMA(0, 0, At, B0); PG8_BAR; PG8_SCHED;
            PG8_LDB(B1, 0, 1); PG8_STAGE(PG8_SB(0, 0), b2, voffB);
            PG8_BAR; PG8_WAIT_L(0); PG8_MMA(0, 1, At, B1); PG8_BAR;
            PG8_LDA(At, 0, 1); PG8_STAGE(PG8_SA(0, 0), a2, voffA);
            PG8_BAR; PG8_WAIT_L(0); PG8_MMA(1, 0, At, B0); PG8_BAR; PG8_SCHED;
            PG8_STAGE(PG8_SB(0, 1), b2 + hstep, voffB);
            PG8_WAIT_V(6); PG8_BAR; PG8_MMA(1, 1, At, B1); PG8_BAR;
            PG8_LDB(B0, 1, 0); PG8_SCHED; PG8_LDA(At, 1, 0); PG8_STAGE(PG8_SA(0, 1), a2 + hstep, voffA);
            PG8_WAIT_L(8); PG8_BAR; PG8_WAIT_L(0); PG8_MMA(0, 0, At, B0); PG8_BAR; PG8_SCHED;
            PG8_LDB(B1, 1, 1); PG8_STAGE(PG8_SB(1, 0), b3, voffB);
            PG8_BAR; PG8_WAIT_L(0); PG8_MMA(0, 1, At, B1); PG8_BAR;
            PG8_LDA(At, 1, 1); PG8_STAGE(PG8_SA(1, 0), a3, voffA);
            PG8_BAR; PG8_WAIT_L(0); PG8_MMA(1, 0, At, B0); PG8_BAR; PG8_SCHED;
            PG8_STAGE(PG8_SB(1, 1), b3 + hstep, voffB);
            PG8_WAIT_V(6); PG8_BAR; PG8_MMA(1, 1, At, B1); PG8_BAR;
            }
        }
        if constexpr (ALIGN_EPI) { if (wr == 0) PG8_BAR; }
        if constexpr (!Epi::AFTER_DRAIN) { E(acc, cur, wr, wc, fr, fq); S.done(cur); }
        if (!has_next) break;
#pragma unroll
        for (int a = 0; a < 2; ++a)
#pragma unroll
            for (int b = 0; b < 2; ++b)
#pragma unroll
                for (int m = 0; m < 4; ++m)
#pragma unroll
                    for (int n = 0; n < 2; ++n) acc[a][b][m][n] = (f32x4){0.f, 0.f, 0.f, 0.f};
        cur = nxt; cA = nA; cB = nB; ++ui;
        if constexpr (ALIGN_EPI) { if (wr == 1) PG8_BAR; }
    }
    PG8_WAIT_V(0);
    if constexpr (!ALIGN_EPI) { if (wr == 0) PG8_BAR; }
    PG8_BAR;
    if constexpr (Epi::AFTER_DRAIN) { E.fused(acc, cur, wr, wc, fr, fq, lds, wid, lane); S.done(cur); }
#undef PG8_SA
#undef PG8_SB
#undef PG8_STAGE
#undef PG8_LDA
#undef PG8_LDB
#undef PG8_MMA
#undef PG8_WAIT_V
#undef PG8_WAIT_L
#undef PG8_BAR
#undef PG8_SCHED
}
}
constexpr int NWAVES = 8;
constexpr int RING_OFF = 0, RING_BYTES = 131072, TAB_OFF = RING_BYTES, TAB_BYTES = 8192, LDSCTL_OFF = TAB_OFF + TAB_BYTES, MISC_OFF = LDSCTL_OFF + 320, LDS_BYTES = 147456;
static_assert(MISC_OFF + 128 <= LDS_BYTES, "LDS map");
constexpr int CW_TMO = 0, CW_CODE = 1, CW_BAR = 4096;
constexpr size_t CTL_ZERO_BYTES = 64 * 1024;
constexpr float QK_C2 = 0.07216878364870323f * 1.4426950408889634f;
typedef float f32x2v __attribute__((ext_vector_type(2)));
typedef unsigned u32x2v __attribute__((ext_vector_type(2)));
__device__ __forceinline__ float bf2f(unsigned short b) { return __uint_as_float((unsigned)b << 16); }
__device__ __forceinline__ float gelu_f(float x) { const float u = 1.5957691216057308f * (x + 0.044715f * x * x * x); return x * __builtin_amdgcn_rcpf(1.f + __builtin_amdgcn_exp2f(-1.4426950408889634f * u)); }
__device__ __forceinline__ float wave_sum64(float v) {
#pragma unroll
    for (int o = 1; o < 64; o <<= 1) v += __shfl_xor(v, o);
    return v;
}
struct Args { const void* in[26]; float* out; unsigned char* ws; int ph_lo, ph_hi; };
struct Frame { LAS unsigned char* lds; volatile LAS unsigned* MISC; gu32* ctl; int tid, lane, wave, vcu, G; };

__device__ __forceinline__ int rope_pc(int lr) { const int nn = lr >> 5, i = lr & 31, c5 = i >> 4, f = i & 15; return 32 * c5 + 8 * (f >> 2) + 4 * nn + (f & 3); }
__device__ __forceinline__ int map_win(int n) { if (n < 768) return n; if (n < 832) return 2816 + rope_pc(n - 768); if (n < 1856) return 768 + (n - 832); return 1792 + (n - 1856); }
__device__ __forceinline__ int map_wuq(int n) { const int h = n / 192, lc = n - h * 192; return lc < 128 ? n : h * 192 + 128 + rope_pc(lc - 128); }
__device__ __forceinline__ int map_id(int n) { return n; }

template <class MapF, class ScaleF>
__device__ __forceinline__ void p0_transpose_item(const float* W, int K, int N, bf16* WT, LAS float* scr, int item, int lane, MapF mapf, ScaleF ks) {
    const int nblk = N / 32, kb = item / nblk, nb = item % nblk, k0 = 64 * kb, n0 = 32 * nb;
#pragma unroll 8
    for (int i = 0; i < 32; ++i) { const int kk = 2 * i + (lane >> 5); scr[kk * 33 + (lane & 31)] = W[(size_t)(k0 + kk) * N + n0 + (lane & 31)] * ks(k0 + kk); }
    LDS_WAIT(); asm volatile("" ::: "memory");
    const int c = lane & 7;
#pragma unroll
    for (int j = 0; j < 4; ++j) { const int n = (lane >> 3) + 8 * j; const LAS float* s = scr + (8 * c) * 33 + n;
        v4u o; o.x = pk2(s[0 * 33], s[1 * 33]); o.y = pk2(s[2 * 33], s[3 * 33]); o.z = pk2(s[4 * 33], s[5 * 33]); o.w = pk2(s[6 * 33], s[7 * 33]);
        *(GAS v4u*)(WT + (size_t)mapf(n0 + n) * K + k0 + 8 * c) = o; }
    LDS_WAIT(); asm volatile("" ::: "memory");
}
template <class ScaleF>
__device__ __forceinline__ void p0_cvt512(const float* src, bf16* dst, size_t e0, int lane, ScaleF sf) {
    const size_t e = e0 + (size_t)lane * 8; const f32x4 a = *(const GAS f32x4*)(src + e), b = *(const GAS f32x4*)(src + e + 4);
    v4u o; o.x = pk2(a.x * sf(e), a.y * sf(e + 1)); o.y = pk2(a.z * sf(e + 2), a.w * sf(e + 3)); o.z = pk2(b.x * sf(e + 4), b.y * sf(e + 5)); o.w = pk2(b.z * sf(e + 6), b.w * sf(e + 7));
    *(GAS v4u*)(dst + e) = o;
}
__device__ __forceinline__ void p0_prologue(const Args& A, Frame& F) {
    unsigned char* ws = A.ws;
    const float* x = (const float*)A.in[0]; const float* p = (const float*)A.in[1]; const int* pos = (const int*)A.in[2];
    const float *g_mix = (const float*)A.in[3], *w_in = (const float*)A.in[4], *g_cq = (const float*)A.in[5], *w_uq = (const float*)A.in[6], *g_ckv = (const float*)A.in[7], *w_ukv = (const float*)A.in[8];
    const float *w_sgu = (const float*)A.in[11], *g_oa = (const float*)A.in[13], *g_os = (const float*)A.in[14], *w_out = (const float*)A.in[15], *g_ffn = (const float*)A.in[16], *w_pq = (const float*)A.in[17];
    const float *k1 = (const float*)A.in[18], *k2 = (const float*)A.in[19], *pu = (const float*)A.in[20], *pv = (const float*)A.in[21], *g_ple = (const float*)A.in[22], *w_pg = (const float*)A.in[23], *w_pp = (const float*)A.in[24];
    LAS float* scr = (LAS float*)(F.lds + RING_OFF + F.wave * 16384);
    const int gw = F.vcu * NWAVES + F.wave, NGW = F.G * NWAVES, lane = F.lane;
    for (int m = gw; m < T_TOK; m += NGW) {
        const GAS f32x4* xr = (const GAS f32x4*)(x + (size_t)m * DM) + lane; f32x4 v[8]; float s = 0.f;
#pragma unroll
        for (int j = 0; j < 8; ++j) { v[j] = xr[64 * j]; s += (v[j].x * v[j].x + v[j].y * v[j].y) + (v[j].z * v[j].z + v[j].w * v[j].w); }
        s = wave_sum64(s); if (lane == 0) ((float*)(ws + WS_RSX))[m] = 1.0f / sqrtf(s * (1.f / DM) + 1e-6f);
        GAS u32x2v* o8 = (GAS u32x2v*)((bf16*)(ws + WS_R1) + (size_t)m * DM) + lane;
#pragma unroll
        for (int j = 0; j < 8; ++j) o8[64 * j] = (u32x2v){pk2(v[j].x, v[j].y), pk2(v[j].z, v[j].w)};
        const f32x4 pvv = *((const GAS f32x4*)(p + (size_t)m * 256) + lane);
        *((GAS u32x2v*)((bf16*)(ws + WS_PB) + (size_t)m * 256) + lane) = (u32x2v){pk2(pvv.x, pvv.y), pk2(pvv.z, pvv.w)};
    }
    for (int it = gw; it < T_TOK * 32 / 64; it += NGW) { const int idx = it * 64 + lane, row = idx >> 5, i = idx & 31;
        const double f = exp2((double)i * (-13.287712379549449 / 32.0)); const double a = (double)pos[row] * f;
        ((f32x2v*)(ws + WS_CS))[idx] = (f32x2v){(float)cos(a), (float)sin(a)}; }
    constexpr int I_IN = 32 * 90, I_UQ = 8 * 48, I_UKV = 4 * 64, I_SQ = 32 * 64, I_PP = 4 * 64;
    constexpr int NITEMS = I_IN + I_UQ + I_UKV + 3 * I_SQ + I_PP;
    for (int it = gw; it < NITEMS; it += NGW) {
        int r = it;
        if (r < I_IN) { p0_transpose_item(w_in, 2048, 2880, (bf16*)(ws + WS_WT_IN), scr, r, lane, [](int n) { return map_win(n); }, [=](int k) { return g_mix[k]; }); continue; } r -= I_IN;
        if (r < I_UQ) { p0_transpose_item(w_uq, 512, 1536, (bf16*)(ws + WS_WT_UQ), scr, r, lane, [](int n) { return map_wuq(n); }, [=](int k) { return g_cq[k] * QK_C2; }); continue; } r -= I_UQ;
        if (r < I_UKV) { p0_transpose_item(w_ukv, 256, 2048, (bf16*)(ws + WS_WT_UKV), scr, r, lane, [](int n) { return n; }, [=](int k) { return g_ckv[k]; }); continue; } r -= I_UKV;
        if (r < I_SQ) { p0_transpose_item(w_out, 2048, 2048, (bf16*)(ws + WS_WT_OUT), scr, r, lane, [](int n) { return n; }, [=](int k) { return k < 1024 ? g_oa[k] : g_os[k - 1024]; }); continue; } r -= I_SQ;
        if (r < I_SQ) { p0_transpose_item(w_pq, 2048, 2048, (bf16*)(ws + WS_WT_PQ), scr, r, lane, [](int n) { return n; }, [=](int k) { return g_ffn[k]; }); continue; } r -= I_SQ;
        if (r < I_SQ) { p0_transpose_item(w_pg, 2048, 2048, (bf16*)(ws + WS_WT_PG), scr, r, lane, [](int n) { return n; }, [=](int k) { return g_ple[k]; }); continue; } r -= I_SQ;
        p0_transpose_item(w_pp, 256, 2048, (bf16*)(ws + WS_WT_PP), scr, r, lane, [](int n) { return n; }, [](int) { return 1.f; });
    }
    for (int it = gw; it < 192 * 2048 / 512; it += NGW) *(GAS v4u*)((bf16*)(ws + WS_WT_IN) + (size_t)2880 * 2048 + (size_t)it * 512 + lane * 8) = (v4u){0u, 0u, 0u, 0u};
    for (int it = gw; it < 3 * 256; it += NGW) { const int w = it >> 8, c = it & 255;
        if (w == 0) p0_cvt512(k1, (bf16*)(ws + WS_K1B), (size_t)c * 512, lane, [](size_t) { return 1.f; });
        else if (w == 1) p0_cvt512(k2, (bf16*)(ws + WS_K2B), (size_t)c * 512, lane, [](size_t) { return 1.f; });
        else p0_cvt512(w_sgu, (bf16*)(ws + WS_WSGU), (size_t)c * 512, lane, [](size_t e) { const int s = (int)(e & 127), t = (int)((e >> 7) & 127); return s <= t ? 1.f : 0.f; }); }
#if CUT >= 7
    { LAS float* rowb = (LAS float*)(F.lds + RING_OFF + F.wave * 16384);
      for (int it = gw; it < 2 * 16384; it += NGW) { const int w = it >= 16384, row = w ? it - 16384 : it; const float* src = (w ? pv : pu) + (size_t)row * 2048;
        if (w ? !V_FP6 : !U_FP6) continue;
#pragma unroll
        for (int q = 0; q < 8; ++q) { const int e = 256 * q + 4 * lane; f32x4 x = *(const GAS f32x4*)(src + e);
            if (!w) x = x * *(const GAS f32x4*)(g_ffn + e) * 64.f; else x = x * 4.f;
#pragma unroll
            for (int c = 0; c < 4; ++c) rowb[(e + c) + ((e + c) >> 5)] = x[c]; }
        LDS_WAIT(); asm volatile("" ::: "memory");
        unsigned dw[6];
        if (!w) {
            typedef float v16f_ __attribute__((ext_vector_type(16))); typedef unsigned v6u_ __attribute__((ext_vector_type(6))); v16f_ x0, x1;
#pragma unroll
            for (int i = 0; i < 16; ++i) { x0[i] = rowb[33 * lane + i]; x1[i] = rowb[33 * lane + 16 + i]; }
            v6u_ pk; asm("v_cvt_scalef32_2xpk16_fp6_f32 %0, %1, %2, 1.0" : "=&v"(pk) : "v"(x0), "v"(x1));
#pragma unroll
            for (int i = 0; i < 6; ++i) dw[i] = pk[i];
        } else {
            unsigned long long acc = 0ull; int nb = 0; int k = 0;
#pragma unroll
            for (int i = 0; i < 32; ++i) { const float v = rowb[33 * lane + i]; const float m = fminf(fabsf(v), 7.5f);
                const float c = m < 2.f ? rintf(8.f * m) : m < 4.f ? rintf(4.f * m) + 8.f : rintf(2.f * m) + 16.f;
                const unsigned code = (unsigned)c | (v < 0.f ? 32u : 0u);
                acc |= (unsigned long long)code << nb; nb += 6;
                if (nb >= 32) { dw[k++] = (unsigned)acc; acc >>= 32; nb -= 32; } } }
        unsigned char* dst = ws + (w ? WS_VB : WS_UB) + (size_t)row * 1536;
        *(GAS v4u*)(dst + 16 * lane) = (v4u){dw[0], dw[1], dw[2], dw[3]}; *(GAS u32x2v*)(dst + 1024 + 8 * lane) = (u32x2v){dw[4], dw[5]};
        LDS_WAIT(); asm volatile("" ::: "memory"); } }
    for (int it = gw; it < 2 * 16384 * 2; it += NGW) { const int w = it >= 16384 * 2, c = w ? it - 16384 * 2 : it; const float* src = (w ? pv : pu) + (size_t)c * 1024 + lane * 16; const int d0 = (c & 1) * 1024 + lane * 16;
        if (w ? V_FP6 : U_FP6) continue;
        f32x4 x[4];
#pragma unroll
        for (int q = 0; q < 4; ++q) x[q] = *(const GAS f32x4*)(src + 4 * q);
        if (!w) {
#pragma unroll
            for (int q = 0; q < 4; ++q) x[q] = x[q] * *(const GAS f32x4*)(g_ffn + d0 + 4 * q) * 256.f; }
        else {
#pragma unroll
            for (int q = 0; q < 4; ++q) x[q] = x[q] * 16.f; }
        v4u o; int t;
        t = 0; t = __builtin_amdgcn_cvt_pk_fp8_f32(x[0][0], x[0][1], t, false); t = __builtin_amdgcn_cvt_pk_fp8_f32(x[0][2], x[0][3], t, true); o.x = (unsigned)t;
        t = 0; t = __builtin_amdgcn_cvt_pk_fp8_f32(x[1][0], x[1][1], t, false); t = __builtin_amdgcn_cvt_pk_fp8_f32(x[1][2], x[1][3], t, true); o.y = (unsigned)t;
        t = 0; t = __builtin_amdgcn_cvt_pk_fp8_f32(x[2][0], x[2][1], t, false); t = __builtin_amdgcn_cvt_pk_fp8_f32(x[2][2], x[2][3], t, true); o.z = (unsigned)t;
        t = 0; t = __builtin_amdgcn_cvt_pk_fp8_f32(x[3][0], x[3][1], t, false); t = __builtin_amdgcn_cvt_pk_fp8_f32(x[3][2], x[3][3], t, true); o.w = (unsigned)t;
        *(GAS v4u*)((unsigned char*)(ws + (w ? WS_VB : WS_UB)) + (size_t)c * 1024 + lane * 16) = o; }
#endif
}

__device__ __forceinline__ v4u pack8(f32x4 a, f32x4 b) { v4u w; w.x = pg8::cvt_pk_bf16(a[0], a[1]); w.y = pg8::cvt_pk_bf16(a[2], a[3]); w.z = pg8::cvt_pk_bf16(b[0], b[1]); w.w = pg8::cvt_pk_bf16(b[2], b[3]); return w; }
__device__ __forceinline__ float sq8(f32x4 a, f32x4 b) { return ((a[0] * a[0] + a[1] * a[1]) + (a[2] * a[2] + a[3] * a[3])) + ((b[0] * b[0] + b[1] * b[1]) + (b[2] * b[2] + b[3] * b[3])); }
__device__ __forceinline__ float fq_sum(float v) { v += __shfl_xor(v, 16); v += __shfl_xor(v, 32); return v; }
#define EPI_ROWS_BEGIN _Pragma("unroll") for (int ai = 0; ai < 2; ++ai) _Pragma("unroll") for (int m = 0; m < 4; ++m) { const int row = u.pm * 256 + ai * 128 + wr * 64 + m * 16 + fr;
#define EPI_ROWS_END }

struct EpiG1 {
    static constexpr bool PERM = true, AFTER_DRAIN = false, MID = false;
    const float* rsx; bf16 *CQ, *CKV, *KR, *UG, *VG; float *pscq, *psckv; f32x2v* psv; const f32x2v* cs;
    __device__ __forceinline__ void operator()(const f32x4 (&acc)[2][2][4][2], const pg8::Unit& u, int wr, int wc, int fr, int fq) const {
        const int pn = u.pn;
        EPI_ROWS_BEGIN
            const float rs = rsx[row];
#pragma unroll
            for (int bj = 0; bj < 2; ++bj) { f32x4 v0 = acc[ai][bj][m][0] * rs, v1 = acc[ai][bj][m][1] * rs; const int lc = bj * 128 + wc * 32 + fq * 8;
                if (pn <= 2) { const float ss = fq_sum(sq8(v0, v1));
                    if (pn < 2) { *(GAS v4u*)(CQ + (size_t)row * 512 + pn * 256 + lc) = pack8(v0, v1); if (fq == 0) pscq[row * 16 + (pn * 2 + bj) * 4 + wc] = ss; }
                    else { *(GAS v4u*)(CKV + (size_t)row * 256 + lc) = pack8(v0, v1); if (fq == 0) psckv[row * 8 + bj * 4 + wc] = ss; } }
                else if (pn <= 10) {
#pragma unroll
                    for (int e = 0; e < 4; ++e) { v0[e] = gelu_f(v0[e]); v1[e] = gelu_f(v1[e]); }
                    if (pn <= 6) *(GAS v4u*)(UG + (size_t)row * 1024 + (pn - 3) * 256 + lc) = pack8(v0, v1);
                    else { const float s = fq_sum(((v0[0] + v0[1]) + (v0[2] + v0[3])) + ((v1[0] + v1[1]) + (v1[2] + v1[3]))), q = fq_sum(sq8(v0, v1));
                        *(GAS v4u*)(VG + (size_t)row * 1024 + (pn - 7) * 256 + lc) = pack8(v0, v1); if (fq == 0) psv[(row * 8 + (pn - 7) * 2 + bj) * 4 + wc] = (f32x2v){s, q}; } }
                else if (bj == 0 && wc < 2) { f32x4 o0, o1;
#pragma unroll
                    for (int e = 0; e < 4; ++e) { const f32x2v c = cs[row * 32 + 16 * wc + 4 * fq + e]; o0[e] = v0[e] * c.x - v1[e] * c.y; o1[e] = v1[e] * c.x + v0[e] * c.y; }
                    *(GAS v4u*)(KR + (size_t)row * 64 + wc * 32 + fq * 8) = pack8(o0, o1); } }
        EPI_ROWS_END
    }
};
struct EpiPlain {
    static constexpr bool PERM = true, AFTER_DRAIN = false, MID = false;
    bf16* O; int ldc;
    __device__ __forceinline__ void operator()(const f32x4 (&acc)[2][2][4][2], const pg8::Unit& u, int wr, int wc, int fr, int fq) const {
        EPI_ROWS_BEGIN
#pragma unroll
            for (int bj = 0; bj < 2; ++bj) *(GAS v4u*)(O + (size_t)row * ldc + u.pn * 256 + bj * 128 + wc * 32 + fq * 8) = pack8(acc[ai][bj][m][0], acc[ai][bj][m][1]);
        EPI_ROWS_END
    }
};
template <class Sched>
__device__ __forceinline__ void setup_rowtab(LAS float* tab, const float* part, int NP, float inv_dim, const Sched& S, int wid) {
    pg8::Unit u; const int tid = wid * 64 + lane_id();
    if (S.next(0, u)) { const int r = tid >> 1, half = tid & 1, n2 = NP >> 1; const float* pp = part + (size_t)(u.pm * 256 + r) * NP + half * n2; float s = 0.f;
        for (int j = 0; j < n2; ++j) s += pp[j];
        s += __shfl_xor(s, 1); if (!half) tab[r] = 1.0f / sqrtf(s * inv_dim + 1e-6f); }
}
struct EpiQ {
    static constexpr bool PERM = true, AFTER_DRAIN = false, MID = false;
    const LAS float* tab; bf16* Q; const f32x2v* cs;
    __device__ __forceinline__ void operator()(const f32x4 (&acc)[2][2][4][2], const pg8::Unit& u, int wr, int wc, int fr, int fq) const {
        EPI_ROWS_BEGIN
            const float rs = tab[ai * 128 + wr * 64 + m * 16 + fr];
#pragma unroll
            for (int bj = 0; bj < 2; ++bj) { f32x4 v0 = acc[ai][bj][m][0] * rs, v1 = acc[ai][bj][m][1] * rs; const int gc = u.pn * 256 + bj * 128 + wc * 32;
                if (((gc >> 6) % 3) == 2) { f32x4 o0, o1;
#pragma unroll
                    for (int e = 0; e < 4; ++e) { const f32x2v c = cs[row * 32 + 16 * (wc & 1) + 4 * fq + e]; o0[e] = v0[e] * c.x - v1[e] * c.y; o1[e] = v1[e] * c.x + v0[e] * c.y; }
                    v0 = o0; v1 = o1; }
                *(GAS v4u*)(Q + (size_t)row * 1536 + gc + fq * 8) = pack8(v0, v1); }
        EPI_ROWS_END
    }
};
struct EpiKV {
    static constexpr bool PERM = true, AFTER_DRAIN = false, MID = false;
    const LAS float* tab; bf16 *KN, *VV;
    __device__ __forceinline__ void operator()(const f32x4 (&acc)[2][2][4][2], const pg8::Unit& u, int wr, int wc, int fr, int fq) const {
        EPI_ROWS_BEGIN
            const float rs = tab[ai * 128 + wr * 64 + m * 16 + fr];
#pragma unroll
            for (int bj = 0; bj < 2; ++bj) *(GAS v4u*)((bj ? VV : KN) + (size_t)row * 1024 + u.pn * 128 + wc * 32 + fq * 8) = pack8(acc[ai][bj][m][0] * rs, acc[ai][bj][m][1] * rs);
        EPI_ROWS_END
    }
};
struct EpiOut {
    static constexpr bool PERM = true, AFTER_DRAIN = false, MID = true;
    const LAS float* tab; const float* x; float* H1; bf16* H1B; float* psh1;
    __device__ __forceinline__ void mid(f32x4 (&acc)[2][2][4][2], const pg8::Unit& u, int wr, int wc, int fr, int fq) const {
#pragma unroll
        for (int ai = 0; ai < 2; ++ai)
#pragma unroll
            for (int m = 0; m < 4; ++m) { const int r = ai * 128 + wr * 64 + m * 16 + fr; const float rr = tab[r] / tab[256 + r];
#pragma unroll
                for (int bj = 0; bj < 2; ++bj) { acc[ai][bj][m][0] *= rr; acc[ai][bj][m][1] *= rr; } }
    }
    __device__ __forceinline__ void operator()(const f32x4 (&acc)[2][2][4][2], const pg8::Unit& u, int wr, int wc, int fr, int fq) const {
        EPI_ROWS_BEGIN
            const float rs = tab[256 + ai * 128 + wr * 64 + m * 16 + fr];
#pragma unroll
            for (int bj = 0; bj < 2; ++bj) { const size_t off = (size_t)row * DM + u.pn * 256 + bj * 128 + wc * 32 + fq * 8;
                const f32x4 v0 = *(const GAS f32x4*)(x + off) + acc[ai][bj][m][0] * rs, v1 = *(const GAS f32x4*)(x + off + 4) + acc[ai][bj][m][1] * rs;
                *(GAS f32x4*)(H1 + off) = v0; *(GAS f32x4*)(H1 + off + 4) = v1; *(GAS v4u*)(H1B + off) = pack8(v0, v1);
                const float ss = fq_sum(sq8(v0, v1)); if (fq == 0) psh1[row * 64 + u.pn * 8 + bj * 4 + wc] = ss; }
        EPI_ROWS_END
    }
};
struct EpiPQ {
    static constexpr bool PERM = true, AFTER_DRAIN = false, MID = false;
    const LAS float* tab; bf16* QP;
    __device__ __forceinline__ void operator()(const f32x4 (&acc)[2][2][4][2], const pg8::Unit& u, int wr, int wc, int fr, int fq) const {
        EPI_ROWS_BEGIN
            const float rs = tab[ai * 128 + wr * 64 + m * 16 + fr];
#pragma unroll
            for (int bj = 0; bj < 2; ++bj) *(GAS v4u*)(QP + (size_t)row * DM + u.pn * 256 + bj * 128 + wc * 32 + fq * 8) = pack8(acc[ai][bj][m][0] * rs, acc[ai][bj][m][1] * rs);
        EPI_ROWS_END
    }
};
struct EpiPLE {
    static constexpr bool PERM = true, AFTER_DRAIN = false, MID = false;
    const float* rsh2; const float* H2; const bf16* PPROJ; float* out; float* psh3;
    __device__ __forceinline__ void operator()(const f32x4 (&acc)[2][2][4][2], const pg8::Unit& u, int wr, int wc, int fr, int fq) const {
        EPI_ROWS_BEGIN
            const float rs = rsh2[row];
#pragma unroll
            for (int bj = 0; bj < 2; ++bj) { const size_t off = (size_t)row * DM + u.pn * 256 + bj * 128 + wc * 32 + fq * 8;
                const v4u pw = *(const GAS v4u*)(PPROJ + off); f32x4 h0 = *(const GAS f32x4*)(H2 + off), h1 = *(const GAS f32x4*)(H2 + off + 4);
                const unsigned pws[4] = {pw.x, pw.y, pw.z, pw.w};
#pragma unroll
                for (int e = 0; e < 4; ++e) { const float a = acc[ai][bj][m][e >> 1][(e & 1) * 2] * rs, b = acc[ai][bj][m][e >> 1][(e & 1) * 2 + 1] * rs;
                    const float ga = __builtin_amdgcn_rcpf(1.f + __builtin_amdgcn_exp2f(-1.4426950408889634f * a)), gb = __builtin_amdgcn_rcpf(1.f + __builtin_amdgcn_exp2f(-1.4426950408889634f * b));
                    const float pa = __uint_as_float(pws[e] << 16), pb = __uint_as_float(pws[e] & 0xffff0000u);
                    if (e < 2) { h0[(e & 1) * 2] += ga * pa; h0[(e & 1) * 2 + 1] += gb * pb; } else { h1[(e & 1) * 2] += ga * pa; h1[(e & 1) * 2 + 1] += gb * pb; } }
                *(GAS f32x4*)(out + off) = h0; *(GAS f32x4*)(out + off + 4) = h1;
                const float ss = fq_sum(sq8(h0, h1)); if (fq == 0) psh3[row * 64 + u.pn * 8 + bj * 4 + wc] = ss; }
        EPI_ROWS_END
    }
};
typedef float f32x16 __attribute__((ext_vector_type(16)));
typedef short s16x4 __attribute__((ext_vector_type(4)));
#define KSWZ(row, colB) ((row) * 256 + ((colB) ^ (((row) & 7) << 4)))
__device__ __forceinline__ int v_st(int k, int c) { const int kk = (k & ~0xC) | ((k & 4) << 1) | ((k & 8) >> 1); return ((kk >> 3) * 4 + (c >> 5)) * 512 + ((kk & 7) * 32 + (c & 31)) * 2; }
__device__ __forceinline__ int v_rd_base(int lane) { return ((lane & 3) << 3) | (((lane >> 2) & 3) << 6) | (((lane >> 4) & 1) << 5) | (((lane >> 5) & 1) << 8); }
__device__ __forceinline__ int crow(int r, int hi) { return (r & 3) + 8 * (r >> 2) + 4 * hi; }
#define TRRD(dst, off) asm volatile("ds_read_b64_tr_b16 %0, %1 offset:%2" : "=&v"(dst) : "v"(vb0), "i"(off) : "memory")
#define SBAR() __builtin_amdgcn_sched_barrier(0)
#define PV_ONE(o_, pa_, VOFF, D0, KS) do { s16x4 l_, h_; TRRD(l_, (VOFF) + (D0) * 512 + (KS) * 4096); TRRD(h_, (VOFF) + (D0) * 512 + (KS) * 4096 + 2048); \
        asm volatile("s_waitcnt lgkmcnt(0)" ::: "memory"); SBAR(); \
        o_ = __builtin_amdgcn_mfma_f32_32x32x16_bf16(pa_, (bf16x8){l_[0], l_[1], l_[2], l_[3], h_[0], h_[1], h_[2], h_[3]}, o_, 0, 0, 0); } while (0)
__device__ __forceinline__ float half_sum32(float v) { v += __shfl_xor(v, 1); v += __shfl_xor(v, 2); v += __shfl_xor(v, 4); v += __shfl_xor(v, 8); v += __shfl_xor(v, 16); return v; }

__device__ __forceinline__ void sgu_phase(const Args& A, Frame& F) {
    unsigned char* ws = A.ws;
    const bf16* VG = (const bf16*)(ws + WS_VG); const bf16* UG = (const bf16*)(ws + WS_UG); const bf16* WS = (const bf16*)(ws + WS_WSGU); const f32x2v* psv = (const f32x2v*)(ws + WS_PSV);
    const float* gln = (const float*)A.in[9]; const float* bln = (const float*)A.in[10]; const float* bs = (const float*)A.in[12];
    bf16* MIX = (bf16*)(ws + WS_MIX); float* pss = (float*)(ws + WS_PSS);
    const int lane = lane_id(), wid = F.wave, tid = wid * 64 + lane, r32 = lane & 31, hi = lane >> 5, tg = wid & 3, dh = wid >> 2;
    LAS unsigned char* V_lds = F.lds + RING_OFF;
    const int vb0 = (int)(uintptr_t)V_lds + v_rd_base(lane);
    for (int unit = F.vcu; unit < 512; unit += F.G) {
        const int g = unit & 7, R0 = (unit >> 3) * 128;
#pragma unroll
        for (int i = 0; i < 4; ++i) { const int s = (tid >> 4) + 32 * i, c = (tid & 15) * 8, row = R0 + s;
            const f32x2v* pp = psv + ((size_t)row * 8 + g) * 4; const f32x2v p0 = pp[0], p1 = pp[1], p2 = pp[2], p3 = pp[3];
            const float mean = ((p0.x + p1.x) + (p2.x + p3.x)) * (1.f / 128.f), var = ((p0.y + p1.y) + (p2.y + p3.y)) * (1.f / 128.f) - mean * mean, rstd = 1.0f / sqrtf(fmaxf(var, 0.f) + 1e-6f);
            const v4u xv = *(const GAS v4u*)(VG + (size_t)row * 1024 + g * 128 + c);
            const f32x4 g0 = *(const GAS f32x4*)(gln + g * 128 + c), g1 = *(const GAS f32x4*)(gln + g * 128 + c + 4), b0 = *(const GAS f32x4*)(bln + g * 128 + c), b1 = *(const GAS f32x4*)(bln + g * 128 + c + 4);
            f32x4 y0, y1;
            y0[0] = (__uint_as_float(xv.x << 16) - mean) * rstd * g0[0] + b0[0]; y0[1] = (__uint_as_float(xv.x & 0xffff0000u) - mean) * rstd * g0[1] + b0[1];
            y0[2] = (__uint_as_float(xv.y << 16) - mean) * rstd * g0[2] + b0[2]; y0[3] = (__uint_as_float(xv.y & 0xffff0000u) - mean) * rstd * g0[3] + b0[3];
            y1[0] = (__uint_as_float(xv.z << 16) - mean) * rstd * g1[0] + b1[0]; y1[1] = (__uint_as_float(xv.z & 0xffff0000u) - mean) * rstd * g1[1] + b1[1];
            y1[2] = (__uint_as_float(xv.w << 16) - mean) * rstd * g1[2] + b1[2]; y1[3] = (__uint_as_float(xv.w & 0xffff0000u) - mean) * rstd * g1[3] + b1[3];
            *(LAS v4u*)(V_lds + (s >> 6) * 16384 + v_st(s & 63, c)) = pack8(y0, y1); }
        bf16x8 afr[8];
#pragma unroll
        for (int ks = 0; ks < 8; ++ks) afr[ks] = *(const GAS bf16x8*)(WS + ((size_t)g * 128 + 32 * tg + r32) * 128 + 16 * ks + 8 * hi);
        __syncthreads();
        f32x16 o0 = {}, o1 = {};
#define SGU_TILE(TL) do { _Pragma("unroll") for (int ks = 0; ks < 4; ++ks) { \
            if (dh == 0) { PV_ONE(o0, afr[4 * TL + ks], TL * 16384, 0, ks); PV_ONE(o1, afr[4 * TL + ks], TL * 16384, 1, ks); } \
            else { PV_ONE(o0, afr[4 * TL + ks], TL * 16384, 2, ks); PV_ONE(o1, afr[4 * TL + ks], TL * 16384, 3, ks); } } } while (0)
        SGU_TILE(0); if (tg >= 2) SGU_TILE(1);
#undef SGU_TILE
#pragma unroll
        for (int r = 0; r < 16; ++r) { const int t = 32 * tg + crow(r, hi), row = R0 + t; const float bias = bs[g * 128 + t];
            const int d0 = 64 * dh + r32; const size_t uoff = (size_t)row * 1024 + g * 128 + d0;
            const float va = bf2f(UG[uoff]) * (o0[r] + bias), vb = bf2f(UG[uoff + 32]) * (o1[r] + bias);
            const float na = __shfl_xor(va, 1), nb = __shfl_xor(vb, 1);
            if ((r32 & 1) == 0) { bf16* mo = MIX + (size_t)row * 2048 + 1024 + g * 128 + d0; *(GAS unsigned*)mo = pg8::cvt_pk_bf16(va, na); *(GAS unsigned*)(mo + 32) = pg8::cvt_pk_bf16(vb, nb); }
            const float ss = half_sum32(va * va + vb * vb); if (r32 == 0) pss[row * 16 + g * 2 + dh] = ss; }
        __syncthreads();
    }
}

#define OPAQUE(x) asm volatile("" : "+v"(x))
constexpr int KT_ROW = 400, KT_BYTES = 64 * KT_ROW;
__device__ __forceinline__ void attn_phase(const Args& A, Frame& F) {
    unsigned char* ws = A.ws;
    const GAS unsigned char* Qg = (const GAS unsigned char*)(ws + WS_Q); const GAS unsigned char* KNg = (const GAS unsigned char*)(ws + WS_KN); const GAS unsigned char* VVg = (const GAS unsigned char*)(ws + WS_VV); const GAS unsigned char* KRg = (const GAS unsigned char*)(ws + WS_KR);
    bf16* MIX = (bf16*)(ws + WS_MIX); float* psa = (float*)(ws + WS_PSA);
    const int wid = F.wave, g = wid & 3, kh = wid >> 2;
    LAS unsigned char* V_lds = F.lds + RING_OFF; LAS unsigned char* Kt_lds = V_lds + 32768;
    LAS float* wsc = (LAS float*)(V_lds + 86016) + wid * 64;
    LAS float* ml1 = (LAS float*)(V_lds + 86016 + 2048);
    for (int item = F.vcu; item < 256; item += F.G) {
        const int bh = item >> 3, s = item & 7, b = bh >> 3, h = bh & 7, tok0 = b * SEQ;
        for (int pass = 0; pass < 2; ++pass) {
            const int jq = pass ? s : 15 - s, q0 = tok0 + 128 * jq, NT = 2 * (jq + 1);
            bf16x8 qr[12];
            { int ln = lane_id(); const int r32 = ln & 31, hi = ln >> 5; const GAS unsigned char* qp = Qg + (size_t)(q0 + 32 * g) * 3072 + h * 384; const unsigned qo = (unsigned)r32 * 3072u + (unsigned)hi * 16u;
#pragma unroll
              for (int ks = 0; ks < 12; ++ks) qr[ks] = *(const GAS bf16x8*)(qp + qo + ks * 32); }
            bf16x8 skn0, skn1, sv0, sv1, skr;
#define ALOAD(t_) do { int ln_ = lane_id(); const int tid_ = wid * 64 + ln_; const unsigned sr_ = tid_ >> 4, sc_ = tid_ & 15; \
                const GAS unsigned char* kb_ = KNg + (size_t)(tok0 + 64 * (t_)) * 2048 + h * 256; const GAS unsigned char* vb_ = VVg + (size_t)(tok0 + 64 * (t_)) * 2048 + h * 256; const GAS unsigned char* rb_ = KRg + (size_t)(tok0 + 64 * (t_)) * 128; \
                const unsigned o_ = sr_ * 2048u + sc_ * 16u; \
                skn0 = *(const GAS bf16x8*)(kb_ + o_); skn1 = *(const GAS bf16x8*)(kb_ + o_ + 65536u); sv0 = *(const GAS bf16x8*)(vb_ + o_); sv1 = *(const GAS bf16x8*)(vb_ + o_ + 65536u); \
                skr = *(const GAS bf16x8*)(rb_ + (unsigned)tid_ * 16u); } while (0)
#define AWRITE(bf_) do { int ln_ = lane_id(); const int tid_ = wid * 64 + ln_; const int sr_ = tid_ >> 4, sc_ = tid_ & 15; \
                LAS unsigned char* kt_ = Kt_lds + (bf_) * KT_BYTES; LAS unsigned char* vt_ = V_lds + (bf_) * 16384; \
                *(LAS bf16x8*)(kt_ + sr_ * KT_ROW + sc_ * 16) = skn0; *(LAS bf16x8*)(kt_ + (sr_ + 32) * KT_ROW + sc_ * 16) = skn1; \
                *(LAS bf16x8*)(vt_ + v_st(sr_, sc_ * 8)) = sv0; *(LAS bf16x8*)(vt_ + v_st(32 + sr_, sc_ * 8)) = sv1; \
                *(LAS bf16x8*)(kt_ + (tid_ >> 3) * KT_ROW + 256 + (tid_ & 7) * 16) = skr; } while (0)
            ALOAD(0); AWRITE(0); __syncthreads();
            float m_reg = -1e30f, l_reg = 0.f; f32x16 o[4] = {};
            for (int t = 0; t < NT; ++t) {
                const int bf = t & 1;
                if (t + 1 < NT) ALOAD(t + 1);
                int ln = lane_id(); const int r32 = ln & 31, hi = ln >> 5;
                f32x16 p = {};
                { const LAS unsigned char* kb = Kt_lds + bf * KT_BYTES + (32 * kh + r32) * KT_ROW + hi * 16;
#pragma unroll
                  for (int ks = 0; ks < 12; ++ks) p = __builtin_amdgcn_mfma_f32_32x32x16_bf16(*(const LAS bf16x8*)(kb + ks * 32), qr[ks], p, 0, 0, 0); }
                if (t >= 2 * jq) { const int dq = (32 * g + r32) - (64 * (t - 2 * jq) + 32 * kh + 4 * hi);
#pragma unroll
                    for (int r = 0; r < 16; ++r) { const int c = (r & 3) + 8 * (r >> 2); if (c > dq) p[r] = -__builtin_inff(); } }
                float pmax = p[0];
#pragma unroll
                for (int r = 1; r < 16; ++r) pmax = fmaxf(pmax, p[r]);
                { auto rr = __builtin_amdgcn_permlane32_swap(__float_as_uint(pmax), __float_as_uint(pmax), false, false); pmax = fmaxf(__uint_as_float(rr[0]), __uint_as_float(rr[1])); }
                const float mn = fmaxf(m_reg, pmax), alpha = __builtin_amdgcn_exp2f(m_reg - mn); m_reg = mn;
                float ps = 0.f;
#pragma unroll
                for (int r = 0; r < 16; ++r) { p[r] = __builtin_amdgcn_exp2f(p[r] - mn); ps += p[r]; }
                { auto rr = __builtin_amdgcn_permlane32_swap(__float_as_uint(ps), __float_as_uint(ps), false, false); ps = __uint_as_float(rr[0]) + __uint_as_float(rr[1]); }
                l_reg = l_reg * alpha + ps;
                if (__any(alpha < 1.f)) { if (hi == 0) wsc[r32] = alpha; asm volatile("s_waitcnt lgkmcnt(0)" ::: "memory");
#pragma unroll
                    for (int r = 0; r < 16; ++r) { const float f = wsc[crow(r, hi)];
#pragma unroll
                        for (int d_ = 0; d_ < 4; ++d_) o[d_][r] *= f; } }
                bf16x8 pa0, pa1;
#define PK4(P, B_, OUT) do { unsigned a0 = pg8::cvt_pk_bf16(P[B_ + 0], P[B_ + 1]), a1 = pg8::cvt_pk_bf16(P[B_ + 2], P[B_ + 3]), b0 = pg8::cvt_pk_bf16(P[B_ + 4], P[B_ + 5]), b1 = pg8::cvt_pk_bf16(P[B_ + 6], P[B_ + 7]); \
                    auto r0 = __builtin_amdgcn_permlane32_swap(a0, b0, false, false); auto r1 = __builtin_amdgcn_permlane32_swap(a1, b1, false, false); \
                    v4u w = {r0[0], r1[0], r0[1], r1[1]}; OUT = __builtin_bit_cast(bf16x8, w); } while (0)
                PK4(p, 0, pa0); PK4(p, 8, pa1);
#undef PK4
                { const int vb0 = (int)(uintptr_t)V_lds + v_rd_base(ln) + bf * 16384 + kh * 8192;
#pragma unroll
                  for (int d0 = 0; d0 < 4; ++d0) { PV_ONE(o[d0], pa0, 0, d0, 0); PV_ONE(o[d0], pa1, 0, d0, 1); } }
                if (t + 1 < NT) AWRITE(bf ^ 1);
                __syncthreads();
            }
#undef ALOAD
#undef AWRITE
            { int ln = lane_id(); const int r32 = ln & 31, hi = ln >> 5;
            LAS float* O1 = (LAS float*)(V_lds + g * 16384) + ln;
            if (kh == 1) {
#pragma unroll
                for (int d0 = 0; d0 < 4; ++d0)
#pragma unroll
                    for (int r = 0; r < 16; ++r) O1[(d0 * 16 + r) * 64] = o[d0][r];
                if (hi == 0) { ml1[g * 64 + r32] = m_reg; ml1[g * 64 + 32 + r32] = l_reg; } }
            __syncthreads();
            if (kh == 0) { const float m1 = ml1[g * 64 + r32], l1 = ml1[g * 64 + 32 + r32], mt = fmaxf(m_reg, m1), a0 = __builtin_amdgcn_exp2f(m_reg - mt), a1 = __builtin_amdgcn_exp2f(m1 - mt), il = 1.0f / (l_reg * a0 + l1 * a1);
                if (hi == 0) { wsc[r32] = a0 * il; wsc[32 + r32] = a1 * il; } asm volatile("s_waitcnt lgkmcnt(0)" ::: "memory");
#pragma unroll
                for (int r = 0; r < 16; ++r) { const int qrow = q0 + 32 * g + crow(r, hi); const float f0 = wsc[crow(r, hi)], f1 = wsc[32 + crow(r, hi)]; float ss = 0.f;
#pragma unroll
                    for (int d0 = 0; d0 < 4; ++d0) { const float v = o[d0][r] * f0 + O1[(d0 * 16 + r) * 64] * f1; ss += v * v; const float vn = __shfl_xor(v, 1);
                        if ((r32 & 1) == 0) *(GAS unsigned*)(MIX + (size_t)qrow * 2048 + h * 128 + d0 * 32 + r32) = pg8::cvt_pk_bf16(v, vn); }
                    ss = half_sum32(ss); if (r32 == 0) psa[qrow * 8 + h] = ss; } }
            __syncthreads(); }
        }
    }
}
typedef __bf16 bf16x2_t __attribute__((ext_vector_type(2)));
__device__ __forceinline__ unsigned ord_key(float f) { const unsigned u = __float_as_uint(f); return u ^ ((unsigned)((int)u >> 31) | 0x80000000u); }
__device__ __forceinline__ float ord_val(unsigned k) { return __uint_as_float((k & 0x80000000u) ? (k ^ 0x80000000u) : ~k); }
__device__ __forceinline__ unsigned umax3(unsigned a, unsigned b, unsigned c) { return max(max(a, b), c); }
__device__ __forceinline__ unsigned pair_max(unsigned v) { auto rr = __builtin_amdgcn_permlane32_swap(v, v, false, false); return max(rr[0], rr[1]); }
__device__ __forceinline__ unsigned pair_or(unsigned v) { auto rr = __builtin_amdgcn_permlane32_swap(v, v, false, false); return rr[0] | rr[1]; }
__host__ __device__ constexpr int cand_a(int c) { return c < 16 ? 0 : c < 24 ? 1 : c < 29 ? 2 : c < 33 ? 3 : c < 36 ? 4 : c < 38 ? 5 : c < 40 ? 6 : c < 42 ? 7 : c - 34; }
__host__ __device__ constexpr int cand_b(int c) { return c < 16 ? c : c < 24 ? c - 16 : c < 29 ? c - 24 : c < 33 ? c - 29 : c < 36 ? c - 33 : c < 38 ? c - 36 : c < 40 ? c - 38 : c < 42 ? c - 40 : 0; }
__device__ __forceinline__ void topk16_of_128(const bf16* keys  , const bf16* qrow  , int r32, int hi, unsigned (&sel)[16]) {
    bf16x8 qf[8];
#pragma unroll
    for (int ks = 0; ks < 8; ++ks) qf[ks] = *(const GAS bf16x8*)(qrow + 16 * ks + 8 * hi);
    unsigned k[64];
#pragma unroll
    for (int kb = 0; kb < 4; ++kb) { f32x16 acc = {};
#pragma unroll
        for (int ks = 0; ks < 8; ++ks) acc = __builtin_amdgcn_mfma_f32_32x32x16_bf16(*(const GAS bf16x8*)(keys + (size_t)(32 * kb + r32) * 128 + 16 * ks + 8 * hi), qf[ks], acc, 0, 0, 0);
#pragma unroll
        for (int r = 0; r < 16; ++r) k[kb * 16 + r] = (ord_key(acc[r]) & ~0x7fu) | (unsigned)(127 - (32 * kb + crow(r, hi))); }
#pragma unroll
    for (int it = 0; it < 16; ++it) { unsigned m = umax3(k[0], k[1], k[2]);
#pragma unroll
        for (int i = 3; i < 63; i += 2) m = umax3(m, k[i], k[i + 1]);
        m = max(m, k[63]); m = pair_max(m); sel[it] = m;
#pragma unroll
        for (int i = 0; i < 64; ++i) k[i] = (k[i] == m) ? 0u : k[i]; }
}
__device__ __forceinline__ void topk_phase(const Args& A, Frame& F) {
    unsigned char* ws = A.ws;
    const bf16* QP = (const bf16*)(ws + WS_R1); const bf16* K1 = (const bf16*)(ws + WS_K1B); const bf16* K2 = (const bf16*)(ws + WS_K2B); int* IDX = (int*)(ws + WS_IDX); float* GATE = (float*)(ws + WS_GATE);
    const int wid = F.wave;
    for (int unit = F.vcu; unit < 256; unit += F.G) {
        const int rb = unit >> 3, h = unit & 7; const int ln = lane_id(), r32 = ln & 31, hi = ln >> 5; const int tok = rb * 256 + wid * 32 + r32;
        unsigned s1[16], s2[16];
        topk16_of_128(K1 + (size_t)h * 16384, QP + (size_t)tok * 2048 + h * 256, r32, hi, s1);
        topk16_of_128(K2 + (size_t)h * 16384, QP + (size_t)tok * 2048 + h * 256 + 128, r32, hi, s2);
        float t1v[16], t2v[16]; int i1[16], i2[16];
#pragma unroll
        for (int a = 0; a < 16; ++a) { t1v[a] = ord_val(s1[a] & ~0x7fu); i1[a] = 127 - (int)(s1[a] & 0x7fu); t2v[a] = ord_val(s2[a] & ~0x7fu); i2[a] = 127 - (int)(s2[a] & 0x7fu); }
        unsigned ck[25]; int ce[25];
#pragma unroll
        for (int j = 0; j < 25; ++j) { constexpr int dummy = 0; (void)dummy;
            const int c0 = 2 * j, c1 = 2 * j + 1;
            const float v0 = t1v[cand_a(c0)] + t2v[cand_b(c0)], v1 = t1v[cand_a(c1)] + t2v[cand_b(c1)];
            const unsigned k0 = (ord_key(v0) & ~0xffu) | (unsigned)(255 - (cand_a(c0) * 16 + cand_b(c0))), k1 = (ord_key(v1) & ~0xffu) | (unsigned)(255 - (cand_a(c1) * 16 + cand_b(c1)));
            const int e0 = i1[cand_a(c0)] * 128 + i2[cand_b(c0)], e1 = i1[cand_a(c1)] * 128 + i2[cand_b(c1)];
            ck[j] = hi ? k1 : k0; ce[j] = hi ? e1 : e0; }
        unsigned gk[16]; int ge[16];
#pragma unroll
        for (int it = 0; it < 16; ++it) { unsigned m = ck[0];
#pragma unroll
            for (int j = 1; j < 25; j += 2) m = umax3(m, ck[j], ck[j + 1]);
            m = pair_max(m); gk[it] = m; int e = 0;
#pragma unroll
            for (int j = 0; j < 25; ++j) { const bool eq = ck[j] == m; e = eq ? ce[j] : e; ck[j] = eq ? 0u : ck[j]; }
            ge[it] = e; }
        float ev[16]; float l = 0.f; const float v0 = ord_val(gk[0] & ~0xffu);
#pragma unroll
        for (int it = 0; it < 16; ++it) { ge[it] = (int)pair_or((unsigned)ge[it]); ev[it] = __builtin_amdgcn_exp2f((ord_val(gk[it] & ~0xffu) - v0) * 1.4426950408889634f); l += ev[it]; }
        const float il = 1.0f / l;
        if (hi == 0) { int* ip = IDX + (size_t)tok * 128 + h * 16; float* gp = GATE + (size_t)tok * 128 + h * 16;
#pragma unroll
            for (int q = 0; q < 4; ++q) { *(GAS v4u*)(ip + 4 * q) = (v4u){(unsigned)ge[4 * q], (unsigned)ge[4 * q + 1], (unsigned)ge[4 * q + 2], (unsigned)ge[4 * q + 3]};
                *(GAS f32x4*)(gp + 4 * q) = (f32x4){ev[4 * q] * il, ev[4 * q + 1] * il, ev[4 * q + 2] * il, ev[4 * q + 3] * il}; } }
    }
}

__device__ __forceinline__ bf16x2_t asbf(unsigned u) { return __builtin_bit_cast(bf16x2_t, u); }
__device__ __forceinline__ float dot8(v4u a, v4u b, float c) {
    c = __builtin_amdgcn_fdot2_f32_bf16(asbf(a.x), asbf(b.x), c, false); c = __builtin_amdgcn_fdot2_f32_bf16(asbf(a.y), asbf(b.y), c, false);
    c = __builtin_amdgcn_fdot2_f32_bf16(asbf(a.z), asbf(b.z), c, false); c = __builtin_amdgcn_fdot2_f32_bf16(asbf(a.w), asbf(b.w), c, false); return c;
}
__device__ __forceinline__ void fmac_s(float& acc, float ws, float x) { asm("v_fmac_f32_e32 %0, %1, %2" : "+v"(acc) : "s"(ws), "v"(x)); }
__device__ __forceinline__ void axpy8(float (&acc)[8], v4u v, float w  ) {
    fmac_s(acc[0], w, __uint_as_float(v.x << 16)); fmac_s(acc[1], w, __uint_as_float(v.x & 0xffff0000u)); fmac_s(acc[2], w, __uint_as_float(v.y << 16)); fmac_s(acc[3], w, __uint_as_float(v.y & 0xffff0000u));
    fmac_s(acc[4], w, __uint_as_float(v.z << 16)); fmac_s(acc[5], w, __uint_as_float(v.z & 0xffff0000u)); fmac_s(acc[6], w, __uint_as_float(v.w << 16)); fmac_s(acc[7], w, __uint_as_float(v.w & 0xffff0000u));
}
constexpr float U8_SCALE = 256.f, V8_SCALE = 16.f;
typedef float f32x2c __attribute__((ext_vector_type(2)));
struct Row2 { v4u c[2]; };
__device__ __forceinline__ Row2 load_row8(const GAS unsigned char* base, unsigned e, unsigned lane16) { const GAS unsigned char* p = base + (size_t)e * 2048 + lane16; Row2 r; r.c[0] = *(const GAS v4u*)p; r.c[1] = *(const GAS v4u*)(p + 1024); return r; }
__device__ __forceinline__ float fma_s(float a, float b, float c) { float r; asm("v_fma_f32 %0, %1, %2, %3" : "=v"(r) : "v"(a), "v"(b), "v"(c)); return r; }
__device__ __forceinline__ float dot4_8(const float* a, unsigned w, float s) { const f32x2c lo = __builtin_amdgcn_cvt_pk_f32_fp8((int)w, false), hi = __builtin_amdgcn_cvt_pk_f32_fp8((int)w, true);
    s = fma_s(a[0], lo.x, s); s = fma_s(a[1], lo.y, s); s = fma_s(a[2], hi.x, s); s = fma_s(a[3], hi.y, s); return s; }
__device__ __forceinline__ void axpy4_8(float* acc, unsigned w, float ws) { const f32x2c lo = __builtin_amdgcn_cvt_pk_f32_fp8((int)w, false), hi = __builtin_amdgcn_cvt_pk_f32_fp8((int)w, true);
    fmac_s(acc[0], ws, lo.x); fmac_s(acc[1], ws, lo.y); fmac_s(acc[2], ws, hi.x); fmac_s(acc[3], ws, hi.y); }
template <bool DRY> __device__ __forceinline__ void gather_phase(const Args& A, Frame& F) {
    unsigned char* ws = A.ws;
    const GAS unsigned char* UB = (const GAS unsigned char*)(ws + WS_UB); const GAS unsigned char* VB = (const GAS unsigned char*)(ws + WS_VB);
    float* H1 = (float*)(ws + WS_H1); bf16* H1B = (bf16*)(ws + WS_H1B); const float* psh1 = (const float*)(ws + WS_PSH1); const int* IDX = (const int*)(ws + WS_IDX); const float* GATE = (const float*)(ws + WS_GATE); float* rsh2 = (float*)(ws + WS_RSH2);
    const int gw = F.vcu * NWAVES + F.wave, NGW = F.G * NWAVES;
    for (int tk = gw; tk < T_TOK; tk += NGW) {
        const int lane = lane_id(); const unsigned lane16 = (unsigned)lane * 16u; const int kq = (lane >> 2) & 15;
        const float rs = (1.0f / sqrtf(wave_sum64(psh1[(size_t)tk * 64 + lane]) * (1.f / 2048.f) + 1e-6f)) * (1.f / U8_SCALE);
        float af[32], acc[32];
#pragma unroll
        for (int j = 0; j < 2; ++j) { const v4u a0 = *(const GAS v4u*)(H1B + (size_t)tk * 2048 + 1024 * j + 16 * lane), a1 = *(const GAS v4u*)(H1B + (size_t)tk * 2048 + 1024 * j + 16 * lane + 8);
            const unsigned aw[8] = {a0.x, a0.y, a0.z, a0.w, a1.x, a1.y, a1.z, a1.w};
#pragma unroll
            for (int q = 0; q < 8; ++q) { af[16 * j + 2 * q] = __uint_as_float(aw[q] << 16); af[16 * j + 2 * q + 1] = __uint_as_float(aw[q] & 0xffff0000u); }
#pragma unroll
            for (int q = 0; q < 4; ++q) { const f32x4 x = *(const GAS f32x4*)(H1 + (size_t)tk * 2048 + 1024 * j + 16 * lane + 4 * q); acc[16 * j + 4 * q] = x[0]; acc[16 * j + 4 * q + 1] = x[1]; acc[16 * j + 4 * q + 2] = x[2]; acc[16 * j + 4 * q + 3] = x[3]; } }
        for (int hd = 0; hd < 8; ++hd) {
            const int ev = IDX[(size_t)tk * 128 + hd * 16 + kq]; const float gv = GATE[(size_t)tk * 128 + hd * 16 + kq];
            float p[16];
            Row2 bA[4], bB[4];
#define LD4(buf, base, k0) do { _Pragma("unroll") for (int q = 0; q < 4; ++q) buf[q] = load_row8(base, (unsigned)__builtin_amdgcn_readlane(ev, 4 * ((k0) + q)), lane16); } while (0)
#define DOT4(buf, k0) do { _Pragma("unroll") for (int q = 0; q < 4; ++q) { float s = 0.f; _Pragma("unroll") for (int j = 0; j < 2; ++j) { s = dot4_8(af + 16 * j, buf[q].c[j].x, s); s = dot4_8(af + 16 * j + 4, buf[q].c[j].y, s); s = dot4_8(af + 16 * j + 8, buf[q].c[j].z, s); s = dot4_8(af + 16 * j + 12, buf[q].c[j].w, s); } p[(k0) + q] = s; } } while (0)
#define AX4(buf, k0) do { _Pragma("unroll") for (int q = 0; q < 4; ++q) { const float wk = __uint_as_float((unsigned)__builtin_amdgcn_readlane((int)__float_as_uint(w), 4 * ((k0) + q))); _Pragma("unroll") for (int j = 0; j < 2; ++j) { axpy4_8(acc + 16 * j, buf[q].c[j].x, wk); axpy4_8(acc + 16 * j + 4, buf[q].c[j].y, wk); axpy4_8(acc + 16 * j + 8, buf[q].c[j].z, wk); axpy4_8(acc + 16 * j + 12, buf[q].c[j].w, wk); } } } while (0)
            LD4(bA, UB, 0); LD4(bB, UB, 4); SBAR(); DOT4(bA, 0); SBAR(); LD4(bA, UB, 8); SBAR(); DOT4(bB, 4); SBAR(); LD4(bB, UB, 12); SBAR(); DOT4(bA, 8); SBAR(); LD4(bA, VB, 0); SBAR(); DOT4(bB, 12); SBAR(); LD4(bB, VB, 4); SBAR();
            { const bool b5 = lane & 32, b4 = lane & 16, b3 = lane & 8, b2 = lane & 4; float q8[8], q4[4], q2[2], q1;
#pragma unroll
              for (int i = 0; i < 8; ++i) { const float keep = b5 ? p[i + 8] : p[i], send = b5 ? p[i] : p[i + 8]; q8[i] = keep + __shfl_xor(send, 32); }
#pragma unroll
              for (int i = 0; i < 4; ++i) { const float keep = b4 ? q8[i + 4] : q8[i], send = b4 ? q8[i] : q8[i + 4]; q4[i] = keep + __shfl_xor(send, 16); }
#pragma unroll
              for (int i = 0; i < 2; ++i) { const float keep = b3 ? q4[i + 2] : q4[i], send = b3 ? q4[i] : q4[i + 2]; q2[i] = keep + __shfl_xor(send, 8); }
              { const float keep = b2 ? q2[1] : q2[0], send = b2 ? q2[0] : q2[1]; q1 = keep + __shfl_xor(send, 4); }
              q1 += __shfl_xor(q1, 2); q1 += __shfl_xor(q1, 1); p[0] = q1; }
            const float w = gv * gelu_f(p[0] * rs) * (1.f / V8_SCALE);
            SBAR(); AX4(bA, 0); SBAR(); LD4(bA, VB, 8); SBAR(); AX4(bB, 4); SBAR(); LD4(bB, VB, 12); SBAR(); AX4(bA, 8); SBAR(); AX4(bB, 12); SBAR();
#undef LD4
#undef DOT4
#undef AX4
        }
        float ss = 0.f;
        float* H1o = DRY ? (float*)(ws + WS_NA0) + (size_t)(tk & 2047) * 2048 : H1 + (size_t)tk * 2048; bf16* H1Bo = DRY ? (bf16*)(ws + WS_NGL) + (size_t)(tk & 2047) * 2048 : H1B + (size_t)tk * 2048;
#pragma unroll
        for (int j = 0; j < 2; ++j) {
#pragma unroll
            for (int q = 0; q < 2; ++q) { const f32x4 y0 = {acc[16 * j + 8 * q], acc[16 * j + 8 * q + 1], acc[16 * j + 8 * q + 2], acc[16 * j + 8 * q + 3]}, y1 = {acc[16 * j + 8 * q + 4], acc[16 * j + 8 * q + 5], acc[16 * j + 8 * q + 6], acc[16 * j + 8 * q + 7]}; ss += sq8(y0, y1);
                *(GAS f32x4*)(H1o + 1024 * j + 16 * lane + 8 * q) = y0; *(GAS f32x4*)(H1o + 1024 * j + 16 * lane + 8 * q + 4) = y1; *(GAS v4u*)(H1Bo + 1024 * j + 16 * lane + 8 * q) = pack8(y0, y1); } }
        ss = wave_sum64(ss); if (lane == 0 && !DRY) rsh2[tk] = 1.0f / sqrtf(ss * (1.f / 2048.f) + 1e-6f);
    }
}
#ifndef NSLICE_SHIFT
#define NSLICE_SHIFT 9
#endif
__device__ __forceinline__ void tok_load(const unsigned char* ws, int tk, int lane, float (&af)[32], float (&acc)[32], float& rs, int (&ev)[2], float (&gv)[2]) {
    const float* H1 = (const float*)(ws + WS_H1); const bf16* H1B = (const bf16*)(ws + WS_H1B); const float* psh1 = (const float*)(ws + WS_PSH1); const int* IDX = (const int*)(ws + WS_IDX); const float* GATE = (const float*)(ws + WS_GATE);
    rs = (1.0f / sqrtf(wave_sum64(psh1[(size_t)tk * 64 + lane]) * (1.f / 2048.f) + 1e-6f)) * (1.f / U8_SCALE);
#pragma unroll
    for (int j = 0; j < 2; ++j) { const v4u a0 = *(const GAS v4u*)(H1B + (size_t)tk * 2048 + 1024 * j + 16 * lane), a1 = *(const GAS v4u*)(H1B + (size_t)tk * 2048 + 1024 * j + 16 * lane + 8);
        const unsigned aw[8] = {a0.x, a0.y, a0.z, a0.w, a1.x, a1.y, a1.z, a1.w};
#pragma unroll
        for (int q = 0; q < 8; ++q) { af[16 * j + 2 * q] = __uint_as_float(aw[q] << 16); af[16 * j + 2 * q + 1] = __uint_as_float(aw[q] & 0xffff0000u); }
#pragma unroll
        for (int q = 0; q < 4; ++q) { const f32x4 x = *(const GAS f32x4*)(H1 + (size_t)tk * 2048 + 1024 * j + 16 * lane + 4 * q); acc[16 * j + 4 * q] = x[0]; acc[16 * j + 4 * q + 1] = x[1]; acc[16 * j + 4 * q + 2] = x[2]; acc[16 * j + 4 * q + 3] = x[3]; } }
    ev[0] = IDX[(size_t)tk * 128 + lane]; ev[1] = IDX[(size_t)tk * 128 + 64 + lane]; gv[0] = GATE[(size_t)tk * 128 + lane]; gv[1] = GATE[(size_t)tk * 128 + 64 + lane];
}
template <bool DRY> __device__ __forceinline__ void tok_store(unsigned char* ws, int tk, int lane, const float (&acc)[32]) {
    float* H1 = (float*)(ws + WS_H1); bf16* H1B = (bf16*)(ws + WS_H1B); float* rsh2 = (float*)(ws + WS_RSH2);
    float ss = 0.f;
    float* H1o = DRY ? (float*)(ws + WS_NA0) + (size_t)(tk & 2047) * 2048 : H1 + (size_t)tk * 2048; bf16* H1Bo = DRY ? (bf16*)(ws + WS_NGL) + (size_t)(tk & 2047) * 2048 : H1B + (size_t)tk * 2048;
#pragma unroll
    for (int j = 0; j < 2; ++j) {
#pragma unroll
        for (int q = 0; q < 2; ++q) { const f32x4 y0 = {acc[16 * j + 8 * q], acc[16 * j + 8 * q + 1], acc[16 * j + 8 * q + 2], acc[16 * j + 8 * q + 3]}, y1 = {acc[16 * j + 8 * q + 4], acc[16 * j + 8 * q + 5], acc[16 * j + 8 * q + 6], acc[16 * j + 8 * q + 7]}; ss += sq8(y0, y1);
            *(GAS f32x4*)(H1o + 1024 * j + 16 * lane + 8 * q) = y0; *(GAS f32x4*)(H1o + 1024 * j + 16 * lane + 8 * q + 4) = y1; *(GAS v4u*)(H1Bo + 1024 * j + 16 * lane + 8 * q) = pack8(y0, y1); } }
    ss = wave_sum64(ss); if (lane == 0 && !DRY) rsh2[tk] = 1.0f / sqrtf(ss * (1.f / 2048.f) + 1e-6f);
}
__device__ __forceinline__ float dot_row8(const float (&af)[32], const Row2& r) { float s = 0.f;
#pragma unroll
    for (int j = 0; j < 2; ++j) { s = dot4_8(af + 16 * j, r.c[j].x, s); s = dot4_8(af + 16 * j + 4, r.c[j].y, s); s = dot4_8(af + 16 * j + 8, r.c[j].z, s); s = dot4_8(af + 16 * j + 12, r.c[j].w, s); }
    return s; }
__device__ __forceinline__ void axpy_row8(float (&acc)[32], const Row2& r, float wk) {
#pragma unroll
    for (int j = 0; j < 2; ++j) { axpy4_8(acc + 16 * j, r.c[j].x, wk); axpy4_8(acc + 16 * j + 4, r.c[j].y, wk); axpy4_8(acc + 16 * j + 8, r.c[j].z, wk); axpy4_8(acc + 16 * j + 12, r.c[j].w, wk); } }
__device__ __forceinline__ void tok_slice(const GAS unsigned char* UB, const GAS unsigned char* VB, int s, int lane, unsigned lane16, const float (&af)[32], float (&acc)[32], float rs, const int (&ev)[2], const float (&gv)[2]) {
    unsigned long long m0 = __ballot((ev[0] >> NSLICE_SHIFT) == s), m1 = __ballot((ev[1] >> NSLICE_SHIFT) == s);
    while (m0 | m1) {
        int e0, e1; float g0, g1;
        if (m0) { const int i = __builtin_ctzll(m0); m0 &= m0 - 1; e0 = __builtin_amdgcn_readlane(ev[0], i); g0 = __uint_as_float((unsigned)__builtin_amdgcn_readlane((int)__float_as_uint(gv[0]), i)); }
        else { const int i = __builtin_ctzll(m1); m1 &= m1 - 1; e0 = __builtin_amdgcn_readlane(ev[1], i); g0 = __uint_as_float((unsigned)__builtin_amdgcn_readlane((int)__float_as_uint(gv[1]), i)); }
        if (m0) { const int i = __builtin_ctzll(m0); m0 &= m0 - 1; e1 = __builtin_amdgcn_readlane(ev[0], i); g1 = __uint_as_float((unsigned)__builtin_amdgcn_readlane((int)__float_as_uint(gv[0]), i)); }
        else if (m1) { const int i = __builtin_ctzll(m1); m1 &= m1 - 1; e1 = __builtin_amdgcn_readlane(ev[1], i); g1 = __uint_as_float((unsigned)__builtin_amdgcn_readlane((int)__float_as_uint(gv[1]), i)); }
        else { e1 = e0; g1 = 0.f; }
        const Row2 u0 = load_row8(UB, (unsigned)e0, lane16), u1 = load_row8(UB, (unsigned)e1, lane16), v0 = load_row8(VB, (unsigned)e0, lane16), v1 = load_row8(VB, (unsigned)e1, lane16);
        const float p0 = dot_row8(af, u0), p1 = dot_row8(af, u1);
        const bool b5 = lane & 32; float h = (b5 ? p1 : p0) + __shfl_xor(b5 ? p0 : p1, 32);
        h += __shfl_xor(h, 16); h += __shfl_xor(h, 8); h += __shfl_xor(h, 4); h += __shfl_xor(h, 2); h += __shfl_xor(h, 1);
        const float w = (b5 ? g1 : g0) * gelu_f(h * rs) * (1.f / V8_SCALE);
        const float w0 = __uint_as_float((unsigned)__builtin_amdgcn_readlane((int)__float_as_uint(w), 0)), w1 = __uint_as_float((unsigned)__builtin_amdgcn_readlane((int)__float_as_uint(w), 32));
        axpy_row8(acc, v0, w0); axpy_row8(acc, v1, w1);
    }
}
template <bool DRY> __device__ __forceinline__ void gather_sliced_phase(const Args& A, Frame& F) {
    unsigned char* ws = A.ws;
    const GAS unsigned char* UB = (const GAS unsigned char*)(ws + WS_UB); const GAS unsigned char* VB = (const GAS unsigned char*)(ws + WS_VB);
    const int gw = F.vcu * NWAVES + F.wave, NGW = F.G * NWAVES;
    for (int tk0 = 2 * gw; tk0 < T_TOK; tk0 += 2 * NGW) {
        const int lane = lane_id(); const unsigned lane16 = (unsigned)lane * 16u;
        float afA[32], accA[32], afB[32], accB[32], rsA, rsB; int evA[2], evB[2]; float gvA[2], gvB[2];
        tok_load(ws, tk0, lane, afA, accA, rsA, evA, gvA); tok_load(ws, tk0 + 1, lane, afB, accB, rsB, evB, gvB);
        for (int s = 0; s < (16384 >> NSLICE_SHIFT); ++s) { tok_slice(UB, VB, s, lane, lane16, afA, accA, rsA, evA, gvA); tok_slice(UB, VB, s, lane, lane16, afB, accB, rsB, evB, gvB); }
        tok_store<DRY>(ws, tk0, lane, accA); tok_store<DRY>(ws, tk0 + 1, lane, accB);
    }
}
#ifndef PROBE_NOV
#define PROBE_NOV 0
#endif
struct Tok2 { f32x2c af[16], acc[16]; float rs; int ev[2]; float gv[2]; };
__device__ __forceinline__ void tok2_load(const unsigned char* ws, int tk, int lane, Tok2& T) {
    const float* H1 = (const float*)(ws + WS_H1); const bf16* H1B = (const bf16*)(ws + WS_H1B); const float* psh1 = (const float*)(ws + WS_PSH1); const int* IDX = (const int*)(ws + WS_IDX); const float* GATE = (const float*)(ws + WS_GATE);
    T.rs = (1.0f / sqrtf(wave_sum64(psh1[(size_t)tk * 64 + lane]) * (1.f / 2048.f) + 1e-6f)) * (1.f / U8_SCALE);
#pragma unroll
    for (int j = 0; j < 2; ++j) { const v4u a0 = *(const GAS v4u*)(H1B + (size_t)tk * 2048 + 1024 * j + 16 * lane), a1 = *(const GAS v4u*)(H1B + (size_t)tk * 2048 + 1024 * j + 16 * lane + 8);
        const unsigned aw[8] = {a0.x, a0.y, a0.z, a0.w, a1.x, a1.y, a1.z, a1.w};
#pragma unroll
        for (int q = 0; q < 8; ++q) T.af[8 * j + q] = (f32x2c){__uint_as_float(aw[q] << 16), __uint_as_float(aw[q] & 0xffff0000u)};
#pragma unroll
        for (int q = 0; q < 4; ++q) { const f32x4 x = *(const GAS f32x4*)(H1 + (size_t)tk * 2048 + 1024 * j + 16 * lane + 4 * q); T.acc[8 * j + 2 * q] = (f32x2c){x[0], x[1]}; T.acc[8 * j + 2 * q + 1] = (f32x2c){x[2], x[3]}; } }
    T.ev[0] = IDX[(size_t)tk * 128 + lane]; T.ev[1] = IDX[(size_t)tk * 128 + 64 + lane]; T.gv[0] = GATE[(size_t)tk * 128 + lane]; T.gv[1] = GATE[(size_t)tk * 128 + 64 + lane];
}
template <bool DRY> __device__ __forceinline__ void tok2_store(unsigned char* ws, int tk, int lane_, const Tok2& T) {
    const int lane = lane_id(); (void)lane_;
    float* H1 = (float*)(ws + WS_H1); bf16* H1B = (bf16*)(ws + WS_H1B); float* rsh2 = (float*)(ws + WS_RSH2);
    float ss = 0.f;
    float* H1o = DRY ? (float*)(ws + WS_NA0) + (size_t)(tk & 2047) * 2048 : H1 + (size_t)tk * 2048; bf16* H1Bo = DRY ? (bf16*)(ws + WS_NGL) + (size_t)(tk & 2047) * 2048 : H1B + (size_t)tk * 2048;
#pragma unroll
    for (int j = 0; j < 2; ++j) {
#pragma unroll
        for (int q = 0; q < 2; ++q) { const f32x4 y0 = {T.acc[8 * j + 4 * q].x, T.acc[8 * j + 4 * q].y, T.acc[8 * j + 4 * q + 1].x, T.acc[8 * j + 4 * q + 1].y}, y1 = {T.acc[8 * j + 4 * q + 2].x, T.acc[8 * j + 4 * q + 2].y, T.acc[8 * j + 4 * q + 3].x, T.acc[8 * j + 4 * q + 3].y}; ss += sq8(y0, y1);
            *(GAS f32x4*)(H1o + 1024 * j + 16 * lane + 8 * q) = y0; *(GAS f32x4*)(H1o + 1024 * j + 16 * lane + 8 * q + 4) = y1; *(GAS v4u*)(H1Bo + 1024 * j + 16 * lane + 8 * q) = pack8(y0, y1); } }
    ss = wave_sum64(ss); if (lane == 0 && !DRY) rsh2[tk] = 1.0f / sqrtf(ss * (1.f / 2048.f) + 1e-6f);
}
__device__ __forceinline__ float dot_row8p(const Tok2& T, const Row2& r) { f32x2c s0 = {0.f, 0.f}, s1 = {0.f, 0.f}, s2 = {0.f, 0.f}, s3 = {0.f, 0.f};
#pragma unroll
    for (int j = 0; j < 2; ++j) { const unsigned w[4] = {r.c[j].x, r.c[j].y, r.c[j].z, r.c[j].w};
#pragma unroll
        for (int d = 0; d < 4; ++d) { const f32x2c lo = __builtin_amdgcn_cvt_pk_f32_fp8((int)w[d], false), hi = __builtin_amdgcn_cvt_pk_f32_fp8((int)w[d], true);
            if (j == 0) { s0 = __builtin_elementwise_fma(T.af[2 * d], lo, s0); s1 = __builtin_elementwise_fma(T.af[2 * d + 1], hi, s1); }
            else { s2 = __builtin_elementwise_fma(T.af[8 + 2 * d], lo, s2); s3 = __builtin_elementwise_fma(T.af[8 + 2 * d + 1], hi, s3); } } }
    const f32x2c t = (s0 + s1) + (s2 + s3); return t.x + t.y; }
__device__ __forceinline__ void axpy_row8p(Tok2& T, const Row2& r, float wk) { const f32x2c w2 = {wk, wk};
#pragma unroll
    for (int j = 0; j < 2; ++j) { const unsigned w[4] = {r.c[j].x, r.c[j].y, r.c[j].z, r.c[j].w};
#pragma unroll
        for (int d = 0; d < 4; ++d) { const f32x2c lo = __builtin_amdgcn_cvt_pk_f32_fp8((int)w[d], false), hi = __builtin_amdgcn_cvt_pk_f32_fp8((int)w[d], true);
            T.acc[8 * j + 2 * d] = __builtin_elementwise_fma(w2, lo, T.acc[8 * j + 2 * d]); T.acc[8 * j + 2 * d + 1] = __builtin_elementwise_fma(w2, hi, T.acc[8 * j + 2 * d + 1]); } } }
__device__ __forceinline__ float dpp_add(float v, const int ctrl, const int rmask) { return v; }
#define DPP_ADD(v, ctrl, rmask) v += __uint_as_float((unsigned)__builtin_amdgcn_update_dpp(0, (int)__float_as_uint(v), ctrl, rmask, 0xF, true))
__device__ __forceinline__ float reduce2(float p0, float p1) {
    auto rr = __builtin_amdgcn_permlane32_swap(__float_as_uint(p0), __float_as_uint(p1), false, false);
    float h = __uint_as_float(rr[0]) + __uint_as_float(rr[1]);
    DPP_ADD(h, 0xB1, 0xF); DPP_ADD(h, 0x4E, 0xF); DPP_ADD(h, 0x141, 0xF); DPP_ADD(h, 0x140, 0xF); DPP_ADD(h, 0x142, 0xA);
    return h; }
__device__ __forceinline__ int take2(unsigned long long& m0, unsigned long long& m1, const Tok2& T, int& e0, float& g0, int& e1, float& g1) {
    if (!(m0 | m1)) return 0;
    if (m0) { const int i = __builtin_ctzll(m0); m0 &= m0 - 1; e0 = __builtin_amdgcn_readlane(T.ev[0], i); g0 = __uint_as_float((unsigned)__builtin_amdgcn_readlane((int)__float_as_uint(T.gv[0]), i)); }
    else { const int i = __builtin_ctzll(m1); m1 &= m1 - 1; e0 = __builtin_amdgcn_readlane(T.ev[1], i); g0 = __uint_as_float((unsigned)__builtin_amdgcn_readlane((int)__float_as_uint(T.gv[1]), i)); }
    if (m0) { const int i = __builtin_ctzll(m0); m0 &= m0 - 1; e1 = __builtin_amdgcn_readlane(T.ev[0], i); g1 = __uint_as_float((unsigned)__builtin_amdgcn_readlane((int)__float_as_uint(T.gv[0]), i)); return 2; }
    if (m1) { const int i = __builtin_ctzll(m1); m1 &= m1 - 1; e1 = __builtin_amdgcn_readlane(T.ev[1], i); g1 = __uint_as_float((unsigned)__builtin_amdgcn_readlane((int)__float_as_uint(T.gv[1]), i)); return 2; }
    e1 = e0; g1 = 0.f; return 1;
}
__device__ __forceinline__ void batch2(Tok2& T, const Row2& u0, const Row2& u1, const Row2& v0, const Row2& v1, float g0, float g1, int lane) {
    const float h = reduce2(dot_row8p(T, u0), dot_row8p(T, u1));
    const float w = ((lane & 32) ? g1 : g0) * gelu_f(h * T.rs) * (1.f / V8_SCALE);
    const float w0 = __uint_as_float((unsigned)__builtin_amdgcn_readlane((int)__float_as_uint(w), 31)), w1 = __uint_as_float((unsigned)__builtin_amdgcn_readlane((int)__float_as_uint(w), 63));
    axpy_row8p(T, v0, w0); axpy_row8p(T, v1, w1);
}
#ifndef GATHER_PREFETCH
#define GATHER_PREFETCH 0
#endif
constexpr int SLICE_EXPERTS = 1 << NSLICE_SHIFT, SLICE_SHARE = 2048;
static_assert(NSLICE_SHIFT != 8 || SLICE_EXPERTS * 2048 / 256 == SLICE_SHARE, "prefetch share");
__device__ __forceinline__ unsigned slice_prefetch(const GAS unsigned char* UB, const GAS unsigned char* VB, int snext, unsigned wx) {
    const GAS unsigned char* pu = UB + (size_t)snext * (SLICE_EXPERTS * 2048) + (size_t)wx * SLICE_SHARE; const GAS unsigned char* pv = VB + (size_t)snext * (SLICE_EXPERTS * 2048) + (size_t)wx * SLICE_SHARE;
    unsigned d;
    asm volatile("s_load_dword %0, %1, 0x0\n\ts_load_dword %0, %1, 0x80\n\ts_load_dword %0, %1, 0x100\n\ts_load_dword %0, %1, 0x180\n\ts_load_dword %0, %1, 0x200\n\ts_load_dword %0, %1, 0x280\n\ts_load_dword %0, %1, 0x300\n\ts_load_dword %0, %1, 0x380\n\ts_load_dword %0, %1, 0x400\n\ts_load_dword %0, %1, 0x480\n\ts_load_dword %0, %1, 0x500\n\ts_load_dword %0, %1, 0x580\n\ts_load_dword %0, %1, 0x600\n\ts_load_dword %0, %1, 0x680\n\ts_load_dword %0, %1, 0x700\n\ts_load_dword %0, %1, 0x780\n\ts_load_dword %0, %2, 0x0\n\ts_load_dword %0, %2, 0x80\n\ts_load_dword %0, %2, 0x100\n\ts_load_dword %0, %2, 0x180\n\ts_load_dword %0, %2, 0x200\n\ts_load_dword %0, %2, 0x280\n\ts_load_dword %0, %2, 0x300\n\ts_load_dword %0, %2, 0x380\n\ts_load_dword %0, %2, 0x400\n\ts_load_dword %0, %2, 0x480\n\ts_load_dword %0, %2, 0x500\n\ts_load_dword %0, %2, 0x580\n\ts_load_dword %0, %2, 0x600\n\ts_load_dword %0, %2, 0x680\n\ts_load_dword %0, %2, 0x700\n\ts_load_dword %0, %2, 0x780\n\ts_nop 0" : "=&s"(d) : "s"(pu), "s"(pv));
    return d;
}
__device__ __forceinline__ void slice_prefetch_done(unsigned& d) { asm volatile("s_waitcnt lgkmcnt(0)" : "+s"(d)); }
template <bool DRY> __device__ __forceinline__ void gather_sliced2_phase(const Args& A, Frame& F) {
    unsigned char* ws = A.ws;
    const GAS unsigned char* UB = (const GAS unsigned char*)(ws + WS_UB); const GAS unsigned char* VB = (const GAS unsigned char*)(ws + WS_VB);
    const int gw = F.vcu * NWAVES + F.wave, NGW = F.G * NWAVES;
    for (int tk0 = 2 * gw; tk0 < T_TOK; tk0 += 2 * NGW) {
        const int lane = lane_id(); const unsigned lane16 = (unsigned)lane * 16u;
        Tok2 TA, TB; tok2_load(ws, tk0, lane, TA); tok2_load(ws, tk0 + 1, lane, TB);
        const unsigned wx = (unsigned)((F.vcu & 31) * NWAVES + F.wave);
        for (int s = 0; s < (16384 >> NSLICE_SHIFT); ++s) {
            unsigned pf_d = 0u; if (GATHER_PREFETCH && NSLICE_SHIFT == 8) pf_d = slice_prefetch(UB, VB, (s + 1) & ((16384 >> NSLICE_SHIFT) - 1), wx);
            unsigned long long a0 = __ballot((TA.ev[0] >> NSLICE_SHIFT) == s), a1 = __ballot((TA.ev[1] >> NSLICE_SHIFT) == s), b0 = __ballot((TB.ev[0] >> NSLICE_SHIFT) == s), b1 = __ballot((TB.ev[1] >> NSLICE_SHIFT) == s);
            while (a0 | a1 | b0 | b1) {
                int eA0 = 0, eA1 = 0, eB0 = 0, eB1 = 0; float gA0 = 0.f, gA1 = 0.f, gB0 = 0.f, gB1 = 0.f;
                const int nA = take2(a0, a1, TA, eA0, gA0, eA1, gA1), nB = take2(b0, b1, TB, eB0, gB0, eB1, gB1);
                if (DRY && PROBE_NOV == 4) { eA0 &= 255; eA1 &= 255; eB0 &= 255; eB1 &= 255; } if (DRY && PROBE_NOV == 5) { eA0 &= 3; eA1 &= 3; eB0 &= 3; eB1 &= 3; }
                Row2 uA0, uA1, vA0, vA1, uB0, uB1, vB0, vB1;
                if (DRY && PROBE_NOV == 2) { uA0.c[0] = uA0.c[1] = (v4u){(unsigned)eA0, (unsigned)lane, 0x38383838u, 0x3c3c3c3cu}; uA1 = uA0; vA0 = uA0; vA1 = uA0; uB0 = uA0; uB1 = uA0; vB0 = uA0; vB1 = uA0; } else
                if (nA) { uA0 = load_row8(UB, (unsigned)eA0, lane16); uA1 = load_row8(UB, (unsigned)eA1, lane16); if (DRY && PROBE_NOV) { vA0 = uA0; vA1 = uA1; } else { vA0 = load_row8(VB, (unsigned)eA0, lane16); vA1 = load_row8(VB, (unsigned)eA1, lane16); } }
                if (!(DRY && PROBE_NOV == 2)) if (nB) { uB0 = load_row8(UB, (unsigned)eB0, lane16); uB1 = load_row8(UB, (unsigned)eB1, lane16); if (DRY && PROBE_NOV) { vB0 = uB0; vB1 = uB1; } else { vB0 = load_row8(VB, (unsigned)eB0, lane16); vB1 = load_row8(VB, (unsigned)eB1, lane16); } }
                if (DRY && PROBE_NOV == 3) { unsigned x = 0;
                    if (nA) x ^= uA0.c[0].x ^ uA0.c[0].w ^ uA0.c[1].y ^ uA1.c[0].x ^ uA1.c[1].w ^ vA0.c[0].x ^ vA0.c[1].w ^ vA1.c[0].y ^ vA1.c[1].z ^ uA0.c[0].y ^ uA0.c[0].z ^ uA0.c[1].x ^ uA0.c[1].z ^ uA0.c[1].w ^ uA1.c[0].y ^ uA1.c[0].z ^ uA1.c[0].w ^ uA1.c[1].x ^ uA1.c[1].y ^ uA1.c[1].z ^ vA0.c[0].y ^ vA0.c[0].z ^ vA0.c[0].w ^ vA0.c[1].x ^ vA0.c[1].y ^ vA0.c[1].z ^ vA1.c[0].x ^ vA1.c[0].z ^ vA1.c[0].w ^ vA1.c[1].x ^ vA1.c[1].y ^ vA1.c[1].w;
                    if (nB) x ^= uB0.c[0].x ^ uB0.c[0].w ^ uB0.c[1].y ^ uB1.c[0].x ^ uB1.c[1].w ^ vB0.c[0].x ^ vB0.c[1].w ^ vB1.c[0].y ^ vB1.c[1].z ^ uB0.c[0].y ^ uB0.c[0].z ^ uB0.c[1].x ^ uB0.c[1].z ^ uB0.c[1].w ^ uB1.c[0].y ^ uB1.c[0].z ^ uB1.c[0].w ^ uB1.c[1].x ^ uB1.c[1].y ^ uB1.c[1].z ^ vB0.c[0].y ^ vB0.c[0].z ^ vB0.c[0].w ^ vB0.c[1].x ^ vB0.c[1].y ^ vB0.c[1].z ^ vB1.c[0].x ^ vB1.c[0].z ^ vB1.c[0].w ^ vB1.c[1].x ^ vB1.c[1].y ^ vB1.c[1].w;
                    TA.acc[0].x += __uint_as_float(x & 1u); } else {
                if (nA) batch2(TA, uA0, uA1, vA0, vA1, gA0, gA1, lane);
                if (nB) batch2(TB, uB0, uB1, vB0, vB1, gB0, gB1, lane); }
            }
            if (GATHER_PREFETCH && NSLICE_SHIFT == 8) slice_prefetch_done(pf_d);
        }
        tok2_store<DRY>(ws, tk0, lane, TA); tok2_store<DRY>(ws, tk0 + 1, lane, TB);
    }
}
struct Acc2 { f32x2c acc[16]; float rs; int ev[2]; float gv[2]; };
struct It8 { int nA, nB; float gA0, gA1, gB0, gB1; Row2 uA0, uA1, vA0, vA1, uB0, uB1, vB0, vB1; };
__device__ __forceinline__ void tok3_load(const unsigned char* ws, int tk, int lane, Acc2& T, LAS unsigned char* afl  ) {
    const float* H1 = (const float*)(ws + WS_H1); const bf16* H1B = (const bf16*)(ws + WS_H1B); const float* psh1 = (const float*)(ws + WS_PSH1); const int* IDX = (const int*)(ws + WS_IDX); const float* GATE = (const float*)(ws + WS_GATE);
    T.rs = (1.0f / sqrtf(wave_sum64(psh1[(size_t)tk * 64 + lane]) * (1.f / 2048.f) + 1e-6f)) * (1.f / U8_SCALE);
#pragma unroll
    for (int j = 0; j < 2; ++j) { const v4u a0 = *(const GAS v4u*)(H1B + (size_t)tk * 2048 + 1024 * j + 16 * lane), a1 = *(const GAS v4u*)(H1B + (size_t)tk * 2048 + 1024 * j + 16 * lane + 8);
        const unsigned aw[8] = {a0.x, a0.y, a0.z, a0.w, a1.x, a1.y, a1.z, a1.w};
#pragma unroll
        for (int d = 0; d < 4; ++d) *(LAS f32x4*)(afl + (4 * j + d) * 1024 + lane * 16) = (f32x4){__uint_as_float(aw[2 * d] << 16), __uint_as_float(aw[2 * d] & 0xffff0000u), __uint_as_float(aw[2 * d + 1] << 16), __uint_as_float(aw[2 * d + 1] & 0xffff0000u)};
#pragma unroll
        for (int q = 0; q < 4; ++q) { const f32x4 x = *(const GAS f32x4*)(H1 + (size_t)tk * 2048 + 1024 * j + 16 * lane + 4 * q); T.acc[8 * j + 2 * q] = (f32x2c){x[0], x[1]}; T.acc[8 * j + 2 * q + 1] = (f32x2c){x[2], x[3]}; } }
    T.ev[0] = IDX[(size_t)tk * 128 + lane]; T.ev[1] = IDX[(size_t)tk * 128 + 64 + lane]; T.gv[0] = GATE[(size_t)tk * 128 + lane]; T.gv[1] = GATE[(size_t)tk * 128 + 64 + lane];
}
template <bool DRY> __device__ __forceinline__ void tok3_store(unsigned char* ws, int tk, int lane, const Acc2& T) {
    float* H1 = (float*)(ws + WS_H1); bf16* H1B = (bf16*)(ws + WS_H1B); float* rsh2 = (float*)(ws + WS_RSH2);
    float ss = 0.f;
    float* H1o = DRY ? (float*)(ws + WS_NA0) + (size_t)(tk & 2047) * 2048 : H1 + (size_t)tk * 2048; bf16* H1Bo = DRY ? (bf16*)(ws + WS_NGL) + (size_t)(tk & 2047) * 2048 : H1B + (size_t)tk * 2048;
#pragma unroll
    for (int j = 0; j < 2; ++j) {
#pragma unroll
        for (int q = 0; q < 2; ++q) { const f32x4 y0 = {T.acc[8 * j + 4 * q].x, T.acc[8 * j + 4 * q].y, T.acc[8 * j + 4 * q + 1].x, T.acc[8 * j + 4 * q + 1].y}, y1 = {T.acc[8 * j + 4 * q + 2].x, T.acc[8 * j + 4 * q + 2].y, T.acc[8 * j + 4 * q + 3].x, T.acc[8 * j + 4 * q + 3].y}; ss += sq8(y0, y1);
            *(GAS f32x4*)(H1o + 1024 * j + 16 * lane + 8 * q) = y0; *(GAS f32x4*)(H1o + 1024 * j + 16 * lane + 8 * q + 4) = y1; *(GAS v4u*)(H1Bo + 1024 * j + 16 * lane + 8 * q) = pack8(y0, y1); } }
    ss = wave_sum64(ss); if (lane == 0 && !DRY) rsh2[tk] = 1.0f / sqrtf(ss * (1.f / 2048.f) + 1e-6f);
}
__device__ __forceinline__ void batch3(Acc2& T, const LAS unsigned char* afl, const Row2& u0, const Row2& u1, const Row2& v0, const Row2& v1, float g0, float g1, int lane) {
    f32x2c s0 = {0.f, 0.f}, s1 = {0.f, 0.f}, t0 = {0.f, 0.f}, t1 = {0.f, 0.f};
    f32x4 aa[8];
#pragma unroll
    for (int c = 0; c < 8; ++c) aa[c] = *(const LAS f32x4*)(afl + c * 1024 + lane * 16);
    asm volatile("s_waitcnt lgkmcnt(0)" : "+v"(aa[0]), "+v"(aa[1]), "+v"(aa[2]), "+v"(aa[3]), "+v"(aa[4]), "+v"(aa[5]), "+v"(aa[6]), "+v"(aa[7]));
#pragma unroll
    for (int j = 0; j < 2; ++j) { const unsigned w0[4] = {u0.c[j].x, u0.c[j].y, u0.c[j].z, u0.c[j].w}, w1[4] = {u1.c[j].x, u1.c[j].y, u1.c[j].z, u1.c[j].w};
#pragma unroll
        for (int d = 0; d < 4; ++d) { const f32x4 a = aa[4 * j + d]; const f32x2c alo = {a[0], a[1]}, ahi = {a[2], a[3]};
            s0 = __builtin_elementwise_fma(alo, __builtin_amdgcn_cvt_pk_f32_fp8((int)w0[d], false), s0); s1 = __builtin_elementwise_fma(ahi, __builtin_amdgcn_cvt_pk_f32_fp8((int)w0[d], true), s1);
            t0 = __builtin_elementwise_fma(alo, __builtin_amdgcn_cvt_pk_f32_fp8((int)w1[d], false), t0); t1 = __builtin_elementwise_fma(ahi, __builtin_amdgcn_cvt_pk_f32_fp8((int)w1[d], true), t1); } }
    const f32x2c ps = s0 + s1, pt = t0 + t1;
    const float h = reduce2(ps.x + ps.y, pt.x + pt.y);
    const float w = ((lane & 32) ? g1 : g0) * gelu_f(h * T.rs) * (1.f / V8_SCALE);
    const float wa = __uint_as_float((unsigned)__builtin_amdgcn_readlane((int)__float_as_uint(w), 31)), wb = __uint_as_float((unsigned)__builtin_amdgcn_readlane((int)__float_as_uint(w), 63));
    const f32x2c wa2 = {wa, wa}, wb2 = {wb, wb};
#pragma unroll
    for (int j = 0; j < 2; ++j) { const unsigned w0[4] = {v0.c[j].x, v0.c[j].y, v0.c[j].z, v0.c[j].w}, w1[4] = {v1.c[j].x, v1.c[j].y, v1.c[j].z, v1.c[j].w};
#pragma unroll
        for (int d = 0; d < 4; ++d) {
            T.acc[8 * j + 2 * d] = __builtin_elementwise_fma(wa2, __builtin_amdgcn_cvt_pk_f32_fp8((int)w0[d], false), T.acc[8 * j + 2 * d]); T.acc[8 * j + 2 * d + 1] = __builtin_elementwise_fma(wa2, __builtin_amdgcn_cvt_pk_f32_fp8((int)w0[d], true), T.acc[8 * j + 2 * d + 1]);
            T.acc[8 * j + 2 * d] = __builtin_elementwise_fma(wb2, __builtin_amdgcn_cvt_pk_f32_fp8((int)w1[d], false), T.acc[8 * j + 2 * d]); T.acc[8 * j + 2 * d + 1] = __builtin_elementwise_fma(wb2, __builtin_amdgcn_cvt_pk_f32_fp8((int)w1[d], true), T.acc[8 * j + 2 * d + 1]); } }
}
struct Sweep { int s; unsigned long long a0, a1, b0, b1; };
__device__ __forceinline__ int take2b(unsigned long long& m0, unsigned long long& m1, const int (&ev)[2], const float (&gv)[2], int& e0, float& g0, int& e1, float& g1) {
    if (!(m0 | m1)) return 0;
    if (m0) { const int i = __builtin_ctzll(m0); m0 &= m0 - 1; e0 = __builtin_amdgcn_readlane(ev[0], i); g0 = __uint_as_float((unsigned)__builtin_amdgcn_readlane((int)__float_as_uint(gv[0]), i)); }
    else { const int i = __builtin_ctzll(m1); m1 &= m1 - 1; e0 = __builtin_amdgcn_readlane(ev[1], i); g0 = __uint_as_float((unsigned)__builtin_amdgcn_readlane((int)__float_as_uint(gv[1]), i)); }
    if (m0) { const int i = __builtin_ctzll(m0); m0 &= m0 - 1; e1 = __builtin_amdgcn_readlane(ev[0], i); g1 = __uint_as_float((unsigned)__builtin_amdgcn_readlane((int)__float_as_uint(gv[0]), i)); return 2; }
    if (m1) { const int i = __builtin_ctzll(m1); m1 &= m1 - 1; e1 = __builtin_amdgcn_readlane(ev[1], i); g1 = __uint_as_float((unsigned)__builtin_amdgcn_readlane((int)__float_as_uint(gv[1]), i)); return 2; }
    e1 = e0; g1 = 0.f; return 1;
}
__device__ __forceinline__ void gen_load(Sweep& W, const Acc2& TA, const Acc2& TB, const GAS unsigned char* UB, const GAS unsigned char* VB, unsigned lane16, It8& I) {
    while (!(W.a0 | W.a1 | W.b0 | W.b1) && W.s + 1 < (16384 >> NSLICE_SHIFT)) { ++W.s;
        W.a0 = __ballot((TA.ev[0] >> NSLICE_SHIFT) == W.s); W.a1 = __ballot((TA.ev[1] >> NSLICE_SHIFT) == W.s); W.b0 = __ballot((TB.ev[0] >> NSLICE_SHIFT) == W.s); W.b1 = __ballot((TB.ev[1] >> NSLICE_SHIFT) == W.s); }
    int eA0 = 0, eA1 = 0, eB0 = 0, eB1 = 0; I.gA0 = 0.f; I.gA1 = 0.f; I.gB0 = 0.f; I.gB1 = 0.f;
    I.nA = take2b(W.a0, W.a1, TA.ev, TA.gv, eA0, I.gA0, eA1, I.gA1); I.nB = take2b(W.b0, W.b1, TB.ev, TB.gv, eB0, I.gB0, eB1, I.gB1);
    if (!I.nA) { eA0 = eB0; eA1 = eB1; } if (!I.nB) { eB0 = eA0; eB1 = eA1; }
    I.uA0 = load_row8(UB, (unsigned)eA0, lane16); I.uA1 = load_row8(UB, (unsigned)eA1, lane16); I.vA0 = load_row8(VB, (unsigned)eA0, lane16); I.vA1 = load_row8(VB, (unsigned)eA1, lane16);
    I.uB0 = load_row8(UB, (unsigned)eB0, lane16); I.uB1 = load_row8(UB, (unsigned)eB1, lane16); I.vB0 = load_row8(VB, (unsigned)eB0, lane16); I.vB1 = load_row8(VB, (unsigned)eB1, lane16);
}
template <bool DRY> __device__ __forceinline__ void gather_sliced3_phase(const Args& A, Frame& F) {
    unsigned char* ws = A.ws;
    const GAS unsigned char* UB = (const GAS unsigned char*)(ws + WS_UB); const GAS unsigned char* VB = (const GAS unsigned char*)(ws + WS_VB);
    const int gw = F.vcu * NWAVES + F.wave, NGW = F.G * NWAVES;
    LAS unsigned char* aflA = F.lds + RING_OFF + F.wave * 16384; LAS unsigned char* aflB = aflA + 8192;
    for (int tk0 = 2 * gw; tk0 < T_TOK; tk0 += 2 * NGW) {
        const int lane = lane_id(); const unsigned lane16 = (unsigned)lane * 16u;
        Acc2 TA, TB; tok3_load(ws, tk0, lane, TA, aflA); tok3_load(ws, tk0 + 1, lane, TB, aflB);
        Sweep W; W.s = -1; W.a0 = W.a1 = W.b0 = W.b1 = 0ull;
        It8 X, Y;
        gen_load(W, TA, TB, UB, VB, lane16, X);
        for (;;) {
            gen_load(W, TA, TB, UB, VB, lane16, Y);
            if (X.nA) batch3(TA, aflA, X.uA0, X.uA1, X.vA0, X.vA1, X.gA0, X.gA1, lane);
            if (X.nB) batch3(TB, aflB, X.uB0, X.uB1, X.vB0, X.vB1, X.gB0, X.gB1, lane);
            if (!(Y.nA | Y.nB)) break;
            gen_load(W, TA, TB, UB, VB, lane16, X);
            if (Y.nA) batch3(TA, aflA, Y.uA0, Y.uA1, Y.vA0, Y.vA1, Y.gA0, Y.gA1, lane);
            if (Y.nB) batch3(TB, aflB, Y.uB0, Y.uB1, Y.vB0, Y.vB1, Y.gB0, Y.gB1, lane);
            if (!(X.nA | X.nB)) break;
        }
        tok3_store<DRY>(ws, tk0, lane, TA); tok3_store<DRY>(ws, tk0 + 1, lane, TB);
    }
}
struct It4 { int tok; float g0, g1; Row2 u0, u1, v0, v1; };
__device__ __forceinline__ void gen4(Sweep& W, const Tok2& TA, const Tok2& TB, const GAS unsigned char* UB, const GAS unsigned char* VB, unsigned lane16, It4& I) {
    while (!(W.a0 | W.a1 | W.b0 | W.b1) && W.s + 1 < (16384 >> NSLICE_SHIFT)) { ++W.s;
        W.a0 = __ballot((TA.ev[0] >> NSLICE_SHIFT) == W.s); W.a1 = __ballot((TA.ev[1] >> NSLICE_SHIFT) == W.s); W.b0 = __ballot((TB.ev[0] >> NSLICE_SHIFT) == W.s); W.b1 = __ballot((TB.ev[1] >> NSLICE_SHIFT) == W.s); }
    int e0 = 0, e1 = 0; I.g0 = 0.f; I.g1 = 0.f; I.tok = -1;
    if (W.a0 | W.a1) { take2b(W.a0, W.a1, TA.ev, TA.gv, e0, I.g0, e1, I.g1); I.tok = 0; }
    else if (W.b0 | W.b1) { take2b(W.b0, W.b1, TB.ev, TB.gv, e0, I.g0, e1, I.g1); I.tok = 1; }
    I.u0 = load_row8(UB, (unsigned)e0, lane16); I.u1 = load_row8(UB, (unsigned)e1, lane16); I.v0 = load_row8(VB, (unsigned)e0, lane16); I.v1 = load_row8(VB, (unsigned)e1, lane16);
}
template <bool DRY> __device__ __forceinline__ void gather_sliced4_phase(const Args& A, Frame& F) {
    unsigned char* ws = A.ws;
    const GAS unsigned char* UB = (const GAS unsigned char*)(ws + WS_UB); const GAS unsigned char* VB = (const GAS unsigned char*)(ws + WS_VB);
    const int gw = F.vcu * NWAVES + F.wave, NGW = F.G * NWAVES;
    for (int tk0 = 2 * gw; tk0 < T_TOK; tk0 += 2 * NGW) {
        const int lane = lane_id(); const unsigned lane16 = (unsigned)lane * 16u;
        Tok2 TA, TB; tok2_load(ws, tk0, lane, TA); tok2_load(ws, tk0 + 1, lane, TB);
        Sweep W; W.s = -1; W.a0 = W.a1 = W.b0 = W.b1 = 0ull;
        It4 X, Y;
        gen4(W, TA, TB, UB, VB, lane16, X);
        for (;;) {
            gen4(W, TA, TB, UB, VB, lane16, Y);
            if (X.tok == 0) batch2(TA, X.u0, X.u1, X.v0, X.v1, X.g0, X.g1, lane); else if (X.tok == 1) batch2(TB, X.u0, X.u1, X.v0, X.v1, X.g0, X.g1, lane);
            if (Y.tok < 0) break;
            gen4(W, TA, TB, UB, VB, lane16, X);
            if (Y.tok == 0) batch2(TA, Y.u0, Y.u1, Y.v0, Y.v1, Y.g0, Y.g1, lane); else if (Y.tok == 1) batch2(TB, Y.u0, Y.u1, Y.v0, Y.v1, Y.g0, Y.g1, lane);
            if (X.tok < 0) break;
        }
        tok2_store<DRY>(ws, tk0, lane, TA); tok2_store<DRY>(ws, tk0 + 1, lane, TB);
    }
}
__device__ __forceinline__ void gen5(Sweep& W, const Acc2& TA, const Acc2& TB, const GAS unsigned char* UB, const GAS unsigned char* VB, unsigned lane16, It4& I) {
    while (!(W.a0 | W.a1 | W.b0 | W.b1) && W.s + 1 < (16384 >> NSLICE_SHIFT)) { ++W.s;
        W.a0 = __ballot((TA.ev[0] >> NSLICE_SHIFT) == W.s); W.a1 = __ballot((TA.ev[1] >> NSLICE_SHIFT) == W.s); W.b0 = __ballot((TB.ev[0] >> NSLICE_SHIFT) == W.s); W.b1 = __ballot((TB.ev[1] >> NSLICE_SHIFT) == W.s); }
    int e0 = 0, e1 = 0; I.g0 = 0.f; I.g1 = 0.f; I.tok = -1;
    if (W.a0 | W.a1) { take2b(W.a0, W.a1, TA.ev, TA.gv, e0, I.g0, e1, I.g1); I.tok = 0; }
    else if (W.b0 | W.b1) { take2b(W.b0, W.b1, TB.ev, TB.gv, e0, I.g0, e1, I.g1); I.tok = 1; }
    I.u0 = load_row8(UB, (unsigned)e0, lane16); I.u1 = load_row8(UB, (unsigned)e1, lane16); I.v0 = load_row8(VB, (unsigned)e0, lane16); I.v1 = load_row8(VB, (unsigned)e1, lane16);
}
template <bool DRY> __device__ __forceinline__ void gather_sliced5_phase(const Args& A, Frame& F) {
    unsigned char* ws = A.ws;
    const GAS unsigned char* UB = (const GAS unsigned char*)(ws + WS_UB); const GAS unsigned char* VB = (const GAS unsigned char*)(ws + WS_VB);
    const int gw = F.vcu * NWAVES + F.wave, NGW = F.G * NWAVES;
    LAS unsigned char* aflA = F.lds + RING_OFF + F.wave * 16384; LAS unsigned char* aflB = aflA + 8192;
    for (int tk0 = 2 * gw; tk0 < T_TOK; tk0 += 2 * NGW) {
        const int lane = lane_id(); const unsigned lane16 = (unsigned)lane * 16u;
        Acc2 TA, TB; tok3_load(ws, tk0, lane, TA, aflA); tok3_load(ws, tk0 + 1, lane, TB, aflB);
        Sweep W; W.s = -1; W.a0 = W.a1 = W.b0 = W.b1 = 0ull;
        It4 X, Y;
        gen5(W, TA, TB, UB, VB, lane16, X);
        for (;;) {
            gen5(W, TA, TB, UB, VB, lane16, Y);
            if (X.tok == 0) batch3(TA, aflA, X.u0, X.u1, X.v0, X.v1, X.g0, X.g1, lane); else if (X.tok == 1) batch3(TB, aflB, X.u0, X.u1, X.v0, X.v1, X.g0, X.g1, lane);
            if (Y.tok < 0) break;
            gen5(W, TA, TB, UB, VB, lane16, X);
            if (Y.tok == 0) batch3(TA, aflA, Y.u0, Y.u1, Y.v0, Y.v1, Y.g0, Y.g1, lane); else if (Y.tok == 1) batch3(TB, aflB, Y.u0, Y.u1, Y.v0, Y.v1, Y.g0, Y.g1, lane);
            if (X.tok < 0) break;
        }
        tok3_store<DRY>(ws, tk0, lane, TA); tok3_store<DRY>(ws, tk0 + 1, lane, TB);
    }
}
struct Cur { int s; unsigned long long m0, m1; };
__device__ __forceinline__ int gen6(Cur& C, const Tok2& T, const GAS unsigned char* UB, const GAS unsigned char* VB, unsigned lane16, Row2& u0, Row2& u1, Row2& v0, Row2& v1, float& g0, float& g1) {
    while (!(C.m0 | C.m1) && C.s + 1 < (16384 >> NSLICE_SHIFT)) { ++C.s; C.m0 = __ballot((T.ev[0] >> NSLICE_SHIFT) == C.s); C.m1 = __ballot((T.ev[1] >> NSLICE_SHIFT) == C.s); }
    int e0 = 0, e1 = 0; g0 = 0.f; g1 = 0.f;
    const int n = take2b(C.m0, C.m1, T.ev, T.gv, e0, g0, e1, g1);
    u0 = load_row8(UB, (unsigned)e0, lane16); u1 = load_row8(UB, (unsigned)e1, lane16); v0 = load_row8(VB, (unsigned)e0, lane16); v1 = load_row8(VB, (unsigned)e1, lane16);
    return n;
}
template <bool DRY> __device__ __forceinline__ void gather_sliced6_phase(const Args& A, Frame& F) {
    unsigned char* ws = A.ws;
    const GAS unsigned char* UB = (const GAS unsigned char*)(ws + WS_UB); const GAS unsigned char* VB = (const GAS unsigned char*)(ws + WS_VB);
    const int gw = F.vcu * NWAVES + F.wave, NGW = F.G * NWAVES;
    for (int tk0 = 2 * gw; tk0 < T_TOK; tk0 += 2 * NGW) {
        const int lane = lane_id(); const unsigned lane16 = (unsigned)lane * 16u;
        Tok2 TA, TB; tok2_load(ws, tk0, lane, TA); SBAR(); tok2_load(ws, tk0 + 1, lane, TB); SBAR();
        Cur CA, CB; CA.s = -1; CA.m0 = CA.m1 = 0ull; CB.s = -1; CB.m0 = CB.m1 = 0ull;
        Row2 uA0, uA1, vA0, vA1, uB0, uB1, vB0, vB1; float gA0, gA1, gB0, gB1;
        int nA = gen6(CA, TA, UB, VB, lane16, uA0, uA1, vA0, vA1, gA0, gA1), nB = gen6(CB, TB, UB, VB, lane16, uB0, uB1, vB0, vB1, gB0, gB1);
        while (nA | nB) {
            if (nA) batch2(TA, uA0, uA1, vA0, vA1, gA0, gA1, lane);
            SBAR(); nA = gen6(CA, TA, UB, VB, lane16, uA0, uA1, vA0, vA1, gA0, gA1); SBAR();
            if (nB) batch2(TB, uB0, uB1, vB0, vB1, gB0, gB1, lane);
            SBAR(); nB = gen6(CB, TB, UB, VB, lane16, uB0, uB1, vB0, vB1, gB0, gB1); SBAR();
        }
        tok2_store<DRY>(ws, tk0, lane, TA); tok2_store<DRY>(ws, tk0 + 1, lane, TB);
    }
}
__device__ __forceinline__ int gen7(Cur& C, const Acc2& T, const GAS unsigned char* UB, const GAS unsigned char* VB, unsigned lane16, Row2& u0, Row2& u1, Row2& v0, Row2& v1, float& g0, float& g1) {
    while (!(C.m0 | C.m1) && C.s + 1 < (16384 >> NSLICE_SHIFT)) { ++C.s; C.m0 = __ballot((T.ev[0] >> NSLICE_SHIFT) == C.s); C.m1 = __ballot((T.ev[1] >> NSLICE_SHIFT) == C.s); }
    int e0 = 0, e1 = 0; g0 = 0.f; g1 = 0.f;
    const int n = take2b(C.m0, C.m1, T.ev, T.gv, e0, g0, e1, g1);
    u0 = load_row8(UB, (unsigned)e0, lane16); u1 = load_row8(UB, (unsigned)e1, lane16); v0 = load_row8(VB, (unsigned)e0, lane16); v1 = load_row8(VB, (unsigned)e1, lane16);
    return n;
}
template <bool DRY> __device__ __forceinline__ void gather_sliced7_phase(const Args& A, Frame& F) {
    unsigned char* ws = A.ws;
    const GAS unsigned char* UB = (const GAS unsigned char*)(ws + WS_UB); const GAS unsigned char* VB = (const GAS unsigned char*)(ws + WS_VB);
    const int gw = F.vcu * NWAVES + F.wave, NGW = F.G * NWAVES;
    LAS unsigned char* aflA = F.lds + RING_OFF + F.wave * 16384; LAS unsigned char* aflB = aflA + 8192;
    for (int tk0 = 2 * gw; tk0 < T_TOK; tk0 += 2 * NGW) {
        const int lane = lane_id(); const unsigned lane16 = (unsigned)lane * 16u;
        Acc2 TA, TB; tok3_load(ws, tk0, lane, TA, aflA); tok3_load(ws, tk0 + 1, lane, TB, aflB);
        Cur CA, CB; CA.s = -1; CA.m0 = CA.m1 = 0ull; CB.s = -1; CB.m0 = CB.m1 = 0ull;
        Row2 uA0, uA1, vA0, vA1, uB0, uB1, vB0, vB1; float gA0, gA1, gB0, gB1;
        int nA = gen7(CA, TA, UB, VB, lane16, uA0, uA1, vA0, vA1, gA0, gA1), nB = gen7(CB, TB, UB, VB, lane16, uB0, uB1, vB0, vB1, gB0, gB1);
        while (nA | nB) {
            if (nA) batch3(TA, aflA, uA0, uA1, vA0, vA1, gA0, gA1, lane);
            nA = gen7(CA, TA, UB, VB, lane16, uA0, uA1, vA0, vA1, gA0, gA1);
            if (nB) batch3(TB, aflB, uB0, uB1, vB0, vB1, gB0, gB1, lane);
            nB = gen7(CB, TB, UB, VB, lane16, uB0, uB1, vB0, vB1, gB0, gB1);
        }
        tok3_store<DRY>(ws, tk0, lane, TA); tok3_store<DRY>(ws, tk0 + 1, lane, TB);
    }
}
__device__ __forceinline__ void fma8_lo(f32x2c& s, f32x2c a, unsigned w) { f32x2c t; asm("v_cvt_pk_f32_fp8_e32 %1, %3\n\tv_pk_fma_f32 %0, %2, %1, %0" : "+v"(s), "=&v"(t) : "v"(a), "v"(w)); }
__device__ __forceinline__ void fma8_hi(f32x2c& s, f32x2c a, unsigned w) { f32x2c t; asm("v_cvt_pk_f32_fp8_sdwa %1, %3 src0_sel:WORD_1\n\tv_pk_fma_f32 %0, %2, %1, %0" : "+v"(s), "=&v"(t) : "v"(a), "v"(w)); }
__device__ __forceinline__ void dots2(const Tok2& T, const Row2& u0, const Row2& u1, float& p0, float& p1) {
    f32x2c s0 = {0.f, 0.f}, s1 = {0.f, 0.f};
#pragma unroll
    for (int j = 0; j < 2; ++j) { const unsigned w0[4] = {u0.c[j].x, u0.c[j].y, u0.c[j].z, u0.c[j].w}, w1[4] = {u1.c[j].x, u1.c[j].y, u1.c[j].z, u1.c[j].w};
#pragma unroll
        for (int d = 0; d < 4; ++d) { fma8_lo(s0, T.af[8 * j + 2 * d], w0[d]); fma8_lo(s1, T.af[8 * j + 2 * d], w1[d]); fma8_hi(s0, T.af[8 * j + 2 * d + 1], w0[d]); fma8_hi(s1, T.af[8 * j + 2 * d + 1], w1[d]); } }
    p0 = s0.x + s0.y; p1 = s1.x + s1.y;
}
__device__ __forceinline__ void axpy2(Tok2& T, const Row2& v0, const Row2& v1, float wa, float wb) { const f32x2c wa2 = {wa, wa}, wb2 = {wb, wb};
#pragma unroll
    for (int j = 0; j < 2; ++j) { const unsigned w0[4] = {v0.c[j].x, v0.c[j].y, v0.c[j].z, v0.c[j].w}, w1[4] = {v1.c[j].x, v1.c[j].y, v1.c[j].z, v1.c[j].w};
#pragma unroll
        for (int d = 0; d < 4; ++d) { fma8_lo(T.acc[8 * j + 2 * d], wa2, w0[d]); fma8_hi(T.acc[8 * j + 2 * d + 1], wa2, w0[d]); fma8_lo(T.acc[8 * j + 2 * d], wb2, w1[d]); fma8_hi(T.acc[8 * j + 2 * d + 1], wb2, w1[d]); } }
}
__device__ __forceinline__ void gates2(const Tok2& T, float p0, float p1, float g0, float g1, int lane, float& w0, float& w1) {
    const float h = reduce2(p0, p1); const float w = ((lane & 32) ? g1 : g0) * gelu_f(h * T.rs) * (1.f / V8_SCALE);
    w0 = __uint_as_float((unsigned)__builtin_amdgcn_readlane((int)__float_as_uint(w), 31)); w1 = __uint_as_float((unsigned)__builtin_amdgcn_readlane((int)__float_as_uint(w), 63));
}
__device__ __forceinline__ int next8(Cur& C, const Tok2& T, int& e0, int& e1, float& g0, float& g1) {
    while (!(C.m0 | C.m1) && C.s + 1 < (16384 >> NSLICE_SHIFT)) { ++C.s; C.m0 = __ballot((T.ev[0] >> NSLICE_SHIFT) == C.s); C.m1 = __ballot((T.ev[1] >> NSLICE_SHIFT) == C.s); }
    e0 = 0; e1 = 0; g0 = 0.f; g1 = 0.f; return take2b(C.m0, C.m1, T.ev, T.gv, e0, g0, e1, g1);
}
__device__ __forceinline__ Row2 load_row8b(__amdgpu_buffer_rsrc_t rs, unsigned e, unsigned lane16) { Row2 r; r.c[0] = __builtin_amdgcn_raw_buffer_load_b128(rs, lane16, e * 2048u, 0); r.c[1] = __builtin_amdgcn_raw_buffer_load_b128(rs, lane16 + 1024u, e * 2048u, 0); return r; }
template <bool DRY> __device__ __forceinline__ void gather_sliced8_phase(const Args& A, Frame& F) {
    unsigned char* ws = A.ws;
    const GAS unsigned char* UB = (const GAS unsigned char*)(ws + WS_UB); const GAS unsigned char* VB = (const GAS unsigned char*)(ws + WS_VB);
    const int gw = F.vcu * NWAVES + F.wave, NGW = F.G * NWAVES;
    const __amdgpu_buffer_rsrc_t RU = __builtin_amdgcn_make_buffer_rsrc((void*)(ws + WS_UB), 0, 16384 * 2048, 0x00020000), RV = __builtin_amdgcn_make_buffer_rsrc((void*)(ws + WS_VB), 0, 16384 * 2048, 0x00020000);
    for (int tk0 = 2 * gw; tk0 < T_TOK; tk0 += 2 * NGW) {
        const int lane = lane_id(); const unsigned lane16 = (unsigned)lane * 16u;
        Tok2 TA, TB; tok2_load(ws, tk0, lane, TA); tok2_load(ws, tk0 + 1, lane, TB);
        Cur CA, CB; CA.s = -1; CA.m0 = CA.m1 = 0ull; CB.s = -1; CB.m0 = CB.m1 = 0ull;
        Row2 uA0, uA1, vA0, vA1, uB0, uB1, vB0, vB1;
        int eA0, eA1, eB0, eB1; float gA0, gA1, gB0, gB1;
        int nA = next8(CA, TA, eA0, eA1, gA0, gA1), nB = next8(CB, TB, eB0, eB1, gB0, gB1);
        uA0 = load_row8b(RU, (unsigned)eA0, lane16); uA1 = load_row8b(RU, (unsigned)eA1, lane16); uB0 = load_row8b(RU, (unsigned)eB0, lane16); uB1 = load_row8b(RU, (unsigned)eB1, lane16);
        vA0 = load_row8b(RV, (unsigned)eA0, lane16); vA1 = load_row8b(RV, (unsigned)eA1, lane16); vB0 = load_row8b(RV, (unsigned)eB0, lane16); vB1 = load_row8b(RV, (unsigned)eB1, lane16);
        do {
            float wA0 = 0.f, wA1 = 0.f, wB0 = 0.f, wB1 = 0.f; const int cA = nA, cB = nB;
            if (cA) { float p0, p1; dots2(TA, uA0, uA1, p0, p1); gates2(TA, p0, p1, gA0, gA1, lane, wA0, wA1); }
            nA = next8(CA, TA, eA0, eA1, gA0, gA1); SBAR(); uA0 = load_row8b(RU, (unsigned)eA0, lane16); uA1 = load_row8b(RU, (unsigned)eA1, lane16); SBAR();
            if (cB) { float p0, p1; dots2(TB, uB0, uB1, p0, p1); gates2(TB, p0, p1, gB0, gB1, lane, wB0, wB1); }
            nB = next8(CB, TB, eB0, eB1, gB0, gB1); SBAR(); uB0 = load_row8b(RU, (unsigned)eB0, lane16); uB1 = load_row8b(RU, (unsigned)eB1, lane16); SBAR();
            if (cA) axpy2(TA, vA0, vA1, wA0, wA1);
            SBAR(); vA0 = load_row8b(RV, (unsigned)eA0, lane16); vA1 = load_row8b(RV, (unsigned)eA1, lane16); SBAR();
            if (cB) axpy2(TB, vB0, vB1, wB0, wB1);
            SBAR(); vB0 = load_row8b(RV, (unsigned)eB0, lane16); vB1 = load_row8b(RV, (unsigned)eB1, lane16); SBAR();
        } while (nA | nB);
        tok2_store<DRY>(ws, tk0, lane, TA); tok2_store<DRY>(ws, tk0 + 1, lane, TB);
    }
}
typedef int v8i __attribute__((ext_vector_type(8)));
struct Tok9 { f32x2c acc[16]; Row2 ahi, alo; float rs; int ev[2]; float gv[2]; };
__device__ __forceinline__ unsigned pk4_fp8(float a, float b, float c, float d) { int t = 0; t = __builtin_amdgcn_cvt_pk_fp8_f32(a, b, t, false); t = __builtin_amdgcn_cvt_pk_fp8_f32(c, d, t, true); return (unsigned)t; }
__device__ __forceinline__ void tok9_load(const unsigned char* ws, int tk, int lane, Tok9& T) {
    const float* H1 = (const float*)(ws + WS_H1); const bf16* H1B = (const bf16*)(ws + WS_H1B); const float* psh1 = (const float*)(ws + WS_PSH1); const int* IDX = (const int*)(ws + WS_IDX); const float* GATE = (const float*)(ws + WS_GATE);
    T.rs = (1.0f / sqrtf(wave_sum64(psh1[(size_t)tk * 64 + lane]) * (1.f / 2048.f) + 1e-6f)) * (1.f / U8_SCALE);
#pragma unroll
    for (int j = 0; j < 2; ++j) { const v4u a0 = *(const GAS v4u*)(H1B + (size_t)tk * 2048 + 1024 * j + 16 * lane), a1 = *(const GAS v4u*)(H1B + (size_t)tk * 2048 + 1024 * j + 16 * lane + 8);
        const unsigned aw[8] = {a0.x, a0.y, a0.z, a0.w, a1.x, a1.y, a1.z, a1.w}; unsigned hi4[4], lo4[4];
#pragma unroll
        for (int d = 0; d < 4; ++d) { const float x0 = __uint_as_float(aw[2 * d] << 16), x1 = __uint_as_float(aw[2 * d] & 0xffff0000u), x2 = __uint_as_float(aw[2 * d + 1] << 16), x3 = __uint_as_float(aw[2 * d + 1] & 0xffff0000u);
            const unsigned h = pk4_fp8(x0, x1, x2, x3); const f32x2c l = __builtin_amdgcn_cvt_pk_f32_fp8((int)h, false), u = __builtin_amdgcn_cvt_pk_f32_fp8((int)h, true);
            hi4[d] = h; lo4[d] = pk4_fp8((x0 - l.x) * 16.f, (x1 - l.y) * 16.f, (x2 - u.x) * 16.f, (x3 - u.y) * 16.f); }
        T.ahi.c[j] = (v4u){hi4[0], hi4[1], hi4[2], hi4[3]}; T.alo.c[j] = (v4u){lo4[0], lo4[1], lo4[2], lo4[3]};
#pragma unroll
        for (int q = 0; q < 4; ++q) { const f32x4 x = *(const GAS f32x4*)(H1 + (size_t)tk * 2048 + 1024 * j + 16 * lane + 4 * q); T.acc[8 * j + 2 * q] = (f32x2c){x[0], x[1]}; T.acc[8 * j + 2 * q + 1] = (f32x2c){x[2], x[3]}; } }
    T.ev[0] = IDX[(size_t)tk * 128 + lane]; T.ev[1] = IDX[(size_t)tk * 128 + 64 + lane]; T.gv[0] = GATE[(size_t)tk * 128 + lane]; T.gv[1] = GATE[(size_t)tk * 128 + 64 + lane];
}
template <bool DRY> __device__ __forceinline__ void tok9_store(unsigned char* ws, int tk, const Tok9& T) {
    const int lane = lane_id();
    float* H1 = (float*)(ws + WS_H1); bf16* H1B = (bf16*)(ws + WS_H1B); float* rsh2 = (float*)(ws + WS_RSH2);
    float ss = 0.f;
    float* H1o = DRY ? (float*)(ws + WS_NA0) + (size_t)(tk & 2047) * 2048 : H1 + (size_t)tk * 2048; bf16* H1Bo = DRY ? (bf16*)(ws + WS_NGL) + (size_t)(tk & 2047) * 2048 : H1B + (size_t)tk * 2048;
#pragma unroll
    for (int j = 0; j < 2; ++j) {
#pragma unroll
        for (int q = 0; q < 2; ++q) { const f32x4 y0 = {T.acc[8 * j + 4 * q].x, T.acc[8 * j + 4 * q].y, T.acc[8 * j + 4 * q + 1].x, T.acc[8 * j + 4 * q + 1].y}, y1 = {T.acc[8 * j + 4 * q + 2].x, T.acc[8 * j + 4 * q + 2].y, T.acc[8 * j + 4 * q + 3].x, T.acc[8 * j + 4 * q + 3].y}; ss += sq8(y0, y1);
            *(GAS f32x4*)(H1o + 1024 * j + 16 * lane + 8 * q) = y0; *(GAS f32x4*)(H1o + 1024 * j + 16 * lane + 8 * q + 4) = y1; *(GAS v4u*)(H1Bo + 1024 * j + 16 * lane + 8 * q) = pack8(y0, y1); } }
    ss = wave_sum64(ss); if (lane == 0 && !DRY) rsh2[tk] = 1.0f / sqrtf(ss * (1.f / 2048.f) + 1e-6f);
}
__device__ __forceinline__ v8i as_v8i(const Row2& r) { return (v8i){(int)r.c[0].x, (int)r.c[0].y, (int)r.c[0].z, (int)r.c[0].w, (int)r.c[1].x, (int)r.c[1].y, (int)r.c[1].z, (int)r.c[1].w}; }
__device__ __forceinline__ float dot_mfma(const Tok9& T, const Row2& u, int lane) {
    const v8i ua = as_v8i(u); f32x4 c = {0.f, 0.f, 0.f, 0.f};
    c = __builtin_amdgcn_mfma_scale_f32_16x16x128_f8f6f4(ua, as_v8i(T.ahi), c, 0, 0, 0, 127, 0, 127);
    c = __builtin_amdgcn_mfma_scale_f32_16x16x128_f8f6f4(ua, as_v8i(T.alo), c, 0, 0, 0, 127, 0, 123);
    const int n = lane & 15; const float t0 = (n & 1) ? c[1] : c[0], t1 = (n & 1) ? c[3] : c[2], v = (n & 2) ? t1 : t0;
    return ((lane >> 4) == (n >> 2)) ? v : 0.f;
}
__device__ __forceinline__ void axpy9(Tok9& T, const Row2& v0, const Row2& v1, float wa, float wb) { const f32x2c wa2 = {wa, wa}, wb2 = {wb, wb};
#pragma unroll
    for (int j = 0; j < 2; ++j) { const unsigned w0[4] = {v0.c[j].x, v0.c[j].y, v0.c[j].z, v0.c[j].w}, w1[4] = {v1.c[j].x, v1.c[j].y, v1.c[j].z, v1.c[j].w};
#pragma unroll
        for (int d = 0; d < 4; ++d) { fma8_lo(T.acc[8 * j + 2 * d], wa2, w0[d]); fma8_hi(T.acc[8 * j + 2 * d + 1], wa2, w0[d]); fma8_lo(T.acc[8 * j + 2 * d], wb2, w1[d]); fma8_hi(T.acc[8 * j + 2 * d + 1], wb2, w1[d]); } }
}
__device__ __forceinline__ void batch9(Tok9& T, const Row2& u0, const Row2& u1, const Row2& v0, const Row2& v1, float g0, float g1, int lane) {
    const float h = reduce2(dot_mfma(T, u0, lane), dot_mfma(T, u1, lane));
    const float w = ((lane & 32) ? g1 : g0) * gelu_f(h * T.rs) * (1.f / V8_SCALE);
    const float w0 = __uint_as_float((unsigned)__builtin_amdgcn_readlane((int)__float_as_uint(w), 31)), w1 = __uint_as_float((unsigned)__builtin_amdgcn_readlane((int)__float_as_uint(w), 63));
    axpy9(T, v0, v1, w0, w1);
}
__device__ __forceinline__ int take9(unsigned long long& m0, unsigned long long& m1, const Tok9& T, int& e0, float& g0, int& e1, float& g1) { return take2b(m0, m1, T.ev, T.gv, e0, g0, e1, g1); }
template <bool DRY> __device__ __forceinline__ void gather_sliced9_phase(const Args& A, Frame& F) {
    unsigned char* ws = A.ws;
    const int gw = F.vcu * NWAVES + F.wave, NGW = F.G * NWAVES;
    const __amdgpu_buffer_rsrc_t RU = __builtin_amdgcn_make_buffer_rsrc((void*)(ws + WS_UB), 0, 16384 * 2048, 0x00020000), RV = __builtin_amdgcn_make_buffer_rsrc((void*)(ws + WS_VB), 0, 16384 * 2048, 0x00020000);
    for (int tk0 = 2 * gw; tk0 < T_TOK; tk0 += 2 * NGW) {
        const int lane = lane_id(); const unsigned lane16 = (unsigned)lane * 16u;
        Tok9 TA, TB; tok9_load(ws, tk0, lane, TA); tok9_load(ws, tk0 + 1, lane, TB);
        for (int s = 0; s < (16384 >> NSLICE_SHIFT); ++s) {
            unsigned long long a0 = __ballot((TA.ev[0] >> NSLICE_SHIFT) == s), a1 = __ballot((TA.ev[1] >> NSLICE_SHIFT) == s), b0 = __ballot((TB.ev[0] >> NSLICE_SHIFT) == s), b1 = __ballot((TB.ev[1] >> NSLICE_SHIFT) == s);
            while (a0 | a1 | b0 | b1) {
                int eA0 = 0, eA1 = 0, eB0 = 0, eB1 = 0; float gA0 = 0.f, gA1 = 0.f, gB0 = 0.f, gB1 = 0.f;
                const int nA = take9(a0, a1, TA, eA0, gA0, eA1, gA1), nB = take9(b0, b1, TB, eB0, gB0, eB1, gB1);
                if (DRY && PROBE_NOV == 5) { eA0 &= 3; eA1 &= 3; eB0 &= 3; eB1 &= 3; } if (DRY && PROBE_NOV == 4) { eA0 &= 255; eA1 &= 255; eB0 &= 255; eB1 &= 255; }
                Row2 uA0, uA1, vA0, vA1, uB0, uB1, vB0, vB1;
                if (nA) { uA0 = load_row8b(RU, (unsigned)eA0, lane16); vA0 = load_row8b(RV, (unsigned)eA0, lane16); if (nA == 2) { uA1 = load_row8b(RU, (unsigned)eA1, lane16); vA1 = load_row8b(RV, (unsigned)eA1, lane16); } else { uA1 = uA0; vA1 = vA0; } }
                if (nB) { uB0 = load_row8b(RU, (unsigned)eB0, lane16); vB0 = load_row8b(RV, (unsigned)eB0, lane16); if (nB == 2) { uB1 = load_row8b(RU, (unsigned)eB1, lane16); vB1 = load_row8b(RV, (unsigned)eB1, lane16); } else { uB1 = uB0; vB1 = vB0; } }
                if (nA) batch9(TA, uA0, uA1, vA0, vA1, gA0, gA1, lane);
                if (nB) batch9(TB, uB0, uB1, vB0, vB1, gB0, gB1, lane);
            }
        }
        tok9_store<DRY>(ws, tk0, TA); tok9_store<DRY>(ws, tk0 + 1, TB);
    }
}
#ifndef A_FP6
#define A_FP6 1
#endif
__device__ __forceinline__ unsigned e2m3_code(float v) { const float m = fminf(fabsf(v), 7.5f); const float c = m < 2.f ? rintf(8.f * m) : m < 4.f ? rintf(4.f * m) + 8.f : rintf(2.f * m) + 16.f; return (unsigned)c | (v < 0.f ? 32u : 0u); }
__device__ __forceinline__ float e2m3_val(unsigned code) { const unsigned e = (code >> 3) & 3u, m = code & 7u; const float mag = e == 0 ? (float)m * 0.125f : (1.f + (float)m * 0.125f) * (float)(1u << (e - 1)); return (code & 32u) ? -mag : mag; }
__device__ __forceinline__ void pack_a6(const float (&x)[32], v8i& hi, v8i& lo) {
    unsigned long long ah = 0ull, al = 0ull; int nb = 0, k = 0; unsigned dh[6], dl[6];
#pragma unroll
    for (int i = 0; i < 32; ++i) { const float xs = x[i] * 0.5f; const unsigned ch = e2m3_code(xs); const unsigned cl = e2m3_code((xs - e2m3_val(ch)) * 8.f);
        ah |= (unsigned long long)ch << nb; al |= (unsigned long long)cl << nb; nb += 6;
        if (nb >= 32) { dh[k] = (unsigned)ah; dl[k] = (unsigned)al; ++k; ah >>= 32; al >>= 32; nb -= 32; } }
    hi = (v8i){(int)dh[0], (int)dh[1], (int)dh[2], (int)dh[3], (int)dh[4], (int)dh[5], 0, 0}; lo = (v8i){(int)dl[0], (int)dl[1], (int)dl[2], (int)dl[3], (int)dl[4], (int)dl[5], 0, 0};
}
typedef unsigned v6u __attribute__((ext_vector_type(6)));
typedef float v32f __attribute__((ext_vector_type(32)));
typedef float v16f __attribute__((ext_vector_type(16)));
__device__ __forceinline__ v6u pack32_fp6(v16f x0, v16f x1) { v6u r; asm("v_cvt_scalef32_2xpk16_fp6_f32 %0, %1, %2, 1.0" : "=&v"(r) : "v"(x0), "v"(x1)); return r; }
__device__ __forceinline__ v32f unpack32_fp6(v6u p) { v32f r; asm("v_cvt_scalef32_pk32_f32_fp6 %0, %1, 1.0" : "=&v"(r) : "v"(p)); return r; }
constexpr float U6_SCALE = 64.f, V6_SCALE = 4.f;
__device__ __forceinline__ float wave_sum_dpp(float v) {
    DPP_ADD(v, 0xB1, 0xF); DPP_ADD(v, 0x4E, 0xF); DPP_ADD(v, 0x141, 0xF); DPP_ADD(v, 0x140, 0xF); DPP_ADD(v, 0x142, 0xA); DPP_ADD(v, 0x143, 0xC);
    return __uint_as_float((unsigned)__builtin_amdgcn_readlane((int)__float_as_uint(v), 63)); }
struct Row6 { v4u p0; u32x2v p1; };
struct Tok6 { f32x2c acc[16]; v8i ahi, alo; float rs; int ev[2]; float gv[2]; };
__device__ __forceinline__ Row6 load_row6(__amdgpu_buffer_rsrc_t rs, unsigned e, unsigned lane16) { Row6 r; r.p0 = __builtin_amdgcn_raw_buffer_load_b128(rs, lane16, e * 1536u, 0); r.p1 = __builtin_amdgcn_raw_buffer_load_b64(rs, (lane16 >> 1) + 1024u, e * 1536u, 0); return r; }
__device__ __forceinline__ void tok6_load(const unsigned char* ws, int tk, int lane, Tok6& T) {
    const float* H1 = (const float*)(ws + WS_H1); const bf16* H1B = (const bf16*)(ws + WS_H1B); const float* psh1 = (const float*)(ws + WS_PSH1); const int* IDX = (const int*)(ws + WS_IDX); const float* GATE = (const float*)(ws + WS_GATE);
    T.rs = (1.0f / sqrtf(wave_sum_dpp(psh1[(size_t)tk * 64 + lane]) * (1.f / 2048.f) + 1e-6f)) * (1.f / U6_SCALE);
    if (A_FP6 && U_FP6) {
        v16f x0, x1, r0, r1;
#pragma unroll
        for (int q = 0; q < 4; ++q) { const v4u a = *(const GAS v4u*)(H1B + (size_t)tk * 2048 + 32 * lane + 8 * q); const unsigned aw[4] = {a.x, a.y, a.z, a.w};
#pragma unroll
            for (int d = 0; d < 8; ++d) { const float xs = ((d & 1) ? __uint_as_float(aw[d >> 1] & 0xffff0000u) : __uint_as_float(aw[d >> 1] << 16)) * 0.5f;
                const float m = fminf(fabsf(xs), 7.5f), qm = m < 2.f ? rintf(8.f * m) * 0.125f : m < 4.f ? rintf(4.f * m) * 0.25f : rintf(2.f * m) * 0.5f, rr = (xs - copysignf(qm, xs)) * 8.f;
                if (q < 2) { x0[8 * q + d] = xs; r0[8 * q + d] = rr; } else { x1[8 * (q - 2) + d] = xs; r1[8 * (q - 2) + d] = rr; } } }
        const v6u ph = pack32_fp6(x0, x1), pl = pack32_fp6(r0, r1);
        T.ahi = (v8i){(int)ph[0], (int)ph[1], (int)ph[2], (int)ph[3], (int)ph[4], (int)ph[5], 0, 0}; T.alo = (v8i){(int)pl[0], (int)pl[1], (int)pl[2], (int)pl[3], (int)pl[4], (int)pl[5], 0, 0};
    } else { unsigned hi8[8], lo8[8];
#pragma unroll
        for (int q = 0; q < 4; ++q) { const v4u a = *(const GAS v4u*)(H1B + (size_t)tk * 2048 + 32 * lane + 8 * q); const unsigned aw[4] = {a.x, a.y, a.z, a.w};
#pragma unroll
            for (int d = 0; d < 2; ++d) { const float x0 = __uint_as_float(aw[2 * d] << 16), x1 = __uint_as_float(aw[2 * d] & 0xffff0000u), x2 = __uint_as_float(aw[2 * d + 1] << 16), x3 = __uint_as_float(aw[2 * d + 1] & 0xffff0000u);
                const unsigned h = pk4_fp8(x0, x1, x2, x3); const f32x2c l = __builtin_amdgcn_cvt_pk_f32_fp8((int)h, false), u = __builtin_amdgcn_cvt_pk_f32_fp8((int)h, true);
                hi8[2 * q + d] = h; lo8[2 * q + d] = pk4_fp8((x0 - l.x) * 16.f, (x1 - l.y) * 16.f, (x2 - u.x) * 16.f, (x3 - u.y) * 16.f); } }
        T.ahi = (v8i){(int)hi8[0], (int)hi8[1], (int)hi8[2], (int)hi8[3], (int)hi8[4], (int)hi8[5], (int)hi8[6], (int)hi8[7]}; T.alo = (v8i){(int)lo8[0], (int)lo8[1], (int)lo8[2], (int)lo8[3], (int)lo8[4], (int)lo8[5], (int)lo8[6], (int)lo8[7]}; }
    SBAR();
#pragma unroll
    for (int q = 0; q < 8; ++q) { const f32x4 x = *(const GAS f32x4*)(H1 + (size_t)tk * 2048 + 32 * lane + 4 * q); T.acc[2 * q] = (f32x2c){x[0], x[1]}; T.acc[2 * q + 1] = (f32x2c){x[2], x[3]}; }
    T.ev[0] = IDX[(size_t)tk * 128 + lane]; T.ev[1] = IDX[(size_t)tk * 128 + 64 + lane]; T.gv[0] = GATE[(size_t)tk * 128 + lane]; T.gv[1] = GATE[(size_t)tk * 128 + 64 + lane];
    SBAR();
}
template <bool DRY> __device__ __forceinline__ void tok6_store(unsigned char* ws, int tk, const Tok6& T) {
    const int lane = lane_id();
    float* H1 = (float*)(ws + WS_H1); bf16* H1B = (bf16*)(ws + WS_H1B); float* rsh2 = (float*)(ws + WS_RSH2);
    float ss = 0.f;
    float* H1o = DRY ? (float*)(ws + WS_NA0) + (size_t)(tk & 2047) * 2048 : H1 + (size_t)tk * 2048; bf16* H1Bo = DRY ? (bf16*)(ws + WS_NGL) + (size_t)(tk & 2047) * 2048 : H1B + (size_t)tk * 2048;
#pragma unroll
    for (int q = 0; q < 4; ++q) { const f32x4 y0 = {T.acc[4 * q].x, T.acc[4 * q].y, T.acc[4 * q + 1].x, T.acc[4 * q + 1].y}, y1 = {T.acc[4 * q + 2].x, T.acc[4 * q + 2].y, T.acc[4 * q + 3].x, T.acc[4 * q + 3].y}; ss += sq8(y0, y1);
        *(GAS f32x4*)(H1o + 32 * lane + 8 * q) = y0; *(GAS f32x4*)(H1o + 32 * lane + 8 * q + 4) = y1; *(GAS v4u*)(H1Bo + 32 * lane + 8 * q) = pack8(y0, y1); }
    ss = wave_sum_dpp(ss); if (lane == 0 && !DRY) rsh2[tk] = 1.0f / sqrtf(ss * (1.f / 2048.f) + 1e-6f);
}
__device__ __forceinline__ float dot6_mfma(const Tok6& T, const Row6& u, int lane) {
    const v8i ua = {(int)u.p0.x, (int)u.p0.y, (int)u.p0.z, (int)u.p0.w, (int)u.p1.x, (int)u.p1.y, 0, 0}; f32x4 c = {0.f, 0.f, 0.f, 0.f};
    if (A_FP6) { c = __builtin_amdgcn_mfma_scale_f32_16x16x128_f8f6f4(ua, T.ahi, c, 2, 2, 0, 127, 0, 128);
                 c = __builtin_amdgcn_mfma_scale_f32_16x16x128_f8f6f4(ua, T.alo, c, 2, 2, 0, 127, 0, 125); }
    else { c = __builtin_amdgcn_mfma_scale_f32_16x16x128_f8f6f4(ua, T.ahi, c, 2, 0, 0, 127, 0, 127); c = __builtin_amdgcn_mfma_scale_f32_16x16x128_f8f6f4(ua, T.alo, c, 2, 0, 0, 127, 0, 123); }
    const int n = lane & 15; const float t0 = (n & 1) ? c[1] : c[0], t1 = (n & 1) ? c[3] : c[2], v = (n & 2) ? t1 : t0;
    return ((lane >> 4) == (n >> 2)) ? v : 0.f;
}
__device__ __forceinline__ void axpy6(Tok6& T, const Row6& v, float wk) {
    const v32f y = unpack32_fp6((v6u){v.p0.x, v.p0.y, v.p0.z, v.p0.w, v.p1.x, v.p1.y}); const f32x2c w2 = {wk, wk};
#pragma unroll
    for (int i = 0; i < 16; ++i) T.acc[i] = __builtin_elementwise_fma(w2, (f32x2c){y[2 * i], y[2 * i + 1]}, T.acc[i]);
}
__device__ __forceinline__ void batch6(Tok6& T, const Row6& u0, const Row6& u1, const Row6& v0, const Row6& v1, float g0, float g1, int n2, int lane) {
    const float h = reduce2(dot6_mfma(T, u0, lane), dot6_mfma(T, u1, lane));
    const float w = ((lane & 32) ? g1 : g0) * gelu_f(h * T.rs) * (1.f / V6_SCALE);
    const float w0 = __uint_as_float((unsigned)__builtin_amdgcn_readlane((int)__float_as_uint(w), 31)), w1 = __uint_as_float((unsigned)__builtin_amdgcn_readlane((int)__float_as_uint(w), 63));
    SBAR(); axpy6(T, v0, w0); SBAR(); if (n2) axpy6(T, v1, w1); SBAR();
}
template <bool DRY> __device__ __forceinline__ void gather_fp6_phase(const Args& A, Frame& F) {
    unsigned char* ws = A.ws;
    const int gw = F.vcu * NWAVES + F.wave, NGW = F.G * NWAVES;
    const __amdgpu_buffer_rsrc_t RU = __builtin_amdgcn_make_buffer_rsrc((void*)(ws + WS_UB), 0, 16384 * 1536, 0x00020000), RV = __builtin_amdgcn_make_buffer_rsrc((void*)(ws + WS_VB), 0, 16384 * 1536, 0x00020000);
    for (int tk0 = 2 * gw; tk0 < T_TOK; tk0 += 2 * NGW) {
        const int lane = lane_id(); const unsigned lane16 = (unsigned)lane * 16u;
        Tok6 TA, TB; tok6_load(ws, tk0, lane, TA); tok6_load(ws, tk0 + 1, lane, TB);
        for (int s = 0; s < (16384 >> NSLICE_SHIFT); ++s) {
            unsigned long long a0 = __ballot((TA.ev[0] >> NSLICE_SHIFT) == s), a1 = __ballot((TA.ev[1] >> NSLICE_SHIFT) == s), b0 = __ballot((TB.ev[0] >> NSLICE_SHIFT) == s), b1 = __ballot((TB.ev[1] >> NSLICE_SHIFT) == s);
            while (a0 | a1 | b0 | b1) {
                int eA0 = 0, eA1 = 0, eB0 = 0, eB1 = 0; float gA0 = 0.f, gA1 = 0.f, gB0 = 0.f, gB1 = 0.f;
                const int nA = take2b(a0, a1, TA.ev, TA.gv, eA0, gA0, eA1, gA1), nB = take2b(b0, b1, TB.ev, TB.gv, eB0, gB0, eB1, gB1);
                Row6 uA0, uA1, vA0, vA1, uB0, uB1, vB0, vB1;
                if (nA) { uA0 = load_row6(RU, (unsigned)eA0, lane16); vA0 = load_row6(RV, (unsigned)eA0, lane16); if (nA == 2) { uA1 = load_row6(RU, (unsigned)eA1, lane16); vA1 = load_row6(RV, (unsigned)eA1, lane16); } else { uA1 = uA0; vA1 = vA0; } }
                if (nB) { uB0 = load_row6(RU, (unsigned)eB0, lane16); vB0 = load_row6(RV, (unsigned)eB0, lane16); if (nB == 2) { uB1 = load_row6(RU, (unsigned)eB1, lane16); vB1 = load_row6(RV, (unsigned)eB1, lane16); } else { uB1 = uB0; vB1 = vB0; } }
                if (nA) batch6(TA, uA0, uA1, vA0, vA1, gA0, gA1, nA == 2, lane);
                if (nB) batch6(TB, uB0, uB1, vB0, vB1, gB0, gB1, nB == 2, lane);
            }
        }
        tok6_store<DRY>(ws, tk0, TA); tok6_store<DRY>(ws, tk0 + 1, TB);
    }
}
struct Row8c { v4u c0, c1; };
__device__ __forceinline__ Row8c load_row8c(__amdgpu_buffer_rsrc_t rs, unsigned e, unsigned lane32) { Row8c r; r.c0 = __builtin_amdgcn_raw_buffer_load_b128(rs, lane32, e * 2048u, 0); r.c1 = __builtin_amdgcn_raw_buffer_load_b128(rs, lane32 + 16u, e * 2048u, 0); return r; }
template <bool DRY> __device__ __forceinline__ void gather_mix_phase(const Args& A, Frame& F) {
    unsigned char* ws = A.ws;
    const int gw = F.vcu * NWAVES + F.wave, NGW = F.G * NWAVES;
    const __amdgpu_buffer_rsrc_t RU = __builtin_amdgcn_make_buffer_rsrc((void*)(ws + WS_UB), 0, 16384 * 2048, 0x00020000), RV = __builtin_amdgcn_make_buffer_rsrc((void*)(ws + WS_VB), 0, 16384 * 2048, 0x00020000);
    for (int tk = gw; tk < T_TOK; tk += NGW) {
        const int lane = lane_id(); const unsigned lane16 = (unsigned)lane * 16u;
        Tok6 T; tok6_load(ws, tk, lane, T); if (!U_FP6) T.rs *= U6_SCALE / U8_SCALE;
        for (int k = 0; k < 128; ++k) {
            const int e = __builtin_amdgcn_readlane(k < 64 ? T.ev[0] : T.ev[1], k & 63); const float g = __uint_as_float((unsigned)__builtin_amdgcn_readlane((int)__float_as_uint(k < 64 ? T.gv[0] : T.gv[1]), k & 63));
            float p;
            if (0) {}
            else if (U_FP6) { const Row6 u = load_row6(RU, (unsigned)e, lane16); p = dot6_mfma(T, u, lane); }
            else { const Row8c u = load_row8c(RU, (unsigned)e, lane16 * 2u); const v8i ua = {(int)u.c0.x, (int)u.c0.y, (int)u.c0.z, (int)u.c0.w, (int)u.c1.x, (int)u.c1.y, (int)u.c1.z, (int)u.c1.w}; f32x4 c = {0.f, 0.f, 0.f, 0.f};
                c = __builtin_amdgcn_mfma_scale_f32_16x16x128_f8f6f4(ua, T.ahi, c, 0, 0, 0, 127, 0, 127); c = __builtin_amdgcn_mfma_scale_f32_16x16x128_f8f6f4(ua, T.alo, c, 0, 0, 0, 127, 0, 123);
                const int n = lane & 15; const float t0 = (n & 1) ? c[1] : c[0], t1 = (n & 1) ? c[3] : c[2], v = (n & 2) ? t1 : t0; p = ((lane >> 4) == (n >> 2)) ? v : 0.f; }
            const float h = wave_sum64(p); const float w = g * gelu_f(h * T.rs) * (V_FP6 ? 1.f / V6_SCALE : 1.f / V8_SCALE);
            if (V_FP6) { const Row6 v = load_row6(RV, (unsigned)e, lane16); axpy6(T, v, w); }
            else { const Row8c v = load_row8c(RV, (unsigned)e, lane16 * 2u); const unsigned wv[8] = {v.c0.x, v.c0.y, v.c0.z, v.c0.w, v.c1.x, v.c1.y, v.c1.z, v.c1.w}; const f32x2c w2 = {w, w};
#pragma unroll
                for (int d = 0; d < 8; ++d) { T.acc[2 * d] = __builtin_elementwise_fma(w2, __builtin_amdgcn_cvt_pk_f32_fp8((int)wv[d], false), T.acc[2 * d]); T.acc[2 * d + 1] = __builtin_elementwise_fma(w2, __builtin_amdgcn_cvt_pk_f32_fp8((int)wv[d], true), T.acc[2 * d + 1]); } }
        }
        tok6_store<DRY>(ws, tk, T);
    }
}
__device__ __forceinline__ void final_phase(const Args& A, Frame& F) {
    unsigned char* ws = A.ws; const float* psh3 = (const float*)(ws + WS_PSH3); const float* gf = (const float*)A.in[25]; float* out = A.out;
    const int gw = F.vcu * NWAVES + F.wave, NGW = F.G * NWAVES;
    for (int tk = gw; tk < T_TOK; tk += NGW) { const int lane = lane_id();
        const float rs = 1.0f / sqrtf(wave_sum64(psh3[(size_t)tk * 64 + lane]) * (1.f / 2048.f) + 1e-6f);
#pragma unroll
        for (int j = 0; j < 8; ++j) { GAS f32x4* o = (GAS f32x4*)(out + (size_t)tk * 2048 + 256 * j) + lane; const f32x4 g = *((const GAS f32x4*)(gf + 256 * j) + lane); *o = *o * rs * g; } }
}
#define PH2_BODY \
        { pg8::Gemm g{(const bf16*)(ws + WS_CQ), (const bf16*)(ws + WS_WT_UQ), T_TOK, 1536, 512}; pg8::StaticOrder S; S.init(T_TOK, 1536, F.G, (int)blockIdx.x); \
          LAS float* tab = (LAS float*)(F.lds + TAB_OFF); setup_rowtab(tab, (const float*)(ws + WS_PSCQ), 16, 1.f / 512.f, S, F.wave); __syncthreads(); \
          EpiQ E{tab, (bf16*)(ws + WS_Q), (const f32x2v*)(ws + WS_CS)}; pg8::gemm_phase<EpiQ, pg8::StaticOrder, true, true>(F.lds + RING_OFF, g, S, E, F.wave); } \
        __syncthreads(); \
        { pg8::Gemm g{(const bf16*)(ws + WS_CKV), (const bf16*)(ws + WS_WT_UKV), T_TOK, 2048, 256}; pg8::StaticOrder S; S.init(T_TOK, 2048, F.G, (int)blockIdx.x); \
          LAS float* tab = (LAS float*)(F.lds + TAB_OFF); setup_rowtab(tab, (const float*)(ws + WS_PSCKV), 8, 1.f / 256.f, S, F.wave); __syncthreads(); \
          EpiKV E{tab, (bf16*)(ws + WS_KN), (bf16*)(ws + WS_VV)}; pg8::gemm_phase<EpiKV, pg8::StaticOrder, true, true>(F.lds + RING_OFF, g, S, E, F.wave); } \
        __syncthreads(); \
        sgu_phase(args, F); __syncthreads();

#define PH4_BODY \
        { pg8::Gemm g{(const bf16*)(ws + WS_MIX), (const bf16*)(ws + WS_WT_OUT), T_TOK, 2048, 2048}; pg8::StaticOrder S; S.init(T_TOK, 2048, F.G, (int)blockIdx.x); \
          LAS float* tab = (LAS float*)(F.lds + TAB_OFF); setup_rowtab(tab, (const float*)(ws + WS_PSA), 8, 1.f / 1024.f, S, F.wave); setup_rowtab(tab + 256, (const float*)(ws + WS_PSS), 16, 1.f / 1024.f, S, F.wave); __syncthreads(); \
          EpiOut E{tab, (const float*)args.in[0], (float*)(ws + WS_H1), (bf16*)(ws + WS_H1B), (float*)(ws + WS_PSH1)}; pg8::gemm_phase<EpiOut, pg8::StaticOrder, true, true>(F.lds + RING_OFF, g, S, E, F.wave); } __syncthreads();

#define PH5_BODY \
        { pg8::Gemm g{(const bf16*)(ws + WS_H1B), (const bf16*)(ws + WS_WT_PQ), T_TOK, 2048, 2048}; pg8::StaticOrder S; S.init(T_TOK, 2048, F.G, (int)blockIdx.x); \
          LAS float* tab = (LAS float*)(F.lds + TAB_OFF); setup_rowtab(tab, (const float*)(ws + WS_PSH1), 64, 1.f / 2048.f, S, F.wave); __syncthreads(); \
          EpiPQ E{tab, (bf16*)(ws + WS_R1)}; pg8::gemm_phase<EpiPQ, pg8::StaticOrder, true, true>(F.lds + RING_OFF, g, S, E, F.wave); }

#define PH8_BODY \
        { pg8::Gemm g{(const bf16*)(ws + WS_H1B), (const bf16*)(ws + WS_WT_PG), T_TOK, 2048, 2048}; pg8::StaticOrder S; S.init(T_TOK, 2048, F.G, (int)blockIdx.x); \
          EpiPLE E{(const float*)(ws + WS_RSH2), (const float*)(ws + WS_H1), (const bf16*)(ws + WS_PPROJ), args.out, (float*)(ws + WS_PSH3)}; pg8::gemm_phase<EpiPLE, pg8::StaticOrder, true, true>(F.lds + RING_OFF, g, S, E, F.wave); } __syncthreads();

#define PHASES_2_9 \
    if (IN(2)) { if (REPEAT_PH == 2) { PH2_BODY __syncthreads(); } PH2_BODY SEAM(2); } \
    if (IN(3)) { if (REPEAT_PH == 3) { attn_phase(args, F); __syncthreads(); } attn_phase(args, F); SEAM(3); } \
    if (IN(4)) { if (REPEAT_PH == 4) { PH4_BODY __syncthreads(); } PH4_BODY SEAM(4); } \
    if (IN(5)) { if (REPEAT_PH == 5) { PH5_BODY __syncthreads(); } PH5_BODY SEAM(5); } \
    PHASES_6_9
#define PHASES_6_9 \
    if (IN(6)) { if (REPEAT_PH == 6) { topk_phase(args, F); __syncthreads(); } topk_phase(args, F); SEAM(6); } \
    if (IN(7)) { if (REPEAT_PH == 7) { GATHER_FN<true>(args, F); __syncthreads(); } GATHER_FN<false>(args, F); SEAM(7); } \
    if (IN(8)) { if (REPEAT_PH == 8) { PH8_BODY __syncthreads(); } PH8_BODY SEAM(8); } \
    if (IN(9)) { final_phase(args, F); }
#define PH1_BODY \
        { pg8::Gemm g{(const bf16*)(ws + WS_R1), (const bf16*)(ws + WS_WT_IN), T_TOK, 3072, 2048}; pg8::StaticOrder S; S.init(T_TOK, 3072, F.G, (int)blockIdx.x); \
          EpiG1 E{(const float*)(ws + WS_RSX), (bf16*)(ws + WS_CQ), (bf16*)(ws + WS_CKV), (bf16*)(ws + WS_KR), (bf16*)(ws + WS_UG), (bf16*)(ws + WS_VG), (float*)(ws + WS_PSCQ), (float*)(ws + WS_PSCKV), (f32x2v*)(ws + WS_PSV), (const f32x2v*)(ws + WS_CS)}; \
          pg8::gemm_phase<EpiG1, pg8::StaticOrder, true, true>(F.lds + RING_OFF, g, S, E, F.wave); } \
        { pg8::Gemm g{(const bf16*)(ws + WS_PB), (const bf16*)(ws + WS_WT_PP), T_TOK, 2048, 256}; pg8::StaticOrder S; S.init(T_TOK, 2048, F.G, (int)blockIdx.x); \
          EpiPlain E{(bf16*)(ws + WS_PPROJ), 2048}; \
          pg8::gemm_phase<EpiPlain, pg8::StaticOrder, true, true>(F.lds + RING_OFF, g, S, E, F.wave); }
constexpr int N_PHASES = 10;
__global__ void __launch_bounds__(NWAVES * 64, 2) mega_fwd(Args args) {
    extern __shared__ __attribute__((aligned(16))) unsigned char lds[];
    Frame F;
    F.lds = (LAS unsigned char*)lds; F.MISC = (volatile LAS unsigned*)(F.lds + MISC_OFF);
    F.wave = __builtin_amdgcn_readfirstlane(threadIdx.x >> 6); F.lane = lane_id(); F.tid = F.wave * 64 + F.lane;
    F.G = gridDim.x; { const int bx = blockIdx.x; F.vcu = (F.G % 8 == 0) ? (bx % 8) * (F.G / 8) + bx / 8 : bx; }
    unsigned char* ws = args.ws; F.ctl = (gu32*)(ws + WS_CTL);
    for (int u = F.wave * 64 + lane_id(); u < (LDS_BYTES - LDSCTL_OFF) / 4; u += NWAVES * 64) ((LAS unsigned*)(F.lds + LDSCTL_OFF))[u] = 0u;
    __syncthreads();
    const int lo = args.ph_lo, hi = args.ph_hi;
    XcdBarrier bar; bar.bar = (unsigned*)(F.ctl + CW_BAR); bar.x = 0; bar.st = nullptr;
    if (hi - lo > 1) bar = xcd_barrier_post((unsigned*)(F.ctl + CW_BAR), F.MISC + 8, F.wave);
#define IN(k) (lo <= (k) && (k) < hi)
#define SEAM(k) do { if (IN(k) && IN((k) + 1)) xcd_barrier(bar, F.wave); } while (0)
    if (IN(0)) { if (REPEAT_PH == 0) { p0_prologue(args, F); __syncthreads(); } p0_prologue(args, F); SEAM(0); }
    if (IN(1)) { if (REPEAT_PH == 1) { PH1_BODY __syncthreads(); } PH1_BODY SEAM(1); }
    PHASES_2_9
#undef IN
#undef SEAM
}

#if CUT > 0 && CUT < 9
__device__ __forceinline__ int rope_unpc(int pc) { const int c5 = pc >> 5, fq = (pc >> 3) & 3, nn = (pc >> 2) & 1, e = pc & 3; return 16 * c5 + 4 * fq + e + 32 * nn; }
__global__ void __launch_bounds__(256) conv1(const unsigned char* ws, int b, float* ZP) {
    const int r = blockIdx.x; const size_t row = (size_t)b * 2048 + r; float* z = ZP + (size_t)r * 2880;
    const bf16 *CQ = (const bf16*)(ws + WS_CQ) + row * 512, *CKV = (const bf16*)(ws + WS_CKV) + row * 256, *KR = (const bf16*)(ws + WS_KR) + row * 64, *UG = (const bf16*)(ws + WS_UG) + row * 1024, *VG = (const bf16*)(ws + WS_VG) + row * 1024;
    for (int i = threadIdx.x; i < 512; i += 256) z[i] = bf2f(CQ[i]);
    for (int i = threadIdx.x; i < 256; i += 256) z[512 + i] = bf2f(CKV[i]);
    if (threadIdx.x < 64) z[768 + rope_unpc(threadIdx.x)] = bf2f(KR[threadIdx.x]);
    for (int i = threadIdx.x; i < 1024; i += 256) { z[832 + i] = bf2f(UG[i]); z[1856 + i] = bf2f(VG[i]); }
}
__global__ void __launch_bounds__(256) conv2(const unsigned char* ws, int b, float* ZP, float* QN, float* KV, float* OSGU) {
    const int r = blockIdx.x; const size_t row = (size_t)b * 2048 + r;
    const bf16 *Q = (const bf16*)(ws + WS_Q) + row * 1536, *KN = (const bf16*)(ws + WS_KN) + row * 1024, *VV = (const bf16*)(ws + WS_VV) + row * 1024, *KR = (const bf16*)(ws + WS_KR) + row * 64, *MIX = (const bf16*)(ws + WS_MIX) + row * 2048;
    for (int i = threadIdx.x; i < 1536; i += 256) { const int h = i / 192, lc = i - h * 192; const int dst = lc < 128 ? i : h * 192 + 128 + rope_unpc(lc - 128); QN[(size_t)r * 1536 + dst] = bf2f(Q[i]) * (1.f / QK_C2); }
    for (int i = threadIdx.x; i < 1024; i += 256) { const int h = i >> 7, d = i & 127; KV[(size_t)r * 2048 + h * 256 + d] = bf2f(KN[i]); KV[(size_t)r * 2048 + h * 256 + 128 + d] = bf2f(VV[i]); OSGU[(size_t)r * 1024 + i] = bf2f(MIX[1024 + i]); }
    if (threadIdx.x < 64) ZP[(size_t)r * 2880 + 768 + rope_unpc(threadIdx.x)] = bf2f(KR[threadIdx.x]);
}
__global__ void __launch_bounds__(256) conv3(const unsigned char* ws, int b, float* OATT, float* OSGU) {
    const int r = blockIdx.x; const size_t row = (size_t)b * 2048 + r; const bf16* MIX = (const bf16*)(ws + WS_MIX) + row * 2048;
    for (int i = threadIdx.x; i < 1024; i += 256) { OATT[(size_t)r * 1024 + i] = bf2f(MIX[i]); OSGU[(size_t)r * 1024 + i] = bf2f(MIX[1024 + i]); }
}
__global__ void __launch_bounds__(256) conv5(const unsigned char* ws, int b, float* QPN) {
    const int r = blockIdx.x; const size_t row = (size_t)b * 2048 + r; const bf16* QP = (const bf16*)(ws + WS_R1) + row * 2048;
    for (int i = threadIdx.x; i < 2048; i += 256) QPN[(size_t)r * 2048 + i] = bf2f(QP[i]);
}
static void launch_conv(int b, void* const* d_in, void* d_ws, hipStream_t stream) {
    unsigned char* ws = (unsigned char*)d_ws; (void)d_in;
    if (CUT == 1) conv1<<<2048, 256, 0, stream>>>(ws, b, (float*)(ws + WS_NZP));
    if (CUT == 2) conv2<<<2048, 256, 0, stream>>>(ws, b, (float*)(ws + WS_NZP), (float*)(ws + WS_NQN), (float*)(ws + WS_NKV), (float*)(ws + WS_NOSGU));
    if (CUT == 3) conv3<<<2048, 256, 0, stream>>>(ws, b, (float*)(ws + WS_NOATT), (float*)(ws + WS_NOSGU));
    if (CUT == 5) conv5<<<2048, 256, 0, stream>>>(ws, b, (float*)(ws + WS_NQPN));
}
#endif
#if CUT > 0
static void launch_fast(void* const* d_in, void* d_out, void* d_ws, hipStream_t stream) {
    static int grid = 0;
    if (grid == 0) {
        int dev = 0, cus = 0, per_cu = 0;
        if (hipGetDevice(&dev) != hipSuccess || hipDeviceGetAttribute(&cus, hipDeviceAttributeMultiprocessorCount, dev) != hipSuccess) { fprintf(stderr, "launch_fast: device query failed\n"); grid = -1; return; }
        if (hipFuncSetAttribute((const void*)mega_fwd, hipFuncAttributeMaxDynamicSharedMemorySize, LDS_BYTES) != hipSuccess) { fprintf(stderr, "launch_fast: hipFuncSetAttribute failed\n"); grid = -1; return; }
        if (hipOccupancyMaxActiveBlocksPerMultiprocessor(&per_cu, (const void*)mega_fwd, NWAVES * 64, LDS_BYTES) != hipSuccess || per_cu < 1) fprintf(stderr, "launch_fast: occupancy query says %d blocks per CU\n", per_cu);
        (void)hipGetLastError();
        grid = cus;
        if (grid != 256) fprintf(stderr, "launch_fast: %d CUs (built for 256)\n", grid);
    }
    if (grid < 0) return;
    (void)hipMemsetAsync((char*)d_ws + WS_CTL, 0, CTL_ZERO_BYTES, stream);
    Args a{};
    for (int i = 0; i < 26; ++i) a.in[i] = d_in[i];
    a.out = (float*)d_out; a.ws = (unsigned char*)d_ws;
    constexpr int LAST = CUT + 1;
#if ONE_LAUNCH
    a.ph_lo = 0; a.ph_hi = LAST; hipLaunchKernelGGL(mega_fwd, dim3(grid), dim3(NWAVES * 64), LDS_BYTES, stream, a);
#else
    for (int ph = 0; ph < LAST; ++ph) { a.ph_lo = ph; a.ph_hi = ph + 1; hipLaunchKernelGGL(mega_fwd, dim3(grid), dim3(NWAVES * 64), LDS_BYTES, stream, a); }
#endif
    const hipError_t le = hipPeekAtLastError(); if (le != hipSuccess) fprintf(stderr, "launch_fast: launch failed: %s\n", hipGetErrorName(le));
}
#endif
#if CUT > 0
static void launch_fast(void* const* d_in, void* d_out, void* d_ws, hipStream_t stream);
static void launch_conv(int b, void* const* d_in, void* d_ws, hipStream_t stream);
#endif
extern "C" void kernel_launch(void* const* d_in, const int* in_sizes, int n_in, void* d_out, int out_size, void* d_ws, size_t ws_size, hipStream_t stream) {
    if (n_in != 26 || out_size != T_TOK * DM || ws_size < WS_END) { fprintf(stderr, "kernel_launch: unexpected shapes n_in %d out %d ws %zu\n", n_in, out_size, ws_size); return; }
    unsigned char* ws = (unsigned char*)d_ws;
    const float* x = (const float*)d_in[0]; const float* p = (const float*)d_in[1]; const int* pos = (const int*)d_in[2];
    const float *g_mix = (const float*)d_in[3], *w_in = (const float*)d_in[4], *g_cq = (const float*)d_in[5], *w_uq = (const float*)d_in[6], *g_ckv = (const float*)d_in[7], *w_ukv = (const float*)d_in[8];
    const float *g_ln = (const float*)d_in[9], *b_ln = (const float*)d_in[10], *w_sgu = (const float*)d_in[11], *b_sgu = (const float*)d_in[12], *g_oa = (const float*)d_in[13], *g_os = (const float*)d_in[14];
    const float *w_out = (const float*)d_in[15], *g_ffn = (const float*)d_in[16], *w_pq = (const float*)d_in[17], *k1 = (const float*)d_in[18], *k2 = (const float*)d_in[19], *pu = (const float*)d_in[20], *pv = (const float*)d_in[21];
    const float *g_ple = (const float*)d_in[22], *w_pg = (const float*)d_in[23], *w_pp = (const float*)d_in[24], *g_fin = (const float*)d_in[25];
    float* out = (float*)d_out;
#if CUT > 0
    launch_fast(d_in, d_out, d_ws, stream);
#endif
#if CUT < 9
    constexpr int S0 = CUT + 1; constexpr int TB = nv::TBAT;
    float* A0 = (float*)(ws + WS_NA0); float* GL = (float*)(ws + WS_NGL); float* PP = (float*)(ws + WS_NPP);
    float* ZP = (float*)(ws + WS_NZP); float* CQN = (float*)(ws + WS_NCQN); float* CKVN = (float*)(ws + WS_NCKVN); float* QN = (float*)(ws + WS_NQN); float* KV = (float*)(ws + WS_NKV);
    float* VLN = (float*)(ws + WS_NVLN); float* OSGU = (float*)(ws + WS_NOSGU); float* OATT = (float*)(ws + WS_NOATT); float* QPN = (float*)(ws + WS_NQPN);
    for (int b = 0; b < NBATCH; ++b) {
        const size_t t0 = (size_t)b * TB; const float* xb = x + t0 * DM; const int* posb = pos + t0; const float* pb = p + t0 * 256;
        float* H1 = (float*)(ws + WS_H1) + t0 * DM; int* IDX = (int*)(ws + WS_IDX) + t0 * 128; float* GATE = (float*)(ws + WS_GATE) + t0 * 128; float* outb = out + t0 * DM;
#if CUT > 0
        launch_conv(b, d_in, d_ws, stream);
#endif
        if (S0 <= 1) {
            nv::nk_rmsnorm<<<TB, 256, 0, stream>>>(xb, DM, g_mix, A0, DM, DM);
            nv::nk_gemm<<<dim3(2880 / 64, TB / 64), 256, 0, stream>>>(A0, DM, w_in, 2880, ZP, 2880, nullptr, 0, DM);
            nv::nk_z_post<<<TB, 256, 0, stream>>>(ZP, posb);
        }
        if (S0 <= 2) {
            nv::nk_rmsnorm<<<TB, 256, 0, stream>>>(ZP, 2880, g_cq, CQN, 512, 512);
            nv::nk_gemm<<<dim3(1536 / 64, TB / 64), 256, 0, stream>>>(CQN, 512, w_uq, 1536, QN, 1536, nullptr, 0, 512);
            nv::nk_q_rope<<<TB, 256, 0, stream>>>(QN, posb);
            nv::nk_rmsnorm<<<TB, 256, 0, stream>>>(ZP + 512, 2880, g_ckv, CKVN, 256, 256);
            nv::nk_gemm<<<dim3(2048 / 64, TB / 64), 256, 0, stream>>>(CKVN, 256, w_ukv, 2048, KV, 2048, nullptr, 0, 256);
            nv::nk_ln_group<<<TB * 8 / 4, 256, 0, stream>>>(ZP, g_ln, b_ln, VLN);
            nv::nk_sgu<<<TB * 1024 / 256, 256, 0, stream>>>(ZP, VLN, w_sgu, b_sgu, OSGU);
        }
        if (S0 <= 3) nv::nk_attn<<<dim3(TB, 8), 256, 0, stream>>>(QN, KV, ZP, OATT);
        if (S0 <= 4) {
            nv::nk_rmsnorm<<<TB, 256, 0, stream>>>(OATT, 1024, g_oa, A0, DM, 1024);
            nv::nk_rmsnorm<<<TB, 256, 0, stream>>>(OSGU, 1024, g_os, A0 + 1024, DM, 1024);
            nv::nk_gemm<<<dim3(DM / 64, TB / 64), 256, 0, stream>>>(A0, DM, w_out, DM, H1, DM, xb, DM, DM);
        }
        if (S0 <= 5) {
            nv::nk_rmsnorm<<<TB, 256, 0, stream>>>(H1, DM, g_ffn, A0, DM, DM);
            nv::nk_gemm<<<dim3(DM / 64, TB / 64), 256, 0, stream>>>(A0, DM, w_pq, DM, QPN, DM, nullptr, 0, DM);
        }
        if (S0 <= 6) nv::nk_topk<<<TB * 8, 128, 0, stream>>>(QPN, k1, k2, IDX, GATE);
        if (S0 <= 7) {
            nv::nk_rmsnorm<<<TB, 256, 0, stream>>>(H1, DM, g_ffn, A0, DM, DM);
            nv::nk_gather<<<TB, 256, 0, stream>>>(H1, A0, IDX, GATE, pu, pv);
        }
        if (S0 <= 8) {
            nv::nk_rmsnorm<<<TB, 256, 0, stream>>>(H1, DM, g_ple, A0, DM, DM);
            nv::nk_gemm<<<dim3(DM / 64, TB / 64), 256, 0, stream>>>(A0, DM, w_pg, DM, GL, DM, nullptr, 0, DM);
            nv::nk_gemm<<<dim3(DM / 64, TB / 64), 256, 0, stream>>>(pb, 256, w_pp, DM, PP, DM, nullptr, 0, 256);
            nv::nk_ple<<<TB * DM / 256, 256, 0, stream>>>(H1, GL, PP, outb);
        }
        nv::nk_rmsnorm<<<TB, 256, 0, stream>>>(outb, DM, g_fin, outb, DM, DM);
    }
#endif
}
```

```cpp
#include <hip/hip_runtime.h>
#include <hip/hip_bf16.h>
#include <cstdio>
#include <cstdint>
#include <cmath>
#ifndef CUT
#define CUT 9
#endif
#ifndef ONE_LAUNCH
#define ONE_LAUNCH 1
#endif
#ifndef REPEAT_PH
#define REPEAT_PH -1
#endif
#ifndef PEER_FP6
#define PEER_FP6 1
#endif
#ifndef U_FP6
#define U_FP6 1
#endif
#ifndef V_FP6
#define V_FP6 1
#endif
#ifndef V_HWPACK
#define V_HWPACK 1
#endif
#ifndef GATHER_FN
#define GATHER_FN gather_fp6_phase
#endif
constexpr int T_TOK = 8192, DM = 2048, SEQ = 2048, NBATCH = 4;
constexpr size_t MiB = 1u << 20;
constexpr size_t WS_CTL = 0;
constexpr size_t WS_WT_IN = 1 * MiB, WS_WT_UQ = 13 * MiB, WS_WT_UKV = 14 * MiB + 512 * 1024, WS_WT_PP = 15 * MiB + 512 * 1024;
constexpr size_t WS_K1B = 16 * MiB + 512 * 1024, WS_K2B = WS_K1B + 256 * 1024, WS_WSGU = 17 * MiB;
constexpr size_t WS_WT_OUT = 18 * MiB, WS_WT_PQ = 26 * MiB, WS_WT_PG = 34 * MiB;
constexpr size_t WS_UB = 42 * MiB, WS_VB = 106 * MiB;
constexpr size_t WS_R1 = 170 * MiB;
constexpr size_t WS_PB = 202 * MiB, WS_CS = 206 * MiB, WS_RSX = 208 * MiB, WS_RSH2 = 208 * MiB + 512 * 1024;
constexpr size_t WS_CQ = 209 * MiB, WS_CKV = 217 * MiB, WS_KR = 221 * MiB, WS_UG = 222 * MiB, WS_VG = 238 * MiB;
constexpr size_t WS_PSCQ = 254 * MiB, WS_PSCKV = 254 * MiB + 512 * 1024, WS_PSV = 255 * MiB;
constexpr size_t WS_Q = 257 * MiB, WS_KN = 281 * MiB, WS_VV = 297 * MiB, WS_H1B = 257 * MiB;
constexpr size_t WS_MIX = 313 * MiB, WS_PSA = 345 * MiB, WS_PSS = 345 * MiB + 512 * 1024;
constexpr size_t WS_H1 = 346 * MiB, WS_PSH1 = 410 * MiB, WS_IDX = 412 * MiB, WS_GATE = 416 * MiB, WS_PPROJ = 420 * MiB, WS_PSH3 = 452 * MiB;
constexpr size_t WS_NA0 = 454 * MiB, WS_NGL = 470 * MiB, WS_NPP = 486 * MiB, WS_END = 502 * MiB;
constexpr size_t WS_NZP = 42 * MiB, WS_NCQN = 65 * MiB, WS_NCKVN = 69 * MiB, WS_NQN = 71 * MiB, WS_NKV = 83 * MiB, WS_NVLN = 99 * MiB, WS_NOSGU = 107 * MiB, WS_NOATT = 115 * MiB, WS_NQPN = 123 * MiB;
namespace nv {
constexpr int TBAT = 2048;
__device__ __forceinline__ float gelu_t(float x) { const float c = 0.7978845608028654f; const float u = c * (x + 0.044715f * x * x * x); return 0.5f * x * (1.f + tanhf(u)); }
__device__ __forceinline__ float wave_sum(float v) {
#pragma unroll
    for (int o = 1; o < 64; o <<= 1) v += __shfl_xor(v, o);
    return v;
}
__device__ __forceinline__ float wave_max(float v) {
#pragma unroll
    for (int o = 1; o < 64; o <<= 1) v = fmaxf(v, __shfl_xor(v, o));
    return v;
}
__device__ __forceinline__ float blk_sum(float v, float* sh) {
    v = wave_sum(v); __syncthreads();
    if ((threadIdx.x & 63) == 0) sh[threadIdx.x >> 6] = v; __syncthreads();
    float r = 0.f; for (int i = 0; i < (int)(blockDim.x >> 6); ++i) r += sh[i]; return r;
}
__device__ __forceinline__ float blk_max(float v, float* sh) {
    v = wave_max(v); __syncthreads();
    if ((threadIdx.x & 63) == 0) sh[threadIdx.x >> 6] = v; __syncthreads();
    float r = sh[0]; for (int i = 1; i < (int)(blockDim.x >> 6); ++i) r = fmaxf(r, sh[i]); return r;
}
__global__ void __launch_bounds__(256) nk_rmsnorm(const float* x, size_t ldx, const float* g, float* out, size_t ldo, int D) {
    __shared__ float sh[8];
    const float* xr = x + (size_t)blockIdx.x * ldx; float* orow = out + (size_t)blockIdx.x * ldo;
    float s = 0.f; for (int i = threadIdx.x; i < D; i += 256) { const float v = xr[i]; s += v * v; }
    s = blk_sum(s, sh); const float r = rsqrtf(s / (float)D + 1e-6f);
    for (int i = threadIdx.x; i < D; i += 256) orow[i] = xr[i] * r * g[i];
}
__global__ void __launch_bounds__(256) nk_gemm(const float* A, size_t lda, const float* B, size_t ldb, float* C, size_t ldc, const float* R, size_t ldr, int K) {
    __shared__ float As[16][68], Bs[16][68];
    const int tid = threadIdx.x, tx = tid & 15, ty = tid >> 4, m0 = blockIdx.y * 64, n0 = blockIdx.x * 64;
    float acc[4][4] = {};
    for (int k0 = 0; k0 < K; k0 += 16) {
        { const int r = tid >> 2, c = (tid & 3) * 4; const float4 v = *(const float4*)(A + (size_t)(m0 + r) * lda + k0 + c); As[c][r] = v.x; As[c + 1][r] = v.y; As[c + 2][r] = v.z; As[c + 3][r] = v.w; }
        { const int r = tid >> 4, c = (tid & 15) * 4; const float4 v = *(const float4*)(B + (size_t)(k0 + r) * ldb + n0 + c); Bs[r][c] = v.x; Bs[r][c + 1] = v.y; Bs[r][c + 2] = v.z; Bs[r][c + 3] = v.w; }
        __syncthreads();
#pragma unroll
        for (int k = 0; k < 16; ++k) { float a[4], b[4];
#pragma unroll
            for (int i = 0; i < 4; ++i) { a[i] = As[k][ty * 4 + i]; b[i] = Bs[k][tx * 4 + i]; }
#pragma unroll
            for (int i = 0; i < 4; ++i)
#pragma unroll
                for (int j = 0; j < 4; ++j) acc[i][j] += a[i] * b[j]; }
        __syncthreads();
    }
#pragma unroll
    for (int i = 0; i < 4; ++i)
#pragma unroll
        for (int j = 0; j < 4; ++j) { const size_t r = m0 + ty * 4 + i, c = n0 + tx * 4 + j; C[r * ldc + c] = acc[i][j] + (R ? R[r * ldr + c] : 0.f); }
}
__device__ __forceinline__ void rope_cs(int pos, int i, float& c, float& s) { const double f = pow(10000.0, -(double)i / 32.0); const double a = (double)pos * f; c = (float)cos(a); s = (float)sin(a); }
__global__ void __launch_bounds__(256) nk_z_post(float* Z, const int* pos) {
    float* z = Z + (size_t)blockIdx.x * 2880; const int t = threadIdx.x;
    if (t < 32) { float c, s; rope_cs(pos[blockIdx.x], t, c, s); const float x1 = z[768 + t], x2 = z[800 + t]; z[768 + t] = x1 * c - x2 * s; z[800 + t] = x2 * c + x1 * s; }
    for (int i = 832 + t; i < 2880; i += 256) z[i] = gelu_t(z[i]);
}
__global__ void __launch_bounds__(256) nk_q_rope(float* Q, const int* pos) {
    float* q = Q + (size_t)blockIdx.x * 1536; const int h = threadIdx.x >> 5, i = threadIdx.x & 31;
    float c, s; rope_cs(pos[blockIdx.x], i, c, s); float* p = q + h * 192 + 128; const float x1 = p[i], x2 = p[32 + i]; p[i] = x1 * c - x2 * s; p[32 + i] = x2 * c + x1 * s;
}
__global__ void __launch_bounds__(256) nk_ln_group(const float* Z, const float* gln, const float* bln, float* VLN) {
    const int wv = blockIdx.x * 4 + (threadIdx.x >> 6), lane = threadIdx.x & 63, row = wv >> 3, g = wv & 7;
    const float* v = Z + (size_t)row * 2880 + 1856 + g * 128; const float a = v[lane], b = v[lane + 64];
    const float mu = wave_sum(a + b) * (1.f / 128.f); const float da = a - mu, db = b - mu; const float var = wave_sum(da * da + db * db) * (1.f / 128.f); const float r = rsqrtf(var + 1e-6f);
    float* o = VLN + (size_t)row * 1024 + g * 128; o[lane] = da * r * gln[g * 128 + lane] + bln[g * 128 + lane]; o[lane + 64] = db * r * gln[g * 128 + lane + 64] + bln[g * 128 + lane + 64];
}
__global__ void __launch_bounds__(256) nk_sgu(const float* Z, const float* VLN, const float* ws, const float* bs, float* OS) {
    const size_t idx = (size_t)blockIdx.x * 256 + threadIdx.x; const int row = (int)(idx >> 10), col = (int)(idx & 1023), g = col >> 7, t = row & 127, r0 = row - t;
    const float* w = ws + ((size_t)g * 128 + t) * 128; float acc = 0.f;
    for (int s = 0; s <= t; ++s) acc += w[s] * VLN[(size_t)(r0 + s) * 1024 + col];
    OS[idx] = Z[(size_t)row * 2880 + 832 + col] * (acc + bs[g * 128 + t]);
}
__global__ void __launch_bounds__(256) nk_attn(const float* Q, const float* KV, const float* Z, float* O) {
    __shared__ float qs[192], sc[2048], sh[8], part[128];
    const int i = blockIdx.x, h = blockIdx.y, tid = threadIdx.x, lane = tid & 63, wv = tid >> 6;
    if (tid < 192) qs[tid] = Q[(size_t)i * 1536 + h * 192 + tid]; __syncthreads();
    const float scale = 0.07216878364870323f;
    for (int j = wv; j <= i; j += 4) { const float* kn = KV + (size_t)j * 2048 + h * 256; const float* kr = Z + (size_t)j * 2880 + 768;
        float p = qs[lane] * kn[lane] + qs[64 + lane] * kn[64 + lane] + qs[128 + lane] * kr[lane]; p = wave_sum(p); if (lane == 0) sc[j] = p * scale; }
    __syncthreads();
    float m = -INFINITY; for (int j = tid; j <= i; j += 256) m = fmaxf(m, sc[j]); m = blk_max(m, sh);
    float l = 0.f; for (int j = tid; j <= i; j += 256) { const float e = expf(sc[j] - m); sc[j] = e; l += e; } l = blk_sum(l, sh);
    const int d = tid & 127, half = tid >> 7; float acc = 0.f;
    for (int j = half; j <= i; j += 2) acc += sc[j] * KV[(size_t)j * 2048 + h * 256 + 128 + d];
    if (half) part[d] = acc; __syncthreads();
    if (!half) O[(size_t)i * 1024 + h * 128 + d] = (acc + part[d]) / l;
}
__global__ void __launch_bounds__(128) nk_topk(const float* QP, const float* k1, const float* k2, int* IDX, float* GATE) {
    __shared__ float q[256], s1[128], s2[128], cand[256], t1[16], t2[16]; __shared__ int i1[16], i2[16];
    const int row = blockIdx.x >> 3, h = blockIdx.x & 7, n = threadIdx.x;
    q[n] = QP[(size_t)row * 2048 + h * 256 + n]; q[n + 128] = QP[(size_t)row * 2048 + h * 256 + 128 + n]; __syncthreads();
    { const float* a = k1 + ((size_t)h * 128 + n) * 128; const float* b = k2 + ((size_t)h * 128 + n) * 128; float x = 0.f, y = 0.f;
      for (int d = 0; d < 128; ++d) { x += q[d] * a[d]; y += q[128 + d] * b[d]; } s1[n] = x; s2[n] = y; }
    __syncthreads();
    if (n == 0 || n == 64) { float* s = n ? s2 : s1; float* tv = n ? t2 : t1; int* ti = n ? i2 : i1;
        for (int r = 0; r < 16; ++r) { float best = -INFINITY; int bi = 0; for (int j = 0; j < 128; ++j) if (s[j] > best) { best = s[j]; bi = j; } tv[r] = best; ti[r] = bi; s[bi] = -INFINITY; } }
    __syncthreads();
    cand[n] = t1[n >> 4] + t2[n & 15]; cand[n + 128] = t1[(n + 128) >> 4] + t2[n & 15]; __syncthreads();
    if (n == 0) { float tv[16]; int te[16];
        for (int r = 0; r < 16; ++r) { float best = -INFINITY; int bi = 0; for (int j = 0; j < 256; ++j) if (cand[j] > best) { best = cand[j]; bi = j; } tv[r] = best; te[r] = i1[bi >> 4] * 128 + i2[bi & 15]; cand[bi] = -INFINITY; }
        float l = 0.f, e[16]; for (int r = 0; r < 16; ++r) { e[r] = expf(tv[r] - tv[0]); l += e[r]; }
        for (int r = 0; r < 16; ++r) { IDX[(size_t)row * 128 + h * 16 + r] = te[r]; GATE[(size_t)row * 128 + h * 16 + r] = e[r] / l; } }
}
__global__ void __launch_bounds__(256) nk_gather(float* H, const float* A2, const int* IDX, const float* GATE, const float* U, const float* V) {
    __shared__ float a[2048], red[4][2048];
    const int row = blockIdx.x, tid = threadIdx.x, lane = tid & 63, wv = tid >> 6;
    for (int i = tid; i < 2048; i += 256) a[i] = A2[(size_t)row * 2048 + i]; __syncthreads();
    float acc[32];
#pragma unroll
    for (int i = 0; i < 32; ++i) acc[i] = 0.f;
    for (int k = 0; k < 32; ++k) { const int j = wv * 32 + k; const int e = IDX[(size_t)row * 128 + j]; const float gt = GATE[(size_t)row * 128 + j];
        const float* u = U + (size_t)e * 2048; const float* v = V + (size_t)e * 2048; float p = 0.f;
#pragma unroll
        for (int i = 0; i < 32; ++i) p += u[lane + 64 * i] * a[lane + 64 * i];
        p = wave_sum(p); const float w = gt * gelu_t(p);
#pragma unroll
        for (int i = 0; i < 32; ++i) acc[i] += w * v[lane + 64 * i]; }
#pragma unroll
    for (int i = 0; i < 32; ++i) red[wv][lane + 64 * i] = acc[i];
    __syncthreads();
    for (int i = tid; i < 2048; i += 256) H[(size_t)row * 2048 + i] += red[0][i] + red[1][i] + red[2][i] + red[3][i];
}
__global__ void __launch_bounds__(256) nk_ple(const float* H2, const float* GL, const float* PP, float* out) {
    const size_t i = (size_t)blockIdx.x * 256 + threadIdx.x; out[i] = H2[i] + PP[i] / (1.f + expf(-GL[i]));
}
}
#define GAS __attribute__((address_space(1)))
#define LAS __attribute__((address_space(3)))
typedef unsigned short bf16;
typedef unsigned v4u __attribute__((ext_vector_type(4)));
typedef float f32x4 __attribute__((ext_vector_type(4)));
typedef short bf16x8 __attribute__((ext_vector_type(8)));
typedef GAS unsigned gu32;
typedef GAS unsigned long long gu64;
#define RLX_AGENT __ATOMIC_RELAXED, __HIP_MEMORY_SCOPE_AGENT
#define LDS_WAIT() asm volatile("s_waitcnt lgkmcnt(0)" ::: "memory")
#define VM_WAIT() asm volatile("s_waitcnt vmcnt(0)" ::: "memory")
__device__ __forceinline__ unsigned long long rt() { return __builtin_amdgcn_s_memrealtime(); }
__device__ __forceinline__ unsigned f2bf(float f) { unsigned u = __builtin_bit_cast(unsigned, f); return (u + 0x7fffu + ((u >> 16) & 1u)) >> 16; }
__device__ __forceinline__ unsigned pk2(float lo, float hi) { return f2bf(lo) | (f2bf(hi) << 16); }
#define XB_TMO      128
#define XB_XCNT(j)  (256  + 64 * (j))
#define XB_XSUB(j)  (1280 + 64 * (j))
#define XB_XGEN(j)  (2304 + 64 * (j))
#define XB_TOP      3328
#define XB_TOPGEN   3392
#define XCD_BAR_WORDS 3456
#define XB_SPIN_CAP (1u << 18)

__device__ __forceinline__ unsigned xb_ld(unsigned* p)              { return __hip_atomic_load(p, __ATOMIC_RELAXED, __HIP_MEMORY_SCOPE_AGENT); }
__device__ __forceinline__ unsigned xb_add(unsigned* p, unsigned v) { return __hip_atomic_fetch_add(p, v, __ATOMIC_RELAXED, __HIP_MEMORY_SCOPE_AGENT); }
__device__ __forceinline__ unsigned xb_xcc_id() { return (unsigned)__builtin_amdgcn_s_getreg((3 << 11) | 20) & 0xFu; }
#define XB_SPIN(cond, bar) do { unsigned _sp = 0; while (cond) { __builtin_amdgcn_s_sleep(1); \
    if ((++_sp & 255u) == 0u) { if (xb_ld(&(bar)[XB_TMO])) break; if (_sp > XB_SPIN_CAP) { atomicAdd(&(bar)[XB_TMO], 1u); break; } } } } while (0)

struct XcdBarrier {
    unsigned* bar; unsigned x;
    volatile LAS unsigned* st;
};

__device__ __forceinline__ int lane_id() { int r; asm volatile("v_mbcnt_lo_u32_b32 %0, -1, 0\n\tv_mbcnt_hi_u32_b32 %0, -1, %0" : "=v"(r)); return r; }
__device__ __forceinline__ XcdBarrier xcd_barrier_post(unsigned* bar, volatile LAS unsigned* st, int wid) {
    XcdBarrier b; b.bar = bar; b.x = xb_xcc_id(); b.st = st;
    if (wid == 0 && lane_id() == 0) (void)xb_add(&bar[XB_XCNT(b.x)], 1u);
    return b;
}
__device__ __forceinline__ void xcd_barrier_complete(unsigned* bar, unsigned x, unsigned& nloc, unsigned& nx) {
    const unsigned G = gridDim.x * gridDim.y * gridDim.z;
    unsigned sum, cnt, mine, sp = 0u;
    for (;;) {
        sum = 0u; cnt = 0u; mine = 0u;
#pragma unroll
        for (unsigned j = 0; j < 16; ++j) { const unsigned c = xb_ld(&bar[XB_XCNT(j)]); sum += c; cnt += (c > 0u) ? 1u : 0u; mine = (j == x) ? c : mine; }
        if (sum == G) break;
        __builtin_amdgcn_s_sleep(1);
        if ((++sp & 255u) == 0u) { if (xb_ld(&bar[XB_TMO])) break; if (sp > XB_SPIN_CAP) { atomicAdd(&bar[XB_TMO], 1u); break; } }
    }
    nloc = mine > 0u ? mine : 1u; nx = cnt > 0u ? cnt : 1u;
}

__device__ __forceinline__ void xcd_barrier(const XcdBarrier& b, int wid) {
    asm volatile("s_waitcnt vmcnt(0)" ::: "memory");
    __syncthreads();
    if (wid == 0 && lane_id() == 0) {
        unsigned* bar = b.bar;
        __builtin_amdgcn_s_waitcnt(0);
        unsigned nloc = b.st[0], nx = b.st[1];
        if (nloc == 0u) { xcd_barrier_complete(bar, b.x, nloc, nx); b.st[0] = nloc; b.st[1] = nx; }
        const unsigned old = xb_add(&bar[XB_XSUB(b.x)], 1u);
        const unsigned gen = old / nloc;
        if (old + 1u == (gen + 1u) * nloc) {
            __builtin_amdgcn_fence(__ATOMIC_RELEASE, "agent");
            asm volatile("s_waitcnt vmcnt(0)" ::: "memory");
            const unsigned og = xb_add(&bar[XB_TOP], 1u);
            const unsigned tg = og / nx;
            if (og + 1u == (tg + 1u) * nx) xb_add(&bar[XB_TOPGEN], 1u);
            else XB_SPIN(xb_ld(&bar[XB_TOPGEN]) == tg, bar);
            __builtin_amdgcn_fence(__ATOMIC_ACQUIRE, "agent");
            xb_add(&bar[XB_XGEN(b.x)], 1u);
            asm volatile("s_waitcnt vmcnt(0)" ::: "memory");
        } else {
            XB_SPIN(xb_ld(&bar[XB_XGEN(b.x)]) == gen, bar);
            __builtin_amdgcn_fence(__ATOMIC_ACQUIRE, "agent");
            asm volatile("s_waitcnt vmcnt(0)" ::: "memory");
        }
    }
    __syncthreads();
}
namespace pg8 {
#define PG8_LAS __attribute__((address_space(3)))
typedef unsigned short bf16_t;
typedef short bf16x8 __attribute__((ext_vector_type(8)));
typedef float f32x4 __attribute__((ext_vector_type(4)));
typedef unsigned u32x4 __attribute__((ext_vector_type(4)));
constexpr int BM = 256, BK = 64, HALF = 128, HTB = HALF * BK * 2  , STAGE_BYTES = 8 * HTB, NXCD = 8, WGM = 8;

__host__ __device__ __forceinline__ int lds_byte(int r, int c) { const int st = (r >> 4) * 2 + (c >> 5), rr = r & 15, cc = c & 31, ob = rr * 64 + cc * 2; return st * 1024 + (ob ^ (((ob >> 9) & 1) << 5)); }
__host__ __device__ __forceinline__ void stage_rc(int b, int& R, int& C) { const int st = b / 1024, sb = b % 1024, swz = sb ^ (((sb >> 9) & 1) << 5); R = (st >> 1) * 16 + swz / 64; C = (st & 1) * 32 + (swz % 64) / 2; }
__host__ __device__ __forceinline__ int perm32(int rho) { const int n = rho >> 4, i = rho & 15; return 8 * (i >> 2) + 4 * n + (i & 3); }

struct Unit { int pm, pn; };
struct Gemm { const bf16_t* A; const bf16_t* Bt; int M, N, K; };

struct StaticOrder {
    int nM, nN, nwg, G, c;
    __host__ __device__ void init(int M, int N, int G_, int c_) { nM = M / BM; nN = N / BM; nwg = nM * nN; G = G_; c = c_; }
    __host__ __device__ bool next(int i, Unit& u) const {
        const long L = (long)i * G + c; if (L >= nwg) return false;
        int wgid = (int)L; { const int q = nwg / NXCD, r = nwg % NXCD, xcd = wgid % NXCD, off = wgid / NXCD; wgid = (xcd < r ? xcd * (q + 1) : r * (q + 1) + (xcd - r) * q) + off; }
        const int nig = WGM * nN, gid = wgid / nig, fm = gid * WGM, gsz = (nM - fm) < WGM ? (nM - fm) : WGM;
        u.pm = fm + ((wgid % nig) % gsz); u.pn = (wgid % nig) / gsz; return true;
    }
    __device__ __forceinline__ void a_ready(const Unit&) const {}
    __device__ __forceinline__ void done(const Unit&) const {}
};

__device__ __forceinline__ unsigned cvt_pk_bf16(float lo, float hi) { unsigned r; asm volatile("v_cvt_pk_bf16_f32 %0, %1, %2" : "=v"(r) : "v"(lo), "v"(hi)); return r; }
typedef float f32x2 __attribute__((ext_vector_type(2)));
template <class Epi, class Sched, bool ALIGN_EPI = false, bool SP2 = false>
__device__ __forceinline__ void gemm_phase(PG8_LAS unsigned char* lds, const Gemm g, const Sched& S, const Epi& E, const int wid) {
    const int lane = ::lane_id(), tid = wid * 64 + lane, wr = wid >> 2, wc = wid & 3, fr = lane & 15, fq = lane >> 4;
    const int K = g.K, nt = K / BK;
    unsigned voffA[2], voffB[2];
#pragma unroll
    for (int i = 0; i < 2; ++i) { int R, C; stage_rc(tid * 16 + i * 8192, R, C); const int Rb = Epi::PERM ? ((R & ~31) + perm32(R & 31)) : R;
        voffA[i] = (unsigned)(R * K + C) * 2u; voffB[i] = (unsigned)(Rb * K + C) * 2u; }
    const size_t kstep = (size_t)(BK * 2);
    const size_t hstep = (size_t)HALF * K * 2;
    const size_t tstep = 2 * hstep;
    const unsigned ldsw = (unsigned)wid * 1024u;
    const int aoff = lds_byte(wr * 64 + fr, fq * 8), boff = lds_byte(wc * 32 + fr, fq * 8);
#define PG8_SA(b, h) (((b) * 2 + (h)) * HTB)
#define PG8_SB(b, h) ((4 + (b) * 2 + (h)) * HTB)
#define PG8_STAGE(bufoff, gbase, voff) do { _Pragma("unroll") for (int _i = 0; _i < 2; ++_i) \
        __builtin_amdgcn_global_load_lds((const unsigned*)((const char*)(gbase) + (voff)[_i]), (PG8_LAS unsigned*)(lds + (bufoff) + ldsw + _i * 8192), 16, 0, 0); } while (0)
#define PG8_LDA(dst, b, h) do { _Pragma("unroll") for (int m = 0; m < 4; ++m) _Pragma("unroll") for (int k = 0; k < 2; ++k) dst[m][k] = *(const PG8_LAS bf16x8*)(lds + PG8_SA(b, h) + aoff + m * 2048 + k * 1024); } while (0)
#define PG8_LDB(dst, b, h) do { _Pragma("unroll") for (int n = 0; n < 2; ++n) _Pragma("unroll") for (int k = 0; k < 2; ++k) dst[n][k] = *(const PG8_LAS bf16x8*)(lds + PG8_SB(b, h) + boff + n * 2048 + k * 1024); } while (0)
#define PG8_MMA(ai, bj, At, Bt) do { __builtin_amdgcn_s_setprio(1); _Pragma("unroll") for (int m = 0; m < 4; ++m) _Pragma("unroll") for (int n = 0; n < 2; ++n) _Pragma("unroll") for (int k = 0; k < 2; ++k) \
        acc[ai][bj][m][n] = __builtin_amdgcn_mfma_f32_16x16x32_bf16(Bt[n][k], At[m][k], acc[ai][bj][m][n], 0, 0, 0); __builtin_amdgcn_s_setprio(0); } while (0)
#define PG8_WAIT_V(n) asm volatile("s_waitcnt vmcnt(" #n ")" ::: "memory")
#define PG8_WAIT_L(n) asm volatile("s_waitcnt lgkmcnt(" #n ")" ::: "memory")
#define PG8_BAR __builtin_amdgcn_s_barrier()
#define PG8_SCHED __builtin_amdgcn_sched_barrier(0)
    Unit cur, nxt; int ui = 0;
    if (!S.next(0, cur)) return;
    f32x4 acc[2][2][4][2];
#pragma unroll
    for (int a = 0; a < 2; ++a)
#pragma unroll
        for (int b = 0; b < 2; ++b)
#pragma unroll
            for (int m = 0; m < 4; ++m)
#pragma unroll
                for (int n = 0; n < 2; ++n) acc[a][b][m][n] = (f32x4){0.f, 0.f, 0.f, 0.f};
    bf16x8 At[4][2], B0[2][2], B1[2][2];
    const char* cA = (const char*)g.A + (size_t)cur.pm * tstep; const char* cB = (const char*)g.Bt + (size_t)cur.pn * tstep;
    S.a_ready(cur);
    if constexpr (SP2) {
        PG8_STAGE(PG8_SB(0, 0), cB, voffB); PG8_STAGE(PG8_SB(0, 1), cB + hstep, voffB); PG8_STAGE(PG8_SA(0, 0), cA, voffA); PG8_STAGE(PG8_SA(0, 1), cA + hstep, voffA);
        if (wr == 1) PG8_BAR;
        PG8_WAIT_V(2); PG8_BAR;
        PG8_STAGE(PG8_SB(1, 0), cB + kstep, voffB); PG8_STAGE(PG8_SA(1, 0), cA + kstep, voffA); PG8_STAGE(PG8_SB(1, 1), cB + hstep + kstep, voffB);
        PG8_WAIT_V(6); PG8_BAR;
    } else {
        PG8_STAGE(PG8_SB(0, 0), cB, voffB); PG8_STAGE(PG8_SA(0, 0), cA, voffA); PG8_STAGE(PG8_SB(0, 1), cB + hstep, voffB); PG8_STAGE(PG8_SA(0, 1), cA + hstep, voffA);
        if (wr == 1) PG8_BAR;
        PG8_WAIT_V(4); PG8_BAR;
        PG8_STAGE(PG8_SB(1, 0), cB + kstep, voffB); PG8_STAGE(PG8_SA(1, 0), cA + kstep, voffA); PG8_STAGE(PG8_SB(1, 1), cB + hstep + kstep, voffB);
        PG8_WAIT_V(6); PG8_BAR;
    }
    for (;;) {
        const bool has_next = S.next(ui + 1, nxt);
        const char* nA = has_next ? (const char*)g.A + (size_t)nxt.pm * tstep : cA; const char* nB = has_next ? (const char*)g.Bt + (size_t)nxt.pn * tstep : cB;
        for (int t = 0; t < nt; t += 2) {
            if constexpr (Epi::MID) { if (t == (nt >> 1)) E.mid(acc, cur, wr, wc, fr, fq); }
            const bool last = (t == nt - 2);
            const char* a1 = cA + (size_t)(t + 1) * kstep;
            const char* a2 = last ? nA : cA + (size_t)(t + 2) * kstep; const char* b2 = last ? nB : cB + (size_t)(t + 2) * kstep;
            const char* a3 = a2 + kstep; const char* b3 = b2 + kstep;
            if (last && has_next) S.a_ready(nxt);
            if constexpr (SP2) {
            PG8_LDB(B0, 0, 0); PG8_LDB(B1, 0, 1); PG8_SCHED; PG8_LDA(At, 0, 0); PG8_STAGE(PG8_SA(1, 1), a1 + hstep, voffA);
            PG8_WAIT_V(8); PG8_WAIT_L(0); PG8_BAR; PG8_MMA(0, 0, At, B0); PG8_MMA(0, 1, At, B1); PG8_BAR; PG8_SCHED;
            PG8_LDA(At, 0, 1); PG8_STAGE(PG8_SB(0, 0), b2, voffB); PG8_STAGE(PG8_SB(0, 1), b2 + hstep, voffB); PG8_STAGE(PG8_SA(0, 0), a2, voffA);
            PG8_WAIT_V(8); PG8_WAIT_L(0); PG8_BAR; PG8_MMA(1, 0, At, B0); PG8_MMA(1, 1, At, B1); PG8_BAR; PG8_SCHED;
            PG8_LDB(B0, 1, 0); PG8_LDB(B1, 1, 1); PG8_SCHED; PG8_LDA(At, 1, 0); PG8_STAGE(PG8_SA(0, 1), a2 + hstep, voffA);
            PG8_WAIT_V(8); PG8_WAIT_L(0); PG8_BAR; PG8_MMA(0, 0, At, B0); PG8_MMA(0, 1, At, B1); PG8_BAR; PG8_SCHED;
            PG8_LDA(At, 1, 1); PG8_STAGE(PG8_SB(1, 0), b3, voffB); PG8_STAGE(PG8_SB(1, 1), b3 + hstep, voffB); PG8_STAGE(PG8_SA(1, 0), a3, voffA);
            PG8_WAIT_V(8); PG8_WAIT_L(0); PG8_BAR; PG8_MMA(1, 0, At, B0); PG8_MMA(1, 1, At, B1); PG8_BAR; PG8_SCHED;
            } else {
            PG8_LDB(B0, 0, 0); PG8_SCHED; PG8_LDA(At, 0, 0); PG8_STAGE(PG8_SA(1, 1), a1 + hstep, voffA);
            PG8_WAIT_L(8); PG8_BAR; PG8_WAIT_L(0); PG8_MMA(0, 0, At, B0); PG8_BAR; PG8_SCHED;
            PG8_LDB(B1, 0, 1); PG8_STAGE(PG8_SB(0, 0), b2, voffB);
            PG8_BAR; PG8_WAIT_L(0); PG8_MMA(0, 1, At, B1); PG8_BAR;
            PG8_LDA(At, 0, 1); PG8_STAGE(PG8_SA(0, 0), a2, voffA);
            PG8_BAR; PG8_WAIT_L(0); PG8_MMA(1, 0, At, B0); PG8_BAR; PG8_SCHED;
            PG8_STAGE(PG8_SB(0, 1), b2 + hstep, voffB);
            PG8_WAIT_V(6); PG8_BAR; PG8_MMA(1, 1, At, B1); PG8_BAR;
            PG8_LDB(B0, 1, 0); PG8_SCHED; PG8_LDA(At, 1, 0); PG8_STAGE(PG8_SA(0, 1), a2 + hstep, voffA);
            PG8_WAIT_L(8); PG8_BAR; PG8_WAIT_L(0); PG8_MMA(0, 0, At, B0); PG8_BAR; PG8_SCHED;
            PG8_LDB(B1, 1, 1); PG8_STAGE(PG8_SB(1, 0), b3, voffB);
            PG8_BAR; PG8_WAIT_L(0); PG8_MMA(0, 1, At, B1); PG8_BAR;
            PG8_LDA(At, 1, 1); PG8_STAGE(PG8_SA(1, 0), a3, voffA);
            PG8_BAR; PG8_WAIT_L(0); PG8_MMA(1, 0, At, B0); PG8_BAR; PG8_SCHED;
            PG8_STAGE(PG8_SB(1, 1), b3 + hstep, voffB);
            PG8_WAIT_V(6); PG8_BAR; PG8_MMA(1, 1, At, B1); PG8_BAR;
            }
        }
        if constexpr (ALIGN_EPI) { if (wr == 0) PG8_BAR; }
        if constexpr (!Epi::AFTER_DRAIN) { E(acc, cur, wr, wc, fr, fq); S.done(cur); }
        if (!has_next) break;
#pragma unroll
        for (int a = 0; a < 2; ++a)
#pragma unroll
            for (int b = 0; b < 2; ++b)
#pragma unroll
                for (int m = 0; m < 4; ++m)
#pragma unroll
                    for (int n = 0; n < 2; ++n) acc[a][b][m][n] = (f32x4){0.f, 0.f, 0.f, 0.f};
        cur = nxt; cA = nA; cB = nB; ++ui;
        if constexpr (ALIGN_EPI) { if (wr == 1) PG8_BAR; }
    }
    PG8_WAIT_V(0);
    if constexpr (!ALIGN_EPI) { if (wr == 0) PG8_BAR; }
    PG8_BAR;
    if constexpr (Epi::AFTER_DRAIN) { E.fused(acc, cur, wr, wc, fr, fq, lds, wid, lane); S.done(cur); }
#undef PG8_SA
#undef PG8_SB
#undef PG8_STAGE
#undef PG8_LDA
#undef PG8_LDB
#undef PG8_MMA
#undef PG8_WAIT_V
#undef PG8_WAIT_L
#undef PG8_BAR
#undef PG8_SCHED
}
}
constexpr int NWAVES = 8;
constexpr int RING_OFF = 0, RING_BYTES = 131072, TAB_OFF = RING_BYTES, TAB_BYTES = 8192, LDSCTL_OFF = TAB_OFF + TAB_BYTES, MISC_OFF = LDSCTL_OFF + 320, LDS_BYTES = 147456;
static_assert(MISC_OFF + 128 <= LDS_BYTES, "LDS map");
constexpr int CW_TMO = 0, CW_CODE = 1, CW_BAR = 4096;
constexpr size_t CTL_ZERO_BYTES = 64 * 1024;
constexpr float QK_C2 = 0.07216878364870323f * 1.4426950408889634f;
typedef float f32x2v __attribute__((ext_vector_type(2)));
typedef unsigned u32x2v __attribute__((ext_vector_type(2)));
__device__ __forceinline__ float bf2f(unsigned short b) { return __uint_as_float((unsigned)b << 16); }
__device__ __forceinline__ float gelu_f(float x) { const float u = 1.5957691216057308f * (x + 0.044715f * x * x * x); return x * __builtin_amdgcn_rcpf(1.f + __builtin_amdgcn_exp2f(-1.4426950408889634f * u)); }
__device__ __forceinline__ float wave_sum64(float v) {
#pragma unroll
    for (int o = 1; o < 64; o <<= 1) v += __shfl_xor(v, o);
    return v;
}
struct Args { const void* in[26]; float* out; unsigned char* ws; int ph_lo, ph_hi; };
struct Frame { LAS unsigned char* lds; volatile LAS unsigned* MISC; gu32* ctl; int tid, lane, wave, vcu, G; };

__device__ __forceinline__ int rope_pc(int lr) { const int nn = lr >> 5, i = lr & 31, c5 = i >> 4, f = i & 15; return 32 * c5 + 8 * (f >> 2) + 4 * nn + (f & 3); }
__device__ __forceinline__ int map_win(int n) { if (n < 768) return n; if (n < 832) return 2816 + rope_pc(n - 768); if (n < 1856) return 768 + (n - 832); return 1792 + (n - 1856); }
__device__ __forceinline__ int map_wuq(int n) { const int h = n / 192, lc = n - h * 192; return lc < 128 ? n : h * 192 + 128 + rope_pc(lc - 128); }
__device__ __forceinline__ int map_id(int n) { return n; }

template <class MapF, class ScaleF>
__device__ __forceinline__ void p0_transpose_item(const float* W, int K, int N, bf16* WT, LAS float* scr, int item, int lane, MapF mapf, ScaleF ks) {
    const int nblk = N / 32, kb = item / nblk, nb = item % nblk, k0 = 64 * kb, n0 = 32 * nb;
#pragma unroll 8
    for (int i = 0; i < 32; ++i) { const int kk = 2 * i + (lane >> 5); scr[kk * 33 + (lane & 31)] = W[(size_t)(k0 + kk) * N + n0 + (lane & 31)] * ks(k0 + kk); }
    LDS_WAIT(); asm volatile("" ::: "memory");
    const int c = lane & 7;
#pragma unroll
    for (int j = 0; j < 4; ++j) { const int n = (lane >> 3) + 8 * j; const LAS float* s = scr + (8 * c) * 33 + n;
        v4u o; o.x = pk2(s[0 * 33], s[1 * 33]); o.y = pk2(s[2 * 33], s[3 * 33]); o.z = pk2(s[4 * 33], s[5 * 33]); o.w = pk2(s[6 * 33], s[7 * 33]);
        *(GAS v4u*)(WT + (size_t)mapf(n0 + n) * K + k0 + 8 * c) = o; }
    LDS_WAIT(); asm volatile("" ::: "memory");
}
template <class ScaleF>
__device__ __forceinline__ void p0_cvt512(const float* src, bf16* dst, size_t e0, int lane, ScaleF sf) {
    const size_t e = e0 + (size_t)lane * 8; const f32x4 a = *(const GAS f32x4*)(src + e), b = *(const GAS f32x4*)(src + e + 4);
    v4u o; o.x = pk2(a.x * sf(e), a.y * sf(e + 1)); o.y = pk2(a.z * sf(e + 2), a.w * sf(e + 3)); o.z = pk2(b.x * sf(e + 4), b.y * sf(e + 5)); o.w = pk2(b.z * sf(e + 6), b.w * sf(e + 7));
    *(GAS v4u*)(dst + e) = o;
}
__device__ __forceinline__ void p0_prologue(const Args& A, Frame& F) {
    unsigned char* ws = A.ws;
    const float* x = (const float*)A.in[0]; const float* p = (const float*)A.in[1]; const int* pos = (const int*)A.in[2];
    const float *g_mix = (const float*)A.in[3], *w_in = (const float*)A.in[4], *g_cq = (const float*)A.in[5], *w_uq = (const float*)A.in[6], *g_ckv = (const float*)A.in[7], *w_ukv = (const float*)A.in[8];
    const float *w_sgu = (const float*)A.in[11], *g_oa = (const float*)A.in[13], *g_os = (const float*)A.in[14], *w_out = (const float*)A.in[15], *g_ffn = (const float*)A.in[16], *w_pq = (const float*)A.in[17];
    const float *k1 = (const float*)A.in[18], *k2 = (const float*)A.in[19], *pu = (const float*)A.in[20], *pv = (const float*)A.in[21], *g_ple = (const float*)A.in[22], *w_pg = (const float*)A.in[23], *w_pp = (const float*)A.in[24];
    LAS float* scr = (LAS float*)(F.lds + RING_OFF + F.wave * 16384);
    const int gw = F.vcu * NWAVES + F.wave, NGW = F.G * NWAVES, lane = F.lane;
    for (int m = gw; m < T_TOK; m += NGW) {
        const GAS f32x4* xr = (const GAS f32x4*)(x + (size_t)m * DM) + lane; f32x4 v[8]; float s = 0.f;
#pragma unroll
        for (int j = 0; j < 8; ++j) { v[j] = xr[64 * j]; s += (v[j].x * v[j].x + v[j].y * v[j].y) + (v[j].z * v[j].z + v[j].w * v[j].w); }
        s = wave_sum64(s); if (lane == 0) ((float*)(ws + WS_RSX))[m] = 1.0f / sqrtf(s * (1.f / DM) + 1e-6f);
        GAS u32x2v* o8 = (GAS u32x2v*)((bf16*)(ws + WS_R1) + (size_t)m * DM) + lane;
#pragma unroll
        for (int j = 0; j < 8; ++j) o8[64 * j] = (u32x2v){pk2(v[j].x, v[j].y), pk2(v[j].z, v[j].w)};
        const f32x4 pvv = *((const GAS f32x4*)(p + (size_t)m * 256) + lane);
        *((GAS u32x2v*)((bf16*)(ws + WS_PB) + (size_t)m * 256) + lane) = (u32x2v){pk2(pvv.x, pvv.y), pk2(pvv.z, pvv.w)};
    }
    for (int it = gw; it < T_TOK * 32 / 64; it += NGW) { const int idx = it * 64 + lane, row = idx >> 5, i = idx & 31;
        const double f = exp2((double)i * (-13.287712379549449 / 32.0)); const double a = (double)pos[row] * f;
        ((f32x2v*)(ws + WS_CS))[idx] = (f32x2v){(float)cos(a), (float)sin(a)}; }
    constexpr int I_IN = 32 * 90, I_UQ = 8 * 48, I_UKV = 4 * 64, I_SQ = 32 * 64, I_PP = 4 * 64;
    constexpr int NITEMS = I_IN + I_UQ + I_UKV + 3 * I_SQ + I_PP;
    for (int it = gw; it < NITEMS; it += NGW) {
        int r = it;
        if (r < I_IN) { p0_transpose_item(w_in, 2048, 2880, (bf16*)(ws + WS_WT_IN), scr, r, lane, [](int n) { return map_win(n); }, [=](int k) { return g_mix[k]; }); continue; } r -= I_IN;
        if (r < I_UQ) { p0_transpose_item(w_uq, 512, 1536, (bf16*)(ws + WS_WT_UQ), scr, r, lane, [](int n) { return map_wuq(n); }, [=](int k) { return g_cq[k] * QK_C2; }); continue; } r -= I_UQ;
        if (r < I_UKV) { p0_transpose_item(w_ukv, 256, 2048, (bf16*)(ws + WS_WT_UKV), scr, r, lane, [](int n) { return n; }, [=](int k) { return g_ckv[k]; }); continue; } r -= I_UKV;
        if (r < I_SQ) { p0_transpose_item(w_out, 2048, 2048, (bf16*)(ws + WS_WT_OUT), scr, r, lane, [](int n) { return n; }, [=](int k) { return k < 1024 ? g_oa[k] : g_os[k - 1024]; }); continue; } r -= I_SQ;
        if (r < I_SQ) { p0_transpose_item(w_pq, 2048, 2048, (bf16*)(ws + WS_WT_PQ), scr, r, lane, [](int n) { return n; }, [=](int k) { return g_ffn[k]; }); continue; } r -= I_SQ;
        if (r < I_SQ) { p0_transpose_item(w_pg, 2048, 2048, (bf16*)(ws + WS_WT_PG), scr, r, lane, [](int n) { return n; }, [=](int k) { return g_ple[k]; }); continue; } r -= I_SQ;
        p0_transpose_item(w_pp, 256, 2048, (bf16*)(ws + WS_WT_PP), scr, r, lane, [](int n) { return n; }, [](int) { return 1.f; });
    }
    for (int it = gw; it < 192 * 2048 / 512; it += NGW) *(GAS v4u*)((bf16*)(ws + WS_WT_IN) + (size_t)2880 * 2048 + (size_t)it * 512 + lane * 8) = (v4u){0u, 0u, 0u, 0u};
    for (int it = gw; it < 3 * 256; it += NGW) { const int w = it >> 8, c = it & 255;
        if (w == 0) p0_cvt512(k1, (bf16*)(ws + WS_K1B), (size_t)c * 512, lane, [](size_t) { return 1.f; });
        else if (w == 1) p0_cvt512(k2, (bf16*)(ws + WS_K2B), (size_t)c * 512, lane, [](size_t) { return 1.f; });
        else p0_cvt512(w_sgu, (bf16*)(ws + WS_WSGU), (size_t)c * 512, lane, [](size_t e) { const int s = (int)(e & 127), t = (int)((e >> 7) & 127); return s <= t ? 1.f : 0.f; }); }
#if CUT >= 7
    { LAS float* rowb = (LAS float*)(F.lds + RING_OFF + F.wave * 16384);
      for (int it = gw; it < 2 * 16384; it += NGW) { const int w = it >= 16384, row = w ? it - 16384 : it; const float* src = (w ? pv : pu) + (size_t)row * 2048;
        if (w ? !V_FP6 : !U_FP6) continue;
#pragma unroll
        for (int q = 0; q < 8; ++q) { const int e = 256 * q + 4 * lane; f32x4 x = *(const GAS f32x4*)(src + e);
            if (!w) x = x * *(const GAS f32x4*)(g_ffn + e) * 64.f; else x = x * 4.f;
#pragma unroll
            for (int c = 0; c < 4; ++c) rowb[(e + c) + ((e + c) >> 5)] = x[c]; }
        LDS_WAIT(); asm volatile("" ::: "memory");
        unsigned dw[6];
        if (!w || V_HWPACK) {
            typedef float v16f_ __attribute__((ext_vector_type(16))); typedef unsigned v6u_ __attribute__((ext_vector_type(6))); v16f_ x0, x1;
            if (!w) { _Pragma("unroll") for (int i = 0; i < 16; ++i) { x0[i] = rowb[33 * lane + i]; x1[i] = rowb[33 * lane + 16 + i]; } }
            else { _Pragma("unroll") for (int i = 0; i < 16; ++i) { x0[i] = rowb[33 * lane + 2 * i]; x1[i] = rowb[33 * lane + 2 * i + 1]; } }
            v6u_ pk; asm("v_cvt_scalef32_2xpk16_fp6_f32 %0, %1, %2, 1.0" : "=&v"(pk) : "v"(x0), "v"(x1));
#pragma unroll
            for (int i = 0; i < 6; ++i) dw[i] = pk[i];
        } else {
            unsigned long long acc = 0ull; int nb = 0; int k = 0;
#pragma unroll
            for (int i = 0; i < 32; ++i) { const float v = rowb[33 * lane + i]; const float m = fminf(fabsf(v), 7.5f);
                const float c = m < 2.f ? rintf(8.f * m) : m < 4.f ? rintf(4.f * m) + 8.f : rintf(2.f * m) + 16.f;
                const unsigned code = (unsigned)c | (v < 0.f ? 32u : 0u);
                acc |= (unsigned long long)code << nb; nb += 6;
                if (nb >= 32) { dw[k++] = (unsigned)acc; acc >>= 32; nb -= 32; } } }
        unsigned char* dst = ws + (w ? WS_VB : WS_UB) + (size_t)row * 1536;
        *(GAS v4u*)(dst + 16 * lane) = (v4u){dw[0], dw[1], dw[2], dw[3]}; *(GAS u32x2v*)(dst + 1024 + 8 * lane) = (u32x2v){dw[4], dw[5]};
        LDS_WAIT(); asm volatile("" ::: "memory"); } }
    for (int it = gw; it < 2 * 16384 * 2; it += NGW) { const int w = it >= 16384 * 2, c = w ? it - 16384 * 2 : it; const float* src = (w ? pv : pu) + (size_t)c * 1024 + lane * 16; const int d0 = (c & 1) * 1024 + lane * 16;
        if (w ? V_FP6 : U_FP6) continue;
        f32x4 x[4];
#pragma unroll
        for (int q = 0; q < 4; ++q) x[q] = *(const GAS f32x4*)(src + 4 * q);
        if (!w) {
#pragma unroll
            for (int q = 0; q < 4; ++q) x[q] = x[q] * *(const GAS f32x4*)(g_ffn + d0 + 4 * q) * 256.f; }
        else {
#pragma unroll
            for (int q = 0; q < 4; ++q) x[q] = x[q] * 16.f; }
        v4u o; int t;
        t = 0; t = __builtin_amdgcn_cvt_pk_fp8_f32(x[0][0], x[0][1], t, false); t = __builtin_amdgcn_cvt_pk_fp8_f32(x[0][2], x[0][3], t, true); o.x = (unsigned)t;
        t = 0; t = __builtin_amdgcn_cvt_pk_fp8_f32(x[1][0], x[1][1], t, false); t = __builtin_amdgcn_cvt_pk_fp8_f32(x[1][2], x[1][3], t, true); o.y = (unsigned)t;
        t = 0; t = __builtin_amdgcn_cvt_pk_fp8_f32(x[2][0], x[2][1], t, false); t = __builtin_amdgcn_cvt_pk_fp8_f32(x[2][2], x[2][3], t, true); o.z = (unsigned)t;
        t = 0; t = __builtin_amdgcn_cvt_pk_fp8_f32(x[3][0], x[3][1], t, false); t = __builtin_amdgcn_cvt_pk_fp8_f32(x[3][2], x[3][3], t, true); o.w = (unsigned)t;
        *(GAS v4u*)((unsigned char*)(ws + (w ? WS_VB : WS_UB)) + (size_t)c * 1024 + lane * 16) = o; }
#endif
}

__device__ __forceinline__ v4u pack8(f32x4 a, f32x4 b) { v4u w; w.x = pg8::cvt_pk_bf16(a[0], a[1]); w.y = pg8::cvt_pk_bf16(a[2], a[3]); w.z = pg8::cvt_pk_bf16(b[0], b[1]); w.w = pg8::cvt_pk_bf16(b[2], b[3]); return w; }
__device__ __forceinline__ float sq8(f32x4 a, f32x4 b) { return ((a[0] * a[0] + a[1] * a[1]) + (a[2] * a[2] + a[3] * a[3])) + ((b[0] * b[0] + b[1] * b[1]) + (b[2] * b[2] + b[3] * b[3])); }
__device__ __forceinline__ float fq_sum(float v) { v += __shfl_xor(v, 16); v += __shfl_xor(v, 32); return v; }
#define EPI_ROWS_BEGIN _Pragma("unroll") for (int ai = 0; ai < 2; ++ai) _Pragma("unroll") for (int m = 0; m < 4; ++m) { const int row = u.pm * 256 + ai * 128 + wr * 64 + m * 16 + fr;
#define EPI_ROWS_END }

struct EpiG1 {
    static constexpr bool PERM = true, AFTER_DRAIN = false, MID = false;
    const float* rsx; bf16 *CQ, *CKV, *KR, *UG, *VG; float *pscq, *psckv; f32x2v* psv; const f32x2v* cs;
    __device__ __forceinline__ void operator()(const f32x4 (&acc)[2][2][4][2], const pg8::Unit& u, int wr, int wc, int fr, int fq) const {
        const int pn = u.pn;
        EPI_ROWS_BEGIN
            const float rs = rsx[row];
#pragma unroll
            for (int bj = 0; bj < 2; ++bj) { f32x4 v0 = acc[ai][bj][m][0] * rs, v1 = acc[ai][bj][m][1] * rs; const int lc = bj * 128 + wc * 32 + fq * 8;
                if (pn <= 2) { const float ss = fq_sum(sq8(v0, v1));
                    if (pn < 2) { *(GAS v4u*)(CQ + (size_t)row * 512 + pn * 256 + lc) = pack8(v0, v1); if (fq == 0) pscq[row * 16 + (pn * 2 + bj) * 4 + wc] = ss; }
                    else { *(GAS v4u*)(CKV + (size_t)row * 256 + lc) = pack8(v0, v1); if (fq == 0) psckv[row * 8 + bj * 4 + wc] = ss; } }
                else if (pn <= 10) {
#pragma unroll
                    for (int e = 0; e < 4; ++e) { v0[e] = gelu_f(v0[e]); v1[e] = gelu_f(v1[e]); }
                    if (pn <= 6) *(GAS v4u*)(UG + (size_t)row * 1024 + (pn - 3) * 256 + lc) = pack8(v0, v1);
                    else { const float s = fq_sum(((v0[0] + v0[1]) + (v0[2] + v0[3])) + ((v1[0] + v1[1]) + (v1[2] + v1[3]))), q = fq_sum(sq8(v0, v1));
                        *(GAS v4u*)(VG + (size_t)row * 1024 + (pn - 7) * 256 + lc) = pack8(v0, v1); if (fq == 0) psv[(row * 8 + (pn - 7) * 2 + bj) * 4 + wc] = (f32x2v){s, q}; } }
                else if (bj == 0 && wc < 2) { f32x4 o0, o1;
#pragma unroll
                    for (int e = 0; e < 4; ++e) { const f32x2v c = cs[row * 32 + 16 * wc + 4 * fq + e]; o0[e] = v0[e] * c.x - v1[e] * c.y; o1[e] = v1[e] * c.x + v0[e] * c.y; }
                    *(GAS v4u*)(KR + (size_t)row * 64 + wc * 32 + fq * 8) = pack8(o0, o1); } }
        EPI_ROWS_END
    }
};
struct EpiPlain {
    static constexpr bool PERM = true, AFTER_DRAIN = false, MID = false;
    bf16* O; int ldc;
    __device__ __forceinline__ void operator()(const f32x4 (&acc)[2][2][4][2], const pg8::Unit& u, int wr, int wc, int fr, int fq) const {
        EPI_ROWS_BEGIN
#pragma unroll
            for (int bj = 0; bj < 2; ++bj) *(GAS v4u*)(O + (size_t)row * ldc + u.pn * 256 + bj * 128 + wc * 32 + fq * 8) = pack8(acc[ai][bj][m][0], acc[ai][bj][m][1]);
        EPI_ROWS_END
    }
};
template <class Sched>
__device__ __forceinline__ void setup_rowtab(LAS float* tab, const float* part, int NP, float inv_dim, const Sched& S, int wid) {
    pg8::Unit u; const int tid = wid * 64 + lane_id();
    if (S.next(0, u)) { const int r = tid >> 1, half = tid & 1, n2 = NP >> 1; const float* pp = part + (size_t)(u.pm * 256 + r) * NP + half * n2; float s = 0.f;
        for (int j = 0; j < n2; ++j) s += pp[j];
        s += __shfl_xor(s, 1); if (!half) tab[r] = 1.0f / sqrtf(s * inv_dim + 1e-6f); }
}
struct EpiQ {
    static constexpr bool PERM = true, AFTER_DRAIN = false, MID = false;
    const LAS float* tab; bf16* Q; const f32x2v* cs;
    __device__ __forceinline__ void operator()(const f32x4 (&acc)[2][2][4][2], const pg8::Unit& u, int wr, int wc, int fr, int fq) const {
        EPI_ROWS_BEGIN
            const float rs = tab[ai * 128 + wr * 64 + m * 16 + fr];
#pragma unroll
            for (int bj = 0; bj < 2; ++bj) { f32x4 v0 = acc[ai][bj][m][0] * rs, v1 = acc[ai][bj][m][1] * rs; const int gc = u.pn * 256 + bj * 128 + wc * 32;
                if (((gc >> 6) % 3) == 2) { f32x4 o0, o1;
#pragma unroll
                    for (int e = 0; e < 4; ++e) { const f32x2v c = cs[row * 32 + 16 * (wc & 1) + 4 * fq + e]; o0[e] = v0[e] * c.x - v1[e] * c.y; o1[e] = v1[e] * c.x + v0[e] * c.y; }
                    v0 = o0; v1 = o1; }
                *(GAS v4u*)(Q + (size_t)row * 1536 + gc + fq * 8) = pack8(v0, v1); }
        EPI_ROWS_END
    }
};
struct EpiKV {
    static constexpr bool PERM = true, AFTER_DRAIN = false, MID = false;
    const LAS float* tab; bf16 *KN, *VV;
    __device__ __forceinline__ void operator()(const f32x4 (&acc)[2][2][4][2], const pg8::Unit& u, int wr, int wc, int fr, int fq) const {
        EPI_ROWS_BEGIN
            const float rs = tab[ai * 128 + wr * 64 + m * 16 + fr];
#pragma unroll
            for (int bj = 0; bj < 2; ++bj) *(GAS v4u*)((bj ? VV : KN) + (size_t)row * 1024 + u.pn * 128 + wc * 32 + fq * 8) = pack8(acc[ai][bj][m][0] * rs, acc[ai][bj][m][1] * rs);
        EPI_ROWS_END
    }
};
struct EpiOut {
    static constexpr bool PERM = true, AFTER_DRAIN = false, MID = true;
    const LAS float* tab; const float* x; float* H1; bf16* H1B; float* psh1;
    __device__ __forceinline__ void mid(f32x4 (&acc)[2][2][4][2], const pg8::Unit& u, int wr, int wc, int fr, int fq) const {
#pragma unroll
        for (int ai = 0; ai < 2; ++ai)
#pragma unroll
            for (int m = 0; m < 4; ++m) { const int r = ai * 128 + wr * 64 + m * 16 + fr; const float rr = tab[r] / tab[256 + r];
#pragma unroll
                for (int bj = 0; bj < 2; ++bj) { acc[ai][bj][m][0] *= rr; acc[ai][bj][m][1] *= rr; } }
    }
    __device__ __forceinline__ void operator()(const f32x4 (&acc)[2][2][4][2], const pg8::Unit& u, int wr, int wc, int fr, int fq) const {
        EPI_ROWS_BEGIN
            const float rs = tab[256 + ai * 128 + wr * 64 + m * 16 + fr];
#pragma unroll
            for (int bj = 0; bj < 2; ++bj) { const size_t off = (size_t)row * DM + u.pn * 256 + bj * 128 + wc * 32 + fq * 8;
                const f32x4 v0 = *(const GAS f32x4*)(x + off) + acc[ai][bj][m][0] * rs, v1 = *(const GAS f32x4*)(x + off + 4) + acc[ai][bj][m][1] * rs;
                *(GAS f32x4*)(H1 + off) = v0; *(GAS f32x4*)(H1 + off + 4) = v1; *(GAS v4u*)(H1B + off) = pack8(v0, v1);
                const float ss = fq_sum(sq8(v0, v1)); if (fq == 0) psh1[row * 64 + u.pn * 8 + bj * 4 + wc] = ss; }
        EPI_ROWS_END
    }
};
struct EpiPQ {
    static constexpr bool PERM = true, AFTER_DRAIN = false, MID = false;
    const LAS float* tab; bf16* QP;
    __device__ __forceinline__ void operator()(const f32x4 (&acc)[2][2][4][2], const pg8::Unit& u, int wr, int wc, int fr, int fq) const {
        EPI_ROWS_BEGIN
            const float rs = tab[ai * 128 + wr * 64 + m * 16 + fr];
#pragma unroll
            for (int bj = 0; bj < 2; ++bj) *(GAS v4u*)(QP + (size_t)row * DM + u.pn * 256 + bj * 128 + wc * 32 + fq * 8) = pack8(acc[ai][bj][m][0] * rs, acc[ai][bj][m][1] * rs);
        EPI_ROWS_END
    }
};
struct EpiPLE {
    static constexpr bool PERM = true, AFTER_DRAIN = false, MID = false;
    const float* rsh2; const float* H2; const bf16* PPROJ; float* out; float* psh3;
    __device__ __forceinline__ void operator()(const f32x4 (&acc)[2][2][4][2], const pg8::Unit& u, int wr, int wc, int fr, int fq) const {
        EPI_ROWS_BEGIN
            const float rs = rsh2[row];
#pragma unroll
            for (int bj = 0; bj < 2; ++bj) { const size_t off = (size_t)row * DM + u.pn * 256 + bj * 128 + wc * 32 + fq * 8;
                const v4u pw = *(const GAS v4u*)(PPROJ + off); f32x4 h0 = *(const GAS f32x4*)(H2 + off), h1 = *(const GAS f32x4*)(H2 + off + 4);
                const unsigned pws[4] = {pw.x, pw.y, pw.z, pw.w};
#pragma unroll
                for (int e = 0; e < 4; ++e) { const float a = acc[ai][bj][m][e >> 1][(e & 1) * 2] * rs, b = acc[ai][bj][m][e >> 1][(e & 1) * 2 + 1] * rs;
                    const float ga = __builtin_amdgcn_rcpf(1.f + __builtin_amdgcn_exp2f(-1.4426950408889634f * a)), gb = __builtin_amdgcn_rcpf(1.f + __builtin_amdgcn_exp2f(-1.4426950408889634f * b));
                    const float pa = __uint_as_float(pws[e] << 16), pb = __uint_as_float(pws[e] & 0xffff0000u);
                    if (e < 2) { h0[(e & 1) * 2] += ga * pa; h0[(e & 1) * 2 + 1] += gb * pb; } else { h1[(e & 1) * 2] += ga * pa; h1[(e & 1) * 2 + 1] += gb * pb; } }
                *(GAS f32x4*)(out + off) = h0; *(GAS f32x4*)(out + off + 4) = h1;
                const float ss = fq_sum(sq8(h0, h1)); if (fq == 0) psh3[row * 64 + u.pn * 8 + bj * 4 + wc] = ss; }
        EPI_ROWS_END
    }
};
typedef float f32x16 __attribute__((ext_vector_type(16)));
typedef short s16x4 __attribute__((ext_vector_type(4)));
#define KSWZ(row, colB) ((row) * 256 + ((colB) ^ (((row) & 7) << 4)))
__device__ __forceinline__ int v_st(int k, int c) { const int kk = (k & ~0xC) | ((k & 4) << 1) | ((k & 8) >> 1); return ((kk >> 3) * 4 + (c >> 5)) * 512 + ((kk & 7) * 32 + (c & 31)) * 2; }
__device__ __forceinline__ int v_rd_base(int lane) { return ((lane & 3) << 3) | (((lane >> 2) & 3) << 6) | (((lane >> 4) & 1) << 5) | (((lane >> 5) & 1) << 8); }
__device__ __forceinline__ int crow(int r, int hi) { return (r & 3) + 8 * (r >> 2) + 4 * hi; }
#define TRRD(dst, off) asm volatile("ds_read_b64_tr_b16 %0, %1 offset:%2" : "=&v"(dst) : "v"(vb0), "i"(off) : "memory")
#define SBAR() __builtin_amdgcn_sched_barrier(0)
#define PV_ONE(o_, pa_, VOFF, D0, KS) do { s16x4 l_, h_; TRRD(l_, (VOFF) + (D0) * 512 + (KS) * 4096); TRRD(h_, (VOFF) + (D0) * 512 + (KS) * 4096 + 2048); \
        asm volatile("s_waitcnt lgkmcnt(0)" ::: "memory"); SBAR(); \
        o_ = __builtin_amdgcn_mfma_f32_32x32x16_bf16(pa_, (bf16x8){l_[0], l_[1], l_[2], l_[3], h_[0], h_[1], h_[2], h_[3]}, o_, 0, 0, 0); } while (0)
__device__ __forceinline__ float half_sum32(float v) { v += __shfl_xor(v, 1); v += __shfl_xor(v, 2); v += __shfl_xor(v, 4); v += __shfl_xor(v, 8); v += __shfl_xor(v, 16); return v; }

__device__ __forceinline__ void sgu_phase(const Args& A, Frame& F) {
    unsigned char* ws = A.ws;
    const bf16* VG = (const bf16*)(ws + WS_VG); const bf16* UG = (const bf16*)(ws + WS_UG); const bf16* WS = (const bf16*)(ws + WS_WSGU); const f32x2v* psv = (const f32x2v*)(ws + WS_PSV);
    const float* gln = (const float*)A.in[9]; const float* bln = (const float*)A.in[10]; const float* bs = (const float*)A.in[12];
    bf16* MIX = (bf16*)(ws + WS_MIX); float* pss = (float*)(ws + WS_PSS);
    const int lane = lane_id(), wid = F.wave, tid = wid * 64 + lane, r32 = lane & 31, hi = lane >> 5, tg = wid & 3, dh = wid >> 2;
    LAS unsigned char* V_lds = F.lds + RING_OFF;
    const int vb0 = (int)(uintptr_t)V_lds + v_rd_base(lane);
    for (int unit = F.vcu; unit < 512; unit += F.G) {
        const int g = unit & 7, R0 = (unit >> 3) * 128;
#pragma unroll
        for (int i = 0; i < 4; ++i) { const int s = (tid >> 4) + 32 * i, c = (tid & 15) * 8, row = R0 + s;
            const f32x2v* pp = psv + ((size_t)row * 8 + g) * 4; const f32x2v p0 = pp[0], p1 = pp[1], p2 = pp[2], p3 = pp[3];
            const float mean = ((p0.x + p1.x) + (p2.x + p3.x)) * (1.f / 128.f), var = ((p0.y + p1.y) + (p2.y + p3.y)) * (1.f / 128.f) - mean * mean, rstd = 1.0f / sqrtf(fmaxf(var, 0.f) + 1e-6f);
            const v4u xv = *(const GAS v4u*)(VG + (size_t)row * 1024 + g * 128 + c);
            const f32x4 g0 = *(const GAS f32x4*)(gln + g * 128 + c), g1 = *(const GAS f32x4*)(gln + g * 128 + c + 4), b0 = *(const GAS f32x4*)(bln + g * 128 + c), b1 = *(const GAS f32x4*)(bln + g * 128 + c + 4);
            f32x4 y0, y1;
            y0[0] = (__uint_as_float(xv.x << 16) - mean) * rstd * g0[0] + b0[0]; y0[1] = (__uint_as_float(xv.x & 0xffff0000u) - mean) * rstd * g0[1] + b0[1];
            y0[2] = (__uint_as_float(xv.y << 16) - mean) * rstd * g0[2] + b0[2]; y0[3] = (__uint_as_float(xv.y & 0xffff0000u) - mean) * rstd * g0[3] + b0[3];
            y1[0] = (__uint_as_float(xv.z << 16) - mean) * rstd * g1[0] + b1[0]; y1[1] = (__uint_as_float(xv.z & 0xffff0000u) - mean) * rstd * g1[1] + b1[1];
            y1[2] = (__uint_as_float(xv.w << 16) - mean) * rstd * g1[2] + b1[2]; y1[3] = (__uint_as_float(xv.w & 0xffff0000u) - mean) * rstd * g1[3] + b1[3];
            *(LAS v4u*)(V_lds + (s >> 6) * 16384 + v_st(s & 63, c)) = pack8(y0, y1); }
        bf16x8 afr[8];
#pragma unroll
        for (int ks = 0; ks < 8; ++ks) afr[ks] = *(const GAS bf16x8*)(WS + ((size_t)g * 128 + 32 * tg + r32) * 128 + 16 * ks + 8 * hi);
        __syncthreads();
        f32x16 o0 = {}, o1 = {};
#define SGU_TILE(TL) do { _Pragma("unroll") for (int ks = 0; ks < 4; ++ks) { \
            if (dh == 0) { PV_ONE(o0, afr[4 * TL + ks], TL * 16384, 0, ks); PV_ONE(o1, afr[4 * TL + ks], TL * 16384, 1, ks); } \
            else { PV_ONE(o0, afr[4 * TL + ks], TL * 16384, 2, ks); PV_ONE(o1, afr[4 * TL + ks], TL * 16384, 3, ks); } } } while (0)
        SGU_TILE(0); if (tg >= 2) SGU_TILE(1);
#undef SGU_TILE
#pragma unroll
        for (int r = 0; r < 16; ++r) { const int t = 32 * tg + crow(r, hi), row = R0 + t; const float bias = bs[g * 128 + t];
            const int d0 = 64 * dh + r32; const size_t uoff = (size_t)row * 1024 + g * 128 + d0;
            const float va = bf2f(UG[uoff]) * (o0[r] + bias), vb = bf2f(UG[uoff + 32]) * (o1[r] + bias);
            const float na = __shfl_xor(va, 1), nb = __shfl_xor(vb, 1);
            if ((r32 & 1) == 0) { bf16* mo = MIX + (size_t)row * 2048 + 1024 + g * 128 + d0; *(GAS unsigned*)mo = pg8::cvt_pk_bf16(va, na); *(GAS unsigned*)(mo + 32) = pg8::cvt_pk_bf16(vb, nb); }
            const float ss = half_sum32(va * va + vb * vb); if (r32 == 0) pss[row * 16 + g * 2 + dh] = ss; }
        __syncthreads();
    }
}

#define OPAQUE(x) asm volatile("" : "+v"(x))
constexpr int KT_ROW = 400, KT_BYTES = 64 * KT_ROW;
__device__ __forceinline__ void attn_phase(const Args& A, Frame& F) {
    unsigned char* ws = A.ws;
    const GAS unsigned char* Qg = (const GAS unsigned char*)(ws + WS_Q); const GAS unsigned char* KNg = (const GAS unsigned char*)(ws + WS_KN); const GAS unsigned char* VVg = (const GAS unsigned char*)(ws + WS_VV); const GAS unsigned char* KRg = (const GAS unsigned char*)(ws + WS_KR);
    bf16* MIX = (bf16*)(ws + WS_MIX); float* psa = (float*)(ws + WS_PSA);
    const int wid = F.wave, g = wid & 3, kh = wid >> 2;
    LAS unsigned char* V_lds = F.lds + RING_OFF; LAS unsigned char* Kt_lds = V_lds + 32768;
    LAS float* wsc = (LAS float*)(V_lds + 86016) + wid * 64;
    LAS float* ml1 = (LAS float*)(V_lds + 86016 + 2048);
    for (int item = F.vcu; item < 256; item += F.G) {
        const int bh = item >> 3, s = item & 7, b = bh >> 3, h = bh & 7, tok0 = b * SEQ;
        for (int pass = 0; pass < 2; ++pass) {
            const int jq = pass ? s : 15 - s, q0 = tok0 + 128 * jq, NT = 2 * (jq + 1);
            bf16x8 qr[12];
            { int ln = lane_id(); const int r32 = ln & 31, hi = ln >> 5; const GAS unsigned char* qp = Qg + (size_t)(q0 + 32 * g) * 3072 + h * 384; const unsigned qo = (unsigned)r32 * 3072u + (unsigned)hi * 16u;
#pragma unroll
              for (int ks = 0; ks < 12; ++ks) qr[ks] = *(const GAS bf16x8*)(qp + qo + ks * 32); }
            bf16x8 skn0, skn1, sv0, sv1, skr;
#define ALOAD(t_) do { int ln_ = lane_id(); const int tid_ = wid * 64 + ln_; const unsigned sr_ = tid_ >> 4, sc_ = tid_ & 15; \
                const GAS unsigned char* kb_ = KNg + (size_t)(tok0 + 64 * (t_)) * 2048 + h * 256; const GAS unsigned char* vb_ = VVg + (size_t)(tok0 + 64 * (t_)) * 2048 + h * 256; const GAS unsigned char* rb_ = KRg + (size_t)(tok0 + 64 * (t_)) * 128; \
                const unsigned o_ = sr_ * 2048u + sc_ * 16u; \
                skn0 = *(const GAS bf16x8*)(kb_ + o_); skn1 = *(const GAS bf16x8*)(kb_ + o_ + 65536u); sv0 = *(const GAS bf16x8*)(vb_ + o_); sv1 = *(const GAS bf16x8*)(vb_ + o_ + 65536u); \
                skr = *(const GAS bf16x8*)(rb_ + (unsigned)tid_ * 16u); } while (0)
#define AWRITE(bf_) do { int ln_ = lane_id(); const int tid_ = wid * 64 + ln_; const int sr_ = tid_ >> 4, sc_ = tid_ & 15; \
                LAS unsigned char* kt_ = Kt_lds + (bf_) * KT_BYTES; LAS unsigned char* vt_ = V_lds + (bf_) * 16384; \
                *(LAS bf16x8*)(kt_ + sr_ * KT_ROW + sc_ * 16) = skn0; *(LAS bf16x8*)(kt_ + (sr_ + 32) * KT_ROW + sc_ * 16) = skn1; \
                *(LAS bf16x8*)(vt_ + v_st(sr_, sc_ * 8)) = sv0; *(LAS bf16x8*)(vt_ + v_st(32 + sr_, sc_ * 8)) = sv1; \
                *(LAS bf16x8*)(kt_ + (tid_ >> 3) * KT_ROW + 256 + (tid_ & 7) * 16) = skr; } while (0)
            ALOAD(0); AWRITE(0); __syncthreads();
            float m_reg = -1e30f, l_reg = 0.f; f32x16 o[4] = {};
            for (int t = 0; t < NT; ++t) {
                const int bf = t & 1;
                if (t + 1 < NT) ALOAD(t + 1);
                int ln = lane_id(); const int r32 = ln & 31, hi = ln >> 5;
                f32x16 p = {};
                { const LAS unsigned char* kb = Kt_lds + bf * KT_BYTES + (32 * kh + r32) * KT_ROW + hi * 16;
#pragma unroll
                  for (int ks = 0; ks < 12; ++ks) p = __builtin_amdgcn_mfma_f32_32x32x16_bf16(*(const LAS bf16x8*)(kb + ks * 32), qr[ks], p, 0, 0, 0); }
                if (t >= 2 * jq) { const int dq = (32 * g + r32) - (64 * (t - 2 * jq) + 32 * kh + 4 * hi);
#pragma unroll
                    for (int r = 0; r < 16; ++r) { const int c = (r & 3) + 8 * (r >> 2); if (c > dq) p[r] = -__builtin_inff(); } }
                float pmax = p[0];
#pragma unroll
                for (int r = 1; r < 16; ++r) pmax = fmaxf(pmax, p[r]);
                { auto rr = __builtin_amdgcn_permlane32_swap(__float_as_uint(pmax), __float_as_uint(pmax), false, false); pmax = fmaxf(__uint_as_float(rr[0]), __uint_as_float(rr[1])); }
                const float mn = fmaxf(m_reg, pmax), alpha = __builtin_amdgcn_exp2f(m_reg - mn); m_reg = mn;
                float ps = 0.f;
#pragma unroll
                for (int r = 0; r < 16; ++r) { p[r] = __builtin_amdgcn_exp2f(p[r] - mn); ps += p[r]; }
                { auto rr = __builtin_amdgcn_permlane32_swap(__float_as_uint(ps), __float_as_uint(ps), false, false); ps = __uint_as_float(rr[0]) + __uint_as_float(rr[1]); }
                l_reg = l_reg * alpha + ps;
                if (__any(alpha < 1.f)) { if (hi == 0) wsc[r32] = alpha; asm volatile("s_waitcnt lgkmcnt(0)" ::: "memory");
#pragma unroll
                    for (int r = 0; r < 16; ++r) { const float f = wsc[crow(r, hi)];
#pragma unroll
                        for (int d_ = 0; d_ < 4; ++d_) o[d_][r] *= f; } }
                bf16x8 pa0, pa1;
#define PK4(P, B_, OUT) do { unsigned a0 = pg8::cvt_pk_bf16(P[B_ + 0], P[B_ + 1]), a1 = pg8::cvt_pk_bf16(P[B_ + 2], P[B_ + 3]), b0 = pg8::cvt_pk_bf16(P[B_ + 4], P[B_ + 5]), b1 = pg8::cvt_pk_bf16(P[B_ + 6], P[B_ + 7]); \
                    auto r0 = __builtin_amdgcn_permlane32_swap(a0, b0, false, false); auto r1 = __builtin_amdgcn_permlane32_swap(a1, b1, false, false); \
                    v4u w = {r0[0], r1[0], r0[1], r1[1]}; OUT = __builtin_bit_cast(bf16x8, w); } while (0)
                PK4(p, 0, pa0); PK4(p, 8, pa1);
#undef PK4
                { const int vb0 = (int)(uintptr_t)V_lds + v_rd_base(ln) + bf * 16384 + kh * 8192;
#pragma unroll
                  for (int d0 = 0; d0 < 4; ++d0) { PV_ONE(o[d0], pa0, 0, d0, 0); PV_ONE(o[d0], pa1, 0, d0, 1); } }
                if (t + 1 < NT) AWRITE(bf ^ 1);
                __syncthreads();
            }
#undef ALOAD
#undef AWRITE
            { int ln = lane_id(); const int r32 = ln & 31, hi = ln >> 5;
            LAS float* O1 = (LAS float*)(V_lds + g * 16384) + ln;
            if (kh == 1) {
#pragma unroll
                for (int d0 = 0; d0 < 4; ++d0)
#pragma unroll
                    for (int r = 0; r < 16; ++r) O1[(d0 * 16 + r) * 64] = o[d0][r];
                if (hi == 0) { ml1[g * 64 + r32] = m_reg; ml1[g * 64 + 32 + r32] = l_reg; } }
            __syncthreads();
            if (kh == 0) { const float m1 = ml1[g * 64 + r32], l1 = ml1[g * 64 + 32 + r32], mt = fmaxf(m_reg, m1), a0 = __builtin_amdgcn_exp2f(m_reg - mt), a1 = __builtin_amdgcn_exp2f(m1 - mt), il = 1.0f / (l_reg * a0 + l1 * a1);
                if (hi == 0) { wsc[r32] = a0 * il; wsc[32 + r32] = a1 * il; } asm volatile("s_waitcnt lgkmcnt(0)" ::: "memory");
#pragma unroll
                for (int r = 0; r < 16; ++r) { const int qrow = q0 + 32 * g + crow(r, hi); const float f0 = wsc[crow(r, hi)], f1 = wsc[32 + crow(r, hi)]; float ss = 0.f;
#pragma unroll
                    for (int d0 = 0; d0 < 4; ++d0) { const float v = o[d0][r] * f0 + O1[(d0 * 16 + r) * 64] * f1; ss += v * v; const float vn = __shfl_xor(v, 1);
                        if ((r32 & 1) == 0) *(GAS unsigned*)(MIX + (size_t)qrow * 2048 + h * 128 + d0 * 32 + r32) = pg8::cvt_pk_bf16(v, vn); }
                    ss = half_sum32(ss); if (r32 == 0) psa[qrow * 8 + h] = ss; } }
            __syncthreads(); }
        }
    }
}
typedef __bf16 bf16x2_t __attribute__((ext_vector_type(2)));
__device__ __forceinline__ unsigned ord_key(float f) { const unsigned u = __float_as_uint(f); return u ^ ((unsigned)((int)u >> 31) | 0x80000000u); }
__device__ __forceinline__ float ord_val(unsigned k) { return __uint_as_float((k & 0x80000000u) ? (k ^ 0x80000000u) : ~k); }
__device__ __forceinline__ unsigned umax3(unsigned a, unsigned b, unsigned c) { return max(max(a, b), c); }
__device__ __forceinline__ unsigned pair_max(unsigned v) { auto rr = __builtin_amdgcn_permlane32_swap(v, v, false, false); return max(rr[0], rr[1]); }
__device__ __forceinline__ unsigned pair_or(unsigned v) { auto rr = __builtin_amdgcn_permlane32_swap(v, v, false, false); return rr[0] | rr[1]; }
__host__ __device__ constexpr int cand_a(int c) { return c < 16 ? 0 : c < 24 ? 1 : c < 29 ? 2 : c < 33 ? 3 : c < 36 ? 4 : c < 38 ? 5 : c < 40 ? 6 : c < 42 ? 7 : c - 34; }
__host__ __device__ constexpr int cand_b(int c) { return c < 16 ? c : c < 24 ? c - 16 : c < 29 ? c - 24 : c < 33 ? c - 29 : c < 36 ? c - 33 : c < 38 ? c - 36 : c < 40 ? c - 38 : c < 42 ? c - 40 : 0; }
__device__ __forceinline__ void topk16_of_128(const bf16* keys  , const bf16* qrow  , int r32, int hi, unsigned (&sel)[16]) {
    bf16x8 qf[8];
#pragma unroll
    for (int ks = 0; ks < 8; ++ks) qf[ks] = *(const GAS bf16x8*)(qrow + 16 * ks + 8 * hi);
    unsigned k[64];
#pragma unroll
    for (int kb = 0; kb < 4; ++kb) { f32x16 acc = {};
#pragma unroll
        for (int ks = 0; ks < 8; ++ks) acc = __builtin_amdgcn_mfma_f32_32x32x16_bf16(*(const GAS bf16x8*)(keys + (size_t)(32 * kb + r32) * 128 + 16 * ks + 8 * hi), qf[ks], acc, 0, 0, 0);
#pragma unroll
        for (int r = 0; r < 16; ++r) k[kb * 16 + r] = (ord_key(acc[r]) & ~0x7fu) | (unsigned)(127 - (32 * kb + crow(r, hi))); }
#pragma unroll
    for (int it = 0; it < 16; ++it) { unsigned m = umax3(k[0], k[1], k[2]);
#pragma unroll
        for (int i = 3; i < 63; i += 2) m = umax3(m, k[i], k[i + 1]);
        m = max(m, k[63]); m = pair_max(m); sel[it] = m;
#pragma unroll
        for (int i = 0; i < 64; ++i) k[i] = (k[i] == m) ? 0u : k[i]; }
}
__device__ __forceinline__ void topk_phase(const Args& A, Frame& F) {
    unsigned char* ws = A.ws;
    const bf16* QP = (const bf16*)(ws + WS_R1); const bf16* K1 = (const bf16*)(ws + WS_K1B); const bf16* K2 = (const bf16*)(ws + WS_K2B); int* IDX = (int*)(ws + WS_IDX); float* GATE = (float*)(ws + WS_GATE);
    const int wid = F.wave;
    for (int unit = F.vcu; unit < 256; unit += F.G) {
        const int rb = unit >> 3, h = unit & 7; const int ln = lane_id(), r32 = ln & 31, hi = ln >> 5; const int tok = rb * 256 + wid * 32 + r32;
        unsigned s1[16], s2[16];
        topk16_of_128(K1 + (size_t)h * 16384, QP + (size_t)tok * 2048 + h * 256, r32, hi, s1);
        topk16_of_128(K2 + (size_t)h * 16384, QP + (size_t)tok * 2048 + h * 256 + 128, r32, hi, s2);
        float t1v[16], t2v[16]; int i1[16], i2[16];
#pragma unroll
        for (int a = 0; a < 16; ++a) { t1v[a] = ord_val(s1[a] & ~0x7fu); i1[a] = 127 - (int)(s1[a] & 0x7fu); t2v[a] = ord_val(s2[a] & ~0x7fu); i2[a] = 127 - (int)(s2[a] & 0x7fu); }
        unsigned ck[25]; int ce[25];
#pragma unroll
        for (int j = 0; j < 25; ++j) { constexpr int dummy = 0; (void)dummy;
            const int c0 = 2 * j, c1 = 2 * j + 1;
            const float v0 = t1v[cand_a(c0)] + t2v[cand_b(c0)], v1 = t1v[cand_a(c1)] + t2v[cand_b(c1)];
            const unsigned k0 = (ord_key(v0) & ~0xffu) | (unsigned)(255 - (cand_a(c0) * 16 + cand_b(c0))), k1 = (ord_key(v1) & ~0xffu) | (unsigned)(255 - (cand_a(c1) * 16 + cand_b(c1)));
            const int e0 = i1[cand_a(c0)] * 128 + i2[cand_b(c0)], e1 = i1[cand_a(c1)] * 128 + i2[cand_b(c1)];
            ck[j] = hi ? k1 : k0; ce[j] = hi ? e1 : e0; }
        unsigned gk[16]; int ge[16];
#pragma unroll
        for (int it = 0; it < 16; ++it) { unsigned m = ck[0];
#pragma unroll
            for (int j = 1; j < 25; j += 2) m = umax3(m, ck[j], ck[j + 1]);
            m = pair_max(m); gk[it] = m; int e = 0;
#pragma unroll
            for (int j = 0; j < 25; ++j) { const bool eq = ck[j] == m; e = eq ? ce[j] : e; ck[j] = eq ? 0u : ck[j]; }
            ge[it] = e; }
        float ev[16]; float l = 0.f; const float v0 = ord_val(gk[0] & ~0xffu);
#pragma unroll
        for (int it = 0; it < 16; ++it) { ge[it] = (int)pair_or((unsigned)ge[it]); ev[it] = __builtin_amdgcn_exp2f((ord_val(gk[it] & ~0xffu) - v0) * 1.4426950408889634f); l += ev[it]; }
        const float il = 1.0f / l;
        if (hi == 0) { int* ip = IDX + (size_t)tok * 128 + h * 16; float* gp = GATE + (size_t)tok * 128 + h * 16;
#pragma unroll
            for (int q = 0; q < 4; ++q) { *(GAS v4u*)(ip + 4 * q) = (v4u){(unsigned)ge[4 * q], (unsigned)ge[4 * q + 1], (unsigned)ge[4 * q + 2], (unsigned)ge[4 * q + 3]};
                *(GAS f32x4*)(gp + 4 * q) = (f32x4){ev[4 * q] * il, ev[4 * q + 1] * il, ev[4 * q + 2] * il, ev[4 * q + 3] * il}; } }
    }
}

__device__ __forceinline__ bf16x2_t asbf(unsigned u) { return __builtin_bit_cast(bf16x2_t, u); }
__device__ __forceinline__ float dot8(v4u a, v4u b, float c) {
    c = __builtin_amdgcn_fdot2_f32_bf16(asbf(a.x), asbf(b.x), c, false); c = __builtin_amdgcn_fdot2_f32_bf16(asbf(a.y), asbf(b.y), c, false);
    c = __builtin_amdgcn_fdot2_f32_bf16(asbf(a.z), asbf(b.z), c, false); c = __builtin_amdgcn_fdot2_f32_bf16(asbf(a.w), asbf(b.w), c, false); return c;
}
__device__ __forceinline__ void fmac_s(float& acc, float ws, float x) { asm("v_fmac_f32_e32 %0, %1, %2" : "+v"(acc) : "s"(ws), "v"(x)); }
__device__ __forceinline__ void axpy8(float (&acc)[8], v4u v, float w  ) {
    fmac_s(acc[0], w, __uint_as_float(v.x << 16)); fmac_s(acc[1], w, __uint_as_float(v.x & 0xffff0000u)); fmac_s(acc[2], w, __uint_as_float(v.y << 16)); fmac_s(acc[3], w, __uint_as_float(v.y & 0xffff0000u));
    fmac_s(acc[4], w, __uint_as_float(v.z << 16)); fmac_s(acc[5], w, __uint_as_float(v.z & 0xffff0000u)); fmac_s(acc[6], w, __uint_as_float(v.w << 16)); fmac_s(acc[7], w, __uint_as_float(v.w & 0xffff0000u));
}
constexpr float U8_SCALE = 256.f, V8_SCALE = 16.f;
typedef float f32x2c __attribute__((ext_vector_type(2)));
struct Row2 { v4u c[2]; };
__device__ __forceinline__ Row2 load_row8(const GAS unsigned char* base, unsigned e, unsigned lane16) { const GAS unsigned char* p = base + (size_t)e * 2048 + lane16; Row2 r; r.c[0] = *(const GAS v4u*)p; r.c[1] = *(const GAS v4u*)(p + 1024); return r; }
__device__ __forceinline__ float fma_s(float a, float b, float c) { float r; asm("v_fma_f32 %0, %1, %2, %3" : "=v"(r) : "v"(a), "v"(b), "v"(c)); return r; }
__device__ __forceinline__ float dot4_8(const float* a, unsigned w, float s) { const f32x2c lo = __builtin_amdgcn_cvt_pk_f32_fp8((int)w, false), hi = __builtin_amdgcn_cvt_pk_f32_fp8((int)w, true);
    s = fma_s(a[0], lo.x, s); s = fma_s(a[1], lo.y, s); s = fma_s(a[2], hi.x, s); s = fma_s(a[3], hi.y, s); return s; }
__device__ __forceinline__ void axpy4_8(float* acc, unsigned w, float ws) { const f32x2c lo = __builtin_amdgcn_cvt_pk_f32_fp8((int)w, false), hi = __builtin_amdgcn_cvt_pk_f32_fp8((int)w, true);
    fmac_s(acc[0], ws, lo.x); fmac_s(acc[1], ws, lo.y); fmac_s(acc[2], ws, hi.x); fmac_s(acc[3], ws, hi.y); }
template <bool DRY> __device__ __forceinline__ void gather_phase(const Args& A, Frame& F) {
    unsigned char* ws = A.ws;
    const GAS unsigned char* UB = (const GAS unsigned char*)(ws + WS_UB); const GAS unsigned char* VB = (const GAS unsigned char*)(ws + WS_VB);
    float* H1 = (float*)(ws + WS_H1); bf16* H1B = (bf16*)(ws + WS_H1B); const float* psh1 = (const float*)(ws + WS_PSH1); const int* IDX = (const int*)(ws + WS_IDX); const float* GATE = (const float*)(ws + WS_GATE); float* rsh2 = (float*)(ws + WS_RSH2);
    const int gw = F.vcu * NWAVES + F.wave, NGW = F.G * NWAVES;
    for (int tk = gw; tk < T_TOK; tk += NGW) {
        const int lane = lane_id(); const unsigned lane16 = (unsigned)lane * 16u; const int kq = (lane >> 2) & 15;
        const float rs = (1.0f / sqrtf(wave_sum64(psh1[(size_t)tk * 64 + lane]) * (1.f / 2048.f) + 1e-6f)) * (1.f / U8_SCALE);
        float af[32], acc[32];
#pragma unroll
        for (int j = 0; j < 2; ++j) { const v4u a0 = *(const GAS v4u*)(H1B + (size_t)tk * 2048 + 1024 * j + 16 * lane), a1 = *(const GAS v4u*)(H1B + (size_t)tk * 2048 + 1024 * j + 16 * lane + 8);
            const unsigned aw[8] = {a0.x, a0.y, a0.z, a0.w, a1.x, a1.y, a1.z, a1.w};
#pragma unroll
            for (int q = 0; q < 8; ++q) { af[16 * j + 2 * q] = __uint_as_float(aw[q] << 16); af[16 * j + 2 * q + 1] = __uint_as_float(aw[q] & 0xffff0000u); }
#pragma unroll
            for (int q = 0; q < 4; ++q) { const f32x4 x = *(const GAS f32x4*)(H1 + (size_t)tk * 2048 + 1024 * j + 16 * lane + 4 * q); acc[16 * j + 4 * q] = x[0]; acc[16 * j + 4 * q + 1] = x[1]; acc[16 * j + 4 * q + 2] = x[2]; acc[16 * j + 4 * q + 3] = x[3]; } }
        for (int hd = 0; hd < 8; ++hd) {
            const int ev = IDX[(size_t)tk * 128 + hd * 16 + kq]; const float gv = GATE[(size_t)tk * 128 + hd * 16 + kq];
            float p[16];
            Row2 bA[4], bB[4];
#define LD4(buf, base, k0) do { _Pragma("unroll") for (int q = 0; q < 4; ++q) buf[q] = load_row8(base, (unsigned)__builtin_amdgcn_readlane(ev, 4 * ((k0) + q)), lane16); } while (0)
#define DOT4(buf, k0) do { _Pragma("unroll") for (int q = 0; q < 4; ++q) { float s = 0.f; _Pragma("unroll") for (int j = 0; j < 2; ++j) { s = dot4_8(af + 16 * j, buf[q].c[j].x, s); s = dot4_8(af + 16 * j + 4, buf[q].c[j].y, s); s = dot4_8(af + 16 * j + 8, buf[q].c[j].z, s); s = dot4_8(af + 16 * j + 12, buf[q].c[j].w, s); } p[(k0) + q] = s; } } while (0)
#define AX4(buf, k0) do { _Pragma("unroll") for (int q = 0; q < 4; ++q) { const float wk = __uint_as_float((unsigned)__builtin_amdgcn_readlane((int)__float_as_uint(w), 4 * ((k0) + q))); _Pragma("unroll") for (int j = 0; j < 2; ++j) { axpy4_8(acc + 16 * j, buf[q].c[j].x, wk); axpy4_8(acc + 16 * j + 4, buf[q].c[j].y, wk); axpy4_8(acc + 16 * j + 8, buf[q].c[j].z, wk); axpy4_8(acc + 16 * j + 12, buf[q].c[j].w, wk); } } } while (0)
            LD4(bA, UB, 0); LD4(bB, UB, 4); SBAR(); DOT4(bA, 0); SBAR(); LD4(bA, UB, 8); SBAR(); DOT4(bB, 4); SBAR(); LD4(bB, UB, 12); SBAR(); DOT4(bA, 8); SBAR(); LD4(bA, VB, 0); SBAR(); DOT4(bB, 12); SBAR(); LD4(bB, VB, 4); SBAR();
            { const bool b5 = lane & 32, b4 = lane & 16, b3 = lane & 8, b2 = lane & 4; float q8[8], q4[4], q2[2], q1;
#pragma unroll
              for (int i = 0; i < 8; ++i) { const float keep = b5 ? p[i + 8] : p[i], send = b5 ? p[i] : p[i + 8]; q8[i] = keep + __shfl_xor(send, 32); }
#pragma unroll
              for (int i = 0; i < 4; ++i) { const float keep = b4 ? q8[i + 4] : q8[i], send = b4 ? q8[i] : q8[i + 4]; q4[i] = keep + __shfl_xor(send, 16); }
#pragma unroll
              for (int i = 0; i < 2; ++i) { const float keep = b3 ? q4[i + 2] : q4[i], send = b3 ? q4[i] : q4[i + 2]; q2[i] = keep + __shfl_xor(send, 8); }
              { const float keep = b2 ? q2[1] : q2[0], send = b2 ? q2[0] : q2[1]; q1 = keep + __shfl_xor(send, 4); }
              q1 += __shfl_xor(q1, 2); q1 += __shfl_xor(q1, 1); p[0] = q1; }
            const float w = gv * gelu_f(p[0] * rs) * (1.f / V8_SCALE);
            SBAR(); AX4(bA, 0); SBAR(); LD4(bA, VB, 8); SBAR(); AX4(bB, 4); SBAR(); LD4(bB, VB, 12); SBAR(); AX4(bA, 8); SBAR(); AX4(bB, 12); SBAR();
#undef LD4
#undef DOT4
#undef AX4
        }
        float ss = 0.f;
        float* H1o = DRY ? (float*)(ws + WS_NA0) + (size_t)(tk & 2047) * 2048 : H1 + (size_t)tk * 2048; bf16* H1Bo = DRY ? (bf16*)(ws + WS_NGL) + (size_t)(tk & 2047) * 2048 : H1B + (size_t)tk * 2048;
#pragma unroll
        for (int j = 0; j < 2; ++j) {
#pragma unroll
            for (int q = 0; q < 2; ++q) { const f32x4 y0 = {acc[16 * j + 8 * q], acc[16 * j + 8 * q + 1], acc[16 * j + 8 * q + 2], acc[16 * j + 8 * q + 3]}, y1 = {acc[16 * j + 8 * q + 4], acc[16 * j + 8 * q + 5], acc[16 * j + 8 * q + 6], acc[16 * j + 8 * q + 7]}; ss += sq8(y0, y1);
                *(GAS f32x4*)(H1o + 1024 * j + 16 * lane + 8 * q) = y0; *(GAS f32x4*)(H1o + 1024 * j + 16 * lane + 8 * q + 4) = y1; *(GAS v4u*)(H1Bo + 1024 * j + 16 * lane + 8 * q) = pack8(y0, y1); } }
        ss = wave_sum64(ss); if (lane == 0 && !DRY) rsh2[tk] = 1.0f / sqrtf(ss * (1.f / 2048.f) + 1e-6f);
    }
}
#ifndef NSLICE_SHIFT
#define NSLICE_SHIFT 9
#endif
__device__ __forceinline__ void tok_load(const unsigned char* ws, int tk, int lane, float (&af)[32], float (&acc)[32], float& rs, int (&ev)[2], float (&gv)[2]) {
    const float* H1 = (const float*)(ws + WS_H1); const bf16* H1B = (const bf16*)(ws + WS_H1B); const float* psh1 = (const float*)(ws + WS_PSH1); const int* IDX = (const int*)(ws + WS_IDX); const float* GATE = (const float*)(ws + WS_GATE);
    rs = (1.0f / sqrtf(wave_sum64(psh1[(size_t)tk * 64 + lane]) * (1.f / 2048.f) + 1e-6f)) * (1.f / U8_SCALE);
#pragma unroll
    for (int j = 0; j < 2; ++j) { const v4u a0 = *(const GAS v4u*)(H1B + (size_t)tk * 2048 + 1024 * j + 16 * lane), a1 = *(const GAS v4u*)(H1B + (size_t)tk * 2048 + 1024 * j + 16 * lane + 8);
        const unsigned aw[8] = {a0.x, a0.y, a0.z, a0.w, a1.x, a1.y, a1.z, a1.w};
#pragma unroll
        for (int q = 0; q < 8; ++q) { af[16 * j + 2 * q] = __uint_as_float(aw[q] << 16); af[16 * j + 2 * q + 1] = __uint_as_float(aw[q] & 0xffff0000u); }
#pragma unroll
        for (int q = 0; q < 4; ++q) { const f32x4 x = *(const GAS f32x4*)(H1 + (size_t)tk * 2048 + 1024 * j + 16 * lane + 4 * q); acc[16 * j + 4 * q] = x[0]; acc[16 * j + 4 * q + 1] = x[1]; acc[16 * j + 4 * q + 2] = x[2]; acc[16 * j + 4 * q + 3] = x[3]; } }
    ev[0] = IDX[(size_t)tk * 128 + lane]; ev[1] = IDX[(size_t)tk * 128 + 64 + lane]; gv[0] = GATE[(size_t)tk * 128 + lane]; gv[1] = GATE[(size_t)tk * 128 + 64 + lane];
}
template <bool DRY> __device__ __forceinline__ void tok_store(unsigned char* ws, int tk, int lane, const float (&acc)[32]) {
    float* H1 = (float*)(ws + WS_H1); bf16* H1B = (bf16*)(ws + WS_H1B); float* rsh2 = (float*)(ws + WS_RSH2);
    float ss = 0.f;
    float* H1o = DRY ? (float*)(ws + WS_NA0) + (size_t)(tk & 2047) * 2048 : H1 + (size_t)tk * 2048; bf16* H1Bo = DRY ? (bf16*)(ws + WS_NGL) + (size_t)(tk & 2047) * 2048 : H1B + (size_t)tk * 2048;
#pragma unroll
    for (int j = 0; j < 2; ++j) {
#pragma unroll
        for (int q = 0; q < 2; ++q) { const f32x4 y0 = {acc[16 * j + 8 * q], acc[16 * j + 8 * q + 1], acc[16 * j + 8 * q + 2], acc[16 * j + 8 * q + 3]}, y1 = {acc[16 * j + 8 * q + 4], acc[16 * j + 8 * q + 5], acc[16 * j + 8 * q + 6], acc[16 * j + 8 * q + 7]}; ss += sq8(y0, y1);
            *(GAS f32x4*)(H1o + 1024 * j + 16 * lane + 8 * q) = y0; *(GAS f32x4*)(H1o + 1024 * j + 16 * lane + 8 * q + 4) = y1; *(GAS v4u*)(H1Bo + 1024 * j + 16 * lane + 8 * q) = pack8(y0, y1); } }
    ss = wave_sum64(ss); if (lane == 0 && !DRY) rsh2[tk] = 1.0f / sqrtf(ss * (1.f / 2048.f) + 1e-6f);
}
__device__ __forceinline__ float dot_row8(const float (&af)[32], const Row2& r) { float s = 0.f;
#pragma unroll
    for (int j = 0; j < 2; ++j) { s = dot4_8(af + 16 * j, r.c[j].x, s); s = dot4_8(af + 16 * j + 4, r.c[j].y, s); s = dot4_8(af + 16 * j + 8, r.c[j].z, s); s = dot4_8(af + 16 * j + 12, r.c[j].w, s); }
    return s; }
__device__ __forceinline__ void axpy_row8(float (&acc)[32], const Row2& r, float wk) {
#pragma unroll
    for (int j = 0; j < 2; ++j) { axpy4_8(acc + 16 * j, r.c[j].x, wk); axpy4_8(acc + 16 * j + 4, r.c[j].y, wk); axpy4_8(acc + 16 * j + 8, r.c[j].z, wk); axpy4_8(acc + 16 * j + 12, r.c[j].w, wk); } }
__device__ __forceinline__ void tok_slice(const GAS unsigned char* UB, const GAS unsigned char* VB, int s, int lane, unsigned lane16, const float (&af)[32], float (&acc)[32], float rs, const int (&ev)[2], const float (&gv)[2]) {
    unsigned long long m0 = __ballot((ev[0] >> NSLICE_SHIFT) == s), m1 = __ballot((ev[1] >> NSLICE_SHIFT) == s);
    while (m0 | m1) {
        int e0, e1; float g0, g1;
        if (m0) { const int i = __builtin_ctzll(m0); m0 &= m0 - 1; e0 = __builtin_amdgcn_readlane(ev[0], i); g0 = __uint_as_float((unsigned)__builtin_amdgcn_readlane((int)__float_as_uint(gv[0]), i)); }
        else { const int i = __builtin_ctzll(m1); m1 &= m1 - 1; e0 = __builtin_amdgcn_readlane(ev[1], i); g0 = __uint_as_float((unsigned)__builtin_amdgcn_readlane((int)__float_as_uint(gv[1]), i)); }
        if (m0) { const int i = __builtin_ctzll(m0); m0 &= m0 - 1; e1 = __builtin_amdgcn_readlane(ev[0], i); g1 = __uint_as_float((unsigned)__builtin_amdgcn_readlane((int)__float_as_uint(gv[0]), i)); }
        else if (m1) { const int i = __builtin_ctzll(m1); m1 &= m1 - 1; e1 = __builtin_amdgcn_readlane(ev[1], i); g1 = __uint_as_float((unsigned)__builtin_amdgcn_readlane((int)__float_as_uint(gv[1]), i)); }
        else { e1 = e0; g1 = 0.f; }
        const Row2 u0 = load_row8(UB, (unsigned)e0, lane16), u1 = load_row8(UB, (unsigned)e1, lane16), v0 = load_row8(VB, (unsigned)e0, lane16), v1 = load_row8(VB, (unsigned)e1, lane16);
        const float p0 = dot_row8(af, u0), p1 = dot_row8(af, u1);
        const bool b5 = lane & 32; float h = (b5 ? p1 : p0) + __shfl_xor(b5 ? p0 : p1, 32);
        h += __shfl_xor(h, 16); h += __shfl_xor(h, 8); h += __shfl_xor(h, 4); h += __shfl_xor(h, 2); h += __shfl_xor(h, 1);
        const float w = (b5 ? g1 : g0) * gelu_f(h * rs) * (1.f / V8_SCALE);
        const float w0 = __uint_as_float((unsigned)__builtin_amdgcn_readlane((int)__float_as_uint(w), 0)), w1 = __uint_as_float((unsigned)__builtin_amdgcn_readlane((int)__float_as_uint(w), 32));
        axpy_row8(acc, v0, w0); axpy_row8(acc, v1, w1);
    }
}
template <bool DRY> __device__ __forceinline__ void gather_sliced_phase(const Args& A, Frame& F) {
    unsigned char* ws = A.ws;
    const GAS unsigned char* UB = (const GAS unsigned char*)(ws + WS_UB); const GAS unsigned char* VB = (const GAS unsigned char*)(ws + WS_VB);
    const int gw = F.vcu * NWAVES + F.wave, NGW = F.G * NWAVES;
    for (int tk0 = 2 * gw; tk0 < T_TOK; tk0 += 2 * NGW) {
        const int lane = lane_id(); const unsigned lane16 = (unsigned)lane * 16u;
        float afA[32], accA[32], afB[32], accB[32], rsA, rsB; int evA[2], evB[2]; float gvA[2], gvB[2];
        tok_load(ws, tk0, lane, afA, accA, rsA, evA, gvA); tok_load(ws, tk0 + 1, lane, afB, accB, rsB, evB, gvB);
        for (int s = 0; s < (16384 >> NSLICE_SHIFT); ++s) { tok_slice(UB, VB, s, lane, lane16, afA, accA, rsA, evA, gvA); tok_slice(UB, VB, s, lane, lane16, afB, accB, rsB, evB, gvB); }
        tok_store<DRY>(ws, tk0, lane, accA); tok_store<DRY>(ws, tk0 + 1, lane, accB);
    }
}
#ifndef PROBE_NOV
#define PROBE_NOV 0
#endif
struct Tok2 { f32x2c af[16], acc[16]; float rs; int ev[2]; float gv[2]; };
__device__ __forceinline__ void tok2_load(const unsigned char* ws, int tk, int lane, Tok2& T) {
    const float* H1 = (const float*)(ws + WS_H1); const bf16* H1B = (const bf16*)(ws + WS_H1B); const float* psh1 = (const float*)(ws + WS_PSH1); const int* IDX = (const int*)(ws + WS_IDX); const float* GATE = (const float*)(ws + WS_GATE);
    T.rs = (1.0f / sqrtf(wave_sum64(psh1[(size_t)tk * 64 + lane]) * (1.f / 2048.f) + 1e-6f)) * (1.f / U8_SCALE);
#pragma unroll
    for (int j = 0; j < 2; ++j) { const v4u a0 = *(const GAS v4u*)(H1B + (size_t)tk * 2048 + 1024 * j + 16 * lane), a1 = *(const GAS v4u*)(H1B + (size_t)tk * 2048 + 1024 * j + 16 * lane + 8);
        const unsigned aw[8] = {a0.x, a0.y, a0.z, a0.w, a1.x, a1.y, a1.z, a1.w};
#pragma unroll
        for (int q = 0; q < 8; ++q) T.af[8 * j + q] = (f32x2c){__uint_as_float(aw[q] << 16), __uint_as_float(aw[q] & 0xffff0000u)};
#pragma unroll
        for (int q = 0; q < 4; ++q) { const f32x4 x = *(const GAS f32x4*)(H1 + (size_t)tk * 2048 + 1024 * j + 16 * lane + 4 * q); T.acc[8 * j + 2 * q] = (f32x2c){x[0], x[1]}; T.acc[8 * j + 2 * q + 1] = (f32x2c){x[2], x[3]}; } }
    T.ev[0] = IDX[(size_t)tk * 128 + lane]; T.ev[1] = IDX[(size_t)tk * 128 + 64 + lane]; T.gv[0] = GATE[(size_t)tk * 128 + lane]; T.gv[1] = GATE[(size_t)tk * 128 + 64 + lane];
}
template <bool DRY> __device__ __forceinline__ void tok2_store(unsigned char* ws, int tk, int lane_, const Tok2& T) {
    const int lane = lane_id(); (void)lane_;
    float* H1 = (float*)(ws + WS_H1); bf16* H1B = (bf16*)(ws + WS_H1B); float* rsh2 = (float*)(ws + WS_RSH2);
    float ss = 0.f;
    float* H1o = DRY ? (float*)(ws + WS_NA0) + (size_t)(tk & 2047) * 2048 : H1 + (size_t)tk * 2048; bf16* H1Bo = DRY ? (bf16*)(ws + WS_NGL) + (size_t)(tk & 2047) * 2048 : H1B + (size_t)tk * 2048;
#pragma unroll
    for (int j = 0; j < 2; ++j) {
#pragma unroll
        for (int q = 0; q < 2; ++q) { const f32x4 y0 = {T.acc[8 * j + 4 * q].x, T.acc[8 * j + 4 * q].y, T.acc[8 * j + 4 * q + 1].x, T.acc[8 * j + 4 * q + 1].y}, y1 = {T.acc[8 * j + 4 * q + 2].x, T.acc[8 * j + 4 * q + 2].y, T.acc[8 * j + 4 * q + 3].x, T.acc[8 * j + 4 * q + 3].y}; ss += sq8(y0, y1);
            *(GAS f32x4*)(H1o + 1024 * j + 16 * lane + 8 * q) = y0; *(GAS f32x4*)(H1o + 1024 * j + 16 * lane + 8 * q + 4) = y1; *(GAS v4u*)(H1Bo + 1024 * j + 16 * lane + 8 * q) = pack8(y0, y1); } }
    ss = wave_sum64(ss); if (lane == 0 && !DRY) rsh2[tk] = 1.0f / sqrtf(ss * (1.f / 2048.f) + 1e-6f);
}
__device__ __forceinline__ float dot_row8p(const Tok2& T, const Row2& r) { f32x2c s0 = {0.f, 0.f}, s1 = {0.f, 0.f}, s2 = {0.f, 0.f}, s3 = {0.f, 0.f};
#pragma unroll
    for (int j = 0; j < 2; ++j) { const unsigned w[4] = {r.c[j].x, r.c[j].y, r.c[j].z, r.c[j].w};
#pragma unroll
        for (int d = 0; d < 4; ++d) { const f32x2c lo = __builtin_amdgcn_cvt_pk_f32_fp8((int)w[d], false), hi = __builtin_amdgcn_cvt_pk_f32_fp8((int)w[d], true);
            if (j == 0) { s0 = __builtin_elementwise_fma(T.af[2 * d], lo, s0); s1 = __builtin_elementwise_fma(T.af[2 * d + 1], hi, s1); }
            else { s2 = __builtin_elementwise_fma(T.af[8 + 2 * d], lo, s2); s3 = __builtin_elementwise_fma(T.af[8 + 2 * d + 1], hi, s3); } } }
    const f32x2c t = (s0 + s1) + (s2 + s3); return t.x + t.y; }
__device__ __forceinline__ void axpy_row8p(Tok2& T, const Row2& r, float wk) { const f32x2c w2 = {wk, wk};
#pragma unroll
    for (int j = 0; j < 2; ++j) { const unsigned w[4] = {r.c[j].x, r.c[j].y, r.c[j].z, r.c[j].w};
#pragma unroll
        for (int d = 0; d < 4; ++d) { const f32x2c lo = __builtin_amdgcn_cvt_pk_f32_fp8((int)w[d], false), hi = __builtin_amdgcn_cvt_pk_f32_fp8((int)w[d], true);
            T.acc[8 * j + 2 * d] = __builtin_elementwise_fma(w2, lo, T.acc[8 * j + 2 * d]); T.acc[8 * j + 2 * d + 1] = __builtin_elementwise_fma(w2, hi, T.acc[8 * j + 2 * d + 1]); } } }
__device__ __forceinline__ float dpp_add(float v, const int ctrl, const int rmask) { return v; }
#define DPP_ADD(v, ctrl, rmask) v += __uint_as_float((unsigned)__builtin_amdgcn_update_dpp(0, (int)__float_as_uint(v), ctrl, rmask, 0xF, true))
__device__ __forceinline__ float reduce2(float p0, float p1) {
    auto rr = __builtin_amdgcn_permlane32_swap(__float_as_uint(p0), __float_as_uint(p1), false, false);
    float h = __uint_as_float(rr[0]) + __uint_as_float(rr[1]);
    DPP_ADD(h, 0xB1, 0xF); DPP_ADD(h, 0x4E, 0xF); DPP_ADD(h, 0x141, 0xF); DPP_ADD(h, 0x140, 0xF); DPP_ADD(h, 0x142, 0xA);
    return h; }
__device__ __forceinline__ int take2(unsigned long long& m0, unsigned long long& m1, const Tok2& T, int& e0, float& g0, int& e1, float& g1) {
    if (!(m0 | m1)) return 0;
    if (m0) { const int i = __builtin_ctzll(m0); m0 &= m0 - 1; e0 = __builtin_amdgcn_readlane(T.ev[0], i); g0 = __uint_as_float((unsigned)__builtin_amdgcn_readlane((int)__float_as_uint(T.gv[0]), i)); }
    else { const int i = __builtin_ctzll(m1); m1 &= m1 - 1; e0 = __builtin_amdgcn_readlane(T.ev[1], i); g0 = __uint_as_float((unsigned)__builtin_amdgcn_readlane((int)__float_as_uint(T.gv[1]), i)); }
    if (m0) { const int i = __builtin_ctzll(m0); m0 &= m0 - 1; e1 = __builtin_amdgcn_readlane(T.ev[0], i); g1 = __uint_as_float((unsigned)__builtin_amdgcn_readlane((int)__float_as_uint(T.gv[0]), i)); return 2; }
    if (m1) { const int i = __builtin_ctzll(m1); m1 &= m1 - 1; e1 = __builtin_amdgcn_readlane(T.ev[1], i); g1 = __uint_as_float((unsigned)__builtin_amdgcn_readlane((int)__float_as_uint(T.gv[1]), i)); return 2; }
    e1 = e0; g1 = 0.f; return 1;
}
__device__ __forceinline__ void batch2(Tok2& T, const Row2& u0, const Row2& u1, const Row2& v0, const Row2& v1, float g0, float g1, int lane) {
    const float h = reduce2(dot_row8p(T, u0), dot_row8p(T, u1));
    const float w = ((lane & 32) ? g1 : g0) * gelu_f(h * T.rs) * (1.f / V8_SCALE);
    const float w0 = __uint_as_float((unsigned)__builtin_amdgcn_readlane((int)__float_as_uint(w), 31)), w1 = __uint_as_float((unsigned)__builtin_amdgcn_readlane((int)__float_as_uint(w), 63));
    axpy_row8p(T, v0, w0); axpy_row8p(T, v1, w1);
}
#ifndef GATHER_PREFETCH
#define GATHER_PREFETCH 0
#endif
constexpr int SLICE_EXPERTS = 1 << NSLICE_SHIFT, SLICE_SHARE = 2048;
static_assert(NSLICE_SHIFT != 8 || SLICE_EXPERTS * 2048 / 256 == SLICE_SHARE, "prefetch share");
__device__ __forceinline__ unsigned slice_prefetch(const GAS unsigned char* UB, const GAS unsigned char* VB, int snext, unsigned wx) {
    const GAS unsigned char* pu = UB + (size_t)snext * (SLICE_EXPERTS * 2048) + (size_t)wx * SLICE_SHARE; const GAS unsigned char* pv = VB + (size_t)snext * (SLICE_EXPERTS * 2048) + (size_t)wx * SLICE_SHARE;
    unsigned d;
    asm volatile("s_load_dword %0, %1, 0x0\n\ts_load_dword %0, %1, 0x80\n\ts_load_dword %0, %1, 0x100\n\ts_load_dword %0, %1, 0x180\n\ts_load_dword %0, %1, 0x200\n\ts_load_dword %0, %1, 0x280\n\ts_load_dword %0, %1, 0x300\n\ts_load_dword %0, %1, 0x380\n\ts_load_dword %0, %1, 0x400\n\ts_load_dword %0, %1, 0x480\n\ts_load_dword %0, %1, 0x500\n\ts_load_dword %0, %1, 0x580\n\ts_load_dword %0, %1, 0x600\n\ts_load_dword %0, %1, 0x680\n\ts_load_dword %0, %1, 0x700\n\ts_load_dword %0, %1, 0x780\n\ts_load_dword %0, %2, 0x0\n\ts_load_dword %0, %2, 0x80\n\ts_load_dword %0, %2, 0x100\n\ts_load_dword %0, %2, 0x180\n\ts_load_dword %0, %2, 0x200\n\ts_load_dword %0, %2, 0x280\n\ts_load_dword %0, %2, 0x300\n\ts_load_dword %0, %2, 0x380\n\ts_load_dword %0, %2, 0x400\n\ts_load_dword %0, %2, 0x480\n\ts_load_dword %0, %2, 0x500\n\ts_load_dword %0, %2, 0x580\n\ts_load_dword %0, %2, 0x600\n\ts_load_dword %0, %2, 0x680\n\ts_load_dword %0, %2, 0x700\n\ts_load_dword %0, %2, 0x780\n\ts_nop 0" : "=&s"(d) : "s"(pu), "s"(pv));
    return d;
}
__device__ __forceinline__ void slice_prefetch_done(unsigned& d) { asm volatile("s_waitcnt lgkmcnt(0)" : "+s"(d)); }
template <bool DRY> __device__ __forceinline__ void gather_sliced2_phase(const Args& A, Frame& F) {
    unsigned char* ws = A.ws;
    const GAS unsigned char* UB = (const GAS unsigned char*)(ws + WS_UB); const GAS unsigned char* VB = (const GAS unsigned char*)(ws + WS_VB);
    const int gw = F.vcu * NWAVES + F.wave, NGW = F.G * NWAVES;
    for (int tk0 = 2 * gw; tk0 < T_TOK; tk0 += 2 * NGW) {
        const int lane = lane_id(); const unsigned lane16 = (unsigned)lane * 16u;
        Tok2 TA, TB; tok2_load(ws, tk0, lane, TA); tok2_load(ws, tk0 + 1, lane, TB);
        const unsigned wx = (unsigned)((F.vcu & 31) * NWAVES + F.wave);
        for (int s = 0; s < (16384 >> NSLICE_SHIFT); ++s) {
            unsigned pf_d = 0u; if (GATHER_PREFETCH && NSLICE_SHIFT == 8) pf_d = slice_prefetch(UB, VB, (s + 1) & ((16384 >> NSLICE_SHIFT) - 1), wx);
            unsigned long long a0 = __ballot((TA.ev[0] >> NSLICE_SHIFT) == s), a1 = __ballot((TA.ev[1] >> NSLICE_SHIFT) == s), b0 = __ballot((TB.ev[0] >> NSLICE_SHIFT) == s), b1 = __ballot((TB.ev[1] >> NSLICE_SHIFT) == s);
            while (a0 | a1 | b0 | b1) {
                int eA0 = 0, eA1 = 0, eB0 = 0, eB1 = 0; float gA0 = 0.f, gA1 = 0.f, gB0 = 0.f, gB1 = 0.f;
                const int nA = take2(a0, a1, TA, eA0, gA0, eA1, gA1), nB = take2(b0, b1, TB, eB0, gB0, eB1, gB1);
                if (DRY && PROBE_NOV == 4) { eA0 &= 255; eA1 &= 255; eB0 &= 255; eB1 &= 255; } if (DRY && PROBE_NOV == 5) { eA0 &= 3; eA1 &= 3; eB0 &= 3; eB1 &= 3; }
                Row2 uA0, uA1, vA0, vA1, uB0, uB1, vB0, vB1;
                if (DRY && PROBE_NOV == 2) { uA0.c[0] = uA0.c[1] = (v4u){(unsigned)eA0, (unsigned)lane, 0x38383838u, 0x3c3c3c3cu}; uA1 = uA0; vA0 = uA0; vA1 = uA0; uB0 = uA0; uB1 = uA0; vB0 = uA0; vB1 = uA0; } else
                if (nA) { uA0 = load_row8(UB, (unsigned)eA0, lane16); uA1 = load_row8(UB, (unsigned)eA1, lane16); if (DRY && PROBE_NOV) { vA0 = uA0; vA1 = uA1; } else { vA0 = load_row8(VB, (unsigned)eA0, lane16); vA1 = load_row8(VB, (unsigned)eA1, lane16); } }
                if (!(DRY && PROBE_NOV == 2)) if (nB) { uB0 = load_row8(UB, (unsigned)eB0, lane16); uB1 = load_row8(UB, (unsigned)eB1, lane16); if (DRY && PROBE_NOV) { vB0 = uB0; vB1 = uB1; } else { vB0 = load_row8(VB, (unsigned)eB0, lane16); vB1 = load_row8(VB, (unsigned)eB1, lane16); } }
                if (DRY && PROBE_NOV == 3) { unsigned x = 0;
                    if (nA) x ^= uA0.c[0].x ^ uA0.c[0].w ^ uA0.c[1].y ^ uA1.c[0].x ^ uA1.c[1].w ^ vA0.c[0].x ^ vA0.c[1].w ^ vA1.c[0].y ^ vA1.c[1].z ^ uA0.c[0].y ^ uA0.c[0].z ^ uA0.c[1].x ^ uA0.c[1].z ^ uA0.c[1].w ^ uA1.c[0].y ^ uA1.c[0].z ^ uA1.c[0].w ^ uA1.c[1].x ^ uA1.c[1].y ^ uA1.c[1].z ^ vA0.c[0].y ^ vA0.c[0].z ^ vA0.c[0].w ^ vA0.c[1].x ^ vA0.c[1].y ^ vA0.c[1].z ^ vA1.c[0].x ^ vA1.c[0].z ^ vA1.c[0].w ^ vA1.c[1].x ^ vA1.c[1].y ^ vA1.c[1].w;
                    if (nB) x ^= uB0.c[0].x ^ uB0.c[0].w ^ uB0.c[1].y ^ uB1.c[0].x ^ uB1.c[1].w ^ vB0.c[0].x ^ vB0.c[1].w ^ vB1.c[0].y ^ vB1.c[1].z ^ uB0.c[0].y ^ uB0.c[0].z ^ uB0.c[1].x ^ uB0.c[1].z ^ uB0.c[1].w ^ uB1.c[0].y ^ uB1.c[0].z ^ uB1.c[0].w ^ uB1.c[1].x ^ uB1.c[1].y ^ uB1.c[1].z ^ vB0.c[0].y ^ vB0.c[0].z ^ vB0.c[0].w ^ vB0.c[1].x ^ vB0.c[1].y ^ vB0.c[1].z ^ vB1.c[0].x ^ vB1.c[0].z ^ vB1.c[0].w ^ vB1.c[1].x ^ vB1.c[1].y ^ vB1.c[1].w;
                    TA.acc[0].x += __uint_as_float(x & 1u); } else {
                if (nA) batch2(TA, uA0, uA1, vA0, vA1, gA0, gA1, lane);
                if (nB) batch2(TB, uB0, uB1, vB0, vB1, gB0, gB1, lane); }
            }
            if (GATHER_PREFETCH && NSLICE_SHIFT == 8) slice_prefetch_done(pf_d);
        }
        tok2_store<DRY>(ws, tk0, lane, TA); tok2_store<DRY>(ws, tk0 + 1, lane, TB);
    }
}
struct Acc2 { f32x2c acc[16]; float rs; int ev[2]; float gv[2]; };
struct It8 { int nA, nB; float gA0, gA1, gB0, gB1; Row2 uA0, uA1, vA0, vA1, uB0, uB1, vB0, vB1; };
__device__ __forceinline__ void tok3_load(const unsigned char* ws, int tk, int lane, Acc2& T, LAS unsigned char* afl  ) {
    const float* H1 = (const float*)(ws + WS_H1); const bf16* H1B = (const bf16*)(ws + WS_H1B); const float* psh1 = (const float*)(ws + WS_PSH1); const int* IDX = (const int*)(ws + WS_IDX); const float* GATE = (const float*)(ws + WS_GATE);
    T.rs = (1.0f / sqrtf(wave_sum64(psh1[(size_t)tk * 64 + lane]) * (1.f / 2048.f) + 1e-6f)) * (1.f / U8_SCALE);
#pragma unroll
    for (int j = 0; j < 2; ++j) { const v4u a0 = *(const GAS v4u*)(H1B + (size_t)tk * 2048 + 1024 * j + 16 * lane), a1 = *(const GAS v4u*)(H1B + (size_t)tk * 2048 + 1024 * j + 16 * lane + 8);
        const unsigned aw[8] = {a0.x, a0.y, a0.z, a0.w, a1.x, a1.y, a1.z, a1.w};
#pragma unroll
        for (int d = 0; d < 4; ++d) *(LAS f32x4*)(afl + (4 * j + d) * 1024 + lane * 16) = (f32x4){__uint_as_float(aw[2 * d] << 16), __uint_as_float(aw[2 * d] & 0xffff0000u), __uint_as_float(aw[2 * d + 1] << 16), __uint_as_float(aw[2 * d + 1] & 0xffff0000u)};
#pragma unroll
        for (int q = 0; q < 4; ++q) { const f32x4 x = *(const GAS f32x4*)(H1 + (size_t)tk * 2048 + 1024 * j + 16 * lane + 4 * q); T.acc[8 * j + 2 * q] = (f32x2c){x[0], x[1]}; T.acc[8 * j + 2 * q + 1] = (f32x2c){x[2], x[3]}; } }
    T.ev[0] = IDX[(size_t)tk * 128 + lane]; T.ev[1] = IDX[(size_t)tk * 128 + 64 + lane]; T.gv[0] = GATE[(size_t)tk * 128 + lane]; T.gv[1] = GATE[(size_t)tk * 128 + 64 + lane];
}
template <bool DRY> __device__ __forceinline__ void tok3_store(unsigned char* ws, int tk, int lane, const Acc2& T) {
    float* H1 = (float*)(ws + WS_H1); bf16* H1B = (bf16*)(ws + WS_H1B); float* rsh2 = (float*)(ws + WS_RSH2);
    float ss = 0.f;
    float* H1o = DRY ? (float*)(ws + WS_NA0) + (size_t)(tk & 2047) * 2048 : H1 + (size_t)tk * 2048; bf16* H1Bo = DRY ? (bf16*)(ws + WS_NGL) + (size_t)(tk & 2047) * 2048 : H1B + (size_t)tk * 2048;
#pragma unroll
    for (int j = 0; j < 2; ++j) {
#pragma unroll
        for (int q = 0; q < 2; ++q) { const f32x4 y0 = {T.acc[8 * j + 4 * q].x, T.acc[8 * j + 4 * q].y, T.acc[8 * j + 4 * q + 1].x, T.acc[8 * j + 4 * q + 1].y}, y1 = {T.acc[8 * j + 4 * q + 2].x, T.acc[8 * j + 4 * q + 2].y, T.acc[8 * j + 4 * q + 3].x, T.acc[8 * j + 4 * q + 3].y}; ss += sq8(y0, y1);
            *(GAS f32x4*)(H1o + 1024 * j + 16 * lane + 8 * q) = y0; *(GAS f32x4*)(H1o + 1024 * j + 16 * lane + 8 * q + 4) = y1; *(GAS v4u*)(H1Bo + 1024 * j + 16 * lane + 8 * q) = pack8(y0, y1); } }
    ss = wave_sum64(ss); if (lane == 0 && !DRY) rsh2[tk] = 1.0f / sqrtf(ss * (1.f / 2048.f) + 1e-6f);
}
__device__ __forceinline__ void batch3(Acc2& T, const LAS unsigned char* afl, const Row2& u0, const Row2& u1, const Row2& v0, const Row2& v1, float g0, float g1, int lane) {
    f32x2c s0 = {0.f, 0.f}, s1 = {0.f, 0.f}, t0 = {0.f, 0.f}, t1 = {0.f, 0.f};
    f32x4 aa[8];
#pragma unroll
    for (int c = 0; c < 8; ++c) aa[c] = *(const LAS f32x4*)(afl + c * 1024 + lane * 16);
    asm volatile("s_waitcnt lgkmcnt(0)" : "+v"(aa[0]), "+v"(aa[1]), "+v"(aa[2]), "+v"(aa[3]), "+v"(aa[4]), "+v"(aa[5]), "+v"(aa[6]), "+v"(aa[7]));
#pragma unroll
    for (int j = 0; j < 2; ++j) { const unsigned w0[4] = {u0.c[j].x, u0.c[j].y, u0.c[j].z, u0.c[j].w}, w1[4] = {u1.c[j].x, u1.c[j].y, u1.c[j].z, u1.c[j].w};
#pragma unroll
        for (int d = 0; d < 4; ++d) { const f32x4 a = aa[4 * j + d]; const f32x2c alo = {a[0], a[1]}, ahi = {a[2], a[3]};
            s0 = __builtin_elementwise_fma(alo, __builtin_amdgcn_cvt_pk_f32_fp8((int)w0[d], false), s0); s1 = __builtin_elementwise_fma(ahi, __builtin_amdgcn_cvt_pk_f32_fp8((int)w0[d], true), s1);
            t0 = __builtin_elementwise_fma(alo, __builtin_amdgcn_cvt_pk_f32_fp8((int)w1[d], false), t0); t1 = __builtin_elementwise_fma(ahi, __builtin_amdgcn_cvt_pk_f32_fp8((int)w1[d], true), t1); } }
    const f32x2c ps = s0 + s1, pt = t0 + t1;
    const float h = reduce2(ps.x + ps.y, pt.x + pt.y);
    const float w = ((lane & 32) ? g1 : g0) * gelu_f(h * T.rs) * (1.f / V8_SCALE);
    const float wa = __uint_as_float((unsigned)__builtin_amdgcn_readlane((int)__float_as_uint(w), 31)), wb = __uint_as_float((unsigned)__builtin_amdgcn_readlane((int)__float_as_uint(w), 63));
    const f32x2c wa2 = {wa, wa}, wb2 = {wb, wb};
#pragma unroll
    for (int j = 0; j < 2; ++j) { const unsigned w0[4] = {v0.c[j].x, v0.c[j].y, v0.c[j].z, v0.c[j].w}, w1[4] = {v1.c[j].x, v1.c[j].y, v1.c[j].z, v1.c[j].w};
#pragma unroll
        for (int d = 0; d < 4; ++d) {
            T.acc[8 * j + 2 * d] = __builtin_elementwise_fma(wa2, __builtin_amdgcn_cvt_pk_f32_fp8((int)w0[d], false), T.acc[8 * j + 2 * d]); T.acc[8 * j + 2 * d + 1] = __builtin_elementwise_fma(wa2, __builtin_amdgcn_cvt_pk_f32_fp8((int)w0[d], true), T.acc[8 * j + 2 * d + 1]);
            T.acc[8 * j + 2 * d] = __builtin_elementwise_fma(wb2, __builtin_amdgcn_cvt_pk_f32_fp8((int)w1[d], false), T.acc[8 * j + 2 * d]); T.acc[8 * j + 2 * d + 1] = __builtin_elementwise_fma(wb2, __builtin_amdgcn_cvt_pk_f32_fp8((int)w1[d], true), T.acc[8 * j + 2 * d + 1]); } }
}
struct Sweep { int s; unsigned long long a0, a1, b0, b1; };
__device__ __forceinline__ int take2b(unsigned long long& m0, unsigned long long& m1, const int (&ev)[2], const float (&gv)[2], int& e0, float& g0, int& e1, float& g1) {
    if (!(m0 | m1)) return 0;
    if (m0) { const int i = __builtin_ctzll(m0); m0 &= m0 - 1; e0 = __builtin_amdgcn_readlane(ev[0], i); g0 = __uint_as_float((unsigned)__builtin_amdgcn_readlane((int)__float_as_uint(gv[0]), i)); }
    else { const int i = __builtin_ctzll(m1); m1 &= m1 - 1; e0 = __builtin_amdgcn_readlane(ev[1], i); g0 = __uint_as_float((unsigned)__builtin_amdgcn_readlane((int)__float_as_uint(gv[1]), i)); }
    if (m0) { const int i = __builtin_ctzll(m0); m0 &= m0 - 1; e1 = __builtin_amdgcn_readlane(ev[0], i); g1 = __uint_as_float((unsigned)__builtin_amdgcn_readlane((int)__float_as_uint(gv[0]), i)); return 2; }
    if (m1) { const int i = __builtin_ctzll(m1); m1 &= m1 - 1; e1 = __builtin_amdgcn_readlane(ev[1], i); g1 = __uint_as_float((unsigned)__builtin_amdgcn_readlane((int)__float_as_uint(gv[1]), i)); return 2; }
    e1 = e0; g1 = 0.f; return 1;
}
__device__ __forceinline__ void gen_load(Sweep& W, const Acc2& TA, const Acc2& TB, const GAS unsigned char* UB, const GAS unsigned char* VB, unsigned lane16, It8& I) {
    while (!(W.a0 | W.a1 | W.b0 | W.b1) && W.s + 1 < (16384 >> NSLICE_SHIFT)) { ++W.s;
        W.a0 = __ballot((TA.ev[0] >> NSLICE_SHIFT) == W.s); W.a1 = __ballot((TA.ev[1] >> NSLICE_SHIFT) == W.s); W.b0 = __ballot((TB.ev[0] >> NSLICE_SHIFT) == W.s); W.b1 = __ballot((TB.ev[1] >> NSLICE_SHIFT) == W.s); }
    int eA0 = 0, eA1 = 0, eB0 = 0, eB1 = 0; I.gA0 = 0.f; I.gA1 = 0.f; I.gB0 = 0.f; I.gB1 = 0.f;
    I.nA = take2b(W.a0, W.a1, TA.ev, TA.gv, eA0, I.gA0, eA1, I.gA1); I.nB = take2b(W.b0, W.b1, TB.ev, TB.gv, eB0, I.gB0, eB1, I.gB1);
    if (!I.nA) { eA0 = eB0; eA1 = eB1; } if (!I.nB) { eB0 = eA0; eB1 = eA1; }
    I.uA0 = load_row8(UB, (unsigned)eA0, lane16); I.uA1 = load_row8(UB, (unsigned)eA1, lane16); I.vA0 = load_row8(VB, (unsigned)eA0, lane16); I.vA1 = load_row8(VB, (unsigned)eA1, lane16);
    I.uB0 = load_row8(UB, (unsigned)eB0, lane16); I.uB1 = load_row8(UB, (unsigned)eB1, lane16); I.vB0 = load_row8(VB, (unsigned)eB0, lane16); I.vB1 = load_row8(VB, (unsigned)eB1, lane16);
}
template <bool DRY> __device__ __forceinline__ void gather_sliced3_phase(const Args& A, Frame& F) {
    unsigned char* ws = A.ws;
    const GAS unsigned char* UB = (const GAS unsigned char*)(ws + WS_UB); const GAS unsigned char* VB = (const GAS unsigned char*)(ws + WS_VB);
    const int gw = F.vcu * NWAVES + F.wave, NGW = F.G * NWAVES;
    LAS unsigned char* aflA = F.lds + RING_OFF + F.wave * 16384; LAS unsigned char* aflB = aflA + 8192;
    for (int tk0 = 2 * gw; tk0 < T_TOK; tk0 += 2 * NGW) {
        const int lane = lane_id(); const unsigned lane16 = (unsigned)lane * 16u;
        Acc2 TA, TB; tok3_load(ws, tk0, lane, TA, aflA); tok3_load(ws, tk0 + 1, lane, TB, aflB);
        Sweep W; W.s = -1; W.a0 = W.a1 = W.b0 = W.b1 = 0ull;
        It8 X, Y;
        gen_load(W, TA, TB, UB, VB, lane16, X);
        for (;;) {
            gen_load(W, TA, TB, UB, VB, lane16, Y);
            if (X.nA) batch3(TA, aflA, X.uA0, X.uA1, X.vA0, X.vA1, X.gA0, X.gA1, lane);
            if (X.nB) batch3(TB, aflB, X.uB0, X.uB1, X.vB0, X.vB1, X.gB0, X.gB1, lane);
            if (!(Y.nA | Y.nB)) break;
            gen_load(W, TA, TB, UB, VB, lane16, X);
            if (Y.nA) batch3(TA, aflA, Y.uA0, Y.uA1, Y.vA0, Y.vA1, Y.gA0, Y.gA1, lane);
            if (Y.nB) batch3(TB, aflB, Y.uB0, Y.uB1, Y.vB0, Y.vB1, Y.gB0, Y.gB1, lane);
            if (!(X.nA | X.nB)) break;
        }
        tok3_store<DRY>(ws, tk0, lane, TA); tok3_store<DRY>(ws, tk0 + 1, lane, TB);
    }
}
struct It4 { int tok; float g0, g1; Row2 u0, u1, v0, v1; };
__device__ __forceinline__ void gen4(Sweep& W, const Tok2& TA, const Tok2& TB, const GAS unsigned char* UB, const GAS unsigned char* VB, unsigned lane16, It4& I) {
    while (!(W.a0 | W.a1 | W.b0 | W.b1) && W.s + 1 < (16384 >> NSLICE_SHIFT)) { ++W.s;
        W.a0 = __ballot((TA.ev[0] >> NSLICE_SHIFT) == W.s); W.a1 = __ballot((TA.ev[1] >> NSLICE_SHIFT) == W.s); W.b0 = __ballot((TB.ev[0] >> NSLICE_SHIFT) == W.s); W.b1 = __ballot((TB.ev[1] >> NSLICE_SHIFT) == W.s); }
    int e0 = 0, e1 = 0; I.g0 = 0.f; I.g1 = 0.f; I.tok = -1;
    if (W.a0 | W.a1) { take2b(W.a0, W.a1, TA.ev, TA.gv, e0, I.g0, e1, I.g1); I.tok = 0; }
    else if (W.b0 | W.b1) { take2b(W.b0, W.b1, TB.ev, TB.gv, e0, I.g0, e1, I.g1); I.tok = 1; }
    I.u0 = load_row8(UB, (unsigned)e0, lane16); I.u1 = load_row8(UB, (unsigned)e1, lane16); I.v0 = load_row8(VB, (unsigned)e0, lane16); I.v1 = load_row8(VB, (unsigned)e1, lane16);
}
template <bool DRY> __device__ __forceinline__ void gather_sliced4_phase(const Args& A, Frame& F) {
    unsigned char* ws = A.ws;
    const GAS unsigned char* UB = (const GAS unsigned char*)(ws + WS_UB); const GAS unsigned char* VB = (const GAS unsigned char*)(ws + WS_VB);
    const int gw = F.vcu * NWAVES + F.wave, NGW = F.G * NWAVES;
    for (int tk0 = 2 * gw; tk0 < T_TOK; tk0 += 2 * NGW) {
        const int lane = lane_id(); const unsigned lane16 = (unsigned)lane * 16u;
        Tok2 TA, TB; tok2_load(ws, tk0, lane, TA); tok2_load(ws, tk0 + 1, lane, TB);
        Sweep W; W.s = -1; W.a0 = W.a1 = W.b0 = W.b1 = 0ull;
        It4 X, Y;
        gen4(W, TA, TB, UB, VB, lane16, X);
        for (;;) {
            gen4(W, TA, TB, UB, VB, lane16, Y);
            if (X.tok == 0) batch2(TA, X.u0, X.u1, X.v0, X.v1, X.g0, X.g1, lane); else if (X.tok == 1) batch2(TB, X.u0, X.u1, X.v0, X.v1, X.g0, X.g1, lane);
            if (Y.tok < 0) break;
            gen4(W, TA, TB, UB, VB, lane16, X);
            if (Y.tok == 0) batch2(TA, Y.u0, Y.u1, Y.v0, Y.v1, Y.g0, Y.g1, lane); else if (Y.tok == 1) batch2(TB, Y.u0, Y.u1, Y.v0, Y.v1, Y.g0, Y.g1, lane);
            if (X.tok < 0) break;
        }
        tok2_store<DRY>(ws, tk0, lane, TA); tok2_store<DRY>(ws, tk0 + 1, lane, TB);
    }
}
__device__ __forceinline__ void gen5(Sweep& W, const Acc2& TA, const Acc2& TB, const GAS unsigned char* UB, const GAS unsigned char* VB, unsigned lane16, It4& I) {
    while (!(W.a0 | W.a1 | W.b0 | W.b1) && W.s + 1 < (16384 >> NSLICE_SHIFT)) { ++W.s;
        W.a0 = __ballot((TA.ev[0] >> NSLICE_SHIFT) == W.s); W.a1 = __ballot((TA.ev[1] >> NSLICE_SHIFT) == W.s); W.b0 = __ballot((TB.ev[0] >> NSLICE_SHIFT) == W.s); W.b1 = __ballot((TB.ev[1] >> NSLICE_SHIFT) == W.s); }
    int e0 = 0, e1 = 0; I.g0 = 0.f; I.g1 = 0.f; I.tok = -1;
    if (W.a0 | W.a1) { take2b(W.a0, W.a1, TA.ev, TA.gv, e0, I.g0, e1, I.g1); I.tok = 0; }
    else if (W.b0 | W.b1) { take2b(W.b0, W.b1, TB.ev, TB.gv, e0, I.g0, e1, I.g1); I.tok = 1; }
    I.u0 = load_row8(UB, (unsigned)e0, lane16); I.u1 = load_row8(UB, (unsigned)e1, lane16); I.v0 = load_row8(VB, (unsigned)e0, lane16); I.v1 = load_row8(VB, (unsigned)e1, lane16);
}
template <bool DRY> __device__ __forceinline__ void gather_sliced5_phase(const Args& A, Frame& F) {
    unsigned char* ws = A.ws;
    const GAS unsigned char* UB = (const GAS unsigned char*)(ws + WS_UB); const GAS unsigned char* VB = (const GAS unsigned char*)(ws + WS_VB);
    const int gw = F.vcu * NWAVES + F.wave, NGW = F.G * NWAVES;
    LAS unsigned char* aflA = F.lds + RING_OFF + F.wave * 16384; LAS unsigned char* aflB = aflA + 8192;
    for (int tk0 = 2 * gw; tk0 < T_TOK; tk0 += 2 * NGW) {
        const int lane = lane_id(); const unsigned lane16 = (unsigned)lane * 16u;
        Acc2 TA, TB; tok3_load(ws, tk0, lane, TA, aflA); tok3_load(ws, tk0 + 1, lane, TB, aflB);
        Sweep W; W.s = -1; W.a0 = W.a1 = W.b0 = W.b1 = 0ull;
        It4 X, Y;
        gen5(W, TA, TB, UB, VB, lane16, X);
        for (;;) {
            gen5(W, TA, TB, UB, VB, lane16, Y);
            if (X.tok == 0) batch3(TA, aflA, X.u0, X.u1, X.v0, X.v1, X.g0, X.g1, lane); else if (X.tok == 1) batch3(TB, aflB, X.u0, X.u1, X.v0, X.v1, X.g0, X.g1, lane);
            if (Y.tok < 0) break;
            gen5(W, TA, TB, UB, VB, lane16, X);
            if (Y.tok == 0) batch3(TA, aflA, Y.u0, Y.u1, Y.v0, Y.v1, Y.g0, Y.g1, lane); else if (Y.tok == 1) batch3(TB, aflB, Y.u0, Y.u1, Y.v0, Y.v1, Y.g0, Y.g1, lane);
            if (X.tok < 0) break;
        }
        tok3_store<DRY>(ws, tk0, lane, TA); tok3_store<DRY>(ws, tk0 + 1, lane, TB);
    }
}
struct Cur { int s; unsigned long long m0, m1; };
__device__ __forceinline__ int gen6(Cur& C, const Tok2& T, const GAS unsigned char* UB, const GAS unsigned char* VB, unsigned lane16, Row2& u0, Row2& u1, Row2& v0, Row2& v1, float& g0, float& g1) {
    while (!(C.m0 | C.m1) && C.s + 1 < (16384 >> NSLICE_SHIFT)) { ++C.s; C.m0 = __ballot((T.ev[0] >> NSLICE_SHIFT) == C.s); C.m1 = __ballot((T.ev[1] >> NSLICE_SHIFT) == C.s); }
    int e0 = 0, e1 = 0; g0 = 0.f; g1 = 0.f;
    const int n = take2b(C.m0, C.m1, T.ev, T.gv, e0, g0, e1, g1);
    u0 = load_row8(UB, (unsigned)e0, lane16); u1 = load_row8(UB, (unsigned)e1, lane16); v0 = load_row8(VB, (unsigned)e0, lane16); v1 = load_row8(VB, (unsigned)e1, lane16);
    return n;
}
template <bool DRY> __device__ __forceinline__ void gather_sliced6_phase(const Args& A, Frame& F) {
    unsigned char* ws = A.ws;
    const GAS unsigned char* UB = (const GAS unsigned char*)(ws + WS_UB); const GAS unsigned char* VB = (const GAS unsigned char*)(ws + WS_VB);
    const int gw = F.vcu * NWAVES + F.wave, NGW = F.G * NWAVES;
    for (int tk0 = 2 * gw; tk0 < T_TOK; tk0 += 2 * NGW) {
        const int lane = lane_id(); const unsigned lane16 = (unsigned)lane * 16u;
        Tok2 TA, TB; tok2_load(ws, tk0, lane, TA); SBAR(); tok2_load(ws, tk0 + 1, lane, TB); SBAR();
        Cur CA, CB; CA.s = -1; CA.m0 = CA.m1 = 0ull; CB.s = -1; CB.m0 = CB.m1 = 0ull;
        Row2 uA0, uA1, vA0, vA1, uB0, uB1, vB0, vB1; float gA0, gA1, gB0, gB1;
        int nA = gen6(CA, TA, UB, VB, lane16, uA0, uA1, vA0, vA1, gA0, gA1), nB = gen6(CB, TB, UB, VB, lane16, uB0, uB1, vB0, vB1, gB0, gB1);
        while (nA | nB) {
            if (nA) batch2(TA, uA0, uA1, vA0, vA1, gA0, gA1, lane);
            SBAR(); nA = gen6(CA, TA, UB, VB, lane16, uA0, uA1, vA0, vA1, gA0, gA1); SBAR();
            if (nB) batch2(TB, uB0, uB1, vB0, vB1, gB0, gB1, lane);
            SBAR(); nB = gen6(CB, TB, UB, VB, lane16, uB0, uB1, vB0, vB1, gB0, gB1); SBAR();
        }
        tok2_store<DRY>(ws, tk0, lane, TA); tok2_store<DRY>(ws, tk0 + 1, lane, TB);
    }
}
__device__ __forceinline__ int gen7(Cur& C, const Acc2& T, const GAS unsigned char* UB, const GAS unsigned char* VB, unsigned lane16, Row2& u0, Row2& u1, Row2& v0, Row2& v1, float& g0, float& g1) {
    while (!(C.m0 | C.m1) && C.s + 1 < (16384 >> NSLICE_SHIFT)) { ++C.s; C.m0 = __ballot((T.ev[0] >> NSLICE_SHIFT) == C.s); C.m1 = __ballot((T.ev[1] >> NSLICE_SHIFT) == C.s); }
    int e0 = 0, e1 = 0; g0 = 0.f; g1 = 0.f;
    const int n = take2b(C.m0, C.m1, T.ev, T.gv, e0, g0, e1, g1);
    u0 = load_row8(UB, (unsigned)e0, lane16); u1 = load_row8(UB, (unsigned)e1, lane16); v0 = load_row8(VB, (unsigned)e0, lane16); v1 = load_row8(VB, (unsigned)e1, lane16);
    return n;
}
template <bool DRY> __device__ __forceinline__ void gather_sliced7_phase(const Args& A, Frame& F) {
    unsigned char* ws = A.ws;
    const GAS unsigned char* UB = (const GAS unsigned char*)(ws + WS_UB); const GAS unsigned char* VB = (const GAS unsigned char*)(ws + WS_VB);
    const int gw = F.vcu * NWAVES + F.wave, NGW = F.G * NWAVES;
    LAS unsigned char* aflA = F.lds + RING_OFF + F.wave * 16384; LAS unsigned char* aflB = aflA + 8192;
    for (int tk0 = 2 * gw; tk0 < T_TOK; tk0 += 2 * NGW) {
        const int lane = lane_id(); const unsigned lane16 = (unsigned)lane * 16u;
        Acc2 TA, TB; tok3_load(ws, tk0, lane, TA, aflA); tok3_load(ws, tk0 + 1, lane, TB, aflB);
        Cur CA, CB; CA.s = -1; CA.m0 = CA.m1 = 0ull; CB.s = -1; CB.m0 = CB.m1 = 0ull;
        Row2 uA0, uA1, vA0, vA1, uB0, uB1, vB0, vB1; float gA0, gA1, gB0, gB1;
        int nA = gen7(CA, TA, UB, VB, lane16, uA0, uA1, vA0, vA1, gA0, gA1), nB = gen7(CB, TB, UB, VB, lane16, uB0, uB1, vB0, vB1, gB0, gB1);
        while (nA | nB) {
            if (nA) batch3(TA, aflA, uA0, uA1, vA0, vA1, gA0, gA1, lane);
            nA = gen7(CA, TA, UB, VB, lane16, uA0, uA1, vA0, vA1, gA0, gA1);
            if (nB) batch3(TB, aflB, uB0, uB1, vB0, vB1, gB0, gB1, lane);
            nB = gen7(CB, TB, UB, VB, lane16, uB0, uB1, vB0, vB1, gB0, gB1);
        }
        tok3_store<DRY>(ws, tk0, lane, TA); tok3_store<DRY>(ws, tk0 + 1, lane, TB);
    }
}
__device__ __forceinline__ void fma8_lo(f32x2c& s, f32x2c a, unsigned w) { f32x2c t; asm("v_cvt_pk_f32_fp8_e32 %1, %3\n\tv_pk_fma_f32 %0, %2, %1, %0" : "+v"(s), "=&v"(t) : "v"(a), "v"(w)); }
__device__ __forceinline__ void fma8_hi(f32x2c& s, f32x2c a, unsigned w) { f32x2c t; asm("v_cvt_pk_f32_fp8_sdwa %1, %3 src0_sel:WORD_1\n\tv_pk_fma_f32 %0, %2, %1, %0" : "+v"(s), "=&v"(t) : "v"(a), "v"(w)); }
__device__ __forceinline__ void dots2(const Tok2& T, const Row2& u0, const Row2& u1, float& p0, float& p1) {
    f32x2c s0 = {0.f, 0.f}, s1 = {0.f, 0.f};
#pragma unroll
    for (int j = 0; j < 2; ++j) { const unsigned w0[4] = {u0.c[j].x, u0.c[j].y, u0.c[j].z, u0.c[j].w}, w1[4] = {u1.c[j].x, u1.c[j].y, u1.c[j].z, u1.c[j].w};
#pragma unroll
        for (int d = 0; d < 4; ++d) { fma8_lo(s0, T.af[8 * j + 2 * d], w0[d]); fma8_lo(s1, T.af[8 * j + 2 * d], w1[d]); fma8_hi(s0, T.af[8 * j + 2 * d + 1], w0[d]); fma8_hi(s1, T.af[8 * j + 2 * d + 1], w1[d]); } }
    p0 = s0.x + s0.y; p1 = s1.x + s1.y;
}
__device__ __forceinline__ void axpy2(Tok2& T, const Row2& v0, const Row2& v1, float wa, float wb) { const f32x2c wa2 = {wa, wa}, wb2 = {wb, wb};
#pragma unroll
    for (int j = 0; j < 2; ++j) { const unsigned w0[4] = {v0.c[j].x, v0.c[j].y, v0.c[j].z, v0.c[j].w}, w1[4] = {v1.c[j].x, v1.c[j].y, v1.c[j].z, v1.c[j].w};
#pragma unroll
        for (int d = 0; d < 4; ++d) { fma8_lo(T.acc[8 * j + 2 * d], wa2, w0[d]); fma8_hi(T.acc[8 * j + 2 * d + 1], wa2, w0[d]); fma8_lo(T.acc[8 * j + 2 * d], wb2, w1[d]); fma8_hi(T.acc[8 * j + 2 * d + 1], wb2, w1[d]); } }
}
__device__ __forceinline__ void gates2(const Tok2& T, float p0, float p1, float g0, float g1, int lane, float& w0, float& w1) {
    const float h = reduce2(p0, p1); const float w = ((lane & 32) ? g1 : g0) * gelu_f(h * T.rs) * (1.f / V8_SCALE);
    w0 = __uint_as_float((unsigned)__builtin_amdgcn_readlane((int)__float_as_uint(w), 31)); w1 = __uint_as_float((unsigned)__builtin_amdgcn_readlane((int)__float_as_uint(w), 63));
}
__device__ __forceinline__ int next8(Cur& C, const Tok2& T, int& e0, int& e1, float& g0, float& g1) {
    while (!(C.m0 | C.m1) && C.s + 1 < (16384 >> NSLICE_SHIFT)) { ++C.s; C.m0 = __ballot((T.ev[0] >> NSLICE_SHIFT) == C.s); C.m1 = __ballot((T.ev[1] >> NSLICE_SHIFT) == C.s); }
    e0 = 0; e1 = 0; g0 = 0.f; g1 = 0.f; return take2b(C.m0, C.m1, T.ev, T.gv, e0, g0, e1, g1);
}
__device__ __forceinline__ Row2 load_row8b(__amdgpu_buffer_rsrc_t rs, unsigned e, unsigned lane16) { Row2 r; r.c[0] = __builtin_amdgcn_raw_buffer_load_b128(rs, lane16, e * 2048u, 0); r.c[1] = __builtin_amdgcn_raw_buffer_load_b128(rs, lane16 + 1024u, e * 2048u, 0); return r; }
template <bool DRY> __device__ __forceinline__ void gather_sliced8_phase(const Args& A, Frame& F) {
    unsigned char* ws = A.ws;
    const GAS unsigned char* UB = (const GAS unsigned char*)(ws + WS_UB); const GAS unsigned char* VB = (const GAS unsigned char*)(ws + WS_VB);
    const int gw = F.vcu * NWAVES + F.wave, NGW = F.G * NWAVES;
    const __amdgpu_buffer_rsrc_t RU = __builtin_amdgcn_make_buffer_rsrc((void*)(ws + WS_UB), 0, 16384 * 2048, 0x00020000), RV = __builtin_amdgcn_make_buffer_rsrc((void*)(ws + WS_VB), 0, 16384 * 2048, 0x00020000);
    for (int tk0 = 2 * gw; tk0 < T_TOK; tk0 += 2 * NGW) {
        const int lane = lane_id(); const unsigned lane16 = (unsigned)lane * 16u;
        Tok2 TA, TB; tok2_load(ws, tk0, lane, TA); tok2_load(ws, tk0 + 1, lane, TB);
        Cur CA, CB; CA.s = -1; CA.m0 = CA.m1 = 0ull; CB.s = -1; CB.m0 = CB.m1 = 0ull;
        Row2 uA0, uA1, vA0, vA1, uB0, uB1, vB0, vB1;
        int eA0, eA1, eB0, eB1; float gA0, gA1, gB0, gB1;
        int nA = next8(CA, TA, eA0, eA1, gA0, gA1), nB = next8(CB, TB, eB0, eB1, gB0, gB1);
        uA0 = load_row8b(RU, (unsigned)eA0, lane16); uA1 = load_row8b(RU, (unsigned)eA1, lane16); uB0 = load_row8b(RU, (unsigned)eB0, lane16); uB1 = load_row8b(RU, (unsigned)eB1, lane16);
        vA0 = load_row8b(RV, (unsigned)eA0, lane16); vA1 = load_row8b(RV, (unsigned)eA1, lane16); vB0 = load_row8b(RV, (unsigned)eB0, lane16); vB1 = load_row8b(RV, (unsigned)eB1, lane16);
        do {
            float wA0 = 0.f, wA1 = 0.f, wB0 = 0.f, wB1 = 0.f; const int cA = nA, cB = nB;
            if (cA) { float p0, p1; dots2(TA, uA0, uA1, p0, p1); gates2(TA, p0, p1, gA0, gA1, lane, wA0, wA1); }
            nA = next8(CA, TA, eA0, eA1, gA0, gA1); SBAR(); uA0 = load_row8b(RU, (unsigned)eA0, lane16); uA1 = load_row8b(RU, (unsigned)eA1, lane16); SBAR();
            if (cB) { float p0, p1; dots2(TB, uB0, uB1, p0, p1); gates2(TB, p0, p1, gB0, gB1, lane, wB0, wB1); }
            nB = next8(CB, TB, eB0, eB1, gB0, gB1); SBAR(); uB0 = load_row8b(RU, (unsigned)eB0, lane16); uB1 = load_row8b(RU, (unsigned)eB1, lane16); SBAR();
            if (cA) axpy2(TA, vA0, vA1, wA0, wA1);
            SBAR(); vA0 = load_row8b(RV, (unsigned)eA0, lane16); vA1 = load_row8b(RV, (unsigned)eA1, lane16); SBAR();
            if (cB) axpy2(TB, vB0, vB1, wB0, wB1);
            SBAR(); vB0 = load_row8b(RV, (unsigned)eB0, lane16); vB1 = load_row8b(RV, (unsigned)eB1, lane16); SBAR();
        } while (nA | nB);
        tok2_store<DRY>(ws, tk0, lane, TA); tok2_store<DRY>(ws, tk0 + 1, lane, TB);
    }
}
typedef int v8i __attribute__((ext_vector_type(8)));
struct Tok9 { f32x2c acc[16]; Row2 ahi, alo; float rs; int ev[2]; float gv[2]; };
__device__ __forceinline__ unsigned pk4_fp8(float a, float b, float c, float d) { int t = 0; t = __builtin_amdgcn_cvt_pk_fp8_f32(a, b, t, false); t = __builtin_amdgcn_cvt_pk_fp8_f32(c, d, t, true); return (unsigned)t; }
__device__ __forceinline__ void tok9_load(const unsigned char* ws, int tk, int lane, Tok9& T) {
    const float* H1 = (const float*)(ws + WS_H1); const bf16* H1B = (const bf16*)(ws + WS_H1B); const float* psh1 = (const float*)(ws + WS_PSH1); const int* IDX = (const int*)(ws + WS_IDX); const float* GATE = (const float*)(ws + WS_GATE);
    T.rs = (1.0f / sqrtf(wave_sum64(psh1[(size_t)tk * 64 + lane]) * (1.f / 2048.f) + 1e-6f)) * (1.f / U8_SCALE);
#pragma unroll
    for (int j = 0; j < 2; ++j) { const v4u a0 = *(const GAS v4u*)(H1B + (size_t)tk * 2048 + 1024 * j + 16 * lane), a1 = *(const GAS v4u*)(H1B + (size_t)tk * 2048 + 1024 * j + 16 * lane + 8);
        const unsigned aw[8] = {a0.x, a0.y, a0.z, a0.w, a1.x, a1.y, a1.z, a1.w}; unsigned hi4[4], lo4[4];
#pragma unroll
        for (int d = 0; d < 4; ++d) { const float x0 = __uint_as_float(aw[2 * d] << 16), x1 = __uint_as_float(aw[2 * d] & 0xffff0000u), x2 = __uint_as_float(aw[2 * d + 1] << 16), x3 = __uint_as_float(aw[2 * d + 1] & 0xffff0000u);
            const unsigned h = pk4_fp8(x0, x1, x2, x3); const f32x2c l = __builtin_amdgcn_cvt_pk_f32_fp8((int)h, false), u = __builtin_amdgcn_cvt_pk_f32_fp8((int)h, true);
            hi4[d] = h; lo4[d] = pk4_fp8((x0 - l.x) * 16.f, (x1 - l.y) * 16.f, (x2 - u.x) * 16.f, (x3 - u.y) * 16.f); }
        T.ahi.c[j] = (v4u){hi4[0], hi4[1], hi4[2], hi4[3]}; T.alo.c[j] = (v4u){lo4[0], lo4[1], lo4[2], lo4[3]};
#pragma unroll
        for (int q = 0; q < 4; ++q) { const f32x4 x = *(const GAS f32x4*)(H1 + (size_t)tk * 2048 + 1024 * j + 16 * lane + 4 * q); T.acc[8 * j + 2 * q] = (f32x2c){x[0], x[1]}; T.acc[8 * j + 2 * q + 1] = (f32x2c){x[2], x[3]}; } }
    T.ev[0] = IDX[(size_t)tk * 128 + lane]; T.ev[1] = IDX[(size_t)tk * 128 + 64 + lane]; T.gv[0] = GATE[(size_t)tk * 128 + lane]; T.gv[1] = GATE[(size_t)tk * 128 + 64 + lane];
}
template <bool DRY> __device__ __forceinline__ void tok9_store(unsigned char* ws, int tk, const Tok9& T) {
    const int lane = lane_id();
    float* H1 = (float*)(ws + WS_H1); bf16* H1B = (bf16*)(ws + WS_H1B); float* rsh2 = (float*)(ws + WS_RSH2);
    float ss = 0.f;
    float* H1o = DRY ? (float*)(ws + WS_NA0) + (size_t)(tk & 2047) * 2048 : H1 + (size_t)tk * 2048; bf16* H1Bo = DRY ? (bf16*)(ws + WS_NGL) + (size_t)(tk & 2047) * 2048 : H1B + (size_t)tk * 2048;
#pragma unroll
    for (int j = 0; j < 2; ++j) {
#pragma unroll
        for (int q = 0; q < 2; ++q) { const f32x4 y0 = {T.acc[8 * j + 4 * q].x, T.acc[8 * j + 4 * q].y, T.acc[8 * j + 4 * q + 1].x, T.acc[8 * j + 4 * q + 1].y}, y1 = {T.acc[8 * j + 4 * q + 2].x, T.acc[8 * j + 4 * q + 2].y, T.acc[8 * j + 4 * q + 3].x, T.acc[8 * j + 4 * q + 3].y}; ss += sq8(y0, y1);
            *(GAS f32x4*)(H1o + 1024 * j + 16 * lane + 8 * q) = y0; *(GAS f32x4*)(H1o + 1024 * j + 16 * lane + 8 * q + 4) = y1; *(GAS v4u*)(H1Bo + 1024 * j + 16 * lane + 8 * q) = pack8(y0, y1); } }
    ss = wave_sum64(ss); if (lane == 0 && !DRY) rsh2[tk] = 1.0f / sqrtf(ss * (1.f / 2048.f) + 1e-6f);
}
__device__ __forceinline__ v8i as_v8i(const Row2& r) { return (v8i){(int)r.c[0].x, (int)r.c[0].y, (int)r.c[0].z, (int)r.c[0].w, (int)r.c[1].x, (int)r.c[1].y, (int)r.c[1].z, (int)r.c[1].w}; }
__device__ __forceinline__ float dot_mfma(const Tok9& T, const Row2& u, int lane) {
    const v8i ua = as_v8i(u); f32x4 c = {0.f, 0.f, 0.f, 0.f};
    c = __builtin_amdgcn_mfma_scale_f32_16x16x128_f8f6f4(ua, as_v8i(T.ahi), c, 0, 0, 0, 127, 0, 127);
    c = __builtin_amdgcn_mfma_scale_f32_16x16x128_f8f6f4(ua, as_v8i(T.alo), c, 0, 0, 0, 127, 0, 123);
    const int n = lane & 15; const float t0 = (n & 1) ? c[1] : c[0], t1 = (n & 1) ? c[3] : c[2], v = (n & 2) ? t1 : t0;
    return ((lane >> 4) == (n >> 2)) ? v : 0.f;
}
__device__ __forceinline__ void axpy9(Tok9& T, const Row2& v0, const Row2& v1, float wa, float wb) { const f32x2c wa2 = {wa, wa}, wb2 = {wb, wb};
#pragma unroll
    for (int j = 0; j < 2; ++j) { const unsigned w0[4] = {v0.c[j].x, v0.c[j].y, v0.c[j].z, v0.c[j].w}, w1[4] = {v1.c[j].x, v1.c[j].y, v1.c[j].z, v1.c[j].w};
#pragma unroll
        for (int d = 0; d < 4; ++d) { fma8_lo(T.acc[8 * j + 2 * d], wa2, w0[d]); fma8_hi(T.acc[8 * j + 2 * d + 1], wa2, w0[d]); fma8_lo(T.acc[8 * j + 2 * d], wb2, w1[d]); fma8_hi(T.acc[8 * j + 2 * d + 1], wb2, w1[d]); } }
}
__device__ __forceinline__ void batch9(Tok9& T, const Row2& u0, const Row2& u1, const Row2& v0, const Row2& v1, float g0, float g1, int lane) {
    const float h = reduce2(dot_mfma(T, u0, lane), dot_mfma(T, u1, lane));
    const float w = ((lane & 32) ? g1 : g0) * gelu_f(h * T.rs) * (1.f / V8_SCALE);
    const float w0 = __uint_as_float((unsigned)__builtin_amdgcn_readlane((int)__float_as_uint(w), 31)), w1 = __uint_as_float((unsigned)__builtin_amdgcn_readlane((int)__float_as_uint(w), 63));
    axpy9(T, v0, v1, w0, w1);
}
__device__ __forceinline__ int take9(unsigned long long& m0, unsigned long long& m1, const Tok9& T, int& e0, float& g0, int& e1, float& g1) { return take2b(m0, m1, T.ev, T.gv, e0, g0, e1, g1); }
template <bool DRY> __device__ __forceinline__ void gather_sliced9_phase(const Args& A, Frame& F) {
    unsigned char* ws = A.ws;
    const int gw = F.vcu * NWAVES + F.wave, NGW = F.G * NWAVES;
    const __amdgpu_buffer_rsrc_t RU = __builtin_amdgcn_make_buffer_rsrc((void*)(ws + WS_UB), 0, 16384 * 2048, 0x00020000), RV = __builtin_amdgcn_make_buffer_rsrc((void*)(ws + WS_VB), 0, 16384 * 2048, 0x00020000);
    for (int tk0 = 2 * gw; tk0 < T_TOK; tk0 += 2 * NGW) {
        const int lane = lane_id(); const unsigned lane16 = (unsigned)lane * 16u;
        Tok9 TA, TB; tok9_load(ws, tk0, lane, TA); tok9_load(ws, tk0 + 1, lane, TB);
        for (int s = 0; s < (16384 >> NSLICE_SHIFT); ++s) {
            unsigned long long a0 = __ballot((TA.ev[0] >> NSLICE_SHIFT) == s), a1 = __ballot((TA.ev[1] >> NSLICE_SHIFT) == s), b0 = __ballot((TB.ev[0] >> NSLICE_SHIFT) == s), b1 = __ballot((TB.ev[1] >> NSLICE_SHIFT) == s);
            while (a0 | a1 | b0 | b1) {
                int eA0 = 0, eA1 = 0, eB0 = 0, eB1 = 0; float gA0 = 0.f, gA1 = 0.f, gB0 = 0.f, gB1 = 0.f;
                const int nA = take9(a0, a1, TA, eA0, gA0, eA1, gA1), nB = take9(b0, b1, TB, eB0, gB0, eB1, gB1);
                if (DRY && PROBE_NOV == 5) { eA0 &= 3; eA1 &= 3; eB0 &= 3; eB1 &= 3; } if (DRY && PROBE_NOV == 4) { eA0 &= 255; eA1 &= 255; eB0 &= 255; eB1 &= 255; }
                Row2 uA0, uA1, vA0, vA1, uB0, uB1, vB0, vB1;
                if (nA) { uA0 = load_row8b(RU, (unsigned)eA0, lane16); vA0 = load_row8b(RV, (unsigned)eA0, lane16); if (nA == 2) { uA1 = load_row8b(RU, (unsigned)eA1, lane16); vA1 = load_row8b(RV, (unsigned)eA1, lane16); } else { uA1 = uA0; vA1 = vA0; } }
                if (nB) { uB0 = load_row8b(RU, (unsigned)eB0, lane16); vB0 = load_row8b(RV, (unsigned)eB0, lane16); if (nB == 2) { uB1 = load_row8b(RU, (unsigned)eB1, lane16); vB1 = load_row8b(RV, (unsigned)eB1, lane16); } else { uB1 = uB0; vB1 = vB0; } }
                if (nA) batch9(TA, uA0, uA1, vA0, vA1, gA0, gA1, lane);
                if (nB) batch9(TB, uB0, uB1, vB0, vB1, gB0, gB1, lane);
            }
        }
        tok9_store<DRY>(ws, tk0, TA); tok9_store<DRY>(ws, tk0 + 1, TB);
    }
}
#ifndef A_FP6
#define A_FP6 1
#endif
__device__ __forceinline__ unsigned e2m3_code(float v) { const float m = fminf(fabsf(v), 7.5f); const float c = m < 2.f ? rintf(8.f * m) : m < 4.f ? rintf(4.f * m) + 8.f : rintf(2.f * m) + 16.f; return (unsigned)c | (v < 0.f ? 32u : 0u); }
__device__ __forceinline__ float e2m3_val(unsigned code) { const unsigned e = (code >> 3) & 3u, m = code & 7u; const float mag = e == 0 ? (float)m * 0.125f : (1.f + (float)m * 0.125f) * (float)(1u << (e - 1)); return (code & 32u) ? -mag : mag; }
__device__ __forceinline__ void pack_a6(const float (&x)[32], v8i& hi, v8i& lo) {
    unsigned long long ah = 0ull, al = 0ull; int nb = 0, k = 0; unsigned dh[6], dl[6];
#pragma unroll
    for (int i = 0; i < 32; ++i) { const float xs = x[i] * 0.5f; const unsigned ch = e2m3_code(xs); const unsigned cl = e2m3_code((xs - e2m3_val(ch)) * 8.f);
        ah |= (unsigned long long)ch << nb; al |= (unsigned long long)cl << nb; nb += 6;
        if (nb >= 32) { dh[k] = (unsigned)ah; dl[k] = (unsigned)al; ++k; ah >>= 32; al >>= 32; nb -= 32; } }
    hi = (v8i){(int)dh[0], (int)dh[1], (int)dh[2], (int)dh[3], (int)dh[4], (int)dh[5], 0, 0}; lo = (v8i){(int)dl[0], (int)dl[1], (int)dl[2], (int)dl[3], (int)dl[4], (int)dl[5], 0, 0};
}
typedef unsigned v6u __attribute__((ext_vector_type(6)));
typedef float v32f __attribute__((ext_vector_type(32)));
typedef float v16f __attribute__((ext_vector_type(16)));
__device__ __forceinline__ v6u pack32_fp6(v16f x0, v16f x1) { v6u r; asm("v_cvt_scalef32_2xpk16_fp6_f32 %0, %1, %2, 1.0" : "=&v"(r) : "v"(x0), "v"(x1)); return r; }
__device__ __forceinline__ v32f unpack32_fp6(v6u p) { v32f r; asm("v_cvt_scalef32_pk32_f32_fp6 %0, %1, 1.0" : "=&v"(r) : "v"(p)); return r; }
constexpr float U6_SCALE = 64.f, V6_SCALE = 4.f;
__device__ __forceinline__ float wave_sum_dpp(float v) {
    DPP_ADD(v, 0xB1, 0xF); DPP_ADD(v, 0x4E, 0xF); DPP_ADD(v, 0x141, 0xF); DPP_ADD(v, 0x140, 0xF); DPP_ADD(v, 0x142, 0xA); DPP_ADD(v, 0x143, 0xC);
    return __uint_as_float((unsigned)__builtin_amdgcn_readlane((int)__float_as_uint(v), 63)); }
struct Row6 { v4u p0; u32x2v p1; };
struct Tok6 { f32x2c acc[16]; v8i ahi, alo; float rs; int ev[2]; float gv[2]; };
__device__ __forceinline__ Row6 load_row6(__amdgpu_buffer_rsrc_t rs, unsigned e, unsigned lane16) { Row6 r; r.p0 = __builtin_amdgcn_raw_buffer_load_b128(rs, lane16, e * 1536u, 0); r.p1 = __builtin_amdgcn_raw_buffer_load_b64(rs, (lane16 >> 1) + 1024u, e * 1536u, 0); return r; }
__device__ __forceinline__ void tok6_load(const unsigned char* ws, int tk, int lane, Tok6& T) {
    const float* H1 = (const float*)(ws + WS_H1); const bf16* H1B = (const bf16*)(ws + WS_H1B); const float* psh1 = (const float*)(ws + WS_PSH1); const int* IDX = (const int*)(ws + WS_IDX); const float* GATE = (const float*)(ws + WS_GATE);
    T.rs = (1.0f / sqrtf(wave_sum_dpp(psh1[(size_t)tk * 64 + lane]) * (1.f / 2048.f) + 1e-6f)) * (1.f / U6_SCALE);
    if (A_FP6 && U_FP6) {
        v16f x0, x1, r0, r1;
#pragma unroll
        for (int q = 0; q < 4; ++q) { const v4u a = *(const GAS v4u*)(H1B + (size_t)tk * 2048 + 32 * lane + 8 * q); const unsigned aw[4] = {a.x, a.y, a.z, a.w};
#pragma unroll
            for (int d = 0; d < 8; ++d) { const float xs = ((d & 1) ? __uint_as_float(aw[d >> 1] & 0xffff0000u) : __uint_as_float(aw[d >> 1] << 16)) * 0.5f;
                const float m = fminf(fabsf(xs), 7.5f), qm = m < 2.f ? rintf(8.f * m) * 0.125f : m < 4.f ? rintf(4.f * m) * 0.25f : rintf(2.f * m) * 0.5f, rr = (xs - copysignf(qm, xs)) * 8.f;
                if (q < 2) { x0[8 * q + d] = xs; r0[8 * q + d] = rr; } else { x1[8 * (q - 2) + d] = xs; r1[8 * (q - 2) + d] = rr; } } }
        const v6u ph = pack32_fp6(x0, x1), pl = pack32_fp6(r0, r1);
        T.ahi = (v8i){(int)ph[0], (int)ph[1], (int)ph[2], (int)ph[3], (int)ph[4], (int)ph[5], 0, 0}; T.alo = (v8i){(int)pl[0], (int)pl[1], (int)pl[2], (int)pl[3], (int)pl[4], (int)pl[5], 0, 0};
    } else { unsigned hi8[8], lo8[8];
#pragma unroll
        for (int q = 0; q < 4; ++q) { const v4u a = *(const GAS v4u*)(H1B + (size_t)tk * 2048 + 32 * lane + 8 * q); const unsigned aw[4] = {a.x, a.y, a.z, a.w};
#pragma unroll
            for (int d = 0; d < 2; ++d) { const float x0 = __uint_as_float(aw[2 * d] << 16), x1 = __uint_as_float(aw[2 * d] & 0xffff0000u), x2 = __uint_as_float(aw[2 * d + 1] << 16), x3 = __uint_as_float(aw[2 * d + 1] & 0xffff0000u);
                const unsigned h = pk4_fp8(x0, x1, x2, x3); const f32x2c l = __builtin_amdgcn_cvt_pk_f32_fp8((int)h, false), u = __builtin_amdgcn_cvt_pk_f32_fp8((int)h, true);
                hi8[2 * q + d] = h; lo8[2 * q + d] = pk4_fp8((x0 - l.x) * 16.f, (x1 - l.y) * 16.f, (x2 - u.x) * 16.f, (x3 - u.y) * 16.f); } }
        T.ahi = (v8i){(int)hi8[0], (int)hi8[1], (int)hi8[2], (int)hi8[3], (int)hi8[4], (int)hi8[5], (int)hi8[6], (int)hi8[7]}; T.alo = (v8i){(int)lo8[0], (int)lo8[1], (int)lo8[2], (int)lo8[3], (int)lo8[4], (int)lo8[5], (int)lo8[6], (int)lo8[7]}; }
    SBAR();
#pragma unroll
    for (int q = 0; q < 8; ++q) { const f32x4 x = *(const GAS f32x4*)(H1 + (size_t)tk * 2048 + 32 * lane + 4 * q); T.acc[2 * q] = (f32x2c){x[0], x[1]}; T.acc[2 * q + 1] = (f32x2c){x[2], x[3]}; }
    T.ev[0] = IDX[(size_t)tk * 128 + lane]; T.ev[1] = IDX[(size_t)tk * 128 + 64 + lane]; T.gv[0] = GATE[(size_t)tk * 128 + lane]; T.gv[1] = GATE[(size_t)tk * 128 + 64 + lane];
    SBAR();
}
template <bool DRY> __device__ __forceinline__ void tok6_store(unsigned char* ws, int tk, const Tok6& T) {
    const int lane = lane_id();
    float* H1 = (float*)(ws + WS_H1); bf16* H1B = (bf16*)(ws + WS_H1B); float* rsh2 = (float*)(ws + WS_RSH2);
    float ss = 0.f;
    float* H1o = DRY ? (float*)(ws + WS_NA0) + (size_t)(tk & 2047) * 2048 : H1 + (size_t)tk * 2048; bf16* H1Bo = DRY ? (bf16*)(ws + WS_NGL) + (size_t)(tk & 2047) * 2048 : H1B + (size_t)tk * 2048;
#pragma unroll
    for (int q = 0; q < 4; ++q) { const f32x4 y0 = {T.acc[4 * q].x, T.acc[4 * q].y, T.acc[4 * q + 1].x, T.acc[4 * q + 1].y}, y1 = {T.acc[4 * q + 2].x, T.acc[4 * q + 2].y, T.acc[4 * q + 3].x, T.acc[4 * q + 3].y}; ss += sq8(y0, y1);
        *(GAS f32x4*)(H1o + 32 * lane + 8 * q) = y0; *(GAS f32x4*)(H1o + 32 * lane + 8 * q + 4) = y1; *(GAS v4u*)(H1Bo + 32 * lane + 8 * q) = pack8(y0, y1); }
    ss = wave_sum_dpp(ss); if (lane == 0 && !DRY) rsh2[tk] = 1.0f / sqrtf(ss * (1.f / 2048.f) + 1e-6f);
}
__device__ __forceinline__ float dot6_mfma(const Tok6& T, const Row6& u, int lane) {
    const v8i ua = {(int)u.p0.x, (int)u.p0.y, (int)u.p0.z, (int)u.p0.w, (int)u.p1.x, (int)u.p1.y, 0, 0}; f32x4 c = {0.f, 0.f, 0.f, 0.f};
    if (A_FP6) { c = __builtin_amdgcn_mfma_scale_f32_16x16x128_f8f6f4(ua, T.ahi, c, 2, 2, 0, 127, 0, 128);
                 c = __builtin_amdgcn_mfma_scale_f32_16x16x128_f8f6f4(ua, T.alo, c, 2, 2, 0, 127, 0, 125); }
    else { c = __builtin_amdgcn_mfma_scale_f32_16x16x128_f8f6f4(ua, T.ahi, c, 2, 0, 0, 127, 0, 127); c = __builtin_amdgcn_mfma_scale_f32_16x16x128_f8f6f4(ua, T.alo, c, 2, 0, 0, 127, 0, 123); }
    const int n = lane & 15; const float t0 = (n & 1) ? c[1] : c[0], t1 = (n & 1) ? c[3] : c[2], v = (n & 2) ? t1 : t0;
    return ((lane >> 4) == (n >> 2)) ? v : 0.f;
}
__device__ __forceinline__ void axpy6(Tok6& T, const Row6& v, float wk) {
    const v32f y = unpack32_fp6((v6u){v.p0.x, v.p0.y, v.p0.z, v.p0.w, v.p1.x, v.p1.y}); const f32x2c w2 = {wk, wk};
#pragma unroll
    for (int i = 0; i < 16; ++i) T.acc[i] = __builtin_elementwise_fma(w2, (f32x2c){y[2 * i], y[2 * i + 1]}, T.acc[i]);
}
__device__ __forceinline__ void batch6(Tok6& T, const Row6& u0, const Row6& u1, const Row6& v0, const Row6& v1, float g0, float g1, int n2, int lane) {
    const float h = reduce2(dot6_mfma(T, u0, lane), dot6_mfma(T, u1, lane));
    const float w = ((lane & 32) ? g1 : g0) * gelu_f(h * T.rs) * (1.f / V6_SCALE);
    const float w0 = __uint_as_float((unsigned)__builtin_amdgcn_readlane((int)__float_as_uint(w), 31)), w1 = __uint_as_float((unsigned)__builtin_amdgcn_readlane((int)__float_as_uint(w), 63));
    SBAR(); axpy6(T, v0, w0); SBAR(); if (n2) axpy6(T, v1, w1); SBAR();
}
template <bool DRY> __device__ __forceinline__ void gather_fp6_phase(const Args& A, Frame& F) {
    unsigned char* ws = A.ws;
    const int gw = F.vcu * NWAVES + F.wave, NGW = F.G * NWAVES;
    const __amdgpu_buffer_rsrc_t RU = __builtin_amdgcn_make_buffer_rsrc((void*)(ws + WS_UB), 0, 16384 * 1536, 0x00020000), RV = __builtin_amdgcn_make_buffer_rsrc((void*)(ws + WS_VB), 0, 16384 * 1536, 0x00020000);
    for (int tk0 = 2 * gw; tk0 < T_TOK; tk0 += 2 * NGW) {
        const int lane = lane_id(); const unsigned lane16 = (unsigned)lane * 16u;
        Tok6 TA, TB; tok6_load(ws, tk0, lane, TA); tok6_load(ws, tk0 + 1, lane, TB);
        for (int s = 0; s < (16384 >> NSLICE_SHIFT); ++s) {
            unsigned long long a0 = __ballot((TA.ev[0] >> NSLICE_SHIFT) == s), a1 = __ballot((TA.ev[1] >> NSLICE_SHIFT) == s), b0 = __ballot((TB.ev[0] >> NSLICE_SHIFT) == s), b1 = __ballot((TB.ev[1] >> NSLICE_SHIFT) == s);
            while (a0 | a1 | b0 | b1) {
                int eA0 = 0, eA1 = 0, eB0 = 0, eB1 = 0; float gA0 = 0.f, gA1 = 0.f, gB0 = 0.f, gB1 = 0.f;
                const int nA = take2b(a0, a1, TA.ev, TA.gv, eA0, gA0, eA1, gA1), nB = take2b(b0, b1, TB.ev, TB.gv, eB0, gB0, eB1, gB1);
                Row6 uA0, uA1, vA0, vA1, uB0, uB1, vB0, vB1;
                if (nA) { uA0 = load_row6(RU, (unsigned)eA0, lane16); vA0 = load_row6(RV, (unsigned)eA0, lane16); if (nA == 2) { uA1 = load_row6(RU, (unsigned)eA1, lane16); vA1 = load_row6(RV, (unsigned)eA1, lane16); } else { uA1 = uA0; vA1 = vA0; } }
                if (nB) { uB0 = load_row6(RU, (unsigned)eB0, lane16); vB0 = load_row6(RV, (unsigned)eB0, lane16); if (nB == 2) { uB1 = load_row6(RU, (unsigned)eB1, lane16); vB1 = load_row6(RV, (unsigned)eB1, lane16); } else { uB1 = uB0; vB1 = vB0; } }
                if (nA) batch6(TA, uA0, uA1, vA0, vA1, gA0, gA1, nA == 2, lane);
                if (nB) batch6(TB, uB0, uB1, vB0, vB1, gB0, gB1, nB == 2, lane);
            }
        }
        tok6_store<DRY>(ws, tk0, TA); tok6_store<DRY>(ws, tk0 + 1, TB);
    }
}
struct Row8c { v4u c0, c1; };
__device__ __forceinline__ Row8c load_row8c(__amdgpu_buffer_rsrc_t rs, unsigned e, unsigned lane32) { Row8c r; r.c0 = __builtin_amdgcn_raw_buffer_load_b128(rs, lane32, e * 2048u, 0); r.c1 = __builtin_amdgcn_raw_buffer_load_b128(rs, lane32 + 16u, e * 2048u, 0); return r; }
template <bool DRY> __device__ __forceinline__ void gather_mix_phase(const Args& A, Frame& F) {
    unsigned char* ws = A.ws;
    const int gw = F.vcu * NWAVES + F.wave, NGW = F.G * NWAVES;
    const __amdgpu_buffer_rsrc_t RU = __builtin_amdgcn_make_buffer_rsrc((void*)(ws + WS_UB), 0, 16384 * 2048, 0x00020000), RV = __builtin_amdgcn_make_buffer_rsrc((void*)(ws + WS_VB), 0, 16384 * 2048, 0x00020000);
    for (int tk = gw; tk < T_TOK; tk += NGW) {
        const int lane = lane_id(); const unsigned lane16 = (unsigned)lane * 16u;
        Tok6 T; tok6_load(ws, tk, lane, T); if (!U_FP6) T.rs *= U6_SCALE / U8_SCALE;
        for (int k = 0; k < 128; ++k) {
            const int e = __builtin_amdgcn_readlane(k < 64 ? T.ev[0] : T.ev[1], k & 63); const float g = __uint_as_float((unsigned)__builtin_amdgcn_readlane((int)__float_as_uint(k < 64 ? T.gv[0] : T.gv[1]), k & 63));
            float p;
            if (0) {}
            else if (U_FP6) { const Row6 u = load_row6(RU, (unsigned)e, lane16); p = dot6_mfma(T, u, lane); }
            else { const Row8c u = load_row8c(RU, (unsigned)e, lane16 * 2u); const v8i ua = {(int)u.c0.x, (int)u.c0.y, (int)u.c0.z, (int)u.c0.w, (int)u.c1.x, (int)u.c1.y, (int)u.c1.z, (int)u.c1.w}; f32x4 c = {0.f, 0.f, 0.f, 0.f};
                c = __builtin_amdgcn_mfma_scale_f32_16x16x128_f8f6f4(ua, T.ahi, c, 0, 0, 0, 127, 0, 127); c = __builtin_amdgcn_mfma_scale_f32_16x16x128_f8f6f4(ua, T.alo, c, 0, 0, 0, 127, 0, 123);
                const int n = lane & 15; const float t0 = (n & 1) ? c[1] : c[0], t1 = (n & 1) ? c[3] : c[2], v = (n & 2) ? t1 : t0; p = ((lane >> 4) == (n >> 2)) ? v : 0.f; }
            const float h = wave_sum64(p); const float w = g * gelu_f(h * T.rs) * (V_FP6 ? 1.f / V6_SCALE : 1.f / V8_SCALE);
            if (V_FP6) { const Row6 v = load_row6(RV, (unsigned)e, lane16); axpy6(T, v, w); }
            else { const Row8c v = load_row8c(RV, (unsigned)e, lane16 * 2u); const unsigned wv[8] = {v.c0.x, v.c0.y, v.c0.z, v.c0.w, v.c1.x, v.c1.y, v.c1.z, v.c1.w}; const f32x2c w2 = {w, w};
#pragma unroll
                for (int d = 0; d < 8; ++d) { T.acc[2 * d] = __builtin_elementwise_fma(w2, __builtin_amdgcn_cvt_pk_f32_fp8((int)wv[d], false), T.acc[2 * d]); T.acc[2 * d + 1] = __builtin_elementwise_fma(w2, __builtin_amdgcn_cvt_pk_f32_fp8((int)wv[d], true), T.acc[2 * d + 1]); } }
        }
        tok6_store<DRY>(ws, tk, T);
    }
}
__device__ __forceinline__ void final_phase(const Args& A, Frame& F) {
    unsigned char* ws = A.ws; const float* psh3 = (const float*)(ws + WS_PSH3); const float* gf = (const float*)A.in[25]; float* out = A.out;
    const int gw = F.vcu * NWAVES + F.wave, NGW = F.G * NWAVES;
    for (int tk = gw; tk < T_TOK; tk += NGW) { const int lane = lane_id();
        const float rs = 1.0f / sqrtf(wave_sum64(psh3[(size_t)tk * 64 + lane]) * (1.f / 2048.f) + 1e-6f);
#pragma unroll
        for (int j = 0; j < 8; ++j) { GAS f32x4* o = (GAS f32x4*)(out + (size_t)tk * 2048 + 256 * j) + lane; const f32x4 g = *((const GAS f32x4*)(gf + 256 * j) + lane); *o = *o * rs * g; } }
}
#define PH2_BODY \
        { pg8::Gemm g{(const bf16*)(ws + WS_CQ), (const bf16*)(ws + WS_WT_UQ), T_TOK, 1536, 512}; pg8::StaticOrder S; S.init(T_TOK, 1536, F.G, (int)blockIdx.x); \
          LAS float* tab = (LAS float*)(F.lds + TAB_OFF); setup_rowtab(tab, (const float*)(ws + WS_PSCQ), 16, 1.f / 512.f, S, F.wave); __syncthreads(); \
          EpiQ E{tab, (bf16*)(ws + WS_Q), (const f32x2v*)(ws + WS_CS)}; pg8::gemm_phase<EpiQ, pg8::StaticOrder, true, true>(F.lds + RING_OFF, g, S, E, F.wave); } \
        __syncthreads(); \
        { pg8::Gemm g{(const bf16*)(ws + WS_CKV), (const bf16*)(ws + WS_WT_UKV), T_TOK, 2048, 256}; pg8::StaticOrder S; S.init(T_TOK, 2048, F.G, (int)blockIdx.x); \
          LAS float* tab = (LAS float*)(F.lds + TAB_OFF); setup_rowtab(tab, (const float*)(ws + WS_PSCKV), 8, 1.f / 256.f, S, F.wave); __syncthreads(); \
          EpiKV E{tab, (bf16*)(ws + WS_KN), (bf16*)(ws + WS_VV)}; pg8::gemm_phase<EpiKV, pg8::StaticOrder, true, true>(F.lds + RING_OFF, g, S, E, F.wave); } \
        __syncthreads(); \
        sgu_phase(args, F); __syncthreads();

#define PH4_BODY \
        { pg8::Gemm g{(const bf16*)(ws + WS_MIX), (const bf16*)(ws + WS_WT_OUT), T_TOK, 2048, 2048}; pg8::StaticOrder S; S.init(T_TOK, 2048, F.G, (int)blockIdx.x); \
          LAS float* tab = (LAS float*)(F.lds + TAB_OFF); setup_rowtab(tab, (const float*)(ws + WS_PSA), 8, 1.f / 1024.f, S, F.wave); setup_rowtab(tab + 256, (const float*)(ws + WS_PSS), 16, 1.f / 1024.f, S, F.wave); __syncthreads(); \
          EpiOut E{tab, (const float*)args.in[0], (float*)(ws + WS_H1), (bf16*)(ws + WS_H1B), (float*)(ws + WS_PSH1)}; pg8::gemm_phase<EpiOut, pg8::StaticOrder, true, true>(F.lds + RING_OFF, g, S, E, F.wave); } __syncthreads();

#define PH5_BODY \
        { pg8::Gemm g{(const bf16*)(ws + WS_H1B), (const bf16*)(ws + WS_WT_PQ), T_TOK, 2048, 2048}; pg8::StaticOrder S; S.init(T_TOK, 2048, F.G, (int)blockIdx.x); \
          LAS float* tab = (LAS float*)(F.lds + TAB_OFF); setup_rowtab(tab, (const float*)(ws + WS_PSH1), 64, 1.f / 2048.f, S, F.wave); __syncthreads(); \
          EpiPQ E{tab, (bf16*)(ws + WS_R1)}; pg8::gemm_phase<EpiPQ, pg8::StaticOrder, true, true>(F.lds + RING_OFF, g, S, E, F.wave); }

#define PH8_BODY \
        { pg8::Gemm g{(const bf16*)(ws + WS_H1B), (const bf16*)(ws + WS_WT_PG), T_TOK, 2048, 2048}; pg8::StaticOrder S; S.init(T_TOK, 2048, F.G, (int)blockIdx.x); \
          EpiPLE E{(const float*)(ws + WS_RSH2), (const float*)(ws + WS_H1), (const bf16*)(ws + WS_PPROJ), args.out, (float*)(ws + WS_PSH3)}; pg8::gemm_phase<EpiPLE, pg8::StaticOrder, true, true>(F.lds + RING_OFF, g, S, E, F.wave); } __syncthreads();

#define PHASES_2_9 \
    if (IN(2)) { if (REPEAT_PH == 2) { PH2_BODY __syncthreads(); } PH2_BODY SEAM(2); } \
    if (IN(3)) { if (REPEAT_PH == 3) { attn_phase(args, F); __syncthreads(); } attn_phase(args, F); SEAM(3); } \
    if (IN(4)) { if (REPEAT_PH == 4) { PH4_BODY __syncthreads(); } PH4_BODY SEAM(4); } \
    if (IN(5)) { if (REPEAT_PH == 5) { PH5_BODY __syncthreads(); } PH5_BODY SEAM(5); } \
    PHASES_6_9
#define PHASES_6_9 \
    if (IN(6)) { if (REPEAT_PH == 6) { topk_phase(args, F); __syncthreads(); } topk_phase(args, F); SEAM(6); } \
    if (IN(7)) { if (REPEAT_PH == 7) { GATHER_FN<true>(args, F); __syncthreads(); } GATHER_FN<false>(args, F); SEAM(7); } \
    if (IN(8)) { if (REPEAT_PH == 8) { PH8_BODY __syncthreads(); } PH8_BODY SEAM(8); } \
    if (IN(9)) { final_phase(args, F); }
#define PH1_BODY \
        { pg8::Gemm g{(const bf16*)(ws + WS_R1), (const bf16*)(ws + WS_WT_IN), T_TOK, 3072, 2048}; pg8::StaticOrder S; S.init(T_TOK, 3072, F.G, (int)blockIdx.x); \
          EpiG1 E{(const float*)(ws + WS_RSX), (bf16*)(ws + WS_CQ), (bf16*)(ws + WS_CKV), (bf16*)(ws + WS_KR), (bf16*)(ws + WS_UG), (bf16*)(ws + WS_VG), (float*)(ws + WS_PSCQ), (float*)(ws + WS_PSCKV), (f32x2v*)(ws + WS_PSV), (const f32x2v*)(ws + WS_CS)}; \
          pg8::gemm_phase<EpiG1, pg8::StaticOrder, true, true>(F.lds + RING_OFF, g, S, E, F.wave); } \
        { pg8::Gemm g{(const bf16*)(ws + WS_PB), (const bf16*)(ws + WS_WT_PP), T_TOK, 2048, 256}; pg8::StaticOrder S; S.init(T_TOK, 2048, F.G, (int)blockIdx.x); \
          EpiPlain E{(bf16*)(ws + WS_PPROJ), 2048}; \
          pg8::gemm_phase<EpiPlain, pg8::StaticOrder, true, true>(F.lds + RING_OFF, g, S, E, F.wave); }
constexpr int N_PHASES = 10;
__global__ void __launch_bounds__(NWAVES * 64, 2) mega_fwd(Args args) {
    extern __shared__ __attribute__((aligned(16))) unsigned char lds[];
    Frame F;
    F.lds = (LAS unsigned char*)lds; F.MISC = (volatile LAS unsigned*)(F.lds + MISC_OFF);
    F.wave = __builtin_amdgcn_readfirstlane(threadIdx.x >> 6); F.lane = lane_id(); F.tid = F.wave * 64 + F.lane;
    F.G = gridDim.x; { const int bx = blockIdx.x; F.vcu = (F.G % 8 == 0) ? (bx % 8) * (F.G / 8) + bx / 8 : bx; }
    unsigned char* ws = args.ws; F.ctl = (gu32*)(ws + WS_CTL);
    for (int u = F.wave * 64 + lane_id(); u < (LDS_BYTES - LDSCTL_OFF) / 4; u += NWAVES * 64) ((LAS unsigned*)(F.lds + LDSCTL_OFF))[u] = 0u;
    __syncthreads();
    const int lo = args.ph_lo, hi = args.ph_hi;
    XcdBarrier bar; bar.bar = (unsigned*)(F.ctl + CW_BAR); bar.x = 0; bar.st = nullptr;
    if (hi - lo > 1) bar = xcd_barrier_post((unsigned*)(F.ctl + CW_BAR), F.MISC + 8, F.wave);
#define IN(k) (lo <= (k) && (k) < hi)
#define SEAM(k) do { if (IN(k) && IN((k) + 1)) xcd_barrier(bar, F.wave); } while (0)
    if (IN(0)) { if (REPEAT_PH == 0) { p0_prologue(args, F); __syncthreads(); } p0_prologue(args, F); SEAM(0); }
    if (IN(1)) { if (REPEAT_PH == 1) { PH1_BODY __syncthreads(); } PH1_BODY SEAM(1); }
    PHASES_2_9
#undef IN
#undef SEAM
}

#if CUT > 0 && CUT < 9
__device__ __forceinline__ int rope_unpc(int pc) { const int c5 = pc >> 5, fq = (pc >> 3) & 3, nn = (pc >> 2) & 1, e = pc & 3; return 16 * c5 + 4 * fq + e + 32 * nn; }
__global__ void __launch_bounds__(256) conv1(const unsigned char* ws, int b, float* ZP) {
    const int r = blockIdx.x; const size_t row = (size_t)b * 2048 + r; float* z = ZP + (size_t)r * 2880;
    const bf16 *CQ = (const bf16*)(ws + WS_CQ) + row * 512, *CKV = (const bf16*)(ws + WS_CKV) + row * 256, *KR = (const bf16*)(ws + WS_KR) + row * 64, *UG = (const bf16*)(ws + WS_UG) + row * 1024, *VG = (const bf16*)(ws + WS_VG) + row * 1024;
    for (int i = threadIdx.x; i < 512; i += 256) z[i] = bf2f(CQ[i]);
    for (int i = threadIdx.x; i < 256; i += 256) z[512 + i] = bf2f(CKV[i]);
    if (threadIdx.x < 64) z[768 + rope_unpc(threadIdx.x)] = bf2f(KR[threadIdx.x]);
    for (int i = threadIdx.x; i < 1024; i += 256) { z[832 + i] = bf2f(UG[i]); z[1856 + i] = bf2f(VG[i]); }
}
__global__ void __launch_bounds__(256) conv2(const unsigned char* ws, int b, float* ZP, float* QN, float* KV, float* OSGU) {
    const int r = blockIdx.x; const size_t row = (size_t)b * 2048 + r;
    const bf16 *Q = (const bf16*)(ws + WS_Q) + row * 1536, *KN = (const bf16*)(ws + WS_KN) + row * 1024, *VV = (const bf16*)(ws + WS_VV) + row * 1024, *KR = (const bf16*)(ws + WS_KR) + row * 64, *MIX = (const bf16*)(ws + WS_MIX) + row * 2048;
    for (int i = threadIdx.x; i < 1536; i += 256) { const int h = i / 192, lc = i - h * 192; const int dst = lc < 128 ? i : h * 192 + 128 + rope_unpc(lc - 128); QN[(size_t)r * 1536 + dst] = bf2f(Q[i]) * (1.f / QK_C2); }
    for (int i = threadIdx.x; i < 1024; i += 256) { const int h = i >> 7, d = i & 127; KV[(size_t)r * 2048 + h * 256 + d] = bf2f(KN[i]); KV[(size_t)r * 2048 + h * 256 + 128 + d] = bf2f(VV[i]); OSGU[(size_t)r * 1024 + i] = bf2f(MIX[1024 + i]); }
    if (threadIdx.x < 64) ZP[(size_t)r * 2880 + 768 + rope_unpc(threadIdx.x)] = bf2f(KR[threadIdx.x]);
}
__global__ void __launch_bounds__(256) conv3(const unsigned char* ws, int b, float* OATT, float* OSGU) {
    const int r = blockIdx.x; const size_t row = (size_t)b * 2048 + r; const bf16* MIX = (const bf16*)(ws + WS_MIX) + row * 2048;
    for (int i = threadIdx.x; i < 1024; i += 256) { OATT[(size_t)r * 1024 + i] = bf2f(MIX[i]); OSGU[(size_t)r * 1024 + i] = bf2f(MIX[1024 + i]); }
}
__global__ void __launch_bounds__(256) conv5(const unsigned char* ws, int b, float* QPN) {
    const int r = blockIdx.x; const size_t row = (size_t)b * 2048 + r; const bf16* QP = (const bf16*)(ws + WS_R1) + row * 2048;
    for (int i = threadIdx.x; i < 2048; i += 256) QPN[(size_t)r * 2048 + i] = bf2f(QP[i]);
}
static void launch_conv(int b, void* const* d_in, void* d_ws, hipStream_t stream) {
    unsigned char* ws = (unsigned char*)d_ws; (void)d_in;
    if (CUT == 1) conv1<<<2048, 256, 0, stream>>>(ws, b, (float*)(ws + WS_NZP));
    if (CUT == 2) conv2<<<2048, 256, 0, stream>>>(ws, b, (float*)(ws + WS_NZP), (float*)(ws + WS_NQN), (float*)(ws + WS_NKV), (float*)(ws + WS_NOSGU));
    if (CUT == 3) conv3<<<2048, 256, 0, stream>>>(ws, b, (float*)(ws + WS_NOATT), (float*)(ws + WS_NOSGU));
    if (CUT == 5) conv5<<<2048, 256, 0, stream>>>(ws, b, (float*)(ws + WS_NQPN));
}
#endif
#if CUT > 0
static void launch_fast(void* const* d_in, void* d_out, void* d_ws, hipStream_t stream) {
    static int grid = 0;
    if (grid == 0) {
        int dev = 0, cus = 0, per_cu = 0;
        if (hipGetDevice(&dev) != hipSuccess || hipDeviceGetAttribute(&cus, hipDeviceAttributeMultiprocessorCount, dev) != hipSuccess) { fprintf(stderr, "launch_fast: device query failed\n"); grid = -1; return; }
        if (hipFuncSetAttribute((const void*)mega_fwd, hipFuncAttributeMaxDynamicSharedMemorySize, LDS_BYTES) != hipSuccess) { fprintf(stderr, "launch_fast: hipFuncSetAttribute failed\n"); grid = -1; return; }
        if (hipOccupancyMaxActiveBlocksPerMultiprocessor(&per_cu, (const void*)mega_fwd, NWAVES * 64, LDS_BYTES) != hipSuccess || per_cu < 1) fprintf(stderr, "launch_fast: occupancy query says %d blocks per CU\n", per_cu);
        (void)hipGetLastError();
        grid = cus;
        if (grid != 256) fprintf(stderr, "launch_fast: %d CUs (built for 256)\n", grid);
    }
    if (grid < 0) return;
    (void)hipMemsetAsync((char*)d_ws + WS_CTL, 0, CTL_ZERO_BYTES, stream);
    Args a{};
    for (int i = 0; i < 26; ++i) a.in[i] = d_in[i];
    a.out = (float*)d_out; a.ws = (unsigned char*)d_ws;
    constexpr int LAST = CUT + 1;
#if ONE_LAUNCH
    a.ph_lo = 0; a.ph_hi = LAST; hipLaunchKernelGGL(mega_fwd, dim3(grid), dim3(NWAVES * 64), LDS_BYTES, stream, a);
#else
    for (int ph = 0; ph < LAST; ++ph) { a.ph_lo = ph; a.ph_hi = ph + 1; hipLaunchKernelGGL(mega_fwd, dim3(grid), dim3(NWAVES * 64), LDS_BYTES, stream, a); }
#endif
    const hipError_t le = hipPeekAtLastError(); if (le != hipSuccess) fprintf(stderr, "launch_fast: launch failed: %s\n", hipGetErrorName(le));
}
#endif
#if CUT > 0
static void launch_fast(void* const* d_in, void* d_out, void* d_ws, hipStream_t stream);
static void launch_conv(int b, void* const* d_in, void* d_ws, hipStream_t stream);
#endif
extern "C" void kernel_launch(void* const* d_in, const int* in_sizes, int n_in, void* d_out, int out_size, void* d_ws, size_t ws_size, hipStream_t stream) {
    if (n_in != 26 || out_size != T_TOK * DM || ws_size < WS_END) { fprintf(stderr, "kernel_launch: unexpected shapes n_in %d out %d ws %zu\n", n_in, out_size, ws_size); return; }
    unsigned char* ws = (unsigned char*)d_ws;
    const float* x = (const float*)d_in[0]; const float* p = (const float*)d_in[1]; const int* pos = (const int*)d_in[2];
    const float *g_mix = (const float*)d_in[3], *w_in = (const float*)d_in[4], *g_cq = (const float*)d_in[5], *w_uq = (const float*)d_in[6], *g_ckv = (const float*)d_in[7], *w_ukv = (const float*)d_in[8];
    const float *g_ln = (const float*)d_in[9], *b_ln = (const float*)d_in[10], *w_sgu = (const float*)d_in[11], *b_sgu = (const float*)d_in[12], *g_oa = (const float*)d_in[13], *g_os = (const float*)d_in[14];
    const float *w_out = (const float*)d_in[15], *g_ffn = (const float*)d_in[16], *w_pq = (const float*)d_in[17], *k1 = (const float*)d_in[18], *k2 = (const float*)d_in[19], *pu = (const float*)d_in[20], *pv = (const float*)d_in[21];
    const float *g_ple = (const float*)d_in[22], *w_pg = (const float*)d_in[23], *w_pp = (const float*)d_in[24], *g_fin = (const float*)d_in[25];
    float* out = (float*)d_out;
#if CUT > 0
    launch_fast(d_in, d_out, d_ws, stream);
#endif
#if CUT < 9
    constexpr int S0 = CUT + 1; constexpr int TB = nv::TBAT;
    float* A0 = (float*)(ws + WS_NA0); float* GL = (float*)(ws + WS_NGL); float* PP = (float*)(ws + WS_NPP);
    float* ZP = (float*)(ws + WS_NZP); float* CQN = (float*)(ws + WS_NCQN); float* CKVN = (float*)(ws + WS_NCKVN); float* QN = (float*)(ws + WS_NQN); float* KV = (float*)(ws + WS_NKV);
    float* VLN = (float*)(ws + WS_NVLN); float* OSGU = (float*)(ws + WS_NOSGU); float* OATT = (float*)(ws + WS_NOATT); float* QPN = (float*)(ws + WS_NQPN);
    for (int b = 0; b < NBATCH; ++b) {
        const size_t t0 = (size_t)b * TB; const float* xb = x + t0 * DM; const int* posb = pos + t0; const float* pb = p + t0 * 256;
        float* H1 = (float*)(ws + WS_H1) + t0 * DM; int* IDX = (int*)(ws + WS_IDX) + t0 * 128; float* GATE = (float*)(ws + WS_GATE) + t0 * 128; float* outb = out + t0 * DM;
#if CUT > 0
        launch_conv(b, d_in, d_ws, stream);
#endif
        if (S0 <= 1) {
            nv::nk_rmsnorm<<<TB, 256, 0, stream>>>(xb, DM, g_mix, A0, DM, DM);
            nv::nk_gemm<<<dim3(2880 / 64, TB / 64), 256, 0, stream>>>(A0, DM, w_in, 2880, ZP, 2880, nullptr, 0, DM);
            nv::nk_z_post<<<TB, 256, 0, stream>>>(ZP, posb);
        }
        if (S0 <= 2) {
            nv::nk_rmsnorm<<<TB, 256, 0, stream>>>(ZP, 2880, g_cq, CQN, 512, 512);
            nv::nk_gemm<<<dim3(1536 / 64, TB / 64), 256, 0, stream>>>(CQN, 512, w_uq, 1536, QN, 1536, nullptr, 0, 512);
            nv::nk_q_rope<<<TB, 256, 0, stream>>>(QN, posb);
            nv::nk_rmsnorm<<<TB, 256, 0, stream>>>(ZP + 512, 2880, g_ckv, CKVN, 256, 256);
            nv::nk_gemm<<<dim3(2048 / 64, TB / 64), 256, 0, stream>>>(CKVN, 256, w_ukv, 2048, KV, 2048, nullptr, 0, 256);
            nv::nk_ln_group<<<TB * 8 / 4, 256, 0, stream>>>(ZP, g_ln, b_ln, VLN);
            nv::nk_sgu<<<TB * 1024 / 256, 256, 0, stream>>>(ZP, VLN, w_sgu, b_sgu, OSGU);
        }
        if (S0 <= 3) nv::nk_attn<<<dim3(TB, 8), 256, 0, stream>>>(QN, KV, ZP, OATT);
        if (S0 <= 4) {
            nv::nk_rmsnorm<<<TB, 256, 0, stream>>>(OATT, 1024, g_oa, A0, DM, 1024);
            nv::nk_rmsnorm<<<TB, 256, 0, stream>>>(OSGU, 1024, g_os, A0 + 1024, DM, 1024);
            nv::nk_gemm<<<dim3(DM / 64, TB / 64), 256, 0, stream>>>(A0, DM, w_out, DM, H1, DM, xb, DM, DM);
        }
        if (S0 <= 5) {
            nv::nk_rmsnorm<<<TB, 256, 0, stream>>>(H1, DM, g_ffn, A0, DM, DM);
            nv::nk_gemm<<<dim3(DM / 64, TB / 64), 256, 0, stream>>>(A0, DM, w_pq, DM, QPN, DM, nullptr, 0, DM);
        }
        if (S0 <= 6) nv::nk_topk<<<TB * 8, 128, 0, stream>>>(QPN, k1, k2, IDX, GATE);
        if (S0 <= 7) {
            nv::nk_rmsnorm<<<TB, 256, 0, stream>>>(H1, DM, g_ffn, A0, DM, DM);
            nv::nk_gather<<<TB, 256, 0, stream>>>(H1, A0, IDX, GATE, pu, pv);
        }
        if (S0 <= 8) {
            nv::nk_rmsnorm<<<TB, 256, 0, stream>>>(H1, DM, g_ple, A0, DM, DM);
            nv::nk_gemm<<<dim3(DM / 64, TB / 64), 256, 0, stream>>>(A0, DM, w_pg, DM, GL, DM, nullptr, 0, DM);
            nv::nk_gemm<<<dim3(DM / 64, TB / 64), 256, 0, stream>>>(pb, 256, w_pp, DM, PP, DM, nullptr, 0, 256);
            nv::nk_ple<<<TB * DM / 256, 256, 0, stream>>>(H1, GL, PP, outb);
        }
        nv::nk_rmsnorm<<<TB, 256, 0, stream>>>(outb, DM, g_fin, outb, DM, DM);
    }
#endif
}
```

```cpp
#include <hip/hip_runtime.h>
#include <hip/hip_bf16.h>
#include <cstdio>
#include <cstdint>
#include <cmath>
#ifndef CUT
#define CUT 9
#endif
#ifndef ONE_LAUNCH
#define ONE_LAUNCH 1
#endif
#ifndef REPEAT_PH
#define REPEAT_PH -1
#endif
#ifndef PEER_FP6
#define PEER_FP6 1
#endif
#ifndef U_FP6
#define U_FP6 1
#endif
#ifndef V_FP6
#define V_FP6 1
#endif
#ifndef V_HWPACK
#define V_HWPACK 1
#endif
#ifndef GATHER_FN
#define GATHER_FN gather_fp6_phase
#endif
constexpr int T_TOK = 8192, DM = 2048, SEQ = 2048, NBATCH = 4;
constexpr size_t MiB = 1u << 20;
constexpr size_t WS_CTL = 0;
constexpr size_t WS_WT_IN = 1 * MiB, WS_WT_UQ = 13 * MiB, WS_WT_UKV = 14 * MiB + 512 * 1024, WS_WT_PP = 15 * MiB + 512 * 1024;
constexpr size_t WS_K1B = 16 * MiB + 512 * 1024, WS_K2B = WS_K1B + 256 * 1024, WS_WSGU = 17 * MiB;
constexpr size_t WS_WT_OUT = 18 * MiB, WS_WT_PQ = 26 * MiB, WS_WT_PG = 34 * MiB;
constexpr size_t WS_UB = 42 * MiB, WS_VB = 106 * MiB;
constexpr size_t WS_R1 = 170 * MiB;
constexpr size_t WS_PB = 202 * MiB, WS_CS = 206 * MiB, WS_RSX = 208 * MiB, WS_RSH2 = 208 * MiB + 512 * 1024;
constexpr size_t WS_CQ = 209 * MiB, WS_CKV = 217 * MiB, WS_KR = 221 * MiB, WS_UG = 222 * MiB, WS_VG = 238 * MiB;
constexpr size_t WS_PSCQ = 254 * MiB, WS_PSCKV = 254 * MiB + 512 * 1024, WS_PSV = 255 * MiB;
constexpr size_t WS_Q = 257 * MiB, WS_KN = 281 * MiB, WS_VV = 297 * MiB, WS_H1B = 257 * MiB;
constexpr size_t WS_MIX = 313 * MiB, WS_PSA = 345 * MiB, WS_PSS = 345 * MiB + 512 * 1024;
constexpr size_t WS_H1 = 346 * MiB, WS_PSH1 = 410 * MiB, WS_IDX = 412 * MiB, WS_GATE = 416 * MiB, WS_PPROJ = 420 * MiB, WS_PSH3 = 452 * MiB;
constexpr size_t WS_NA0 = 454 * MiB, WS_NGL = 470 * MiB, WS_NPP = 486 * MiB, WS_END = 502 * MiB;
constexpr size_t WS_NZP = 42 * MiB, WS_NCQN = 65 * MiB, WS_NCKVN = 69 * MiB, WS_NQN = 71 * MiB, WS_NKV = 83 * MiB, WS_NVLN = 99 * MiB, WS_NOSGU = 107 * MiB, WS_NOATT = 115 * MiB, WS_NQPN = 123 * MiB;
namespace nv {
constexpr int TBAT = 2048;
__device__ __forceinline__ float gelu_t(float x) { const float c = 0.7978845608028654f; const float u = c * (x + 0.044715f * x * x * x); return 0.5f * x * (1.f + tanhf(u)); }
__device__ __forceinline__ float wave_sum(float v) {
#pragma unroll
    for (int o = 1; o < 64; o <<= 1) v += __shfl_xor(v, o);
    return v;
}
__device__ __forceinline__ float wave_max(float v) {
#pragma unroll
    for (int o = 1; o < 64; o <<= 1) v = fmaxf(v, __shfl_xor(v, o));
    return v;
}
__device__ __forceinline__ float blk_sum(float v, float* sh) {
    v = wave_sum(v); __syncthreads();
    if ((threadIdx.x & 63) == 0) sh[threadIdx.x >> 6] = v; __syncthreads();
    float r = 0.f; for (int i = 0; i < (int)(blockDim.x >> 6); ++i) r += sh[i]; return r;
}
__device__ __forceinline__ float blk_max(float v, float* sh) {
    v = wave_max(v); __syncthreads();
    if ((threadIdx.x & 63) == 0) sh[threadIdx.x >> 6] = v; __syncthreads();
    float r = sh[0]; for (int i = 1; i < (int)(blockDim.x >> 6); ++i) r = fmaxf(r, sh[i]); return r;
}
__global__ void __launch_bounds__(256) nk_rmsnorm(const float* x, size_t ldx, const float* g, float* out, size_t ldo, int D) {
    __shared__ float sh[8];
    const float* xr = x + (size_t)blockIdx.x * ldx; float* orow = out + (size_t)blockIdx.x * ldo;
    float s = 0.f; for (int i = threadIdx.x; i < D; i += 256) { const float v = xr[i]; s += v * v; }
    s = blk_sum(s, sh); const float r = rsqrtf(s / (float)D + 1e-6f);
    for (int i = threadIdx.x; i < D; i += 256) orow[i] = xr[i] * r * g[i];
}
__global__ void __launch_bounds__(256) nk_gemm(const float* A, size_t lda, const float* B, size_t ldb, float* C, size_t ldc, const float* R, size_t ldr, int K) {
    __shared__ float As[16][68], Bs[16][68];
    const int tid = threadIdx.x, tx = tid & 15, ty = tid >> 4, m0 = blockIdx.y * 64, n0 = blockIdx.x * 64;
    float acc[4][4] = {};
    for (int k0 = 0; k0 < K; k0 += 16) {
        { const int r = tid >> 2, c = (tid & 3) * 4; const float4 v = *(const float4*)(A + (size_t)(m0 + r) * lda + k0 + c); As[c][r] = v.x; As[c + 1][r] = v.y; As[c + 2][r] = v.z; As[c + 3][r] = v.w; }
        { const int r = tid >> 4, c = (tid & 15) * 4; const float4 v = *(const float4*)(B + (size_t)(k0 + r) * ldb + n0 + c); Bs[r][c] = v.x; Bs[r][c + 1] = v.y; Bs[r][c + 2] = v.z; Bs[r][c + 3] = v.w; }
        __syncthreads();
#pragma unroll
        for (int k = 0; k < 16; ++k) { float a[4], b[4];
#pragma unroll
            for (int i = 0; i < 4; ++i) { a[i] = As[k][ty * 4 + i]; b[i] = Bs[k][tx * 4 + i]; }
#pragma unroll
            for (int i = 0; i < 4; ++i)
#pragma unroll
                for (int j = 0; j < 4; ++j) acc[i][j] += a[i] * b[j]; }
        __syncthreads();
    }
#pragma unroll
    for (int i = 0; i < 4; ++i)
#pragma unroll
        for (int j = 0; j < 4; ++j) { const size_t r = m0 + ty * 4 + i, c = n0 + tx * 4 + j; C[r * ldc + c] = acc[i][j] + (R ? R[r * ldr + c] : 0.f); }
}
__device__ __forceinline__ void rope_cs(int pos, int i, float& c, float& s) { const double f = pow(10000.0, -(double)i / 32.0); const double a = (double)pos * f; c = (float)cos(a); s = (float)sin(a); }
__global__ void __launch_bounds__(256) nk_z_post(float* Z, const int* pos) {
    float* z = Z + (size_t)blockIdx.x * 2880; const int t = threadIdx.x;
    if (t < 32) { float c, s; rope_cs(pos[blockIdx.x], t, c, s); const float x1 = z[768 + t], x2 = z[800 + t]; z[768 + t] = x1 * c - x2 * s; z[800 + t] = x2 * c + x1 * s; }
    for (int i = 832 + t; i < 2880; i += 256) z[i] = gelu_t(z[i]);
}
__global__ void __launch_bounds__(256) nk_q_rope(float* Q, const int* pos) {
    float* q = Q + (size_t)blockIdx.x * 1536; const int h = threadIdx.x >> 5, i = threadIdx.x & 31;
    float c, s; rope_cs(pos[blockIdx.x], i, c, s); float* p = q + h * 192 + 128; const float x1 = p[i], x2 = p[32 + i]; p[i] = x1 * c - x2 * s; p[32 + i] = x2 * c + x1 * s;
}
__global__ void __launch_bounds__(256) nk_ln_group(const float* Z, const float* gln, const float* bln, float* VLN) {
    const int wv = blockIdx.x * 4 + (threadIdx.x >> 6), lane = threadIdx.x & 63, row = wv >> 3, g = wv & 7;
    const float* v = Z + (size_t)row * 2880 + 1856 + g * 128; const float a = v[lane], b = v[lane + 64];
    const float mu = wave_sum(a + b) * (1.f / 128.f); const float da = a - mu, db = b - mu; const float var = wave_sum(da * da + db * db) * (1.f / 128.f); const float r = rsqrtf(var + 1e-6f);
    float* o = VLN + (size_t)row * 1024 + g * 128; o[lane] = da * r * gln[g * 128 + lane] + bln[g * 128 + lane]; o[lane + 64] = db * r * gln[g * 128 + lane + 64] + bln[g * 128 + lane + 64];
}
__global__ void __launch_bounds__(256) nk_sgu(const float* Z, const float* VLN, const float* ws, const float* bs, float* OS) {
    const size_t idx = (size_t)blockIdx.x * 256 + threadIdx.x; const int row = (int)(idx >> 10), col = (int)(idx & 1023), g = col >> 7, t = row & 127, r0 = row - t;
    const float* w = ws + ((size_t)g * 128 + t) * 128; float acc = 0.f;
    for (int s = 0; s <= t; ++s) acc += w[s] * VLN[(size_t)(r0 + s) * 1024 + col];
    OS[idx] = Z[(size_t)row * 2880 + 832 + col] * (acc + bs[g * 128 + t]);
}
__global__ void __launch_bounds__(256) nk_attn(const float* Q, const float* KV, const float* Z, float* O) {
    __shared__ float qs[192], sc[2048], sh[8], part[128];
    const int i = blockIdx.x, h = blockIdx.y, tid = threadIdx.x, lane = tid & 63, wv = tid >> 6;
    if (tid < 192) qs[tid] = Q[(size_t)i * 1536 + h * 192 + tid]; __syncthreads();
    const float scale = 0.07216878364870323f;
    for (int j = wv; j <= i; j += 4) { const float* kn = KV + (size_t)j * 2048 + h * 256; const float* kr = Z + (size_t)j * 2880 + 768;
        float p = qs[lane] * kn[lane] + qs[64 + lane] * kn[64 + lane] + qs[128 + lane] * kr[lane]; p = wave_sum(p); if (lane == 0) sc[j] = p * scale; }
    __syncthreads();
    float m = -INFINITY; for (int j = tid; j <= i; j += 256) m = fmaxf(m, sc[j]); m = blk_max(m, sh);
    float l = 0.f; for (int j = tid; j <= i; j += 256) { const float e = expf(sc[j] - m); sc[j] = e; l += e; } l = blk_sum(l, sh);
    const int d = tid & 127, half = tid >> 7; float acc = 0.f;
    for (int j = half; j <= i; j += 2) acc += sc[j] * KV[(size_t)j * 2048 + h * 256 + 128 + d];
    if (half) part[d] = acc; __syncthreads();
    if (!half) O[(size_t)i * 1024 + h * 128 + d] = (acc + part[d]) / l;
}
__global__ void __launch_bounds__(128) nk_topk(const float* QP, const float* k1, const float* k2, int* IDX, float* GATE) {
    __shared__ float q[256], s1[128], s2[128], cand[256], t1[16], t2[16]; __shared__ int i1[16], i2[16];
    const int row = blockIdx.x >> 3, h = blockIdx.x & 7, n = threadIdx.x;
    q[n] = QP[(size_t)row * 2048 + h * 256 + n]; q[n + 128] = QP[(size_t)row * 2048 + h * 256 + 128 + n]; __syncthreads();
    { const float* a = k1 + ((size_t)h * 128 + n) * 128; const float* b = k2 + ((size_t)h * 128 + n) * 128; float x = 0.f, y = 0.f;
      for (int d = 0; d < 128; ++d) { x += q[d] * a[d]; y += q[128 + d] * b[d]; } s1[n] = x; s2[n] = y; }
    __syncthreads();
    if (n == 0 || n == 64) { float* s = n ? s2 : s1; float* tv = n ? t2 : t1; int* ti = n ? i2 : i1;
        for (int r = 0; r < 16; ++r) { float best = -INFINITY; int bi = 0; for (int j = 0; j < 128; ++j) if (s[j] > best) { best = s[j]; bi = j; } tv[r] = best; ti[r] = bi; s[bi] = -INFINITY; } }
    __syncthreads();
    cand[n] = t1[n >> 4] + t2[n & 15]; cand[n + 128] = t1[(n + 128) >> 4] + t2[n & 15]; __syncthreads();
    if (n == 0) { float tv[16]; int te[16];
        for (int r = 0; r < 16; ++r) { float best = -INFINITY; int bi = 0; for (int j = 0; j < 256; ++j) if (cand[j] > best) { best = cand[j]; bi = j; } tv[r] = best; te[r] = i1[bi >> 4] * 128 + i2[bi & 15]; cand[bi] = -INFINITY; }
        float l = 0.f, e[16]; for (int r = 0; r < 16; ++r) { e[r] = expf(tv[r] - tv[0]); l += e[r]; }
        for (int r = 0; r < 16; ++r) { IDX[(size_t)row * 128 + h * 16 + r] = te[r]; GATE[(size_t)row * 128 + h * 16 + r] = e[r] / l; } }
}
__global__ void __launch_bounds__(256) nk_gather(float* H, const float* A2, const int* IDX, const float* GATE, const float* U, const float* V) {
    __shared__ float a[2048], red[4][2048];
    const int row = blockIdx.x, tid = threadIdx.x, lane = tid & 63, wv = tid >> 6;
    for (int i = tid; i < 2048; i += 256) a[i] = A2[(size_t)row * 2048 + i]; __syncthreads();
    float acc[32];
#pragma unroll
    for (int i = 0; i < 32; ++i) acc[i] = 0.f;
    for (int k = 0; k < 32; ++k) { const int j = wv * 32 + k; const int e = IDX[(size_t)row * 128 + j]; const float gt = GATE[(size_t)row * 128 + j];
        const float* u = U + (size_t)e * 2048; const float* v = V + (size_t)e * 2048; float p = 0.f;
#pragma unroll
        for (int i = 0; i < 32; ++i) p += u[lane + 64 * i] * a[lane + 64 * i];
        p = wave_sum(p); const float w = gt * gelu_t(p);
#pragma unroll
        for (int i = 0; i < 32; ++i) acc[i] += w * v[lane + 64 * i]; }
#pragma unroll
    for (int i = 0; i < 32; ++i) red[wv][lane + 64 * i] = acc[i];
    __syncthreads();
    for (int i = tid; i < 2048; i += 256) H[(size_t)row * 2048 + i] += red[0][i] + red[1][i] + red[2][i] + red[3][i];
}
__global__ void __launch_bounds__(256) nk_ple(const float* H2, const float* GL, const float* PP, float* out) {
    const size_t i = (size_t)blockIdx.x * 256 + threadIdx.x; out[i] = H2[i] + PP[i] / (1.f + expf(-GL[i]));
}
}
#define GAS __attribute__((address_space(1)))
#define LAS __attribute__((address_space(3)))
typedef unsigned short bf16;
typedef unsigned v4u __attribute__((ext_vector_type(4)));
typedef float f32x4 __attribute__((ext_vector_type(4)));
typedef short bf16x8 __attribute__((ext_vector_type(8)));
typedef GAS unsigned gu32;
typedef GAS unsigned long long gu64;
#define RLX_AGENT __ATOMIC_RELAXED, __HIP_MEMORY_SCOPE_AGENT
#define LDS_WAIT() asm volatile("s_waitcnt lgkmcnt(0)" ::: "memory")
#define VM_WAIT() asm volatile("s_waitcnt vmcnt(0)" ::: "memory")
__device__ __forceinline__ unsigned long long rt() { return __builtin_amdgcn_s_memrealtime(); }
__device__ __forceinline__ unsigned f2bf(float f) { unsigned u = __builtin_bit_cast(unsigned, f); return (u + 0x7fffu + ((u >> 16) & 1u)) >> 16; }
__device__ __forceinline__ unsigned pk2(float lo, float hi) { return f2bf(lo) | (f2bf(hi) << 16); }
#define XB_TMO      128
#define XB_XCNT(j)  (256  + 64 * (j))
#define XB_XSUB(j)  (1280 + 64 * (j))
#define XB_XGEN(j)  (2304 + 64 * (j))
#define XB_TOP      3328
#define XB_TOPGEN   3392
#define XCD_BAR_WORDS 3456
#define XB_SPIN_CAP (1u << 18)

__device__ __forceinline__ unsigned xb_ld(unsigned* p)              { return __hip_atomic_load(p, __ATOMIC_RELAXED, __HIP_MEMORY_SCOPE_AGENT); }
__device__ __forceinline__ unsigned xb_add(unsigned* p, unsigned v) { return __hip_atomic_fetch_add(p, v, __ATOMIC_RELAXED, __HIP_MEMORY_SCOPE_AGENT); }
__device__ __forceinline__ unsigned xb_xcc_id() { return (unsigned)__builtin_amdgcn_s_getreg((3 << 11) | 20) & 0xFu; }
#define XB_SPIN(cond, bar) do { unsigned _sp = 0; while (cond) { __builtin_amdgcn_s_sleep(1); \
    if ((++_sp & 255u) == 0u) { if (xb_ld(&(bar)[XB_TMO])) break; if (_sp > XB_SPIN_CAP) { atomicAdd(&(bar)[XB_TMO], 1u); break; } } } } while (0)

struct XcdBarrier {
    unsigned* bar; unsigned x;
    volatile LAS unsigned* st;
};

__device__ __forceinline__ int lane_id() { int r; asm volatile("v_mbcnt_lo_u32_b32 %0, -1, 0\n\tv_mbcnt_hi_u32_b32 %0, -1, %0" : "=v"(r)); return r; }
__device__ __forceinline__ XcdBarrier xcd_barrier_post(unsigned* bar, volatile LAS unsigned* st, int wid) {
    XcdBarrier b; b.bar = bar; b.x = xb_xcc_id(); b.st = st;
    if (wid == 0 && lane_id() == 0) (void)xb_add(&bar[XB_XCNT(b.x)], 1u);
    return b;
}
__device__ __forceinline__ void xcd_barrier_complete(unsigned* bar, unsigned x, unsigned& nloc, unsigned& nx) {
    const unsigned G = gridDim.x * gridDim.y * gridDim.z;
    unsigned sum, cnt, mine, sp = 0u;
    for (;;) {
        sum = 0u; cnt = 0u; mine = 0u;
#pragma unroll
        for (unsigned j = 0; j < 16; ++j) { const unsigned c = xb_ld(&bar[XB_XCNT(j)]); sum += c; cnt += (c > 0u) ? 1u : 0u; mine = (j == x) ? c : mine; }
        if (sum == G) break;
        __builtin_amdgcn_s_sleep(1);
        if ((++sp & 255u) == 0u) { if (xb_ld(&bar[XB_TMO])) break; if (sp > XB_SPIN_CAP) { atomicAdd(&bar[XB_TMO], 1u); break; } }
    }
    nloc = mine > 0u ? mine : 1u; nx = cnt > 0u ? cnt : 1u;
}

__device__ __forceinline__ void xcd_barrier(const XcdBarrier& b, int wid) {
    asm volatile("s_waitcnt vmcnt(0)" ::: "memory");
    __syncthreads();
    if (wid == 0 && lane_id() == 0) {
        unsigned* bar = b.bar;
        __builtin_amdgcn_s_waitcnt(0);
        unsigned nloc = b.st[0], nx = b.st[1];
        if (nloc == 0u) { xcd_barrier_complete(bar, b.x, nloc, nx); b.st[0] = nloc; b.st[1] = nx; }
        const unsigned old = xb_add(&bar[XB_XSUB(b.x)], 1u);
        const unsigned gen = old / nloc;
        if (old + 1u == (gen + 1u) * nloc) {
            __builtin_amdgcn_fence(__ATOMIC_RELEASE, "agent");
            asm volatile("s_waitcnt vmcnt(0)" ::: "memory");
            const unsigned og = xb_add(&bar[XB_TOP], 1u);
            const unsigned tg = og / nx;
            if (og + 1u == (tg + 1u) * nx) xb_add(&bar[XB_TOPGEN], 1u);
            else XB_SPIN(xb_ld(&bar[XB_TOPGEN]) == tg, bar);
            __builtin_amdgcn_fence(__ATOMIC_ACQUIRE, "agent");
            xb_add(&bar[XB_XGEN(b.x)], 1u);
            asm volatile("s_waitcnt vmcnt(0)" ::: "memory");
        } else {
            XB_SPIN(xb_ld(&bar[XB_XGEN(b.x)]) == gen, bar);
            __builtin_amdgcn_fence(__ATOMIC_ACQUIRE, "agent");
            asm volatile("s_waitcnt vmcnt(0)" ::: "memory");
        }
    }
    __syncthreads();
}
namespace pg8 {
#define PG8_LAS __attribute__((address_space(3)))
typedef unsigned short bf16_t;
typedef short bf16x8 __attribute__((ext_vector_type(8)));
typedef float f32x4 __attribute__((ext_vector_type(4)));
typedef unsigned u32x4 __attribute__((ext_vector_type(4)));
constexpr int BM = 256, BK = 64, HALF = 128, HTB = HALF * BK * 2  , STAGE_BYTES = 8 * HTB, NXCD = 8, WGM = 8;

__host__ __device__ __forceinline__ int lds_byte(int r, int c) { const int st = (r >> 4) * 2 + (c >> 5), rr = r & 15, cc = c & 31, ob = rr * 64 + cc * 2; return st * 1024 + (ob ^ (((ob >> 9) & 1) << 5)); }
__host__ __device__ __forceinline__ void stage_rc(int b, int& R, int& C) { const int st = b / 1024, sb = b % 1024, swz = sb ^ (((sb >> 9) & 1) << 5); R = (st >> 1) * 16 + swz / 64; C = (st & 1) * 32 + (swz % 64) / 2; }
__host__ __device__ __forceinline__ int perm32(int rho) { const int n = rho >> 4, i = rho & 15; return 8 * (i >> 2) + 4 * n + (i & 3); }

struct Unit { int pm, pn; };
struct Gemm { const bf16_t* A; const bf16_t* Bt; int M, N, K; };

struct StaticOrder {
    int nM, nN, nwg, G, c;
    __host__ __device__ void init(int M, int N, int G_, int c_) { nM = M / BM; nN = N / BM; nwg = nM * nN; G = G_; c = c_; }
    __host__ __device__ bool next(int i, Unit& u) const {
        const long L = (long)i * G + c; if (L >= nwg) return false;
        int wgid = (int)L; { const int q = nwg / NXCD, r = nwg % NXCD, xcd = wgid % NXCD, off = wgid / NXCD; wgid = (xcd < r ? xcd * (q + 1) : r * (q + 1) + (xcd - r) * q) + off; }
        const int nig = WGM * nN, gid = wgid / nig, fm = gid * WGM, gsz = (nM - fm) < WGM ? (nM - fm) : WGM;
        u.pm = fm + ((wgid % nig) % gsz); u.pn = (wgid % nig) / gsz; return true;
    }
    __device__ __forceinline__ void a_ready(const Unit&) const {}
    __device__ __forceinline__ void done(const Unit&) const {}
};

__device__ __forceinline__ unsigned cvt_pk_bf16(float lo, float hi) { unsigned r; asm volatile("v_cvt_pk_bf16_f32 %0, %1, %2" : "=v"(r) : "v"(lo), "v"(hi)); return r; }
typedef float f32x2 __attribute__((ext_vector_type(2)));
template <class Epi, class Sched, bool ALIGN_EPI = false, bool SP2 = false>
__device__ __forceinline__ void gemm_phase(PG8_LAS unsigned char* lds, const Gemm g, const Sched& S, const Epi& E, const int wid) {
    const int lane = ::lane_id(), tid = wid * 64 + lane, wr = wid >> 2, wc = wid & 3, fr = lane & 15, fq = lane >> 4;
    const int K = g.K, nt = K / BK;
    unsigned voffA[2], voffB[2];
#pragma unroll
    for (int i = 0; i < 2; ++i) { int R, C; stage_rc(tid * 16 + i * 8192, R, C); const int Rb = Epi::PERM ? ((R & ~31) + perm32(R & 31)) : R;
        voffA[i] = (unsigned)(R * K + C) * 2u; voffB[i] = (unsigned)(Rb * K + C) * 2u; }
    const size_t kstep = (size_t)(BK * 2);
    const size_t hstep = (size_t)HALF * K * 2;
    const size_t tstep = 2 * hstep;
    const unsigned ldsw = (unsigned)wid * 1024u;
    const int aoff = lds_byte(wr * 64 + fr, fq * 8), boff = lds_byte(wc * 32 + fr, fq * 8);
#define PG8_SA(b, h) (((b) * 2 + (h)) * HTB)
#define PG8_SB(b, h) ((4 + (b) * 2 + (h)) * HTB)
#define PG8_STAGE(bufoff, gbase, voff) do { _Pragma("unroll") for (int _i = 0; _i < 2; ++_i) \
        __builtin_amdgcn_global_load_lds((const unsigned*)((const char*)(gbase) + (voff)[_i]), (PG8_LAS unsigned*)(lds + (bufoff) + ldsw + _i * 8192), 16, 0, 0); } while (0)
#define PG8_LDA(dst, b, h) do { _Pragma("unroll") for (int m = 0; m < 4; ++m) _Pragma("unroll") for (int k = 0; k < 2; ++k) dst[m][k] = *(const PG8_LAS bf16x8*)(lds + PG8_SA(b, h) + aoff + m * 2048 + k * 1024); } while (0)
#define PG8_LDB(dst, b, h) do { _Pragma("unroll") for (int n = 0; n < 2; ++n) _Pragma("unroll") for (int k = 0; k < 2; ++k) dst[n][k] = *(const PG8_LAS bf16x8*)(lds + PG8_SB(b, h) + boff + n * 2048 + k * 1024); } while (0)
#define PG8_MMA(ai, bj, At, Bt) do { __builtin_amdgcn_s_setprio(1); _Pragma("unroll") for (int m = 0; m < 4; ++m) _Pragma("unroll") for (int n = 0; n < 2; ++n) _Pragma("unroll") for (int k = 0; k < 2; ++k) \
        acc[ai][bj][m][n] = __builtin_amdgcn_mfma_f32_16x16x32_bf16(Bt[n][k], At[m][k], acc[ai][bj][m][n], 0, 0, 0); __builtin_amdgcn_s_setprio(0); } while (0)
#define PG8_WAIT_V(n) asm volatile("s_waitcnt vmcnt(" #n ")" ::: "memory")
#define PG8_WAIT_L(n) asm volatile("s_waitcnt lgkmcnt(" #n ")" ::: "memory")
#define PG8_BAR __builtin_amdgcn_s_barrier()
#define PG8_SCHED __builtin_amdgcn_sched_barrier(0)
    Unit cur, nxt; int ui = 0;
    if (!S.next(0, cur)) return;
    f32x4 acc[2][2][4][2];
#pragma unroll
    for (int a = 0; a < 2; ++a)
#pragma unroll
        for (int b = 0; b < 2; ++b)
#pragma unroll
            for (int m = 0; m < 4; ++m)
#pragma unroll
                for (int n = 0; n < 2; ++n) acc[a][b][m][n] = (f32x4){0.f, 0.f, 0.f, 0.f};
    bf16x8 At[4][2], B0[2][2], B1[2][2];
    const char* cA = (const char*)g.A + (size_t)cur.pm * tstep; const char* cB = (const char*)g.Bt + (size_t)cur.pn * tstep;
    S.a_ready(cur);
    if constexpr (SP2) {
        PG8_STAGE(PG8_SB(0, 0), cB, voffB); PG8_STAGE(PG8_SB(0, 1), cB + hstep, voffB); PG8_STAGE(PG8_SA(0, 0), cA, voffA); PG8_STAGE(PG8_SA(0, 1), cA + hstep, voffA);
        if (wr == 1) PG8_BAR;
        PG8_WAIT_V(2); PG8_BAR;
        PG8_STAGE(PG8_SB(1, 0), cB + kstep, voffB); PG8_STAGE(PG8_SA(1, 0), cA + kstep, voffA); PG8_STAGE(PG8_SB(1, 1), cB + hstep + kstep, voffB);
        PG8_WAIT_V(6); PG8_BAR;
    } else {
        PG8_STAGE(PG8_SB(0, 0), cB, voffB); PG8_STAGE(PG8_SA(0, 0), cA, voffA); PG8_STAGE(PG8_SB(0, 1), cB + hstep, voffB); PG8_STAGE(PG8_SA(0, 1), cA + hstep, voffA);
        if (wr == 1) PG8_BAR;
        PG8_WAIT_V(4); PG8_BAR;
        PG8_STAGE(PG8_SB(1, 0), cB + kstep, voffB); PG8_STAGE(PG8_SA(1, 0), cA + kstep, voffA); PG8_STAGE(PG8_SB(1, 1), cB + hstep + kstep, voffB);
        PG8_WAIT_V(6); PG8_BAR;
    }
    for (;;) {
        const bool has_next = S.next(ui + 1, nxt);
        const char* nA = has_next ? (const char*)g.A + (size_t)nxt.pm * tstep : cA; const char* nB = has_next ? (const char*)g.Bt + (size_t)nxt.pn * tstep : cB;
        for (int t = 0; t < nt; t += 2) {
            if constexpr (Epi::MID) { if (t == (nt >> 1)) E.mid(acc, cur, wr, wc, fr, fq); }
            const bool last = (t == nt - 2);
            const char* a1 = cA + (size_t)(t + 1) * kstep;
            const char* a2 = last ? nA : cA + (size_t)(t + 2) * kstep; const char* b2 = last ? nB : cB + (size_t)(t + 2) * kstep;
            const char* a3 = a2 + kstep; const char* b3 = b2 + kstep;
            if (last && has_next) S.a_ready(nxt);
            if constexpr (SP2) {
            PG8_LDB(B0, 0, 0); PG8_LDB(B1, 0, 1); PG8_SCHED; PG8_LDA(At, 0, 0); PG8_STAGE(PG8_SA(1, 1), a1 + hstep, voffA);
            PG8_WAIT_V(8); PG8_WAIT_L(0); PG8_BAR; PG8_MMA(0, 0, At, B0); PG8_MMA(0, 1, At, B1); PG8_BAR; PG8_SCHED;
            PG8_LDA(At, 0, 1); PG8_STAGE(PG8_SB(0, 0), b2, voffB); PG8_STAGE(PG8_SB(0, 1), b2 + hstep, voffB); PG8_STAGE(PG8_SA(0, 0), a2, voffA);
            PG8_WAIT_V(8); PG8_WAIT_L(0); PG8_BAR; PG8_MMA(1, 0, At, B0); PG8_MMA(1, 1, At, B1); PG8_BAR; PG8_SCHED;
            PG8_LDB(B0, 1, 0); PG8_LDB(B1, 1, 1); PG8_SCHED; PG8_LDA(At, 1, 0); PG8_STAGE(PG8_SA(0, 1), a2 + hstep, voffA);
            PG8_WAIT_V(8); PG8_WAIT_L(0); PG8_BAR; PG8_MMA(0, 0, At, B0); PG8_MMA(0, 1, At, B1); PG8_BAR; PG8_SCHED;
            PG8_LDA(At, 1, 1); PG8_STAGE(PG8_SB(1, 0), b3, voffB); PG8_STAGE(PG8_SB(1, 1), b3 + hstep, voffB); PG8_STAGE(PG8_SA(1, 0), a3, voffA);
            PG8_WAIT_V(8); PG8_WAIT_L(0); PG8_BAR; PG8_MMA(1, 0, At, B0); PG8_MMA(1, 1, At, B1); PG8_BAR; PG8_SCHED;
            } else {
            PG8_LDB(B0, 0, 0); PG8_SCHED; PG8_LDA(At, 0, 0); PG8_STAGE(PG8_SA(1, 1), a1 + hstep, voffA);
            PG8_WAIT_L(8); PG8_BAR; PG8_WAIT_L(0); PG8_MMA(0, 0, At, B0); PG8_BAR; PG8_SCHED;
            PG8_LDB(B1, 0, 1); PG8_STAGE(PG8_SB(0, 0), b2, voffB);
            PG8_BAR; PG8_WAIT_L(0); PG8_MMA(0, 1, At, B1); PG8_BAR;
            PG8_LDA(At, 0, 1); PG8_STAGE(PG8_SA(0, 0), a2, voffA);
            PG8_BAR; PG8_WAIT_L(0); PG8_MMA(1, 0, At, B0); PG8_BAR; PG8_SCHED;
            PG8_STAGE(PG8_SB(0, 1), b2 + hstep, voffB);
            PG8_WAIT_V(6); PG8_BAR; PG8_MMA(1, 1, At, B1); PG8_BAR;
            PG8_LDB(B0, 1, 0); PG8_SCHED; PG8_LDA(At, 1, 0); PG8_STAGE(PG8_SA(0, 1), a2 + hstep, voffA);
            PG8_WAIT_L(8); PG8_BAR; PG8_WAIT_L(0); PG8_MMA(0, 0, At, B0); PG8_BAR; PG8_SCHED;
            PG8_LDB(B1, 1, 1); PG8_STAGE(PG8_SB(1, 0), b3, voffB);
            PG8_BAR; PG8_WAIT_L(0); PG8_MMA(0, 1, At, B1); PG8_BAR;
            PG8_LDA(At, 1, 1); PG8_STAGE(PG8_SA(1, 0), a3, voffA);
            PG8_BAR; PG8_WAIT_L(0); PG8_MMA(1, 0, At, B0); PG8_BAR; PG8_SCHED;
            PG8_STAGE(PG8_SB(1, 1), b3 + hstep, voffB);
            PG8_WAIT_V(6); PG8_BAR; PG8_MMA(1, 1, At, B1); PG8_BAR;
            }
        }
        if constexpr (ALIGN_EPI) { if (wr == 0) PG8_BAR; }
        if constexpr (!Epi::AFTER_DRAIN) { E(acc, cur, wr, wc, fr, fq); S.done(cur); }
        if (!has_next) break;
#pragma unroll
        for (int a = 0; a < 2; ++a)
#pragma unroll
            for (int b = 0; b < 2; ++b)
#pragma unroll
                for (int m = 0; m < 4; ++m)
#pragma unroll
                    for (int n = 0; n < 2; ++n) acc[a][b][m][n] = (f32x4){0.f, 0.f, 0.f, 0.f};
        cur = nxt; cA = nA; cB = nB; ++ui;
        if constexpr (ALIGN_EPI) { if (wr == 1) PG8_BAR; }
    }
    PG8_WAIT_V(0);
    if constexpr (!ALIGN_EPI) { if (wr == 0) PG8_BAR; }
    PG8_BAR;
    if constexpr (Epi::AFTER_DRAIN) { E.fused(acc, cur, wr, wc, fr, fq, lds, wid, lane); S.done(cur); }
#undef PG8_SA
#undef PG8_SB
#undef PG8_STAGE
#undef PG8_LDA
#undef PG8_LDB
#undef PG8_MMA
#undef PG8_WAIT_V
#undef PG8_WAIT_L
#undef PG8_BAR
#undef PG8_SCHED
}
}
constexpr int NWAVES = 8;
constexpr int RING_OFF = 0, RING_BYTES = 131072, TAB_OFF = RING_BYTES, TAB_BYTES = 8192, LDSCTL_OFF = TAB_OFF + TAB_BYTES, MISC_OFF = LDSCTL_OFF + 320, LDS_BYTES = 147456;
static_assert(MISC_OFF + 128 <= LDS_BYTES, "LDS map");
constexpr int CW_TMO = 0, CW_CODE = 1, CW_BAR = 4096;
constexpr size_t CTL_ZERO_BYTES = 64 * 1024;
constexpr float QK_C2 = 0.07216878364870323f * 1.4426950408889634f;
typedef float f32x2v __attribute__((ext_vector_type(2)));
typedef unsigned u32x2v __attribute__((ext_vector_type(2)));
__device__ __forceinline__ float bf2f(unsigned short b) { return __uint_as_float((unsigned)b << 16); }
__device__ __forceinline__ float gelu_f(float x) { const float u = 1.5957691216057308f * (x + 0.044715f * x * x * x); return x * __builtin_amdgcn_rcpf(1.f + __builtin_amdgcn_exp2f(-1.4426950408889634f * u)); }
__device__ __forceinline__ float wave_sum64(float v) {
#pragma unroll
    for (int o = 1; o < 64; o <<= 1) v += __shfl_xor(v, o);
    return v;
}
struct Args { const void* in[26]; float* out; unsigned char* ws; int ph_lo, ph_hi; };
struct Frame { LAS unsigned char* lds; volatile LAS unsigned* MISC; gu32* ctl; int tid, lane, wave, vcu, G; };

__device__ __forceinline__ int rope_pc(int lr) { const int nn = lr >> 5, i = lr & 31, c5 = i >> 4, f = i & 15; return 32 * c5 + 8 * (f >> 2) + 4 * nn + (f & 3); }
__device__ __forceinline__ int map_win(int n) { if (n < 768) return n; if (n < 832) return 2816 + rope_pc(n - 768); if (n < 1856) return 768 + (n - 832); return 1792 + (n - 1856); }
__device__ __forceinline__ int map_wuq(int n) { const int h = n / 192, lc = n - h * 192; return lc < 128 ? n : h * 192 + 128 + rope_pc(lc - 128); }
__device__ __forceinline__ int map_id(int n) { return n; }

template <class MapF, class ScaleF>
__device__ __forceinline__ void p0_transpose_item(const float* W, int K, int N, bf16* WT, LAS float* scr, int item, int lane, MapF mapf, ScaleF ks) {
    const int nblk = N / 32, kb = item / nblk, nb = item % nblk, k0 = 64 * kb, n0 = 32 * nb;
#pragma unroll 8
    for (int i = 0; i < 32; ++i) { const int kk = 2 * i + (lane >> 5); scr[kk * 33 + (lane & 31)] = W[(size_t)(k0 + kk) * N + n0 + (lane & 31)] * ks(k0 + kk); }
    LDS_WAIT(); asm volatile("" ::: "memory");
    const int c = lane & 7;
#pragma unroll
    for (int j = 0; j < 4; ++j) { const int n = (lane >> 3) + 8 * j; const LAS float* s = scr + (8 * c) * 33 + n;
        v4u o; o.x = pk2(s[0 * 33], s[1 * 33]); o.y = pk2(s[2 * 33], s[3 * 33]); o.z = pk2(s[4 * 33], s[5 * 33]); o.w = pk2(s[6 * 33], s[7 * 33]);
        *(GAS v4u*)(WT + (size_t)mapf(n0 + n) * K + k0 + 8 * c) = o; }
    LDS_WAIT(); asm volatile("" ::: "memory");
}
template <class ScaleF>
__device__ __forceinline__ void p0_cvt512(const float* src, bf16* dst, size_t e0, int lane, ScaleF sf) {
    const size_t e = e0 + (size_t)lane * 8; const f32x4 a = *(const GAS f32x4*)(src + e), b = *(const GAS f32x4*)(src + e + 4);
    v4u o; o.x = pk2(a.x * sf(e), a.y * sf(e + 1)); o.y = pk2(a.z * sf(e + 2), a.w * sf(e + 3)); o.z = pk2(b.x * sf(e + 4), b.y * sf(e + 5)); o.w = pk2(b.z * sf(e + 6), b.w * sf(e + 7));
    *(GAS v4u*)(dst + e) = o;
}
__device__ __forceinline__ void p0_prologue(const Args& A, Frame& F) {
    unsigned char* ws = A.ws;
    const float* x = (const float*)A.in[0]; const float* p = (const float*)A.in[1]; const int* pos = (const int*)A.in[2];
    const float *g_mix = (const float*)A.in[3], *w_in = (const float*)A.in[4], *g_cq = (const float*)A.in[5], *w_uq = (const float*)A.in[6], *g_ckv = (const float*)A.in[7], *w_ukv = (const float*)A.in[8];
    const float *w_sgu = (const float*)A.in[11], *g_oa = (const float*)A.in[13], *g_os = (const float*)A.in[14], *w_out = (const float*)A.in[15], *g_ffn = (const float*)A.in[16], *w_pq = (const float*)A.in[17];
    const float *k1 = (const float*)A.in[18], *k2 = (const float*)A.in[19], *pu = (const float*)A.in[20], *pv = (const float*)A.in[21], *g_ple = (const float*)A.in[22], *w_pg = (const float*)A.in[23], *w_pp = (const float*)A.in[24];
    LAS float* scr = (LAS float*)(F.lds + RING_OFF + F.wave * 16384);
    const int gw = F.vcu * NWAVES + F.wave, NGW = F.G * NWAVES, lane = F.lane;
    for (int m = gw; m < T_TOK; m += NGW) {
        const GAS f32x4* xr = (const GAS f32x4*)(x + (size_t)m * DM) + lane; f32x4 v[8]; float s = 0.f;
#pragma unroll
        for (int j = 0; j < 8; ++j) { v[j] = xr[64 * j]; s += (v[j].x * v[j].x + v[j].y * v[j].y) + (v[j].z * v[j].z + v[j].w * v[j].w); }
        s = wave_sum64(s); if (lane == 0) ((float*)(ws + WS_RSX))[m] = 1.0f / sqrtf(s * (1.f / DM) + 1e-6f);
        GAS u32x2v* o8 = (GAS u32x2v*)((bf16*)(ws + WS_R1) + (size_t)m * DM) + lane;
#pragma unroll
        for (int j = 0; j < 8; ++j) o8[64 * j] = (u32x2v){pk2(v[j].x, v[j].y), pk2(v[j].z, v[j].w)};
        const f32x4 pvv = *((const GAS f32x4*)(p + (size_t)m * 256) + lane);
        *((GAS u32x2v*)((bf16*)(ws + WS_PB) + (size_t)m * 256) + lane) = (u32x2v){pk2(pvv.x, pvv.y), pk2(pvv.z, pvv.w)};
    }
    for (int it = gw; it < T_TOK * 32 / 64; it += NGW) { const int idx = it * 64 + lane, row = idx >> 5, i = idx & 31;
        const double f = exp2((double)i * (-13.287712379549449 / 32.0)); const double a = (double)pos[row] * f;
        ((f32x2v*)(ws + WS_CS))[idx] = (f32x2v){(float)cos(a), (float)sin(a)}; }
    constexpr int I_IN = 32 * 90, I_UQ = 8 * 48, I_UKV = 4 * 64, I_SQ = 32 * 64, I_PP = 4 * 64;
    constexpr int NITEMS = I_IN + I_UQ + I_UKV + 3 * I_SQ + I_PP;
    for (int it = gw; it < NITEMS; it += NGW) {
        int r = it;
        if (r < I_IN) { p0_transpose_item(w_in, 2048, 2880, (bf16*)(ws + WS_WT_IN), scr, r, lane, [](int n) { return map_win(n); }, [=](int k) { return g_mix[k]; }); continue; } r -= I_IN;
        if (r < I_UQ) { p0_transpose_item(w_uq, 512, 1536, (bf16*)(ws + WS_WT_UQ), scr, r, lane, [](int n) { return map_wuq(n); }, [=](int k) { return g_cq[k] * QK_C2; }); continue; } r -= I_UQ;
        if (r < I_UKV) { p0_transpose_item(w_ukv, 256, 2048, (bf16*)(ws + WS_WT_UKV), scr, r, lane, [](int n) { return n; }, [=](int k) { return g_ckv[k]; }); continue; } r -= I_UKV;
        if (r < I_SQ) { p0_transpose_item(w_out, 2048, 2048, (bf16*)(ws + WS_WT_OUT), scr, r, lane, [](int n) { return n; }, [=](int k) { return k < 1024 ? g_oa[k] : g_os[k - 1024]; }); continue; } r -= I_SQ;
        if (r < I_SQ) { p0_transpose_item(w_pq, 2048, 2048, (bf16*)(ws + WS_WT_PQ), scr, r, lane, [](int n) { return n; }, [=](int k) { return g_ffn[k]; }); continue; } r -= I_SQ;
        if (r < I_SQ) { p0_transpose_item(w_pg, 2048, 2048, (bf16*)(ws + WS_WT_PG), scr, r, lane, [](int n) { return n; }, [=](int k) { return g_ple[k]; }); continue; } r -= I_SQ;
        p0_transpose_item(w_pp, 256, 2048, (bf16*)(ws + WS_WT_PP), scr, r, lane, [](int n) { return n; }, [](int) { return 1.f; });
    }
    for (int it = gw; it < 192 * 2048 / 512; it += NGW) *(GAS v4u*)((bf16*)(ws + WS_WT_IN) + (size_t)2880 * 2048 + (size_t)it * 512 + lane * 8) = (v4u){0u, 0u, 0u, 0u};
    for (int it = gw; it < 3 * 256; it += NGW) { const int w = it >> 8, c = it & 255;
        if (w == 0) p0_cvt512(k1, (bf16*)(ws + WS_K1B), (size_t)c * 512, lane, [](size_t) { return 1.f; });
        else if (w == 1) p0_cvt512(k2, (bf16*)(ws + WS_K2B), (size_t)c * 512, lane, [](size_t) { return 1.f; });
        else p0_cvt512(w_sgu, (bf16*)(ws + WS_WSGU), (size_t)c * 512, lane, [](size_t e) { const int s = (int)(e & 127), t = (int)((e >> 7) & 127); return s <= t ? 1.f : 0.f; }); }
#if CUT >= 7
    for (int it = gw; it < 2 * 16384; it += NGW) { const int w = it >= 16384, row = w ? it - 16384 : it; const float* src = (w ? pv : pu) + (size_t)row * 2048 + 32 * lane;
        if (w ? !V_FP6 : !U_FP6) continue;
        typedef float v16f_ __attribute__((ext_vector_type(16))); typedef unsigned v6u_ __attribute__((ext_vector_type(6))); v16f_ x0, x1; f32x4 x[8];
#pragma unroll
        for (int q = 0; q < 8; ++q) x[q] = *(const GAS f32x4*)(src + 4 * q);
        if (!w) {
#pragma unroll
            for (int q = 0; q < 8; ++q) { const f32x4 g = *(const GAS f32x4*)(g_ffn + 32 * lane + 4 * q); x[q] = x[q] * g * 64.f; }
#pragma unroll
            for (int i = 0; i < 16; ++i) { x0[i] = x[i >> 2][i & 3]; x1[i] = x[4 + (i >> 2)][i & 3]; } }
        else {
#pragma unroll
            for (int i = 0; i < 16; ++i) { x0[i] = x[(2 * i) >> 2][(2 * i) & 3] * 4.f; x1[i] = x[(2 * i + 1) >> 2][(2 * i + 1) & 3] * 4.f; } }
        v6u_ pk; asm("v_cvt_scalef32_2xpk16_fp6_f32 %0, %1, %2, 1.0" : "=&v"(pk) : "v"(x0), "v"(x1));
        unsigned char* dst = ws + (w ? WS_VB : WS_UB) + (size_t)row * 1536;
        *(GAS v4u*)(dst + 16 * lane) = (v4u){pk[0], pk[1], pk[2], pk[3]}; *(GAS u32x2v*)(dst + 1024 + 8 * lane) = (u32x2v){pk[4], pk[5]}; }
    for (int it = gw; it < 2 * 16384 * 2; it += NGW) { const int w = it >= 16384 * 2, c = w ? it - 16384 * 2 : it; const float* src = (w ? pv : pu) + (size_t)c * 1024 + lane * 16; const int d0 = (c & 1) * 1024 + lane * 16;
        if (w ? V_FP6 : U_FP6) continue;
        f32x4 x[4];
#pragma unroll
        for (int q = 0; q < 4; ++q) x[q] = *(const GAS f32x4*)(src + 4 * q);
        if (!w) {
#pragma unroll
            for (int q = 0; q < 4; ++q) x[q] = x[q] * *(const GAS f32x4*)(g_ffn + d0 + 4 * q) * 256.f; }
        else {
#pragma unroll
            for (int q = 0; q < 4; ++q) x[q] = x[q] * 16.f; }
        v4u o; int t;
        t = 0; t = __builtin_amdgcn_cvt_pk_fp8_f32(x[0][0], x[0][1], t, false); t = __builtin_amdgcn_cvt_pk_fp8_f32(x[0][2], x[0][3], t, true); o.x = (unsigned)t;
        t = 0; t = __builtin_amdgcn_cvt_pk_fp8_f32(x[1][0], x[1][1], t, false); t = __builtin_amdgcn_cvt_pk_fp8_f32(x[1][2], x[1][3], t, true); o.y = (unsigned)t;
        t = 0; t = __builtin_amdgcn_cvt_pk_fp8_f32(x[2][0], x[2][1], t, false); t = __builtin_amdgcn_cvt_pk_fp8_f32(x[2][2], x[2][3], t, true); o.z = (unsigned)t;
        t = 0; t = __builtin_amdgcn_cvt_pk_fp8_f32(x[3][0], x[3][1], t, false); t = __builtin_amdgcn_cvt_pk_fp8_f32(x[3][2], x[3][3], t, true); o.w = (unsigned)t;
        *(GAS v4u*)((unsigned char*)(ws + (w ? WS_VB : WS_UB)) + (size_t)c * 1024 + lane * 16) = o; }
#endif
}

__device__ __forceinline__ v4u pack8(f32x4 a, f32x4 b) { v4u w; w.x = pg8::cvt_pk_bf16(a[0], a[1]); w.y = pg8::cvt_pk_bf16(a[2], a[3]); w.z = pg8::cvt_pk_bf16(b[0], b[1]); w.w = pg8::cvt_pk_bf16(b[2], b[3]); return w; }
__device__ __forceinline__ float sq8(f32x4 a, f32x4 b) { return ((a[0] * a[0] + a[1] * a[1]) + (a[2] * a[2] + a[3] * a[3])) + ((b[0] * b[0] + b[1] * b[1]) + (b[2] * b[2] + b[3] * b[3])); }
__device__ __forceinline__ float fq_sum(float v) { v += __shfl_xor(v, 16); v += __shfl_xor(v, 32); return v; }
#define EPI_ROWS_BEGIN _Pragma("unroll") for (int ai = 0; ai < 2; ++ai) _Pragma("unroll") for (int m = 0; m < 4; ++m) { const int row = u.pm * 256 + ai * 128 + wr * 64 + m * 16 + fr;
#define EPI_ROWS_END }

struct EpiG1 {
    static constexpr bool PERM = true, AFTER_DRAIN = false, MID = false;
    const float* rsx; bf16 *CQ, *CKV, *KR, *UG, *VG; float *pscq, *psckv; f32x2v* psv; const f32x2v* cs;
    __device__ __forceinline__ void operator()(const f32x4 (&acc)[2][2][4][2], const pg8::Unit& u, int wr, int wc, int fr, int fq) const {
        const int pn = u.pn;
        EPI_ROWS_BEGIN
            const float rs = rsx[row];
#pragma unroll
            for (int bj = 0; bj < 2; ++bj) { f32x4 v0 = acc[ai][bj][m][0] * rs, v1 = acc[ai][bj][m][1] * rs; const int lc = bj * 128 + wc * 32 + fq * 8;
                if (pn <= 2) { const float ss = fq_sum(sq8(v0, v1));
                    if (pn < 2) { *(GAS v4u*)(CQ + (size_t)row * 512 + pn * 256 + lc) = pack8(v0, v1); if (fq == 0) pscq[row * 16 + (pn * 2 + bj) * 4 + wc] = ss; }
                    else { *(GAS v4u*)(CKV + (size_t)row * 256 + lc) = pack8(v0, v1); if (fq == 0) psckv[row * 8 + bj * 4 + wc] = ss; } }
                else if (pn <= 10) {
#pragma unroll
                    for (int e = 0; e < 4; ++e) { v0[e] = gelu_f(v0[e]); v1[e] = gelu_f(v1[e]); }
                    if (pn <= 6) *(GAS v4u*)(UG + (size_t)row * 1024 + (pn - 3) * 256 + lc) = pack8(v0, v1);
                    else { const float s = fq_sum(((v0[0] + v0[1]) + (v0[2] + v0[3])) + ((v1[0] + v1[1]) + (v1[2] + v1[3]))), q = fq_sum(sq8(v0, v1));
                        *(GAS v4u*)(VG + (size_t)row * 1024 + (pn - 7) * 256 + lc) = pack8(v0, v1); if (fq == 0) psv[(row * 8 + (pn - 7) * 2 + bj) * 4 + wc] = (f32x2v){s, q}; } }
                else if (bj == 0 && wc < 2) { f32x4 o0, o1;
#pragma unroll
                    for (int e = 0; e < 4; ++e) { const f32x2v c = cs[row * 32 + 16 * wc + 4 * fq + e]; o0[e] = v0[e] * c.x - v1[e] * c.y; o1[e] = v1[e] * c.x + v0[e] * c.y; }
                    *(GAS v4u*)(KR + (size_t)row * 64 + wc * 32 + fq * 8) = pack8(o0, o1); } }
        EPI_ROWS_END
    }
};
struct EpiPlain {
    static constexpr bool PERM = true, AFTER_DRAIN = false, MID = false;
    bf16* O; int ldc;
    __device__ __forceinline__ void operator()(const f32x4 (&acc)[2][2][4][2], const pg8::Unit& u, int wr, int wc, int fr, int fq) const {
        EPI_ROWS_BEGIN
#pragma unroll
            for (int bj = 0; bj < 2; ++bj) *(GAS v4u*)(O + (size_t)row * ldc + u.pn * 256 + bj * 128 + wc * 32 + fq * 8) = pack8(acc[ai][bj][m][0], acc[ai][bj][m][1]);
        EPI_ROWS_END
    }
};
template <class Sched>
__device__ __forceinline__ void setup_rowtab(LAS float* tab, const float* part, int NP, float inv_dim, const Sched& S, int wid) {
    pg8::Unit u; const int tid = wid * 64 + lane_id();
    if (S.next(0, u)) { const int r = tid >> 1, half = tid & 1, n2 = NP >> 1; const float* pp = part + (size_t)(u.pm * 256 + r) * NP + half * n2; float s = 0.f;
        for (int j = 0; j < n2; ++j) s += pp[j];
        s += __shfl_xor(s, 1); if (!half) tab[r] = 1.0f / sqrtf(s * inv_dim + 1e-6f); }
}
struct EpiQ {
    static constexpr bool PERM = true, AFTER_DRAIN = false, MID = false;
    const LAS float* tab; bf16* Q; const f32x2v* cs;
    __device__ __forceinline__ void operator()(const f32x4 (&acc)[2][2][4][2], const pg8::Unit& u, int wr, int wc, int fr, int fq) const {
        EPI_ROWS_BEGIN
            const float rs = tab[ai * 128 + wr * 64 + m * 16 + fr];
#pragma unroll
            for (int bj = 0; bj < 2; ++bj) { f32x4 v0 = acc[ai][bj][m][0] * rs, v1 = acc[ai][bj][m][1] * rs; const int gc = u.pn * 256 + bj * 128 + wc * 32;
                if (((gc >> 6) % 3) == 2) { f32x4 o0, o1;
#pragma unroll
                    for (int e = 0; e < 4; ++e) { const f32x2v c = cs[row * 32 + 16 * (wc & 1) + 4 * fq + e]; o0[e] = v0[e] * c.x - v1[e] * c.y; o1[e] = v1[e] * c.x + v0[e] * c.y; }
                    v0 = o0; v1 = o1; }
                *(GAS v4u*)(Q + (size_t)row * 1536 + gc + fq * 8) = pack8(v0, v1); }
        EPI_ROWS_END
    }
};
struct EpiKV {
    static constexpr bool PERM = true, AFTER_DRAIN = false, MID = false;
    const LAS float* tab; bf16 *KN, *VV;
    __device__ __forceinline__ void operator()(const f32x4 (&acc)[2][2][4][2], const pg8::Unit& u, int wr, int wc, int fr, int fq) const {
        EPI_ROWS_BEGIN
            const float rs = tab[ai * 128 + wr * 64 + m * 16 + fr];
#pragma unroll
            for (int bj = 0; bj < 2; ++bj) *(GAS v4u*)((bj ? VV : KN) + (size_t)row * 1024 + u.pn * 128 + wc * 32 + fq * 8) = pack8(acc[ai][bj][m][0] * rs, acc[ai][bj][m][1] * rs);
        EPI_ROWS_END
    }
};
struct EpiOut {
    static constexpr bool PERM = true, AFTER_DRAIN = false, MID = true;
    const LAS float* tab; const float* x; float* H1; bf16* H1B; float* psh1;
    __device__ __forceinline__ void mid(f32x4 (&acc)[2][2][4][2], const pg8::Unit& u, int wr, int wc, int fr, int fq) const {
#pragma unroll
        for (int ai = 0; ai < 2; ++ai)
#pragma unroll
            for (int m = 0; m < 4; ++m) { const int r = ai * 128 + wr * 64 + m * 16 + fr; const float rr = tab[r] / tab[256 + r];
#pragma unroll
                for (int bj = 0; bj < 2; ++bj) { acc[ai][bj][m][0] *= rr; acc[ai][bj][m][1] *= rr; } }
    }
    __device__ __forceinline__ void operator()(const f32x4 (&acc)[2][2][4][2], const pg8::Unit& u, int wr, int wc, int fr, int fq) const {
        EPI_ROWS_BEGIN
            const float rs = tab[256 + ai * 128 + wr * 64 + m * 16 + fr];
#pragma unroll
            for (int bj = 0; bj < 2; ++bj) { const size_t off = (size_t)row * DM + u.pn * 256 + bj * 128 + wc * 32 + fq * 8;
                const f32x4 v0 = *(const GAS f32x4*)(x + off) + acc[ai][bj][m][0] * rs, v1 = *(const GAS f32x4*)(x + off + 4) + acc[ai][bj][m][1] * rs;
                *(GAS f32x4*)(H1 + off) = v0; *(GAS f32x4*)(H1 + off + 4) = v1; *(GAS v4u*)(H1B + off) = pack8(v0, v1);
                const float ss = fq_sum(sq8(v0, v1)); if (fq == 0) psh1[row * 64 + u.pn * 8 + bj * 4 + wc] = ss; }
        EPI_ROWS_END
    }
};
struct EpiPQ {
    static constexpr bool PERM = true, AFTER_DRAIN = false, MID = false;
    const LAS float* tab; bf16* QP;
    __device__ __forceinline__ void operator()(const f32x4 (&acc)[2][2][4][2], const pg8::Unit& u, int wr, int wc, int fr, int fq) const {
        EPI_ROWS_BEGIN
            const float rs = tab[ai * 128 + wr * 64 + m * 16 + fr];
#pragma unroll
            for (int bj = 0; bj < 2; ++bj) *(GAS v4u*)(QP + (size_t)row * DM + u.pn * 256 + bj * 128 + wc * 32 + fq * 8) = pack8(acc[ai][bj][m][0] * rs, acc[ai][bj][m][1] * rs);
        EPI_ROWS_END
    }
};
struct EpiPLE {
    static constexpr bool PERM = true, AFTER_DRAIN = false, MID = false;
    const float* rsh2; const float* H2; const bf16* PPROJ; float* out; float* psh3;
    __device__ __forceinline__ void operator()(const f32x4 (&acc)[2][2][4][2], const pg8::Unit& u, int wr, int wc, int fr, int fq) const {
        EPI_ROWS_BEGIN
            const float rs = rsh2[row];
#pragma unroll
            for (int bj = 0; bj < 2; ++bj) { const size_t off = (size_t)row * DM + u.pn * 256 + bj * 128 + wc * 32 + fq * 8;
                const v4u pw = *(const GAS v4u*)(PPROJ + off); f32x4 h0 = *(const GAS f32x4*)(H2 + off), h1 = *(const GAS f32x4*)(H2 + off + 4);
                const unsigned pws[4] = {pw.x, pw.y, pw.z, pw.w};
#pragma unroll
                for (int e = 0; e < 4; ++e) { const float a = acc[ai][bj][m][e >> 1][(e & 1) * 2] * rs, b = acc[ai][bj][m][e >> 1][(e & 1) * 2 + 1] * rs;
                    const float ga = __builtin_amdgcn_rcpf(1.f + __builtin_amdgcn_exp2f(-1.4426950408889634f * a)), gb = __builtin_amdgcn_rcpf(1.f + __builtin_amdgcn_exp2f(-1.4426950408889634f * b));
                    const float pa = __uint_as_float(pws[e] << 16), pb = __uint_as_float(pws[e] & 0xffff0000u);
                    if (e < 2) { h0[(e & 1) * 2] += ga * pa; h0[(e & 1) * 2 + 1] += gb * pb; } else { h1[(e & 1) * 2] += ga * pa; h1[(e & 1) * 2 + 1] += gb * pb; } }
                *(GAS f32x4*)(out + off) = h0; *(GAS f32x4*)(out + off + 4) = h1;
                const float ss = fq_sum(sq8(h0, h1)); if (fq == 0) psh3[row * 64 + u.pn * 8 + bj * 4 + wc] = ss; }
        EPI_ROWS_END
    }
};
typedef float f32x16 __attribute__((ext_vector_type(16)));
typedef short s16x4 __attribute__((ext_vector_type(4)));
#define KSWZ(row, colB) ((row) * 256 + ((colB) ^ (((row) & 7) << 4)))
__device__ __forceinline__ int v_st(int k, int c) { const int kk = (k & ~0xC) | ((k & 4) << 1) | ((k & 8) >> 1); return ((kk >> 3) * 4 + (c >> 5)) * 512 + ((kk & 7) * 32 + (c & 31)) * 2; }
__device__ __forceinline__ int v_rd_base(int lane) { return ((lane & 3) << 3) | (((lane >> 2) & 3) << 6) | (((lane >> 4) & 1) << 5) | (((lane >> 5) & 1) << 8); }
__device__ __forceinline__ int crow(int r, int hi) { return (r & 3) + 8 * (r >> 2) + 4 * hi; }
#define TRRD(dst, off) asm volatile("ds_read_b64_tr_b16 %0, %1 offset:%2" : "=&v"(dst) : "v"(vb0), "i"(off) : "memory")
#define SBAR() __builtin_amdgcn_sched_barrier(0)
#define PV_ONE(o_, pa_, VOFF, D0, KS) do { s16x4 l_, h_; TRRD(l_, (VOFF) + (D0) * 512 + (KS) * 4096); TRRD(h_, (VOFF) + (D0) * 512 + (KS) * 4096 + 2048); \
        asm volatile("s_waitcnt lgkmcnt(0)" ::: "memory"); SBAR(); \
        o_ = __builtin_amdgcn_mfma_f32_32x32x16_bf16(pa_, (bf16x8){l_[0], l_[1], l_[2], l_[3], h_[0], h_[1], h_[2], h_[3]}, o_, 0, 0, 0); } while (0)
__device__ __forceinline__ float half_sum32(float v) { v += __shfl_xor(v, 1); v += __shfl_xor(v, 2); v += __shfl_xor(v, 4); v += __shfl_xor(v, 8); v += __shfl_xor(v, 16); return v; }

__device__ __forceinline__ void sgu_phase(const Args& A, Frame& F) {
    unsigned char* ws = A.ws;
    const bf16* VG = (const bf16*)(ws + WS_VG); const bf16* UG = (const bf16*)(ws + WS_UG); const bf16* WS = (const bf16*)(ws + WS_WSGU); const f32x2v* psv = (const f32x2v*)(ws + WS_PSV);
    const float* gln = (const float*)A.in[9]; const float* bln = (const float*)A.in[10]; const float* bs = (const float*)A.in[12];
    bf16* MIX = (bf16*)(ws + WS_MIX); float* pss = (float*)(ws + WS_PSS);
    const int lane = lane_id(), wid = F.wave, tid = wid * 64 + lane, r32 = lane & 31, hi = lane >> 5, tg = wid & 3, dh = wid >> 2;
    LAS unsigned char* V_lds = F.lds + RING_OFF;
    const int vb0 = (int)(uintptr_t)V_lds + v_rd_base(lane);
    for (int unit = F.vcu; unit < 512; unit += F.G) {
        const int g = unit & 7, R0 = (unit >> 3) * 128;
#pragma unroll
        for (int i = 0; i < 4; ++i) { const int s = (tid >> 4) + 32 * i, c = (tid & 15) * 8, row = R0 + s;
            const f32x2v* pp = psv + ((size_t)row * 8 + g) * 4; const f32x2v p0 = pp[0], p1 = pp[1], p2 = pp[2], p3 = pp[3];
            const float mean = ((p0.x + p1.x) + (p2.x + p3.x)) * (1.f / 128.f), var = ((p0.y + p1.y) + (p2.y + p3.y)) * (1.f / 128.f) - mean * mean, rstd = 1.0f / sqrtf(fmaxf(var, 0.f) + 1e-6f);
            const v4u xv = *(const GAS v4u*)(VG + (size_t)row * 1024 + g * 128 + c);
            const f32x4 g0 = *(const GAS f32x4*)(gln + g * 128 + c), g1 = *(const GAS f32x4*)(gln + g * 128 + c + 4), b0 = *(const GAS f32x4*)(bln + g * 128 + c), b1 = *(const GAS f32x4*)(bln + g * 128 + c + 4);
            f32x4 y0, y1;
            y0[0] = (__uint_as_float(xv.x << 16) - mean) * rstd * g0[0] + b0[0]; y0[1] = (__uint_as_float(xv.x & 0xffff0000u) - mean) * rstd * g0[1] + b0[1];
            y0[2] = (__uint_as_float(xv.y << 16) - mean) * rstd * g0[2] + b0[2]; y0[3] = (__uint_as_float(xv.y & 0xffff0000u) - mean) * rstd * g0[3] + b0[3];
            y1[0] = (__uint_as_float(xv.z << 16) - mean) * rstd * g1[0] + b1[0]; y1[1] = (__uint_as_float(xv.z & 0xffff0000u) - mean) * rstd * g1[1] + b1[1];
            y1[2] = (__uint_as_float(xv.w << 16) - mean) * rstd * g1[2] + b1[2]; y1[3] = (__uint_as_float(xv.w & 0xffff0000u) - mean) * rstd * g1[3] + b1[3];
            *(LAS v4u*)(V_lds + (s >> 6) * 16384 + v_st(s & 63, c)) = pack8(y0, y1); }
        bf16x8 afr[8];
#pragma unroll
        for (int ks = 0; ks < 8; ++ks) afr[ks] = *(const GAS bf16x8*)(WS + ((size_t)g * 128 + 32 * tg + r32) * 128 + 16 * ks + 8 * hi);
        __syncthreads();
        f32x16 o0 = {}, o1 = {};
#define SGU_TILE(TL) do { _Pragma("unroll") for (int ks = 0; ks < 4; ++ks) { \
            if (dh == 0) { PV_ONE(o0, afr[4 * TL + ks], TL * 16384, 0, ks); PV_ONE(o1, afr[4 * TL + ks], TL * 16384, 1, ks); } \
            else { PV_ONE(o0, afr[4 * TL + ks], TL * 16384, 2, ks); PV_ONE(o1, afr[4 * TL + ks], TL * 16384, 3, ks); } } } while (0)
        SGU_TILE(0); if (tg >= 2) SGU_TILE(1);
#undef SGU_TILE
#pragma unroll
        for (int r = 0; r < 16; ++r) { const int t = 32 * tg + crow(r, hi), row = R0 + t; const float bias = bs[g * 128 + t];
            const int d0 = 64 * dh + r32; const size_t uoff = (size_t)row * 1024 + g * 128 + d0;
            const float va = bf2f(UG[uoff]) * (o0[r] + bias), vb = bf2f(UG[uoff + 32]) * (o1[r] + bias);
            const float na = __shfl_xor(va, 1), nb = __shfl_xor(vb, 1);
            if ((r32 & 1) == 0) { bf16* mo = MIX + (size_t)row * 2048 + 1024 + g * 128 + d0; *(GAS unsigned*)mo = pg8::cvt_pk_bf16(va, na); *(GAS unsigned*)(mo + 32) = pg8::cvt_pk_bf16(vb, nb); }
            const float ss = half_sum32(va * va + vb * vb); if (r32 == 0) pss[row * 16 + g * 2 + dh] = ss; }
        __syncthreads();
    }
}

#define OPAQUE(x) asm volatile("" : "+v"(x))
constexpr int KT_ROW = 400, KT_BYTES = 64 * KT_ROW;
__device__ __forceinline__ void attn_phase(const Args& A, Frame& F) {
    unsigned char* ws = A.ws;
    const GAS unsigned char* Qg = (const GAS unsigned char*)(ws + WS_Q); const GAS unsigned char* KNg = (const GAS unsigned char*)(ws + WS_KN); const GAS unsigned char* VVg = (const GAS unsigned char*)(ws + WS_VV); const GAS unsigned char* KRg = (const GAS unsigned char*)(ws + WS_KR);
    bf16* MIX = (bf16*)(ws + WS_MIX); float* psa = (float*)(ws + WS_PSA);
    const int wid = F.wave, g = wid & 3, kh = wid >> 2;
    LAS unsigned char* V_lds = F.lds + RING_OFF; LAS unsigned char* Kt_lds = V_lds + 32768;
    LAS float* wsc = (LAS float*)(V_lds + 86016) + wid * 64;
    LAS float* ml1 = (LAS float*)(V_lds + 86016 + 2048);
    for (int item = F.vcu; item < 256; item += F.G) {
        const int bh = item >> 3, s = item & 7, b = bh >> 3, h = bh & 7, tok0 = b * SEQ;
        for (int pass = 0; pass < 2; ++pass) {
            const int jq = pass ? s : 15 - s, q0 = tok0 + 128 * jq, NT = 2 * (jq + 1);
            bf16x8 qr[12];
            { int ln = lane_id(); const int r32 = ln & 31, hi = ln >> 5; const GAS unsigned char* qp = Qg + (size_t)(q0 + 32 * g) * 3072 + h * 384; const unsigned qo = (unsigned)r32 * 3072u + (unsigned)hi * 16u;
#pragma unroll
              for (int ks = 0; ks < 12; ++ks) qr[ks] = *(const GAS bf16x8*)(qp + qo + ks * 32); }
            bf16x8 skn0, skn1, sv0, sv1, skr;
#define ALOAD(t_) do { int ln_ = lane_id(); const int tid_ = wid * 64 + ln_; const unsigned sr_ = tid_ >> 4, sc_ = tid_ & 15; \
                const GAS unsigned char* kb_ = KNg + (size_t)(tok0 + 64 * (t_)) * 2048 + h * 256; const GAS unsigned char* vb_ = VVg + (size_t)(tok0 + 64 * (t_)) * 2048 + h * 256; const GAS unsigned char* rb_ = KRg + (size_t)(tok0 + 64 * (t_)) * 128; \
                const unsigned o_ = sr_ * 2048u + sc_ * 16u; \
                skn0 = *(const GAS bf16x8*)(kb_ + o_); skn1 = *(const GAS bf16x8*)(kb_ + o_ + 65536u); sv0 = *(const GAS bf16x8*)(vb_ + o_); sv1 = *(const GAS bf16x8*)(vb_ + o_ + 65536u); \
                skr = *(const GAS bf16x8*)(rb_ + (unsigned)tid_ * 16u); } while (0)
#define AWRITE(bf_) do { int ln_ = lane_id(); const int tid_ = wid * 64 + ln_; const int sr_ = tid_ >> 4, sc_ = tid_ & 15; \
                LAS unsigned char* kt_ = Kt_lds + (bf_) * KT_BYTES; LAS unsigned char* vt_ = V_lds + (bf_) * 16384; \
                *(LAS bf16x8*)(kt_ + sr_ * KT_ROW + sc_ * 16) = skn0; *(LAS bf16x8*)(kt_ + (sr_ + 32) * KT_ROW + sc_ * 16) = skn1; \
                *(LAS bf16x8*)(vt_ + v_st(sr_, sc_ * 8)) = sv0; *(LAS bf16x8*)(vt_ + v_st(32 + sr_, sc_ * 8)) = sv1; \
                *(LAS bf16x8*)(kt_ + (tid_ >> 3) * KT_ROW + 256 + (tid_ & 7) * 16) = skr; } while (0)
            ALOAD(0); AWRITE(0); __syncthreads();
            float m_reg = -1e30f, l_reg = 0.f; f32x16 o[4] = {};
            for (int t = 0; t < NT; ++t) {
                const int bf = t & 1;
                if (t + 1 < NT) ALOAD(t + 1);
                int ln = lane_id(); const int r32 = ln & 31, hi = ln >> 5;
                f32x16 p = {};
                { const LAS unsigned char* kb = Kt_lds + bf * KT_BYTES + (32 * kh + r32) * KT_ROW + hi * 16;
#pragma unroll
                  for (int ks = 0; ks < 12; ++ks) p = __builtin_amdgcn_mfma_f32_32x32x16_bf16(*(const LAS bf16x8*)(kb + ks * 32), qr[ks], p, 0, 0, 0); }
                if (t >= 2 * jq) { const int dq = (32 * g + r32) - (64 * (t - 2 * jq) + 32 * kh + 4 * hi);
#pragma unroll
                    for (int r = 0; r < 16; ++r) { const int c = (r & 3) + 8 * (r >> 2); if (c > dq) p[r] = -__builtin_inff(); } }
                float pmax = p[0];
#pragma unroll
                for (int r = 1; r < 16; ++r) pmax = fmaxf(pmax, p[r]);
                { auto rr = __builtin_amdgcn_permlane32_swap(__float_as_uint(pmax), __float_as_uint(pmax), false, false); pmax = fmaxf(__uint_as_float(rr[0]), __uint_as_float(rr[1])); }
                const float mn = fmaxf(m_reg, pmax), alpha = __builtin_amdgcn_exp2f(m_reg - mn); m_reg = mn;
                float ps = 0.f;
#pragma unroll
                for (int r = 0; r < 16; ++r) { p[r] = __builtin_amdgcn_exp2f(p[r] - mn); ps += p[r]; }
                { auto rr = __builtin_amdgcn_permlane32_swap(__float_as_uint(ps), __float_as_uint(ps), false, false); ps = __uint_as_float(rr[0]) + __uint_as_float(rr[1]); }
                l_reg = l_reg * alpha + ps;
                if (__any(alpha < 1.f)) { if (hi == 0) wsc[r32] = alpha; asm volatile("s_waitcnt lgkmcnt(0)" ::: "memory");
#pragma unroll
                    for (int r = 0; r < 16; ++r) { const float f = wsc[crow(r, hi)];
#pragma unroll
                        for (int d_ = 0; d_ < 4; ++d_) o[d_][r] *= f; } }
                bf16x8 pa0, pa1;
#define PK4(P, B_, OUT) do { unsigned a0 = pg8::cvt_pk_bf16(P[B_ + 0], P[B_ + 1]), a1 = pg8::cvt_pk_bf16(P[B_ + 2], P[B_ + 3]), b0 = pg8::cvt_pk_bf16(P[B_ + 4], P[B_ + 5]), b1 = pg8::cvt_pk_bf16(P[B_ + 6], P[B_ + 7]); \
                    auto r0 = __builtin_amdgcn_permlane32_swap(a0, b0, false, false); auto r1 = __builtin_amdgcn_permlane32_swap(a1, b1, false, false); \
                    v4u w = {r0[0], r1[0], r0[1], r1[1]}; OUT = __builtin_bit_cast(bf16x8, w); } while (0)
                PK4(p, 0, pa0); PK4(p, 8, pa1);
#undef PK4
                { const int vb0 = (int)(uintptr_t)V_lds + v_rd_base(ln) + bf * 16384 + kh * 8192;
#pragma unroll
                  for (int dp = 0; dp < 2; ++dp) {
                      s16x4 l0, h0, l1, h1, l2, h2, l3, h3;
                      if (dp == 0) { TRRD(l0, 0); TRRD(h0, 2048); TRRD(l1, 4096); TRRD(h1, 4096 + 2048); TRRD(l2, 512); TRRD(h2, 512 + 2048); TRRD(l3, 512 + 4096); TRRD(h3, 512 + 4096 + 2048); }
                      else { TRRD(l0, 1024); TRRD(h0, 1024 + 2048); TRRD(l1, 1024 + 4096); TRRD(h1, 1024 + 4096 + 2048); TRRD(l2, 1536); TRRD(h2, 1536 + 2048); TRRD(l3, 1536 + 4096); TRRD(h3, 1536 + 4096 + 2048); }
                      asm volatile("s_waitcnt lgkmcnt(0)" ::: "memory"); SBAR();
                      o[2 * dp] = __builtin_amdgcn_mfma_f32_32x32x16_bf16(pa0, (bf16x8){l0[0], l0[1], l0[2], l0[3], h0[0], h0[1], h0[2], h0[3]}, o[2 * dp], 0, 0, 0);
                      o[2 * dp + 1] = __builtin_amdgcn_mfma_f32_32x32x16_bf16(pa0, (bf16x8){l2[0], l2[1], l2[2], l2[3], h2[0], h2[1], h2[2], h2[3]}, o[2 * dp + 1], 0, 0, 0);
                      o[2 * dp] = __builtin_amdgcn_mfma_f32_32x32x16_bf16(pa1, (bf16x8){l1[0], l1[1], l1[2], l1[3], h1[0], h1[1], h1[2], h1[3]}, o[2 * dp], 0, 0, 0);
                      o[2 * dp + 1] = __builtin_amdgcn_mfma_f32_32x32x16_bf16(pa1, (bf16x8){l3[0], l3[1], l3[2], l3[3], h3[0], h3[1], h3[2], h3[3]}, o[2 * dp + 1], 0, 0, 0); } }
                if (t + 1 < NT) AWRITE(bf ^ 1);
                __syncthreads();
            }
#undef ALOAD
#undef AWRITE
            { int ln = lane_id(); const int r32 = ln & 31, hi = ln >> 5;
            LAS float* O1 = (LAS float*)(V_lds + g * 16384) + ln;
            if (kh == 1) {
#pragma unroll
                for (int d0 = 0; d0 < 4; ++d0)
#pragma unroll
                    for (int r = 0; r < 16; ++r) O1[(d0 * 16 + r) * 64] = o[d0][r];
                if (hi == 0) { ml1[g * 64 + r32] = m_reg; ml1[g * 64 + 32 + r32] = l_reg; } }
            __syncthreads();
            if (kh == 0) { const float m1 = ml1[g * 64 + r32], l1 = ml1[g * 64 + 32 + r32], mt = fmaxf(m_reg, m1), a0 = __builtin_amdgcn_exp2f(m_reg - mt), a1 = __builtin_amdgcn_exp2f(m1 - mt), il = 1.0f / (l_reg * a0 + l1 * a1);
                if (hi == 0) { wsc[r32] = a0 * il; wsc[32 + r32] = a1 * il; } asm volatile("s_waitcnt lgkmcnt(0)" ::: "memory");
#pragma unroll
                for (int r = 0; r < 16; ++r) { const int qrow = q0 + 32 * g + crow(r, hi); const float f0 = wsc[crow(r, hi)], f1 = wsc[32 + crow(r, hi)]; float ss = 0.f;
#pragma unroll
                    for (int d0 = 0; d0 < 4; ++d0) { const float v = o[d0][r] * f0 + O1[(d0 * 16 + r) * 64] * f1; ss += v * v; const float vn = __shfl_xor(v, 1);
                        if ((r32 & 1) == 0) *(GAS unsigned*)(MIX + (size_t)qrow * 2048 + h * 128 + d0 * 32 + r32) = pg8::cvt_pk_bf16(v, vn); }
                    ss = half_sum32(ss); if (r32 == 0) psa[qrow * 8 + h] = ss; } }
            __syncthreads(); }
        }
    }
}
typedef __bf16 bf16x2_t __attribute__((ext_vector_type(2)));
__device__ __forceinline__ unsigned ord_key(float f) { const unsigned u = __float_as_uint(f); return u ^ ((unsigned)((int)u >> 31) | 0x80000000u); }
__device__ __forceinline__ float ord_val(unsigned k) { return __uint_as_float((k & 0x80000000u) ? (k ^ 0x80000000u) : ~k); }
__device__ __forceinline__ unsigned umax3(unsigned a, unsigned b, unsigned c) { return max(max(a, b), c); }
__device__ __forceinline__ unsigned pair_max(unsigned v) { auto rr = __builtin_amdgcn_permlane32_swap(v, v, false, false); return max(rr[0], rr[1]); }
__device__ __forceinline__ unsigned pair_or(unsigned v) { auto rr = __builtin_amdgcn_permlane32_swap(v, v, false, false); return rr[0] | rr[1]; }
__host__ __device__ constexpr int cand_a(int c) { return c < 16 ? 0 : c < 24 ? 1 : c < 29 ? 2 : c < 33 ? 3 : c < 36 ? 4 : c < 38 ? 5 : c < 40 ? 6 : c < 42 ? 7 : c - 34; }
__host__ __device__ constexpr int cand_b(int c) { return c < 16 ? c : c < 24 ? c - 16 : c < 29 ? c - 24 : c < 33 ? c - 29 : c < 36 ? c - 33 : c < 38 ? c - 36 : c < 40 ? c - 38 : c < 42 ? c - 40 : 0; }
__device__ __forceinline__ void topk16_of_128(const bf16* keys  , const bf16* qrow  , int r32, int hi, unsigned (&sel)[16]) {
    bf16x8 qf[8];
#pragma unroll
    for (int ks = 0; ks < 8; ++ks) qf[ks] = *(const GAS bf16x8*)(qrow + 16 * ks + 8 * hi);
    unsigned k[64];
#pragma unroll
    for (int kb = 0; kb < 4; ++kb) { f32x16 acc = {};
#pragma unroll
        for (int ks = 0; ks < 8; ++ks) acc = __builtin_amdgcn_mfma_f32_32x32x16_bf16(*(const GAS bf16x8*)(keys + (size_t)(32 * kb + r32) * 128 + 16 * ks + 8 * hi), qf[ks], acc, 0, 0, 0);
#pragma unroll
        for (int r = 0; r < 16; ++r) k[kb * 16 + r] = (ord_key(acc[r]) & ~0x7fu) | (unsigned)(127 - (32 * kb + crow(r, hi))); }
#pragma unroll
    for (int it = 0; it < 16; ++it) { unsigned m = umax3(k[0], k[1], k[2]);
#pragma unroll
        for (int i = 3; i < 63; i += 2) m = umax3(m, k[i], k[i + 1]);
        m = max(m, k[63]); m = pair_max(m); sel[it] = m;
#pragma unroll
        for (int i = 0; i < 64; ++i) k[i] = (k[i] == m) ? 0u : k[i]; }
}
__device__ __forceinline__ void topk_phase(const Args& A, Frame& F) {
    unsigned char* ws = A.ws;
    const bf16* QP = (const bf16*)(ws + WS_R1); const bf16* K1 = (const bf16*)(ws + WS_K1B); const bf16* K2 = (const bf16*)(ws + WS_K2B); int* IDX = (int*)(ws + WS_IDX); float* GATE = (float*)(ws + WS_GATE);
    const int wid = F.wave;
    for (int unit = F.vcu; unit < 256; unit += F.G) {
        const int rb = unit >> 3, h = unit & 7; const int ln = lane_id(), r32 = ln & 31, hi = ln >> 5; const int tok = rb * 256 + wid * 32 + r32;
        unsigned s1[16], s2[16];
        topk16_of_128(K1 + (size_t)h * 16384, QP + (size_t)tok * 2048 + h * 256, r32, hi, s1);
        topk16_of_128(K2 + (size_t)h * 16384, QP + (size_t)tok * 2048 + h * 256 + 128, r32, hi, s2);
        float t1v[16], t2v[16]; int i1[16], i2[16];
#pragma unroll
        for (int a = 0; a < 16; ++a) { t1v[a] = ord_val(s1[a] & ~0x7fu); i1[a] = 127 - (int)(s1[a] & 0x7fu); t2v[a] = ord_val(s2[a] & ~0x7fu); i2[a] = 127 - (int)(s2[a] & 0x7fu); }
        unsigned ck[25]; int ce[25];
#pragma unroll
        for (int j = 0; j < 25; ++j) { constexpr int dummy = 0; (void)dummy;
            const int c0 = 2 * j, c1 = 2 * j + 1;
            const float v0 = t1v[cand_a(c0)] + t2v[cand_b(c0)], v1 = t1v[cand_a(c1)] + t2v[cand_b(c1)];
            const unsigned k0 = (ord_key(v0) & ~0xffu) | (unsigned)(255 - (cand_a(c0) * 16 + cand_b(c0))), k1 = (ord_key(v1) & ~0xffu) | (unsigned)(255 - (cand_a(c1) * 16 + cand_b(c1)));
            const int e0 = i1[cand_a(c0)] * 128 + i2[cand_b(c0)], e1 = i1[cand_a(c1)] * 128 + i2[cand_b(c1)];
            ck[j] = hi ? k1 : k0; ce[j] = hi ? e1 : e0; }
        unsigned gk[16]; int ge[16];
#pragma unroll
        for (int it = 0; it < 16; ++it) { unsigned m = ck[0];
#pragma unroll
            for (int j = 1; j < 25; j += 2) m = umax3(m, ck[j], ck[j + 1]);
            m = pair_max(m); gk[it] = m; int e = 0;
#pragma unroll
            for (int j = 0; j < 25; ++j) { const bool eq = ck[j] == m; e = eq ? ce[j] : e; ck[j] = eq ? 0u : ck[j]; }
            ge[it] = e; }
        float ev[16]; float l = 0.f; const float v0 = ord_val(gk[0] & ~0xffu);
#pragma unroll
        for (int it = 0; it < 16; ++it) { ge[it] = (int)pair_or((unsigned)ge[it]); ev[it] = __builtin_amdgcn_exp2f((ord_val(gk[it] & ~0xffu) - v0) * 1.4426950408889634f); l += ev[it]; }
        const float il = 1.0f / l;
        if (hi == 0) { int* ip = IDX + (size_t)tok * 128 + h * 16; float* gp = GATE + (size_t)tok * 128 + h * 16;
#pragma unroll
            for (int q = 0; q < 4; ++q) { *(GAS v4u*)(ip + 4 * q) = (v4u){(unsigned)ge[4 * q], (unsigned)ge[4 * q + 1], (unsigned)ge[4 * q + 2], (unsigned)ge[4 * q + 3]};
                *(GAS f32x4*)(gp + 4 * q) = (f32x4){ev[4 * q] * il, ev[4 * q + 1] * il, ev[4 * q + 2] * il, ev[4 * q + 3] * il}; } }
    }
}

__device__ __forceinline__ bf16x2_t asbf(unsigned u) { return __builtin_bit_cast(bf16x2_t, u); }
__device__ __forceinline__ float dot8(v4u a, v4u b, float c) {
    c = __builtin_amdgcn_fdot2_f32_bf16(asbf(a.x), asbf(b.x), c, false); c = __builtin_amdgcn_fdot2_f32_bf16(asbf(a.y), asbf(b.y), c, false);
    c = __builtin_amdgcn_fdot2_f32_bf16(asbf(a.z), asbf(b.z), c, false); c = __builtin_amdgcn_fdot2_f32_bf16(asbf(a.w), asbf(b.w), c, false); return c;
}
__device__ __forceinline__ void fmac_s(float& acc, float ws, float x) { asm("v_fmac_f32_e32 %0, %1, %2" : "+v"(acc) : "s"(ws), "v"(x)); }
__device__ __forceinline__ void axpy8(float (&acc)[8], v4u v, float w  ) {
    fmac_s(acc[0], w, __uint_as_float(v.x << 16)); fmac_s(acc[1], w, __uint_as_float(v.x & 0xffff0000u)); fmac_s(acc[2], w, __uint_as_float(v.y << 16)); fmac_s(acc[3], w, __uint_as_float(v.y & 0xffff0000u));
    fmac_s(acc[4], w, __uint_as_float(v.z << 16)); fmac_s(acc[5], w, __uint_as_float(v.z & 0xffff0000u)); fmac_s(acc[6], w, __uint_as_float(v.w << 16)); fmac_s(acc[7], w, __uint_as_float(v.w & 0xffff0000u));
}
constexpr float U8_SCALE = 256.f, V8_SCALE = 16.f;
typedef float f32x2c __attribute__((ext_vector_type(2)));
struct Row2 { v4u c[2]; };
__device__ __forceinline__ Row2 load_row8(const GAS unsigned char* base, unsigned e, unsigned lane16) { const GAS unsigned char* p = base + (size_t)e * 2048 + lane16; Row2 r; r.c[0] = *(const GAS v4u*)p; r.c[1] = *(const GAS v4u*)(p + 1024); return r; }
__device__ __forceinline__ float fma_s(float a, float b, float c) { float r; asm("v_fma_f32 %0, %1, %2, %3" : "=v"(r) : "v"(a), "v"(b), "v"(c)); return r; }
__device__ __forceinline__ float dot4_8(const float* a, unsigned w, float s) { const f32x2c lo = __builtin_amdgcn_cvt_pk_f32_fp8((int)w, false), hi = __builtin_amdgcn_cvt_pk_f32_fp8((int)w, true);
    s = fma_s(a[0], lo.x, s); s = fma_s(a[1], lo.y, s); s = fma_s(a[2], hi.x, s); s = fma_s(a[3], hi.y, s); return s; }
__device__ __forceinline__ void axpy4_8(float* acc, unsigned w, float ws) { const f32x2c lo = __builtin_amdgcn_cvt_pk_f32_fp8((int)w, false), hi = __builtin_amdgcn_cvt_pk_f32_fp8((int)w, true);
    fmac_s(acc[0], ws, lo.x); fmac_s(acc[1], ws, lo.y); fmac_s(acc[2], ws, hi.x); fmac_s(acc[3], ws, hi.y); }
template <bool DRY> __device__ __forceinline__ void gather_phase(const Args& A, Frame& F) {
    unsigned char* ws = A.ws;
    const GAS unsigned char* UB = (const GAS unsigned char*)(ws + WS_UB); const GAS unsigned char* VB = (const GAS unsigned char*)(ws + WS_VB);
    float* H1 = (float*)(ws + WS_H1); bf16* H1B = (bf16*)(ws + WS_H1B); const float* psh1 = (const float*)(ws + WS_PSH1); const int* IDX = (const int*)(ws + WS_IDX); const float* GATE = (const float*)(ws + WS_GATE); float* rsh2 = (float*)(ws + WS_RSH2);
    const int gw = F.vcu * NWAVES + F.wave, NGW = F.G * NWAVES;
    for (int tk = gw; tk < T_TOK; tk += NGW) {
        const int lane = lane_id(); const unsigned lane16 = (unsigned)lane * 16u; const int kq = (lane >> 2) & 15;
        const float rs = (1.0f / sqrtf(wave_sum64(psh1[(size_t)tk * 64 + lane]) * (1.f / 2048.f) + 1e-6f)) * (1.f / U8_SCALE);
        float af[32], acc[32];
#pragma unroll
        for (int j = 0; j < 2; ++j) { const v4u a0 = *(const GAS v4u*)(H1B + (size_t)tk * 2048 + 1024 * j + 16 * lane), a1 = *(const GAS v4u*)(H1B + (size_t)tk * 2048 + 1024 * j + 16 * lane + 8);
            const unsigned aw[8] = {a0.x, a0.y, a0.z, a0.w, a1.x, a1.y, a1.z, a1.w};
#pragma unroll
            for (int q = 0; q < 8; ++q) { af[16 * j + 2 * q] = __uint_as_float(aw[q] << 16); af[16 * j + 2 * q + 1] = __uint_as_float(aw[q] & 0xffff0000u); }
#pragma unroll
            for (int q = 0; q < 4; ++q) { const f32x4 x = *(const GAS f32x4*)(H1 + (size_t)tk * 2048 + 1024 * j + 16 * lane + 4 * q); acc[16 * j + 4 * q] = x[0]; acc[16 * j + 4 * q + 1] = x[1]; acc[16 * j + 4 * q + 2] = x[2]; acc[16 * j + 4 * q + 3] = x[3]; } }
        for (int hd = 0; hd < 8; ++hd) {
            const int ev = IDX[(size_t)tk * 128 + hd * 16 + kq]; const float gv = GATE[(size_t)tk * 128 + hd * 16 + kq];
            float p[16];
            Row2 bA[4], bB[4];
#define LD4(buf, base, k0) do { _Pragma("unroll") for (int q = 0; q < 4; ++q) buf[q] = load_row8(base, (unsigned)__builtin_amdgcn_readlane(ev, 4 * ((k0) + q)), lane16); } while (0)
#define DOT4(buf, k0) do { _Pragma("unroll") for (int q = 0; q < 4; ++q) { float s = 0.f; _Pragma("unroll") for (int j = 0; j < 2; ++j) { s = dot4_8(af + 16 * j, buf[q].c[j].x, s); s = dot4_8(af + 16 * j + 4, buf[q].c[j].y, s); s = dot4_8(af + 16 * j + 8, buf[q].c[j].z, s); s = dot4_8(af + 16 * j + 12, buf[q].c[j].w, s); } p[(k0) + q] = s; } } while (0)
#define AX4(buf, k0) do { _Pragma("unroll") for (int q = 0; q < 4; ++q) { const float wk = __uint_as_float((unsigned)__builtin_amdgcn_readlane((int)__float_as_uint(w), 4 * ((k0) + q))); _Pragma("unroll") for (int j = 0; j < 2; ++j) { axpy4_8(acc + 16 * j, buf[q].c[j].x, wk); axpy4_8(acc + 16 * j + 4, buf[q].c[j].y, wk); axpy4_8(acc + 16 * j + 8, buf[q].c[j].z, wk); axpy4_8(acc + 16 * j + 12, buf[q].c[j].w, wk); } } } while (0)
            LD4(bA, UB, 0); LD4(bB, UB, 4); SBAR(); DOT4(bA, 0); SBAR(); LD4(bA, UB, 8); SBAR(); DOT4(bB, 4); SBAR(); LD4(bB, UB, 12); SBAR(); DOT4(bA, 8); SBAR(); LD4(bA, VB, 0); SBAR(); DOT4(bB, 12); SBAR(); LD4(bB, VB, 4); SBAR();
            { const bool b5 = lane & 32, b4 = lane & 16, b3 = lane & 8, b2 = lane & 4; float q8[8], q4[4], q2[2], q1;
#pragma unroll
              for (int i = 0; i < 8; ++i) { const float keep = b5 ? p[i + 8] : p[i], send = b5 ? p[i] : p[i + 8]; q8[i] = keep + __shfl_xor(send, 32); }
#pragma unroll
              for (int i = 0; i < 4; ++i) { const float keep = b4 ? q8[i + 4] : q8[i], send = b4 ? q8[i] : q8[i + 4]; q4[i] = keep + __shfl_xor(send, 16); }
#pragma unroll
              for (int i = 0; i < 2; ++i) { const float keep = b3 ? q4[i + 2] : q4[i], send = b3 ? q4[i] : q4[i + 2]; q2[i] = keep + __shfl_xor(send, 8); }
              { const float keep = b2 ? q2[1] : q2[0], send = b2 ? q2[0] : q2[1]; q1 = keep + __shfl_xor(send, 4); }
              q1 += __shfl_xor(q1, 2); q1 += __shfl_xor(q1, 1); p[0] = q1; }
            const float w = gv * gelu_f(p[0] * rs) * (1.f / V8_SCALE);
            SBAR(); AX4(bA, 0); SBAR(); LD4(bA, VB, 8); SBAR(); AX4(bB, 4); SBAR(); LD4(bB, VB, 12); SBAR(); AX4(bA, 8); SBAR(); AX4(bB, 12); SBAR();
#undef LD4
#undef DOT4
#undef AX4
        }
        float ss = 0.f;
        float* H1o = DRY ? (float*)(ws + WS_NA0) + (size_t)(tk & 2047) * 2048 : H1 + (size_t)tk * 2048; bf16* H1Bo = DRY ? (bf16*)(ws + WS_NGL) + (size_t)(tk & 2047) * 2048 : H1B + (size_t)tk * 2048;
#pragma unroll
        for (int j = 0; j < 2; ++j) {
#pragma unroll
            for (int q = 0; q < 2; ++q) { const f32x4 y0 = {acc[16 * j + 8 * q], acc[16 * j + 8 * q + 1], acc[16 * j + 8 * q + 2], acc[16 * j + 8 * q + 3]}, y1 = {acc[16 * j + 8 * q + 4], acc[16 * j + 8 * q + 5], acc[16 * j + 8 * q + 6], acc[16 * j + 8 * q + 7]}; ss += sq8(y0, y1);
                *(GAS f32x4*)(H1o + 1024 * j + 16 * lane + 8 * q) = y0; *(GAS f32x4*)(H1o + 1024 * j + 16 * lane + 8 * q + 4) = y1; *(GAS v4u*)(H1Bo + 1024 * j + 16 * lane + 8 * q) = pack8(y0, y1); } }
        ss = wave_sum64(ss); if (lane == 0 && !DRY) rsh2[tk] = 1.0f / sqrtf(ss * (1.f / 2048.f) + 1e-6f);
    }
}
#ifndef NSLICE_SHIFT
#define NSLICE_SHIFT 9
#endif
__device__ __forceinline__ void tok_load(const unsigned char* ws, int tk, int lane, float (&af)[32], float (&acc)[32], float& rs, int (&ev)[2], float (&gv)[2]) {
    const float* H1 = (const float*)(ws + WS_H1); const bf16* H1B = (const bf16*)(ws + WS_H1B); const float* psh1 = (const float*)(ws + WS_PSH1); const int* IDX = (const int*)(ws + WS_IDX); const float* GATE = (const float*)(ws + WS_GATE);
    rs = (1.0f / sqrtf(wave_sum64(psh1[(size_t)tk * 64 + lane]) * (1.f / 2048.f) + 1e-6f)) * (1.f / U8_SCALE);
#pragma unroll
    for (int j = 0; j < 2; ++j) { const v4u a0 = *(const GAS v4u*)(H1B + (size_t)tk * 2048 + 1024 * j + 16 * lane), a1 = *(const GAS v4u*)(H1B + (size_t)tk * 2048 + 1024 * j + 16 * lane + 8);
        const unsigned aw[8] = {a0.x, a0.y, a0.z, a0.w, a1.x, a1.y, a1.z, a1.w};
#pragma unroll
        for (int q = 0; q < 8; ++q) { af[16 * j + 2 * q] = __uint_as_float(aw[q] << 16); af[16 * j + 2 * q + 1] = __uint_as_float(aw[q] & 0xffff0000u); }
#pragma unroll
        for (int q = 0; q < 4; ++q) { const f32x4 x = *(const GAS f32x4*)(H1 + (size_t)tk * 2048 + 1024 * j + 16 * lane + 4 * q); acc[16 * j + 4 * q] = x[0]; acc[16 * j + 4 * q + 1] = x[1]; acc[16 * j + 4 * q + 2] = x[2]; acc[16 * j + 4 * q + 3] = x[3]; } }
    ev[0] = IDX[(size_t)tk * 128 + lane]; ev[1] = IDX[(size_t)tk * 128 + 64 + lane]; gv[0] = GATE[(size_t)tk * 128 + lane]; gv[1] = GATE[(size_t)tk * 128 + 64 + lane];
}
template <bool DRY> __device__ __forceinline__ void tok_store(unsigned char* ws, int tk, int lane, const float (&acc)[32]) {
    float* H1 = (float*)(ws + WS_H1); bf16* H1B = (bf16*)(ws + WS_H1B); float* rsh2 = (float*)(ws + WS_RSH2);
    float ss = 0.f;
    float* H1o = DRY ? (float*)(ws + WS_NA0) + (size_t)(tk & 2047) * 2048 : H1 + (size_t)tk * 2048; bf16* H1Bo = DRY ? (bf16*)(ws + WS_NGL) + (size_t)(tk & 2047) * 2048 : H1B + (size_t)tk * 2048;
#pragma unroll
    for (int j = 0; j < 2; ++j) {
#pragma unroll
        for (int q = 0; q < 2; ++q) { const f32x4 y0 = {acc[16 * j + 8 * q], acc[16 * j + 8 * q + 1], acc[16 * j + 8 * q + 2], acc[16 * j + 8 * q + 3]}, y1 = {acc[16 * j + 8 * q + 4], acc[16 * j + 8 * q + 5], acc[16 * j + 8 * q + 6], acc[16 * j + 8 * q + 7]}; ss += sq8(y0, y1);
            *(GAS f32x4*)(H1o + 1024 * j + 16 * lane + 8 * q) = y0; *(GAS f32x4*)(H1o + 1024 * j + 16 * lane + 8 * q + 4) = y1; *(GAS v4u*)(H1Bo + 1024 * j + 16 * lane + 8 * q) = pack8(y0, y1); } }
    ss = wave_sum64(ss); if (lane == 0 && !DRY) rsh2[tk] = 1.0f / sqrtf(ss * (1.f / 2048.f) + 1e-6f);
}
__device__ __forceinline__ float dot_row8(const float (&af)[32], const Row2& r) { float s = 0.f;
#pragma unroll
    for (int j = 0; j < 2; ++j) { s = dot4_8(af + 16 * j, r.c[j].x, s); s = dot4_8(af + 16 * j + 4, r.c[j].y, s); s = dot4_8(af + 16 * j + 8, r.c[j].z, s); s = dot4_8(af + 16 * j + 12, r.c[j].w, s); }
    return s; }
__device__ __forceinline__ void axpy_row8(float (&acc)[32], const Row2& r, float wk) {
#pragma unroll
    for (int j = 0; j < 2; ++j) { axpy4_8(acc + 16 * j, r.c[j].x, wk); axpy4_8(acc + 16 * j + 4, r.c[j].y, wk); axpy4_8(acc + 16 * j + 8, r.c[j].z, wk); axpy4_8(acc + 16 * j + 12, r.c[j].w, wk); } }
__device__ __forceinline__ void tok_slice(const GAS unsigned char* UB, const GAS unsigned char* VB, int s, int lane, unsigned lane16, const float (&af)[32], float (&acc)[32], float rs, const int (&ev)[2], const float (&gv)[2]) {
    unsigned long long m0 = __ballot((ev[0] >> NSLICE_SHIFT) == s), m1 = __ballot((ev[1] >> NSLICE_SHIFT) == s);
    while (m0 | m1) {
        int e0, e1; float g0, g1;
        if (m0) { const int i = __builtin_ctzll(m0); m0 &= m0 - 1; e0 = __builtin_amdgcn_readlane(ev[0], i); g0 = __uint_as_float((unsigned)__builtin_amdgcn_readlane((int)__float_as_uint(gv[0]), i)); }
        else { const int i = __builtin_ctzll(m1); m1 &= m1 - 1; e0 = __builtin_amdgcn_readlane(ev[1], i); g0 = __uint_as_float((unsigned)__builtin_amdgcn_readlane((int)__float_as_uint(gv[1]), i)); }
        if (m0) { const int i = __builtin_ctzll(m0); m0 &= m0 - 1; e1 = __builtin_amdgcn_readlane(ev[0], i); g1 = __uint_as_float((unsigned)__builtin_amdgcn_readlane((int)__float_as_uint(gv[0]), i)); }
        else if (m1) { const int i = __builtin_ctzll(m1); m1 &= m1 - 1; e1 = __builtin_amdgcn_readlane(ev[1], i); g1 = __uint_as_float((unsigned)__builtin_amdgcn_readlane((int)__float_as_uint(gv[1]), i)); }
        else { e1 = e0; g1 = 0.f; }
        const Row2 u0 = load_row8(UB, (unsigned)e0, lane16), u1 = load_row8(UB, (unsigned)e1, lane16), v0 = load_row8(VB, (unsigned)e0, lane16), v1 = load_row8(VB, (unsigned)e1, lane16);
        const float p0 = dot_row8(af, u0), p1 = dot_row8(af, u1);
        const bool b5 = lane & 32; float h = (b5 ? p1 : p0) + __shfl_xor(b5 ? p0 : p1, 32);
        h += __shfl_xor(h, 16); h += __shfl_xor(h, 8); h += __shfl_xor(h, 4); h += __shfl_xor(h, 2); h += __shfl_xor(h, 1);
        const float w = (b5 ? g1 : g0) * gelu_f(h * rs) * (1.f / V8_SCALE);
        const float w0 = __uint_as_float((unsigned)__builtin_amdgcn_readlane((int)__float_as_uint(w), 0)), w1 = __uint_as_float((unsigned)__builtin_amdgcn_readlane((int)__float_as_uint(w), 32));
        axpy_row8(acc, v0, w0); axpy_row8(acc, v1, w1);
    }
}
template <bool DRY> __device__ __forceinline__ void gather_sliced_phase(const Args& A, Frame& F) {
    unsigned char* ws = A.ws;
    const GAS unsigned char* UB = (const GAS unsigned char*)(ws + WS_UB); const GAS unsigned char* VB = (const GAS unsigned char*)(ws + WS_VB);
    const int gw = F.vcu * NWAVES + F.wave, NGW = F.G * NWAVES;
    for (int tk0 = 2 * gw; tk0 < T_TOK; tk0 += 2 * NGW) {
        const int lane = lane_id(); const unsigned lane16 = (unsigned)lane * 16u;
        float afA[32], accA[32], afB[32], accB[32], rsA, rsB; int evA[2], evB[2]; float gvA[2], gvB[2];
        tok_load(ws, tk0, lane, afA, accA, rsA, evA, gvA); tok_load(ws, tk0 + 1, lane, afB, accB, rsB, evB, gvB);
        for (int s = 0; s < (16384 >> NSLICE_SHIFT); ++s) { tok_slice(UB, VB, s, lane, lane16, afA, accA, rsA, evA, gvA); tok_slice(UB, VB, s, lane, lane16, afB, accB, rsB, evB, gvB); }
        tok_store<DRY>(ws, tk0, lane, accA); tok_store<DRY>(ws, tk0 + 1, lane, accB);
    }
}
#ifndef PROBE_NOV
#define PROBE_NOV 0
#endif
struct Tok2 { f32x2c af[16], acc[16]; float rs; int ev[2]; float gv[2]; };
__device__ __forceinline__ void tok2_load(const unsigned char* ws, int tk, int lane, Tok2& T) {
    const float* H1 = (const float*)(ws + WS_H1); const bf16* H1B = (const bf16*)(ws + WS_H1B); const float* psh1 = (const float*)(ws + WS_PSH1); const int* IDX = (const int*)(ws + WS_IDX); const float* GATE = (const float*)(ws + WS_GATE);
    T.rs = (1.0f / sqrtf(wave_sum64(psh1[(size_t)tk * 64 + lane]) * (1.f / 2048.f) + 1e-6f)) * (1.f / U8_SCALE);
#pragma unroll
    for (int j = 0; j < 2; ++j) { const v4u a0 = *(const GAS v4u*)(H1B + (size_t)tk * 2048 + 1024 * j + 16 * lane), a1 = *(const GAS v4u*)(H1B + (size_t)tk * 2048 + 1024 * j + 16 * lane + 8);
        const unsigned aw[8] = {a0.x, a0.y, a0.z, a0.w, a1.x, a1.y, a1.z, a1.w};
#pragma unroll
        for (int q = 0; q < 8; ++q) T.af[8 * j + q] = (f32x2c){__uint_as_float(aw[q] << 16), __uint_as_float(aw[q] & 0xffff0000u)};
#pragma unroll
        for (int q = 0; q < 4; ++q) { const f32x4 x = *(const GAS f32x4*)(H1 + (size_t)tk * 2048 + 1024 * j + 16 * lane + 4 * q); T.acc[8 * j + 2 * q] = (f32x2c){x[0], x[1]}; T.acc[8 * j + 2 * q + 1] = (f32x2c){x[2], x[3]}; } }
    T.ev[0] = IDX[(size_t)tk * 128 + lane]; T.ev[1] = IDX[(size_t)tk * 128 + 64 + lane]; T.gv[0] = GATE[(size_t)tk * 128 + lane]; T.gv[1] = GATE[(size_t)tk * 128 + 64 + lane];
}
template <bool DRY> __device__ __forceinline__ void tok2_store(unsigned char* ws, int tk, int lane_, const Tok2& T) {
    const int lane = lane_id(); (void)lane_;
    float* H1 = (float*)(ws + WS_H1); bf16* H1B = (bf16*)(ws + WS_H1B); float* rsh2 = (float*)(ws + WS_RSH2);
    float ss = 0.f;
    float* H1o = DRY ? (float*)(ws + WS_NA0) + (size_t)(tk & 2047) * 2048 : H1 + (size_t)tk * 2048; bf16* H1Bo = DRY ? (bf16*)(ws + WS_NGL) + (size_t)(tk & 2047) * 2048 : H1B + (size_t)tk * 2048;
#pragma unroll
    for (int j = 0; j < 2; ++j) {
#pragma unroll
        for (int q = 0; q < 2; ++q) { const f32x4 y0 = {T.acc[8 * j + 4 * q].x, T.acc[8 * j + 4 * q].y, T.acc[8 * j + 4 * q + 1].x, T.acc[8 * j + 4 * q + 1].y}, y1 = {T.acc[8 * j + 4 * q + 2].x, T.acc[8 * j + 4 * q + 2].y, T.acc[8 * j + 4 * q + 3].x, T.acc[8 * j + 4 * q + 3].y}; ss += sq8(y0, y1);
            *(GAS f32x4*)(H1o + 1024 * j + 16 * lane + 8 * q) = y0; *(GAS f32x4*)(H1o + 1024 * j + 16 * lane + 8 * q + 4) = y1; *(GAS v4u*)(H1Bo + 1024 * j + 16 * lane + 8 * q) = pack8(y0, y1); } }
    ss = wave_sum64(ss); if (lane == 0 && !DRY) rsh2[tk] = 1.0f / sqrtf(ss * (1.f / 2048.f) + 1e-6f);
}
__device__ __forceinline__ float dot_row8p(const Tok2& T, const Row2& r) { f32x2c s0 = {0.f, 0.f}, s1 = {0.f, 0.f}, s2 = {0.f, 0.f}, s3 = {0.f, 0.f};
#pragma unroll
    for (int j = 0; j < 2; ++j) { const unsigned w[4] = {r.c[j].x, r.c[j].y, r.c[j].z, r.c[j].w};
#pragma unroll
        for (int d = 0; d < 4; ++d) { const f32x2c lo = __builtin_amdgcn_cvt_pk_f32_fp8((int)w[d], false), hi = __builtin_amdgcn_cvt_pk_f32_fp8((int)w[d], true);
            if (j == 0) { s0 = __builtin_elementwise_fma(T.af[2 * d], lo, s0); s1 = __builtin_elementwise_fma(T.af[2 * d + 1], hi, s1); }
            else { s2 = __builtin_elementwise_fma(T.af[8 + 2 * d], lo, s2); s3 = __builtin_elementwise_fma(T.af[8 + 2 * d + 1], hi, s3); } } }
    const f32x2c t = (s0 + s1) + (s2 + s3); return t.x + t.y; }
__device__ __forceinline__ void axpy_row8p(Tok2& T, const Row2& r, float wk) { const f32x2c w2 = {wk, wk};
#pragma unroll
    for (int j = 0; j < 2; ++j) { const unsigned w[4] = {r.c[j].x, r.c[j].y, r.c[j].z, r.c[j].w};
#pragma unroll
        for (int d = 0; d < 4; ++d) { const f32x2c lo = __builtin_amdgcn_cvt_pk_f32_fp8((int)w[d], false), hi = __builtin_amdgcn_cvt_pk_f32_fp8((int)w[d], true);
            T.acc[8 * j + 2 * d] = __builtin_elementwise_fma(w2, lo, T.acc[8 * j + 2 * d]); T.acc[8 * j + 2 * d + 1] = __builtin_elementwise_fma(w2, hi, T.acc[8 * j + 2 * d + 1]); } } }
__device__ __forceinline__ float dpp_add(float v, const int ctrl, const int rmask) { return v; }
#define DPP_ADD(v, ctrl, rmask) v += __uint_as_float((unsigned)__builtin_amdgcn_update_dpp(0, (int)__float_as_uint(v), ctrl, rmask, 0xF, true))
__device__ __forceinline__ float reduce2(float p0, float p1) {
    auto rr = __builtin_amdgcn_permlane32_swap(__float_as_uint(p0), __float_as_uint(p1), false, false);
    float h = __uint_as_float(rr[0]) + __uint_as_float(rr[1]);
    DPP_ADD(h, 0xB1, 0xF); DPP_ADD(h, 0x4E, 0xF); DPP_ADD(h, 0x141, 0xF); DPP_ADD(h, 0x140, 0xF); DPP_ADD(h, 0x142, 0xA);
    return h; }
__device__ __forceinline__ int take2(unsigned long long& m0, unsigned long long& m1, const Tok2& T, int& e0, float& g0, int& e1, float& g1) {
    if (!(m0 | m1)) return 0;
    if (m0) { const int i = __builtin_ctzll(m0); m0 &= m0 - 1; e0 = __builtin_amdgcn_readlane(T.ev[0], i); g0 = __uint_as_float((unsigned)__builtin_amdgcn_readlane((int)__float_as_uint(T.gv[0]), i)); }
    else { const int i = __builtin_ctzll(m1); m1 &= m1 - 1; e0 = __builtin_amdgcn_readlane(T.ev[1], i); g0 = __uint_as_float((unsigned)__builtin_amdgcn_readlane((int)__float_as_uint(T.gv[1]), i)); }
    if (m0) { const int i = __builtin_ctzll(m0); m0 &= m0 - 1; e1 = __builtin_amdgcn_readlane(T.ev[0], i); g1 = __uint_as_float((unsigned)__builtin_amdgcn_readlane((int)__float_as_uint(T.gv[0]), i)); return 2; }
    if (m1) { const int i = __builtin_ctzll(m1); m1 &= m1 - 1; e1 = __builtin_amdgcn_readlane(T.ev[1], i); g1 = __uint_as_float((unsigned)__builtin_amdgcn_readlane((int)__float_as_uint(T.gv[1]), i)); return 2; }
    e1 = e0; g1 = 0.f; return 1;
}
__device__ __forceinline__ void batch2(Tok2& T, const Row2& u0, const Row2& u1, const Row2& v0, const Row2& v1, float g0, float g1, int lane) {
    const float h = reduce2(dot_row8p(T, u0), dot_row8p(T, u1));
    const float w = ((lane & 32) ? g1 : g0) * gelu_f(h * T.rs) * (1.f / V8_SCALE);
    const float w0 = __uint_as_float((unsigned)__builtin_amdgcn_readlane((int)__float_as_uint(w), 31)), w1 = __uint_as_float((unsigned)__builtin_amdgcn_readlane((int)__float_as_uint(w), 63));
    axpy_row8p(T, v0, w0); axpy_row8p(T, v1, w1);
}
#ifndef GATHER_PREFETCH
#define GATHER_PREFETCH 0
#endif
constexpr int SLICE_EXPERTS = 1 << NSLICE_SHIFT, SLICE_SHARE = 2048;
static_assert(NSLICE_SHIFT != 8 || SLICE_EXPERTS * 2048 / 256 == SLICE_SHARE, "prefetch share");
__device__ __forceinline__ unsigned slice_prefetch(const GAS unsigned char* UB, const GAS unsigned char* VB, int snext, unsigned wx) {
    const GAS unsigned char* pu = UB + (size_t)snext * (SLICE_EXPERTS * 2048) + (size_t)wx * SLICE_SHARE; const GAS unsigned char* pv = VB + (size_t)snext * (SLICE_EXPERTS * 2048) + (size_t)wx * SLICE_SHARE;
    unsigned d;
    asm volatile("s_load_dword %0, %1, 0x0\n\ts_load_dword %0, %1, 0x80\n\ts_load_dword %0, %1, 0x100\n\ts_load_dword %0, %1, 0x180\n\ts_load_dword %0, %1, 0x200\n\ts_load_dword %0, %1, 0x280\n\ts_load_dword %0, %1, 0x300\n\ts_load_dword %0, %1, 0x380\n\ts_load_dword %0, %1, 0x400\n\ts_load_dword %0, %1, 0x480\n\ts_load_dword %0, %1, 0x500\n\ts_load_dword %0, %1, 0x580\n\ts_load_dword %0, %1, 0x600\n\ts_load_dword %0, %1, 0x680\n\ts_load_dword %0, %1, 0x700\n\ts_load_dword %0, %1, 0x780\n\ts_load_dword %0, %2, 0x0\n\ts_load_dword %0, %2, 0x80\n\ts_load_dword %0, %2, 0x100\n\ts_load_dword %0, %2, 0x180\n\ts_load_dword %0, %2, 0x200\n\ts_load_dword %0, %2, 0x280\n\ts_load_dword %0, %2, 0x300\n\ts_load_dword %0, %2, 0x380\n\ts_load_dword %0, %2, 0x400\n\ts_load_dword %0, %2, 0x480\n\ts_load_dword %0, %2, 0x500\n\ts_load_dword %0, %2, 0x580\n\ts_load_dword %0, %2, 0x600\n\ts_load_dword %0, %2, 0x680\n\ts_load_dword %0, %2, 0x700\n\ts_load_dword %0, %2, 0x780\n\ts_nop 0" : "=&s"(d) : "s"(pu), "s"(pv));
    return d;
}
__device__ __forceinline__ void slice_prefetch_done(unsigned& d) { asm volatile("s_waitcnt lgkmcnt(0)" : "+s"(d)); }
template <bool DRY> __device__ __forceinline__ void gather_sliced2_phase(const Args& A, Frame& F) {
    unsigned char* ws = A.ws;
    const GAS unsigned char* UB = (const GAS unsigned char*)(ws + WS_UB); const GAS unsigned char* VB = (const GAS unsigned char*)(ws + WS_VB);
    const int gw = F.vcu * NWAVES + F.wave, NGW = F.G * NWAVES;
    for (int tk0 = 2 * gw; tk0 < T_TOK; tk0 += 2 * NGW) {
        const int lane = lane_id(); const unsigned lane16 = (unsigned)lane * 16u;
        Tok2 TA, TB; tok2_load(ws, tk0, lane, TA); tok2_load(ws, tk0 + 1, lane, TB);
        const unsigned wx = (unsigned)((F.vcu & 31) * NWAVES + F.wave);
        for (int s = 0; s < (16384 >> NSLICE_SHIFT); ++s) {
            unsigned pf_d = 0u; if (GATHER_PREFETCH && NSLICE_SHIFT == 8) pf_d = slice_prefetch(UB, VB, (s + 1) & ((16384 >> NSLICE_SHIFT) - 1), wx);
            unsigned long long a0 = __ballot((TA.ev[0] >> NSLICE_SHIFT) == s), a1 = __ballot((TA.ev[1] >> NSLICE_SHIFT) == s), b0 = __ballot((TB.ev[0] >> NSLICE_SHIFT) == s), b1 = __ballot((TB.ev[1] >> NSLICE_SHIFT) == s);
            while (a0 | a1 | b0 | b1) {
                int eA0 = 0, eA1 = 0, eB0 = 0, eB1 = 0; float gA0 = 0.f, gA1 = 0.f, gB0 = 0.f, gB1 = 0.f;
                const int nA = take2(a0, a1, TA, eA0, gA0, eA1, gA1), nB = take2(b0, b1, TB, eB0, gB0, eB1, gB1);
                if (DRY && PROBE_NOV == 4) { eA0 &= 255; eA1 &= 255; eB0 &= 255; eB1 &= 255; } if (DRY && PROBE_NOV == 5) { eA0 &= 3; eA1 &= 3; eB0 &= 3; eB1 &= 3; }
                Row2 uA0, uA1, vA0, vA1, uB0, uB1, vB0, vB1;
                if (DRY && PROBE_NOV == 2) { uA0.c[0] = uA0.c[1] = (v4u){(unsigned)eA0, (unsigned)lane, 0x38383838u, 0x3c3c3c3cu}; uA1 = uA0; vA0 = uA0; vA1 = uA0; uB0 = uA0; uB1 = uA0; vB0 = uA0; vB1 = uA0; } else
                if (nA) { uA0 = load_row8(UB, (unsigned)eA0, lane16); uA1 = load_row8(UB, (unsigned)eA1, lane16); if (DRY && PROBE_NOV) { vA0 = uA0; vA1 = uA1; } else { vA0 = load_row8(VB, (unsigned)eA0, lane16); vA1 = load_row8(VB, (unsigned)eA1, lane16); } }
                if (!(DRY && PROBE_NOV == 2)) if (nB) { uB0 = load_row8(UB, (unsigned)eB0, lane16); uB1 = load_row8(UB, (unsigned)eB1, lane16); if (DRY && PROBE_NOV) { vB0 = uB0; vB1 = uB1; } else { vB0 = load_row8(VB, (unsigned)eB0, lane16); vB1 = load_row8(VB, (unsigned)eB1, lane16); } }
                if (DRY && PROBE_NOV == 3) { unsigned x = 0;
                    if (nA) x ^= uA0.c[0].x ^ uA0.c[0].w ^ uA0.c[1].y ^ uA1.c[0].x ^ uA1.c[1].w ^ vA0.c[0].x ^ vA0.c[1].w ^ vA1.c[0].y ^ vA1.c[1].z ^ uA0.c[0].y ^ uA0.c[0].z ^ uA0.c[1].x ^ uA0.c[1].z ^ uA0.c[1].w ^ uA1.c[0].y ^ uA1.c[0].z ^ uA1.c[0].w ^ uA1.c[1].x ^ uA1.c[1].y ^ uA1.c[1].z ^ vA0.c[0].y ^ vA0.c[0].z ^ vA0.c[0].w ^ vA0.c[1].x ^ vA0.c[1].y ^ vA0.c[1].z ^ vA1.c[0].x ^ vA1.c[0].z ^ vA1.c[0].w ^ vA1.c[1].x ^ vA1.c[1].y ^ vA1.c[1].w;
                    if (nB) x ^= uB0.c[0].x ^ uB0.c[0].w ^ uB0.c[1].y ^ uB1.c[0].x ^ uB1.c[1].w ^ vB0.c[0].x ^ vB0.c[1].w ^ vB1.c[0].y ^ vB1.c[1].z ^ uB0.c[0].y ^ uB0.c[0].z ^ uB0.c[1].x ^ uB0.c[1].z ^ uB0.c[1].w ^ uB1.c[0].y ^ uB1.c[0].z ^ uB1.c[0].w ^ uB1.c[1].x ^ uB1.c[1].y ^ uB1.c[1].z ^ vB0.c[0].y ^ vB0.c[0].z ^ vB0.c[0].w ^ vB0.c[1].x ^ vB0.c[1].y ^ vB0.c[1].z ^ vB1.c[0].x ^ vB1.c[0].z ^ vB1.c[0].w ^ vB1.c[1].x ^ vB1.c[1].y ^ vB1.c[1].w;
                    TA.acc[0].x += __uint_as_float(x & 1u); } else {
                if (nA) batch2(TA, uA0, uA1, vA0, vA1, gA0, gA1, lane);
                if (nB) batch2(TB, uB0, uB1, vB0, vB1, gB0, gB1, lane); }
            }
            if (GATHER_PREFETCH && NSLICE_SHIFT == 8) slice_prefetch_done(pf_d);
        }
        tok2_store<DRY>(ws, tk0, lane, TA); tok2_store<DRY>(ws, tk0 + 1, lane, TB);
    }
}
struct Acc2 { f32x2c acc[16]; float rs; int ev[2]; float gv[2]; };
struct It8 { int nA, nB; float gA0, gA1, gB0, gB1; Row2 uA0, uA1, vA0, vA1, uB0, uB1, vB0, vB1; };
__device__ __forceinline__ void tok3_load(const unsigned char* ws, int tk, int lane, Acc2& T, LAS unsigned char* afl  ) {
    const float* H1 = (const float*)(ws + WS_H1); const bf16* H1B = (const bf16*)(ws + WS_H1B); const float* psh1 = (const float*)(ws + WS_PSH1); const int* IDX = (const int*)(ws + WS_IDX); const float* GATE = (const float*)(ws + WS_GATE);
    T.rs = (1.0f / sqrtf(wave_sum64(psh1[(size_t)tk * 64 + lane]) * (1.f / 2048.f) + 1e-6f)) * (1.f / U8_SCALE);
#pragma unroll
    for (int j = 0; j < 2; ++j) { const v4u a0 = *(const GAS v4u*)(H1B + (size_t)tk * 2048 + 1024 * j + 16 * lane), a1 = *(const GAS v4u*)(H1B + (size_t)tk * 2048 + 1024 * j + 16 * lane + 8);
        const unsigned aw[8] = {a0.x, a0.y, a0.z, a0.w, a1.x, a1.y, a1.z, a1.w};
#pragma unroll
        for (int d = 0; d < 4; ++d) *(LAS f32x4*)(afl + (4 * j + d) * 1024 + lane * 16) = (f32x4){__uint_as_float(aw[2 * d] << 16), __uint_as_float(aw[2 * d] & 0xffff0000u), __uint_as_float(aw[2 * d + 1] << 16), __uint_as_float(aw[2 * d + 1] & 0xffff0000u)};
#pragma unroll
        for (int q = 0; q < 4; ++q) { const f32x4 x = *(const GAS f32x4*)(H1 + (size_t)tk * 2048 + 1024 * j + 16 * lane + 4 * q); T.acc[8 * j + 2 * q] = (f32x2c){x[0], x[1]}; T.acc[8 * j + 2 * q + 1] = (f32x2c){x[2], x[3]}; } }
    T.ev[0] = IDX[(size_t)tk * 128 + lane]; T.ev[1] = IDX[(size_t)tk * 128 + 64 + lane]; T.gv[0] = GATE[(size_t)tk * 128 + lane]; T.gv[1] = GATE[(size_t)tk * 128 + 64 + lane];
}
template <bool DRY> __device__ __forceinline__ void tok3_store(unsigned char* ws, int tk, int lane, const Acc2& T) {
    float* H1 = (float*)(ws + WS_H1); bf16* H1B = (bf16*)(ws + WS_H1B); float* rsh2 = (float*)(ws + WS_RSH2);
    float ss = 0.f;
    float* H1o = DRY ? (float*)(ws + WS_NA0) + (size_t)(tk & 2047) * 2048 : H1 + (size_t)tk * 2048; bf16* H1Bo = DRY ? (bf16*)(ws + WS_NGL) + (size_t)(tk & 2047) * 2048 : H1B + (size_t)tk * 2048;
#pragma unroll
    for (int j = 0; j < 2; ++j) {
#pragma unroll
        for (int q = 0; q < 2; ++q) { const f32x4 y0 = {T.acc[8 * j + 4 * q].x, T.acc[8 * j + 4 * q].y, T.acc[8 * j + 4 * q + 1].x, T.acc[8 * j + 4 * q + 1].y}, y1 = {T.acc[8 * j + 4 * q + 2].x, T.acc[8 * j + 4 * q + 2].y, T.acc[8 * j + 4 * q + 3].x, T.acc[8 * j + 4 * q + 3].y}; ss += sq8(y0, y1);
            *(GAS f32x4*)(H1o + 1024 * j + 16 * lane + 8 * q) = y0; *(GAS f32x4*)(H1o + 1024 * j + 16 * lane + 8 * q + 4) = y1; *(GAS v4u*)(H1Bo + 1024 * j + 16 * lane + 8 * q) = pack8(y0, y1); } }
    ss = wave_sum64(ss); if (lane == 0 && !DRY) rsh2[tk] = 1.0f / sqrtf(ss * (1.f / 2048.f) + 1e-6f);
}
__device__ __forceinline__ void batch3(Acc2& T, const LAS unsigned char* afl, const Row2& u0, const Row2& u1, const Row2& v0, const Row2& v1, float g0, float g1, int lane) {
    f32x2c s0 = {0.f, 0.f}, s1 = {0.f, 0.f}, t0 = {0.f, 0.f}, t1 = {0.f, 0.f};
    f32x4 aa[8];
#pragma unroll
    for (int c = 0; c < 8; ++c) aa[c] = *(const LAS f32x4*)(afl + c * 1024 + lane * 16);
    asm volatile("s_waitcnt lgkmcnt(0)" : "+v"(aa[0]), "+v"(aa[1]), "+v"(aa[2]), "+v"(aa[3]), "+v"(aa[4]), "+v"(aa[5]), "+v"(aa[6]), "+v"(aa[7]));
#pragma unroll
    for (int j = 0; j < 2; ++j) { const unsigned w0[4] = {u0.c[j].x, u0.c[j].y, u0.c[j].z, u0.c[j].w}, w1[4] = {u1.c[j].x, u1.c[j].y, u1.c[j].z, u1.c[j].w};
#pragma unroll
        for (int d = 0; d < 4; ++d) { const f32x4 a = aa[4 * j + d]; const f32x2c alo = {a[0], a[1]}, ahi = {a[2], a[3]};
            s0 = __builtin_elementwise_fma(alo, __builtin_amdgcn_cvt_pk_f32_fp8((int)w0[d], false), s0); s1 = __builtin_elementwise_fma(ahi, __builtin_amdgcn_cvt_pk_f32_fp8((int)w0[d], true), s1);
            t0 = __builtin_elementwise_fma(alo, __builtin_amdgcn_cvt_pk_f32_fp8((int)w1[d], false), t0); t1 = __builtin_elementwise_fma(ahi, __builtin_amdgcn_cvt_pk_f32_fp8((int)w1[d], true), t1); } }
    const f32x2c ps = s0 + s1, pt = t0 + t1;
    const float h = reduce2(ps.x + ps.y, pt.x + pt.y);
    const float w = ((lane & 32) ? g1 : g0) * gelu_f(h * T.rs) * (1.f / V8_SCALE);
    const float wa = __uint_as_float((unsigned)__builtin_amdgcn_readlane((int)__float_as_uint(w), 31)), wb = __uint_as_float((unsigned)__builtin_amdgcn_readlane((int)__float_as_uint(w), 63));
    const f32x2c wa2 = {wa, wa}, wb2 = {wb, wb};
#pragma unroll
    for (int j = 0; j < 2; ++j) { const unsigned w0[4] = {v0.c[j].x, v0.c[j].y, v0.c[j].z, v0.c[j].w}, w1[4] = {v1.c[j].x, v1.c[j].y, v1.c[j].z, v1.c[j].w};
#pragma unroll
        for (int d = 0; d < 4; ++d) {
            T.acc[8 * j + 2 * d] = __builtin_elementwise_fma(wa2, __builtin_amdgcn_cvt_pk_f32_fp8((int)w0[d], false), T.acc[8 * j + 2 * d]); T.acc[8 * j + 2 * d + 1] = __builtin_elementwise_fma(wa2, __builtin_amdgcn_cvt_pk_f32_fp8((int)w0[d], true), T.acc[8 * j + 2 * d + 1]);
            T.acc[8 * j + 2 * d] = __builtin_elementwise_fma(wb2, __builtin_amdgcn_cvt_pk_f32_fp8((int)w1[d], false), T.acc[8 * j + 2 * d]); T.acc[8 * j + 2 * d + 1] = __builtin_elementwise_fma(wb2, __builtin_amdgcn_cvt_pk_f32_fp8((int)w1[d], true), T.acc[8 * j + 2 * d + 1]); } }
}
struct Sweep { int s; unsigned long long a0, a1, b0, b1; };
__device__ __forceinline__ int take2b(unsigned long long& m0, unsigned long long& m1, const int (&ev)[2], const float (&gv)[2], int& e0, float& g0, int& e1, float& g1) {
    if (!(m0 | m1)) return 0;
    if (m0) { const int i = __builtin_ctzll(m0); m0 &= m0 - 1; e0 = __builtin_amdgcn_readlane(ev[0], i); g0 = __uint_as_float((unsigned)__builtin_amdgcn_readlane((int)__float_as_uint(gv[0]), i)); }
    else { const int i = __builtin_ctzll(m1); m1 &= m1 - 1; e0 = __builtin_amdgcn_readlane(ev[1], i); g0 = __uint_as_float((unsigned)__builtin_amdgcn_readlane((int)__float_as_uint(gv[1]), i)); }
    if (m0) { const int i = __builtin_ctzll(m0); m0 &= m0 - 1; e1 = __builtin_amdgcn_readlane(ev[0], i); g1 = __uint_as_float((unsigned)__builtin_amdgcn_readlane((int)__float_as_uint(gv[0]), i)); return 2; }
    if (m1) { const int i = __builtin_ctzll(m1); m1 &= m1 - 1; e1 = __builtin_amdgcn_readlane(ev[1], i); g1 = __uint_as_float((unsigned)__builtin_amdgcn_readlane((int)__float_as_uint(gv[1]), i)); return 2; }
    e1 = e0; g1 = 0.f; return 1;
}
__device__ __forceinline__ void gen_load(Sweep& W, const Acc2& TA, const Acc2& TB, const GAS unsigned char* UB, const GAS unsigned char* VB, unsigned lane16, It8& I) {
    while (!(W.a0 | W.a1 | W.b0 | W.b1) && W.s + 1 < (16384 >> NSLICE_SHIFT)) { ++W.s;
        W.a0 = __ballot((TA.ev[0] >> NSLICE_SHIFT) == W.s); W.a1 = __ballot((TA.ev[1] >> NSLICE_SHIFT) == W.s); W.b0 = __ballot((TB.ev[0] >> NSLICE_SHIFT) == W.s); W.b1 = __ballot((TB.ev[1] >> NSLICE_SHIFT) == W.s); }
    int eA0 = 0, eA1 = 0, eB0 = 0, eB1 = 0; I.gA0 = 0.f; I.gA1 = 0.f; I.gB0 = 0.f; I.gB1 = 0.f;
    I.nA = take2b(W.a0, W.a1, TA.ev, TA.gv, eA0, I.gA0, eA1, I.gA1); I.nB = take2b(W.b0, W.b1, TB.ev, TB.gv, eB0, I.gB0, eB1, I.gB1);
    if (!I.nA) { eA0 = eB0; eA1 = eB1; } if (!I.nB) { eB0 = eA0; eB1 = eA1; }
    I.uA0 = load_row8(UB, (unsigned)eA0, lane16); I.uA1 = load_row8(UB, (unsigned)eA1, lane16); I.vA0 = load_row8(VB, (unsigned)eA0, lane16); I.vA1 = load_row8(VB, (unsigned)eA1, lane16);
    I.uB0 = load_row8(UB, (unsigned)eB0, lane16); I.uB1 = load_row8(UB, (unsigned)eB1, lane16); I.vB0 = load_row8(VB, (unsigned)eB0, lane16); I.vB1 = load_row8(VB, (unsigned)eB1, lane16);
}
template <bool DRY> __device__ __forceinline__ void gather_sliced3_phase(const Args& A, Frame& F) {
    unsigned char* ws = A.ws;
    const GAS unsigned char* UB = (const GAS unsigned char*)(ws + WS_UB); const GAS unsigned char* VB = (const GAS unsigned char*)(ws + WS_VB);
    const int gw = F.vcu * NWAVES + F.wave, NGW = F.G * NWAVES;
    LAS unsigned char* aflA = F.lds + RING_OFF + F.wave * 16384; LAS unsigned char* aflB = aflA + 8192;
    for (int tk0 = 2 * gw; tk0 < T_TOK; tk0 += 2 * NGW) {
        const int lane = lane_id(); const unsigned lane16 = (unsigned)lane * 16u;
        Acc2 TA, TB; tok3_load(ws, tk0, lane, TA, aflA); tok3_load(ws, tk0 + 1, lane, TB, aflB);
        Sweep W; W.s = -1; W.a0 = W.a1 = W.b0 = W.b1 = 0ull;
        It8 X, Y;
        gen_load(W, TA, TB, UB, VB, lane16, X);
        for (;;) {
            gen_load(W, TA, TB, UB, VB, lane16, Y);
            if (X.nA) batch3(TA, aflA, X.uA0, X.uA1, X.vA0, X.vA1, X.gA0, X.gA1, lane);
            if (X.nB) batch3(TB, aflB, X.uB0, X.uB1, X.vB0, X.vB1, X.gB0, X.gB1, lane);
            if (!(Y.nA | Y.nB)) break;
            gen_load(W, TA, TB, UB, VB, lane16, X);
            if (Y.nA) batch3(TA, aflA, Y.uA0, Y.uA1, Y.vA0, Y.vA1, Y.gA0, Y.gA1, lane);
            if (Y.nB) batch3(TB, aflB, Y.uB0, Y.uB1, Y.vB0, Y.vB1, Y.gB0, Y.gB1, lane);
            if (!(X.nA | X.nB)) break;
        }
        tok3_store<DRY>(ws, tk0, lane, TA); tok3_store<DRY>(ws, tk0 + 1, lane, TB);
    }
}
struct It4 { int tok; float g0, g1; Row2 u0, u1, v0, v1; };
__device__ __forceinline__ void gen4(Sweep& W, const Tok2& TA, const Tok2& TB, const GAS unsigned char* UB, const GAS unsigned char* VB, unsigned lane16, It4& I) {
    while (!(W.a0 | W.a1 | W.b0 | W.b1) && W.s + 1 < (16384 >> NSLICE_SHIFT)) { ++W.s;
        W.a0 = __ballot((TA.ev[0] >> NSLICE_SHIFT) == W.s); W.a1 = __ballot((TA.ev[1] >> NSLICE_SHIFT) == W.s); W.b0 = __ballot((TB.ev[0] >> NSLICE_SHIFT) == W.s); W.b1 = __ballot((TB.ev[1] >> NSLICE_SHIFT) == W.s); }
    int e0 = 0, e1 = 0; I.g0 = 0.f; I.g1 = 0.f; I.tok = -1;
    if (W.a0 | W.a1) { take2b(W.a0, W.a1, TA.ev, TA.gv, e0, I.g0, e1, I.g1); I.tok = 0; }
    else if (W.b0 | W.b1) { take2b(W.b0, W.b1, TB.ev, TB.gv, e0, I.g0, e1, I.g1); I.tok = 1; }
    I.u0 = load_row8(UB, (unsigned)e0, lane16); I.u1 = load_row8(UB, (unsigned)e1, lane16); I.v0 = load_row8(VB, (unsigned)e0, lane16); I.v1 = load_row8(VB, (unsigned)e1, lane16);
}
template <bool DRY> __device__ __forceinline__ void gather_sliced4_phase(const Args& A, Frame& F) {
    unsigned char* ws = A.ws;
    const GAS unsigned char* UB = (const GAS unsigned char*)(ws + WS_UB); const GAS unsigned char* VB = (const GAS unsigned char*)(ws + WS_VB);
    const int gw = F.vcu * NWAVES + F.wave, NGW = F.G * NWAVES;
    for (int tk0 = 2 * gw; tk0 < T_TOK; tk0 += 2 * NGW) {
        const int lane = lane_id(); const unsigned lane16 = (unsigned)lane * 16u;
        Tok2 TA, TB; tok2_load(ws, tk0, lane, TA); tok2_load(ws, tk0 + 1, lane, TB);
        Sweep W; W.s = -1; W.a0 = W.a1 = W.b0 = W.b1 = 0ull;
        It4 X, Y;
        gen4(W, TA, TB, UB, VB, lane16, X);
        for (;;) {
            gen4(W, TA, TB, UB, VB, lane16, Y);
            if (X.tok == 0) batch2(TA, X.u0, X.u1, X.v0, X.v1, X.g0, X.g1, lane); else if (X.tok == 1) batch2(TB, X.u0, X.u1, X.v0, X.v1, X.g0, X.g1, lane);
            if (Y.tok < 0) break;
            gen4(W, TA, TB, UB, VB, lane16, X);
            if (Y.tok == 0) batch2(TA, Y.u0, Y.u1, Y.v0, Y.v1, Y.g0, Y.g1, lane); else if (Y.tok == 1) batch2(TB, Y.u0, Y.u1, Y.v0, Y.v1, Y.g0, Y.g1, lane);
            if (X.tok < 0) break;
        }
        tok2_store<DRY>(ws, tk0, lane, TA); tok2_store<DRY>(ws, tk0 + 1, lane, TB);
    }
}
__device__ __forceinline__ void gen5(Sweep& W, const Acc2& TA, const Acc2& TB, const GAS unsigned char* UB, const GAS unsigned char* VB, unsigned lane16, It4& I) {
    while (!(W.a0 | W.a1 | W.b0 | W.b1) && W.s + 1 < (16384 >> NSLICE_SHIFT)) { ++W.s;
        W.a0 = __ballot((TA.ev[0] >> NSLICE_SHIFT) == W.s); W.a1 = __ballot((TA.ev[1] >> NSLICE_SHIFT) == W.s); W.b0 = __ballot((TB.ev[0] >> NSLICE_SHIFT) == W.s); W.b1 = __ballot((TB.ev[1] >> NSLICE_SHIFT) == W.s); }
    int e0 = 0, e1 = 0; I.g0 = 0.f; I.g1 = 0.f; I.tok = -1;
    if (W.a0 | W.a1) { take2b(W.a0, W.a1, TA.ev, TA.gv, e0, I.g0, e1, I.g1); I.tok = 0; }
    else if (W.b0 | W.b1) { take2b(W.b0, W.b1, TB.ev, TB.gv, e0, I.g0, e1, I.g1); I.tok = 1; }
    I.u0 = load_row8(UB, (unsigned)e0, lane16); I.u1 = load_row8(UB, (unsigned)e1, lane16); I.v0 = load_row8(VB, (unsigned)e0, lane16); I.v1 = load_row8(VB, (unsigned)e1, lane16);
}
template <bool DRY> __device__ __forceinline__ void gather_sliced5_phase(const Args& A, Frame& F) {
    unsigned char* ws = A.ws;
    const GAS unsigned char* UB = (const GAS unsigned char*)(ws + WS_UB); const GAS unsigned char* VB = (const GAS unsigned char*)(ws + WS_VB);
    const int gw = F.vcu * NWAVES + F.wave, NGW = F.G * NWAVES;
    LAS unsigned char* aflA = F.lds + RING_OFF + F.wave * 16384; LAS unsigned char* aflB = aflA + 8192;
    for (int tk0 = 2 * gw; tk0 < T_TOK; tk0 += 2 * NGW) {
        const int lane = lane_id(); const unsigned lane16 = (unsigned)lane * 16u;
        Acc2 TA, TB; tok3_load(ws, tk0, lane, TA, aflA); tok3_load(ws, tk0 + 1, lane, TB, aflB);
        Sweep W; W.s = -1; W.a0 = W.a1 = W.b0 = W.b1 = 0ull;
        It4 X, Y;
        gen5(W, TA, TB, UB, VB, lane16, X);
        for (;;) {
            gen5(W, TA, TB, UB, VB, lane16, Y);
            if (X.tok == 0) batch3(TA, aflA, X.u0, X.u1, X.v0, X.v1, X.g0, X.g1, lane); else if (X.tok == 1) batch3(TB, aflB, X.u0, X.u1, X.v0, X.v1, X.g0, X.g1, lane);
            if (Y.tok < 0) break;
            gen5(W, TA, TB, UB, VB, lane16, X);
            if (Y.tok == 0) batch3(TA, aflA, Y.u0, Y.u1, Y.v0, Y.v1, Y.g0, Y.g1, lane); else if (Y.tok == 1) batch3(TB, aflB, Y.u0, Y.u1, Y.v0, Y.v1, Y.g0, Y.g1, lane);
            if (X.tok < 0) break;
        }
        tok3_store<DRY>(ws, tk0, lane, TA); tok3_store<DRY>(ws, tk0 + 1, lane, TB);
    }
}
struct Cur { int s; unsigned long long m0, m1; };
__device__ __forceinline__ int gen6(Cur& C, const Tok2& T, const GAS unsigned char* UB, const GAS unsigned char* VB, unsigned lane16, Row2& u0, Row2& u1, Row2& v0, Row2& v1, float& g0, float& g1) {
    while (!(C.m0 | C.m1) && C.s + 1 < (16384 >> NSLICE_SHIFT)) { ++C.s; C.m0 = __ballot((T.ev[0] >> NSLICE_SHIFT) == C.s); C.m1 = __ballot((T.ev[1] >> NSLICE_SHIFT) == C.s); }
    int e0 = 0, e1 = 0; g0 = 0.f; g1 = 0.f;
    const int n = take2b(C.m0, C.m1, T.ev, T.gv, e0, g0, e1, g1);
    u0 = load_row8(UB, (unsigned)e0, lane16); u1 = load_row8(UB, (unsigned)e1, lane16); v0 = load_row8(VB, (unsigned)e0, lane16); v1 = load_row8(VB, (unsigned)e1, lane16);
    return n;
}
template <bool DRY> __device__ __forceinline__ void gather_sliced6_phase(const Args& A, Frame& F) {
    unsigned char* ws = A.ws;
    const GAS unsigned char* UB = (const GAS unsigned char*)(ws + WS_UB); const GAS unsigned char* VB = (const GAS unsigned char*)(ws + WS_VB);
    const int gw = F.vcu * NWAVES + F.wave, NGW = F.G * NWAVES;
    for (int tk0 = 2 * gw; tk0 < T_TOK; tk0 += 2 * NGW) {
        const int lane = lane_id(); const unsigned lane16 = (unsigned)lane * 16u;
        Tok2 TA, TB; tok2_load(ws, tk0, lane, TA); SBAR(); tok2_load(ws, tk0 + 1, lane, TB); SBAR();
        Cur CA, CB; CA.s = -1; CA.m0 = CA.m1 = 0ull; CB.s = -1; CB.m0 = CB.m1 = 0ull;
        Row2 uA0, uA1, vA0, vA1, uB0, uB1, vB0, vB1; float gA0, gA1, gB0, gB1;
        int nA = gen6(CA, TA, UB, VB, lane16, uA0, uA1, vA0, vA1, gA0, gA1), nB = gen6(CB, TB, UB, VB, lane16, uB0, uB1, vB0, vB1, gB0, gB1);
        while (nA | nB) {
            if (nA) batch2(TA, uA0, uA1, vA0, vA1, gA0, gA1, lane);
            SBAR(); nA = gen6(CA, TA, UB, VB, lane16, uA0, uA1, vA0, vA1, gA0, gA1); SBAR();
            if (nB) batch2(TB, uB0, uB1, vB0, vB1, gB0, gB1, lane);
            SBAR(); nB = gen6(CB, TB, UB, VB, lane16, uB0, uB1, vB0, vB1, gB0, gB1); SBAR();
        }
        tok2_store<DRY>(ws, tk0, lane, TA); tok2_store<DRY>(ws, tk0 + 1, lane, TB);
    }
}
__device__ __forceinline__ int gen7(Cur& C, const Acc2& T, const GAS unsigned char* UB, const GAS unsigned char* VB, unsigned lane16, Row2& u0, Row2& u1, Row2& v0, Row2& v1, float& g0, float& g1) {
    while (!(C.m0 | C.m1) && C.s + 1 < (16384 >> NSLICE_SHIFT)) { ++C.s; C.m0 = __ballot((T.ev[0] >> NSLICE_SHIFT) == C.s); C.m1 = __ballot((T.ev[1] >> NSLICE_SHIFT) == C.s); }
    int e0 = 0, e1 = 0; g0 = 0.f; g1 = 0.f;
    const int n = take2b(C.m0, C.m1, T.ev, T.gv, e0, g0, e1, g1);
    u0 = load_row8(UB, (unsigned)e0, lane16); u1 = load_row8(UB, (unsigned)e1, lane16); v0 = load_row8(VB, (unsigned)e0, lane16); v1 = load_row8(VB, (unsigned)e1, lane16);
    return n;
}
template <bool DRY> __device__ __forceinline__ void gather_sliced7_phase(const Args& A, Frame& F) {
    unsigned char* ws = A.ws;
    const GAS unsigned char* UB = (const GAS unsigned char*)(ws + WS_UB); const GAS unsigned char* VB = (const GAS unsigned char*)(ws + WS_VB);
    const int gw = F.vcu * NWAVES + F.wave, NGW = F.G * NWAVES;
    LAS unsigned char* aflA = F.lds + RING_OFF + F.wave * 16384; LAS unsigned char* aflB = aflA + 8192;
    for (int tk0 = 2 * gw; tk0 < T_TOK; tk0 += 2 * NGW) {
        const int lane = lane_id(); const unsigned lane16 = (unsigned)lane * 16u;
        Acc2 TA, TB; tok3_load(ws, tk0, lane, TA, aflA); tok3_load(ws, tk0 + 1, lane, TB, aflB);
        Cur CA, CB; CA.s = -1; CA.m0 = CA.m1 = 0ull; CB.s = -1; CB.m0 = CB.m1 = 0ull;
        Row2 uA0, uA1, vA0, vA1, uB0, uB1, vB0, vB1; float gA0, gA1, gB0, gB1;
        int nA = gen7(CA, TA, UB, VB, lane16, uA0, uA1, vA0, vA1, gA0, gA1), nB = gen7(CB, TB, UB, VB, lane16, uB0, uB1, vB0, vB1, gB0, gB1);
        while (nA | nB) {
            if (nA) batch3(TA, aflA, uA0, uA1, vA0, vA1, gA0, gA1, lane);
            nA = gen7(CA, TA, UB, VB, lane16, uA0, uA1, vA0, vA1, gA0, gA1);
            if (nB) batch3(TB, aflB, uB0, uB1, vB0, vB1, gB0, gB1, lane);
            nB = gen7(CB, TB, UB, VB, lane16, uB0, uB1, vB0, vB1, gB0, gB1);
        }
        tok3_store<DRY>(ws, tk0, lane, TA); tok3_store<DRY>(ws, tk0 + 1, lane, TB);
    }
}
__device__ __forceinline__ void fma8_lo(f32x2c& s, f32x2c a, unsigned w) { f32x2c t; asm("v_cvt_pk_f32_fp8_e32 %1, %3\n\tv_pk_fma_f32 %0, %2, %1, %0" : "+v"(s), "=&v"(t) : "v"(a), "v"(w)); }
__device__ __forceinline__ void fma8_hi(f32x2c& s, f32x2c a, unsigned w) { f32x2c t; asm("v_cvt_pk_f32_fp8_sdwa %1, %3 src0_sel:WORD_1\n\tv_pk_fma_f32 %0, %2, %1, %0" : "+v"(s), "=&v"(t) : "v"(a), "v"(w)); }
__device__ __forceinline__ void dots2(const Tok2& T, const Row2& u0, const Row2& u1, float& p0, float& p1) {
    f32x2c s0 = {0.f, 0.f}, s1 = {0.f, 0.f};
#pragma unroll
    for (int j = 0; j < 2; ++j) { const unsigned w0[4] = {u0.c[j].x, u0.c[j].y, u0.c[j].z, u0.c[j].w}, w1[4] = {u1.c[j].x, u1.c[j].y, u1.c[j].z, u1.c[j].w};
#pragma unroll
        for (int d = 0; d < 4; ++d) { fma8_lo(s0, T.af[8 * j + 2 * d], w0[d]); fma8_lo(s1, T.af[8 * j + 2 * d], w1[d]); fma8_hi(s0, T.af[8 * j + 2 * d + 1], w0[d]); fma8_hi(s1, T.af[8 * j + 2 * d + 1], w1[d]); } }
    p0 = s0.x + s0.y; p1 = s1.x + s1.y;
}
__device__ __forceinline__ void axpy2(Tok2& T, const Row2& v0, const Row2& v1, float wa, float wb) { const f32x2c wa2 = {wa, wa}, wb2 = {wb, wb};
#pragma unroll
    for (int j = 0; j < 2; ++j) { const unsigned w0[4] = {v0.c[j].x, v0.c[j].y, v0.c[j].z, v0.c[j].w}, w1[4] = {v1.c[j].x, v1.c[j].y, v1.c[j].z, v1.c[j].w};
#pragma unroll
        for (int d = 0; d < 4; ++d) { fma8_lo(T.acc[8 * j + 2 * d], wa2, w0[d]); fma8_hi(T.acc[8 * j + 2 * d + 1], wa2, w0[d]); fma8_lo(T.acc[8 * j + 2 * d], wb2, w1[d]); fma8_hi(T.acc[8 * j + 2 * d + 1], wb2, w1[d]); } }
}
__device__ __forceinline__ void gates2(const Tok2& T, float p0, float p1, float g0, float g1, int lane, float& w0, float& w1) {
    const float h = reduce2(p0, p1); const float w = ((lane & 32) ? g1 : g0) * gelu_f(h * T.rs) * (1.f / V8_SCALE);
    w0 = __uint_as_float((unsigned)__builtin_amdgcn_readlane((int)__float_as_uint(w), 31)); w1 = __uint_as_float((unsigned)__builtin_amdgcn_readlane((int)__float_as_uint(w), 63));
}
__device__ __forceinline__ int next8(Cur& C, const Tok2& T, int& e0, int& e1, float& g0, float& g1) {
    while (!(C.m0 | C.m1) && C.s + 1 < (16384 >> NSLICE_SHIFT)) { ++C.s; C.m0 = __ballot((T.ev[0] >> NSLICE_SHIFT) == C.s); C.m1 = __ballot((T.ev[1] >> NSLICE_SHIFT) == C.s); }
    e0 = 0; e1 = 0; g0 = 0.f; g1 = 0.f; return take2b(C.m0, C.m1, T.ev, T.gv, e0, g0, e1, g1);
}
__device__ __forceinline__ Row2 load_row8b(__amdgpu_buffer_rsrc_t rs, unsigned e, unsigned lane16) { Row2 r; r.c[0] = __builtin_amdgcn_raw_buffer_load_b128(rs, lane16, e * 2048u, 0); r.c[1] = __builtin_amdgcn_raw_buffer_load_b128(rs, lane16 + 1024u, e * 2048u, 0); return r; }
template <bool DRY> __device__ __forceinline__ void gather_sliced8_phase(const Args& A, Frame& F) {
    unsigned char* ws = A.ws;
    const GAS unsigned char* UB = (const GAS unsigned char*)(ws + WS_UB); const GAS unsigned char* VB = (const GAS unsigned char*)(ws + WS_VB);
    const int gw = F.vcu * NWAVES + F.wave, NGW = F.G * NWAVES;
    const __amdgpu_buffer_rsrc_t RU = __builtin_amdgcn_make_buffer_rsrc((void*)(ws + WS_UB), 0, 16384 * 2048, 0x00020000), RV = __builtin_amdgcn_make_buffer_rsrc((void*)(ws + WS_VB), 0, 16384 * 2048, 0x00020000);
    for (int tk0 = 2 * gw; tk0 < T_TOK; tk0 += 2 * NGW) {
        const int lane = lane_id(); const unsigned lane16 = (unsigned)lane * 16u;
        Tok2 TA, TB; tok2_load(ws, tk0, lane, TA); tok2_load(ws, tk0 + 1, lane, TB);
        Cur CA, CB; CA.s = -1; CA.m0 = CA.m1 = 0ull; CB.s = -1; CB.m0 = CB.m1 = 0ull;
        Row2 uA0, uA1, vA0, vA1, uB0, uB1, vB0, vB1;
        int eA0, eA1, eB0, eB1; float gA0, gA1, gB0, gB1;
        int nA = next8(CA, TA, eA0, eA1, gA0, gA1), nB = next8(CB, TB, eB0, eB1, gB0, gB1);
        uA0 = load_row8b(RU, (unsigned)eA0, lane16); uA1 = load_row8b(RU, (unsigned)eA1, lane16); uB0 = load_row8b(RU, (unsigned)eB0, lane16); uB1 = load_row8b(RU, (unsigned)eB1, lane16);
        vA0 = load_row8b(RV, (unsigned)eA0, lane16); vA1 = load_row8b(RV, (unsigned)eA1, lane16); vB0 = load_row8b(RV, (unsigned)eB0, lane16); vB1 = load_row8b(RV, (unsigned)eB1, lane16);
        do {
            float wA0 = 0.f, wA1 = 0.f, wB0 = 0.f, wB1 = 0.f; const int cA = nA, cB = nB;
            if (cA) { float p0, p1; dots2(TA, uA0, uA1, p0, p1); gates2(TA, p0, p1, gA0, gA1, lane, wA0, wA1); }
            nA = next8(CA, TA, eA0, eA1, gA0, gA1); SBAR(); uA0 = load_row8b(RU, (unsigned)eA0, lane16); uA1 = load_row8b(RU, (unsigned)eA1, lane16); SBAR();
            if (cB) { float p0, p1; dots2(TB, uB0, uB1, p0, p1); gates2(TB, p0, p1, gB0, gB1, lane, wB0, wB1); }
            nB = next8(CB, TB, eB0, eB1, gB0, gB1); SBAR(); uB0 = load_row8b(RU, (unsigned)eB0, lane16); uB1 = load_row8b(RU, (unsigned)eB1, lane16); SBAR();
            if (cA) axpy2(TA, vA0, vA1, wA0, wA1);
            SBAR(); vA0 = load_row8b(RV, (unsigned)eA0, lane16); vA1 = load_row8b(RV, (unsigned)eA1, lane16); SBAR();
            if (cB) axpy2(TB, vB0, vB1, wB0, wB1);
            SBAR(); vB0 = load_row8b(RV, (unsigned)eB0, lane16); vB1 = load_row8b(RV, (unsigned)eB1, lane16); SBAR();
        } while (nA | nB);
        tok2_store<DRY>(ws, tk0, lane, TA); tok2_store<DRY>(ws, tk0 + 1, lane, TB);
    }
}
typedef int v8i __attribute__((ext_vector_type(8)));
struct Tok9 { f32x2c acc[16]; Row2 ahi, alo; float rs; int ev[2]; float gv[2]; };
__device__ __forceinline__ unsigned pk4_fp8(float a, float b, float c, float d) { int t = 0; t = __builtin_amdgcn_cvt_pk_fp8_f32(a, b, t, false); t = __builtin_amdgcn_cvt_pk_fp8_f32(c, d, t, true); return (unsigned)t; }
__device__ __forceinline__ void tok9_load(const unsigned char* ws, int tk, int lane, Tok9& T) {
    const float* H1 = (const float*)(ws + WS_H1); const bf16* H1B = (const bf16*)(ws + WS_H1B); const float* psh1 = (const float*)(ws + WS_PSH1); const int* IDX = (const int*)(ws + WS_IDX); const float* GATE = (const float*)(ws + WS_GATE);
    T.rs = (1.0f / sqrtf(wave_sum64(psh1[(size_t)tk * 64 + lane]) * (1.f / 2048.f) + 1e-6f)) * (1.f / U8_SCALE);
#pragma unroll
    for (int j = 0; j < 2; ++j) { const v4u a0 = *(const GAS v4u*)(H1B + (size_t)tk * 2048 + 1024 * j + 16 * lane), a1 = *(const GAS v4u*)(H1B + (size_t)tk * 2048 + 1024 * j + 16 * lane + 8);
        const unsigned aw[8] = {a0.x, a0.y, a0.z, a0.w, a1.x, a1.y, a1.z, a1.w}; unsigned hi4[4], lo4[4];
#pragma unroll
        for (int d = 0; d < 4; ++d) { const float x0 = __uint_as_float(aw[2 * d] << 16), x1 = __uint_as_float(aw[2 * d] & 0xffff0000u), x2 = __uint_as_float(aw[2 * d + 1] << 16), x3 = __uint_as_float(aw[2 * d + 1] & 0xffff0000u);
            const unsigned h = pk4_fp8(x0, x1, x2, x3); const f32x2c l = __builtin_amdgcn_cvt_pk_f32_fp8((int)h, false), u = __builtin_amdgcn_cvt_pk_f32_fp8((int)h, true);
            hi4[d] = h; lo4[d] = pk4_fp8((x0 - l.x) * 16.f, (x1 - l.y) * 16.f, (x2 - u.x) * 16.f, (x3 - u.y) * 16.f); }
        T.ahi.c[j] = (v4u){hi4[0], hi4[1], hi4[2], hi4[3]}; T.alo.c[j] = (v4u){lo4[0], lo4[1], lo4[2], lo4[3]};
#pragma unroll
        for (int q = 0; q < 4; ++q) { const f32x4 x = *(const GAS f32x4*)(H1 + (size_t)tk * 2048 + 1024 * j + 16 * lane + 4 * q); T.acc[8 * j + 2 * q] = (f32x2c){x[0], x[1]}; T.acc[8 * j + 2 * q + 1] = (f32x2c){x[2], x[3]}; } }
    T.ev[0] = IDX[(size_t)tk * 128 + lane]; T.ev[1] = IDX[(size_t)tk * 128 + 64 + lane]; T.gv[0] = GATE[(size_t)tk * 128 + lane]; T.gv[1] = GATE[(size_t)tk * 128 + 64 + lane];
}
template <bool DRY> __device__ __forceinline__ void tok9_store(unsigned char* ws, int tk, const Tok9& T) {
    const int lane = lane_id();
    float* H1 = (float*)(ws + WS_H1); bf16* H1B = (bf16*)(ws + WS_H1B); float* rsh2 = (float*)(ws + WS_RSH2);
    float ss = 0.f;
    float* H1o = DRY ? (float*)(ws + WS_NA0) + (size_t)(tk & 2047) * 2048 : H1 + (size_t)tk * 2048; bf16* H1Bo = DRY ? (bf16*)(ws + WS_NGL) + (size_t)(tk & 2047) * 2048 : H1B + (size_t)tk * 2048;
#pragma unroll
    for (int j = 0; j < 2; ++j) {
#pragma unroll
        for (int q = 0; q < 2; ++q) { const f32x4 y0 = {T.acc[8 * j + 4 * q].x, T.acc[8 * j + 4 * q].y, T.acc[8 * j + 4 * q + 1].x, T.acc[8 * j + 4 * q + 1].y}, y1 = {T.acc[8 * j + 4 * q + 2].x, T.acc[8 * j + 4 * q + 2].y, T.acc[8 * j + 4 * q + 3].x, T.acc[8 * j + 4 * q + 3].y}; ss += sq8(y0, y1);
            *(GAS f32x4*)(H1o + 1024 * j + 16 * lane + 8 * q) = y0; *(GAS f32x4*)(H1o + 1024 * j + 16 * lane + 8 * q + 4) = y1; *(GAS v4u*)(H1Bo + 1024 * j + 16 * lane + 8 * q) = pack8(y0, y1); } }
    ss = wave_sum64(ss); if (lane == 0 && !DRY) rsh2[tk] = 1.0f / sqrtf(ss * (1.f / 2048.f) + 1e-6f);
}
__device__ __forceinline__ v8i as_v8i(const Row2& r) { return (v8i){(int)r.c[0].x, (int)r.c[0].y, (int)r.c[0].z, (int)r.c[0].w, (int)r.c[1].x, (int)r.c[1].y, (int)r.c[1].z, (int)r.c[1].w}; }
__device__ __forceinline__ float dot_mfma(const Tok9& T, const Row2& u, int lane) {
    const v8i ua = as_v8i(u); f32x4 c = {0.f, 0.f, 0.f, 0.f};
    c = __builtin_amdgcn_mfma_scale_f32_16x16x128_f8f6f4(ua, as_v8i(T.ahi), c, 0, 0, 0, 127, 0, 127);
    c = __builtin_amdgcn_mfma_scale_f32_16x16x128_f8f6f4(ua, as_v8i(T.alo), c, 0, 0, 0, 127, 0, 123);
    const int n = lane & 15; const float t0 = (n & 1) ? c[1] : c[0], t1 = (n & 1) ? c[3] : c[2], v = (n & 2) ? t1 : t0;
    return ((lane >> 4) == (n >> 2)) ? v : 0.f;
}
__device__ __forceinline__ void axpy9(Tok9& T, const Row2& v0, const Row2& v1, float wa, float wb) { const f32x2c wa2 = {wa, wa}, wb2 = {wb, wb};
#pragma unroll
    for (int j = 0; j < 2; ++j) { const unsigned w0[4] = {v0.c[j].x, v0.c[j].y, v0.c[j].z, v0.c[j].w}, w1[4] = {v1.c[j].x, v1.c[j].y, v1.c[j].z, v1.c[j].w};
#pragma unroll
        for (int d = 0; d < 4; ++d) { fma8_lo(T.acc[8 * j + 2 * d], wa2, w0[d]); fma8_hi(T.acc[8 * j + 2 * d + 1], wa2, w0[d]); fma8_lo(T.acc[8 * j + 2 * d], wb2, w1[d]); fma8_hi(T.acc[8 * j + 2 * d + 1], wb2, w1[d]); } }
}
__device__ __forceinline__ void batch9(Tok9& T, const Row2& u0, const Row2& u1, const Row2& v0, const Row2& v1, float g0, float g1, int lane) {
    const float h = reduce2(dot_mfma(T, u0, lane), dot_mfma(T, u1, lane));
    const float w = ((lane & 32) ? g1 : g0) * gelu_f(h * T.rs) * (1.f / V8_SCALE);
    const float w0 = __uint_as_float((unsigned)__builtin_amdgcn_readlane((int)__float_as_uint(w), 31)), w1 = __uint_as_float((unsigned)__builtin_amdgcn_readlane((int)__float_as_uint(w), 63));
    axpy9(T, v0, v1, w0, w1);
}
__device__ __forceinline__ int take9(unsigned long long& m0, unsigned long long& m1, const Tok9& T, int& e0, float& g0, int& e1, float& g1) { return take2b(m0, m1, T.ev, T.gv, e0, g0, e1, g1); }
template <bool DRY> __device__ __forceinline__ void gather_sliced9_phase(const Args& A, Frame& F) {
    unsigned char* ws = A.ws;
    const int gw = F.vcu * NWAVES + F.wave, NGW = F.G * NWAVES;
    const __amdgpu_buffer_rsrc_t RU = __builtin_amdgcn_make_buffer_rsrc((void*)(ws + WS_UB), 0, 16384 * 2048, 0x00020000), RV = __builtin_amdgcn_make_buffer_rsrc((void*)(ws + WS_VB), 0, 16384 * 2048, 0x00020000);
    for (int tk0 = 2 * gw; tk0 < T_TOK; tk0 += 2 * NGW) {
        const int lane = lane_id(); const unsigned lane16 = (unsigned)lane * 16u;
        Tok9 TA, TB; tok9_load(ws, tk0, lane, TA); tok9_load(ws, tk0 + 1, lane, TB);
        for (int s = 0; s < (16384 >> NSLICE_SHIFT); ++s) {
            unsigned long long a0 = __ballot((TA.ev[0] >> NSLICE_SHIFT) == s), a1 = __ballot((TA.ev[1] >> NSLICE_SHIFT) == s), b0 = __ballot((TB.ev[0] >> NSLICE_SHIFT) == s), b1 = __ballot((TB.ev[1] >> NSLICE_SHIFT) == s);
            while (a0 | a1 | b0 | b1) {
                int eA0 = 0, eA1 = 0, eB0 = 0, eB1 = 0; float gA0 = 0.f, gA1 = 0.f, gB0 = 0.f, gB1 = 0.f;
                const int nA = take9(a0, a1, TA, eA0, gA0, eA1, gA1), nB = take9(b0, b1, TB, eB0, gB0, eB1, gB1);
                if (DRY && PROBE_NOV == 5) { eA0 &= 3; eA1 &= 3; eB0 &= 3; eB1 &= 3; } if (DRY && PROBE_NOV == 4) { eA0 &= 255; eA1 &= 255; eB0 &= 255; eB1 &= 255; }
                Row2 uA0, uA1, vA0, vA1, uB0, uB1, vB0, vB1;
                if (nA) { uA0 = load_row8b(RU, (unsigned)eA0, lane16); vA0 = load_row8b(RV, (unsigned)eA0, lane16); if (nA == 2) { uA1 = load_row8b(RU, (unsigned)eA1, lane16); vA1 = load_row8b(RV, (unsigned)eA1, lane16); } else { uA1 = uA0; vA1 = vA0; } }
                if (nB) { uB0 = load_row8b(RU, (unsigned)eB0, lane16); vB0 = load_row8b(RV, (unsigned)eB0, lane16); if (nB == 2) { uB1 = load_row8b(RU, (unsigned)eB1, lane16); vB1 = load_row8b(RV, (unsigned)eB1, lane16); } else { uB1 = uB0; vB1 = vB0; } }
                if (nA) batch9(TA, uA0, uA1, vA0, vA1, gA0, gA1, lane);
                if (nB) batch9(TB, uB0, uB1, vB0, vB1, gB0, gB1, lane);
            }
        }
        tok9_store<DRY>(ws, tk0, TA); tok9_store<DRY>(ws, tk0 + 1, TB);
    }
}
#ifndef A_FP6
#define A_FP6 1
#endif
__device__ __forceinline__ unsigned e2m3_code(float v) { const float m = fminf(fabsf(v), 7.5f); const float c = m < 2.f ? rintf(8.f * m) : m < 4.f ? rintf(4.f * m) + 8.f : rintf(2.f * m) + 16.f; return (unsigned)c | (v < 0.f ? 32u : 0u); }
__device__ __forceinline__ float e2m3_val(unsigned code) { const unsigned e = (code >> 3) & 3u, m = code & 7u; const float mag = e == 0 ? (float)m * 0.125f : (1.f + (float)m * 0.125f) * (float)(1u << (e - 1)); return (code & 32u) ? -mag : mag; }
__device__ __forceinline__ void pack_a6(const float (&x)[32], v8i& hi, v8i& lo) {
    unsigned long long ah = 0ull, al = 0ull; int nb = 0, k = 0; unsigned dh[6], dl[6];
#pragma unroll
    for (int i = 0; i < 32; ++i) { const float xs = x[i] * 0.5f; const unsigned ch = e2m3_code(xs); const unsigned cl = e2m3_code((xs - e2m3_val(ch)) * 8.f);
        ah |= (unsigned long long)ch << nb; al |= (unsigned long long)cl << nb; nb += 6;
        if (nb >= 32) { dh[k] = (unsigned)ah; dl[k] = (unsigned)al; ++k; ah >>= 32; al >>= 32; nb -= 32; } }
    hi = (v8i){(int)dh[0], (int)dh[1], (int)dh[2], (int)dh[3], (int)dh[4], (int)dh[5], 0, 0}; lo = (v8i){(int)dl[0], (int)dl[1], (int)dl[2], (int)dl[3], (int)dl[4], (int)dl[5], 0, 0};
}
typedef unsigned v6u __attribute__((ext_vector_type(6)));
typedef float v32f __attribute__((ext_vector_type(32)));
typedef float v16f __attribute__((ext_vector_type(16)));
__device__ __forceinline__ v6u pack32_fp6(v16f x0, v16f x1) { v6u r; asm("v_cvt_scalef32_2xpk16_fp6_f32 %0, %1, %2, 1.0" : "=&v"(r) : "v"(x0), "v"(x1)); return r; }
__device__ __forceinline__ v32f unpack32_fp6(v6u p) { v32f r; asm("v_cvt_scalef32_pk32_f32_fp6 %0, %1, 1.0" : "=&v"(r) : "v"(p)); return r; }
constexpr float U6_SCALE = 64.f, V6_SCALE = 4.f;
__device__ __forceinline__ float wave_sum_dpp(float v) {
    DPP_ADD(v, 0xB1, 0xF); DPP_ADD(v, 0x4E, 0xF); DPP_ADD(v, 0x141, 0xF); DPP_ADD(v, 0x140, 0xF); DPP_ADD(v, 0x142, 0xA); DPP_ADD(v, 0x143, 0xC);
    return __uint_as_float((unsigned)__builtin_amdgcn_readlane((int)__float_as_uint(v), 63)); }
struct Row6 { v4u p0; u32x2v p1; };
struct Tok6 { f32x2c acc[16]; v8i ahi, alo; float rs; int ev[2]; float gv[2]; };
__device__ __forceinline__ Row6 load_row6(__amdgpu_buffer_rsrc_t rs, unsigned e, unsigned lane16) { Row6 r; r.p0 = __builtin_amdgcn_raw_buffer_load_b128(rs, lane16, e * 1536u, 0); r.p1 = __builtin_amdgcn_raw_buffer_load_b64(rs, (lane16 >> 1) + 1024u, e * 1536u, 0); return r; }
__device__ __forceinline__ void tok6_load(const unsigned char* ws, int tk, int lane, Tok6& T) {
    const float* H1 = (const float*)(ws + WS_H1); const bf16* H1B = (const bf16*)(ws + WS_H1B); const float* psh1 = (const float*)(ws + WS_PSH1); const int* IDX = (const int*)(ws + WS_IDX); const float* GATE = (const float*)(ws + WS_GATE);
    T.rs = (1.0f / sqrtf(wave_sum_dpp(psh1[(size_t)tk * 64 + lane]) * (1.f / 2048.f) + 1e-6f)) * (1.f / U6_SCALE);
    if (A_FP6 && U_FP6) {
        v16f x0, x1, r0, r1;
#pragma unroll
        for (int q = 0; q < 4; ++q) { const v4u a = *(const GAS v4u*)(H1B + (size_t)tk * 2048 + 32 * lane + 8 * q); const unsigned aw[4] = {a.x, a.y, a.z, a.w};
#pragma unroll
            for (int d = 0; d < 8; ++d) { const float xs = ((d & 1) ? __uint_as_float(aw[d >> 1] & 0xffff0000u) : __uint_as_float(aw[d >> 1] << 16)) * 0.5f;
                const float m = fminf(fabsf(xs), 7.5f), qm = m < 2.f ? rintf(8.f * m) * 0.125f : m < 4.f ? rintf(4.f * m) * 0.25f : rintf(2.f * m) * 0.5f, rr = (xs - copysignf(qm, xs)) * 8.f;
                if (q < 2) { x0[8 * q + d] = xs; r0[8 * q + d] = rr; } else { x1[8 * (q - 2) + d] = xs; r1[8 * (q - 2) + d] = rr; } } }
        const v6u ph = pack32_fp6(x0, x1), pl = pack32_fp6(r0, r1);
        T.ahi = (v8i){(int)ph[0], (int)ph[1], (int)ph[2], (int)ph[3], (int)ph[4], (int)ph[5], 0, 0}; T.alo = (v8i){(int)pl[0], (int)pl[1], (int)pl[2], (int)pl[3], (int)pl[4], (int)pl[5], 0, 0};
    } else { unsigned hi8[8], lo8[8];
#pragma unroll
        for (int q = 0; q < 4; ++q) { const v4u a = *(const GAS v4u*)(H1B + (size_t)tk * 2048 + 32 * lane + 8 * q); const unsigned aw[4] = {a.x, a.y, a.z, a.w};
#pragma unroll
            for (int d = 0; d < 2; ++d) { const float x0 = __uint_as_float(aw[2 * d] << 16), x1 = __uint_as_float(aw[2 * d] & 0xffff0000u), x2 = __uint_as_float(aw[2 * d + 1] << 16), x3 = __uint_as_float(aw[2 * d + 1] & 0xffff0000u);
                const unsigned h = pk4_fp8(x0, x1, x2, x3); const f32x2c l = __builtin_amdgcn_cvt_pk_f32_fp8((int)h, false), u = __builtin_amdgcn_cvt_pk_f32_fp8((int)h, true);
                hi8[2 * q + d] = h; lo8[2 * q + d] = pk4_fp8((x0 - l.x) * 16.f, (x1 - l.y) * 16.f, (x2 - u.x) * 16.f, (x3 - u.y) * 16.f); } }
        T.ahi = (v8i){(int)hi8[0], (int)hi8[1], (int)hi8[2], (int)hi8[3], (int)hi8[4], (int)hi8[5], (int)hi8[6], (int)hi8[7]}; T.alo = (v8i){(int)lo8[0], (int)lo8[1], (int)lo8[2], (int)lo8[3], (int)lo8[4], (int)lo8[5], (int)lo8[6], (int)lo8[7]}; }
    SBAR();
#pragma unroll
    for (int q = 0; q < 8; ++q) { const f32x4 x = *(const GAS f32x4*)(H1 + (size_t)tk * 2048 + 32 * lane + 4 * q); T.acc[2 * q] = (f32x2c){x[0], x[1]}; T.acc[2 * q + 1] = (f32x2c){x[2], x[3]}; }
    T.ev[0] = IDX[(size_t)tk * 128 + lane]; T.ev[1] = IDX[(size_t)tk * 128 + 64 + lane]; T.gv[0] = GATE[(size_t)tk * 128 + lane]; T.gv[1] = GATE[(size_t)tk * 128 + 64 + lane];
    SBAR();
}
template <bool DRY> __device__ __forceinline__ void tok6_store(unsigned char* ws, int tk, const Tok6& T) {
    const int lane = lane_id();
    float* H1 = (float*)(ws + WS_H1); bf16* H1B = (bf16*)(ws + WS_H1B); float* rsh2 = (float*)(ws + WS_RSH2);
    float ss = 0.f;
    float* H1o = DRY ? (float*)(ws + WS_NA0) + (size_t)(tk & 2047) * 2048 : H1 + (size_t)tk * 2048; bf16* H1Bo = DRY ? (bf16*)(ws + WS_NGL) + (size_t)(tk & 2047) * 2048 : H1B + (size_t)tk * 2048;
#pragma unroll
    for (int q = 0; q < 4; ++q) { const f32x4 y0 = {T.acc[4 * q].x, T.acc[4 * q].y, T.acc[4 * q + 1].x, T.acc[4 * q + 1].y}, y1 = {T.acc[4 * q + 2].x, T.acc[4 * q + 2].y, T.acc[4 * q + 3].x, T.acc[4 * q + 3].y}; ss += sq8(y0, y1);
        *(GAS f32x4*)(H1o + 32 * lane + 8 * q) = y0; *(GAS f32x4*)(H1o + 32 * lane + 8 * q + 4) = y1; *(GAS v4u*)(H1Bo + 32 * lane + 8 * q) = pack8(y0, y1); }
    ss = wave_sum_dpp(ss); if (lane == 0 && !DRY) rsh2[tk] = 1.0f / sqrtf(ss * (1.f / 2048.f) + 1e-6f);
}
__device__ __forceinline__ float dot6_mfma(const Tok6& T, const Row6& u, int lane) {
    const v8i ua = {(int)u.p0.x, (int)u.p0.y, (int)u.p0.z, (int)u.p0.w, (int)u.p1.x, (int)u.p1.y, 0, 0}; f32x4 c = {0.f, 0.f, 0.f, 0.f};
    if (A_FP6) { c = __builtin_amdgcn_mfma_scale_f32_16x16x128_f8f6f4(ua, T.ahi, c, 2, 2, 0, 127, 0, 128);
                 c = __builtin_amdgcn_mfma_scale_f32_16x16x128_f8f6f4(ua, T.alo, c, 2, 2, 0, 127, 0, 125); }
    else { c = __builtin_amdgcn_mfma_scale_f32_16x16x128_f8f6f4(ua, T.ahi, c, 2, 0, 0, 127, 0, 127); c = __builtin_amdgcn_mfma_scale_f32_16x16x128_f8f6f4(ua, T.alo, c, 2, 0, 0, 127, 0, 123); }
    const int n = lane & 15; const float t0 = (n & 1) ? c[1] : c[0], t1 = (n & 1) ? c[3] : c[2], v = (n & 2) ? t1 : t0;
    return ((lane >> 4) == (n >> 2)) ? v : 0.f;
}
__device__ __forceinline__ void axpy6(Tok6& T, const Row6& v, float wk) {
    const v32f y = unpack32_fp6((v6u){v.p0.x, v.p0.y, v.p0.z, v.p0.w, v.p1.x, v.p1.y}); const f32x2c w2 = {wk, wk};
#pragma unroll
    for (int i = 0; i < 16; ++i) T.acc[i] = __builtin_elementwise_fma(w2, (f32x2c){y[2 * i], y[2 * i + 1]}, T.acc[i]);
}
__device__ __forceinline__ void batch6(Tok6& T, const Row6& u0, const Row6& u1, const Row6& v0, const Row6& v1, float g0, float g1, int n2, int lane) {
    const float h = reduce2(dot6_mfma(T, u0, lane), dot6_mfma(T, u1, lane));
    const float w = ((lane & 32) ? g1 : g0) * gelu_f(h * T.rs) * (1.f / V6_SCALE);
    const float w0 = __uint_as_float((unsigned)__builtin_amdgcn_readlane((int)__float_as_uint(w), 31)), w1 = __uint_as_float((unsigned)__builtin_amdgcn_readlane((int)__float_as_uint(w), 63));
    SBAR(); axpy6(T, v0, w0); SBAR(); if (n2) axpy6(T, v1, w1); SBAR();
}
template <bool DRY> __device__ __forceinline__ void gather_fp6_phase(const Args& A, Frame& F) {
    unsigned char* ws = A.ws;
    const int gw = F.vcu * NWAVES + F.wave, NGW = F.G * NWAVES;
    const __amdgpu_buffer_rsrc_t RU = __builtin_amdgcn_make_buffer_rsrc((void*)(ws + WS_UB), 0, 16384 * 1536, 0x00020000), RV = __builtin_amdgcn_make_buffer_rsrc((void*)(ws + WS_VB), 0, 16384 * 1536, 0x00020000);
    for (int tk0 = 2 * gw; tk0 < T_TOK; tk0 += 2 * NGW) {
        const int lane = lane_id(); const unsigned lane16 = (unsigned)lane * 16u;
        Tok6 TA, TB; tok6_load(ws, tk0, lane, TA); tok6_load(ws, tk0 + 1, lane, TB);
        for (int s = 0; s < (16384 >> NSLICE_SHIFT); ++s) {
            unsigned long long a0 = __ballot((TA.ev[0] >> NSLICE_SHIFT) == s), a1 = __ballot((TA.ev[1] >> NSLICE_SHIFT) == s), b0 = __ballot((TB.ev[0] >> NSLICE_SHIFT) == s), b1 = __ballot((TB.ev[1] >> NSLICE_SHIFT) == s);
            while (a0 | a1 | b0 | b1) {
                int eA0 = 0, eA1 = 0, eB0 = 0, eB1 = 0; float gA0 = 0.f, gA1 = 0.f, gB0 = 0.f, gB1 = 0.f;
                const int nA = take2b(a0, a1, TA.ev, TA.gv, eA0, gA0, eA1, gA1), nB = take2b(b0, b1, TB.ev, TB.gv, eB0, gB0, eB1, gB1);
                Row6 uA0, uA1, vA0, vA1, uB0, uB1, vB0, vB1;
                if (nA) { uA0 = load_row6(RU, (unsigned)eA0, lane16); vA0 = load_row6(RV, (unsigned)eA0, lane16); if (nA == 2) { uA1 = load_row6(RU, (unsigned)eA1, lane16); vA1 = load_row6(RV, (unsigned)eA1, lane16); } else { uA1 = uA0; vA1 = vA0; } }
                if (nB) { uB0 = load_row6(RU, (unsigned)eB0, lane16); vB0 = load_row6(RV, (unsigned)eB0, lane16); if (nB == 2) { uB1 = load_row6(RU, (unsigned)eB1, lane16); vB1 = load_row6(RV, (unsigned)eB1, lane16); } else { uB1 = uB0; vB1 = vB0; } }
                if (nA) batch6(TA, uA0, uA1, vA0, vA1, gA0, gA1, nA == 2, lane);
                if (nB) batch6(TB, uB0, uB1, vB0, vB1, gB0, gB1, nB == 2, lane);
            }
        }
        tok6_store<DRY>(ws, tk0, TA); tok6_store<DRY>(ws, tk0 + 1, TB);
    }
}
struct Pair6 { Row6 u, v; float g; };
__device__ __forceinline__ void sort_pairs(const Tok6& T_, int lane, LAS u32x2v* lst  ) {
    struct { int ev[2]; float gv[2]; } T; T.ev[0] = T_.ev[0]; T.ev[1] = T_.ev[1]; T.gv[0] = T_.gv[0]; T.gv[1] = T_.gv[1];
    int r0 = 0, r1 = 0;
    for (int j = 0; j < 64; ++j) { const int k0 = __builtin_amdgcn_readlane(T.ev[0], j), k1 = __builtin_amdgcn_readlane(T.ev[1], j);
        r0 += (k0 < T.ev[0] || (k0 == T.ev[0] && j < lane)) + (k1 < T.ev[0]);
        r1 += (k0 <= T.ev[1]) + (k1 < T.ev[1] || (k1 == T.ev[1] && j < lane)); }
    lst[r0] = (u32x2v){(unsigned)T.ev[0], __float_as_uint(T.gv[0])}; lst[r1] = (u32x2v){(unsigned)T.ev[1], __float_as_uint(T.gv[1])};
}
__device__ __forceinline__ Pair6 issue1(const LAS u32x2v* lst, int j, __amdgpu_buffer_rsrc_t RU, __amdgpu_buffer_rsrc_t RV, unsigned lane16) {
    const u32x2v eg = lst[j]; const unsigned e = (unsigned)__builtin_amdgcn_readfirstlane((int)eg.x); Pair6 P; P.g = __uint_as_float((unsigned)__builtin_amdgcn_readfirstlane((int)eg.y));
    P.u = load_row6(RU, e, lane16); P.v = load_row6(RV, e, lane16); return P;
}
__device__ __forceinline__ void step1(Tok6& T, const Pair6& P, int lane, v32f& y  ) {
    const float h = wave_sum_dpp(dot6_mfma(T, P.u, lane));
    const float w = P.g * gelu_f(h * T.rs) * (1.f / V6_SCALE);
    const v6u pv = {P.v.p0.x, P.v.p0.y, P.v.p0.z, P.v.p0.w, P.v.p1.x, P.v.p1.y};
    asm volatile("v_cvt_scalef32_pk32_f32_fp6 %0, %1, 1.0" : "+v"(y) : "v"(pv));
    const f32x2c w2 = {w, w};
#pragma unroll
    for (int i = 0; i < 16; ++i) T.acc[i] = __builtin_elementwise_fma(w2, (f32x2c){y[2 * i], y[2 * i + 1]}, T.acc[i]);
}
#define ISSUE6(lst_, j_, U0, U1, V0, V1, G) do { const u32x2v eg_ = (lst_)[j_]; const unsigned e_ = (unsigned)__builtin_amdgcn_readfirstlane((int)eg_.x) * 1536u; G = __uint_as_float((unsigned)__builtin_amdgcn_readfirstlane((int)eg_.y)); \
        U0 = __builtin_amdgcn_raw_buffer_load_b128(RU, lane16, e_, 0); U1 = __builtin_amdgcn_raw_buffer_load_b64(RU, lane8, e_, 0); V0 = __builtin_amdgcn_raw_buffer_load_b128(RV, lane16, e_, 0); V1 = __builtin_amdgcn_raw_buffer_load_b64(RV, lane8, e_, 0); } while (0)
#define STEP6(T, U0, U1, V0, V1, G) do { const v8i ua_ = {(int)U0.x, (int)U0.y, (int)U0.z, (int)U0.w, (int)U1.x, (int)U1.y, 0, 0}; f32x4 c_ = {0.f, 0.f, 0.f, 0.f}; \
        c_ = __builtin_amdgcn_mfma_scale_f32_16x16x128_f8f6f4(ua_, T.ahi, c_, 2, 2, 0, 127, 0, 128); c_ = __builtin_amdgcn_mfma_scale_f32_16x16x128_f8f6f4(ua_, T.alo, c_, 2, 2, 0, 127, 0, 125); \
        const int n_ = lane & 15; const float t0_ = (n_ & 1) ? c_[1] : c_[0], t1_ = (n_ & 1) ? c_[3] : c_[2], d_ = (n_ & 2) ? t1_ : t0_; \
        const float h_ = wave_sum_dpp(((lane >> 4) == (n_ >> 2)) ? d_ : 0.f); const float w_ = G * gelu_f(h_ * T.rs) * (1.f / V6_SCALE); const f32x2c w2_ = {w_, w_}; \
        const v32f y_ = unpack32_fp6((v6u){V0.x, V0.y, V0.z, V0.w, V1.x, V1.y}); \
        _Pragma("unroll") for (int i_ = 0; i_ < 16; ++i_) T.acc[i_] = __builtin_elementwise_fma(w2_, (f32x2c){y_[2 * i_], y_[2 * i_ + 1]}, T.acc[i_]); } while (0)
template <bool DRY> __device__ __forceinline__ void gather_fp6p_phase(const Args& A, Frame& F) {
    unsigned char* ws = A.ws;
    const int gw = F.vcu * NWAVES + F.wave, NGW = F.G * NWAVES;
    const __amdgpu_buffer_rsrc_t RU = __builtin_amdgcn_make_buffer_rsrc((void*)(ws + WS_UB), 0, 16384 * 1536, 0x00020000), RV = __builtin_amdgcn_make_buffer_rsrc((void*)(ws + WS_VB), 0, 16384 * 1536, 0x00020000);
    LAS u32x2v* lstA = (LAS u32x2v*)(F.lds + RING_OFF + F.wave * 2048); LAS u32x2v* lstB = lstA + 128;
    for (int tk0 = 2 * gw; tk0 < T_TOK; tk0 += 2 * NGW) {
        const int lane = lane_id(); const unsigned lane16 = (unsigned)lane * 16u, lane8 = (unsigned)lane * 8u + 1024u;
        Tok6 TA, TB; tok6_load(ws, tk0, lane, TA); sort_pairs(TA, lane, lstA); SBAR(); tok6_load(ws, tk0 + 1, lane, TB); sort_pairs(TB, lane, lstB); SBAR();
        v4u a0u, a0v, b0u, b0v, a1u, a1v, b1u, b1v; u32x2v a0u1, a0v1, b0u1, b0v1, a1u1, a1v1, b1u1, b1v1; float a0g, b0g, a1g, b1g;
        ISSUE6(lstA, 0, a0u, a0u1, a0v, a0v1, a0g); ISSUE6(lstB, 0, b0u, b0u1, b0v, b0v1, b0g); ISSUE6(lstA, 1, a1u, a1u1, a1v, a1v1, a1g); ISSUE6(lstB, 1, b1u, b1u1, b1v, b1v1, b1g);
        int k = 0;
        do {
            STEP6(TA, a0u, a0u1, a0v, a0v1, a0g); SBAR(); ISSUE6(lstA, 2 * k + 2, a0u, a0u1, a0v, a0v1, a0g); SBAR();
            STEP6(TB, b0u, b0u1, b0v, b0v1, b0g); SBAR(); ISSUE6(lstB, 2 * k + 2, b0u, b0u1, b0v, b0v1, b0g); SBAR();
            STEP6(TA, a1u, a1u1, a1v, a1v1, a1g); SBAR(); ISSUE6(lstA, 2 * k + 3, a1u, a1u1, a1v, a1v1, a1g); SBAR();
            STEP6(TB, b1u, b1u1, b1v, b1v1, b1g); SBAR(); ISSUE6(lstB, 2 * k + 3, b1u, b1u1, b1v, b1v1, b1g); SBAR();
        } while (++k < 63);
        STEP6(TA, a0u, a0u1, a0v, a0v1, a0g); STEP6(TB, b0u, b0u1, b0v, b0v1, b0g); STEP6(TA, a1u, a1u1, a1v, a1v1, a1g); STEP6(TB, b1u, b1u1, b1v, b1v1, b1g);
        tok6_store<DRY>(ws, tk0, TA); tok6_store<DRY>(ws, tk0 + 1, TB);
    }
}
struct Row8c { v4u c0, c1; };
__device__ __forceinline__ Row8c load_row8c(__amdgpu_buffer_rsrc_t rs, unsigned e, unsigned lane32) { Row8c r; r.c0 = __builtin_amdgcn_raw_buffer_load_b128(rs, lane32, e * 2048u, 0); r.c1 = __builtin_amdgcn_raw_buffer_load_b128(rs, lane32 + 16u, e * 2048u, 0); return r; }
template <bool DRY> __device__ __forceinline__ void gather_mix_phase(const Args& A, Frame& F) {
    unsigned char* ws = A.ws;
    const int gw = F.vcu * NWAVES + F.wave, NGW = F.G * NWAVES;
    const __amdgpu_buffer_rsrc_t RU = __builtin_amdgcn_make_buffer_rsrc((void*)(ws + WS_UB), 0, 16384 * 2048, 0x00020000), RV = __builtin_amdgcn_make_buffer_rsrc((void*)(ws + WS_VB), 0, 16384 * 2048, 0x00020000);
    for (int tk = gw; tk < T_TOK; tk += NGW) {
        const int lane = lane_id(); const unsigned lane16 = (unsigned)lane * 16u;
        Tok6 T; tok6_load(ws, tk, lane, T); if (!U_FP6) T.rs *= U6_SCALE / U8_SCALE;
        for (int k = 0; k < 128; ++k) {
            const int e = __builtin_amdgcn_readlane(k < 64 ? T.ev[0] : T.ev[1], k & 63); const float g = __uint_as_float((unsigned)__builtin_amdgcn_readlane((int)__float_as_uint(k < 64 ? T.gv[0] : T.gv[1]), k & 63));
            float p;
            if (0) {}
            else if (U_FP6) { const Row6 u = load_row6(RU, (unsigned)e, lane16); p = dot6_mfma(T, u, lane); }
            else { const Row8c u = load_row8c(RU, (unsigned)e, lane16 * 2u); const v8i ua = {(int)u.c0.x, (int)u.c0.y, (int)u.c0.z, (int)u.c0.w, (int)u.c1.x, (int)u.c1.y, (int)u.c1.z, (int)u.c1.w}; f32x4 c = {0.f, 0.f, 0.f, 0.f};
                c = __builtin_amdgcn_mfma_scale_f32_16x16x128_f8f6f4(ua, T.ahi, c, 0, 0, 0, 127, 0, 127); c = __builtin_amdgcn_mfma_scale_f32_16x16x128_f8f6f4(ua, T.alo, c, 0, 0, 0, 127, 0, 123);
                const int n = lane & 15; const float t0 = (n & 1) ? c[1] : c[0], t1 = (n & 1) ? c[3] : c[2], v = (n & 2) ? t1 : t0; p = ((lane >> 4) == (n >> 2)) ? v : 0.f; }
            const float h = wave_sum64(p); const float w = g * gelu_f(h * T.rs) * (V_FP6 ? 1.f / V6_SCALE : 1.f / V8_SCALE);
            if (V_FP6) { const Row6 v = load_row6(RV, (unsigned)e, lane16); axpy6(T, v, w); }
            else { const Row8c v = load_row8c(RV, (unsigned)e, lane16 * 2u); const unsigned wv[8] = {v.c0.x, v.c0.y, v.c0.z, v.c0.w, v.c1.x, v.c1.y, v.c1.z, v.c1.w}; const f32x2c w2 = {w, w};
#pragma unroll
                for (int d = 0; d < 8; ++d) { T.acc[2 * d] = __builtin_elementwise_fma(w2, __builtin_amdgcn_cvt_pk_f32_fp8((int)wv[d], false), T.acc[2 * d]); T.acc[2 * d + 1] = __builtin_elementwise_fma(w2, __builtin_amdgcn_cvt_pk_f32_fp8((int)wv[d], true), T.acc[2 * d + 1]); } }
        }
        tok6_store<DRY>(ws, tk, T);
    }
}
__device__ __forceinline__ void final_phase(const Args& A, Frame& F) {
    unsigned char* ws = A.ws; const float* psh3 = (const float*)(ws + WS_PSH3); const float* gf = (const float*)A.in[25]; float* out = A.out;
    const int gw = F.vcu * NWAVES + F.wave, NGW = F.G * NWAVES;
    for (int tk = gw; tk < T_TOK; tk += NGW) { const int lane = lane_id();
        const float rs = 1.0f / sqrtf(wave_sum64(psh3[(size_t)tk * 64 + lane]) * (1.f / 2048.f) + 1e-6f);
#pragma unroll
        for (int j = 0; j < 8; ++j) { GAS f32x4* o = (GAS f32x4*)(out + (size_t)tk * 2048 + 256 * j) + lane; const f32x4 g = *((const GAS f32x4*)(gf + 256 * j) + lane); *o = *o * rs * g; } }
}
#define PH2_BODY \
        { pg8::Gemm g{(const bf16*)(ws + WS_CQ), (const bf16*)(ws + WS_WT_UQ), T_TOK, 1536, 512}; pg8::StaticOrder S; S.init(T_TOK, 1536, F.G, (int)blockIdx.x); \
          LAS float* tab = (LAS float*)(F.lds + TAB_OFF); setup_rowtab(tab, (const float*)(ws + WS_PSCQ), 16, 1.f / 512.f, S, F.wave); __syncthreads(); \
          EpiQ E{tab, (bf16*)(ws + WS_Q), (const f32x2v*)(ws + WS_CS)}; pg8::gemm_phase<EpiQ, pg8::StaticOrder, true, true>(F.lds + RING_OFF, g, S, E, F.wave); } \
        __syncthreads(); \
        { pg8::Gemm g{(const bf16*)(ws + WS_CKV), (const bf16*)(ws + WS_WT_UKV), T_TOK, 2048, 256}; pg8::StaticOrder S; S.init(T_TOK, 2048, F.G, (int)blockIdx.x); \
          LAS float* tab = (LAS float*)(F.lds + TAB_OFF); setup_rowtab(tab, (const float*)(ws + WS_PSCKV), 8, 1.f / 256.f, S, F.wave); __syncthreads(); \
          EpiKV E{tab, (bf16*)(ws + WS_KN), (bf16*)(ws + WS_VV)}; pg8::gemm_phase<EpiKV, pg8::StaticOrder, true, true>(F.lds + RING_OFF, g, S, E, F.wave); } \
        __syncthreads(); \
        sgu_phase(args, F); __syncthreads();

#define PH4_BODY \
        { pg8::Gemm g{(const bf16*)(ws + WS_MIX), (const bf16*)(ws + WS_WT_OUT), T_TOK, 2048, 2048}; pg8::StaticOrder S; S.init(T_TOK, 2048, F.G, (int)blockIdx.x); \
          LAS float* tab = (LAS float*)(F.lds + TAB_OFF); setup_rowtab(tab, (const float*)(ws + WS_PSA), 8, 1.f / 1024.f, S, F.wave); setup_rowtab(tab + 256, (const float*)(ws + WS_PSS), 16, 1.f / 1024.f, S, F.wave); __syncthreads(); \
          EpiOut E{tab, (const float*)args.in[0], (float*)(ws + WS_H1), (bf16*)(ws + WS_H1B), (float*)(ws + WS_PSH1)}; pg8::gemm_phase<EpiOut, pg8::StaticOrder, true, true>(F.lds + RING_OFF, g, S, E, F.wave); } __syncthreads();

#define PH5_BODY \
        { pg8::Gemm g{(const bf16*)(ws + WS_H1B), (const bf16*)(ws + WS_WT_PQ), T_TOK, 2048, 2048}; pg8::StaticOrder S; S.init(T_TOK, 2048, F.G, (int)blockIdx.x); \
          LAS float* tab = (LAS float*)(F.lds + TAB_OFF); setup_rowtab(tab, (const float*)(ws + WS_PSH1), 64, 1.f / 2048.f, S, F.wave); __syncthreads(); \
          EpiPQ E{tab, (bf16*)(ws + WS_R1)}; pg8::gemm_phase<EpiPQ, pg8::StaticOrder, true, true>(F.lds + RING_OFF, g, S, E, F.wave); }

#define PH8_BODY \
        { pg8::Gemm g{(const bf16*)(ws + WS_H1B), (const bf16*)(ws + WS_WT_PG), T_TOK, 2048, 2048}; pg8::StaticOrder S; S.init(T_TOK, 2048, F.G, (int)blockIdx.x); \
          EpiPLE E{(const float*)(ws + WS_RSH2), (const float*)(ws + WS_H1), (const bf16*)(ws + WS_PPROJ), args.out, (float*)(ws + WS_PSH3)}; pg8::gemm_phase<EpiPLE, pg8::StaticOrder, true, true>(F.lds + RING_OFF, g, S, E, F.wave); } __syncthreads();

#define PHASES_2_9 \
    if (IN(2)) { if (REPEAT_PH == 2) { PH2_BODY __syncthreads(); } PH2_BODY SEAM(2); } \
    if (IN(3)) { if (REPEAT_PH == 3) { attn_phase(args, F); __syncthreads(); } attn_phase(args, F); SEAM(3); } \
    if (IN(4)) { if (REPEAT_PH == 4) { PH4_BODY __syncthreads(); } PH4_BODY SEAM(4); } \
    if (IN(5)) { if (REPEAT_PH == 5) { PH5_BODY __syncthreads(); } PH5_BODY SEAM(5); } \
    PHASES_6_9
#define PHASES_6_9 \
    if (IN(6)) { if (REPEAT_PH == 6) { topk_phase(args, F); __syncthreads(); } topk_phase(args, F); SEAM(6); } \
    if (IN(7)) { if (REPEAT_PH == 7) { GATHER_FN<true>(args, F); __syncthreads(); } GATHER_FN<false>(args, F); SEAM(7); } \
    if (IN(8)) { if (REPEAT_PH == 8) { PH8_BODY __syncthreads(); } PH8_BODY SEAM(8); } \
    if (IN(9)) { final_phase(args, F); }
#define PH1_BODY \
        { pg8::Gemm g{(const bf16*)(ws + WS_R1), (const bf16*)(ws + WS_WT_IN), T_TOK, 3072, 2048}; pg8::StaticOrder S; S.init(T_TOK, 3072, F.G, (int)blockIdx.x); \
          EpiG1 E{(const float*)(ws + WS_RSX), (bf16*)(ws + WS_CQ), (bf16*)(ws + WS_CKV), (bf16*)(ws + WS_KR), (bf16*)(ws + WS_UG), (bf16*)(ws + WS_VG), (float*)(ws + WS_PSCQ), (float*)(ws + WS_PSCKV), (f32x2v*)(ws + WS_PSV), (const f32x2v*)(ws + WS_CS)}; \
          pg8::gemm_phase<EpiG1, pg8::StaticOrder, true, true>(F.lds + RING_OFF, g, S, E, F.wave); } \
        { pg8::Gemm g{(const bf16*)(ws + WS_PB), (const bf16*)(ws + WS_WT_PP), T_TOK, 2048, 256}; pg8::StaticOrder S; S.init(T_TOK, 2048, F.G, (int)blockIdx.x); \
          EpiPlain E{(bf16*)(ws + WS_PPROJ), 2048}; \
          pg8::gemm_phase<EpiPlain, pg8::StaticOrder, true, true>(F.lds + RING_OFF, g, S, E, F.wave); }
constexpr int N_PHASES = 10;
__global__ void __launch_bounds__(NWAVES * 64, 2) mega_fwd(Args args) {
    extern __shared__ __attribute__((aligned(16))) unsigned char lds[];
    Frame F;
    F.lds = (LAS unsigned char*)lds; F.MISC = (volatile LAS unsigned*)(F.lds + MISC_OFF);
    F.wave = __builtin_amdgcn_readfirstlane(threadIdx.x >> 6); F.lane = lane_id(); F.tid = F.wave * 64 + F.lane;
    F.G = gridDim.x; { const int bx = blockIdx.x; F.vcu = (F.G % 8 == 0) ? (bx % 8) * (F.G / 8) + bx / 8 : bx; }
    unsigned char* ws = args.ws; F.ctl = (gu32*)(ws + WS_CTL);
    for (int u = F.wave * 64 + lane_id(); u < (LDS_BYTES - LDSCTL_OFF) / 4; u += NWAVES * 64) ((LAS unsigned*)(F.lds + LDSCTL_OFF))[u] = 0u;
    __syncthreads();
    const int lo = args.ph_lo, hi = args.ph_hi;
    XcdBarrier bar; bar.bar = (unsigned*)(F.ctl + CW_BAR); bar.x = 0; bar.st = nullptr;
    if (hi - lo > 1) bar = xcd_barrier_post((unsigned*)(F.ctl + CW_BAR), F.MISC + 8, F.wave);
#define IN(k) (lo <= (k) && (k) < hi)
#define SEAM(k) do { if (IN(k) && IN((k) + 1)) { xcd_barrier(bar, F.wave); if (REPEAT_PH == 100 + (k)) { xcd_barrier(bar, F.wave); xcd_barrier(bar, F.wave); xcd_barrier(bar, F.wave); xcd_barrier(bar, F.wave); } } } while (0)
    if (IN(0)) { if (REPEAT_PH == 0) { p0_prologue(args, F); __syncthreads(); } p0_prologue(args, F); SEAM(0); }
    if (IN(1)) { if (REPEAT_PH == 1) { PH1_BODY __syncthreads(); } PH1_BODY SEAM(1); }
    PHASES_2_9
#undef IN
#undef SEAM
}

#if CUT > 0 && CUT < 9
__device__ __forceinline__ int rope_unpc(int pc) { const int c5 = pc >> 5, fq = (pc >> 3) & 3, nn = (pc >> 2) & 1, e = pc & 3; return 16 * c5 + 4 * fq + e + 32 * nn; }
__global__ void __launch_bounds__(256) conv1(const unsigned char* ws, int b, float* ZP) {
    const int r = blockIdx.x; const size_t row = (size_t)b * 2048 + r; float* z = ZP + (size_t)r * 2880;
    const bf16 *CQ = (const bf16*)(ws + WS_CQ) + row * 512, *CKV = (const bf16*)(ws + WS_CKV) + row * 256, *KR = (const bf16*)(ws + WS_KR) + row * 64, *UG = (const bf16*)(ws + WS_UG) + row * 1024, *VG = (const bf16*)(ws + WS_VG) + row * 1024;
    for (int i = threadIdx.x; i < 512; i += 256) z[i] = bf2f(CQ[i]);
    for (int i = threadIdx.x; i < 256; i += 256) z[512 + i] = bf2f(CKV[i]);
    if (threadIdx.x < 64) z[768 + rope_unpc(threadIdx.x)] = bf2f(KR[threadIdx.x]);
    for (int i = threadIdx.x; i < 1024; i += 256) { z[832 + i] = bf2f(UG[i]); z[1856 + i] = bf2f(VG[i]); }
}
__global__ void __launch_bounds__(256) conv2(const unsigned char* ws, int b, float* ZP, float* QN, float* KV, float* OSGU) {
    const int r = blockIdx.x; const size_t row = (size_t)b * 2048 + r;
    const bf16 *Q = (const bf16*)(ws + WS_Q) + row * 1536, *KN = (const bf16*)(ws + WS_KN) + row * 1024, *VV = (const bf16*)(ws + WS_VV) + row * 1024, *KR = (const bf16*)(ws + WS_KR) + row * 64, *MIX = (const bf16*)(ws + WS_MIX) + row * 2048;
    for (int i = threadIdx.x; i < 1536; i += 256) { const int h = i / 192, lc = i - h * 192; const int dst = lc < 128 ? i : h * 192 + 128 + rope_unpc(lc - 128); QN[(size_t)r * 1536 + dst] = bf2f(Q[i]) * (1.f / QK_C2); }
    for (int i = threadIdx.x; i < 1024; i += 256) { const int h = i >> 7, d = i & 127; KV[(size_t)r * 2048 + h * 256 + d] = bf2f(KN[i]); KV[(size_t)r * 2048 + h * 256 + 128 + d] = bf2f(VV[i]); OSGU[(size_t)r * 1024 + i] = bf2f(MIX[1024 + i]); }
    if (threadIdx.x < 64) ZP[(size_t)r * 2880 + 768 + rope_unpc(threadIdx.x)] = bf2f(KR[threadIdx.x]);
}
__global__ void __launch_bounds__(256) conv3(const unsigned char* ws, int b, float* OATT, float* OSGU) {
    const int r = blockIdx.x; const size_t row = (size_t)b * 2048 + r; const bf16* MIX = (const bf16*)(ws + WS_MIX) + row * 2048;
    for (int i = threadIdx.x; i < 1024; i += 256) { OATT[(size_t)r * 1024 + i] = bf2f(MIX[i]); OSGU[(size_t)r * 1024 + i] = bf2f(MIX[1024 + i]); }
}
__global__ void __launch_bounds__(256) conv5(const unsigned char* ws, int b, float* QPN) {
    const int r = blockIdx.x; const size_t row = (size_t)b * 2048 + r; const bf16* QP = (const bf16*)(ws + WS_R1) + row * 2048;
    for (int i = threadIdx.x; i < 2048; i += 256) QPN[(size_t)r * 2048 + i] = bf2f(QP[i]);
}
static void launch_conv(int b, void* const* d_in, void* d_ws, hipStream_t stream) {
    unsigned char* ws = (unsigned char*)d_ws; (void)d_in;
    if (CUT == 1) conv1<<<2048, 256, 0, stream>>>(ws, b, (float*)(ws + WS_NZP));
    if (CUT == 2) conv2<<<2048, 256, 0, stream>>>(ws, b, (float*)(ws + WS_NZP), (float*)(ws + WS_NQN), (float*)(ws + WS_NKV), (float*)(ws + WS_NOSGU));
    if (CUT == 3) conv3<<<2048, 256, 0, stream>>>(ws, b, (float*)(ws + WS_NOATT), (float*)(ws + WS_NOSGU));
    if (CUT == 5) conv5<<<2048, 256, 0, stream>>>(ws, b, (float*)(ws + WS_NQPN));
}
#endif
#if CUT > 0
static void launch_fast(void* const* d_in, void* d_out, void* d_ws, hipStream_t stream) {
    static int grid = 0;
    if (grid == 0) {
        int dev = 0, cus = 0, per_cu = 0;
        if (hipGetDevice(&dev) != hipSuccess || hipDeviceGetAttribute(&cus, hipDeviceAttributeMultiprocessorCount, dev) != hipSuccess) { fprintf(stderr, "launch_fast: device query failed\n"); grid = -1; return; }
        if (hipFuncSetAttribute((const void*)mega_fwd, hipFuncAttributeMaxDynamicSharedMemorySize, LDS_BYTES) != hipSuccess) { fprintf(stderr, "launch_fast: hipFuncSetAttribute failed\n"); grid = -1; return; }
        if (hipOccupancyMaxActiveBlocksPerMultiprocessor(&per_cu, (const void*)mega_fwd, NWAVES * 64, LDS_BYTES) != hipSuccess || per_cu < 1) fprintf(stderr, "launch_fast: occupancy query says %d blocks per CU\n", per_cu);
        (void)hipGetLastError();
        grid = cus;
        if (grid != 256) fprintf(stderr, "launch_fast: %d CUs (built for 256)\n", grid);
    }
    if (grid < 0) return;
    (void)hipMemsetAsync((char*)d_ws + WS_CTL, 0, CTL_ZERO_BYTES, stream);
    Args a{};
    for (int i = 0; i < 26; ++i) a.in[i] = d_in[i];
    a.out = (float*)d_out; a.ws = (unsigned char*)d_ws;
    constexpr int LAST = CUT + 1;
#if ONE_LAUNCH
    a.ph_lo = 0; a.ph_hi = LAST; hipLaunchKernelGGL(mega_fwd, dim3(grid), dim3(NWAVES * 64), LDS_BYTES, stream, a);
#else
    for (int ph = 0; ph < LAST; ++ph) { a.ph_lo = ph; a.ph_hi = ph + 1; hipLaunchKernelGGL(mega_fwd, dim3(grid), dim3(NWAVES * 64), LDS_BYTES, stream, a); }
#endif
    const hipError_t le = hipPeekAtLastError(); if (le != hipSuccess) fprintf(stderr, "launch_fast: launch failed: %s\n", hipGetErrorName(le));
}
#endif
#if CUT > 0
static void launch_fast(void* const* d_in, void* d_out, void* d_ws, hipStream_t stream);
static void launch_conv(int b, void* const* d_in, void* d_ws, hipStream_t stream);
#endif
extern "C" void kernel_launch(void* const* d_in, const int* in_sizes, int n_in, void* d_out, int out_size, void* d_ws, size_t ws_size, hipStream_t stream) {
    if (n_in != 26 || out_size != T_TOK * DM || ws_size < WS_END) { fprintf(stderr, "kernel_launch: unexpected shapes n_in %d out %d ws %zu\n", n_in, out_size, ws_size); return; }
    unsigned char* ws = (unsigned char*)d_ws;
    const float* x = (const float*)d_in[0]; const float* p = (const float*)d_in[1]; const int* pos = (const int*)d_in[2];
    const float *g_mix = (const float*)d_in[3], *w_in = (const float*)d_in[4], *g_cq = (const float*)d_in[5], *w_uq = (const float*)d_in[6], *g_ckv = (const float*)d_in[7], *w_ukv = (const float*)d_in[8];
    const float *g_ln = (const float*)d_in[9], *b_ln = (const float*)d_in[10], *w_sgu = (const float*)d_in[11], *b_sgu = (const float*)d_in[12], *g_oa = (const float*)d_in[13], *g_os = (const float*)d_in[14];
    const float *w_out = (const float*)d_in[15], *g_ffn = (const float*)d_in[16], *w_pq = (const float*)d_in[17], *k1 = (const float*)d_in[18], *k2 = (const float*)d_in[19], *pu = (const float*)d_in[20], *pv = (const float*)d_in[21];
    const float *g_ple = (const float*)d_in[22], *w_pg = (const float*)d_in[23], *w_pp = (const float*)d_in[24], *g_fin = (const float*)d_in[25];
    float* out = (float*)d_out;
#if CUT > 0
    launch_fast(d_in, d_out, d_ws, stream);
#endif
#if CUT < 9
    constexpr int S0 = CUT + 1; constexpr int TB = nv::TBAT;
    float* A0 = (float*)(ws + WS_NA0); float* GL = (float*)(ws + WS_NGL); float* PP = (float*)(ws + WS_NPP);
    float* ZP = (float*)(ws + WS_NZP); float* CQN = (float*)(ws + WS_NCQN); float* CKVN = (float*)(ws + WS_NCKVN); float* QN = (float*)(ws + WS_NQN); float* KV = (float*)(ws + WS_NKV);
    float* VLN = (float*)(ws + WS_NVLN); float* OSGU = (float*)(ws + WS_NOSGU); float* OATT = (float*)(ws + WS_NOATT); float* QPN = (float*)(ws + WS_NQPN);
    for (int b = 0; b < NBATCH; ++b) {
        const size_t t0 = (size_t)b * TB; const float* xb = x + t0 * DM; const int* posb = pos + t0; const float* pb = p + t0 * 256;
        float* H1 = (float*)(ws + WS_H1) + t0 * DM; int* IDX = (int*)(ws + WS_IDX) + t0 * 128; float* GATE = (float*)(ws + WS_GATE) + t0 * 128; float* outb = out + t0 * DM;
#if CUT > 0
        launch_conv(b, d_in, d_ws, stream);
#endif
        if (S0 <= 1) {
            nv::nk_rmsnorm<<<TB, 256, 0, stream>>>(xb, DM, g_mix, A0, DM, DM);
            nv::nk_gemm<<<dim3(2880 / 64, TB / 64), 256, 0, stream>>>(A0, DM, w_in, 2880, ZP, 2880, nullptr, 0, DM);
            nv::nk_z_post<<<TB, 256, 0, stream>>>(ZP, posb);
        }
        if (S0 <= 2) {
            nv::nk_rmsnorm<<<TB, 256, 0, stream>>>(ZP, 2880, g_cq, CQN, 512, 512);
            nv::nk_gemm<<<dim3(1536 / 64, TB / 64), 256, 0, stream>>>(CQN, 512, w_uq, 1536, QN, 1536, nullptr, 0, 512);
            nv::nk_q_rope<<<TB, 256, 0, stream>>>(QN, posb);
            nv::nk_rmsnorm<<<TB, 256, 0, stream>>>(ZP + 512, 2880, g_ckv, CKVN, 256, 256);
            nv::nk_gemm<<<dim3(2048 / 64, TB / 64), 256, 0, stream>>>(CKVN, 256, w_ukv, 2048, KV, 2048, nullptr, 0, 256);
            nv::nk_ln_group<<<TB * 8 / 4, 256, 0, stream>>>(ZP, g_ln, b_ln, VLN);
            nv::nk_sgu<<<TB * 1024 / 256, 256, 0, stream>>>(ZP, VLN, w_sgu, b_sgu, OSGU);
        }
        if (S0 <= 3) nv::nk_attn<<<dim3(TB, 8), 256, 0, stream>>>(QN, KV, ZP, OATT);
        if (S0 <= 4) {
            nv::nk_rmsnorm<<<TB, 256, 0, stream>>>(OATT, 1024, g_oa, A0, DM, 1024);
            nv::nk_rmsnorm<<<TB, 256, 0, stream>>>(OSGU, 1024, g_os, A0 + 1024, DM, 1024);
            nv::nk_gemm<<<dim3(DM / 64, TB / 64), 256, 0, stream>>>(A0, DM, w_out, DM, H1, DM, xb, DM, DM);
        }
        if (S0 <= 5) {
            nv::nk_rmsnorm<<<TB, 256, 0, stream>>>(H1, DM, g_ffn, A0, DM, DM);
            nv::nk_gemm<<<dim3(DM / 64, TB / 64), 256, 0, stream>>>(A0, DM, w_pq, DM, QPN, DM, nullptr, 0, DM);
        }
        if (S0 <= 6) nv::nk_topk<<<TB * 8, 128, 0, stream>>>(QPN, k1, k2, IDX, GATE);
        if (S0 <= 7) {
            nv::nk_rmsnorm<<<TB, 256, 0, stream>>>(H1, DM, g_ffn, A0, DM, DM);
            nv::nk_gather<<<TB, 256, 0, stream>>>(H1, A0, IDX, GATE, pu, pv);
        }
        if (S0 <= 8) {
            nv::nk_rmsnorm<<<TB, 256, 0, stream>>>(H1, DM, g_ple, A0, DM, DM);
            nv::nk_gemm<<<dim3(DM / 64, TB / 64), 256, 0, stream>>>(A0, DM, w_pg, DM, GL, DM, nullptr, 0, DM);
            nv::nk_gemm<<<dim3(DM / 64, TB / 64), 256, 0, stream>>>(pb, 256, w_pp, DM, PP, DM, nullptr, 0, 256);
            nv::nk_ple<<<TB * DM / 256, 256, 0, stream>>>(H1, GL, PP, outb);
        }
        nv::nk_rmsnorm<<<TB, 256, 0, stream>>>(outb, DM, g_fin, outb, DM, DM);
    }
#endif
}
```
